# Optimizing an MI355X kernel written in HIP

```python
import jax, jax.numpy as jnp
from jax import lax
import numpy as np

D_MODEL = 1024
BATCH = 32
SEQ = 256
DEPTH = 4
DEC_BATCH = 2
DEC_SEQ = 2048
PAST_LEN = 512

GRID_W = 64
D_FF = 2816
F_GROUPS = 4
F_GC = 128
F_W = F_GROUPS * F_GC
MLA_HEADS = 8
MLA_Q_LORA = 384
MLA_KV_LORA = 256
MLA_NOPE = 64
MLA_ROPE = 32
MLA_V = 64
NA_HEADS = 8
NA_HEAD_DIM = 64
NA_KH = 8
NA_KW = 16
NA_W = NA_HEADS * NA_HEAD_DIM
IN_SPLITS = (F_W, F_W + MLA_Q_LORA, F_W + MLA_Q_LORA + MLA_KV_LORA, F_W + MLA_Q_LORA + MLA_KV_LORA + MLA_ROPE)
IN_W = F_W + MLA_Q_LORA + MLA_KV_LORA + MLA_ROPE + 3 * NA_W
ROPE_BASE = 10000.0
AXIS_DIM = MLA_ROPE // 2
Q_BLOCK = 128
ALPHA = (2.0 * DEPTH) ** 0.25
BETA = (8.0 * DEPTH) ** -0.25
MLA_SCALE = (MLA_NOPE + MLA_ROPE) ** -0.5
NA_SCALE = NA_HEAD_DIM ** -0.5
NEG_INF = -1e30
F32 = jnp.float32

kernel_name = 'hybrid_dit_fourier_mla_natten_step'


def _ln_plain(x, eps=1e-6):
    xf = x.astype(F32)
    mu = jnp.mean(xf, axis=-1, keepdims=True)
    var = jnp.mean(jnp.square(xf - mu), axis=-1, keepdims=True)
    return (xf - mu) * lax.rsqrt(var + eps)


def _layernorm(x, g, b):
    return (_ln_plain(x, 1e-5) * g.astype(F32) + b.astype(F32)).astype(x.dtype)


def _rmsnorm(x, g, eps=1e-6):
    xf = x.astype(F32)
    y = xf * lax.rsqrt(jnp.mean(jnp.square(xf), axis=-1, keepdims=True) + eps)
    return (y * g.astype(F32)).astype(x.dtype)


def _modulate(x, shift, scale):
    return (_ln_plain(x) * (1.0 + scale.astype(F32)) + shift.astype(F32)).astype(x.dtype)


def _adaln(cvec, w_ada, b_ada):
    return jnp.split(jax.nn.silu(cvec) @ w_ada + b_ada, 9, axis=-1)


def _swiglu(h, w1, w3, w2):
    return (jax.nn.silu(h @ w1) * (h @ w3)) @ w2


def _ffn_sublayer(x, shift, scale, gate, w1, w3, w2, g, b):
    y = _swiglu(_modulate(x, shift, scale), w1, w3, w2)
    return _layernorm(ALPHA * x + 0.5 * gate * y, g, b)


def _axial_rope_tables(n):
    t = jnp.arange(n, dtype=jnp.int32)
    pos = jnp.stack([t // GRID_W, t % GRID_W], axis=-1).astype(F32)
    half = AXIS_DIM // 2
    inv_freq = ROPE_BASE ** (-jnp.arange(half, dtype=F32) / half)
    ang = pos[:, :, None] * inv_freq
    ang = jnp.concatenate([ang, ang], axis=-1)
    return jnp.cos(ang), jnp.sin(ang)


def _apply_axial_rope(x, cos, sin):
    B, n, h, d = x.shape
    xr = x.reshape(B, n, h, 2, AXIS_DIM)
    x1 = xr[..., :AXIS_DIM // 2]
    x2 = xr[..., AXIS_DIM // 2:]
    rot = jnp.concatenate([-x2, x1], axis=-1)
    cs = cos[:, None].astype(x.dtype)
    sn = sin[:, None].astype(x.dtype)
    return (xr * cs + rot * sn).reshape(B, n, h, d)


def _block_attention(q, k, v, scale):
    B, Lq, H, dk = q.shape
    dv = v.shape[-1]
    nb = Lq // Q_BLOCK
    qb = jnp.moveaxis(q.reshape(B, nb, Q_BLOCK, H, dk), 1, 0)

    def one_block(qblk):
        s = jnp.einsum('bqhd,bkhd->bhqk', qblk, k).astype(F32) * scale
        p = jax.nn.softmax(s, axis=-1).astype(v.dtype)
        return jnp.einsum('bhqk,bkhd->bqhd', p, v)

    o = lax.map(one_block, qb)
    return jnp.moveaxis(o, 0, 1).reshape(B, Lq, H * dv)


def _neighbourhood_attention(q, k, v, k_ctx, v_ctx, rpb):
    B, N, H, dh = q.shape
    rows = N // GRID_W
    kh = min(NA_KH, rows)
    r = jnp.arange(rows, dtype=jnp.int32)
    col = jnp.arange(GRID_W, dtype=jnp.int32)
    row_start = jnp.clip(r - kh // 2, 0, rows - kh)
    row_idx = row_start[:, None] + jnp.arange(kh, dtype=jnp.int32)[None, :]
    col_start = jnp.clip(col - NA_KW // 2, 0, GRID_W - NA_KW)
    col_ok = (col[None, :] >= col_start[:, None]) & (col[None, :] < col_start[:, None] + NA_KW)
    qg = q.reshape(B, rows, GRID_W, H, dh)
    kg = k.reshape(B, rows, GRID_W, H, dh)[:, row_idx]
    vg = v.reshape(B, rows, GRID_W, H, dh)[:, row_idx]
    s_loc = jnp.einsum('brqhd,brkwhd->bhrqkw', qg, kg).astype(F32) * NA_SCALE
    dr = row_idx - r[:, None] + (NA_KH - 1)
    dc = jnp.clip(col[None, :] - col[:, None], -(NA_KW - 1), NA_KW - 1) + (NA_KW - 1)
    bias = rpb[:, dr[:, None, :, None], dc[None, :, None, :]]
    s_loc = s_loc + bias[None].astype(F32)
    s_loc = jnp.where(col_ok[None, None, None, :, None, :], s_loc, NEG_INF)
    s_ctx = jnp.einsum('brqhd,bchd->bhrqc', qg, k_ctx).astype(F32) * NA_SCALE
    n_loc = kh * GRID_W
    s = jnp.concatenate([s_loc.reshape(B, H, rows, GRID_W, n_loc), s_ctx], axis=-1)
    p = jax.nn.softmax(s, axis=-1).astype(v.dtype)
    p_loc = p[..., :n_loc].reshape(B, H, rows, GRID_W, kh, GRID_W)
    p_ctx = p[..., n_loc:]
    o = (jnp.einsum('bhrqkw,brkwhd->brqhd', p_loc, vg)
         + jnp.einsum('bhrqc,bchd->brqhd', p_ctx, v_ctx))
    return o.reshape(B, N, H * dh)


def _fourier(u_f):
    B, L, _ = u_f.shape
    f = u_f.reshape(B, L, F_GROUPS, F_GC).astype(F32)
    spec = jnp.fft.fft2(f, axes=(1, 3), norm='ortho').real
    return spec.reshape(B, L, F_W).astype(u_f.dtype)


def _mla_q(u_q, g, w_uq):
    B, L, _ = u_q.shape
    q = (_rmsnorm(u_q, g) @ w_uq).reshape(B, L, MLA_HEADS, MLA_NOPE + MLA_ROPE)
    return q[..., :MLA_NOPE], q[..., MLA_NOPE:]


def _mla_kv_up(c_kv, w_ukv):
    B, L, _ = c_kv.shape
    kv = (c_kv @ w_ukv).reshape(B, L, MLA_HEADS, MLA_NOPE + MLA_V)
    return kv[..., :MLA_NOPE], kv[..., MLA_NOPE:]


def _mla_keys(k_nope, k_rope):
    kr = jnp.broadcast_to(k_rope[:, :, None, :], k_nope.shape[:3] + (MLA_ROPE,))
    return jnp.concatenate([k_nope, kr], axis=-1)


def _na_qkv(u_na):
    B, L, _ = u_na.shape
    q, k, v = jnp.split(u_na, 3, axis=-1)
    return (q.reshape(B, L, NA_HEADS, NA_HEAD_DIM), k.reshape(B, L, NA_HEADS, NA_HEAD_DIM),
            v.reshape(B, L, NA_HEADS, NA_HEAD_DIM))


def _merge(h, y_f, y_m, y_n, p):
    g_f, g_m, g_n = jnp.split(jax.nn.sigmoid(h @ p['w_gate'] + p['b_gate']), 3, axis=-1)
    return (g_f * y_f + g_m * y_m + g_n * y_n) @ p['w_out']


def _mixer_context(h, p):
    u_f, u_q, u_kv, k_rope, u_na = jnp.split(h @ p['w_in'], IN_SPLITS, axis=-1)
    y_f = _fourier(u_f) @ p['w_branch_f']
    q_nope, q_rope = _mla_q(u_q, p['mla_q_norm'], p['mla_w_uq'])
    c_kv = _rmsnorm(u_kv, p['mla_kv_norm'])
    k_nope, v_m = _mla_kv_up(c_kv, p['mla_w_ukv'])
    q_m = jnp.concatenate([q_nope, q_rope], axis=-1)
    y_m = _block_attention(q_m, _mla_keys(k_nope, k_rope), v_m, MLA_SCALE) @ p['w_branch_m']
    q_n, k_n, v_n = _na_qkv(u_na)
    y_n = _block_attention(q_n, k_n, v_n, NA_SCALE) @ p['w_branch_n']
    return _merge(h, y_f, y_m, y_n, p), c_kv, k_rope, k_n, v_n


def _mixer_latent(h, p, ckv_ctx, krope_ctx, k_ctx, v_ctx):
    B, N, _ = h.shape
    cos, sin = _axial_rope_tables(N)
    u_f, u_q, u_kv, u_r, u_na = jnp.split(h @ p['w_in'], IN_SPLITS, axis=-1)
    y_f = _fourier(u_f) @ p['w_branch_f']
    q_nope, q_rope = _mla_q(u_q, p['mla_q_norm'], p['mla_w_uq'])
    q_m = jnp.concatenate([q_nope, _apply_axial_rope(q_rope, cos, sin)], axis=-1)
    c_kv = _rmsnorm(u_kv, p['mla_kv_norm'])
    k_nope, v_m = _mla_kv_up(c_kv, p['mla_w_ukv'])
    k_rope = _apply_axial_rope(u_r[:, :, None, :], cos, sin)[:, :, 0, :]
    k_nope_c, v_c = _mla_kv_up(ckv_ctx, p['mla_w_ukv'])
    k_all = jnp.concatenate([_mla_keys(k_nope, k_rope), _mla_keys(k_nope_c, krope_ctx)], axis=1)
    v_all = jnp.concatenate([v_m, v_c], axis=1)
    y_m = _block_attention(q_m, k_all, v_all, MLA_SCALE) @ p['w_branch_m']
    q_n, k_n, v_n = _na_qkv(u_na)
    y_n = _neighbourhood_attention(q_n, k_n, v_n, k_ctx, v_ctx, p['na_rpb']) @ p['w_branch_n']
    return _merge(h, y_f, y_m, y_n, p)


def setup_inputs(seed: int = 0) -> dict:
    key = jax.random.key(seed)
    ks = list(jax.random.split(key, 40))

    def nrm(i, shape, s):
        return jax.random.normal(ks[i], shape, F32) * s

    D = D_MODEL
    return {
        'x_prompt': nrm(0, (BATCH, SEQ, D), 1.0),
        'x_sample': nrm(1, (DEC_BATCH, DEC_SEQ, D), 1.0),
        'cache_mla_ckv': nrm(2, (DEC_BATCH, DEPTH, PAST_LEN, MLA_KV_LORA), 1.0),
        'cache_mla_krope': nrm(3, (DEC_BATCH, DEPTH, PAST_LEN, MLA_ROPE), 1.0),
        'cache_na_k': nrm(4, (DEC_BATCH, DEPTH, PAST_LEN, NA_HEADS, NA_HEAD_DIM), 1.0),
        'cache_na_v': nrm(5, (DEC_BATCH, DEPTH, PAST_LEN, NA_HEADS, NA_HEAD_DIM), 1.0),
        'c': nrm(6, (DEC_BATCH, D), 1.0),
        'c_ctx': nrm(7, (D,), 1.0),
        'w_ada': nrm(8, (DEPTH, D, 9 * D), 0.5 * D ** -0.5),
        'b_ada': nrm(9, (DEPTH, 9 * D), 0.01),
        'ffn1_w1': nrm(10, (DEPTH, D, D_FF), D ** -0.5),
        'ffn1_w3': nrm(11, (DEPTH, D, D_FF), D ** -0.5),
        'ffn1_w2': nrm(12, (DEPTH, D_FF, D), BETA * D_FF ** -0.5),
        'ffn2_w1': nrm(13, (DEPTH, D, D_FF), D ** -0.5),
        'ffn2_w3': nrm(14, (DEPTH, D, D_FF), D ** -0.5),
        'ffn2_w2': nrm(15, (DEPTH, D_FF, D), BETA * D_FF ** -0.5),
        'w_in': nrm(16, (DEPTH, D, IN_W), D ** -0.5),
        'mla_q_norm': 1.0 + nrm(17, (DEPTH, MLA_Q_LORA), 0.01),
        'mla_w_uq': nrm(18, (DEPTH, MLA_Q_LORA, MLA_HEADS * (MLA_NOPE + MLA_ROPE)), MLA_Q_LORA ** -0.5),
        'mla_kv_norm': 1.0 + nrm(19, (DEPTH, MLA_KV_LORA), 0.01),
        'mla_w_ukv': nrm(20, (DEPTH, MLA_KV_LORA, MLA_HEADS * (MLA_NOPE + MLA_V)), MLA_KV_LORA ** -0.5),
        'na_rpb': nrm(21, (DEPTH, NA_HEADS, 2 * NA_KH - 1, 2 * NA_KW - 1), 0.1),
        'w_branch_f': nrm(22, (DEPTH, F_W, D), BETA * F_W ** -0.5),
        'w_branch_m': nrm(23, (DEPTH, MLA_HEADS * MLA_V, D), BETA * (MLA_HEADS * MLA_V) ** -0.5),
        'w_branch_n': nrm(24, (DEPTH, NA_W, D), BETA * NA_W ** -0.5),
        'w_gate': nrm(25, (DEPTH, D, 3 * D), D ** -0.5),
        'b_gate': nrm(26, (DEPTH, 3 * D), 0.01),
        'w_out': nrm(27, (DEPTH, D, D), BETA * D ** -0.5),
        'ln_g': 1.0 + nrm(28, (DEPTH, 3, D), 0.01),
        'ln_b': nrm(29, (DEPTH, 3, D), 0.01),
    }


def reference(x_prompt, x_sample, cache_mla_ckv, cache_mla_krope, cache_na_k, cache_na_v, c, c_ctx,
              w_ada, b_ada, ffn1_w1, ffn1_w3, ffn1_w2, ffn2_w1, ffn2_w3, ffn2_w2, w_in,
              mla_q_norm, mla_w_uq, mla_kv_norm, mla_w_ukv, na_rpb, w_branch_f, w_branch_m, w_branch_n,
              w_gate, b_gate, w_out, ln_g, ln_b):
    xp = x_prompt
    xs = x_sample
    ckv_list, krope_list, nak_list, nav_list = [], [], [], []
    c_lat = c[:, None, :]
    for l in range(DEPTH):
        p = {'w_in': w_in[l], 'mla_q_norm': mla_q_norm[l], 'mla_w_uq': mla_w_uq[l],
             'mla_kv_norm': mla_kv_norm[l], 'mla_w_ukv': mla_w_ukv[l], 'na_rpb': na_rpb[l],
             'w_branch_f': w_branch_f[l], 'w_branch_m': w_branch_m[l], 'w_branch_n': w_branch_n[l],
             'w_gate': w_gate[l], 'b_gate': b_gate[l], 'w_out': w_out[l]}
        m = _adaln(c_ctx, w_ada[l], b_ada[l])
        xp = _ffn_sublayer(xp, m[0], m[1], m[2], ffn1_w1[l], ffn1_w3[l], ffn1_w2[l], ln_g[l, 0], ln_b[l, 0])
        mix, ckv, krope, nak, nav = _mixer_context(_modulate(xp, m[3], m[4]), p)
        xp = _layernorm(ALPHA * xp + m[5] * mix, ln_g[l, 1], ln_b[l, 1])
        xp = _ffn_sublayer(xp, m[6], m[7], m[8], ffn2_w1[l], ffn2_w3[l], ffn2_w2[l], ln_g[l, 2], ln_b[l, 2])
        ckv_list.append(ckv)
        krope_list.append(krope)
        nak_list.append(nak)
        nav_list.append(nav)
        ms = _adaln(c_lat, w_ada[l], b_ada[l])
        xs = _ffn_sublayer(xs, ms[0], ms[1], ms[2], ffn1_w1[l], ffn1_w3[l], ffn1_w2[l], ln_g[l, 0], ln_b[l, 0])
        mix_s = _mixer_latent(_modulate(xs, ms[3], ms[4]), p, cache_mla_ckv[:, l], cache_mla_krope[:, l],
                              cache_na_k[:, l], cache_na_v[:, l])
        xs = _layernorm(ALPHA * xs + ms[5] * mix_s, ln_g[l, 1], ln_b[l, 1])
        xs = _ffn_sublayer(xs, ms[6], ms[7], ms[8], ffn2_w1[l], ffn2_w3[l], ffn2_w2[l], ln_g[l, 2], ln_b[l, 2])
    new_mla_ckv = jnp.stack(ckv_list, axis=1)
    new_mla_krope = jnp.stack(krope_list, axis=1)
    new_na_k = jnp.stack(nak_list, axis=1)
    new_na_v = jnp.stack(nav_list, axis=1)
    return (xp, xs, new_mla_ckv, new_mla_krope, new_na_k, new_na_v)
```

```cpp
#include <hip/hip_runtime.h>
#include <hip/hip_cooperative_groups.h>
#include <cstdint>
#include <cstdio>
namespace cg = cooperative_groups;

typedef unsigned short bf16_t;
typedef short bf16x8 __attribute__((ext_vector_type(8)));
typedef float f32x16 __attribute__((ext_vector_type(16)));
typedef float f32x4 __attribute__((ext_vector_type(4)));
typedef unsigned u32x4 __attribute__((ext_vector_type(4)));
typedef unsigned u32x2 __attribute__((ext_vector_type(2)));
#define DEVI __device__ __forceinline__

constexpr int D = 1024, NCTX = 8192, NLAT = 4096, M = 12288, MX = 13312, DFF = 2816, NL = 4;
constexpr float ALPHA_F = 1.6817928305074290f;
constexpr float LOG2E = 1.4426950408889634f;
constexpr float MLA_QS = 0.10206207261596575f * LOG2E;
constexpr float NA_QS = 0.125f * LOG2E;
constexpr size_t OUT_CKV = 12582912, OUT_KR = 20971520, OUT_NAK = 22020096, OUT_NAV = 38797312;

constexpr size_t al256(size_t x) { return (x + 255) & ~(size_t)255; }
constexpr size_t WS_X = 0;
constexpr size_t WS_H = WS_X + (size_t)M * D * 4;
constexpr size_t WS_MOD = WS_H + (size_t)M * D * 2;
constexpr size_t WS_MODP = WS_MOD + al256((size_t)NL * 3 * 9216 * 4);
constexpr size_t WS_ROPE = WS_MODP + al256((size_t)NL * 16 * 3 * 9216 * 4);
constexpr size_t WS_TABC = WS_ROPE + 4096;
constexpr size_t WS_TABL = WS_TABC + (size_t)256 * 512 * 2;
constexpr size_t WS_WCS = WS_TABL + (size_t)2048 * 4096 * 2;
constexpr size_t WS_CCKV = WS_WCS + (size_t)256 * 128 * 2;
constexpr size_t WS_CKR = WS_CCKV + (size_t)NL * 1024 * 256 * 2;
constexpr size_t WS_CNAK = WS_CKR + (size_t)NL * 1024 * 32 * 2;
constexpr size_t WS_CNAVT = WS_CNAK + (size_t)NL * 1024 * 512 * 2;
constexpr size_t WS_W = WS_CNAVT + (size_t)NL * 1024 * 512 * 2;
constexpr size_t OFF_W13_1 = 0, OFF_W2_1 = 5767168, OFF_W13_2 = 8650752, OFF_W2_2 = 14417920, OFF_WIN = 17301504,
                 OFF_WOUT = 23330816, OFF_WBF = 24379392, OFF_WBM = 24903680, OFF_WBN = 25427968, OFF_WUQ = 25952256,
                 OFF_WUKV = 26247168, LAYER_W = 26509312;
constexpr size_t WS_R1 = WS_W + (size_t)NL * LAYER_W * 2;
constexpr size_t WS_ACT = WS_R1;
constexpr size_t WS_UF = WS_R1;
constexpr size_t WS_UQ = WS_UF + (size_t)M * 512 * 2;
constexpr size_t WS_UKV = WS_UQ + (size_t)M * 384 * 2;
constexpr size_t WS_KRF = WS_UKV + (size_t)M * 256 * 4;
constexpr size_t WS_CKV = WS_KRF + (size_t)M * 32 * 4;
constexpr size_t WS_KR = WS_CKV + (size_t)M * 256 * 2;
constexpr size_t WS_NAQ = WS_KR + (size_t)M * 32 * 2;
constexpr size_t WS_NAK = WS_NAQ + (size_t)M * 512 * 2;
constexpr size_t WS_NAVT = WS_NAK + (size_t)M * 512 * 2;
constexpr size_t WS_GATE = WS_NAVT + (size_t)M * 512 * 2;
constexpr size_t WS_Q = WS_GATE + (size_t)M * 3072 * 2;
constexpr size_t WS_KN = WS_Q + (size_t)M * 768 * 2;
constexpr size_t WS_VTM = WS_KN + (size_t)MX * 512 * 2;
constexpr size_t WS_F1T = WS_VTM + (size_t)MX * 512 * 2;
constexpr size_t WS_YF = WS_F1T + (size_t)M * 1024 * 2;
constexpr size_t WS_YM = WS_YF + (size_t)M * 512 * 2;
constexpr size_t WS_YN = WS_YM + (size_t)M * 512 * 2;
constexpr size_t WS_MERGED = WS_YN + (size_t)M * 512 * 2;
constexpr size_t WS_END = WS_MERGED + (size_t)M * 1024 * 2;
static_assert(WS_END - WS_R1 >= (size_t)M * DFF * 2, "ACT must fit in R1");

constexpr int NPHASE = 3 + 13 * NL;

struct P {
    const float* in[30];
    float* out;
    unsigned char* ws;
    int ph_lo, ph_hi;
};

typedef __bf16 bf16v2 __attribute__((ext_vector_type(2)));
typedef float f32x2 __attribute__((ext_vector_type(2)));
DEVI unsigned pk2(float lo, float hi) { f32x2 v = {lo, hi}; bf16v2 b = __builtin_convertvector(v, bf16v2); return __builtin_bit_cast(unsigned, b); }
DEVI bf16_t f2bf(float x) { return (bf16_t)(pk2(x, 0.f) & 0xffffu); }
DEVI float bf2f(unsigned v) { return __uint_as_float(v << 16); }
DEVI float wave_sum(float v) {
#pragma unroll
    for (int o = 1; o < 64; o <<= 1) v += __shfl_xor(v, o);
    return v;
}
DEVI float fast_exp2(float x) { return __builtin_amdgcn_exp2f(x); }
DEVI float sigmoidf_(float x) { return 1.f / (1.f + __expf(-x)); }

constexpr int LDT = 72;
constexpr int TILE_E = 128 * LDT;
constexpr int SMEM_BYTES = 4 * TILE_E * 2;

DEVI void gemm_core(const bf16_t* __restrict__ A, int lda, const bf16_t* __restrict__ B, int ldb, int K,
                    f32x16 (&acc)[2][2], bf16_t* smem, int tid) {
    const int lane = tid & 63, wave = tid >> 6, wr = wave >> 1, wc = wave & 1;
    const int lr = tid >> 3, lc = (tid & 7) * 8;
    const bf16_t* ga = A + (size_t)lr * lda + lc;
    const bf16_t* gb = B + (size_t)lr * ldb + lc;
    u32x4 ra[4], rb[4];
#pragma unroll
    for (int i = 0; i < 4; ++i) {
        ra[i] = *(const u32x4*)(ga + (size_t)(32 * i) * lda);
        rb[i] = *(const u32x4*)(gb + (size_t)(32 * i) * ldb);
    }
    const int soff = lr * LDT + lc;
#pragma unroll
    for (int i = 0; i < 4; ++i) {
        *(u32x4*)(smem + soff + 32 * i * LDT) = ra[i];
        *(u32x4*)(smem + TILE_E + soff + 32 * i * LDT) = rb[i];
    }
    __syncthreads();
    const int nk = K >> 6;
    const int aoff = (wr * 64 + (lane & 31)) * LDT + (lane >> 5) * 8;
    const int boff = TILE_E + (wc * 64 + (lane & 31)) * LDT + (lane >> 5) * 8;
    for (int kt = 0; kt < nk; ++kt) {
        const bf16_t* cur = smem + (kt & 1) * 2 * TILE_E;
        const bool more = (kt + 1 < nk);
        if (more) {
            ga += 64; gb += 64;
#pragma unroll
            for (int i = 0; i < 4; ++i) {
                ra[i] = *(const u32x4*)(ga + (size_t)(32 * i) * lda);
                rb[i] = *(const u32x4*)(gb + (size_t)(32 * i) * ldb);
            }
        }
#pragma unroll
        for (int ks = 0; ks < 4; ++ks) {
            bf16x8 a0 = *(const bf16x8*)(cur + aoff + ks * 16);
            bf16x8 a1 = *(const bf16x8*)(cur + aoff + 32 * LDT + ks * 16);
            bf16x8 b0 = *(const bf16x8*)(cur + boff + ks * 16);
            bf16x8 b1 = *(const bf16x8*)(cur + boff + 32 * LDT + ks * 16);
            acc[0][0] = __builtin_amdgcn_mfma_f32_32x32x16_bf16(a0, b0, acc[0][0], 0, 0, 0);
            acc[0][1] = __builtin_amdgcn_mfma_f32_32x32x16_bf16(a0, b1, acc[0][1], 0, 0, 0);
            acc[1][0] = __builtin_amdgcn_mfma_f32_32x32x16_bf16(a1, b0, acc[1][0], 0, 0, 0);
            acc[1][1] = __builtin_amdgcn_mfma_f32_32x32x16_bf16(a1, b1, acc[1][1], 0, 0, 0);
        }
        if (more) {
            bf16_t* nxt = smem + ((kt + 1) & 1) * 2 * TILE_E;
#pragma unroll
            for (int i = 0; i < 4; ++i) {
                *(u32x4*)(nxt + soff + 32 * i * LDT) = ra[i];
                *(u32x4*)(nxt + TILE_E + soff + 32 * i * LDT) = rb[i];
            }
        }
        __syncthreads();
    }
}

DEVI void zero_acc(f32x16 (&acc)[2][2]) {
#pragma unroll
    for (int i = 0; i < 2; ++i)
#pragma unroll
        for (int j = 0; j < 2; ++j)
#pragma unroll
            for (int r = 0; r < 16; ++r) acc[i][j][r] = 0.f;
}

#define EPI_SETUP const int lane = tid & 63, wave = tid >> 6, wr = wave >> 1, wc = wave & 1, hl = lane >> 5, c32 = lane & 31; (void)wr; (void)wc; (void)hl; (void)c32;

DEVI int mod_group(int row) { return row < NCTX ? 0 : 1 + ((row - NCTX) >> 11); }

DEVI void job_ffn_up(const P& p, int l, int which, int t, bf16_t* sm, int tid) {
    const int nN = 44; const int m0 = (t / nN) * 128, n0 = (t % nN) * 128;
    const bf16_t* H = (const bf16_t*)(p.ws + WS_H);
    const bf16_t* W = (const bf16_t*)(p.ws + WS_W) + (size_t)l * LAYER_W + (which ? OFF_W13_2 : OFF_W13_1);
    bf16_t* ACT = (bf16_t*)(p.ws + WS_ACT);
    f32x16 acc[2][2]; zero_acc(acc);
    gemm_core(H + (size_t)m0 * D, D, W + (size_t)n0 * D, D, D, acc, sm, tid);
    EPI_SETUP
    const int oc = (n0 >> 1) + wc * 32 + c32;
#pragma unroll
    for (int i = 0; i < 2; ++i) {
        const int rb = m0 + wr * 64 + i * 32 + 4 * hl;
#pragma unroll
        for (int r = 0; r < 16; ++r) {
            const int row = rb + (r & 3) + 8 * (r >> 2);
            const float a = acc[i][0][r], b = acc[i][1][r];
            const float v = a * sigmoidf_(a) * b;
            ACT[(size_t)row * DFF + oc] = f2bf(v);
        }
    }
}

DEVI void job_resid(const P& p, const bf16_t* A, int lda, const bf16_t* Bt, int K, const float* gate_base, float coef, int t, bf16_t* sm, int tid) {
    const int nN = 8; const int m0 = (t / nN) * 128, n0 = (t % nN) * 128;
    float* X = (float*)(p.ws + WS_X);
    f32x16 acc[2][2]; zero_acc(acc);
    gemm_core(A + (size_t)m0 * lda, lda, Bt + (size_t)n0 * K, K, K, acc, sm, tid);
    EPI_SETUP
    const float* gate = gate_base + (size_t)mod_group(m0) * 9216;
#pragma unroll
    for (int j = 0; j < 2; ++j) {
        const int col = n0 + wc * 64 + j * 32 + c32;
        const float gv = coef * gate[col];
#pragma unroll
        for (int i = 0; i < 2; ++i) {
            const int rb = m0 + wr * 64 + i * 32 + 4 * hl;
#pragma unroll
            for (int r = 0; r < 16; ++r) {
                const int row = rb + (r & 3) + 8 * (r >> 2);
                float* xp = X + (size_t)row * D + col;
                *xp = ALPHA_F * (*xp) + gv * acc[i][j][r];
            }
        }
    }
}

DEVI void job_in(const P& p, int l, int t, bf16_t* sm, int tid) {
    const int nN = 46; const int m0 = (t / nN) * 128, n0 = (t % nN) * 128;
    const bf16_t* H = (const bf16_t*)(p.ws + WS_H);
    const bf16_t* W = (const bf16_t*)(p.ws + WS_W) + (size_t)l * LAYER_W + OFF_WIN;
    f32x16 acc[2][2]; zero_acc(acc);
    gemm_core(H + (size_t)m0 * D, D, W + (size_t)n0 * D, D, D, acc, sm, tid);
    EPI_SETUP
    const bool ctx = m0 < NCTX;
#pragma unroll
    for (int j = 0; j < 2; ++j) {
        const int col = n0 + wc * 64 + j * 32 + c32;
#pragma unroll
        for (int i = 0; i < 2; ++i) {
            const int rb = m0 + wr * 64 + i * 32 + 4 * hl;
            if (n0 < 512) {
                bf16_t* O = (bf16_t*)(p.ws + WS_UF);
#pragma unroll
                for (int r = 0; r < 16; ++r) O[(size_t)(rb + (r & 3) + 8 * (r >> 2)) * 512 + col] = f2bf(acc[i][j][r]);
            } else if (n0 < 896) {
                bf16_t* O = (bf16_t*)(p.ws + WS_UQ);
#pragma unroll
                for (int r = 0; r < 16; ++r) O[(size_t)(rb + (r & 3) + 8 * (r >> 2)) * 384 + (col - 512)] = f2bf(acc[i][j][r]);
            } else if (n0 < 1152) {
                float* O = (float*)(p.ws + WS_UKV);
#pragma unroll
                for (int r = 0; r < 16; ++r) O[(size_t)(rb + (r & 3) + 8 * (r >> 2)) * 256 + (col - 896)] = acc[i][j][r];
            } else if (n0 < 1280) {
                if (col < 1184) {
                    float* O = (float*)(p.ws + WS_KRF);
#pragma unroll
                    for (int r = 0; r < 16; ++r) O[(size_t)(rb + (r & 3) + 8 * (r >> 2)) * 32 + (col - 1152)] = acc[i][j][r];
                }
            } else if (n0 < 1792) {
                bf16_t* O = (bf16_t*)(p.ws + WS_NAQ);
#pragma unroll
                for (int r = 0; r < 16; ++r) O[(size_t)(rb + (r & 3) + 8 * (r >> 2)) * 512 + (col - 1280)] = f2bf(acc[i][j][r] * NA_QS);
            } else if (n0 < 2304) {
                bf16_t* O = (bf16_t*)(p.ws + WS_NAK);
                const int cc = col - 1792;
#pragma unroll
                for (int r = 0; r < 16; ++r) {
                    const int row = rb + (r & 3) + 8 * (r >> 2);
                    O[(size_t)row * 512 + cc] = f2bf(acc[i][j][r]);
                    if (ctx) p.out[OUT_NAK + ((size_t)((row >> 8) * 4 + l) * 256 + (row & 255)) * 512 + cc] = acc[i][j][r];
                }
            } else if (n0 < 2816) {
                bf16_t* VT = (bf16_t*)(p.ws + WS_NAVT);
                const int cc = col - 2304, h = cc >> 6, d = cc & 63;
#pragma unroll
                for (int qd = 0; qd < 4; ++qd) {
                    const int row = rb + 8 * qd;
                    u32x2 pk; pk.x = pk2(acc[i][j][4 * qd], acc[i][j][4 * qd + 1]); pk.y = pk2(acc[i][j][4 * qd + 2], acc[i][j][4 * qd + 3]);
                    if (ctx) {
                        const int b = row >> 8, s = row & 255;
                        *(u32x2*)(VT + ((size_t)((b * 8 + h) * 64 + d)) * 256 + s) = pk;
#pragma unroll
                        for (int e = 0; e < 4; ++e)
                            p.out[OUT_NAV + ((size_t)(b * 4 + l) * 256 + (s + e)) * 512 + cc] = acc[i][j][4 * qd + e];
                    } else {
                        const int rr = row - NCTX, b = rr >> 11, n = rr & 2047;
                        *(u32x2*)(VT + (size_t)4194304 + ((size_t)((b * 8 + h) * 64 + d)) * 2048 + n) = pk;
                    }
                }
            } else {
                bf16_t* O = (bf16_t*)(p.ws + WS_GATE);
                const int gc = col - 2816;
                const float bg = p.in[26][l * 3072 + gc];
                bf16_t* gp = O + (size_t)gc * M + rb;
#pragma unroll
                for (int qd = 0; qd < 4; ++qd) {
                    u32x2 pk;
                    pk.x = pk2(sigmoidf_(acc[i][j][4 * qd] + bg), sigmoidf_(acc[i][j][4 * qd + 1] + bg));
                    pk.y = pk2(sigmoidf_(acc[i][j][4 * qd + 2] + bg), sigmoidf_(acc[i][j][4 * qd + 3] + bg));
                    *(u32x2*)(gp + 8 * qd) = pk;
                }
            }
        }
    }
}

DEVI void job_uq(const P& p, int l, int t, bf16_t* sm, int tid) {
    const int nN = 6; const int m0 = (t / nN) * 128, n0 = (t % nN) * 128;
    const bf16_t* A = (const bf16_t*)(p.ws + WS_UQ);
    const bf16_t* W = (const bf16_t*)(p.ws + WS_W) + (size_t)l * LAYER_W + OFF_WUQ;
    bf16_t* Q = (bf16_t*)(p.ws + WS_Q);
    const float* ropec = (const float*)(p.ws + WS_ROPE);
    const float* ropes = ropec + 512;
    f32x16 acc[2][2]; zero_acc(acc);
    gemm_core(A + (size_t)m0 * 384, 384, W + (size_t)n0 * 384, 384, 384, acc, sm, tid);
    EPI_SETUP
    const bool lat = m0 >= NCTX;
#pragma unroll
    for (int j = 0; j < 2; ++j) {
        const int c0 = n0 + wc * 64 + j * 32;
        const int col = c0 + c32;
        const bool rope = lat && (((c0 >> 5) % 3) == 2);
        const int axis = c32 >> 4, ii = c32 & 15;
#pragma unroll
        for (int i = 0; i < 2; ++i) {
            const int rb = m0 + wr * 64 + i * 32 + 4 * hl;
#pragma unroll
            for (int r = 0; r < 16; ++r) {
                const int row = rb + (r & 3) + 8 * (r >> 2);
                float v = acc[i][j][r];
                const float pr = __shfl_xor(v, 8);
                if (rope) {
                    const int n = (row - NCTX) & 2047;
                    const int pos = axis ? (n & 63) : (n >> 6);
                    const float cs = ropec[pos * 8 + (ii & 7)], sn = ropes[pos * 8 + (ii & 7)];
                    const float rot = (ii < 8) ? -pr : pr;
                    v = v * cs + rot * sn;
                }
                Q[(size_t)row * 768 + col] = f2bf(v * MLA_QS);
            }
        }
    }
}

DEVI void job_ukv(const P& p, int l, int t, bf16_t* sm, int tid) {
    const int nN = 8; const int m0 = (t / nN) * 128, h = t % nN, n0 = h * 128;
    const bf16_t* A = (m0 < M) ? (const bf16_t*)(p.ws + WS_CKV) + (size_t)m0 * 256
                               : (const bf16_t*)(p.ws + WS_CCKV) + ((size_t)l * 1024 + (m0 - M)) * 256;
    const bf16_t* W = (const bf16_t*)(p.ws + WS_W) + (size_t)l * LAYER_W + OFF_WUKV;
    bf16_t* KN = (bf16_t*)(p.ws + WS_KN);
    bf16_t* VT = (bf16_t*)(p.ws + WS_VTM);
    f32x16 acc[2][2]; zero_acc(acc);
    gemm_core(A, 256, W + (size_t)n0 * 256, 256, 256, acc, sm, tid);
    EPI_SETUP
#pragma unroll
    for (int j = 0; j < 2; ++j) {
        const int d = j * 32 + c32;
#pragma unroll
        for (int i = 0; i < 2; ++i) {
            const int rb = m0 + wr * 64 + i * 32 + 4 * hl;
            if (wc == 0) {
#pragma unroll
                for (int r = 0; r < 16; ++r) KN[(size_t)(rb + (r & 3) + 8 * (r >> 2)) * 512 + h * 64 + d] = f2bf(acc[i][j][r]);
            } else {
#pragma unroll
                for (int qd = 0; qd < 4; ++qd) {
                    const int row = rb + 8 * qd;
                    u32x2 pk; pk.x = pk2(acc[i][j][4 * qd], acc[i][j][4 * qd + 1]); pk.y = pk2(acc[i][j][4 * qd + 2], acc[i][j][4 * qd + 3]);
                    size_t addr;
                    if (m0 < NCTX) { const int b = row >> 8, s = row & 255; addr = ((size_t)((b * 8 + h) * 64 + d)) * 256 + s; }
                    else if (m0 < M) { const int rr = row - NCTX, b = rr >> 11, n = rr & 2047; addr = (size_t)4194304 + ((size_t)((b * 8 + h) * 64 + d)) * 2560 + n; }
                    else { const int rr = row - M, b = rr >> 9, n = rr & 511; addr = (size_t)4194304 + ((size_t)((b * 8 + h) * 64 + d)) * 2560 + 2048 + n; }
                    *(u32x2*)(VT + addr) = pk;
                }
            }
        }
    }
}

template <int ldo>
DEVI void job_store(const bf16_t* A, int lda, const bf16_t* Bt, int ldb, int K, bf16_t* Out, bf16_t* sm, int tid) {
    f32x16 acc[2][2]; zero_acc(acc);
    gemm_core(A, lda, Bt, ldb, K, acc, sm, tid);
    EPI_SETUP
    bf16_t* st = sm + (wr * 64 + 4 * hl) * 136 + wc * 64 + c32;
#pragma unroll
    for (int i = 0; i < 2; ++i)
#pragma unroll
        for (int j = 0; j < 2; ++j)
#pragma unroll
            for (int r = 0; r < 16; ++r) st[(i * 32 + (r & 3) + 8 * (r >> 2)) * 136 + j * 32] = f2bf(acc[i][j][r]);
    __syncthreads();
    const int orow = tid >> 4, oc = (tid & 15) * 8;
#pragma unroll
    for (int k = 0; k < 8; ++k) {
        const u32x4 v = *(const u32x4*)(sm + (orow + 16 * k) * 136 + oc);
        *(u32x4*)(Out + (size_t)(orow + 16 * k) * ldo + oc) = v;
    }
    __syncthreads();
}

DEVI void job_f1(const P& p, int t, bf16_t* sm, int tid) {
    const bf16_t* WCS = (const bf16_t*)(p.ws + WS_WCS);
    const bf16_t* UF = (const bf16_t*)(p.ws + WS_UF);
    bf16_t* F1T = (bf16_t*)(p.ws + WS_F1T);
    if (t < 512) {
        const int bs = t >> 4, g = (t >> 2) & 3, mi = (t >> 1) & 1, ni = t & 1;
        job_store<256>(WCS + mi * 128 * 128, 128, UF + ((size_t)bs * 256 + ni * 128) * 512 + g * 128, 512, 128,
                  F1T + ((size_t)(bs * 4 + g) * 256 + mi * 128) * 256 + ni * 128, sm, tid);
    } else {
        t -= 512;
        const int bs = t >> 7, g = (t >> 5) & 3, mi = (t >> 4) & 1, ni = t & 15;
        job_store<2048>(WCS + mi * 128 * 128, 128, UF + ((size_t)NCTX + bs * 2048 + ni * 128) * 512 + g * 128, 512, 128,
                  F1T + (size_t)8388608 + ((size_t)(bs * 4 + g) * 256 + mi * 128) * 2048 + ni * 128, sm, tid);
    }
}
DEVI void job_f2_lat(const P& p, int t, bf16_t* sm, int tid) {
    const int bs = t >> 6, mi = (t >> 2) & 15, ni = t & 3;
    const bf16_t* TAB = (const bf16_t*)(p.ws + WS_TABL);
    const bf16_t* F1T = (const bf16_t*)(p.ws + WS_F1T) + (size_t)8388608;
    bf16_t* YF = (bf16_t*)(p.ws + WS_YF);
    job_store<512>(TAB + (size_t)mi * 128 * 4096, 4096, F1T + (size_t)bs * 512 * 4096 + (size_t)ni * 128 * 4096, 4096, 4096,
              YF + ((size_t)NCTX + bs * 2048 + mi * 128) * 512 + ni * 128, sm, tid);
}
DEVI void job_f2_ctx(const P& p, int t, bf16_t* sm, int tid) {
    const int bs = t >> 3, mi = (t >> 2) & 1, ni = t & 3;
    const bf16_t* TAB = (const bf16_t*)(p.ws + WS_TABC);
    const bf16_t* F1T = (const bf16_t*)(p.ws + WS_F1T);
    bf16_t* YF = (bf16_t*)(p.ws + WS_YF);
    job_store<512>(TAB + (size_t)mi * 128 * 512, 512, F1T + (size_t)bs * 512 * 512 + (size_t)ni * 128 * 512, 512, 512,
              YF + ((size_t)bs * 256 + mi * 128) * 512 + ni * 128, sm, tid);
}

DEVI void job_merge(const P& p, int l, int t, bf16_t* sm, int tid) {
    const int nN = 8; const int m0 = (t / nN) * 128, n0 = (t % nN) * 128;
    const bf16_t* Wl = (const bf16_t*)(p.ws + WS_W) + (size_t)l * LAYER_W;
    const bf16_t* GATE = (const bf16_t*)(p.ws + WS_GATE);
    bf16_t* MG = (bf16_t*)(p.ws + WS_MERGED);
    EPI_SETUP
    f32x16 tot[2][2]; zero_acc(tot);
#pragma unroll 1
    for (int s = 0; s < 3; ++s) {
        const bf16_t* A = (const bf16_t*)(p.ws + (s == 0 ? WS_YF : (s == 1 ? WS_YM : WS_YN)));
        const bf16_t* W = Wl + (s == 0 ? OFF_WBF : (s == 1 ? OFF_WBM : OFF_WBN));
        f32x16 acc[2][2]; zero_acc(acc);
        gemm_core(A + (size_t)m0 * 512, 512, W + (size_t)n0 * 512, 512, 512, acc, sm, tid);
#pragma unroll
        for (int j = 0; j < 2; ++j) {
            const int col = n0 + wc * 64 + j * 32 + c32;
#pragma unroll
            for (int i = 0; i < 2; ++i) {
                const int rb = m0 + wr * 64 + i * 32 + 4 * hl;
                const bf16_t* gp = GATE + (size_t)(s * 1024 + col) * M + rb;
#pragma unroll
                for (int qd = 0; qd < 4; ++qd) {
                    const u32x2 g = *(const u32x2*)(gp + 8 * qd);
                    tot[i][j][4 * qd + 0] += bf2f(g.x & 0xffffu) * acc[i][j][4 * qd + 0];
                    tot[i][j][4 * qd + 1] += bf2f(g.x >> 16) * acc[i][j][4 * qd + 1];
                    tot[i][j][4 * qd + 2] += bf2f(g.y & 0xffffu) * acc[i][j][4 * qd + 2];
                    tot[i][j][4 * qd + 3] += bf2f(g.y >> 16) * acc[i][j][4 * qd + 3];
                }
            }
        }
    }
#pragma unroll
    for (int j = 0; j < 2; ++j) {
        const int col = n0 + wc * 64 + j * 32 + c32;
#pragma unroll
        for (int i = 0; i < 2; ++i) {
            const int rb = m0 + wr * 64 + i * 32 + 4 * hl;
#pragma unroll
            for (int r = 0; r < 16; ++r) MG[(size_t)(rb + (r & 3) + 8 * (r >> 2)) * 1024 + col] = f2bf(tot[i][j][r]);
        }
    }
}

struct TileSrc { const bf16_t* k; const bf16_t* k2; const bf16_t* v; const bf16_t* vhi; };
DEVI int pi_row(int r) { return (r & 0x13) | ((r & 4) << 1) | ((r & 8) >> 1); }

template <int NKS>
DEVI void attn_load(const TileSrc& s, bf16x8 (&kf)[NKS], bf16x8 (&vf)[4]) {
#pragma unroll
    for (int ks = 0; ks < NKS; ++ks) kf[ks] = (ks < 4) ? *(const bf16x8*)(s.k + ks * 16) : *(const bf16x8*)(s.k2 + (ks - 4) * 16);
    vf[0] = *(const bf16x8*)(s.v);
    vf[1] = *(const bf16x8*)(s.v + 16);
    vf[2] = *(const bf16x8*)(s.vhi);
    vf[3] = *(const bf16x8*)(s.vhi + 16);
}

template <int NKS, class Src, class Mask>
DEVI void attn_wave(const bf16_t* qptr, int nt, Src src, Mask mask, bf16_t* optr, int lane) {
    bf16x8 q[NKS];
#pragma unroll
    for (int ks = 0; ks < NKS; ++ks) q[ks] = *(const bf16x8*)(qptr + ks * 16);
    f32x16 o0, o1;
#pragma unroll
    for (int r = 0; r < 16; ++r) { o0[r] = 0.f; o1[r] = 0.f; }
    float m = -1e30f, lsum = 0.f;
    bf16x8 kf[NKS], vf[4];
    { TileSrc s0 = src(0); attn_load<NKS>(s0, kf, vf); }
    for (int t = 0; t < nt; ++t) {
        bf16x8 kn[NKS], vn[4];
        { TileSrc s1 = src(t + 1 < nt ? t + 1 : t); attn_load<NKS>(s1, kn, vn); }
        f32x16 s;
#pragma unroll
        for (int r = 0; r < 16; ++r) s[r] = 0.f;
#pragma unroll
        for (int ks = 0; ks < NKS; ++ks) s = __builtin_amdgcn_mfma_f32_32x32x16_bf16(kf[ks], q[ks], s, 0, 0, 0);
        mask(t, s);
        float mx = s[0];
#pragma unroll
        for (int r = 1; r < 16; ++r) mx = fmaxf(mx, s[r]);
        mx = fmaxf(mx, __shfl_xor(mx, 32));
        const float mn = fmaxf(m, mx);
        const float alpha = fast_exp2(m - mn);
        m = mn;
        float rs = 0.f;
#pragma unroll
        for (int r = 0; r < 16; ++r) { s[r] = fast_exp2(s[r] - mn); rs += s[r]; }
        lsum = lsum * alpha + rs;
#pragma unroll
        for (int r = 0; r < 16; ++r) { o0[r] *= alpha; o1[r] *= alpha; }
        bf16x8 p0, p1;
        {
            u32x4 a, b;
            a.x = pk2(s[0], s[1]); a.y = pk2(s[2], s[3]); a.z = pk2(s[4], s[5]); a.w = pk2(s[6], s[7]);
            b.x = pk2(s[8], s[9]); b.y = pk2(s[10], s[11]); b.z = pk2(s[12], s[13]); b.w = pk2(s[14], s[15]);
            p0 = __builtin_bit_cast(bf16x8, a); p1 = __builtin_bit_cast(bf16x8, b);
        }
        o0 = __builtin_amdgcn_mfma_f32_32x32x16_bf16(vf[0], p0, o0, 0, 0, 0);
        o0 = __builtin_amdgcn_mfma_f32_32x32x16_bf16(vf[1], p1, o0, 0, 0, 0);
        o1 = __builtin_amdgcn_mfma_f32_32x32x16_bf16(vf[2], p0, o1, 0, 0, 0);
        o1 = __builtin_amdgcn_mfma_f32_32x32x16_bf16(vf[3], p1, o1, 0, 0, 0);
#pragma unroll
        for (int ks = 0; ks < NKS; ++ks) kf[ks] = kn[ks];
#pragma unroll
        for (int x = 0; x < 4; ++x) vf[x] = vn[x];
    }
    lsum += __shfl_xor(lsum, 32);
    const float inv = 1.f / lsum;
    const int hl = lane >> 5;
#pragma unroll
    for (int qd = 0; qd < 4; ++qd) {
        u32x2 a, b;
        a.x = pk2(o0[4 * qd] * inv, o0[4 * qd + 1] * inv); a.y = pk2(o0[4 * qd + 2] * inv, o0[4 * qd + 3] * inv);
        b.x = pk2(o1[4 * qd] * inv, o1[4 * qd + 1] * inv); b.y = pk2(o1[4 * qd + 2] * inv, o1[4 * qd + 3] * inv);
        *(u32x2*)(optr + 8 * qd + 4 * hl) = a;
        *(u32x2*)(optr + 32 + 8 * qd + 4 * hl) = b;
    }
}

struct NoMask { DEVI void operator()(int, f32x16&) const {} };

DEVI void attn_mla(const P& p, int l, bool lat, int b, int h, int qg, int lane) {
    const int hl = lane >> 5, c32 = lane & 31, pr = pi_row(c32);
    const bf16_t* Q = (const bf16_t*)(p.ws + WS_Q);
    const bf16_t* KN = (const bf16_t*)(p.ws + WS_KN);
    const bf16_t* KR = (const bf16_t*)(p.ws + WS_KR);
    const bf16_t* CKR = (const bf16_t*)(p.ws + WS_CKR) + (size_t)l * 1024 * 32;
    const bf16_t* VT = (const bf16_t*)(p.ws + WS_VTM);
    bf16_t* YM = (bf16_t*)(p.ws + WS_YM);
    if (!lat) {
        const int row0 = b * 256;
        const int qrow = row0 + qg * 32 + c32;
        const bf16_t* k0 = KN + (size_t)(row0 + pr) * 512 + h * 64 + hl * 8;
        const bf16_t* r0 = KR + (size_t)(row0 + pr) * 32 + hl * 8;
        const bf16_t* v0 = VT + ((size_t)((b * 8 + h) * 64 + c32)) * 256 + hl * 8;
        auto src = [=](int t) { TileSrc s; s.k = k0 + (size_t)t * 32 * 512; s.k2 = r0 + (size_t)t * 32 * 32; s.v = v0 + t * 32; s.vhi = s.v + 32 * 256; return s; };
        attn_wave<6>(Q + (size_t)qrow * 768 + h * 96 + hl * 8, 8, src, NoMask(), YM + (size_t)qrow * 512 + h * 64, lane);
    } else {
        const int row0 = NCTX + b * 2048;
        const int qrow = row0 + qg * 32 + c32;
        const bf16_t* k0 = KN + (size_t)(row0 + pr) * 512 + h * 64 + hl * 8;
        const bf16_t* r0 = KR + (size_t)(row0 + pr) * 32 + hl * 8;
        const bf16_t* k1 = KN + (size_t)(M + b * 512 + pr) * 512 + h * 64 + hl * 8;
        const bf16_t* r1 = CKR + (size_t)(b * 512 + pr) * 32 + hl * 8;
        const bf16_t* v0 = VT + (size_t)4194304 + ((size_t)((b * 8 + h) * 64 + c32)) * 2560 + hl * 8;
        auto src = [=](int t) {
            TileSrc s;
            if (t < 64) { s.k = k0 + (size_t)t * 32 * 512; s.k2 = r0 + (size_t)t * 32 * 32; }
            else { s.k = k1 + (size_t)(t - 64) * 32 * 512; s.k2 = r1 + (size_t)(t - 64) * 32 * 32; }
            s.v = v0 + t * 32; s.vhi = s.v + 32 * 2560; return s; };
        attn_wave<6>(Q + (size_t)qrow * 768 + h * 96 + hl * 8, 80, src, NoMask(), YM + (size_t)qrow * 512 + h * 64, lane);
    }
}

DEVI void attn_na_ctx(const P& p, int b, int h, int qg, int lane) {
    const int hl = lane >> 5, c32 = lane & 31, pr = pi_row(c32);
    const bf16_t* Qn = (const bf16_t*)(p.ws + WS_NAQ);
    const bf16_t* Kn = (const bf16_t*)(p.ws + WS_NAK);
    const bf16_t* VT = (const bf16_t*)(p.ws + WS_NAVT);
    bf16_t* YN = (bf16_t*)(p.ws + WS_YN);
    const int row0 = b * 256, qrow = row0 + qg * 32 + c32;
    const bf16_t* k0 = Kn + (size_t)(row0 + pr) * 512 + h * 64 + hl * 8;
    const bf16_t* v0 = VT + ((size_t)((b * 8 + h) * 64 + c32)) * 256 + hl * 8;
    auto src = [=](int t) { TileSrc s; s.k = k0 + (size_t)t * 32 * 512; s.k2 = s.k; s.v = v0 + t * 32; s.vhi = s.v + 32 * 256; return s; };
    attn_wave<4>(Qn + (size_t)qrow * 512 + h * 64 + hl * 8, 8, src, NoMask(), YN + (size_t)qrow * 512 + h * 64, lane);
}

struct NaMask {
    const float* rpb;
    int rs, rq, qc, hl;
    DEVI void operator()(int t, f32x16& s) const {
        if (t >= 16) return;
        const int kr = t >> 1, kh = t & 1;
        const int cs = min(max(qc - 8, 0), 48);
        const float* rp = rpb + (rs + kr - rq + 7) * 31;
#pragma unroll
        for (int r = 0; r < 16; ++r) {
            const int kk = (r & 3) + 4 * ((r >> 2) & 1) + 8 * hl + 16 * (r >> 3);
            const int kc = kh * 32 + kk;
            const bool ok = (kc >= cs) && (kc < cs + 16);
            const int dc = min(max(kc - qc + 15, 0), 30);
            const float bias = rp[dc] * LOG2E;
            s[r] = ok ? s[r] + bias : -1e30f;
        }
    }
};
DEVI void attn_na_lat(const P& p, int l, int b, int h, int rq, int qh, int lane) {
    const int hl = lane >> 5, c32 = lane & 31, pr = pi_row(c32);
    const bf16_t* Qn = (const bf16_t*)(p.ws + WS_NAQ);
    const bf16_t* Kn = (const bf16_t*)(p.ws + WS_NAK);
    const bf16_t* VT = (const bf16_t*)(p.ws + WS_NAVT) + (size_t)4194304;
    const bf16_t* CK = (const bf16_t*)(p.ws + WS_CNAK) + (size_t)l * 1024 * 512;
    const bf16_t* CV = (const bf16_t*)(p.ws + WS_CNAVT) + (size_t)l * 1024 * 512;
    bf16_t* YN = (bf16_t*)(p.ws + WS_YN);
    const int row0 = NCTX + b * 2048;
    const int qrow = row0 + rq * 64 + qh * 32 + c32;
    const int rs = min(max(rq - 4, 0), 24);
    const bf16_t* k0 = Kn + (size_t)(row0 + rs * 64 + pr) * 512 + h * 64 + hl * 8;
    const bf16_t* v0 = VT + ((size_t)((b * 8 + h) * 64 + c32)) * 2048 + rs * 64 + hl * 8;
    const bf16_t* k1 = CK + (size_t)(b * 512 + pr) * 512 + h * 64 + hl * 8;
    const bf16_t* v1 = CV + ((size_t)((b * 8 + h) * 64 + c32)) * 512 + hl * 8;
    auto src = [=](int t) {
        TileSrc s;
        if (t < 16) { s.k = k0 + (size_t)t * 32 * 512; s.v = v0 + t * 32; s.vhi = s.v + 32 * 2048; }
        else { s.k = k1 + (size_t)(t - 16) * 32 * 512; s.v = v1 + (t - 16) * 32; s.vhi = s.v + 32 * 512; }
        s.k2 = s.k; return s; };
    NaMask mk; mk.rpb = p.in[21] + (size_t)(l * 8 + h) * 15 * 31; mk.rs = rs; mk.rq = rq; mk.qc = qh * 32 + c32; mk.hl = hl;
    attn_wave<4>(Qn + (size_t)qrow * 512 + h * 64 + hl * 8, 32, src, mk, YN + (size_t)qrow * 512 + h * 64, lane);
}

DEVI void row_ln_mod(const float* src, float* xdst, bf16_t* hdst, const float* lng, const float* lnb, const float* shift, const float* scale, int lane) {
    f32x4 v[4];
#pragma unroll
    for (int j = 0; j < 4; ++j) v[j] = *(const f32x4*)(src + 4 * lane + 256 * j);
    if (lng) {
        float s = 0.f;
#pragma unroll
        for (int j = 0; j < 4; ++j) s += (v[j].x + v[j].y) + (v[j].z + v[j].w);
        const float mu = wave_sum(s) * (1.f / D);
        float q = 0.f;
#pragma unroll
        for (int j = 0; j < 4; ++j) { v[j] = v[j] - mu; q += (v[j].x * v[j].x + v[j].y * v[j].y) + (v[j].z * v[j].z + v[j].w * v[j].w); }
        const float rstd = rsqrtf(wave_sum(q) * (1.f / D) + 1e-5f);
#pragma unroll
        for (int j = 0; j < 4; ++j) {
            const f32x4 g = *(const f32x4*)(lng + 4 * lane + 256 * j), bb = *(const f32x4*)(lnb + 4 * lane + 256 * j);
            v[j] = v[j] * rstd * g + bb;
        }
    }
    if (xdst) {
#pragma unroll
        for (int j = 0; j < 4; ++j) *(f32x4*)(xdst + 4 * lane + 256 * j) = v[j];
    }
    if (hdst) {
        float s = 0.f;
#pragma unroll
        for (int j = 0; j < 4; ++j) s += (v[j].x + v[j].y) + (v[j].z + v[j].w);
        const float mu = wave_sum(s) * (1.f / D);
        float q = 0.f;
#pragma unroll
        for (int j = 0; j < 4; ++j) { v[j] = v[j] - mu; q += (v[j].x * v[j].x + v[j].y * v[j].y) + (v[j].z * v[j].z + v[j].w * v[j].w); }
        const float rstd = rsqrtf(wave_sum(q) * (1.f / D) + 1e-6f);
#pragma unroll
        for (int j = 0; j < 4; ++j) {
            const f32x4 sc = *(const f32x4*)(scale + 4 * lane + 256 * j), sh = *(const f32x4*)(shift + 4 * lane + 256 * j);
            const f32x4 o = v[j] * rstd * (sc + 1.f) + sh;
            u32x2 pk; pk.x = pk2(o.x, o.y); pk.y = pk2(o.z, o.w);
            *(u32x2*)(hdst + 4 * lane + 256 * j) = pk;
        }
    }
}

DEVI void phase_rows(const P& p, int l, int lnidx, int ml, int ms, bool final_, int gw, int ngw, int lane) {
    float* X = (float*)(p.ws + WS_X);
    bf16_t* H = (bf16_t*)(p.ws + WS_H);
    const float* MOD = (const float*)(p.ws + WS_MOD);
    for (int row = gw; row < M; row += ngw) {
        const float* src = (lnidx < 0) ? (row < NCTX ? p.in[0] + (size_t)row * D : p.in[1] + (size_t)(row - NCTX) * D) : X + (size_t)row * D;
        const float* lng = (lnidx < 0) ? nullptr : p.in[28] + (size_t)(l * 3 + lnidx) * D;
        const float* lnb = (lnidx < 0) ? nullptr : p.in[29] + (size_t)(l * 3 + lnidx) * D;
        if (final_) { row_ln_mod(src, p.out + (size_t)row * D, nullptr, lng, lnb, nullptr, nullptr, lane); continue; }
        const float* mb = MOD + ((size_t)ml * 3 + mod_group(row)) * 9216;
        row_ln_mod(src, X + (size_t)row * D, H + (size_t)row * D, lng, lnb, mb + ms * D, mb + (ms + 1) * D, lane);
    }
}

DEVI void phase_rowmix(const P& p, int l, int gw, int ngw, int lane) {
    bf16_t* UQ = (bf16_t*)(p.ws + WS_UQ);
    const float* UKV = (const float*)(p.ws + WS_UKV);
    const float* KRF = (const float*)(p.ws + WS_KRF);
    bf16_t* CKV = (bf16_t*)(p.ws + WS_CKV);
    bf16_t* KR = (bf16_t*)(p.ws + WS_KR);
    const float* ropec = (const float*)(p.ws + WS_ROPE);
    const float* ropes = ropec + 512;
    const float* gq = p.in[17] + l * 384;
    const float* gkv = p.in[19] + l * 256;
    for (int row = gw; row < M; row += ngw) {
        {
            unsigned* up = (unsigned*)(UQ + (size_t)row * 384) + lane;
            float x[6]; float ss = 0.f;
#pragma unroll
            for (int j = 0; j < 3; ++j) { const unsigned w = up[64 * j]; x[2 * j] = bf2f(w & 0xffffu); x[2 * j + 1] = bf2f(w >> 16); ss += x[2 * j] * x[2 * j] + x[2 * j + 1] * x[2 * j + 1]; }
            const float rs = rsqrtf(wave_sum(ss) * (1.f / 384.f) + 1e-6f);
#pragma unroll
            for (int j = 0; j < 3; ++j) { const int c = 2 * lane + 128 * j; up[64 * j] = pk2(x[2 * j] * rs * gq[c], x[2 * j + 1] * rs * gq[c + 1]); }
        }
        {
            const f32x4 v = *(const f32x4*)(UKV + (size_t)row * 256 + 4 * lane);
            const float ss = v.x * v.x + v.y * v.y + v.z * v.z + v.w * v.w;
            const float rs = rsqrtf(wave_sum(ss) * (1.f / 256.f) + 1e-6f);
            const f32x4 g = *(const f32x4*)(gkv + 4 * lane);
            const f32x4 o = v * rs * g;
            u32x2 pk; pk.x = pk2(o.x, o.y); pk.y = pk2(o.z, o.w);
            *(u32x2*)(CKV + (size_t)row * 256 + 4 * lane) = pk;
            if (row < NCTX) *(f32x4*)(p.out + OUT_CKV + ((size_t)((row >> 8) * 4 + l) * 256 + (row & 255)) * 256 + 4 * lane) = o;
        }
        {
            const float v = KRF[(size_t)row * 32 + (lane & 31)];
            const float pr = __shfl_xor(v, 8);
            float o = v;
            if (row >= NCTX) {
                const int c = lane & 31, axis = c >> 4, ii = c & 15, n = (row - NCTX) & 2047;
                const int pos = axis ? (n & 63) : (n >> 6);
                const float rot = (ii < 8) ? -pr : pr;
                o = v * ropec[pos * 8 + (ii & 7)] + rot * ropes[pos * 8 + (ii & 7)];
            }
            if (lane < 32) {
                KR[(size_t)row * 32 + lane] = f2bf(o);
                if (row < NCTX) p.out[OUT_KR + ((size_t)((row >> 8) * 4 + l) * 256 + (row & 255)) * 32 + lane] = v;
            }
        }
    }
}

DEVI void transpose_item(const float* __restrict__ src, int N, int c0, int k0, bf16_t* __restrict__ dst, int K, float* scr, int lane) {
#pragma unroll 8
    for (int i = 0; i < 32; ++i) { const int kk = 2 * i + (lane >> 5); scr[kk * 33 + (lane & 31)] = src[(size_t)(k0 + kk) * N + c0 + (lane & 31)]; }
    asm volatile("s_waitcnt lgkmcnt(0)" ::: "memory");
    const int c = lane & 7;
#pragma unroll
    for (int j = 0; j < 4; ++j) {
        const int n = (lane >> 3) + 8 * j; const float* s = scr + (8 * c) * 33 + n;
        u32x4 o; o.x = pk2(s[0], s[33]); o.y = pk2(s[2 * 33], s[3 * 33]); o.z = pk2(s[4 * 33], s[5 * 33]); o.w = pk2(s[6 * 33], s[7 * 33]);
        *(u32x4*)(dst + (size_t)n * K + k0 + 8 * c) = o;
    }
    asm volatile("s_waitcnt lgkmcnt(0)" ::: "memory");
}

DEVI void prep_weight_item(const P& p, int item, float* scr, int lane) {
    const int l = item / 12944; int r = item % 12944;
    bf16_t* Wl = (bf16_t*)(p.ws + WS_W) + (size_t)l * LAYER_W;
    if (r < 8448) {
        const int which = r / 4224; r %= 4224;
        if (r < 2816) {
            const int rb = r >> 4, kb = r & 15;
            const float* src = (which ? ((rb & 1) ? p.in[14] : p.in[13]) : ((rb & 1) ? p.in[11] : p.in[10])) + (size_t)l * D * DFF;
            transpose_item(src, DFF, (rb >> 1) * 32, kb * 64, Wl + (which ? OFF_W13_2 : OFF_W13_1) + (size_t)rb * 32 * D, D, scr, lane);
        } else {
            r -= 2816; const int rb = r / 44, kb = r % 44;
            const float* src = (which ? p.in[15] : p.in[12]) + (size_t)l * DFF * D;
            transpose_item(src, D, rb * 32, kb * 64, Wl + (which ? OFF_W2_2 : OFF_W2_1) + (size_t)rb * 32 * DFF, DFF, scr, lane);
        }
        return;
    }
    r -= 8448;
    if (r < 2944) {
        const int rb = r >> 4, kb = r & 15, R0 = rb * 32;
        const float* src; int N, c0;
        if (R0 < 1184) { src = p.in[16] + (size_t)l * D * 2720; N = 2720; c0 = R0; }
        else if (R0 < 1280) return;
        else if (R0 < 2816) { src = p.in[16] + (size_t)l * D * 2720; N = 2720; c0 = R0 - 96; }
        else { src = p.in[25] + (size_t)l * D * 3072; N = 3072; c0 = R0 - 2816; }
        transpose_item(src, N, c0, kb * 64, Wl + OFF_WIN + (size_t)R0 * D, D, scr, lane);
        return;
    }
    r -= 2944;
    if (r < 512) { const int rb = r >> 4, kb = r & 15; transpose_item(p.in[27] + (size_t)l * D * D, D, rb * 32, kb * 64, Wl + OFF_WOUT + (size_t)rb * 32 * D, D, scr, lane); return; }
    r -= 512;
    if (r < 768) { const int w = r >> 8; r &= 255; const int rb = r >> 3, kb = r & 7;
        transpose_item((w == 0 ? p.in[22] : (w == 1 ? p.in[23] : p.in[24])) + (size_t)l * 512 * D, D, rb * 32, kb * 64, Wl + (w == 0 ? OFF_WBF : (w == 1 ? OFF_WBM : OFF_WBN)) + (size_t)rb * 32 * 512, 512, scr, lane); return; }
    r -= 768;
    if (r < 144) { const int rb = r / 6, kb = r % 6; transpose_item(p.in[18] + (size_t)l * 384 * 768, 768, rb * 32, kb * 64, Wl + OFF_WUQ + (size_t)rb * 32 * 384, 384, scr, lane); return; }
    r -= 144;
    { const int rb = r >> 2, kb = r & 3; transpose_item(p.in[20] + (size_t)l * 256 * 1024, 1024, rb * 32, kb * 64, Wl + OFF_WUKV + (size_t)rb * 32 * 256, 256, scr, lane); }
}

DEVI void phase_prep(const P& p, unsigned char* smem, int tid) {
    const int lane = tid & 63, wave = tid >> 6;
    const int gw = blockIdx.x * 4 + wave, ngw = gridDim.x * 4;
    const size_t gt = (size_t)blockIdx.x * 256 + tid, ngt = (size_t)gridDim.x * 256;
    {
        float* sil = (float*)smem;
        const float* wada = p.in[8];
        float* MODP = (float*)(p.ws + WS_MODP);
        for (int item = blockIdx.x; item < 2304; item += gridDim.x) {
            const int l = item / 576, rem = item % 576, kc = rem / 36, cb = rem % 36;
            __syncthreads();
            if (tid < 192) {
                const int g = tid >> 6, k = kc * 64 + (tid & 63);
                const float cv = (g == 0) ? p.in[7][k] : p.in[6][(g - 1) * D + k];
                sil[tid] = cv * sigmoidf_(cv);
            }
            __syncthreads();
            const int col = cb * 256 + tid;
            const float* w = wada + ((size_t)l * D + kc * 64) * 9216 + col;
            float a0 = 0.f, a1 = 0.f, a2 = 0.f;
#pragma unroll 16
            for (int k = 0; k < 64; ++k) { const float wv = w[(size_t)k * 9216]; a0 += sil[k] * wv; a1 += sil[64 + k] * wv; a2 += sil[128 + k] * wv; }
            float* o = MODP + ((size_t)(l * 16 + kc) * 3) * 9216 + col;
            o[0] = a0; o[9216] = a1; o[2 * 9216] = a2;
        }
        __syncthreads();
    }
    {
        float* scr = (float*)smem + wave * (64 * 33);
        for (int item = gw; item < 4 * 12944; item += ngw) prep_weight_item(p, item, scr, lane);
    }
    {
        bf16_t* TABL = (bf16_t*)(p.ws + WS_TABL);
        for (size_t e = gt; e < (size_t)2048 * 4096; e += ngt) {
            const int k = (int)(e >> 12), kk = (int)(e & 4095), lidx = kk & 2047;
            const int idx = (k * lidx) & 2047;
            float sn, cs; sincospif((float)idx * (2.f / 2048.f), &sn, &cs);
            TABL[e] = f2bf((kk < 2048 ? cs : -sn) * 0.022097086912079608f);
        }
        bf16_t* TABC = (bf16_t*)(p.ws + WS_TABC);
        for (size_t e = gt; e < (size_t)256 * 512; e += ngt) {
            const int k = (int)(e >> 9), kk = (int)(e & 511), lidx = kk & 255;
            const int idx = (k * lidx) & 255;
            float sn, cs; sincospif((float)idx * (2.f / 256.f), &sn, &cs);
            TABC[e] = f2bf((kk < 256 ? cs : -sn) * 0.0625f);
        }
        bf16_t* WCS = (bf16_t*)(p.ws + WS_WCS);
        for (size_t e = gt; e < (size_t)256 * 128; e += ngt) {
            const int i = (int)(e >> 7), c = (int)(e & 127), m = i >> 1, cs_ = i & 1;
            const int idx = (m * c) & 127;
            float sn, cs; sincospif((float)idx * (2.f / 128.f), &sn, &cs);
            WCS[e] = f2bf((cs_ ? sn : cs) * 0.08838834764831845f);
        }
        float* ROPE = (float*)(p.ws + WS_ROPE);
        for (size_t e = gt; e < 512; e += ngt) {
            const int pos = (int)(e >> 3), i = (int)(e & 7);
            const float inv_freq = powf(10000.f, -(float)i / 8.f);
            const float ang = (float)pos * inv_freq;
            ROPE[e] = cosf(ang); ROPE[512 + e] = sinf(ang);
        }
    }
    {
        bf16_t* CCKV = (bf16_t*)(p.ws + WS_CCKV);
        for (size_t e = gt; e < (size_t)NL * 1024 * 256; e += ngt) {
            const int c = (int)(e & 255), i = (int)((e >> 8) & 511), b = (int)((e >> 17) & 1), l = (int)(e >> 18);
            CCKV[e] = f2bf(p.in[2][((size_t)(b * 4 + l) * 512 + i) * 256 + c]);
        }
        bf16_t* CKR = (bf16_t*)(p.ws + WS_CKR);
        for (size_t e = gt; e < (size_t)NL * 1024 * 32; e += ngt) {
            const int c = (int)(e & 31), i = (int)((e >> 5) & 511), b = (int)((e >> 14) & 1), l = (int)(e >> 15);
            CKR[e] = f2bf(p.in[3][((size_t)(b * 4 + l) * 512 + i) * 32 + c]);
        }
        bf16_t* CNAK = (bf16_t*)(p.ws + WS_CNAK);
        for (size_t e = gt; e < (size_t)NL * 1024 * 512; e += ngt) {
            const int c = (int)(e & 511), i = (int)((e >> 9) & 511), b = (int)((e >> 18) & 1), l = (int)(e >> 19);
            CNAK[e] = f2bf(p.in[4][((size_t)(b * 4 + l) * 512 + i) * 512 + c]);
        }
        bf16_t* CNAVT = (bf16_t*)(p.ws + WS_CNAVT);
        for (size_t e = gt; e < (size_t)NL * 1024 * 512; e += ngt) {
            const int key = (int)(e & 511), hd = (int)((e >> 9) & 511), b = (int)((e >> 18) & 1), l = (int)(e >> 19);
            CNAVT[e] = f2bf(p.in[5][((size_t)(b * 4 + l) * 512 + key) * 512 + hd]);
        }
    }
}

DEVI void phase_modreduce(const P& p, int tid) {
    const float* MODP = (const float*)(p.ws + WS_MODP);
    float* MOD = (float*)(p.ws + WS_MOD);
    for (int e = blockIdx.x * 256 + tid; e < NL * 3 * 9216; e += gridDim.x * 256) {
        const int l = e / (3 * 9216), rem = e % (3 * 9216);
        float a = p.in[9][l * 9216 + (rem % 9216)];
#pragma unroll
        for (int kc = 0; kc < 16; ++kc) a += MODP[((size_t)(l * 16 + kc) * 3) * 9216 + rem];
        MOD[e] = a;
    }
}

DEVI void run_phase(const P& p, int ph, unsigned char* smem, int tid) {
    bf16_t* sm = (bf16_t*)smem;
    const int lane = tid & 63, wave = tid >> 6;
    const int gw = blockIdx.x * 4 + wave, ngw = gridDim.x * 4;
    const int nb = gridDim.x, bid = blockIdx.x;
    if (ph == 0) { phase_prep(p, smem, tid); return; }
    if (ph == 1) { phase_modreduce(p, tid); return; }
    if (ph == 2) { phase_rows(p, 0, -1, 0, 0, false, gw, ngw, lane); return; }
    const int l = (ph - 3) / 13, s = (ph - 3) % 13;
    const bf16_t* Wl = (const bf16_t*)(p.ws + WS_W) + (size_t)l * LAYER_W;
    const float* MODl = (const float*)(p.ws + WS_MOD) + (size_t)l * 3 * 9216;
    switch (s) {
    case 0: case 10:
        for (int t = bid; t < 96 * 44; t += nb) job_ffn_up(p, l, s == 10, t, sm, tid);
        break;
    case 1: case 11:
        for (int t = bid; t < 96 * 8; t += nb)
            job_resid(p, (const bf16_t*)(p.ws + WS_ACT), DFF, Wl + (s == 11 ? OFF_W2_2 : OFF_W2_1), DFF, MODl + (s == 11 ? 8 : 2) * D, 0.5f, t, sm, tid);
        break;
    case 2: phase_rows(p, l, 0, l, 3, false, gw, ngw, lane); break;
    case 3:
        for (int t = bid; t < 96 * 46; t += nb) job_in(p, l, t, sm, tid);
        break;
    case 4: phase_rowmix(p, l, gw, ngw, lane); break;
    case 5: {
        int t = bid;
        for (; t < 256; t += nb) {
            const int wi = t * 4 + wave;
            attn_na_lat(p, l, wi >> 9, (wi >> 6) & 7, (wi >> 1) & 31, wi & 1, lane);
        }
        for (; t < 256 + 832; t += nb) job_ukv(p, l, t - 256, sm, tid);
        for (; t < 256 + 832 + 576; t += nb) job_uq(p, l, t - 256 - 832, sm, tid);
        for (; t < 256 + 832 + 576 + 768; t += nb) job_f1(p, t - 256 - 832 - 576, sm, tid);
        for (; t < 256 + 832 + 576 + 768 + 512; t += nb) {
            const int wi = (t - 256 - 832 - 576 - 768) * 4 + wave;
            attn_na_ctx(p, wi >> 6, (wi >> 3) & 7, wi & 7, lane);
        }
    } break;
    case 6: {
        int t = bid;
        for (; t < 256; t += nb) {
            const int wi = t * 4 + wave;
            attn_mla(p, l, true, wi >> 9, (wi >> 6) & 7, wi & 63, lane);
        }
        for (; t < 256 + 128; t += nb) job_f2_lat(p, t - 256, sm, tid);
        for (; t < 256 + 128 + 256; t += nb) job_f2_ctx(p, t - 256 - 128, sm, tid);
        for (; t < 256 + 128 + 256 + 512; t += nb) {
            const int wi = (t - 256 - 128 - 256) * 4 + wave;
            attn_mla(p, l, false, wi >> 6, (wi >> 3) & 7, wi & 7, lane);
        }
    } break;
    case 7:
        for (int t = bid; t < 96 * 8; t += nb) job_merge(p, l, t, sm, tid);
        break;
    case 8:
        for (int t = bid; t < 96 * 8; t += nb)
            job_resid(p, (const bf16_t*)(p.ws + WS_MERGED), D, Wl + OFF_WOUT, D, MODl + 5 * D, 1.0f, t, sm, tid);
        break;
    case 9: phase_rows(p, l, 1, l, 6, false, gw, ngw, lane); break;
    case 12:
        if (l == NL - 1) phase_rows(p, l, 2, 0, 0, true, gw, ngw, lane);
        else phase_rows(p, l, 2, l + 1, 0, false, gw, ngw, lane);
        break;
    default: break;
    }
}

__global__ void __launch_bounds__(256, 2) mega_kernel(P p) {
    extern __shared__ __attribute__((aligned(16))) unsigned char smem[];
    cg::grid_group grid = cg::this_grid();
    const int tid = threadIdx.x;
#pragma nounroll
    for (int ph = p.ph_lo; ph < p.ph_hi; ++ph) {
        int tid2 = tid; asm volatile("" : "+v"(tid2));
        run_phase(p, ph, smem, tid2);
        if (ph + 1 < p.ph_hi) grid.sync();
    }
}

extern "C" void kernel_launch(void* const* d_in, const int* in_sizes, int n_in, void* d_out, int out_size, void* d_ws, size_t ws_size,
                              hipStream_t stream) {
    static int grid_blocks = 0;
    if (grid_blocks == 0) {
        if (n_in != 30 || ws_size < WS_END) { fprintf(stderr, "kernel_launch: n_in %d ws %zu need %zu\n", n_in, ws_size, (size_t)WS_END); grid_blocks = -1; return; }
        int dev = 0, cus = 0, per_cu = 0;
        hipGetDevice(&dev);
        hipDeviceGetAttribute(&cus, hipDeviceAttributeMultiprocessorCount, dev);
        hipFuncSetAttribute((const void*)mega_kernel, hipFuncAttributeMaxDynamicSharedMemorySize, SMEM_BYTES);
        hipOccupancyMaxActiveBlocksPerMultiprocessor(&per_cu, (const void*)mega_kernel, 256, SMEM_BYTES);
        if (per_cu < 1) per_cu = 1;
        if (per_cu > 2) per_cu = 2;
        grid_blocks = cus * per_cu;
    }
    if (grid_blocks < 0) return;
    P p{};
    for (int i = 0; i < 30; ++i) p.in[i] = (const float*)d_in[i];
    p.out = (float*)d_out; p.ws = (unsigned char*)d_ws; p.ph_lo = 0; p.ph_hi = NPHASE;
#ifndef MULTI_LAUNCH
#define MULTI_LAUNCH 0
#endif
#if MULTI_LAUNCH
    for (int ph = 0; ph < NPHASE; ++ph) {
        p.ph_lo = ph; p.ph_hi = ph + 1;
        hipLaunchKernelGGL(mega_kernel, dim3(grid_blocks), dim3(256), SMEM_BYTES, stream, p);
    }
#else
    void* args[] = {&p};
    hipError_t e = hipLaunchCooperativeKernel((const void*)mega_kernel, dim3(grid_blocks), dim3(256), args, SMEM_BYTES, stream);
    if (e != hipSuccess) fprintf(stderr, "cooperative launch failed: %s (grid %d)\n", hipGetErrorString(e), grid_blocks);
#endif
}
```

```cpp
#include <hip/hip_runtime.h>
#include <hip/hip_cooperative_groups.h>
#include <cstdint>
#include <cstdio>
namespace cg = cooperative_groups;

typedef unsigned short bf16_t;
typedef short bf16x8 __attribute__((ext_vector_type(8)));
typedef float f32x16 __attribute__((ext_vector_type(16)));
typedef float f32x4 __attribute__((ext_vector_type(4)));
typedef unsigned u32x4 __attribute__((ext_vector_type(4)));
typedef unsigned u32x2 __attribute__((ext_vector_type(2)));
#define DEVI __device__ __forceinline__

constexpr int D = 1024, NCTX = 8192, NLAT = 4096, M = 12288, MX = 13312, DFF = 2816, NL = 4;
constexpr float ALPHA_F = 1.6817928305074290f;
constexpr float LOG2E = 1.4426950408889634f;
constexpr float MLA_QS = 0.10206207261596575f * LOG2E;
constexpr float NA_QS = 0.125f * LOG2E;
constexpr size_t OUT_CKV = 12582912, OUT_KR = 20971520, OUT_NAK = 22020096, OUT_NAV = 38797312;

constexpr size_t al256(size_t x) { return (x + 255) & ~(size_t)255; }
constexpr size_t WS_BAR = 0;
constexpr size_t WS_X = 16384;
constexpr size_t WS_H = WS_X + (size_t)M * D * 4;
constexpr size_t WS_MOD = WS_H + (size_t)M * D * 2;
constexpr size_t WS_MODP = WS_MOD + al256((size_t)NL * 3 * 9216 * 4);
constexpr size_t WS_ROPE = WS_MODP + al256((size_t)NL * 16 * 3 * 9216 * 4);
constexpr size_t WS_TABC = WS_ROPE + 4096;
constexpr size_t WS_TABL = WS_TABC + (size_t)256 * 512 * 2;
constexpr size_t WS_WCS = WS_TABL + (size_t)2048 * 4096 * 2;
constexpr size_t WS_CCKV = WS_WCS + (size_t)256 * 128 * 2;
constexpr size_t WS_CKR = WS_CCKV + (size_t)NL * 1024 * 256 * 2;
constexpr size_t WS_CNAK = WS_CKR + (size_t)NL * 1024 * 32 * 2;
constexpr size_t WS_CNAVT = WS_CNAK + (size_t)NL * 1024 * 512 * 2;
constexpr size_t WS_W = WS_CNAVT + (size_t)NL * 1024 * 512 * 2;
constexpr size_t OFF_W13_1 = 0, OFF_W2_1 = 5767168, OFF_W13_2 = 8650752, OFF_W2_2 = 14417920, OFF_WIN = 17301504,
                 OFF_WOUT = 23330816, OFF_WBF = 24379392, OFF_WBM = 24903680, OFF_WBN = 25427968, OFF_WUQ = 25952256,
                 OFF_WUKV = 26247168, LAYER_W = 26509312;
constexpr size_t WS_R1 = WS_W + (size_t)NL * LAYER_W * 2;
constexpr size_t WS_ACT = WS_R1;
constexpr size_t WS_UF = WS_R1;
constexpr size_t WS_UQ = WS_UF + (size_t)M * 512 * 2;
constexpr size_t WS_UKV = WS_UQ + (size_t)M * 384 * 2;
constexpr size_t WS_KRF = WS_UKV + (size_t)M * 256 * 4;
constexpr size_t WS_CKV = WS_KRF + (size_t)M * 32 * 4;
constexpr size_t WS_KR = WS_CKV + (size_t)M * 256 * 2;
constexpr size_t WS_NAQ = WS_KR + (size_t)M * 32 * 2;
constexpr size_t WS_NAK = WS_NAQ + (size_t)M * 512 * 2;
constexpr size_t WS_NAVT = WS_NAK + (size_t)M * 512 * 2;
constexpr size_t WS_GATE = WS_NAVT + (size_t)M * 512 * 2;
constexpr size_t WS_Q = WS_GATE + (size_t)M * 3072 * 2;
constexpr size_t WS_KN = WS_Q + (size_t)M * 768 * 2;
constexpr size_t WS_VTM = WS_KN + (size_t)MX * 512 * 2;
constexpr size_t WS_F1T = WS_VTM + (size_t)MX * 512 * 2;
constexpr size_t WS_YF = WS_F1T + (size_t)M * 1024 * 2;
constexpr size_t WS_YM = WS_YF + (size_t)M * 512 * 2;
constexpr size_t WS_YN = WS_YM + (size_t)M * 512 * 2;
constexpr size_t WS_MERGED = WS_YN + (size_t)M * 512 * 2;
constexpr size_t WS_END = WS_MERGED + (size_t)M * 1024 * 2;
static_assert(WS_END - WS_R1 >= (size_t)M * DFF * 2, "ACT must fit in R1");

constexpr int NPHASE = 3 + 13 * NL;

struct P {
    const float* in[30];
    float* out;
    unsigned char* ws;
    int ph_lo, ph_hi;
};

typedef __bf16 bf16v2 __attribute__((ext_vector_type(2)));
typedef float f32x2 __attribute__((ext_vector_type(2)));
DEVI unsigned pk2(float lo, float hi) { f32x2 v = {lo, hi}; bf16v2 b = __builtin_convertvector(v, bf16v2); return __builtin_bit_cast(unsigned, b); }
DEVI bf16_t f2bf(float x) { return (bf16_t)(pk2(x, 0.f) & 0xffffu); }
DEVI float bf2f(unsigned v) { return __uint_as_float(v << 16); }
DEVI float wave_sum(float v) {
#pragma unroll
    for (int o = 1; o < 64; o <<= 1) v += __shfl_xor(v, o);
    return v;
}
DEVI float fast_exp2(float x) { return __builtin_amdgcn_exp2f(x); }
DEVI float sigmoidf_(float x) { return 1.f / (1.f + __expf(-x)); }

constexpr int LDT = 72;
constexpr int TILE_E = 128 * LDT;
constexpr int SMEM_BYTES = 4 * TILE_E * 2;

DEVI void gemm_core(const bf16_t* __restrict__ A, int lda, const bf16_t* __restrict__ B, int ldb, int K,
                    f32x16 (&acc)[2][2], bf16_t* smem, int tid) {
    const int lane = tid & 63, wave = tid >> 6, wr = wave >> 1, wc = wave & 1;
    const int lr = tid >> 3, lc = (tid & 7) * 8;
    const bf16_t* ga = A + (size_t)lr * lda + lc;
    const bf16_t* gb = B + (size_t)lr * ldb + lc;
    u32x4 ra[4], rb[4];
#pragma unroll
    for (int i = 0; i < 4; ++i) {
        ra[i] = *(const u32x4*)(ga + (size_t)(32 * i) * lda);
        rb[i] = *(const u32x4*)(gb + (size_t)(32 * i) * ldb);
    }
    const int soff = lr * LDT + lc;
#pragma unroll
    for (int i = 0; i < 4; ++i) {
        *(u32x4*)(smem + soff + 32 * i * LDT) = ra[i];
        *(u32x4*)(smem + TILE_E + soff + 32 * i * LDT) = rb[i];
    }
    __syncthreads();
    const int nk = K >> 6;
    const int aoff = (wr * 64 + (lane & 31)) * LDT + (lane >> 5) * 8;
    const int boff = TILE_E + (wc * 64 + (lane & 31)) * LDT + (lane >> 5) * 8;
    for (int kt = 0; kt < nk; ++kt) {
        const bf16_t* cur = smem + (kt & 1) * 2 * TILE_E;
        const bool more = (kt + 1 < nk);
        if (more) {
            ga += 64; gb += 64;
#pragma unroll
            for (int i = 0; i < 4; ++i) {
                ra[i] = *(const u32x4*)(ga + (size_t)(32 * i) * lda);
                rb[i] = *(const u32x4*)(gb + (size_t)(32 * i) * ldb);
            }
        }
#pragma unroll
        for (int ks = 0; ks < 4; ++ks) {
            bf16x8 a0 = *(const bf16x8*)(cur + aoff + ks * 16);
            bf16x8 a1 = *(const bf16x8*)(cur + aoff + 32 * LDT + ks * 16);
            bf16x8 b0 = *(const bf16x8*)(cur + boff + ks * 16);
            bf16x8 b1 = *(const bf16x8*)(cur + boff + 32 * LDT + ks * 16);
            acc[0][0] = __builtin_amdgcn_mfma_f32_32x32x16_bf16(a0, b0, acc[0][0], 0, 0, 0);
            acc[0][1] = __builtin_amdgcn_mfma_f32_32x32x16_bf16(a0, b1, acc[0][1], 0, 0, 0);
            acc[1][0] = __builtin_amdgcn_mfma_f32_32x32x16_bf16(a1, b0, acc[1][0], 0, 0, 0);
            acc[1][1] = __builtin_amdgcn_mfma_f32_32x32x16_bf16(a1, b1, acc[1][1], 0, 0, 0);
        }
        if (more) {
            bf16_t* nxt = smem + ((kt + 1) & 1) * 2 * TILE_E;
#pragma unroll
            for (int i = 0; i < 4; ++i) {
                *(u32x4*)(nxt + soff + 32 * i * LDT) = ra[i];
                *(u32x4*)(nxt + TILE_E + soff + 32 * i * LDT) = rb[i];
            }
        }
        __syncthreads();
    }
}

DEVI void zero_acc(f32x16 (&acc)[2][2]) {
#pragma unroll
    for (int i = 0; i < 2; ++i)
#pragma unroll
        for (int j = 0; j < 2; ++j)
#pragma unroll
            for (int r = 0; r < 16; ++r) acc[i][j][r] = 0.f;
}

#define EPI_SETUP const int lane = tid & 63, wave = tid >> 6, wr = wave >> 1, wc = wave & 1, hl = lane >> 5, c32 = lane & 31; (void)wr; (void)wc; (void)hl; (void)c32;

DEVI int mod_group(int row) { return row < NCTX ? 0 : 1 + ((row - NCTX) >> 11); }

DEVI void job_ffn_up(const P& p, int l, int which, int t, bf16_t* sm, int tid) {
    const int nN = 44; const int m0 = (t / nN) * 128, n0 = (t % nN) * 128;
    const bf16_t* H = (const bf16_t*)(p.ws + WS_H);
    const bf16_t* W = (const bf16_t*)(p.ws + WS_W) + (size_t)l * LAYER_W + (which ? OFF_W13_2 : OFF_W13_1);
    bf16_t* ACT = (bf16_t*)(p.ws + WS_ACT);
    f32x16 acc[2][2]; zero_acc(acc);
    gemm_core(H + (size_t)m0 * D, D, W + (size_t)n0 * D, D, D, acc, sm, tid);
    EPI_SETUP
    const int oc = (n0 >> 1) + wc * 32 + c32;
#pragma unroll
    for (int i = 0; i < 2; ++i) {
        const int rb = m0 + wr * 64 + i * 32 + 4 * hl;
#pragma unroll
        for (int r = 0; r < 16; ++r) {
            const int row = rb + (r & 3) + 8 * (r >> 2);
            const float a = acc[i][0][r], b = acc[i][1][r];
            const float v = a * sigmoidf_(a) * b;
            ACT[(size_t)row * DFF + oc] = f2bf(v);
        }
    }
}

DEVI void job_resid(const P& p, const bf16_t* A, int lda, const bf16_t* Bt, int K, const float* gate_base, float coef, int t, bf16_t* sm, int tid) {
    const int nN = 8; const int m0 = (t / nN) * 128, n0 = (t % nN) * 128;
    float* X = (float*)(p.ws + WS_X);
    f32x16 acc[2][2]; zero_acc(acc);
    gemm_core(A + (size_t)m0 * lda, lda, Bt + (size_t)n0 * K, K, K, acc, sm, tid);
    EPI_SETUP
    const float* gate = gate_base + (size_t)mod_group(m0) * 9216;
#pragma unroll
    for (int j = 0; j < 2; ++j) {
        const int col = n0 + wc * 64 + j * 32 + c32;
        const float gv = coef * gate[col];
#pragma unroll
        for (int i = 0; i < 2; ++i) {
            const int rb = m0 + wr * 64 + i * 32 + 4 * hl;
#pragma unroll
            for (int r = 0; r < 16; ++r) {
                const int row = rb + (r & 3) + 8 * (r >> 2);
                float* xp = X + (size_t)row * D + col;
                *xp = ALPHA_F * (*xp) + gv * acc[i][j][r];
            }
        }
    }
}

DEVI void job_in(const P& p, int l, int t, bf16_t* sm, int tid) {
    const int nN = 46; const int m0 = (t / nN) * 128, n0 = (t % nN) * 128;
    const bf16_t* H = (const bf16_t*)(p.ws + WS_H);
    const bf16_t* W = (const bf16_t*)(p.ws + WS_W) + (size_t)l * LAYER_W + OFF_WIN;
    f32x16 acc[2][2]; zero_acc(acc);
    gemm_core(H + (size_t)m0 * D, D, W + (size_t)n0 * D, D, D, acc, sm, tid);
    EPI_SETUP
    const bool ctx = m0 < NCTX;
#pragma unroll
    for (int j = 0; j < 2; ++j) {
        const int col = n0 + wc * 64 + j * 32 + c32;
#pragma unroll
        for (int i = 0; i < 2; ++i) {
            const int rb = m0 + wr * 64 + i * 32 + 4 * hl;
            if (n0 < 512) {
                bf16_t* O = (bf16_t*)(p.ws + WS_UF);
#pragma unroll
                for (int r = 0; r < 16; ++r) O[(size_t)(rb + (r & 3) + 8 * (r >> 2)) * 512 + col] = f2bf(acc[i][j][r]);
            } else if (n0 < 896) {
                bf16_t* O = (bf16_t*)(p.ws + WS_UQ);
#pragma unroll
                for (int r = 0; r < 16; ++r) O[(size_t)(rb + (r & 3) + 8 * (r >> 2)) * 384 + (col - 512)] = f2bf(acc[i][j][r]);
            } else if (n0 < 1152) {
                float* O = (float*)(p.ws + WS_UKV);
#pragma unroll
                for (int r = 0; r < 16; ++r) O[(size_t)(rb + (r & 3) + 8 * (r >> 2)) * 256 + (col - 896)] = acc[i][j][r];
            } else if (n0 < 1280) {
                if (col < 1184) {
                    float* O = (float*)(p.ws + WS_KRF);
#pragma unroll
                    for (int r = 0; r < 16; ++r) O[(size_t)(rb + (r & 3) + 8 * (r >> 2)) * 32 + (col - 1152)] = acc[i][j][r];
                }
            } else if (n0 < 1792) {
                bf16_t* O = (bf16_t*)(p.ws + WS_NAQ);
#pragma unroll
                for (int r = 0; r < 16; ++r) O[(size_t)(rb + (r & 3) + 8 * (r >> 2)) * 512 + (col - 1280)] = f2bf(acc[i][j][r] * NA_QS);
            } else if (n0 < 2304) {
                bf16_t* O = (bf16_t*)(p.ws + WS_NAK);
                const int cc = col - 1792;
#pragma unroll
                for (int r = 0; r < 16; ++r) {
                    const int row = rb + (r & 3) + 8 * (r >> 2);
                    O[(size_t)row * 512 + cc] = f2bf(acc[i][j][r]);
                    if (ctx) p.out[OUT_NAK + ((size_t)((row >> 8) * 4 + l) * 256 + (row & 255)) * 512 + cc] = acc[i][j][r];
                }
            } else if (n0 < 2816) {
                bf16_t* VT = (bf16_t*)(p.ws + WS_NAVT);
                const int cc = col - 2304, h = cc >> 6, d = cc & 63;
#pragma unroll
                for (int qd = 0; qd < 4; ++qd) {
                    const int row = rb + 8 * qd;
                    u32x2 pk; pk.x = pk2(acc[i][j][4 * qd], acc[i][j][4 * qd + 1]); pk.y = pk2(acc[i][j][4 * qd + 2], acc[i][j][4 * qd + 3]);
                    if (ctx) {
                        const int b = row >> 8, s = row & 255;
                        *(u32x2*)(VT + ((size_t)((b * 8 + h) * 64 + d)) * 256 + s) = pk;
#pragma unroll
                        for (int e = 0; e < 4; ++e)
                            p.out[OUT_NAV + ((size_t)(b * 4 + l) * 256 + (s + e)) * 512 + cc] = acc[i][j][4 * qd + e];
                    } else {
                        const int rr = row - NCTX, b = rr >> 11, n = rr & 2047;
                        *(u32x2*)(VT + (size_t)4194304 + ((size_t)((b * 8 + h) * 64 + d)) * 2048 + n) = pk;
                    }
                }
            } else {
                bf16_t* O = (bf16_t*)(p.ws + WS_GATE);
                const int gc = col - 2816;
                const float bg = p.in[26][l * 3072 + gc];
                bf16_t* gp = O + (size_t)gc * M + rb;
#pragma unroll
                for (int qd = 0; qd < 4; ++qd) {
                    u32x2 pk;
                    pk.x = pk2(sigmoidf_(acc[i][j][4 * qd] + bg), sigmoidf_(acc[i][j][4 * qd + 1] + bg));
                    pk.y = pk2(sigmoidf_(acc[i][j][4 * qd + 2] + bg), sigmoidf_(acc[i][j][4 * qd + 3] + bg));
                    *(u32x2*)(gp + 8 * qd) = pk;
                }
            }
        }
    }
}

DEVI void job_uq(const P& p, int l, int t, bf16_t* sm, int tid) {
    const int nN = 6; const int m0 = (t / nN) * 128, n0 = (t % nN) * 128;
    const bf16_t* A = (const bf16_t*)(p.ws + WS_UQ);
    const bf16_t* W = (const bf16_t*)(p.ws + WS_W) + (size_t)l * LAYER_W + OFF_WUQ;
    bf16_t* Q = (bf16_t*)(p.ws + WS_Q);
    const float* ropec = (const float*)(p.ws + WS_ROPE);
    const float* ropes = ropec + 512;
    f32x16 acc[2][2]; zero_acc(acc);
    gemm_core(A + (size_t)m0 * 384, 384, W + (size_t)n0 * 384, 384, 384, acc, sm, tid);
    EPI_SETUP
    const bool lat = m0 >= NCTX;
#pragma unroll
    for (int j = 0; j < 2; ++j) {
        const int c0 = n0 + wc * 64 + j * 32;
        const int col = c0 + c32;
        const bool rope = lat && (((c0 >> 5) % 3) == 2);
        const int axis = c32 >> 4, ii = c32 & 15;
#pragma unroll
        for (int i = 0; i < 2; ++i) {
            const int rb = m0 + wr * 64 + i * 32 + 4 * hl;
#pragma unroll
            for (int r = 0; r < 16; ++r) {
                const int row = rb + (r & 3) + 8 * (r >> 2);
                float v = acc[i][j][r];
                const float pr = __shfl_xor(v, 8);
                if (rope) {
                    const int n = (row - NCTX) & 2047;
                    const int pos = axis ? (n & 63) : (n >> 6);
                    const float cs = ropec[pos * 8 + (ii & 7)], sn = ropes[pos * 8 + (ii & 7)];
                    const float rot = (ii < 8) ? -pr : pr;
                    v = v * cs + rot * sn;
                }
                Q[(size_t)row * 768 + col] = f2bf(v * MLA_QS);
            }
        }
    }
}

DEVI void job_ukv(const P& p, int l, int t, bf16_t* sm, int tid) {
    const int nN = 8; const int m0 = (t / nN) * 128, h = t % nN, n0 = h * 128;
    const bf16_t* A = (m0 < M) ? (const bf16_t*)(p.ws + WS_CKV) + (size_t)m0 * 256
                               : (const bf16_t*)(p.ws + WS_CCKV) + ((size_t)l * 1024 + (m0 - M)) * 256;
    const bf16_t* W = (const bf16_t*)(p.ws + WS_W) + (size_t)l * LAYER_W + OFF_WUKV;
    bf16_t* KN = (bf16_t*)(p.ws + WS_KN);
    bf16_t* VT = (bf16_t*)(p.ws + WS_VTM);
    f32x16 acc[2][2]; zero_acc(acc);
    gemm_core(A, 256, W + (size_t)n0 * 256, 256, 256, acc, sm, tid);
    EPI_SETUP
#pragma unroll
    for (int j = 0; j < 2; ++j) {
        const int d = j * 32 + c32;
#pragma unroll
        for (int i = 0; i < 2; ++i) {
            const int rb = m0 + wr * 64 + i * 32 + 4 * hl;
            if (wc == 0) {
#pragma unroll
                for (int r = 0; r < 16; ++r) KN[(size_t)(rb + (r & 3) + 8 * (r >> 2)) * 512 + h * 64 + d] = f2bf(acc[i][j][r]);
            } else {
#pragma unroll
                for (int qd = 0; qd < 4; ++qd) {
                    const int row = rb + 8 * qd;
                    u32x2 pk; pk.x = pk2(acc[i][j][4 * qd], acc[i][j][4 * qd + 1]); pk.y = pk2(acc[i][j][4 * qd + 2], acc[i][j][4 * qd + 3]);
                    size_t addr;
                    if (m0 < NCTX) { const int b = row >> 8, s = row & 255; addr = ((size_t)((b * 8 + h) * 64 + d)) * 256 + s; }
                    else if (m0 < M) { const int rr = row - NCTX, b = rr >> 11, n = rr & 2047; addr = (size_t)4194304 + ((size_t)((b * 8 + h) * 64 + d)) * 2560 + n; }
                    else { const int rr = row - M, b = rr >> 9, n = rr & 511; addr = (size_t)4194304 + ((size_t)((b * 8 + h) * 64 + d)) * 2560 + 2048 + n; }
                    *(u32x2*)(VT + addr) = pk;
                }
            }
        }
    }
}

template <int ldo>
DEVI void job_store(const bf16_t* A, int lda, const bf16_t* Bt, int ldb, int K, bf16_t* Out, bf16_t* sm, int tid) {
    f32x16 acc[2][2]; zero_acc(acc);
    gemm_core(A, lda, Bt, ldb, K, acc, sm, tid);
    EPI_SETUP
    bf16_t* st = sm + (wr * 64 + 4 * hl) * 136 + wc * 64 + c32;
#pragma unroll
    for (int i = 0; i < 2; ++i)
#pragma unroll
        for (int j = 0; j < 2; ++j)
#pragma unroll
            for (int r = 0; r < 16; ++r) st[(i * 32 + (r & 3) + 8 * (r >> 2)) * 136 + j * 32] = f2bf(acc[i][j][r]);
    __syncthreads();
    const int orow = tid >> 4, oc = (tid & 15) * 8;
#pragma unroll
    for (int k = 0; k < 8; ++k) {
        const u32x4 v = *(const u32x4*)(sm + (orow + 16 * k) * 136 + oc);
        *(u32x4*)(Out + (size_t)(orow + 16 * k) * ldo + oc) = v;
    }
    __syncthreads();
}

DEVI void job_f1(const P& p, int t, bf16_t* sm, int tid) {
    const bf16_t* WCS = (const bf16_t*)(p.ws + WS_WCS);
    const bf16_t* UF = (const bf16_t*)(p.ws + WS_UF);
    bf16_t* F1T = (bf16_t*)(p.ws + WS_F1T);
    if (t < 512) {
        const int bs = t >> 4, g = (t >> 2) & 3, mi = (t >> 1) & 1, ni = t & 1;
        job_store<256>(WCS + mi * 128 * 128, 128, UF + ((size_t)bs * 256 + ni * 128) * 512 + g * 128, 512, 128,
                  F1T + ((size_t)(bs * 4 + g) * 256 + mi * 128) * 256 + ni * 128, sm, tid);
    } else {
        t -= 512;
        const int bs = t >> 7, g = (t >> 5) & 3, mi = (t >> 4) & 1, ni = t & 15;
        job_store<2048>(WCS + mi * 128 * 128, 128, UF + ((size_t)NCTX + bs * 2048 + ni * 128) * 512 + g * 128, 512, 128,
                  F1T + (size_t)8388608 + ((size_t)(bs * 4 + g) * 256 + mi * 128) * 2048 + ni * 128, sm, tid);
    }
}
DEVI void job_f2_lat(const P& p, int t, bf16_t* sm, int tid) {
    const int bs = t >> 6, mi = (t >> 2) & 15, ni = t & 3;
    const bf16_t* TAB = (const bf16_t*)(p.ws + WS_TABL);
    const bf16_t* F1T = (const bf16_t*)(p.ws + WS_F1T) + (size_t)8388608;
    bf16_t* YF = (bf16_t*)(p.ws + WS_YF);
    job_store<512>(TAB + (size_t)mi * 128 * 4096, 4096, F1T + (size_t)bs * 512 * 4096 + (size_t)ni * 128 * 4096, 4096, 4096,
              YF + ((size_t)NCTX + bs * 2048 + mi * 128) * 512 + ni * 128, sm, tid);
}
DEVI void job_f2_ctx(const P& p, int t, bf16_t* sm, int tid) {
    const int bs = t >> 3, mi = (t >> 2) & 1, ni = t & 3;
    const bf16_t* TAB = (const bf16_t*)(p.ws + WS_TABC);
    const bf16_t* F1T = (const bf16_t*)(p.ws + WS_F1T);
    bf16_t* YF = (bf16_t*)(p.ws + WS_YF);
    job_store<512>(TAB + (size_t)mi * 128 * 512, 512, F1T + (size_t)bs * 512 * 512 + (size_t)ni * 128 * 512, 512, 512,
              YF + ((size_t)bs * 256 + mi * 128) * 512 + ni * 128, sm, tid);
}

DEVI void job_merge(const P& p, int l, int t, bf16_t* sm, int tid) {
    const int nN = 8; const int m0 = (t / nN) * 128, n0 = (t % nN) * 128;
    const bf16_t* Wl = (const bf16_t*)(p.ws + WS_W) + (size_t)l * LAYER_W;
    const bf16_t* GATE = (const bf16_t*)(p.ws + WS_GATE);
    bf16_t* MG = (bf16_t*)(p.ws + WS_MERGED);
    EPI_SETUP
    f32x16 tot[2][2]; zero_acc(tot);
#pragma unroll 1
    for (int s = 0; s < 3; ++s) {
        const bf16_t* A = (const bf16_t*)(p.ws + (s == 0 ? WS_YF : (s == 1 ? WS_YM : WS_YN)));
        const bf16_t* W = Wl + (s == 0 ? OFF_WBF : (s == 1 ? OFF_WBM : OFF_WBN));
        f32x16 acc[2][2]; zero_acc(acc);
        gemm_core(A + (size_t)m0 * 512, 512, W + (size_t)n0 * 512, 512, 512, acc, sm, tid);
#pragma unroll
        for (int j = 0; j < 2; ++j) {
            const int col = n0 + wc * 64 + j * 32 + c32;
#pragma unroll
            for (int i = 0; i < 2; ++i) {
                const int rb = m0 + wr * 64 + i * 32 + 4 * hl;
                const bf16_t* gp = GATE + (size_t)(s * 1024 + col) * M + rb;
#pragma unroll
                for (int qd = 0; qd < 4; ++qd) {
                    const u32x2 g = *(const u32x2*)(gp + 8 * qd);
                    tot[i][j][4 * qd + 0] += bf2f(g.x & 0xffffu) * acc[i][j][4 * qd + 0];
                    tot[i][j][4 * qd + 1] += bf2f(g.x >> 16) * acc[i][j][4 * qd + 1];
                    tot[i][j][4 * qd + 2] += bf2f(g.y & 0xffffu) * acc[i][j][4 * qd + 2];
                    tot[i][j][4 * qd + 3] += bf2f(g.y >> 16) * acc[i][j][4 * qd + 3];
                }
            }
        }
    }
#pragma unroll
    for (int j = 0; j < 2; ++j) {
        const int col = n0 + wc * 64 + j * 32 + c32;
#pragma unroll
        for (int i = 0; i < 2; ++i) {
            const int rb = m0 + wr * 64 + i * 32 + 4 * hl;
#pragma unroll
            for (int r = 0; r < 16; ++r) MG[(size_t)(rb + (r & 3) + 8 * (r >> 2)) * 1024 + col] = f2bf(tot[i][j][r]);
        }
    }
}

struct TileSrc { const bf16_t* k; const bf16_t* k2; const bf16_t* v; const bf16_t* vhi; };
DEVI int pi_row(int r) { return (r & 0x13) | ((r & 4) << 1) | ((r & 8) >> 1); }

template <int NKS>
DEVI void attn_load(const TileSrc& s, bf16x8 (&kf)[NKS], bf16x8 (&vf)[4]) {
#pragma unroll
    for (int ks = 0; ks < NKS; ++ks) kf[ks] = (ks < 4) ? *(const bf16x8*)(s.k + ks * 16) : *(const bf16x8*)(s.k2 + (ks - 4) * 16);
    vf[0] = *(const bf16x8*)(s.v);
    vf[1] = *(const bf16x8*)(s.v + 16);
    vf[2] = *(const bf16x8*)(s.vhi);
    vf[3] = *(const bf16x8*)(s.vhi + 16);
}

template <int NKS, class Src, class Mask>
DEVI void attn_wave(const bf16_t* qptr, int nt, Src src, Mask mask, bf16_t* optr, int lane) {
    bf16x8 q[NKS];
#pragma unroll
    for (int ks = 0; ks < NKS; ++ks) q[ks] = *(const bf16x8*)(qptr + ks * 16);
    f32x16 o0, o1;
#pragma unroll
    for (int r = 0; r < 16; ++r) { o0[r] = 0.f; o1[r] = 0.f; }
    float m = -1e30f, lsum = 0.f;
    bf16x8 kf[NKS], vf[4];
    { TileSrc s0 = src(0); attn_load<NKS>(s0, kf, vf); }
    for (int t = 0; t < nt; ++t) {
        bf16x8 kn[NKS], vn[4];
        { TileSrc s1 = src(t + 1 < nt ? t + 1 : t); attn_load<NKS>(s1, kn, vn); }
        f32x16 s;
#pragma unroll
        for (int r = 0; r < 16; ++r) s[r] = 0.f;
#pragma unroll
        for (int ks = 0; ks < NKS; ++ks) s = __builtin_amdgcn_mfma_f32_32x32x16_bf16(kf[ks], q[ks], s, 0, 0, 0);
        mask(t, s);
        float mx = s[0];
#pragma unroll
        for (int r = 1; r < 16; ++r) mx = fmaxf(mx, s[r]);
        mx = fmaxf(mx, __shfl_xor(mx, 32));
        const float mn = fmaxf(m, mx);
        const float alpha = fast_exp2(m - mn);
        m = mn;
        float rs = 0.f;
#pragma unroll
        for (int r = 0; r < 16; ++r) { s[r] = fast_exp2(s[r] - mn); rs += s[r]; }
        lsum = lsum * alpha + rs;
#pragma unroll
        for (int r = 0; r < 16; ++r) { o0[r] *= alpha; o1[r] *= alpha; }
        bf16x8 p0, p1;
        {
            u32x4 a, b;
            a.x = pk2(s[0], s[1]); a.y = pk2(s[2], s[3]); a.z = pk2(s[4], s[5]); a.w = pk2(s[6], s[7]);
            b.x = pk2(s[8], s[9]); b.y = pk2(s[10], s[11]); b.z = pk2(s[12], s[13]); b.w = pk2(s[14], s[15]);
            p0 = __builtin_bit_cast(bf16x8, a); p1 = __builtin_bit_cast(bf16x8, b);
        }
        o0 = __builtin_amdgcn_mfma_f32_32x32x16_bf16(vf[0], p0, o0, 0, 0, 0);
        o0 = __builtin_amdgcn_mfma_f32_32x32x16_bf16(vf[1], p1, o0, 0, 0, 0);
        o1 = __builtin_amdgcn_mfma_f32_32x32x16_bf16(vf[2], p0, o1, 0, 0, 0);
        o1 = __builtin_amdgcn_mfma_f32_32x32x16_bf16(vf[3], p1, o1, 0, 0, 0);
#pragma unroll
        for (int ks = 0; ks < NKS; ++ks) kf[ks] = kn[ks];
#pragma unroll
        for (int x = 0; x < 4; ++x) vf[x] = vn[x];
    }
    lsum += __shfl_xor(lsum, 32);
    const float inv = 1.f / lsum;
    const int hl = lane >> 5;
#pragma unroll
    for (int qd = 0; qd < 4; ++qd) {
        u32x2 a, b;
        a.x = pk2(o0[4 * qd] * inv, o0[4 * qd + 1] * inv); a.y = pk2(o0[4 * qd + 2] * inv, o0[4 * qd + 3] * inv);
        b.x = pk2(o1[4 * qd] * inv, o1[4 * qd + 1] * inv); b.y = pk2(o1[4 * qd + 2] * inv, o1[4 * qd + 3] * inv);
        *(u32x2*)(optr + 8 * qd + 4 * hl) = a;
        *(u32x2*)(optr + 32 + 8 * qd + 4 * hl) = b;
    }
}

struct NoMask { DEVI void operator()(int, f32x16&) const {} };

DEVI void attn_mla(const P& p, int l, bool lat, int b, int h, int qg, int lane) {
    const int hl = lane >> 5, c32 = lane & 31, pr = pi_row(c32);
    const bf16_t* Q = (const bf16_t*)(p.ws + WS_Q);
    const bf16_t* KN = (const bf16_t*)(p.ws + WS_KN);
    const bf16_t* KR = (const bf16_t*)(p.ws + WS_KR);
    const bf16_t* CKR = (const bf16_t*)(p.ws + WS_CKR) + (size_t)l * 1024 * 32;
    const bf16_t* VT = (const bf16_t*)(p.ws + WS_VTM);
    bf16_t* YM = (bf16_t*)(p.ws + WS_YM);
    if (!lat) {
        const int row0 = b * 256;
        const int qrow = row0 + qg * 32 + c32;
        const bf16_t* k0 = KN + (size_t)(row0 + pr) * 512 + h * 64 + hl * 8;
        const bf16_t* r0 = KR + (size_t)(row0 + pr) * 32 + hl * 8;
        const bf16_t* v0 = VT + ((size_t)((b * 8 + h) * 64 + c32)) * 256 + hl * 8;
        auto src = [=](int t) { TileSrc s; s.k = k0 + (size_t)t * 32 * 512; s.k2 = r0 + (size_t)t * 32 * 32; s.v = v0 + t * 32; s.vhi = s.v + 32 * 256; return s; };
        attn_wave<6>(Q + (size_t)qrow * 768 + h * 96 + hl * 8, 8, src, NoMask(), YM + (size_t)qrow * 512 + h * 64, lane);
    } else {
        const int row0 = NCTX + b * 2048;
        const int qrow = row0 + qg * 32 + c32;
        const bf16_t* k0 = KN + (size_t)(row0 + pr) * 512 + h * 64 + hl * 8;
        const bf16_t* r0 = KR + (size_t)(row0 + pr) * 32 + hl * 8;
        const bf16_t* k1 = KN + (size_t)(M + b * 512 + pr) * 512 + h * 64 + hl * 8;
        const bf16_t* r1 = CKR + (size_t)(b * 512 + pr) * 32 + hl * 8;
        const bf16_t* v0 = VT + (size_t)4194304 + ((size_t)((b * 8 + h) * 64 + c32)) * 2560 + hl * 8;
        auto src = [=](int t) {
            TileSrc s;
            if (t < 64) { s.k = k0 + (size_t)t * 32 * 512; s.k2 = r0 + (size_t)t * 32 * 32; }
            else { s.k = k1 + (size_t)(t - 64) * 32 * 512; s.k2 = r1 + (size_t)(t - 64) * 32 * 32; }
            s.v = v0 + t * 32; s.vhi = s.v + 32 * 2560; return s; };
        attn_wave<6>(Q + (size_t)qrow * 768 + h * 96 + hl * 8, 80, src, NoMask(), YM + (size_t)qrow * 512 + h * 64, lane);
    }
}

DEVI void attn_na_ctx(const P& p, int b, int h, int qg, int lane) {
    const int hl = lane >> 5, c32 = lane & 31, pr = pi_row(c32);
    const bf16_t* Qn = (const bf16_t*)(p.ws + WS_NAQ);
    const bf16_t* Kn = (const bf16_t*)(p.ws + WS_NAK);
    const bf16_t* VT = (const bf16_t*)(p.ws + WS_NAVT);
    bf16_t* YN = (bf16_t*)(p.ws + WS_YN);
    const int row0 = b * 256, qrow = row0 + qg * 32 + c32;
    const bf16_t* k0 = Kn + (size_t)(row0 + pr) * 512 + h * 64 + hl * 8;
    const bf16_t* v0 = VT + ((size_t)((b * 8 + h) * 64 + c32)) * 256 + hl * 8;
    auto src = [=](int t) { TileSrc s; s.k = k0 + (size_t)t * 32 * 512; s.k2 = s.k; s.v = v0 + t * 32; s.vhi = s.v + 32 * 256; return s; };
    attn_wave<4>(Qn + (size_t)qrow * 512 + h * 64 + hl * 8, 8, src, NoMask(), YN + (size_t)qrow * 512 + h * 64, lane);
}

struct NaMask {
    const float* rpb;
    int rs, rq, qc, hl;
    DEVI void operator()(int t, f32x16& s) const {
        if (t >= 16) return;
        const int kr = t >> 1, kh = t & 1;
        const int cs = min(max(qc - 8, 0), 48);
        const float* rp = rpb + (rs + kr - rq + 7) * 31;
#pragma unroll
        for (int r = 0; r < 16; ++r) {
            const int kk = (r & 3) + 4 * ((r >> 2) & 1) + 8 * hl + 16 * (r >> 3);
            const int kc = kh * 32 + kk;
            const bool ok = (kc >= cs) && (kc < cs + 16);
            const int dc = min(max(kc - qc + 15, 0), 30);
            const float bias = rp[dc] * LOG2E;
            s[r] = ok ? s[r] + bias : -1e30f;
        }
    }
};
DEVI void attn_na_lat(const P& p, int l, int b, int h, int rq, int qh, int lane) {
    const int hl = lane >> 5, c32 = lane & 31, pr = pi_row(c32);
    const bf16_t* Qn = (const bf16_t*)(p.ws + WS_NAQ);
    const bf16_t* Kn = (const bf16_t*)(p.ws + WS_NAK);
    const bf16_t* VT = (const bf16_t*)(p.ws + WS_NAVT) + (size_t)4194304;
    const bf16_t* CK = (const bf16_t*)(p.ws + WS_CNAK) + (size_t)l * 1024 * 512;
    const bf16_t* CV = (const bf16_t*)(p.ws + WS_CNAVT) + (size_t)l * 1024 * 512;
    bf16_t* YN = (bf16_t*)(p.ws + WS_YN);
    const int row0 = NCTX + b * 2048;
    const int qrow = row0 + rq * 64 + qh * 32 + c32;
    const int rs = min(max(rq - 4, 0), 24);
    const bf16_t* k0 = Kn + (size_t)(row0 + rs * 64 + pr) * 512 + h * 64 + hl * 8;
    const bf16_t* v0 = VT + ((size_t)((b * 8 + h) * 64 + c32)) * 2048 + rs * 64 + hl * 8;
    const bf16_t* k1 = CK + (size_t)(b * 512 + pr) * 512 + h * 64 + hl * 8;
    const bf16_t* v1 = CV + ((size_t)((b * 8 + h) * 64 + c32)) * 512 + hl * 8;
    auto src = [=](int t) {
        TileSrc s;
        if (t < 16) { s.k = k0 + (size_t)t * 32 * 512; s.v = v0 + t * 32; s.vhi = s.v + 32 * 2048; }
        else { s.k = k1 + (size_t)(t - 16) * 32 * 512; s.v = v1 + (t - 16) * 32; s.vhi = s.v + 32 * 512; }
        s.k2 = s.k; return s; };
    NaMask mk; mk.rpb = p.in[21] + (size_t)(l * 8 + h) * 15 * 31; mk.rs = rs; mk.rq = rq; mk.qc = qh * 32 + c32; mk.hl = hl;
    attn_wave<4>(Qn + (size_t)qrow * 512 + h * 64 + hl * 8, 32, src, mk, YN + (size_t)qrow * 512 + h * 64, lane);
}

DEVI void row_ln_mod(const float* src, float* xdst, bf16_t* hdst, const float* lng, const float* lnb, const float* shift, const float* scale, int lane) {
    f32x4 v[4];
#pragma unroll
    for (int j = 0; j < 4; ++j) v[j] = *(const f32x4*)(src + 4 * lane + 256 * j);
    if (lng) {
        float s = 0.f;
#pragma unroll
        for (int j = 0; j < 4; ++j) s += (v[j].x + v[j].y) + (v[j].z + v[j].w);
        const float mu = wave_sum(s) * (1.f / D);
        float q = 0.f;
#pragma unroll
        for (int j = 0; j < 4; ++j) { v[j] = v[j] - mu; q += (v[j].x * v[j].x + v[j].y * v[j].y) + (v[j].z * v[j].z + v[j].w * v[j].w); }
        const float rstd = rsqrtf(wave_sum(q) * (1.f / D) + 1e-5f);
#pragma unroll
        for (int j = 0; j < 4; ++j) {
            const f32x4 g = *(const f32x4*)(lng + 4 * lane + 256 * j), bb = *(const f32x4*)(lnb + 4 * lane + 256 * j);
            v[j] = v[j] * rstd * g + bb;
        }
    }
    if (xdst) {
#pragma unroll
        for (int j = 0; j < 4; ++j) *(f32x4*)(xdst + 4 * lane + 256 * j) = v[j];
    }
    if (hdst) {
        float s = 0.f;
#pragma unroll
        for (int j = 0; j < 4; ++j) s += (v[j].x + v[j].y) + (v[j].z + v[j].w);
        const float mu = wave_sum(s) * (1.f / D);
        float q = 0.f;
#pragma unroll
        for (int j = 0; j < 4; ++j) { v[j] = v[j] - mu; q += (v[j].x * v[j].x + v[j].y * v[j].y) + (v[j].z * v[j].z + v[j].w * v[j].w); }
        const float rstd = rsqrtf(wave_sum(q) * (1.f / D) + 1e-6f);
#pragma unroll
        for (int j = 0; j < 4; ++j) {
            const f32x4 sc = *(const f32x4*)(scale + 4 * lane + 256 * j), sh = *(const f32x4*)(shift + 4 * lane + 256 * j);
            const f32x4 o = v[j] * rstd * (sc + 1.f) + sh;
            u32x2 pk; pk.x = pk2(o.x, o.y); pk.y = pk2(o.z, o.w);
            *(u32x2*)(hdst + 4 * lane + 256 * j) = pk;
        }
    }
}

DEVI void phase_rows(const P& p, int l, int lnidx, int ml, int ms, bool final_, int gw, int ngw, int lane) {
    float* X = (float*)(p.ws + WS_X);
    bf16_t* H = (bf16_t*)(p.ws + WS_H);
    const float* MOD = (const float*)(p.ws + WS_MOD);
    for (int row = gw; row < M; row += ngw) {
        const float* src = (lnidx < 0) ? (row < NCTX ? p.in[0] + (size_t)row * D : p.in[1] + (size_t)(row - NCTX) * D) : X + (size_t)row * D;
        const float* lng = (lnidx < 0) ? nullptr : p.in[28] + (size_t)(l * 3 + lnidx) * D;
        const float* lnb = (lnidx < 0) ? nullptr : p.in[29] + (size_t)(l * 3 + lnidx) * D;
        if (final_) { row_ln_mod(src, p.out + (size_t)row * D, nullptr, lng, lnb, nullptr, nullptr, lane); continue; }
        const float* mb = MOD + ((size_t)ml * 3 + mod_group(row)) * 9216;
        row_ln_mod(src, X + (size_t)row * D, H + (size_t)row * D, lng, lnb, mb + ms * D, mb + (ms + 1) * D, lane);
    }
}

DEVI void phase_rowmix(const P& p, int l, int gw, int ngw, int lane) {
    bf16_t* UQ = (bf16_t*)(p.ws + WS_UQ);
    const float* UKV = (const float*)(p.ws + WS_UKV);
    const float* KRF = (const float*)(p.ws + WS_KRF);
    bf16_t* CKV = (bf16_t*)(p.ws + WS_CKV);
    bf16_t* KR = (bf16_t*)(p.ws + WS_KR);
    const float* ropec = (const float*)(p.ws + WS_ROPE);
    const float* ropes = ropec + 512;
    const float* gq = p.in[17] + l * 384;
    const float* gkv = p.in[19] + l * 256;
    for (int row = gw; row < M; row += ngw) {
        {
            unsigned* up = (unsigned*)(UQ + (size_t)row * 384) + lane;
            float x[6]; float ss = 0.f;
#pragma unroll
            for (int j = 0; j < 3; ++j) { const unsigned w = up[64 * j]; x[2 * j] = bf2f(w & 0xffffu); x[2 * j + 1] = bf2f(w >> 16); ss += x[2 * j] * x[2 * j] + x[2 * j + 1] * x[2 * j + 1]; }
            const float rs = rsqrtf(wave_sum(ss) * (1.f / 384.f) + 1e-6f);
#pragma unroll
            for (int j = 0; j < 3; ++j) { const int c = 2 * lane + 128 * j; up[64 * j] = pk2(x[2 * j] * rs * gq[c], x[2 * j + 1] * rs * gq[c + 1]); }
        }
        {
            const f32x4 v = *(const f32x4*)(UKV + (size_t)row * 256 + 4 * lane);
            const float ss = v.x * v.x + v.y * v.y + v.z * v.z + v.w * v.w;
            const float rs = rsqrtf(wave_sum(ss) * (1.f / 256.f) + 1e-6f);
            const f32x4 g = *(const f32x4*)(gkv + 4 * lane);
            const f32x4 o = v * rs * g;
            u32x2 pk; pk.x = pk2(o.x, o.y); pk.y = pk2(o.z, o.w);
            *(u32x2*)(CKV + (size_t)row * 256 + 4 * lane) = pk;
            if (row < NCTX) *(f32x4*)(p.out + OUT_CKV + ((size_t)((row >> 8) * 4 + l) * 256 + (row & 255)) * 256 + 4 * lane) = o;
        }
        {
            const float v = KRF[(size_t)row * 32 + (lane & 31)];
            const float pr = __shfl_xor(v, 8);
            float o = v;
            if (row >= NCTX) {
                const int c = lane & 31, axis = c >> 4, ii = c & 15, n = (row - NCTX) & 2047;
                const int pos = axis ? (n & 63) : (n >> 6);
                const float rot = (ii < 8) ? -pr : pr;
                o = v * ropec[pos * 8 + (ii & 7)] + rot * ropes[pos * 8 + (ii & 7)];
            }
            if (lane < 32) {
                KR[(size_t)row * 32 + lane] = f2bf(o);
                if (row < NCTX) p.out[OUT_KR + ((size_t)((row >> 8) * 4 + l) * 256 + (row & 255)) * 32 + lane] = v;
            }
        }
    }
}

DEVI void transpose_item(const float* __restrict__ src, int N, int c0, int k0, bf16_t* __restrict__ dst, int K, float* scr, int lane) {
#pragma unroll 8
    for (int i = 0; i < 32; ++i) { const int kk = 2 * i + (lane >> 5); scr[kk * 33 + (lane & 31)] = src[(size_t)(k0 + kk) * N + c0 + (lane & 31)]; }
    asm volatile("s_waitcnt lgkmcnt(0)" ::: "memory");
    const int c = lane & 7;
#pragma unroll
    for (int j = 0; j < 4; ++j) {
        const int n = (lane >> 3) + 8 * j; const float* s = scr + (8 * c) * 33 + n;
        u32x4 o; o.x = pk2(s[0], s[33]); o.y = pk2(s[2 * 33], s[3 * 33]); o.z = pk2(s[4 * 33], s[5 * 33]); o.w = pk2(s[6 * 33], s[7 * 33]);
        *(u32x4*)(dst + (size_t)n * K + k0 + 8 * c) = o;
    }
    asm volatile("s_waitcnt lgkmcnt(0)" ::: "memory");
}

DEVI void prep_weight_item(const P& p, int item, float* scr, int lane) {
    const int l = item / 12944; int r = item % 12944;
    bf16_t* Wl = (bf16_t*)(p.ws + WS_W) + (size_t)l * LAYER_W;
    if (r < 8448) {
        const int which = r / 4224; r %= 4224;
        if (r < 2816) {
            const int rb = r >> 4, kb = r & 15;
            const float* src = (which ? ((rb & 1) ? p.in[14] : p.in[13]) : ((rb & 1) ? p.in[11] : p.in[10])) + (size_t)l * D * DFF;
            transpose_item(src, DFF, (rb >> 1) * 32, kb * 64, Wl + (which ? OFF_W13_2 : OFF_W13_1) + (size_t)rb * 32 * D, D, scr, lane);
        } else {
            r -= 2816; const int rb = r / 44, kb = r % 44;
            const float* src = (which ? p.in[15] : p.in[12]) + (size_t)l * DFF * D;
            transpose_item(src, D, rb * 32, kb * 64, Wl + (which ? OFF_W2_2 : OFF_W2_1) + (size_t)rb * 32 * DFF, DFF, scr, lane);
        }
        return;
    }
    r -= 8448;
    if (r < 2944) {
        const int rb = r >> 4, kb = r & 15, R0 = rb * 32;
        const float* src; int N, c0;
        if (R0 < 1184) { src = p.in[16] + (size_t)l * D * 2720; N = 2720; c0 = R0; }
        else if (R0 < 1280) return;
        else if (R0 < 2816) { src = p.in[16] + (size_t)l * D * 2720; N = 2720; c0 = R0 - 96; }
        else { src = p.in[25] + (size_t)l * D * 3072; N = 3072; c0 = R0 - 2816; }
        transpose_item(src, N, c0, kb * 64, Wl + OFF_WIN + (size_t)R0 * D, D, scr, lane);
        return;
    }
    r -= 2944;
    if (r < 512) { const int rb = r >> 4, kb = r & 15; transpose_item(p.in[27] + (size_t)l * D * D, D, rb * 32, kb * 64, Wl + OFF_WOUT + (size_t)rb * 32 * D, D, scr, lane); return; }
    r -= 512;
    if (r < 768) { const int w = r >> 8; r &= 255; const int rb = r >> 3, kb = r & 7;
        transpose_item((w == 0 ? p.in[22] : (w == 1 ? p.in[23] : p.in[24])) + (size_t)l * 512 * D, D, rb * 32, kb * 64, Wl + (w == 0 ? OFF_WBF : (w == 1 ? OFF_WBM : OFF_WBN)) + (size_t)rb * 32 * 512, 512, scr, lane); return; }
    r -= 768;
    if (r < 144) { const int rb = r / 6, kb = r % 6; transpose_item(p.in[18] + (size_t)l * 384 * 768, 768, rb * 32, kb * 64, Wl + OFF_WUQ + (size_t)rb * 32 * 384, 384, scr, lane); return; }
    r -= 144;
    { const int rb = r >> 2, kb = r & 3; transpose_item(p.in[20] + (size_t)l * 256 * 1024, 1024, rb * 32, kb * 64, Wl + OFF_WUKV + (size_t)rb * 32 * 256, 256, scr, lane); }
}

DEVI void phase_prep(const P& p, unsigned char* smem, int tid) {
    const int lane = tid & 63, wave = tid >> 6;
    const int gw = blockIdx.x * 4 + wave, ngw = gridDim.x * 4;
    const size_t gt = (size_t)blockIdx.x * 256 + tid, ngt = (size_t)gridDim.x * 256;
    {
        float* sil = (float*)smem;
        const float* wada = p.in[8];
        float* MODP = (float*)(p.ws + WS_MODP);
        for (int item = blockIdx.x; item < 2304; item += gridDim.x) {
            const int l = item / 576, rem = item % 576, kc = rem / 36, cb = rem % 36;
            __syncthreads();
            if (tid < 192) {
                const int g = tid >> 6, k = kc * 64 + (tid & 63);
                const float cv = (g == 0) ? p.in[7][k] : p.in[6][(g - 1) * D + k];
                sil[tid] = cv * sigmoidf_(cv);
            }
            __syncthreads();
            const int col = cb * 256 + tid;
            const float* w = wada + ((size_t)l * D + kc * 64) * 9216 + col;
            float a0 = 0.f, a1 = 0.f, a2 = 0.f;
#pragma unroll 16
            for (int k = 0; k < 64; ++k) { const float wv = w[(size_t)k * 9216]; a0 += sil[k] * wv; a1 += sil[64 + k] * wv; a2 += sil[128 + k] * wv; }
            float* o = MODP + ((size_t)(l * 16 + kc) * 3) * 9216 + col;
            o[0] = a0; o[9216] = a1; o[2 * 9216] = a2;
        }
        __syncthreads();
    }
    {
        float* scr = (float*)smem + wave * (64 * 33);
        for (int item = gw; item < 4 * 12944; item += ngw) prep_weight_item(p, item, scr, lane);
    }
    {
        bf16_t* TABL = (bf16_t*)(p.ws + WS_TABL);
        for (size_t e = gt; e < (size_t)2048 * 4096; e += ngt) {
            const int k = (int)(e >> 12), kk = (int)(e & 4095), lidx = kk & 2047;
            const int idx = (k * lidx) & 2047;
            float sn, cs; sincospif((float)idx * (2.f / 2048.f), &sn, &cs);
            TABL[e] = f2bf((kk < 2048 ? cs : -sn) * 0.022097086912079608f);
        }
        bf16_t* TABC = (bf16_t*)(p.ws + WS_TABC);
        for (size_t e = gt; e < (size_t)256 * 512; e += ngt) {
            const int k = (int)(e >> 9), kk = (int)(e & 511), lidx = kk & 255;
            const int idx = (k * lidx) & 255;
            float sn, cs; sincospif((float)idx * (2.f / 256.f), &sn, &cs);
            TABC[e] = f2bf((kk < 256 ? cs : -sn) * 0.0625f);
        }
        bf16_t* WCS = (bf16_t*)(p.ws + WS_WCS);
        for (size_t e = gt; e < (size_t)256 * 128; e += ngt) {
            const int i = (int)(e >> 7), c = (int)(e & 127), m = i >> 1, cs_ = i & 1;
            const int idx = (m * c) & 127;
            float sn, cs; sincospif((float)idx * (2.f / 128.f), &sn, &cs);
            WCS[e] = f2bf((cs_ ? sn : cs) * 0.08838834764831845f);
        }
        float* ROPE = (float*)(p.ws + WS_ROPE);
        for (size_t e = gt; e < 512; e += ngt) {
            const int pos = (int)(e >> 3), i = (int)(e & 7);
            const float inv_freq = powf(10000.f, -(float)i / 8.f);
            const float ang = (float)pos * inv_freq;
            ROPE[e] = cosf(ang); ROPE[512 + e] = sinf(ang);
        }
    }
    {
        bf16_t* CCKV = (bf16_t*)(p.ws + WS_CCKV);
        for (size_t e = gt; e < (size_t)NL * 1024 * 256; e += ngt) {
            const int c = (int)(e & 255), i = (int)((e >> 8) & 511), b = (int)((e >> 17) & 1), l = (int)(e >> 18);
            CCKV[e] = f2bf(p.in[2][((size_t)(b * 4 + l) * 512 + i) * 256 + c]);
        }
        bf16_t* CKR = (bf16_t*)(p.ws + WS_CKR);
        for (size_t e = gt; e < (size_t)NL * 1024 * 32; e += ngt) {
            const int c = (int)(e & 31), i = (int)((e >> 5) & 511), b = (int)((e >> 14) & 1), l = (int)(e >> 15);
            CKR[e] = f2bf(p.in[3][((size_t)(b * 4 + l) * 512 + i) * 32 + c]);
        }
        bf16_t* CNAK = (bf16_t*)(p.ws + WS_CNAK);
        for (size_t e = gt; e < (size_t)NL * 1024 * 512; e += ngt) {
            const int c = (int)(e & 511), i = (int)((e >> 9) & 511), b = (int)((e >> 18) & 1), l = (int)(e >> 19);
            CNAK[e] = f2bf(p.in[4][((size_t)(b * 4 + l) * 512 + i) * 512 + c]);
        }
        bf16_t* CNAVT = (bf16_t*)(p.ws + WS_CNAVT);
        for (size_t e = gt; e < (size_t)NL * 1024 * 512; e += ngt) {
            const int key = (int)(e & 511), hd = (int)((e >> 9) & 511), b = (int)((e >> 18) & 1), l = (int)(e >> 19);
            CNAVT[e] = f2bf(p.in[5][((size_t)(b * 4 + l) * 512 + key) * 512 + hd]);
        }
    }
}

DEVI void phase_modreduce(const P& p, int tid) {
    const float* MODP = (const float*)(p.ws + WS_MODP);
    float* MOD = (float*)(p.ws + WS_MOD);
    for (int e = blockIdx.x * 256 + tid; e < NL * 3 * 9216; e += gridDim.x * 256) {
        const int l = e / (3 * 9216), rem = e % (3 * 9216);
        float a = p.in[9][l * 9216 + (rem % 9216)];
#pragma unroll
        for (int kc = 0; kc < 16; ++kc) a += MODP[((size_t)(l * 16 + kc) * 3) * 9216 + rem];
        MOD[e] = a;
    }
}

#define XB_TMO      128
#define XB_XCNT(j)  (256  + 64 * (j))
#define XB_XSUB(j)  (1280 + 64 * (j))
#define XB_XGEN(j)  (2304 + 64 * (j))
#define XB_TOP      3328
#define XB_TOPGEN   3392
#define XCD_BAR_WORDS 3456
#define XB_SPIN_CAP (1u << 20)
#define LAS __attribute__((address_space(3)))
DEVI unsigned xb_ld(unsigned* p)              { return __hip_atomic_load(p, __ATOMIC_RELAXED, __HIP_MEMORY_SCOPE_AGENT); }
DEVI unsigned xb_add(unsigned* p, unsigned v) { return __hip_atomic_fetch_add(p, v, __ATOMIC_RELAXED, __HIP_MEMORY_SCOPE_AGENT); }
DEVI unsigned xb_xcc_id() { return (unsigned)__builtin_amdgcn_s_getreg((3 << 11) | 20) & 0xFu; }
#define XB_SPIN(cond, bar) do { unsigned _sp = 0; while (cond) { __builtin_amdgcn_s_sleep(1); \
    if ((++_sp & 255u) == 0u) { if (xb_ld(&(bar)[XB_TMO])) break; if (_sp > XB_SPIN_CAP) { atomicAdd(&(bar)[XB_TMO], 1u); break; } } } } while (0)
struct XcdBarrier { unsigned* bar; unsigned x; volatile LAS unsigned* st; };
DEVI XcdBarrier xcd_barrier_post(unsigned* bar, volatile LAS unsigned* st) {
    XcdBarrier b; b.bar = bar; b.x = xb_xcc_id(); b.st = st;
    if (threadIdx.x == 0) (void)xb_add(&bar[XB_XCNT(b.x)], 1u);
    return b;
}
DEVI void xcd_barrier_complete(unsigned* bar, unsigned x, unsigned& nloc, unsigned& nx) {
    const unsigned G = gridDim.x * gridDim.y * gridDim.z;
    unsigned sum, cnt, mine, sp = 0u;
    for (;;) {
        sum = 0u; cnt = 0u; mine = 0u;
#pragma unroll
        for (unsigned j = 0; j < 16; ++j) { const unsigned c = xb_ld(&bar[XB_XCNT(j)]); sum += c; cnt += (c > 0u) ? 1u : 0u; mine = (j == x) ? c : mine; }
        if (sum == G) break;
        __builtin_amdgcn_s_sleep(1);
        if ((++sp & 255u) == 0u) { if (xb_ld(&bar[XB_TMO])) break; if (sp > XB_SPIN_CAP) { atomicAdd(&bar[XB_TMO], 1u); break; } }
    }
    nloc = mine > 0u ? mine : 1u; nx = cnt > 0u ? cnt : 1u;
}
DEVI void xcd_barrier(const XcdBarrier& b) {
    asm volatile("s_waitcnt vmcnt(0)" ::: "memory");
    __syncthreads();
    if (threadIdx.x == 0) {
        unsigned* bar = b.bar;
        __builtin_amdgcn_s_waitcnt(0);
        unsigned nloc = b.st[0], nx = b.st[1];
        if (nloc == 0u) { xcd_barrier_complete(bar, b.x, nloc, nx); b.st[0] = nloc; b.st[1] = nx; }
        const unsigned old = xb_add(&bar[XB_XSUB(b.x)], 1u);
        const unsigned gen = old / nloc;
        if (old + 1u == (gen + 1u) * nloc) {
            __builtin_amdgcn_fence(__ATOMIC_RELEASE, "agent");
            asm volatile("s_waitcnt vmcnt(0)" ::: "memory");
            const unsigned og = xb_add(&bar[XB_TOP], 1u);
            const unsigned tg = og / nx;
            if (og + 1u == (tg + 1u) * nx) xb_add(&bar[XB_TOPGEN], 1u);
            else XB_SPIN(xb_ld(&bar[XB_TOPGEN]) == tg, bar);
            __builtin_amdgcn_fence(__ATOMIC_ACQUIRE, "agent");
            xb_add(&bar[XB_XGEN(b.x)], 1u);
            asm volatile("s_waitcnt vmcnt(0)" ::: "memory");
        } else {
            XB_SPIN(xb_ld(&bar[XB_XGEN(b.x)]) == gen, bar);
            __builtin_amdgcn_fence(__ATOMIC_ACQUIRE, "agent");
            asm volatile("s_waitcnt vmcnt(0)" ::: "memory");
        }
    }
    __syncthreads();
}

DEVI void run_phase(const P& p, int ph, unsigned char* smem, int tid) {
    bf16_t* sm = (bf16_t*)smem;
    const int lane = tid & 63, wave = tid >> 6;
    const int gw = blockIdx.x * 4 + wave, ngw = gridDim.x * 4;
    const int nb = gridDim.x, bid = blockIdx.x;
    if (ph == 0) { phase_prep(p, smem, tid); return; }
    if (ph == 1) { phase_modreduce(p, tid); return; }
    if (ph == 2) { phase_rows(p, 0, -1, 0, 0, false, gw, ngw, lane); return; }
    const int l = (ph - 3) / 13, s = (ph - 3) % 13;
    const bf16_t* Wl = (const bf16_t*)(p.ws + WS_W) + (size_t)l * LAYER_W;
    const float* MODl = (const float*)(p.ws + WS_MOD) + (size_t)l * 3 * 9216;
    switch (s) {
    case 0: case 10:
        for (int t = bid; t < 96 * 44; t += nb) job_ffn_up(p, l, s == 10, t, sm, tid);
        break;
    case 1: case 11:
        for (int t = bid; t < 96 * 8; t += nb)
            job_resid(p, (const bf16_t*)(p.ws + WS_ACT), DFF, Wl + (s == 11 ? OFF_W2_2 : OFF_W2_1), DFF, MODl + (s == 11 ? 8 : 2) * D, 0.5f, t, sm, tid);
        break;
    case 2: phase_rows(p, l, 0, l, 3, false, gw, ngw, lane); break;
    case 3:
        for (int t = bid; t < 96 * 46; t += nb) job_in(p, l, t, sm, tid);
        break;
    case 4: phase_rowmix(p, l, gw, ngw, lane); break;
    case 5: {
        int t = bid;
        for (; t < 256; t += nb) {
            const int wi = t * 4 + wave;
            attn_na_lat(p, l, wi >> 9, (wi >> 6) & 7, (wi >> 1) & 31, wi & 1, lane);
        }
        for (; t < 256 + 832; t += nb) job_ukv(p, l, t - 256, sm, tid);
        for (; t < 256 + 832 + 576; t += nb) job_uq(p, l, t - 256 - 832, sm, tid);
        for (; t < 256 + 832 + 576 + 768; t += nb) job_f1(p, t - 256 - 832 - 576, sm, tid);
        for (; t < 256 + 832 + 576 + 768 + 512; t += nb) {
            const int wi = (t - 256 - 832 - 576 - 768) * 4 + wave;
            attn_na_ctx(p, wi >> 6, (wi >> 3) & 7, wi & 7, lane);
        }
    } break;
    case 6: {
        int t = bid;
        for (; t < 256; t += nb) {
            const int wi = t * 4 + wave;
            attn_mla(p, l, true, wi >> 9, (wi >> 6) & 7, wi & 63, lane);
        }
        for (; t < 256 + 128; t += nb) job_f2_lat(p, t - 256, sm, tid);
        for (; t < 256 + 128 + 256; t += nb) job_f2_ctx(p, t - 256 - 128, sm, tid);
        for (; t < 256 + 128 + 256 + 512; t += nb) {
            const int wi = (t - 256 - 128 - 256) * 4 + wave;
            attn_mla(p, l, false, wi >> 6, (wi >> 3) & 7, wi & 7, lane);
        }
    } break;
    case 7:
        for (int t = bid; t < 96 * 8; t += nb) job_merge(p, l, t, sm, tid);
        break;
    case 8:
        for (int t = bid; t < 96 * 8; t += nb)
            job_resid(p, (const bf16_t*)(p.ws + WS_MERGED), D, Wl + OFF_WOUT, D, MODl + 5 * D, 1.0f, t, sm, tid);
        break;
    case 9: phase_rows(p, l, 1, l, 6, false, gw, ngw, lane); break;
    case 12:
        if (l == NL - 1) phase_rows(p, l, 2, 0, 0, true, gw, ngw, lane);
        else phase_rows(p, l, 2, l + 1, 0, false, gw, ngw, lane);
        break;
    default: break;
    }
}

__global__ void __launch_bounds__(256, 2) mega_kernel(P p) {
    extern __shared__ __attribute__((aligned(16))) unsigned char smem[];
    __shared__ uint4 xb_words;
    cg::grid_group grid = cg::this_grid();
    const int tid = threadIdx.x;
    unsigned* bar = (unsigned*)(p.ws + WS_BAR);
    if (tid == 0) xb_words = make_uint4(0u, 0u, 0u, 0u);
    if (p.ph_lo == 0 && blockIdx.x == 0) for (int i = tid; i < XCD_BAR_WORDS; i += 256) bar[i] = 0u;
    __syncthreads();
    XcdBarrier xb; xb.bar = bar; xb.x = 0; xb.st = (volatile LAS unsigned*)&xb_words;
#pragma nounroll
    for (int ph = p.ph_lo; ph < p.ph_hi; ++ph) {
        int tid2 = tid; asm volatile("" : "+v"(tid2));
        run_phase(p, ph, smem, tid2);
        if (ph + 1 < p.ph_hi) {
            if (ph == p.ph_lo) { grid.sync(); xb = xcd_barrier_post(bar, (volatile LAS unsigned*)&xb_words); }
            else xcd_barrier(xb);
        }
    }
}

extern "C" void kernel_launch(void* const* d_in, const int* in_sizes, int n_in, void* d_out, int out_size, void* d_ws, size_t ws_size,
                              hipStream_t stream) {
    static int grid_blocks = 0;
    if (grid_blocks == 0) {
        if (n_in != 30 || ws_size < WS_END) { fprintf(stderr, "kernel_launch: n_in %d ws %zu need %zu\n", n_in, ws_size, (size_t)WS_END); grid_blocks = -1; return; }
        int dev = 0, cus = 0, per_cu = 0;
        hipGetDevice(&dev);
        hipDeviceGetAttribute(&cus, hipDeviceAttributeMultiprocessorCount, dev);
        hipFuncSetAttribute((const void*)mega_kernel, hipFuncAttributeMaxDynamicSharedMemorySize, SMEM_BYTES);
        hipOccupancyMaxActiveBlocksPerMultiprocessor(&per_cu, (const void*)mega_kernel, 256, SMEM_BYTES);
        if (per_cu < 1) per_cu = 1;
        if (per_cu > 2) per_cu = 2;
        grid_blocks = cus * per_cu;
    }
    if (grid_blocks < 0) return;
    P p{};
    for (int i = 0; i < 30; ++i) p.in[i] = (const float*)d_in[i];
    p.out = (float*)d_out; p.ws = (unsigned char*)d_ws; p.ph_lo = 0; p.ph_hi = NPHASE;
#ifndef MULTI_LAUNCH
#define MULTI_LAUNCH 0
#endif
#if MULTI_LAUNCH
    for (int ph = 0; ph < NPHASE; ++ph) {
        p.ph_lo = ph; p.ph_hi = ph + 1;
        hipLaunchKernelGGL(mega_kernel, dim3(grid_blocks), dim3(256), SMEM_BYTES, stream, p);
    }
#else
    void* args[] = {&p};
    hipError_t e = hipLaunchCooperativeKernel((const void*)mega_kernel, dim3(grid_blocks), dim3(256), args, SMEM_BYTES, stream);
    if (e != hipSuccess) fprintf(stderr, "cooperative launch failed: %s (grid %d)\n", hipGetErrorString(e), grid_blocks);
#endif
}
```

```cpp
#include <hip/hip_runtime.h>
#include <hip/hip_cooperative_groups.h>
#include <cstdint>
#include <cstdio>
namespace cg = cooperative_groups;

typedef unsigned short bf16_t;
typedef short bf16x8 __attribute__((ext_vector_type(8)));
typedef float f32x16 __attribute__((ext_vector_type(16)));
typedef float f32x4 __attribute__((ext_vector_type(4)));
typedef unsigned u32x4 __attribute__((ext_vector_type(4)));
typedef unsigned u32x2 __attribute__((ext_vector_type(2)));
#define DEVI __device__ __forceinline__

constexpr int D = 1024, NCTX = 8192, NLAT = 4096, M = 12288, MX = 13312, DFF = 2816, NL = 4;
constexpr float ALPHA_F = 1.6817928305074290f;
constexpr float LOG2E = 1.4426950408889634f;
constexpr float MLA_QS = 0.10206207261596575f * LOG2E;
constexpr float NA_QS = 0.125f * LOG2E;
constexpr size_t OUT_CKV = 12582912, OUT_KR = 20971520, OUT_NAK = 22020096, OUT_NAV = 38797312;

constexpr size_t al256(size_t x) { return (x + 255) & ~(size_t)255; }
constexpr size_t WS_BAR = 0;
constexpr size_t WS_X = 16384;
constexpr size_t WS_H = WS_X + (size_t)M * D * 4;
constexpr size_t WS_MOD = WS_H + (size_t)M * D * 2;
constexpr size_t WS_MODP = WS_MOD + al256((size_t)NL * 3 * 9216 * 4);
constexpr size_t WS_ROPE = WS_MODP + al256((size_t)NL * 16 * 3 * 9216 * 4);
constexpr size_t WS_TABC = WS_ROPE + 4096;
constexpr size_t WS_TABL = WS_TABC + (size_t)256 * 512 * 2;
constexpr size_t WS_WCS = WS_TABL + (size_t)2048 * 4096 * 2;
constexpr size_t WS_CCKV = WS_WCS + (size_t)256 * 128 * 2;
constexpr size_t WS_CKR = WS_CCKV + (size_t)NL * 1024 * 256 * 2;
constexpr size_t WS_CNAK = WS_CKR + (size_t)NL * 1024 * 32 * 2;
constexpr size_t WS_CNAVT = WS_CNAK + (size_t)NL * 1024 * 512 * 2;
constexpr size_t WS_W = WS_CNAVT + (size_t)NL * 1024 * 512 * 2;
constexpr size_t OFF_W13_1 = 0, OFF_W2_1 = 5767168, OFF_W13_2 = 8650752, OFF_W2_2 = 14417920, OFF_WIN = 17301504,
                 OFF_WOUT = 23330816, OFF_WBF = 24379392, OFF_WBM = 24903680, OFF_WBN = 25427968, OFF_WUQ = 25952256,
                 OFF_WUKV = 26247168, LAYER_W = 26509312;
constexpr size_t WS_R1 = WS_W + (size_t)NL * LAYER_W * 2;
constexpr size_t WS_ACT = WS_R1;
constexpr size_t WS_UF = WS_R1;
constexpr size_t WS_UQ = WS_UF + (size_t)M * 512 * 2;
constexpr size_t WS_UKV = WS_UQ + (size_t)M * 384 * 2;
constexpr size_t WS_KRF = WS_UKV + (size_t)M * 256 * 4;
constexpr size_t WS_CKV = WS_KRF + (size_t)M * 32 * 4;
constexpr size_t WS_KR = WS_CKV + (size_t)M * 256 * 2;
constexpr size_t WS_NAQ = WS_KR + (size_t)M * 32 * 2;
constexpr size_t WS_NAK = WS_NAQ + (size_t)M * 512 * 2;
constexpr size_t WS_NAVT = WS_NAK + (size_t)M * 512 * 2;
constexpr size_t WS_GATE = WS_NAVT + (size_t)M * 512 * 2;
constexpr size_t WS_Q = WS_GATE + (size_t)M * 3072 * 2;
constexpr size_t WS_KN = WS_Q + (size_t)M * 768 * 2;
constexpr size_t WS_VTM = WS_KN + (size_t)MX * 512 * 2;
constexpr size_t WS_F1T = WS_VTM + (size_t)MX * 512 * 2;
constexpr size_t WS_YF = WS_F1T + (size_t)M * 1024 * 2;
constexpr size_t WS_YM = WS_YF + (size_t)M * 512 * 2;
constexpr size_t WS_YN = WS_YM + (size_t)M * 512 * 2;
constexpr size_t WS_MERGED = WS_YN + (size_t)M * 512 * 2;
constexpr size_t WS_END = WS_MERGED + (size_t)M * 1024 * 2;
static_assert(WS_END - WS_R1 >= (size_t)M * DFF * 2, "ACT must fit in R1");

constexpr int NPHASE = 3 + 13 * NL;

struct P {
    const float* in[30];
    float* out;
    unsigned char* ws;
    int ph_lo, ph_hi;
};

typedef __bf16 bf16v2 __attribute__((ext_vector_type(2)));
typedef float f32x2 __attribute__((ext_vector_type(2)));
DEVI unsigned pk2(float lo, float hi) { f32x2 v = {lo, hi}; bf16v2 b = __builtin_convertvector(v, bf16v2); return __builtin_bit_cast(unsigned, b); }
DEVI bf16_t f2bf(float x) { return (bf16_t)(pk2(x, 0.f) & 0xffffu); }
DEVI float bf2f(unsigned v) { return __uint_as_float(v << 16); }
DEVI float wave_sum(float v) {
#pragma unroll
    for (int o = 1; o < 64; o <<= 1) v += __shfl_xor(v, o);
    return v;
}
DEVI float fast_exp2(float x) { return __builtin_amdgcn_exp2f(x); }
DEVI float sigmoidf_(float x) { return 1.f / (1.f + __expf(-x)); }

constexpr int LDT = 72;
constexpr int TILE_E = 128 * LDT;
constexpr int SMEM_BYTES = 4 * TILE_E * 2;

DEVI void gemm_ldg(const bf16_t* ga, const bf16_t* gb, int lda, int ldb, u32x4 (&ra)[4], u32x4 (&rb)[4]) {
#pragma unroll
    for (int i = 0; i < 4; ++i) {
        ra[i] = *(const u32x4*)(ga + (size_t)(32 * i) * lda);
        rb[i] = *(const u32x4*)(gb + (size_t)(32 * i) * ldb);
    }
}
DEVI void gemm_sts(bf16_t* buf, int soff, const u32x4 (&ra)[4], const u32x4 (&rb)[4]) {
#pragma unroll
    for (int i = 0; i < 4; ++i) {
        *(u32x4*)(buf + soff + 32 * i * LDT) = ra[i];
        *(u32x4*)(buf + TILE_E + soff + 32 * i * LDT) = rb[i];
    }
}
DEVI void gemm_mma(const bf16_t* cur, int aoff, int boff, f32x16 (&acc)[2][2]) {
#pragma unroll
    for (int ks = 0; ks < 4; ++ks) {
        bf16x8 a0 = *(const bf16x8*)(cur + aoff + ks * 16);
        bf16x8 a1 = *(const bf16x8*)(cur + aoff + 32 * LDT + ks * 16);
        bf16x8 b0 = *(const bf16x8*)(cur + boff + ks * 16);
        bf16x8 b1 = *(const bf16x8*)(cur + boff + 32 * LDT + ks * 16);
        acc[0][0] = __builtin_amdgcn_mfma_f32_32x32x16_bf16(a0, b0, acc[0][0], 0, 0, 0);
        acc[0][1] = __builtin_amdgcn_mfma_f32_32x32x16_bf16(a0, b1, acc[0][1], 0, 0, 0);
        acc[1][0] = __builtin_amdgcn_mfma_f32_32x32x16_bf16(a1, b0, acc[1][0], 0, 0, 0);
        acc[1][1] = __builtin_amdgcn_mfma_f32_32x32x16_bf16(a1, b1, acc[1][1], 0, 0, 0);
    }
}

template <bool DEEP = true>
DEVI void gemm_core(const bf16_t* __restrict__ A, int lda, const bf16_t* __restrict__ B, int ldb, int K,
                    f32x16 (&acc)[2][2], bf16_t* smem, int tid) {
    const int lane = tid & 63, wave = tid >> 6, wr = wave >> 1, wc = wave & 1;
    const int lr = tid >> 3, lc = (tid & 7) * 8;
    const bf16_t* ga = A + (size_t)lr * lda + lc;
    const bf16_t* gb = B + (size_t)lr * ldb + lc;
    const int soff = lr * LDT + lc;
    const int nk = K >> 6;
    const int aoff = (wr * 64 + (lane & 31)) * LDT + (lane >> 5) * 8;
    const int boff = TILE_E + (wc * 64 + (lane & 31)) * LDT + (lane >> 5) * 8;
    bf16_t* buf0 = smem; bf16_t* buf1 = smem + 2 * TILE_E;
    if constexpr (DEEP) {
        u32x4 ra0[4], rb0[4], ra1[4], rb1[4];
        gemm_ldg(ga, gb, lda, ldb, ra0, rb0);
        gemm_ldg(ga + 64, gb + 64, lda, ldb, ra1, rb1);
        gemm_sts(buf0, soff, ra0, rb0);
        __syncthreads();
        for (int kt = 0; kt < nk; kt += 2) {
            if (kt + 2 < nk) gemm_ldg(ga + (size_t)(kt + 2) * 64, gb + (size_t)(kt + 2) * 64, lda, ldb, ra0, rb0);
            gemm_mma(buf0, aoff, boff, acc);
            gemm_sts(buf1, soff, ra1, rb1);
            __syncthreads();
            if (kt + 3 < nk) gemm_ldg(ga + (size_t)(kt + 3) * 64, gb + (size_t)(kt + 3) * 64, lda, ldb, ra1, rb1);
            gemm_mma(buf1, aoff, boff, acc);
            if (kt + 2 < nk) gemm_sts(buf0, soff, ra0, rb0);
            __syncthreads();
        }
    } else {
        u32x4 ra[4], rb[4];
        gemm_ldg(ga, gb, lda, ldb, ra, rb);
        gemm_sts(buf0, soff, ra, rb);
        __syncthreads();
        for (int kt = 0; kt < nk; ++kt) {
            bf16_t* cur = (kt & 1) ? buf1 : buf0;
            bf16_t* nxt = (kt & 1) ? buf0 : buf1;
            const bool more = (kt + 1 < nk);
            if (more) { ga += 64; gb += 64; gemm_ldg(ga, gb, lda, ldb, ra, rb); }
            gemm_mma(cur, aoff, boff, acc);
            if (more) gemm_sts(nxt, soff, ra, rb);
            __syncthreads();
        }
    }
}

DEVI void zero_acc(f32x16 (&acc)[2][2]) {
#pragma unroll
    for (int i = 0; i < 2; ++i)
#pragma unroll
        for (int j = 0; j < 2; ++j)
#pragma unroll
            for (int r = 0; r < 16; ++r) acc[i][j][r] = 0.f;
}

#define EPI_SETUP const int lane = tid & 63, wave = tid >> 6, wr = wave >> 1, wc = wave & 1, hl = lane >> 5, c32 = lane & 31; (void)wr; (void)wc; (void)hl; (void)c32;

DEVI int mod_group(int row) { return row < NCTX ? 0 : 1 + ((row - NCTX) >> 11); }

DEVI void job_ffn_up(const P& p, int l, int which, int t, bf16_t* sm, int tid) {
    const int nN = 44; const int m0 = (t / nN) * 128, n0 = (t % nN) * 128;
    const bf16_t* H = (const bf16_t*)(p.ws + WS_H);
    const bf16_t* W = (const bf16_t*)(p.ws + WS_W) + (size_t)l * LAYER_W + (which ? OFF_W13_2 : OFF_W13_1);
    bf16_t* ACT = (bf16_t*)(p.ws + WS_ACT);
    f32x16 acc[2][2]; zero_acc(acc);
    gemm_core(H + (size_t)m0 * D, D, W + (size_t)n0 * D, D, D, acc, sm, tid);
    EPI_SETUP
    const int oc = (n0 >> 1) + wc * 32 + c32;
#pragma unroll
    for (int i = 0; i < 2; ++i) {
        const int rb = m0 + wr * 64 + i * 32 + 4 * hl;
#pragma unroll
        for (int r = 0; r < 16; ++r) {
            const int row = rb + (r & 3) + 8 * (r >> 2);
            const float a = acc[i][0][r], b = acc[i][1][r];
            const float v = a * sigmoidf_(a) * b;
            ACT[(size_t)row * DFF + oc] = f2bf(v);
        }
    }
}

DEVI void job_resid(const P& p, const bf16_t* A, int lda, const bf16_t* Bt, int K, const float* gate_base, float coef, int t, bf16_t* sm, int tid) {
    const int nN = 8; const int m0 = (t / nN) * 128, n0 = (t % nN) * 128;
    float* X = (float*)(p.ws + WS_X);
    f32x16 acc[2][2]; zero_acc(acc);
    gemm_core(A + (size_t)m0 * lda, lda, Bt + (size_t)n0 * K, K, K, acc, sm, tid);
    EPI_SETUP
    const float* gate = gate_base + (size_t)mod_group(m0) * 9216;
#pragma unroll
    for (int j = 0; j < 2; ++j) {
        const int col = n0 + wc * 64 + j * 32 + c32;
        const float gv = coef * gate[col];
#pragma unroll
        for (int i = 0; i < 2; ++i) {
            const int rb = m0 + wr * 64 + i * 32 + 4 * hl;
#pragma unroll
            for (int r = 0; r < 16; ++r) {
                const int row = rb + (r & 3) + 8 * (r >> 2);
                float* xp = X + (size_t)row * D + col;
                *xp = ALPHA_F * (*xp) + gv * acc[i][j][r];
            }
        }
    }
}

DEVI void job_in(const P& p, int l, int t, bf16_t* sm, int tid) {
    const int nN = 46; const int m0 = (t / nN) * 128, n0 = (t % nN) * 128;
    const bf16_t* H = (const bf16_t*)(p.ws + WS_H);
    const bf16_t* W = (const bf16_t*)(p.ws + WS_W) + (size_t)l * LAYER_W + OFF_WIN;
    f32x16 acc[2][2]; zero_acc(acc);
    gemm_core(H + (size_t)m0 * D, D, W + (size_t)n0 * D, D, D, acc, sm, tid);
    EPI_SETUP
    const bool ctx = m0 < NCTX;
#pragma unroll
    for (int j = 0; j < 2; ++j) {
        const int col = n0 + wc * 64 + j * 32 + c32;
#pragma unroll
        for (int i = 0; i < 2; ++i) {
            const int rb = m0 + wr * 64 + i * 32 + 4 * hl;
            if (n0 < 512) {
                bf16_t* O = (bf16_t*)(p.ws + WS_UF);
#pragma unroll
                for (int r = 0; r < 16; ++r) O[(size_t)(rb + (r & 3) + 8 * (r >> 2)) * 512 + col] = f2bf(acc[i][j][r]);
            } else if (n0 < 896) {
                bf16_t* O = (bf16_t*)(p.ws + WS_UQ);
#pragma unroll
                for (int r = 0; r < 16; ++r) O[(size_t)(rb + (r & 3) + 8 * (r >> 2)) * 384 + (col - 512)] = f2bf(acc[i][j][r]);
            } else if (n0 < 1152) {
                float* O = (float*)(p.ws + WS_UKV);
#pragma unroll
                for (int r = 0; r < 16; ++r) O[(size_t)(rb + (r & 3) + 8 * (r >> 2)) * 256 + (col - 896)] = acc[i][j][r];
            } else if (n0 < 1280) {
                if (col < 1184) {
                    float* O = (float*)(p.ws + WS_KRF);
#pragma unroll
                    for (int r = 0; r < 16; ++r) O[(size_t)(rb + (r & 3) + 8 * (r >> 2)) * 32 + (col - 1152)] = acc[i][j][r];
                }
            } else if (n0 < 1792) {
                bf16_t* O = (bf16_t*)(p.ws + WS_NAQ);
#pragma unroll
                for (int r = 0; r < 16; ++r) O[(size_t)(rb + (r & 3) + 8 * (r >> 2)) * 512 + (col - 1280)] = f2bf(acc[i][j][r] * NA_QS);
            } else if (n0 < 2304) {
                bf16_t* O = (bf16_t*)(p.ws + WS_NAK);
                const int cc = col - 1792;
#pragma unroll
                for (int r = 0; r < 16; ++r) {
                    const int row = rb + (r & 3) + 8 * (r >> 2);
                    O[(size_t)row * 512 + cc] = f2bf(acc[i][j][r]);
                    if (ctx) p.out[OUT_NAK + ((size_t)((row >> 8) * 4 + l) * 256 + (row & 255)) * 512 + cc] = acc[i][j][r];
                }
            } else if (n0 < 2816) {
                bf16_t* VT = (bf16_t*)(p.ws + WS_NAVT);
                const int cc = col - 2304, h = cc >> 6, d = cc & 63;
#pragma unroll
                for (int qd = 0; qd < 4; ++qd) {
                    const int row = rb + 8 * qd;
                    u32x2 pk; pk.x = pk2(acc[i][j][4 * qd], acc[i][j][4 * qd + 1]); pk.y = pk2(acc[i][j][4 * qd + 2], acc[i][j][4 * qd + 3]);
                    if (ctx) {
                        const int b = row >> 8, s = row & 255;
                        *(u32x2*)(VT + ((size_t)((b * 8 + h) * 64 + d)) * 256 + s) = pk;
#pragma unroll
                        for (int e = 0; e < 4; ++e)
                            p.out[OUT_NAV + ((size_t)(b * 4 + l) * 256 + (s + e)) * 512 + cc] = acc[i][j][4 * qd + e];
                    } else {
                        const int rr = row - NCTX, b = rr >> 11, n = rr & 2047;
                        *(u32x2*)(VT + (size_t)4194304 + ((size_t)((b * 8 + h) * 64 + d)) * 2048 + n) = pk;
                    }
                }
            } else {
                bf16_t* O = (bf16_t*)(p.ws + WS_GATE);
                const int gc = col - 2816;
                const float bg = p.in[26][l * 3072 + gc];
                bf16_t* gp = O + (size_t)gc * M + rb;
#pragma unroll
                for (int qd = 0; qd < 4; ++qd) {
                    u32x2 pk;
                    pk.x = pk2(sigmoidf_(acc[i][j][4 * qd] + bg), sigmoidf_(acc[i][j][4 * qd + 1] + bg));
                    pk.y = pk2(sigmoidf_(acc[i][j][4 * qd + 2] + bg), sigmoidf_(acc[i][j][4 * qd + 3] + bg));
                    *(u32x2*)(gp + 8 * qd) = pk;
                }
            }
        }
    }
}

DEVI void job_uq(const P& p, int l, int t, bf16_t* sm, int tid) {
    const int nN = 6; const int m0 = (t / nN) * 128, n0 = (t % nN) * 128;
    const bf16_t* A = (const bf16_t*)(p.ws + WS_UQ);
    const bf16_t* W = (const bf16_t*)(p.ws + WS_W) + (size_t)l * LAYER_W + OFF_WUQ;
    bf16_t* Q = (bf16_t*)(p.ws + WS_Q);
    const float* ropec = (const float*)(p.ws + WS_ROPE);
    const float* ropes = ropec + 512;
    f32x16 acc[2][2]; zero_acc(acc);
    gemm_core(A + (size_t)m0 * 384, 384, W + (size_t)n0 * 384, 384, 384, acc, sm, tid);
    EPI_SETUP
    const bool lat = m0 >= NCTX;
#pragma unroll
    for (int j = 0; j < 2; ++j) {
        const int c0 = n0 + wc * 64 + j * 32;
        const int col = c0 + c32;
        const bool rope = lat && (((c0 >> 5) % 3) == 2);
        const int axis = c32 >> 4, ii = c32 & 15;
#pragma unroll
        for (int i = 0; i < 2; ++i) {
            const int rb = m0 + wr * 64 + i * 32 + 4 * hl;
#pragma unroll
            for (int r = 0; r < 16; ++r) {
                const int row = rb + (r & 3) + 8 * (r >> 2);
                float v = acc[i][j][r];
                const float pr = __shfl_xor(v, 8);
                if (rope) {
                    const int n = (row - NCTX) & 2047;
                    const int pos = axis ? (n & 63) : (n >> 6);
                    const float cs = ropec[pos * 8 + (ii & 7)], sn = ropes[pos * 8 + (ii & 7)];
                    const float rot = (ii < 8) ? -pr : pr;
                    v = v * cs + rot * sn;
                }
                Q[(size_t)row * 768 + col] = f2bf(v * MLA_QS);
            }
        }
    }
}

DEVI void job_ukv(const P& p, int l, int t, bf16_t* sm, int tid) {
    const int nN = 8; const int m0 = (t / nN) * 128, h = t % nN, n0 = h * 128;
    const bf16_t* A = (m0 < M) ? (const bf16_t*)(p.ws + WS_CKV) + (size_t)m0 * 256
                               : (const bf16_t*)(p.ws + WS_CCKV) + ((size_t)l * 1024 + (m0 - M)) * 256;
    const bf16_t* W = (const bf16_t*)(p.ws + WS_W) + (size_t)l * LAYER_W + OFF_WUKV;
    bf16_t* KN = (bf16_t*)(p.ws + WS_KN);
    bf16_t* VT = (bf16_t*)(p.ws + WS_VTM);
    f32x16 acc[2][2]; zero_acc(acc);
    gemm_core(A, 256, W + (size_t)n0 * 256, 256, 256, acc, sm, tid);
    EPI_SETUP
#pragma unroll
    for (int j = 0; j < 2; ++j) {
        const int d = j * 32 + c32;
#pragma unroll
        for (int i = 0; i < 2; ++i) {
            const int rb = m0 + wr * 64 + i * 32 + 4 * hl;
            if (wc == 0) {
#pragma unroll
                for (int r = 0; r < 16; ++r) KN[(size_t)(rb + (r & 3) + 8 * (r >> 2)) * 512 + h * 64 + d] = f2bf(acc[i][j][r]);
            } else {
#pragma unroll
                for (int qd = 0; qd < 4; ++qd) {
                    const int row = rb + 8 * qd;
                    u32x2 pk; pk.x = pk2(acc[i][j][4 * qd], acc[i][j][4 * qd + 1]); pk.y = pk2(acc[i][j][4 * qd + 2], acc[i][j][4 * qd + 3]);
                    size_t addr;
                    if (m0 < NCTX) { const int b = row >> 8, s = row & 255; addr = ((size_t)((b * 8 + h) * 64 + d)) * 256 + s; }
                    else if (m0 < M) { const int rr = row - NCTX, b = rr >> 11, n = rr & 2047; addr = (size_t)4194304 + ((size_t)((b * 8 + h) * 64 + d)) * 2560 + n; }
                    else { const int rr = row - M, b = rr >> 9, n = rr & 511; addr = (size_t)4194304 + ((size_t)((b * 8 + h) * 64 + d)) * 2560 + 2048 + n; }
                    *(u32x2*)(VT + addr) = pk;
                }
            }
        }
    }
}

template <int ldo>
DEVI void job_store(const bf16_t* A, int lda, const bf16_t* Bt, int ldb, int K, bf16_t* Out, bf16_t* sm, int tid) {
    f32x16 acc[2][2]; zero_acc(acc);
    gemm_core(A, lda, Bt, ldb, K, acc, sm, tid);
    EPI_SETUP
    bf16_t* st = sm + (wr * 64 + 4 * hl) * 136 + wc * 64 + c32;
#pragma unroll
    for (int i = 0; i < 2; ++i)
#pragma unroll
        for (int j = 0; j < 2; ++j)
#pragma unroll
            for (int r = 0; r < 16; ++r) st[(i * 32 + (r & 3) + 8 * (r >> 2)) * 136 + j * 32] = f2bf(acc[i][j][r]);
    __syncthreads();
    const int orow = tid >> 4, oc = (tid & 15) * 8;
#pragma unroll
    for (int k = 0; k < 8; ++k) {
        const u32x4 v = *(const u32x4*)(sm + (orow + 16 * k) * 136 + oc);
        *(u32x4*)(Out + (size_t)(orow + 16 * k) * ldo + oc) = v;
    }
    __syncthreads();
}

DEVI void job_f1(const P& p, int t, bf16_t* sm, int tid) {
    const bf16_t* WCS = (const bf16_t*)(p.ws + WS_WCS);
    const bf16_t* UF = (const bf16_t*)(p.ws + WS_UF);
    bf16_t* F1T = (bf16_t*)(p.ws + WS_F1T);
    if (t < 512) {
        const int bs = t >> 4, g = (t >> 2) & 3, mi = (t >> 1) & 1, ni = t & 1;
        job_store<256>(WCS + mi * 128 * 128, 128, UF + ((size_t)bs * 256 + ni * 128) * 512 + g * 128, 512, 128,
                  F1T + ((size_t)(bs * 4 + g) * 256 + mi * 128) * 256 + ni * 128, sm, tid);
    } else {
        t -= 512;
        const int bs = t >> 7, g = (t >> 5) & 3, mi = (t >> 4) & 1, ni = t & 15;
        job_store<2048>(WCS + mi * 128 * 128, 128, UF + ((size_t)NCTX + bs * 2048 + ni * 128) * 512 + g * 128, 512, 128,
                  F1T + (size_t)8388608 + ((size_t)(bs * 4 + g) * 256 + mi * 128) * 2048 + ni * 128, sm, tid);
    }
}
DEVI void job_f2_lat(const P& p, int t, bf16_t* sm, int tid) {
    const int bs = t >> 6, mi = (t >> 2) & 15, ni = t & 3;
    const bf16_t* TAB = (const bf16_t*)(p.ws + WS_TABL);
    const bf16_t* F1T = (const bf16_t*)(p.ws + WS_F1T) + (size_t)8388608;
    bf16_t* YF = (bf16_t*)(p.ws + WS_YF);
    job_store<512>(TAB + (size_t)mi * 128 * 4096, 4096, F1T + (size_t)bs * 512 * 4096 + (size_t)ni * 128 * 4096, 4096, 4096,
              YF + ((size_t)NCTX + bs * 2048 + mi * 128) * 512 + ni * 128, sm, tid);
}
DEVI void job_f2_ctx(const P& p, int t, bf16_t* sm, int tid) {
    const int bs = t >> 3, mi = (t >> 2) & 1, ni = t & 3;
    const bf16_t* TAB = (const bf16_t*)(p.ws + WS_TABC);
    const bf16_t* F1T = (const bf16_t*)(p.ws + WS_F1T);
    bf16_t* YF = (bf16_t*)(p.ws + WS_YF);
    job_store<512>(TAB + (size_t)mi * 128 * 512, 512, F1T + (size_t)bs * 512 * 512 + (size_t)ni * 128 * 512, 512, 512,
              YF + ((size_t)bs * 256 + mi * 128) * 512 + ni * 128, sm, tid);
}

DEVI void job_merge(const P& p, int l, int t, bf16_t* sm, int tid) {
    const int nN = 8; const int m0 = (t / nN) * 128, n0 = (t % nN) * 128;
    const bf16_t* Wl = (const bf16_t*)(p.ws + WS_W) + (size_t)l * LAYER_W;
    const bf16_t* GATE = (const bf16_t*)(p.ws + WS_GATE);
    bf16_t* MG = (bf16_t*)(p.ws + WS_MERGED);
    EPI_SETUP
    f32x16 tot[2][2]; zero_acc(tot);
#pragma unroll 1
    for (int s = 0; s < 3; ++s) {
        const bf16_t* A = (const bf16_t*)(p.ws + (s == 0 ? WS_YF : (s == 1 ? WS_YM : WS_YN)));
        const bf16_t* W = Wl + (s == 0 ? OFF_WBF : (s == 1 ? OFF_WBM : OFF_WBN));
        f32x16 acc[2][2]; zero_acc(acc);
        gemm_core<false>(A + (size_t)m0 * 512, 512, W + (size_t)n0 * 512, 512, 512, acc, sm, tid);
#pragma unroll
        for (int j = 0; j < 2; ++j) {
            const int col = n0 + wc * 64 + j * 32 + c32;
#pragma unroll
            for (int i = 0; i < 2; ++i) {
                const int rb = m0 + wr * 64 + i * 32 + 4 * hl;
                const bf16_t* gp = GATE + (size_t)(s * 1024 + col) * M + rb;
#pragma unroll
                for (int qd = 0; qd < 4; ++qd) {
                    const u32x2 g = *(const u32x2*)(gp + 8 * qd);
                    tot[i][j][4 * qd + 0] += bf2f(g.x & 0xffffu) * acc[i][j][4 * qd + 0];
                    tot[i][j][4 * qd + 1] += bf2f(g.x >> 16) * acc[i][j][4 * qd + 1];
                    tot[i][j][4 * qd + 2] += bf2f(g.y & 0xffffu) * acc[i][j][4 * qd + 2];
                    tot[i][j][4 * qd + 3] += bf2f(g.y >> 16) * acc[i][j][4 * qd + 3];
                }
            }
        }
    }
#pragma unroll
    for (int j = 0; j < 2; ++j) {
        const int col = n0 + wc * 64 + j * 32 + c32;
#pragma unroll
        for (int i = 0; i < 2; ++i) {
            const int rb = m0 + wr * 64 + i * 32 + 4 * hl;
#pragma unroll
            for (int r = 0; r < 16; ++r) MG[(size_t)(rb + (r & 3) + 8 * (r >> 2)) * 1024 + col] = f2bf(tot[i][j][r]);
        }
    }
}

struct TileSrc { const bf16_t* k; const bf16_t* k2; const bf16_t* v; const bf16_t* vhi; };
DEVI int pi_row(int r) { return (r & 0x13) | ((r & 4) << 1) | ((r & 8) >> 1); }

template <int NKS>
DEVI void attn_load(const TileSrc& s, bf16x8 (&kf)[NKS], bf16x8 (&vf)[4]) {
#pragma unroll
    for (int ks = 0; ks < NKS; ++ks) kf[ks] = (ks < 4) ? *(const bf16x8*)(s.k + ks * 16) : *(const bf16x8*)(s.k2 + (ks - 4) * 16);
    vf[0] = *(const bf16x8*)(s.v);
    vf[1] = *(const bf16x8*)(s.v + 16);
    vf[2] = *(const bf16x8*)(s.vhi);
    vf[3] = *(const bf16x8*)(s.vhi + 16);
}

template <int NKS, class Src, class Mask>
DEVI void attn_wave(const bf16_t* qptr, int nt, Src src, Mask mask, bf16_t* optr, int lane) {
    bf16x8 q[NKS];
#pragma unroll
    for (int ks = 0; ks < NKS; ++ks) q[ks] = *(const bf16x8*)(qptr + ks * 16);
    f32x16 o0, o1;
#pragma unroll
    for (int r = 0; r < 16; ++r) { o0[r] = 0.f; o1[r] = 0.f; }
    float m = -1e30f, lsum = 0.f;
    bf16x8 kf[NKS], vf[4];
    { TileSrc s0 = src(0); attn_load<NKS>(s0, kf, vf); }
    for (int t = 0; t < nt; ++t) {
        bf16x8 kn[NKS], vn[4];
        { TileSrc s1 = src(t + 1 < nt ? t + 1 : t); attn_load<NKS>(s1, kn, vn); }
        f32x16 s;
#pragma unroll
        for (int r = 0; r < 16; ++r) s[r] = 0.f;
#pragma unroll
        for (int ks = 0; ks < NKS; ++ks) s = __builtin_amdgcn_mfma_f32_32x32x16_bf16(kf[ks], q[ks], s, 0, 0, 0);
        mask(t, s);
        float mx = s[0];
#pragma unroll
        for (int r = 1; r < 16; ++r) mx = fmaxf(mx, s[r]);
        mx = fmaxf(mx, __shfl_xor(mx, 32));
        const float mn = fmaxf(m, mx);
        const float alpha = fast_exp2(m - mn);
        m = mn;
        float rs = 0.f;
#pragma unroll
        for (int r = 0; r < 16; ++r) { s[r] = fast_exp2(s[r] - mn); rs += s[r]; }
        lsum = lsum * alpha + rs;
#pragma unroll
        for (int r = 0; r < 16; ++r) { o0[r] *= alpha; o1[r] *= alpha; }
        bf16x8 p0, p1;
        {
            u32x4 a, b;
            a.x = pk2(s[0], s[1]); a.y = pk2(s[2], s[3]); a.z = pk2(s[4], s[5]); a.w = pk2(s[6], s[7]);
            b.x = pk2(s[8], s[9]); b.y = pk2(s[10], s[11]); b.z = pk2(s[12], s[13]); b.w = pk2(s[14], s[15]);
            p0 = __builtin_bit_cast(bf16x8, a); p1 = __builtin_bit_cast(bf16x8, b);
        }
        o0 = __builtin_amdgcn_mfma_f32_32x32x16_bf16(vf[0], p0, o0, 0, 0, 0);
        o0 = __builtin_amdgcn_mfma_f32_32x32x16_bf16(vf[1], p1, o0, 0, 0, 0);
        o1 = __builtin_amdgcn_mfma_f32_32x32x16_bf16(vf[2], p0, o1, 0, 0, 0);
        o1 = __builtin_amdgcn_mfma_f32_32x32x16_bf16(vf[3], p1, o1, 0, 0, 0);
#pragma unroll
        for (int ks = 0; ks < NKS; ++ks) kf[ks] = kn[ks];
#pragma unroll
        for (int x = 0; x < 4; ++x) vf[x] = vn[x];
    }
    lsum += __shfl_xor(lsum, 32);
    const float inv = 1.f / lsum;
    const int hl = lane >> 5;
#pragma unroll
    for (int qd = 0; qd < 4; ++qd) {
        u32x2 a, b;
        a.x = pk2(o0[4 * qd] * inv, o0[4 * qd + 1] * inv); a.y = pk2(o0[4 * qd + 2] * inv, o0[4 * qd + 3] * inv);
        b.x = pk2(o1[4 * qd] * inv, o1[4 * qd + 1] * inv); b.y = pk2(o1[4 * qd + 2] * inv, o1[4 * qd + 3] * inv);
        *(u32x2*)(optr + 8 * qd + 4 * hl) = a;
        *(u32x2*)(optr + 32 + 8 * qd + 4 * hl) = b;
    }
}

struct NoMask { DEVI void operator()(int, f32x16&) const {} };

DEVI void attn_mla(const P& p, int l, bool lat, int b, int h, int qg, int lane) {
    const int hl = lane >> 5, c32 = lane & 31, pr = pi_row(c32);
    const bf16_t* Q = (const bf16_t*)(p.ws + WS_Q);
    const bf16_t* KN = (const bf16_t*)(p.ws + WS_KN);
    const bf16_t* KR = (const bf16_t*)(p.ws + WS_KR);
    const bf16_t* CKR = (const bf16_t*)(p.ws + WS_CKR) + (size_t)l * 1024 * 32;
    const bf16_t* VT = (const bf16_t*)(p.ws + WS_VTM);
    bf16_t* YM = (bf16_t*)(p.ws + WS_YM);
    if (!lat) {
        const int row0 = b * 256;
        const int qrow = row0 + qg * 32 + c32;
        const bf16_t* k0 = KN + (size_t)(row0 + pr) * 512 + h * 64 + hl * 8;
        const bf16_t* r0 = KR + (size_t)(row0 + pr) * 32 + hl * 8;
        const bf16_t* v0 = VT + ((size_t)((b * 8 + h) * 64 + c32)) * 256 + hl * 8;
        auto src = [=](int t) { TileSrc s; s.k = k0 + (size_t)t * 32 * 512; s.k2 = r0 + (size_t)t * 32 * 32; s.v = v0 + t * 32; s.vhi = s.v + 32 * 256; return s; };
        attn_wave<6>(Q + (size_t)qrow * 768 + h * 96 + hl * 8, 8, src, NoMask(), YM + (size_t)qrow * 512 + h * 64, lane);
    } else {
        const int row0 = NCTX + b * 2048;
        const int qrow = row0 + qg * 32 + c32;
        const bf16_t* k0 = KN + (size_t)(row0 + pr) * 512 + h * 64 + hl * 8;
        const bf16_t* r0 = KR + (size_t)(row0 + pr) * 32 + hl * 8;
        const bf16_t* k1 = KN + (size_t)(M + b * 512 + pr) * 512 + h * 64 + hl * 8;
        const bf16_t* r1 = CKR + (size_t)(b * 512 + pr) * 32 + hl * 8;
        const bf16_t* v0 = VT + (size_t)4194304 + ((size_t)((b * 8 + h) * 64 + c32)) * 2560 + hl * 8;
        auto src = [=](int t) {
            TileSrc s;
            if (t < 64) { s.k = k0 + (size_t)t * 32 * 512; s.k2 = r0 + (size_t)t * 32 * 32; }
            else { s.k = k1 + (size_t)(t - 64) * 32 * 512; s.k2 = r1 + (size_t)(t - 64) * 32 * 32; }
            s.v = v0 + t * 32; s.vhi = s.v + 32 * 2560; return s; };
        attn_wave<6>(Q + (size_t)qrow * 768 + h * 96 + hl * 8, 80, src, NoMask(), YM + (size_t)qrow * 512 + h * 64, lane);
    }
}

DEVI void attn_na_ctx(const P& p, int b, int h, int qg, int lane) {
    const int hl = lane >> 5, c32 = lane & 31, pr = pi_row(c32);
    const bf16_t* Qn = (const bf16_t*)(p.ws + WS_NAQ);
    const bf16_t* Kn = (const bf16_t*)(p.ws + WS_NAK);
    const bf16_t* VT = (const bf16_t*)(p.ws + WS_NAVT);
    bf16_t* YN = (bf16_t*)(p.ws + WS_YN);
    const int row0 = b * 256, qrow = row0 + qg * 32 + c32;
    const bf16_t* k0 = Kn + (size_t)(row0 + pr) * 512 + h * 64 + hl * 8;
    const bf16_t* v0 = VT + ((size_t)((b * 8 + h) * 64 + c32)) * 256 + hl * 8;
    auto src = [=](int t) { TileSrc s; s.k = k0 + (size_t)t * 32 * 512; s.k2 = s.k; s.v = v0 + t * 32; s.vhi = s.v + 32 * 256; return s; };
    attn_wave<4>(Qn + (size_t)qrow * 512 + h * 64 + hl * 8, 8, src, NoMask(), YN + (size_t)qrow * 512 + h * 64, lane);
}

struct NaMask {
    const float* rpb;
    int rs, rq, qc, hl;
    DEVI void operator()(int t, f32x16& s) const {
        if (t >= 16) return;
        const int kr = t >> 1, kh = t & 1;
        const int cs = min(max(qc - 8, 0), 48);
        const float* rp = rpb + (rs + kr - rq + 7) * 31;
#pragma unroll
        for (int r = 0; r < 16; ++r) {
            const int kk = (r & 3) + 4 * ((r >> 2) & 1) + 8 * hl + 16 * (r >> 3);
            const int kc = kh * 32 + kk;
            const bool ok = (kc >= cs) && (kc < cs + 16);
            const int dc = min(max(kc - qc + 15, 0), 30);
            const float bias = rp[dc] * LOG2E;
            s[r] = ok ? s[r] + bias : -1e30f;
        }
    }
};
DEVI void attn_na_lat(const P& p, int l, int b, int h, int rq, int qh, int lane) {
    const int hl = lane >> 5, c32 = lane & 31, pr = pi_row(c32);
    const bf16_t* Qn = (const bf16_t*)(p.ws + WS_NAQ);
    const bf16_t* Kn = (const bf16_t*)(p.ws + WS_NAK);
    const bf16_t* VT = (const bf16_t*)(p.ws + WS_NAVT) + (size_t)4194304;
    const bf16_t* CK = (const bf16_t*)(p.ws + WS_CNAK) + (size_t)l * 1024 * 512;
    const bf16_t* CV = (const bf16_t*)(p.ws + WS_CNAVT) + (size_t)l * 1024 * 512;
    bf16_t* YN = (bf16_t*)(p.ws + WS_YN);
    const int row0 = NCTX + b * 2048;
    const int qrow = row0 + rq * 64 + qh * 32 + c32;
    const int rs = min(max(rq - 4, 0), 24);
    const bf16_t* k0 = Kn + (size_t)(row0 + rs * 64 + pr) * 512 + h * 64 + hl * 8;
    const bf16_t* v0 = VT + ((size_t)((b * 8 + h) * 64 + c32)) * 2048 + rs * 64 + hl * 8;
    const bf16_t* k1 = CK + (size_t)(b * 512 + pr) * 512 + h * 64 + hl * 8;
    const bf16_t* v1 = CV + ((size_t)((b * 8 + h) * 64 + c32)) * 512 + hl * 8;
    auto src = [=](int t) {
        TileSrc s;
        if (t < 16) { s.k = k0 + (size_t)t * 32 * 512; s.v = v0 + t * 32; s.vhi = s.v + 32 * 2048; }
        else { s.k = k1 + (size_t)(t - 16) * 32 * 512; s.v = v1 + (t - 16) * 32; s.vhi = s.v + 32 * 512; }
        s.k2 = s.k; return s; };
    NaMask mk; mk.rpb = p.in[21] + (size_t)(l * 8 + h) * 15 * 31; mk.rs = rs; mk.rq = rq; mk.qc = qh * 32 + c32; mk.hl = hl;
    attn_wave<4>(Qn + (size_t)qrow * 512 + h * 64 + hl * 8, 32, src, mk, YN + (size_t)qrow * 512 + h * 64, lane);
}

DEVI void row_ln_mod(const float* src, float* xdst, bf16_t* hdst, const float* lng, const float* lnb, const float* shift, const float* scale, int lane) {
    f32x4 v[4];
#pragma unroll
    for (int j = 0; j < 4; ++j) v[j] = *(const f32x4*)(src + 4 * lane + 256 * j);
    if (lng) {
        float s = 0.f;
#pragma unroll
        for (int j = 0; j < 4; ++j) s += (v[j].x + v[j].y) + (v[j].z + v[j].w);
        const float mu = wave_sum(s) * (1.f / D);
        float q = 0.f;
#pragma unroll
        for (int j = 0; j < 4; ++j) { v[j] = v[j] - mu; q += (v[j].x * v[j].x + v[j].y * v[j].y) + (v[j].z * v[j].z + v[j].w * v[j].w); }
        const float rstd = rsqrtf(wave_sum(q) * (1.f / D) + 1e-5f);
#pragma unroll
        for (int j = 0; j < 4; ++j) {
            const f32x4 g = *(const f32x4*)(lng + 4 * lane + 256 * j), bb = *(const f32x4*)(lnb + 4 * lane + 256 * j);
            v[j] = v[j] * rstd * g + bb;
        }
    }
    if (xdst) {
#pragma unroll
        for (int j = 0; j < 4; ++j) *(f32x4*)(xdst + 4 * lane + 256 * j) = v[j];
    }
    if (hdst) {
        float s = 0.f;
#pragma unroll
        for (int j = 0; j < 4; ++j) s += (v[j].x + v[j].y) + (v[j].z + v[j].w);
        const float mu = wave_sum(s) * (1.f / D);
        float q = 0.f;
#pragma unroll
        for (int j = 0; j < 4; ++j) { v[j] = v[j] - mu; q += (v[j].x * v[j].x + v[j].y * v[j].y) + (v[j].z * v[j].z + v[j].w * v[j].w); }
        const float rstd = rsqrtf(wave_sum(q) * (1.f / D) + 1e-6f);
#pragma unroll
        for (int j = 0; j < 4; ++j) {
            const f32x4 sc = *(const f32x4*)(scale + 4 * lane + 256 * j), sh = *(const f32x4*)(shift + 4 * lane + 256 * j);
            const f32x4 o = v[j] * rstd * (sc + 1.f) + sh;
            u32x2 pk; pk.x = pk2(o.x, o.y); pk.y = pk2(o.z, o.w);
            *(u32x2*)(hdst + 4 * lane + 256 * j) = pk;
        }
    }
}

DEVI void phase_rows(const P& p, int l, int lnidx, int ml, int ms, bool final_, int gw, int ngw, int lane) {
    float* X = (float*)(p.ws + WS_X);
    bf16_t* H = (bf16_t*)(p.ws + WS_H);
    const float* MOD = (const float*)(p.ws + WS_MOD);
    for (int row = gw; row < M; row += ngw) {
        const float* src = (lnidx < 0) ? (row < NCTX ? p.in[0] + (size_t)row * D : p.in[1] + (size_t)(row - NCTX) * D) : X + (size_t)row * D;
        const float* lng = (lnidx < 0) ? nullptr : p.in[28] + (size_t)(l * 3 + lnidx) * D;
        const float* lnb = (lnidx < 0) ? nullptr : p.in[29] + (size_t)(l * 3 + lnidx) * D;
        if (final_) { row_ln_mod(src, p.out + (size_t)row * D, nullptr, lng, lnb, nullptr, nullptr, lane); continue; }
        const float* mb = MOD + ((size_t)ml * 3 + mod_group(row)) * 9216;
        row_ln_mod(src, X + (size_t)row * D, H + (size_t)row * D, lng, lnb, mb + ms * D, mb + (ms + 1) * D, lane);
    }
}

DEVI void phase_rowmix(const P& p, int l, int gw, int ngw, int lane) {
    bf16_t* UQ = (bf16_t*)(p.ws + WS_UQ);
    const float* UKV = (const float*)(p.ws + WS_UKV);
    const float* KRF = (const float*)(p.ws + WS_KRF);
    bf16_t* CKV = (bf16_t*)(p.ws + WS_CKV);
    bf16_t* KR = (bf16_t*)(p.ws + WS_KR);
    const float* ropec = (const float*)(p.ws + WS_ROPE);
    const float* ropes = ropec + 512;
    const float* gq = p.in[17] + l * 384;
    const float* gkv = p.in[19] + l * 256;
    for (int row = gw; row < M; row += ngw) {
        {
            unsigned* up = (unsigned*)(UQ + (size_t)row * 384) + lane;
            float x[6]; float ss = 0.f;
#pragma unroll
            for (int j = 0; j < 3; ++j) { const unsigned w = up[64 * j]; x[2 * j] = bf2f(w & 0xffffu); x[2 * j + 1] = bf2f(w >> 16); ss += x[2 * j] * x[2 * j] + x[2 * j + 1] * x[2 * j + 1]; }
            const float rs = rsqrtf(wave_sum(ss) * (1.f / 384.f) + 1e-6f);
#pragma unroll
            for (int j = 0; j < 3; ++j) { const int c = 2 * lane + 128 * j; up[64 * j] = pk2(x[2 * j] * rs * gq[c], x[2 * j + 1] * rs * gq[c + 1]); }
        }
        {
            const f32x4 v = *(const f32x4*)(UKV + (size_t)row * 256 + 4 * lane);
            const float ss = v.x * v.x + v.y * v.y + v.z * v.z + v.w * v.w;
            const float rs = rsqrtf(wave_sum(ss) * (1.f / 256.f) + 1e-6f);
            const f32x4 g = *(const f32x4*)(gkv + 4 * lane);
            const f32x4 o = v * rs * g;
            u32x2 pk; pk.x = pk2(o.x, o.y); pk.y = pk2(o.z, o.w);
            *(u32x2*)(CKV + (size_t)row * 256 + 4 * lane) = pk;
            if (row < NCTX) *(f32x4*)(p.out + OUT_CKV + ((size_t)((row >> 8) * 4 + l) * 256 + (row & 255)) * 256 + 4 * lane) = o;
        }
        {
            const float v = KRF[(size_t)row * 32 + (lane & 31)];
            const float pr = __shfl_xor(v, 8);
            float o = v;
            if (row >= NCTX) {
                const int c = lane & 31, axis = c >> 4, ii = c & 15, n = (row - NCTX) & 2047;
                const int pos = axis ? (n & 63) : (n >> 6);
                const float rot = (ii < 8) ? -pr : pr;
                o = v * ropec[pos * 8 + (ii & 7)] + rot * ropes[pos * 8 + (ii & 7)];
            }
            if (lane < 32) {
                KR[(size_t)row * 32 + lane] = f2bf(o);
                if (row < NCTX) p.out[OUT_KR + ((size_t)((row >> 8) * 4 + l) * 256 + (row & 255)) * 32 + lane] = v;
            }
        }
    }
}

DEVI void transpose_item(const float* __restrict__ src, int N, int c0, int k0, bf16_t* __restrict__ dst, int K, float* scr, int lane) {
#pragma unroll 8
    for (int i = 0; i < 32; ++i) { const int kk = 2 * i + (lane >> 5); scr[kk * 33 + (lane & 31)] = src[(size_t)(k0 + kk) * N + c0 + (lane & 31)]; }
    asm volatile("s_waitcnt lgkmcnt(0)" ::: "memory");
    const int c = lane & 7;
#pragma unroll
    for (int j = 0; j < 4; ++j) {
        const int n = (lane >> 3) + 8 * j; const float* s = scr + (8 * c) * 33 + n;
        u32x4 o; o.x = pk2(s[0], s[33]); o.y = pk2(s[2 * 33], s[3 * 33]); o.z = pk2(s[4 * 33], s[5 * 33]); o.w = pk2(s[6 * 33], s[7 * 33]);
        *(u32x4*)(dst + (size_t)n * K + k0 + 8 * c) = o;
    }
    asm volatile("s_waitcnt lgkmcnt(0)" ::: "memory");
}

DEVI void prep_weight_item(const P& p, int item, float* scr, int lane) {
    const int l = item / 12944; int r = item % 12944;
    bf16_t* Wl = (bf16_t*)(p.ws + WS_W) + (size_t)l * LAYER_W;
    if (r < 8448) {
        const int which = r / 4224; r %= 4224;
        if (r < 2816) {
            const int rb = r >> 4, kb = r & 15;
            const float* src = (which ? ((rb & 1) ? p.in[14] : p.in[13]) : ((rb & 1) ? p.in[11] : p.in[10])) + (size_t)l * D * DFF;
            transpose_item(src, DFF, (rb >> 1) * 32, kb * 64, Wl + (which ? OFF_W13_2 : OFF_W13_1) + (size_t)rb * 32 * D, D, scr, lane);
        } else {
            r -= 2816; const int rb = r / 44, kb = r % 44;
            const float* src = (which ? p.in[15] : p.in[12]) + (size_t)l * DFF * D;
            transpose_item(src, D, rb * 32, kb * 64, Wl + (which ? OFF_W2_2 : OFF_W2_1) + (size_t)rb * 32 * DFF, DFF, scr, lane);
        }
        return;
    }
    r -= 8448;
    if (r < 2944) {
        const int rb = r >> 4, kb = r & 15, R0 = rb * 32;
        const float* src; int N, c0;
        if (R0 < 1184) { src = p.in[16] + (size_t)l * D * 2720; N = 2720; c0 = R0; }
        else if (R0 < 1280) return;
        else if (R0 < 2816) { src = p.in[16] + (size_t)l * D * 2720; N = 2720; c0 = R0 - 96; }
        else { src = p.in[25] + (size_t)l * D * 3072; N = 3072; c0 = R0 - 2816; }
        transpose_item(src, N, c0, kb * 64, Wl + OFF_WIN + (size_t)R0 * D, D, scr, lane);
        return;
    }
    r -= 2944;
    if (r < 512) { const int rb = r >> 4, kb = r & 15; transpose_item(p.in[27] + (size_t)l * D * D, D, rb * 32, kb * 64, Wl + OFF_WOUT + (size_t)rb * 32 * D, D, scr, lane); return; }
    r -= 512;
    if (r < 768) { const int w = r >> 8; r &= 255; const int rb = r >> 3, kb = r & 7;
        transpose_item((w == 0 ? p.in[22] : (w == 1 ? p.in[23] : p.in[24])) + (size_t)l * 512 * D, D, rb * 32, kb * 64, Wl + (w == 0 ? OFF_WBF : (w == 1 ? OFF_WBM : OFF_WBN)) + (size_t)rb * 32 * 512, 512, scr, lane); return; }
    r -= 768;
    if (r < 144) { const int rb = r / 6, kb = r % 6; transpose_item(p.in[18] + (size_t)l * 384 * 768, 768, rb * 32, kb * 64, Wl + OFF_WUQ + (size_t)rb * 32 * 384, 384, scr, lane); return; }
    r -= 144;
    { const int rb = r >> 2, kb = r & 3; transpose_item(p.in[20] + (size_t)l * 256 * 1024, 1024, rb * 32, kb * 64, Wl + OFF_WUKV + (size_t)rb * 32 * 256, 256, scr, lane); }
}

DEVI void phase_prep(const P& p, unsigned char* smem, int tid) {
    const int lane = tid & 63, wave = tid >> 6;
    const int gw = blockIdx.x * 4 + wave, ngw = gridDim.x * 4;
    const size_t gt = (size_t)blockIdx.x * 256 + tid, ngt = (size_t)gridDim.x * 256;
    {
        float* sil = (float*)smem;
        const float* wada = p.in[8];
        float* MODP = (float*)(p.ws + WS_MODP);
        for (int item = blockIdx.x; item < 2304; item += gridDim.x) {
            const int l = item / 576, rem = item % 576, kc = rem / 36, cb = rem % 36;
            __syncthreads();
            if (tid < 192) {
                const int g = tid >> 6, k = kc * 64 + (tid & 63);
                const float cv = (g == 0) ? p.in[7][k] : p.in[6][(g - 1) * D + k];
                sil[tid] = cv * sigmoidf_(cv);
            }
            __syncthreads();
            const int col = cb * 256 + tid;
            const float* w = wada + ((size_t)l * D + kc * 64) * 9216 + col;
            float a0 = 0.f, a1 = 0.f, a2 = 0.f;
#pragma unroll 16
            for (int k = 0; k < 64; ++k) { const float wv = w[(size_t)k * 9216]; a0 += sil[k] * wv; a1 += sil[64 + k] * wv; a2 += sil[128 + k] * wv; }
            float* o = MODP + ((size_t)(l * 16 + kc) * 3) * 9216 + col;
            o[0] = a0; o[9216] = a1; o[2 * 9216] = a2;
        }
        __syncthreads();
    }
    {
        float* scr = (float*)smem + wave * (64 * 33);
        for (int item = gw; item < 4 * 12944; item += ngw) prep_weight_item(p, item, scr, lane);
    }
    {
        bf16_t* TABL = (bf16_t*)(p.ws + WS_TABL);
        for (size_t e = gt; e < (size_t)2048 * 4096; e += ngt) {
            const int k = (int)(e >> 12), kk = (int)(e & 4095), lidx = kk & 2047;
            const int idx = (k * lidx) & 2047;
            float sn, cs; sincospif((float)idx * (2.f / 2048.f), &sn, &cs);
            TABL[e] = f2bf((kk < 2048 ? cs : -sn) * 0.022097086912079608f);
        }
        bf16_t* TABC = (bf16_t*)(p.ws + WS_TABC);
        for (size_t e = gt; e < (size_t)256 * 512; e += ngt) {
            const int k = (int)(e >> 9), kk = (int)(e & 511), lidx = kk & 255;
            const int idx = (k * lidx) & 255;
            float sn, cs; sincospif((float)idx * (2.f / 256.f), &sn, &cs);
            TABC[e] = f2bf((kk < 256 ? cs : -sn) * 0.0625f);
        }
        bf16_t* WCS = (bf16_t*)(p.ws + WS_WCS);
        for (size_t e = gt; e < (size_t)256 * 128; e += ngt) {
            const int i = (int)(e >> 7), c = (int)(e & 127), m = i >> 1, cs_ = i & 1;
            const int idx = (m * c) & 127;
            float sn, cs; sincospif((float)idx * (2.f / 128.f), &sn, &cs);
            WCS[e] = f2bf((cs_ ? sn : cs) * 0.08838834764831845f);
        }
        float* ROPE = (float*)(p.ws + WS_ROPE);
        for (size_t e = gt; e < 512; e += ngt) {
            const int pos = (int)(e >> 3), i = (int)(e & 7);
            const float inv_freq = powf(10000.f, -(float)i / 8.f);
            const float ang = (float)pos * inv_freq;
            ROPE[e] = cosf(ang); ROPE[512 + e] = sinf(ang);
        }
    }
    {
        bf16_t* CCKV = (bf16_t*)(p.ws + WS_CCKV);
        for (size_t e = gt; e < (size_t)NL * 1024 * 256; e += ngt) {
            const int c = (int)(e & 255), i = (int)((e >> 8) & 511), b = (int)((e >> 17) & 1), l = (int)(e >> 18);
            CCKV[e] = f2bf(p.in[2][((size_t)(b * 4 + l) * 512 + i) * 256 + c]);
        }
        bf16_t* CKR = (bf16_t*)(p.ws + WS_CKR);
        for (size_t e = gt; e < (size_t)NL * 1024 * 32; e += ngt) {
            const int c = (int)(e & 31), i = (int)((e >> 5) & 511), b = (int)((e >> 14) & 1), l = (int)(e >> 15);
            CKR[e] = f2bf(p.in[3][((size_t)(b * 4 + l) * 512 + i) * 32 + c]);
        }
        bf16_t* CNAK = (bf16_t*)(p.ws + WS_CNAK);
        for (size_t e = gt; e < (size_t)NL * 1024 * 512; e += ngt) {
            const int c = (int)(e & 511), i = (int)((e >> 9) & 511), b = (int)((e >> 18) & 1), l = (int)(e >> 19);
            CNAK[e] = f2bf(p.in[4][((size_t)(b * 4 + l) * 512 + i) * 512 + c]);
        }
        bf16_t* CNAVT = (bf16_t*)(p.ws + WS_CNAVT);
        for (size_t e = gt; e < (size_t)NL * 1024 * 512; e += ngt) {
            const int key = (int)(e & 511), hd = (int)((e >> 9) & 511), b = (int)((e >> 18) & 1), l = (int)(e >> 19);
            CNAVT[e] = f2bf(p.in[5][((size_t)(b * 4 + l) * 512 + key) * 512 + hd]);
        }
    }
}

DEVI void phase_modreduce(const P& p, int tid) {
    const float* MODP = (const float*)(p.ws + WS_MODP);
    float* MOD = (float*)(p.ws + WS_MOD);
    for (int e = blockIdx.x * 256 + tid; e < NL * 3 * 9216; e += gridDim.x * 256) {
        const int l = e / (3 * 9216), rem = e % (3 * 9216);
        float a = p.in[9][l * 9216 + (rem % 9216)];
#pragma unroll
        for (int kc = 0; kc < 16; ++kc) a += MODP[((size_t)(l * 16 + kc) * 3) * 9216 + rem];
        MOD[e] = a;
    }
}

#define XB_TMO      128
#define XB_XCNT(j)  (256  + 64 * (j))
#define XB_XSUB(j)  (1280 + 64 * (j))
#define XB_XGEN(j)  (2304 + 64 * (j))
#define XB_TOP      3328
#define XB_TOPGEN   3392
#define XCD_BAR_WORDS 3456
#define XB_SPIN_CAP (1u << 20)
#define LAS __attribute__((address_space(3)))
DEVI unsigned xb_ld(unsigned* p)              { return __hip_atomic_load(p, __ATOMIC_RELAXED, __HIP_MEMORY_SCOPE_AGENT); }
DEVI unsigned xb_add(unsigned* p, unsigned v) { return __hip_atomic_fetch_add(p, v, __ATOMIC_RELAXED, __HIP_MEMORY_SCOPE_AGENT); }
DEVI unsigned xb_xcc_id() { return (unsigned)__builtin_amdgcn_s_getreg((3 << 11) | 20) & 0xFu; }
#define XB_SPIN(cond, bar) do { unsigned _sp = 0; while (cond) { __builtin_amdgcn_s_sleep(1); \
    if ((++_sp & 255u) == 0u) { if (xb_ld(&(bar)[XB_TMO])) break; if (_sp > XB_SPIN_CAP) { atomicAdd(&(bar)[XB_TMO], 1u); break; } } } } while (0)
struct XcdBarrier { unsigned* bar; unsigned x; volatile LAS unsigned* st; };
DEVI XcdBarrier xcd_barrier_post(unsigned* bar, volatile LAS unsigned* st) {
    XcdBarrier b; b.bar = bar; b.x = xb_xcc_id(); b.st = st;
    if (threadIdx.x == 0) (void)xb_add(&bar[XB_XCNT(b.x)], 1u);
    return b;
}
DEVI void xcd_barrier_complete(unsigned* bar, unsigned x, unsigned& nloc, unsigned& nx) {
    const unsigned G = gridDim.x * gridDim.y * gridDim.z;
    unsigned sum, cnt, mine, sp = 0u;
    for (;;) {
        sum = 0u; cnt = 0u; mine = 0u;
#pragma unroll
        for (unsigned j = 0; j < 16; ++j) { const unsigned c = xb_ld(&bar[XB_XCNT(j)]); sum += c; cnt += (c > 0u) ? 1u : 0u; mine = (j == x) ? c : mine; }
        if (sum == G) break;
        __builtin_amdgcn_s_sleep(1);
        if ((++sp & 255u) == 0u) { if (xb_ld(&bar[XB_TMO])) break; if (sp > XB_SPIN_CAP) { atomicAdd(&bar[XB_TMO], 1u); break; } }
    }
    nloc = mine > 0u ? mine : 1u; nx = cnt > 0u ? cnt : 1u;
}
DEVI void xcd_barrier(const XcdBarrier& b) {
    asm volatile("s_waitcnt vmcnt(0)" ::: "memory");
    __syncthreads();
    if (threadIdx.x == 0) {
        unsigned* bar = b.bar;
        __builtin_amdgcn_s_waitcnt(0);
        unsigned nloc = b.st[0], nx = b.st[1];
        if (nloc == 0u) { xcd_barrier_complete(bar, b.x, nloc, nx); b.st[0] = nloc; b.st[1] = nx; }
        const unsigned old = xb_add(&bar[XB_XSUB(b.x)], 1u);
        const unsigned gen = old / nloc;
        if (old + 1u == (gen + 1u) * nloc) {
            __builtin_amdgcn_fence(__ATOMIC_RELEASE, "agent");
            asm volatile("s_waitcnt vmcnt(0)" ::: "memory");
            const unsigned og = xb_add(&bar[XB_TOP], 1u);
            const unsigned tg = og / nx;
            if (og + 1u == (tg + 1u) * nx) xb_add(&bar[XB_TOPGEN], 1u);
            else XB_SPIN(xb_ld(&bar[XB_TOPGEN]) == tg, bar);
            __builtin_amdgcn_fence(__ATOMIC_ACQUIRE, "agent");
            xb_add(&bar[XB_XGEN(b.x)], 1u);
            asm volatile("s_waitcnt vmcnt(0)" ::: "memory");
        } else {
            XB_SPIN(xb_ld(&bar[XB_XGEN(b.x)]) == gen, bar);
            __builtin_amdgcn_fence(__ATOMIC_ACQUIRE, "agent");
            asm volatile("s_waitcnt vmcnt(0)" ::: "memory");
        }
    }
    __syncthreads();
}

DEVI void run_phase(const P& p, int ph, unsigned char* smem, int tid) {
    bf16_t* sm = (bf16_t*)smem;
    const int lane = tid & 63, wave = tid >> 6;
    const int gw = blockIdx.x * 4 + wave, ngw = gridDim.x * 4;
    const int nb = gridDim.x, bid = blockIdx.x;
    if (ph == 0) { phase_prep(p, smem, tid); return; }
    if (ph == 1) { phase_modreduce(p, tid); return; }
    if (ph == 2) { phase_rows(p, 0, -1, 0, 0, false, gw, ngw, lane); return; }
    const int l = (ph - 3) / 13, s = (ph - 3) % 13;
    const bf16_t* Wl = (const bf16_t*)(p.ws + WS_W) + (size_t)l * LAYER_W;
    const float* MODl = (const float*)(p.ws + WS_MOD) + (size_t)l * 3 * 9216;
    switch (s) {
    case 0: case 10:
        for (int t = bid; t < 96 * 44; t += nb) job_ffn_up(p, l, s == 10, t, sm, tid);
        break;
    case 1: case 11:
        for (int t = bid; t < 96 * 8; t += nb)
            job_resid(p, (const bf16_t*)(p.ws + WS_ACT), DFF, Wl + (s == 11 ? OFF_W2_2 : OFF_W2_1), DFF, MODl + (s == 11 ? 8 : 2) * D, 0.5f, t, sm, tid);
        break;
    case 2: phase_rows(p, l, 0, l, 3, false, gw, ngw, lane); break;
    case 3:
        for (int t = bid; t < 96 * 46; t += nb) job_in(p, l, t, sm, tid);
        break;
    case 4: phase_rowmix(p, l, gw, ngw, lane); break;
    case 5: {
        int t = bid;
        for (; t < 256; t += nb) {
            const int wi = t * 4 + wave;
            attn_na_lat(p, l, wi >> 9, (wi >> 6) & 7, (wi >> 1) & 31, wi & 1, lane);
        }
        for (; t < 256 + 832; t += nb) job_ukv(p, l, t - 256, sm, tid);
        for (; t < 256 + 832 + 576; t += nb) job_uq(p, l, t - 256 - 832, sm, tid);
        for (; t < 256 + 832 + 576 + 768; t += nb) job_f1(p, t - 256 - 832 - 576, sm, tid);
        for (; t < 256 + 832 + 576 + 768 + 512; t += nb) {
            const int wi = (t - 256 - 832 - 576 - 768) * 4 + wave;
            attn_na_ctx(p, wi >> 6, (wi >> 3) & 7, wi & 7, lane);
        }
    } break;
    case 6: {
        int t = bid;
        for (; t < 256; t += nb) {
            const int wi = t * 4 + wave;
            attn_mla(p, l, true, wi >> 9, (wi >> 6) & 7, wi & 63, lane);
        }
        for (; t < 256 + 128; t += nb) job_f2_lat(p, t - 256, sm, tid);
        for (; t < 256 + 128 + 256; t += nb) job_f2_ctx(p, t - 256 - 128, sm, tid);
        for (; t < 256 + 128 + 256 + 512; t += nb) {
            const int wi = (t - 256 - 128 - 256) * 4 + wave;
            attn_mla(p, l, false, wi >> 6, (wi >> 3) & 7, wi & 7, lane);
        }
    } break;
    case 7:
        for (int t = bid; t < 96 * 8; t += nb) job_merge(p, l, t, sm, tid);
        break;
    case 8:
        for (int t = bid; t < 96 * 8; t += nb)
            job_resid(p, (const bf16_t*)(p.ws + WS_MERGED), D, Wl + OFF_WOUT, D, MODl + 5 * D, 1.0f, t, sm, tid);
        break;
    case 9: phase_rows(p, l, 1, l, 6, false, gw, ngw, lane); break;
    case 12:
        if (l == NL - 1) phase_rows(p, l, 2, 0, 0, true, gw, ngw, lane);
        else phase_rows(p, l, 2, l + 1, 0, false, gw, ngw, lane);
        break;
    default: break;
    }
}

__global__ void __launch_bounds__(256, 2) mega_kernel(P p) {
    extern __shared__ __attribute__((aligned(16))) unsigned char smem[];
    __shared__ uint4 xb_words;
    cg::grid_group grid = cg::this_grid();
    const int tid = threadIdx.x;
    unsigned* bar = (unsigned*)(p.ws + WS_BAR);
    if (tid == 0) xb_words = make_uint4(0u, 0u, 0u, 0u);
    if (p.ph_lo == 0 && blockIdx.x == 0) for (int i = tid; i < XCD_BAR_WORDS; i += 256) bar[i] = 0u;
    __syncthreads();
    XcdBarrier xb; xb.bar = bar; xb.x = 0; xb.st = (volatile LAS unsigned*)&xb_words;
#pragma nounroll
    for (int ph = p.ph_lo; ph < p.ph_hi; ++ph) {
        int tid2 = tid; asm volatile("" : "+v"(tid2));
        run_phase(p, ph, smem, tid2);
        if (ph + 1 < p.ph_hi) {
            if (ph == p.ph_lo) { grid.sync(); xb = xcd_barrier_post(bar, (volatile LAS unsigned*)&xb_words); }
            else xcd_barrier(xb);
        }
    }
}

extern "C" void kernel_launch(void* const* d_in, const int* in_sizes, int n_in, void* d_out, int out_size, void* d_ws, size_t ws_size,
                              hipStream_t stream) {
    static int grid_blocks = 0;
    if (grid_blocks == 0) {
        if (n_in != 30 || ws_size < WS_END) { fprintf(stderr, "kernel_launch: n_in %d ws %zu need %zu\n", n_in, ws_size, (size_t)WS_END); grid_blocks = -1; return; }
        int dev = 0, cus = 0, per_cu = 0;
        hipGetDevice(&dev);
        hipDeviceGetAttribute(&cus, hipDeviceAttributeMultiprocessorCount, dev);
        hipFuncSetAttribute((const void*)mega_kernel, hipFuncAttributeMaxDynamicSharedMemorySize, SMEM_BYTES);
        hipOccupancyMaxActiveBlocksPerMultiprocessor(&per_cu, (const void*)mega_kernel, 256, SMEM_BYTES);
        if (per_cu < 1) per_cu = 1;
        if (per_cu > 2) per_cu = 2;
        grid_blocks = cus * per_cu;
    }
    if (grid_blocks < 0) return;
    P p{};
    for (int i = 0; i < 30; ++i) p.in[i] = (const float*)d_in[i];
    p.out = (float*)d_out; p.ws = (unsigned char*)d_ws; p.ph_lo = 0; p.ph_hi = NPHASE;
#ifndef MULTI_LAUNCH
#define MULTI_LAUNCH 0
#endif
#if MULTI_LAUNCH
    for (int ph = 0; ph < NPHASE; ++ph) {
        p.ph_lo = ph; p.ph_hi = ph + 1;
        hipLaunchKernelGGL(mega_kernel, dim3(grid_blocks), dim3(256), SMEM_BYTES, stream, p);
    }
#else
    void* args[] = {&p};
    hipError_t e = hipLaunchCooperativeKernel((const void*)mega_kernel, dim3(grid_blocks), dim3(256), args, SMEM_BYTES, stream);
    if (e != hipSuccess) fprintf(stderr, "cooperative launch failed: %s (grid %d)\n", hipGetErrorString(e), grid_blocks);
#endif
}
```

```cpp
#include <hip/hip_runtime.h>
#include <hip/hip_cooperative_groups.h>
#include <cstdint>
#include <cstdio>
namespace cg = cooperative_groups;

typedef unsigned short bf16_t;
typedef short bf16x8 __attribute__((ext_vector_type(8)));
typedef float f32x16 __attribute__((ext_vector_type(16)));
typedef float f32x4 __attribute__((ext_vector_type(4)));
typedef unsigned u32x4 __attribute__((ext_vector_type(4)));
typedef unsigned u32x2 __attribute__((ext_vector_type(2)));
#define DEVI __device__ __forceinline__

constexpr int D = 1024, NCTX = 8192, NLAT = 4096, M = 12288, MX = 13312, DFF = 2816, NL = 4;
constexpr float ALPHA_F = 1.6817928305074290f;
constexpr float LOG2E = 1.4426950408889634f;
constexpr float MLA_QS = 0.10206207261596575f * LOG2E;
constexpr float NA_QS = 0.125f * LOG2E;
constexpr size_t OUT_CKV = 12582912, OUT_KR = 20971520, OUT_NAK = 22020096, OUT_NAV = 38797312;

constexpr size_t al256(size_t x) { return (x + 255) & ~(size_t)255; }
constexpr size_t WS_BAR = 0;
constexpr size_t WS_X = 16384;
constexpr size_t WS_H = WS_X + (size_t)M * D * 4;
constexpr size_t WS_MOD = WS_H + (size_t)M * D * 2;
constexpr size_t WS_MODP = WS_MOD + al256((size_t)NL * 3 * 9216 * 4);
constexpr size_t WS_ROPE = WS_MODP + al256((size_t)NL * 16 * 3 * 9216 * 4);
constexpr size_t WS_TABC = WS_ROPE + 4096;
constexpr size_t WS_TABL = WS_TABC + (size_t)256 * 512 * 2;
constexpr size_t WS_WCS = WS_TABL + (size_t)2048 * 4096 * 2;
constexpr size_t WS_CCKV = WS_WCS + (size_t)256 * 128 * 2;
constexpr size_t WS_CKR = WS_CCKV + (size_t)NL * 1024 * 256 * 2;
constexpr size_t WS_CNAK = WS_CKR + (size_t)NL * 1024 * 32 * 2;
constexpr size_t WS_CNAVT = WS_CNAK + (size_t)NL * 1024 * 512 * 2;
constexpr size_t WS_W = WS_CNAVT + (size_t)NL * 1024 * 512 * 2;
constexpr size_t OFF_W13_1 = 0, OFF_W2_1 = 5767168, OFF_W13_2 = 8650752, OFF_W2_2 = 14417920, OFF_WIN = 17301504,
                 OFF_WOUT = 23330816, OFF_WBF = 24379392, OFF_WBM = 24903680, OFF_WBN = 25427968, OFF_WUQ = 25952256,
                 OFF_WUKV = 26247168, LAYER_W = 26509312;
constexpr size_t WS_R1 = WS_W + (size_t)NL * LAYER_W * 2;
constexpr size_t WS_ACT = WS_R1;
constexpr size_t WS_UF = WS_R1;
constexpr size_t WS_UQ = WS_UF + (size_t)M * 512 * 2;
constexpr size_t WS_UKV = WS_UQ + (size_t)M * 384 * 2;
constexpr size_t WS_KRF = WS_UKV + (size_t)M * 256 * 4;
constexpr size_t WS_CKV = WS_KRF + (size_t)M * 32 * 4;
constexpr size_t WS_KR = WS_CKV + (size_t)M * 256 * 2;
constexpr size_t WS_NAQ = WS_KR + (size_t)M * 32 * 2;
constexpr size_t WS_NAK = WS_NAQ + (size_t)M * 512 * 2;
constexpr size_t WS_NAVT = WS_NAK + (size_t)M * 512 * 2;
constexpr size_t WS_GATE = WS_NAVT + (size_t)M * 512 * 2;
constexpr size_t WS_Q = WS_GATE + (size_t)M * 3072 * 2;
constexpr size_t WS_KN = WS_Q + (size_t)M * 768 * 2;
constexpr size_t WS_VTM = WS_KN + (size_t)MX * 512 * 2;
constexpr size_t WS_F1T = WS_VTM + (size_t)MX * 512 * 2;
constexpr size_t WS_YF = WS_F1T + (size_t)M * 1024 * 2;
constexpr size_t WS_YM = WS_YF + (size_t)M * 512 * 2;
constexpr size_t WS_YN = WS_YM + (size_t)M * 512 * 2;
constexpr size_t WS_MERGED = WS_YN + (size_t)M * 512 * 2;
constexpr size_t WS_END = WS_MERGED + (size_t)M * 1024 * 2;
static_assert(WS_END - WS_R1 >= (size_t)M * DFF * 2, "ACT must fit in R1");

constexpr int NPHASE = 3 + 13 * NL;

struct P {
    const float* in[30];
    float* out;
    unsigned char* ws;
    int ph_lo, ph_hi;
};

typedef __bf16 bf16v2 __attribute__((ext_vector_type(2)));
typedef float f32x2 __attribute__((ext_vector_type(2)));
DEVI unsigned pk2(float lo, float hi) { f32x2 v = {lo, hi}; bf16v2 b = __builtin_convertvector(v, bf16v2); return __builtin_bit_cast(unsigned, b); }
DEVI bf16_t f2bf(float x) { return (bf16_t)(pk2(x, 0.f) & 0xffffu); }
DEVI float bf2f(unsigned v) { return __uint_as_float(v << 16); }
DEVI float wave_sum(float v) {
#pragma unroll
    for (int o = 1; o < 64; o <<= 1) v += __shfl_xor(v, o);
    return v;
}
DEVI float fast_exp2(float x) { return __builtin_amdgcn_exp2f(x); }
DEVI float sigmoidf_(float x) { return 1.f / (1.f + __expf(-x)); }

constexpr int LDT = 72;
constexpr int TILE_E = 128 * LDT;
constexpr int SMEM_BYTES = 4 * TILE_E * 2;
constexpr int NTHREADS = 512, NWAVES = 8, LDS_TOTAL = 2 * SMEM_BYTES;

DEVI void gemm_ldg(const bf16_t* ga, const bf16_t* gb, int lda, int ldb, u32x4 (&ra)[4], u32x4 (&rb)[4]) {
#pragma unroll
    for (int i = 0; i < 4; ++i) {
        ra[i] = *(const u32x4*)(ga + (size_t)(32 * i) * lda);
        rb[i] = *(const u32x4*)(gb + (size_t)(32 * i) * ldb);
    }
}
DEVI void gemm_sts(bf16_t* buf, int soff, const u32x4 (&ra)[4], const u32x4 (&rb)[4]) {
#pragma unroll
    for (int i = 0; i < 4; ++i) {
        *(u32x4*)(buf + soff + 32 * i * LDT) = ra[i];
        *(u32x4*)(buf + TILE_E + soff + 32 * i * LDT) = rb[i];
    }
}
DEVI void gemm_mma(const bf16_t* cur, int aoff, int boff, f32x16 (&acc)[2][2]) {
#pragma unroll
    for (int ks = 0; ks < 4; ++ks) {
        bf16x8 a0 = *(const bf16x8*)(cur + aoff + ks * 16);
        bf16x8 a1 = *(const bf16x8*)(cur + aoff + 32 * LDT + ks * 16);
        bf16x8 b0 = *(const bf16x8*)(cur + boff + ks * 16);
        bf16x8 b1 = *(const bf16x8*)(cur + boff + 32 * LDT + ks * 16);
        acc[0][0] = __builtin_amdgcn_mfma_f32_32x32x16_bf16(a0, b0, acc[0][0], 0, 0, 0);
        acc[0][1] = __builtin_amdgcn_mfma_f32_32x32x16_bf16(a0, b1, acc[0][1], 0, 0, 0);
        acc[1][0] = __builtin_amdgcn_mfma_f32_32x32x16_bf16(a1, b0, acc[1][0], 0, 0, 0);
        acc[1][1] = __builtin_amdgcn_mfma_f32_32x32x16_bf16(a1, b1, acc[1][1], 0, 0, 0);
    }
}

template <bool DEEP = true>
DEVI void gemm_core(const bf16_t* __restrict__ A, int lda, const bf16_t* __restrict__ B, int ldb, int K,
                    f32x16 (&acc)[2][2], bf16_t* smem, int tid) {
    const int lane = tid & 63, wave = tid >> 6, wr = wave >> 1, wc = wave & 1;
    const int lr = tid >> 3, lc = (tid & 7) * 8;
    const bf16_t* ga = A + (size_t)lr * lda + lc;
    const bf16_t* gb = B + (size_t)lr * ldb + lc;
    const int soff = lr * LDT + lc;
    const int nk = K >> 6;
    const int aoff = (wr * 64 + (lane & 31)) * LDT + (lane >> 5) * 8;
    const int boff = TILE_E + (wc * 64 + (lane & 31)) * LDT + (lane >> 5) * 8;
    bf16_t* buf0 = smem; bf16_t* buf1 = smem + 2 * TILE_E;
    if constexpr (DEEP) {
        u32x4 ra0[4], rb0[4], ra1[4], rb1[4];
        gemm_ldg(ga, gb, lda, ldb, ra0, rb0);
        gemm_ldg(ga + 64, gb + 64, lda, ldb, ra1, rb1);
        gemm_sts(buf0, soff, ra0, rb0);
        __syncthreads();
        for (int kt = 0; kt < nk; kt += 2) {
            if (kt + 2 < nk) gemm_ldg(ga + (size_t)(kt + 2) * 64, gb + (size_t)(kt + 2) * 64, lda, ldb, ra0, rb0);
            gemm_mma(buf0, aoff, boff, acc);
            gemm_sts(buf1, soff, ra1, rb1);
            __syncthreads();
            if (kt + 3 < nk) gemm_ldg(ga + (size_t)(kt + 3) * 64, gb + (size_t)(kt + 3) * 64, lda, ldb, ra1, rb1);
            gemm_mma(buf1, aoff, boff, acc);
            if (kt + 2 < nk) gemm_sts(buf0, soff, ra0, rb0);
            __syncthreads();
        }
    } else {
        u32x4 ra[4], rb[4];
        gemm_ldg(ga, gb, lda, ldb, ra, rb);
        gemm_sts(buf0, soff, ra, rb);
        __syncthreads();
        for (int kt = 0; kt < nk; ++kt) {
            bf16_t* cur = (kt & 1) ? buf1 : buf0;
            bf16_t* nxt = (kt & 1) ? buf0 : buf1;
            const bool more = (kt + 1 < nk);
            if (more) { ga += 64; gb += 64; gemm_ldg(ga, gb, lda, ldb, ra, rb); }
            gemm_mma(cur, aoff, boff, acc);
            if (more) gemm_sts(nxt, soff, ra, rb);
            __syncthreads();
        }
    }
}

DEVI void zero_acc(f32x16 (&acc)[2][2]) {
#pragma unroll
    for (int i = 0; i < 2; ++i)
#pragma unroll
        for (int j = 0; j < 2; ++j)
#pragma unroll
            for (int r = 0; r < 16; ++r) acc[i][j][r] = 0.f;
}

#define EPI_SETUP const int lane = tid & 63, wave = tid >> 6, wr = wave >> 1, wc = wave & 1, hl = lane >> 5, c32 = lane & 31; (void)wr; (void)wc; (void)hl; (void)c32;

DEVI int mod_group(int row) { return row < NCTX ? 0 : 1 + ((row - NCTX) >> 11); }

namespace pg8 {
#define PG8_LAS __attribute__((address_space(3)))
constexpr int BM = 256, BK = 64, HALF = 128, HTB = HALF * BK * 2, NXCD = 8, WGM = 8;
DEVI int lds_byte(int r, int c) { const int st = (r >> 4) * 2 + (c >> 5), rr = r & 15, cc = c & 31, ob = rr * 64 + cc * 2; return st * 1024 + (ob ^ (((ob >> 9) & 1) << 5)); }
DEVI void stage_rc(int b, int& R, int& C) { const int st = b / 1024, sb = b % 1024, swz = sb ^ (((sb >> 9) & 1) << 5); R = (st >> 1) * 16 + swz / 64; C = (st & 1) * 32 + (swz % 64) / 2; }
DEVI int perm32(int rho) { const int n = rho >> 4, i = rho & 15; return 8 * (i >> 2) + 4 * n + (i & 3); }
struct Unit { int pm, pn; };
struct Gemm { const bf16_t* A; const bf16_t* Bt; int M, N, K; };
struct StaticOrder {
    int nM, nN, nwg, G, c;
    DEVI void init(int M, int N, int G_, int c_) { nM = M / BM; nN = N / BM; nwg = nM * nN; G = G_; c = c_; }
    DEVI bool next(int i, Unit& u) const {
        const long L = (long)i * G + c; if (L >= nwg) return false;
        int wgid = (int)L; { const int q = nwg / NXCD, r = nwg % NXCD, xcd = wgid % NXCD, off = wgid / NXCD; wgid = (xcd < r ? xcd * (q + 1) : r * (q + 1) + (xcd - r) * q) + off; }
        const int nig = WGM * nN, gid = wgid / nig, fm = gid * WGM, gsz = (nM - fm) < WGM ? (nM - fm) : WGM;
        u.pm = fm + ((wgid % nig) % gsz); u.pn = (wgid % nig) / gsz; return true;
    }
    DEVI void a_ready(const Unit&) const {}
    DEVI void done(const Unit&) const {}
};
template <class Epi, class Sched, bool ALIGN_EPI = false, bool SP2 = false>
DEVI void gemm_phase(PG8_LAS unsigned char* lds, const Gemm g, const Sched& S, const Epi& E, const int tid) {
    const int wid = __builtin_amdgcn_readfirstlane(tid >> 6), lane = tid & 63, wr = wid >> 2, wc = wid & 3, fr = lane & 15, fq = lane >> 4;
    const int K = g.K, nt = K / BK;
    unsigned voffA[2], voffB[2];
#pragma unroll
    for (int i = 0; i < 2; ++i) { int R, C; stage_rc(tid * 16 + i * 8192, R, C); const int Rb = Epi::PERM ? ((R & ~31) + perm32(R & 31)) : R;
        voffA[i] = (unsigned)(R * K + C) * 2u; voffB[i] = (unsigned)(Rb * K + C) * 2u; }
    const size_t kstep = (size_t)(BK * 2);
    const size_t hstep = (size_t)HALF * K * 2;
    const size_t tstep = 2 * hstep;
    const unsigned ldsw = (unsigned)wid * 1024u;
    const int aoff = lds_byte(wr * 64 + fr, fq * 8), boff = lds_byte(wc * 32 + fr, fq * 8);
#define PG8_SA(b, h) (((b) * 2 + (h)) * HTB)
#define PG8_SB(b, h) ((4 + (b) * 2 + (h)) * HTB)
#define PG8_STAGE(bufoff, gbase, voff) do { _Pragma("unroll") for (int _i = 0; _i < 2; ++_i) \
        __builtin_amdgcn_global_load_lds((const unsigned*)((const char*)(gbase) + (voff)[_i]), (PG8_LAS unsigned*)(lds + (bufoff) + ldsw + _i * 8192), 16, 0, 0); } while (0)
#define PG8_LDA(dst, b, h) do { _Pragma("unroll") for (int m = 0; m < 4; ++m) _Pragma("unroll") for (int k = 0; k < 2; ++k) dst[m][k] = *(const PG8_LAS bf16x8*)(lds + PG8_SA(b, h) + aoff + m * 2048 + k * 1024); } while (0)
#define PG8_LDB(dst, b, h) do { _Pragma("unroll") for (int n = 0; n < 2; ++n) _Pragma("unroll") for (int k = 0; k < 2; ++k) dst[n][k] = *(const PG8_LAS bf16x8*)(lds + PG8_SB(b, h) + boff + n * 2048 + k * 1024); } while (0)
#define PG8_MMA(ai, bj, At, Bt) do { __builtin_amdgcn_s_setprio(1); _Pragma("unroll") for (int m = 0; m < 4; ++m) _Pragma("unroll") for (int n = 0; n < 2; ++n) _Pragma("unroll") for (int k = 0; k < 2; ++k) \
        acc[ai][bj][m][n] = __builtin_amdgcn_mfma_f32_16x16x32_bf16(Bt[n][k], At[m][k], acc[ai][bj][m][n], 0, 0, 0); __builtin_amdgcn_s_setprio(0); } while (0)
#define PG8_WAIT_V(n) asm volatile("s_waitcnt vmcnt(" #n ")" ::: "memory")
#define PG8_WAIT_L(n) asm volatile("s_waitcnt lgkmcnt(" #n ")" ::: "memory")
#define PG8_BAR __builtin_amdgcn_s_barrier()
#define PG8_SCHED __builtin_amdgcn_sched_barrier(0)
    Unit cur, nxt; int ui = 0;
    if (!S.next(0, cur)) return;
    f32x4 acc[2][2][4][2];
#pragma unroll
    for (int a = 0; a < 2; ++a)
#pragma unroll
        for (int b = 0; b < 2; ++b)
#pragma unroll
            for (int m = 0; m < 4; ++m)
#pragma unroll
                for (int n = 0; n < 2; ++n) acc[a][b][m][n] = (f32x4){0.f, 0.f, 0.f, 0.f};
    bf16x8 At[4][2], B0[2][2], B1[2][2];
    const char* cA = (const char*)g.A + (size_t)cur.pm * tstep; const char* cB = (const char*)g.Bt + (size_t)cur.pn * tstep;
    S.a_ready(cur);
    if constexpr (SP2) {
        PG8_STAGE(PG8_SB(0, 0), cB, voffB); PG8_STAGE(PG8_SB(0, 1), cB + hstep, voffB); PG8_STAGE(PG8_SA(0, 0), cA, voffA); PG8_STAGE(PG8_SA(0, 1), cA + hstep, voffA);
        if (wr == 1) PG8_BAR;
        PG8_WAIT_V(2); PG8_BAR;
        PG8_STAGE(PG8_SB(1, 0), cB + kstep, voffB); PG8_STAGE(PG8_SA(1, 0), cA + kstep, voffA); PG8_STAGE(PG8_SB(1, 1), cB + hstep + kstep, voffB);
        PG8_WAIT_V(6); PG8_BAR;
    } else {
        PG8_STAGE(PG8_SB(0, 0), cB, voffB); PG8_STAGE(PG8_SA(0, 0), cA, voffA); PG8_STAGE(PG8_SB(0, 1), cB + hstep, voffB); PG8_STAGE(PG8_SA(0, 1), cA + hstep, voffA);
        if (wr == 1) PG8_BAR;
        PG8_WAIT_V(4); PG8_BAR;
        PG8_STAGE(PG8_SB(1, 0), cB + kstep, voffB); PG8_STAGE(PG8_SA(1, 0), cA + kstep, voffA); PG8_STAGE(PG8_SB(1, 1), cB + hstep + kstep, voffB);
        PG8_WAIT_V(6); PG8_BAR;
    }
    for (;;) {
        const bool has_next = S.next(ui + 1, nxt);
        const char* nA = has_next ? (const char*)g.A + (size_t)nxt.pm * tstep : cA; const char* nB = has_next ? (const char*)g.Bt + (size_t)nxt.pn * tstep : cB;
        for (int t = 0; t < nt; t += 2) {
            const bool last = (t == nt - 2);
            const char* a1 = cA + (size_t)(t + 1) * kstep;
            const char* a2 = last ? nA : cA + (size_t)(t + 2) * kstep; const char* b2 = last ? nB : cB + (size_t)(t + 2) * kstep;
            const char* a3 = a2 + kstep; const char* b3 = b2 + kstep;
            if (last && has_next) S.a_ready(nxt);
            if constexpr (SP2) {
            PG8_LDB(B0, 0, 0); PG8_LDB(B1, 0, 1); PG8_SCHED; PG8_LDA(At, 0, 0); PG8_STAGE(PG8_SA(1, 1), a1 + hstep, voffA);
            PG8_WAIT_V(8); PG8_WAIT_L(0); PG8_BAR; PG8_MMA(0, 0, At, B0); PG8_MMA(0, 1, At, B1); PG8_BAR; PG8_SCHED;
            PG8_LDA(At, 0, 1); PG8_STAGE(PG8_SB(0, 0), b2, voffB); PG8_STAGE(PG8_SB(0, 1), b2 + hstep, voffB); PG8_STAGE(PG8_SA(0, 0), a2, voffA);
            PG8_WAIT_V(8); PG8_WAIT_L(0); PG8_BAR; PG8_MMA(1, 0, At, B0); PG8_MMA(1, 1, At, B1); PG8_BAR; PG8_SCHED;
            PG8_LDB(B0, 1, 0); PG8_LDB(B1, 1, 1); PG8_SCHED; PG8_LDA(At, 1, 0); PG8_STAGE(PG8_SA(0, 1), a2 + hstep, voffA);
            PG8_WAIT_V(8); PG8_WAIT_L(0); PG8_BAR; PG8_MMA(0, 0, At, B0); PG8_MMA(0, 1, At, B1); PG8_BAR; PG8_SCHED;
            PG8_LDA(At, 1, 1); PG8_STAGE(PG8_SB(1, 0), b3, voffB); PG8_STAGE(PG8_SB(1, 1), b3 + hstep, voffB); PG8_STAGE(PG8_SA(1, 0), a3, voffA);
            PG8_WAIT_V(8); PG8_WAIT_L(0); PG8_BAR; PG8_MMA(1, 0, At, B0); PG8_MMA(1, 1, At, B1); PG8_BAR; PG8_SCHED;
            } else {
            PG8_LDB(B0, 0, 0); PG8_SCHED; PG8_LDA(At, 0, 0); PG8_STAGE(PG8_SA(1, 1), a1 + hstep, voffA);
            PG8_WAIT_L(8); PG8_BAR; PG8_WAIT_L(0); PG8_MMA(0, 0, At, B0); PG8_BAR; PG8_SCHED;
            PG8_LDB(B1, 0, 1); PG8_STAGE(PG8_SB(0, 0), b2, voffB);
            PG8_BAR; PG8_WAIT_L(0); PG8_MMA(0, 1, At, B1); PG8_BAR;
            PG8_LDA(At, 0, 1); PG8_STAGE(PG8_SA(0, 0), a2, voffA);
            PG8_BAR; PG8_WAIT_L(0); PG8_MMA(1, 0, At, B0); PG8_BAR; PG8_SCHED;
            PG8_STAGE(PG8_SB(0, 1), b2 + hstep, voffB);
            PG8_WAIT_V(6); PG8_BAR; PG8_MMA(1, 1, At, B1); PG8_BAR;
            PG8_LDB(B0, 1, 0); PG8_SCHED; PG8_LDA(At, 1, 0); PG8_STAGE(PG8_SA(0, 1), a2 + hstep, voffA);
            PG8_WAIT_L(8); PG8_BAR; PG8_WAIT_L(0); PG8_MMA(0, 0, At, B0); PG8_BAR; PG8_SCHED;
            PG8_LDB(B1, 1, 1); PG8_STAGE(PG8_SB(1, 0), b3, voffB);
            PG8_BAR; PG8_WAIT_L(0); PG8_MMA(0, 1, At, B1); PG8_BAR;
            PG8_LDA(At, 1, 1); PG8_STAGE(PG8_SA(1, 0), a3, voffA);
            PG8_BAR; PG8_WAIT_L(0); PG8_MMA(1, 0, At, B0); PG8_BAR; PG8_SCHED;
            PG8_STAGE(PG8_SB(1, 1), b3 + hstep, voffB);
            PG8_WAIT_V(6); PG8_BAR; PG8_MMA(1, 1, At, B1); PG8_BAR;
            }
        }
        if constexpr (ALIGN_EPI) { if (wr == 0) PG8_BAR; }
        E(acc, cur, wr, wc, fr, fq); S.done(cur);
        if (!has_next) break;
#pragma unroll
        for (int a = 0; a < 2; ++a)
#pragma unroll
            for (int b = 0; b < 2; ++b)
#pragma unroll
                for (int m = 0; m < 4; ++m)
#pragma unroll
                    for (int n = 0; n < 2; ++n) acc[a][b][m][n] = (f32x4){0.f, 0.f, 0.f, 0.f};
        cur = nxt; cA = nA; cB = nB; ++ui;
        if constexpr (ALIGN_EPI) { if (wr == 1) PG8_BAR; }
    }
    PG8_WAIT_V(0);
    if constexpr (!ALIGN_EPI) { if (wr == 0) PG8_BAR; }
    PG8_BAR;
#undef PG8_SA
#undef PG8_SB
#undef PG8_STAGE
#undef PG8_LDA
#undef PG8_LDB
#undef PG8_MMA
#undef PG8_WAIT_V
#undef PG8_WAIT_L
#undef PG8_BAR
#undef PG8_SCHED
}

struct EpiSwiGLU {
    static constexpr bool PERM = false;
    bf16_t* ACT;
    DEVI void operator()(const f32x4 (&acc)[2][2][4][2], const Unit& u, int wr, int wc, int fr, int fq) const {
#pragma unroll
        for (int ai = 0; ai < 2; ++ai)
#pragma unroll
            for (int m = 0; m < 4; ++m) {
                const int row = u.pm * BM + ai * HALF + wr * 64 + m * 16 + fr;
                bf16_t* rp = ACT + (size_t)row * DFF + 16 * (8 * u.pn + wc) + 4 * fq;
#pragma unroll
                for (int bj = 0; bj < 2; ++bj) {
                    const f32x4 a = acc[ai][bj][m][0], b = acc[ai][bj][m][1];
                    u32x2 pk;
                    pk.x = pk2(a[0] * sigmoidf_(a[0]) * b[0], a[1] * sigmoidf_(a[1]) * b[1]);
                    pk.y = pk2(a[2] * sigmoidf_(a[2]) * b[2], a[3] * sigmoidf_(a[3]) * b[3]);
                    *(u32x2*)(rp + 64 * bj) = pk;
                }
            }
    }
};
struct EpiResid {
    static constexpr bool PERM = false;
    float* X; const float* gate_base; float coef;
    DEVI void operator()(const f32x4 (&acc)[2][2][4][2], const Unit& u, int wr, int wc, int fr, int fq) const {
        const float* gate = gate_base + (size_t)mod_group(u.pm * BM) * 9216;
        const int col0 = u.pn * BM + wc * 32 + 4 * fq;
        f32x4 gv[2][2];
#pragma unroll
        for (int bj = 0; bj < 2; ++bj)
#pragma unroll
            for (int n = 0; n < 2; ++n) gv[bj][n] = *(const f32x4*)(gate + col0 + bj * HALF + 16 * n) * coef;
#pragma unroll
        for (int ai = 0; ai < 2; ++ai)
#pragma unroll
            for (int m = 0; m < 4; ++m) {
                const int row = u.pm * BM + ai * HALF + wr * 64 + m * 16 + fr;
                float* rp = X + (size_t)row * D + col0;
#pragma unroll
                for (int bj = 0; bj < 2; ++bj)
#pragma unroll
                    for (int n = 0; n < 2; ++n) {
                        f32x4* xp = (f32x4*)(rp + bj * HALF + 16 * n);
                        *xp = (*xp) * ALPHA_F + gv[bj][n] * acc[ai][bj][m][n];
                    }
                __builtin_amdgcn_sched_barrier(0);
            }
    }
};
}

DEVI void job_ffn_up(const P& p, int l, int which, int t, bf16_t* sm, int tid) {
    const int nN = 44; const int m0 = (t / nN) * 128, n0 = (t % nN) * 128;
    const bf16_t* H = (const bf16_t*)(p.ws + WS_H);
    const bf16_t* W = (const bf16_t*)(p.ws + WS_W) + (size_t)l * LAYER_W + (which ? OFF_W13_2 : OFF_W13_1);
    bf16_t* ACT = (bf16_t*)(p.ws + WS_ACT);
    f32x16 acc[2][2]; zero_acc(acc);
    gemm_core(H + (size_t)m0 * D, D, W + (size_t)n0 * D, D, D, acc, sm, tid);
    EPI_SETUP
    const int oc = (n0 >> 1) + wc * 32 + c32;
#pragma unroll
    for (int i = 0; i < 2; ++i) {
        const int rb = m0 + wr * 64 + i * 32 + 4 * hl;
#pragma unroll
        for (int r = 0; r < 16; ++r) {
            const int row = rb + (r & 3) + 8 * (r >> 2);
            const float a = acc[i][0][r], b = acc[i][1][r];
            const float v = a * sigmoidf_(a) * b;
            ACT[(size_t)row * DFF + oc] = f2bf(v);
        }
    }
}

DEVI void job_resid(const P& p, const bf16_t* A, int lda, const bf16_t* Bt, int K, const float* gate_base, float coef, int t, bf16_t* sm, int tid) {
    const int nN = 8; const int m0 = (t / nN) * 128, n0 = (t % nN) * 128;
    float* X = (float*)(p.ws + WS_X);
    f32x16 acc[2][2]; zero_acc(acc);
    gemm_core(A + (size_t)m0 * lda, lda, Bt + (size_t)n0 * K, K, K, acc, sm, tid);
    EPI_SETUP
    const float* gate = gate_base + (size_t)mod_group(m0) * 9216;
#pragma unroll
    for (int j = 0; j < 2; ++j) {
        const int col = n0 + wc * 64 + j * 32 + c32;
        const float gv = coef * gate[col];
#pragma unroll
        for (int i = 0; i < 2; ++i) {
            const int rb = m0 + wr * 64 + i * 32 + 4 * hl;
#pragma unroll
            for (int r = 0; r < 16; ++r) {
                const int row = rb + (r & 3) + 8 * (r >> 2);
                float* xp = X + (size_t)row * D + col;
                *xp = ALPHA_F * (*xp) + gv * acc[i][j][r];
            }
        }
    }
}

DEVI void job_in(const P& p, int l, int t, bf16_t* sm, int tid) {
    const int nN = 46; const int m0 = (t / nN) * 128, n0 = (t % nN) * 128;
    const bf16_t* H = (const bf16_t*)(p.ws + WS_H);
    const bf16_t* W = (const bf16_t*)(p.ws + WS_W) + (size_t)l * LAYER_W + OFF_WIN;
    f32x16 acc[2][2]; zero_acc(acc);
    gemm_core(H + (size_t)m0 * D, D, W + (size_t)n0 * D, D, D, acc, sm, tid);
    EPI_SETUP
    const bool ctx = m0 < NCTX;
#pragma unroll
    for (int j = 0; j < 2; ++j) {
        const int col = n0 + wc * 64 + j * 32 + c32;
#pragma unroll
        for (int i = 0; i < 2; ++i) {
            const int rb = m0 + wr * 64 + i * 32 + 4 * hl;
            if (n0 < 512) {
                bf16_t* O = (bf16_t*)(p.ws + WS_UF);
#pragma unroll
                for (int r = 0; r < 16; ++r) O[(size_t)(rb + (r & 3) + 8 * (r >> 2)) * 512 + col] = f2bf(acc[i][j][r]);
            } else if (n0 < 896) {
                bf16_t* O = (bf16_t*)(p.ws + WS_UQ);
#pragma unroll
                for (int r = 0; r < 16; ++r) O[(size_t)(rb + (r & 3) + 8 * (r >> 2)) * 384 + (col - 512)] = f2bf(acc[i][j][r]);
            } else if (n0 < 1152) {
                float* O = (float*)(p.ws + WS_UKV);
#pragma unroll
                for (int r = 0; r < 16; ++r) O[(size_t)(rb + (r & 3) + 8 * (r >> 2)) * 256 + (col - 896)] = acc[i][j][r];
            } else if (n0 < 1280) {
                if (col < 1184) {
                    float* O = (float*)(p.ws + WS_KRF);
#pragma unroll
                    for (int r = 0; r < 16; ++r) O[(size_t)(rb + (r & 3) + 8 * (r >> 2)) * 32 + (col - 1152)] = acc[i][j][r];
                }
            } else if (n0 < 1792) {
                bf16_t* O = (bf16_t*)(p.ws + WS_NAQ);
#pragma unroll
                for (int r = 0; r < 16; ++r) O[(size_t)(rb + (r & 3) + 8 * (r >> 2)) * 512 + (col - 1280)] = f2bf(acc[i][j][r] * NA_QS);
            } else if (n0 < 2304) {
                bf16_t* O = (bf16_t*)(p.ws + WS_NAK);
                const int cc = col - 1792;
#pragma unroll
                for (int r = 0; r < 16; ++r) {
                    const int row = rb + (r & 3) + 8 * (r >> 2);
                    O[(size_t)row * 512 + cc] = f2bf(acc[i][j][r]);
                    if (ctx) p.out[OUT_NAK + ((size_t)((row >> 8) * 4 + l) * 256 + (row & 255)) * 512 + cc] = acc[i][j][r];
                }
            } else if (n0 < 2816) {
                bf16_t* VT = (bf16_t*)(p.ws + WS_NAVT);
                const int cc = col - 2304, h = cc >> 6, d = cc & 63;
#pragma unroll
                for (int qd = 0; qd < 4; ++qd) {
                    const int row = rb + 8 * qd;
                    u32x2 pk; pk.x = pk2(acc[i][j][4 * qd], acc[i][j][4 * qd + 1]); pk.y = pk2(acc[i][j][4 * qd + 2], acc[i][j][4 * qd + 3]);
                    if (ctx) {
                        const int b = row >> 8, s = row & 255;
                        *(u32x2*)(VT + ((size_t)((b * 8 + h) * 64 + d)) * 256 + s) = pk;
#pragma unroll
                        for (int e = 0; e < 4; ++e)
                            p.out[OUT_NAV + ((size_t)(b * 4 + l) * 256 + (s + e)) * 512 + cc] = acc[i][j][4 * qd + e];
                    } else {
                        const int rr = row - NCTX, b = rr >> 11, n = rr & 2047;
                        *(u32x2*)(VT + (size_t)4194304 + ((size_t)((b * 8 + h) * 64 + d)) * 2048 + n) = pk;
                    }
                }
            } else {
                bf16_t* O = (bf16_t*)(p.ws + WS_GATE);
                const int gc = col - 2816;
                const float bg = p.in[26][l * 3072 + gc];
                bf16_t* gp = O + (size_t)gc * M + rb;
#pragma unroll
                for (int qd = 0; qd < 4; ++qd) {
                    u32x2 pk;
                    pk.x = pk2(sigmoidf_(acc[i][j][4 * qd] + bg), sigmoidf_(acc[i][j][4 * qd + 1] + bg));
                    pk.y = pk2(sigmoidf_(acc[i][j][4 * qd + 2] + bg), sigmoidf_(acc[i][j][4 * qd + 3] + bg));
                    *(u32x2*)(gp + 8 * qd) = pk;
                }
            }
        }
    }
}

DEVI void job_uq(const P& p, int l, int t, bf16_t* sm, int tid) {
    const int nN = 6; const int m0 = (t / nN) * 128, n0 = (t % nN) * 128;
    const bf16_t* A = (const bf16_t*)(p.ws + WS_UQ);
    const bf16_t* W = (const bf16_t*)(p.ws + WS_W) + (size_t)l * LAYER_W + OFF_WUQ;
    bf16_t* Q = (bf16_t*)(p.ws + WS_Q);
    const float* ropec = (const float*)(p.ws + WS_ROPE);
    const float* ropes = ropec + 512;
    f32x16 acc[2][2]; zero_acc(acc);
    gemm_core(A + (size_t)m0 * 384, 384, W + (size_t)n0 * 384, 384, 384, acc, sm, tid);
    EPI_SETUP
    const bool lat = m0 >= NCTX;
#pragma unroll
    for (int j = 0; j < 2; ++j) {
        const int c0 = n0 + wc * 64 + j * 32;
        const int col = c0 + c32;
        const bool rope = lat && (((c0 >> 5) % 3) == 2);
        const int axis = c32 >> 4, ii = c32 & 15;
#pragma unroll
        for (int i = 0; i < 2; ++i) {
            const int rb = m0 + wr * 64 + i * 32 + 4 * hl;
#pragma unroll
            for (int r = 0; r < 16; ++r) {
                const int row = rb + (r & 3) + 8 * (r >> 2);
                float v = acc[i][j][r];
                const float pr = __shfl_xor(v, 8);
                if (rope) {
                    const int n = (row - NCTX) & 2047;
                    const int pos = axis ? (n & 63) : (n >> 6);
                    const float cs = ropec[pos * 8 + (ii & 7)], sn = ropes[pos * 8 + (ii & 7)];
                    const float rot = (ii < 8) ? -pr : pr;
                    v = v * cs + rot * sn;
                }
                Q[(size_t)row * 768 + col] = f2bf(v * MLA_QS);
            }
        }
    }
}

DEVI void job_ukv(const P& p, int l, int t, bf16_t* sm, int tid) {
    const int nN = 8; const int m0 = (t / nN) * 128, h = t % nN, n0 = h * 128;
    const bf16_t* A = (m0 < M) ? (const bf16_t*)(p.ws + WS_CKV) + (size_t)m0 * 256
                               : (const bf16_t*)(p.ws + WS_CCKV) + ((size_t)l * 1024 + (m0 - M)) * 256;
    const bf16_t* W = (const bf16_t*)(p.ws + WS_W) + (size_t)l * LAYER_W + OFF_WUKV;
    bf16_t* KN = (bf16_t*)(p.ws + WS_KN);
    bf16_t* VT = (bf16_t*)(p.ws + WS_VTM);
    f32x16 acc[2][2]; zero_acc(acc);
    gemm_core(A, 256, W + (size_t)n0 * 256, 256, 256, acc, sm, tid);
    EPI_SETUP
#pragma unroll
    for (int j = 0; j < 2; ++j) {
        const int d = j * 32 + c32;
#pragma unroll
        for (int i = 0; i < 2; ++i) {
            const int rb = m0 + wr * 64 + i * 32 + 4 * hl;
            if (wc == 0) {
#pragma unroll
                for (int r = 0; r < 16; ++r) KN[(size_t)(rb + (r & 3) + 8 * (r >> 2)) * 512 + h * 64 + d] = f2bf(acc[i][j][r]);
            } else {
#pragma unroll
                for (int qd = 0; qd < 4; ++qd) {
                    const int row = rb + 8 * qd;
                    u32x2 pk; pk.x = pk2(acc[i][j][4 * qd], acc[i][j][4 * qd + 1]); pk.y = pk2(acc[i][j][4 * qd + 2], acc[i][j][4 * qd + 3]);
                    size_t addr;
                    if (m0 < NCTX) { const int b = row >> 8, s = row & 255; addr = ((size_t)((b * 8 + h) * 64 + d)) * 256 + s; }
                    else if (m0 < M) { const int rr = row - NCTX, b = rr >> 11, n = rr & 2047; addr = (size_t)4194304 + ((size_t)((b * 8 + h) * 64 + d)) * 2560 + n; }
                    else { const int rr = row - M, b = rr >> 9, n = rr & 511; addr = (size_t)4194304 + ((size_t)((b * 8 + h) * 64 + d)) * 2560 + 2048 + n; }
                    *(u32x2*)(VT + addr) = pk;
                }
            }
        }
    }
}

template <int ldo>
DEVI void job_store(const bf16_t* A, int lda, const bf16_t* Bt, int ldb, int K, bf16_t* Out, bf16_t* sm, int tid) {
    f32x16 acc[2][2]; zero_acc(acc);
    gemm_core(A, lda, Bt, ldb, K, acc, sm, tid);
    EPI_SETUP
    bf16_t* st = sm + (wr * 64 + 4 * hl) * 136 + wc * 64 + c32;
#pragma unroll
    for (int i = 0; i < 2; ++i)
#pragma unroll
        for (int j = 0; j < 2; ++j)
#pragma unroll
            for (int r = 0; r < 16; ++r) st[(i * 32 + (r & 3) + 8 * (r >> 2)) * 136 + j * 32] = f2bf(acc[i][j][r]);
    __syncthreads();
    const int orow = tid >> 4, oc = (tid & 15) * 8;
#pragma unroll
    for (int k = 0; k < 8; ++k) {
        const u32x4 v = *(const u32x4*)(sm + (orow + 16 * k) * 136 + oc);
        *(u32x4*)(Out + (size_t)(orow + 16 * k) * ldo + oc) = v;
    }
    __syncthreads();
}

DEVI void job_f1(const P& p, int t, bf16_t* sm, int tid) {
    const bf16_t* WCS = (const bf16_t*)(p.ws + WS_WCS);
    const bf16_t* UF = (const bf16_t*)(p.ws + WS_UF);
    bf16_t* F1T = (bf16_t*)(p.ws + WS_F1T);
    if (t < 512) {
        const int bs = t >> 4, g = (t >> 2) & 3, mi = (t >> 1) & 1, ni = t & 1;
        job_store<256>(WCS + mi * 128 * 128, 128, UF + ((size_t)bs * 256 + ni * 128) * 512 + g * 128, 512, 128,
                  F1T + ((size_t)(bs * 4 + g) * 256 + mi * 128) * 256 + ni * 128, sm, tid);
    } else {
        t -= 512;
        const int bs = t >> 7, g = (t >> 5) & 3, mi = (t >> 4) & 1, ni = t & 15;
        job_store<2048>(WCS + mi * 128 * 128, 128, UF + ((size_t)NCTX + bs * 2048 + ni * 128) * 512 + g * 128, 512, 128,
                  F1T + (size_t)8388608 + ((size_t)(bs * 4 + g) * 256 + mi * 128) * 2048 + ni * 128, sm, tid);
    }
}
DEVI void job_f2_lat(const P& p, int t, bf16_t* sm, int tid) {
    const int bs = t >> 6, mi = (t >> 2) & 15, ni = t & 3;
    const bf16_t* TAB = (const bf16_t*)(p.ws + WS_TABL);
    const bf16_t* F1T = (const bf16_t*)(p.ws + WS_F1T) + (size_t)8388608;
    bf16_t* YF = (bf16_t*)(p.ws + WS_YF);
    job_store<512>(TAB + (size_t)mi * 128 * 4096, 4096, F1T + (size_t)bs * 512 * 4096 + (size_t)ni * 128 * 4096, 4096, 4096,
              YF + ((size_t)NCTX + bs * 2048 + mi * 128) * 512 + ni * 128, sm, tid);
}
DEVI void job_f2_ctx(const P& p, int t, bf16_t* sm, int tid) {
    const int bs = t >> 3, mi = (t >> 2) & 1, ni = t & 3;
    const bf16_t* TAB = (const bf16_t*)(p.ws + WS_TABC);
    const bf16_t* F1T = (const bf16_t*)(p.ws + WS_F1T);
    bf16_t* YF = (bf16_t*)(p.ws + WS_YF);
    job_store<512>(TAB + (size_t)mi * 128 * 512, 512, F1T + (size_t)bs * 512 * 512 + (size_t)ni * 128 * 512, 512, 512,
              YF + ((size_t)bs * 256 + mi * 128) * 512 + ni * 128, sm, tid);
}

DEVI void job_merge(const P& p, int l, int t, bf16_t* sm, int tid) {
    const int nN = 8; const int m0 = (t / nN) * 128, n0 = (t % nN) * 128;
    const bf16_t* Wl = (const bf16_t*)(p.ws + WS_W) + (size_t)l * LAYER_W;
    const bf16_t* GATE = (const bf16_t*)(p.ws + WS_GATE);
    bf16_t* MG = (bf16_t*)(p.ws + WS_MERGED);
    EPI_SETUP
    f32x16 tot[2][2]; zero_acc(tot);
#pragma unroll 1
    for (int s = 0; s < 3; ++s) {
        const bf16_t* A = (const bf16_t*)(p.ws + (s == 0 ? WS_YF : (s == 1 ? WS_YM : WS_YN)));
        const bf16_t* W = Wl + (s == 0 ? OFF_WBF : (s == 1 ? OFF_WBM : OFF_WBN));
        f32x16 acc[2][2]; zero_acc(acc);
        gemm_core<false>(A + (size_t)m0 * 512, 512, W + (size_t)n0 * 512, 512, 512, acc, sm, tid);
#pragma unroll
        for (int j = 0; j < 2; ++j) {
            const int col = n0 + wc * 64 + j * 32 + c32;
#pragma unroll
            for (int i = 0; i < 2; ++i) {
                const int rb = m0 + wr * 64 + i * 32 + 4 * hl;
                const bf16_t* gp = GATE + (size_t)(s * 1024 + col) * M + rb;
#pragma unroll
                for (int qd = 0; qd < 4; ++qd) {
                    const u32x2 g = *(const u32x2*)(gp + 8 * qd);
                    tot[i][j][4 * qd + 0] += bf2f(g.x & 0xffffu) * acc[i][j][4 * qd + 0];
                    tot[i][j][4 * qd + 1] += bf2f(g.x >> 16) * acc[i][j][4 * qd + 1];
                    tot[i][j][4 * qd + 2] += bf2f(g.y & 0xffffu) * acc[i][j][4 * qd + 2];
                    tot[i][j][4 * qd + 3] += bf2f(g.y >> 16) * acc[i][j][4 * qd + 3];
                }
            }
        }
    }
#pragma unroll
    for (int j = 0; j < 2; ++j) {
        const int col = n0 + wc * 64 + j * 32 + c32;
#pragma unroll
        for (int i = 0; i < 2; ++i) {
            const int rb = m0 + wr * 64 + i * 32 + 4 * hl;
#pragma unroll
            for (int r = 0; r < 16; ++r) MG[(size_t)(rb + (r & 3) + 8 * (r >> 2)) * 1024 + col] = f2bf(tot[i][j][r]);
        }
    }
}

struct TileSrc { const bf16_t* k; const bf16_t* k2; const bf16_t* v; const bf16_t* vhi; };
DEVI int pi_row(int r) { return (r & 0x13) | ((r & 4) << 1) | ((r & 8) >> 1); }

template <int NKS>
DEVI void attn_load(const TileSrc& s, bf16x8 (&kf)[NKS], bf16x8 (&vf)[4]) {
#pragma unroll
    for (int ks = 0; ks < NKS; ++ks) kf[ks] = (ks < 4) ? *(const bf16x8*)(s.k + ks * 16) : *(const bf16x8*)(s.k2 + (ks - 4) * 16);
    vf[0] = *(const bf16x8*)(s.v);
    vf[1] = *(const bf16x8*)(s.v + 16);
    vf[2] = *(const bf16x8*)(s.vhi);
    vf[3] = *(const bf16x8*)(s.vhi + 16);
}

template <int NKS, class Src, class Mask>
DEVI void attn_wave(const bf16_t* qptr, int nt, Src src, Mask mask, bf16_t* optr, int lane) {
    bf16x8 q[NKS];
#pragma unroll
    for (int ks = 0; ks < NKS; ++ks) q[ks] = *(const bf16x8*)(qptr + ks * 16);
    f32x16 o0, o1;
#pragma unroll
    for (int r = 0; r < 16; ++r) { o0[r] = 0.f; o1[r] = 0.f; }
    float m = -1e30f, lsum = 0.f;
    bf16x8 kf[NKS], vf[4];
    { TileSrc s0 = src(0); attn_load<NKS>(s0, kf, vf); }
    for (int t = 0; t < nt; ++t) {
        bf16x8 kn[NKS], vn[4];
        { TileSrc s1 = src(t + 1 < nt ? t + 1 : t); attn_load<NKS>(s1, kn, vn); }
        f32x16 s;
#pragma unroll
        for (int r = 0; r < 16; ++r) s[r] = 0.f;
#pragma unroll
        for (int ks = 0; ks < NKS; ++ks) s = __builtin_amdgcn_mfma_f32_32x32x16_bf16(kf[ks], q[ks], s, 0, 0, 0);
        mask(t, s);
        float mx = s[0];
#pragma unroll
        for (int r = 1; r < 16; ++r) mx = fmaxf(mx, s[r]);
        mx = fmaxf(mx, __shfl_xor(mx, 32));
        const float mn = fmaxf(m, mx);
        const float alpha = fast_exp2(m - mn);
        m = mn;
        float rs = 0.f;
#pragma unroll
        for (int r = 0; r < 16; ++r) { s[r] = fast_exp2(s[r] - mn); rs += s[r]; }
        lsum = lsum * alpha + rs;
#pragma unroll
        for (int r = 0; r < 16; ++r) { o0[r] *= alpha; o1[r] *= alpha; }
        bf16x8 p0, p1;
        {
            u32x4 a, b;
            a.x = pk2(s[0], s[1]); a.y = pk2(s[2], s[3]); a.z = pk2(s[4], s[5]); a.w = pk2(s[6], s[7]);
            b.x = pk2(s[8], s[9]); b.y = pk2(s[10], s[11]); b.z = pk2(s[12], s[13]); b.w = pk2(s[14], s[15]);
            p0 = __builtin_bit_cast(bf16x8, a); p1 = __builtin_bit_cast(bf16x8, b);
        }
        o0 = __builtin_amdgcn_mfma_f32_32x32x16_bf16(vf[0], p0, o0, 0, 0, 0);
        o0 = __builtin_amdgcn_mfma_f32_32x32x16_bf16(vf[1], p1, o0, 0, 0, 0);
        o1 = __builtin_amdgcn_mfma_f32_32x32x16_bf16(vf[2], p0, o1, 0, 0, 0);
        o1 = __builtin_amdgcn_mfma_f32_32x32x16_bf16(vf[3], p1, o1, 0, 0, 0);
#pragma unroll
        for (int ks = 0; ks < NKS; ++ks) kf[ks] = kn[ks];
#pragma unroll
        for (int x = 0; x < 4; ++x) vf[x] = vn[x];
    }
    lsum += __shfl_xor(lsum, 32);
    const float inv = 1.f / lsum;
    const int hl = lane >> 5;
#pragma unroll
    for (int qd = 0; qd < 4; ++qd) {
        u32x2 a, b;
        a.x = pk2(o0[4 * qd] * inv, o0[4 * qd + 1] * inv); a.y = pk2(o0[4 * qd + 2] * inv, o0[4 * qd + 3] * inv);
        b.x = pk2(o1[4 * qd] * inv, o1[4 * qd + 1] * inv); b.y = pk2(o1[4 * qd + 2] * inv, o1[4 * qd + 3] * inv);
        *(u32x2*)(optr + 8 * qd + 4 * hl) = a;
        *(u32x2*)(optr + 32 + 8 * qd + 4 * hl) = b;
    }
}

struct NoMask { DEVI void operator()(int, f32x16&) const {} };

DEVI void attn_mla(const P& p, int l, bool lat, int b, int h, int qg, int lane) {
    const int hl = lane >> 5, c32 = lane & 31, pr = pi_row(c32);
    const bf16_t* Q = (const bf16_t*)(p.ws + WS_Q);
    const bf16_t* KN = (const bf16_t*)(p.ws + WS_KN);
    const bf16_t* KR = (const bf16_t*)(p.ws + WS_KR);
    const bf16_t* CKR = (const bf16_t*)(p.ws + WS_CKR) + (size_t)l * 1024 * 32;
    const bf16_t* VT = (const bf16_t*)(p.ws + WS_VTM);
    bf16_t* YM = (bf16_t*)(p.ws + WS_YM);
    if (!lat) {
        const int row0 = b * 256;
        const int qrow = row0 + qg * 32 + c32;
        const bf16_t* k0 = KN + (size_t)(row0 + pr) * 512 + h * 64 + hl * 8;
        const bf16_t* r0 = KR + (size_t)(row0 + pr) * 32 + hl * 8;
        const bf16_t* v0 = VT + ((size_t)((b * 8 + h) * 64 + c32)) * 256 + hl * 8;
        auto src = [=](int t) { TileSrc s; s.k = k0 + (size_t)t * 32 * 512; s.k2 = r0 + (size_t)t * 32 * 32; s.v = v0 + t * 32; s.vhi = s.v + 32 * 256; return s; };
        attn_wave<6>(Q + (size_t)qrow * 768 + h * 96 + hl * 8, 8, src, NoMask(), YM + (size_t)qrow * 512 + h * 64, lane);
    } else {
        const int row0 = NCTX + b * 2048;
        const int qrow = row0 + qg * 32 + c32;
        const bf16_t* k0 = KN + (size_t)(row0 + pr) * 512 + h * 64 + hl * 8;
        const bf16_t* r0 = KR + (size_t)(row0 + pr) * 32 + hl * 8;
        const bf16_t* k1 = KN + (size_t)(M + b * 512 + pr) * 512 + h * 64 + hl * 8;
        const bf16_t* r1 = CKR + (size_t)(b * 512 + pr) * 32 + hl * 8;
        const bf16_t* v0 = VT + (size_t)4194304 + ((size_t)((b * 8 + h) * 64 + c32)) * 2560 + hl * 8;
        auto src = [=](int t) {
            TileSrc s;
            if (t < 64) { s.k = k0 + (size_t)t * 32 * 512; s.k2 = r0 + (size_t)t * 32 * 32; }
            else { s.k = k1 + (size_t)(t - 64) * 32 * 512; s.k2 = r1 + (size_t)(t - 64) * 32 * 32; }
            s.v = v0 + t * 32; s.vhi = s.v + 32 * 2560; return s; };
        attn_wave<6>(Q + (size_t)qrow * 768 + h * 96 + hl * 8, 80, src, NoMask(), YM + (size_t)qrow * 512 + h * 64, lane);
    }
}

DEVI void attn_na_ctx(const P& p, int b, int h, int qg, int lane) {
    const int hl = lane >> 5, c32 = lane & 31, pr = pi_row(c32);
    const bf16_t* Qn = (const bf16_t*)(p.ws + WS_NAQ);
    const bf16_t* Kn = (const bf16_t*)(p.ws + WS_NAK);
    const bf16_t* VT = (const bf16_t*)(p.ws + WS_NAVT);
    bf16_t* YN = (bf16_t*)(p.ws + WS_YN);
    const int row0 = b * 256, qrow = row0 + qg * 32 + c32;
    const bf16_t* k0 = Kn + (size_t)(row0 + pr) * 512 + h * 64 + hl * 8;
    const bf16_t* v0 = VT + ((size_t)((b * 8 + h) * 64 + c32)) * 256 + hl * 8;
    auto src = [=](int t) { TileSrc s; s.k = k0 + (size_t)t * 32 * 512; s.k2 = s.k; s.v = v0 + t * 32; s.vhi = s.v + 32 * 256; return s; };
    attn_wave<4>(Qn + (size_t)qrow * 512 + h * 64 + hl * 8, 8, src, NoMask(), YN + (size_t)qrow * 512 + h * 64, lane);
}

struct NaMask {
    const float* rpb;
    int rs, rq, qc, hl;
    DEVI void operator()(int t, f32x16& s) const {
        if (t >= 16) return;
        const int kr = t >> 1, kh = t & 1;
        const int cs = min(max(qc - 8, 0), 48);
        const float* rp = rpb + (rs + kr - rq + 7) * 31;
#pragma unroll
        for (int r = 0; r < 16; ++r) {
            const int kk = (r & 3) + 4 * ((r >> 2) & 1) + 8 * hl + 16 * (r >> 3);
            const int kc = kh * 32 + kk;
            const bool ok = (kc >= cs) && (kc < cs + 16);
            const int dc = min(max(kc - qc + 15, 0), 30);
            const float bias = rp[dc] * LOG2E;
            s[r] = ok ? s[r] + bias : -1e30f;
        }
    }
};
DEVI void attn_na_lat(const P& p, int l, int b, int h, int rq, int qh, int lane) {
    const int hl = lane >> 5, c32 = lane & 31, pr = pi_row(c32);
    const bf16_t* Qn = (const bf16_t*)(p.ws + WS_NAQ);
    const bf16_t* Kn = (const bf16_t*)(p.ws + WS_NAK);
    const bf16_t* VT = (const bf16_t*)(p.ws + WS_NAVT) + (size_t)4194304;
    const bf16_t* CK = (const bf16_t*)(p.ws + WS_CNAK) + (size_t)l * 1024 * 512;
    const bf16_t* CV = (const bf16_t*)(p.ws + WS_CNAVT) + (size_t)l * 1024 * 512;
    bf16_t* YN = (bf16_t*)(p.ws + WS_YN);
    const int row0 = NCTX + b * 2048;
    const int qrow = row0 + rq * 64 + qh * 32 + c32;
    const int rs = min(max(rq - 4, 0), 24);
    const bf16_t* k0 = Kn + (size_t)(row0 + rs * 64 + pr) * 512 + h * 64 + hl * 8;
    const bf16_t* v0 = VT + ((size_t)((b * 8 + h) * 64 + c32)) * 2048 + rs * 64 + hl * 8;
    const bf16_t* k1 = CK + (size_t)(b * 512 + pr) * 512 + h * 64 + hl * 8;
    const bf16_t* v1 = CV + ((size_t)((b * 8 + h) * 64 + c32)) * 512 + hl * 8;
    auto src = [=](int t) {
        TileSrc s;
        if (t < 16) { s.k = k0 + (size_t)t * 32 * 512; s.v = v0 + t * 32; s.vhi = s.v + 32 * 2048; }
        else { s.k = k1 + (size_t)(t - 16) * 32 * 512; s.v = v1 + (t - 16) * 32; s.vhi = s.v + 32 * 512; }
        s.k2 = s.k; return s; };
    NaMask mk; mk.rpb = p.in[21] + (size_t)(l * 8 + h) * 15 * 31; mk.rs = rs; mk.rq = rq; mk.qc = qh * 32 + c32; mk.hl = hl;
    attn_wave<4>(Qn + (size_t)qrow * 512 + h * 64 + hl * 8, 32, src, mk, YN + (size_t)qrow * 512 + h * 64, lane);
}

DEVI void row_ln_mod(const float* src, float* xdst, bf16_t* hdst, const float* lng, const float* lnb, const float* shift, const float* scale, int lane) {
    f32x4 v[4];
#pragma unroll
    for (int j = 0; j < 4; ++j) v[j] = *(const f32x4*)(src + 4 * lane + 256 * j);
    if (lng) {
        float s = 0.f;
#pragma unroll
        for (int j = 0; j < 4; ++j) s += (v[j].x + v[j].y) + (v[j].z + v[j].w);
        const float mu = wave_sum(s) * (1.f / D);
        float q = 0.f;
#pragma unroll
        for (int j = 0; j < 4; ++j) { v[j] = v[j] - mu; q += (v[j].x * v[j].x + v[j].y * v[j].y) + (v[j].z * v[j].z + v[j].w * v[j].w); }
        const float rstd = rsqrtf(wave_sum(q) * (1.f / D) + 1e-5f);
#pragma unroll
        for (int j = 0; j < 4; ++j) {
            const f32x4 g = *(const f32x4*)(lng + 4 * lane + 256 * j), bb = *(const f32x4*)(lnb + 4 * lane + 256 * j);
            v[j] = v[j] * rstd * g + bb;
        }
    }
    if (xdst) {
#pragma unroll
        for (int j = 0; j < 4; ++j) *(f32x4*)(xdst + 4 * lane + 256 * j) = v[j];
    }
    if (hdst) {
        float s = 0.f;
#pragma unroll
        for (int j = 0; j < 4; ++j) s += (v[j].x + v[j].y) + (v[j].z + v[j].w);
        const float mu = wave_sum(s) * (1.f / D);
        float q = 0.f;
#pragma unroll
        for (int j = 0; j < 4; ++j) { v[j] = v[j] - mu; q += (v[j].x * v[j].x + v[j].y * v[j].y) + (v[j].z * v[j].z + v[j].w * v[j].w); }
        const float rstd = rsqrtf(wave_sum(q) * (1.f / D) + 1e-6f);
#pragma unroll
        for (int j = 0; j < 4; ++j) {
            const f32x4 sc = *(const f32x4*)(scale + 4 * lane + 256 * j), sh = *(const f32x4*)(shift + 4 * lane + 256 * j);
            const f32x4 o = v[j] * rstd * (sc + 1.f) + sh;
            u32x2 pk; pk.x = pk2(o.x, o.y); pk.y = pk2(o.z, o.w);
            *(u32x2*)(hdst + 4 * lane + 256 * j) = pk;
        }
    }
}

DEVI void phase_rows(const P& p, int l, int lnidx, int ml, int ms, bool final_, int gw, int ngw, int lane) {
    float* X = (float*)(p.ws + WS_X);
    bf16_t* H = (bf16_t*)(p.ws + WS_H);
    const float* MOD = (const float*)(p.ws + WS_MOD);
    for (int row = gw; row < M; row += ngw) {
        const float* src = (lnidx < 0) ? (row < NCTX ? p.in[0] + (size_t)row * D : p.in[1] + (size_t)(row - NCTX) * D) : X + (size_t)row * D;
        const float* lng = (lnidx < 0) ? nullptr : p.in[28] + (size_t)(l * 3 + lnidx) * D;
        const float* lnb = (lnidx < 0) ? nullptr : p.in[29] + (size_t)(l * 3 + lnidx) * D;
        if (final_) { row_ln_mod(src, p.out + (size_t)row * D, nullptr, lng, lnb, nullptr, nullptr, lane); continue; }
        const float* mb = MOD + ((size_t)ml * 3 + mod_group(row)) * 9216;
        row_ln_mod(src, X + (size_t)row * D, H + (size_t)row * D, lng, lnb, mb + ms * D, mb + (ms + 1) * D, lane);
    }
}

DEVI void phase_rowmix(const P& p, int l, int gw, int ngw, int lane) {
    bf16_t* UQ = (bf16_t*)(p.ws + WS_UQ);
    const float* UKV = (const float*)(p.ws + WS_UKV);
    const float* KRF = (const float*)(p.ws + WS_KRF);
    bf16_t* CKV = (bf16_t*)(p.ws + WS_CKV);
    bf16_t* KR = (bf16_t*)(p.ws + WS_KR);
    const float* ropec = (const float*)(p.ws + WS_ROPE);
    const float* ropes = ropec + 512;
    const float* gq = p.in[17] + l * 384;
    const float* gkv = p.in[19] + l * 256;
    for (int row = gw; row < M; row += ngw) {
        {
            unsigned* up = (unsigned*)(UQ + (size_t)row * 384) + lane;
            float x[6]; float ss = 0.f;
#pragma unroll
            for (int j = 0; j < 3; ++j) { const unsigned w = up[64 * j]; x[2 * j] = bf2f(w & 0xffffu); x[2 * j + 1] = bf2f(w >> 16); ss += x[2 * j] * x[2 * j] + x[2 * j + 1] * x[2 * j + 1]; }
            const float rs = rsqrtf(wave_sum(ss) * (1.f / 384.f) + 1e-6f);
#pragma unroll
            for (int j = 0; j < 3; ++j) { const int c = 2 * lane + 128 * j; up[64 * j] = pk2(x[2 * j] * rs * gq[c], x[2 * j + 1] * rs * gq[c + 1]); }
        }
        {
            const f32x4 v = *(const f32x4*)(UKV + (size_t)row * 256 + 4 * lane);
            const float ss = v.x * v.x + v.y * v.y + v.z * v.z + v.w * v.w;
            const float rs = rsqrtf(wave_sum(ss) * (1.f / 256.f) + 1e-6f);
            const f32x4 g = *(const f32x4*)(gkv + 4 * lane);
            const f32x4 o = v * rs * g;
            u32x2 pk; pk.x = pk2(o.x, o.y); pk.y = pk2(o.z, o.w);
            *(u32x2*)(CKV + (size_t)row * 256 + 4 * lane) = pk;
            if (row < NCTX) *(f32x4*)(p.out + OUT_CKV + ((size_t)((row >> 8) * 4 + l) * 256 + (row & 255)) * 256 + 4 * lane) = o;
        }
        {
            const float v = KRF[(size_t)row * 32 + (lane & 31)];
            const float pr = __shfl_xor(v, 8);
            float o = v;
            if (row >= NCTX) {
                const int c = lane & 31, axis = c >> 4, ii = c & 15, n = (row - NCTX) & 2047;
                const int pos = axis ? (n & 63) : (n >> 6);
                const float rot = (ii < 8) ? -pr : pr;
                o = v * ropec[pos * 8 + (ii & 7)] + rot * ropes[pos * 8 + (ii & 7)];
            }
            if (lane < 32) {
                KR[(size_t)row * 32 + lane] = f2bf(o);
                if (row < NCTX) p.out[OUT_KR + ((size_t)((row >> 8) * 4 + l) * 256 + (row & 255)) * 32 + lane] = v;
            }
        }
    }
}

DEVI void transpose_item(const float* __restrict__ src, int N, int c0, int k0, bf16_t* __restrict__ dst, int K, float* scr, int lane) {
#pragma unroll 8
    for (int i = 0; i < 32; ++i) { const int kk = 2 * i + (lane >> 5); scr[kk * 33 + (lane & 31)] = src[(size_t)(k0 + kk) * N + c0 + (lane & 31)]; }
    asm volatile("s_waitcnt lgkmcnt(0)" ::: "memory");
    const int c = lane & 7;
#pragma unroll
    for (int j = 0; j < 4; ++j) {
        const int n = (lane >> 3) + 8 * j; const float* s = scr + (8 * c) * 33 + n;
        u32x4 o; o.x = pk2(s[0], s[33]); o.y = pk2(s[2 * 33], s[3 * 33]); o.z = pk2(s[4 * 33], s[5 * 33]); o.w = pk2(s[6 * 33], s[7 * 33]);
        *(u32x4*)(dst + (size_t)n * K + k0 + 8 * c) = o;
    }
    asm volatile("s_waitcnt lgkmcnt(0)" ::: "memory");
}

DEVI void prep_weight_item(const P& p, int item, float* scr, int lane) {
    const int l = item / 12944; int r = item % 12944;
    bf16_t* Wl = (bf16_t*)(p.ws + WS_W) + (size_t)l * LAYER_W;
    if (r < 8448) {
        const int which = r / 4224; r %= 4224;
        if (r < 2816) {
            const int rb = r >> 4, kb = r & 15;
            const float* src = ((lane & 16) ? (which ? p.in[14] : p.in[11]) : (which ? p.in[13] : p.in[10])) + (size_t)l * D * DFF;
            transpose_item(src, DFF, rb * 16 - (lane & 16), kb * 64, Wl + (which ? OFF_W13_2 : OFF_W13_1) + (size_t)rb * 32 * D, D, scr, lane);
        } else {
            r -= 2816; const int rb = r / 44, kb = r % 44;
            const float* src = (which ? p.in[15] : p.in[12]) + (size_t)l * DFF * D;
            transpose_item(src, D, rb * 32, kb * 64, Wl + (which ? OFF_W2_2 : OFF_W2_1) + (size_t)rb * 32 * DFF, DFF, scr, lane);
        }
        return;
    }
    r -= 8448;
    if (r < 2944) {
        const int rb = r >> 4, kb = r & 15, R0 = rb * 32;
        const float* src; int N, c0;
        if (R0 < 1184) { src = p.in[16] + (size_t)l * D * 2720; N = 2720; c0 = R0; }
        else if (R0 < 1280) return;
        else if (R0 < 2816) { src = p.in[16] + (size_t)l * D * 2720; N = 2720; c0 = R0 - 96; }
        else { src = p.in[25] + (size_t)l * D * 3072; N = 3072; c0 = R0 - 2816; }
        transpose_item(src, N, c0, kb * 64, Wl + OFF_WIN + (size_t)R0 * D, D, scr, lane);
        return;
    }
    r -= 2944;
    if (r < 512) { const int rb = r >> 4, kb = r & 15; transpose_item(p.in[27] + (size_t)l * D * D, D, rb * 32, kb * 64, Wl + OFF_WOUT + (size_t)rb * 32 * D, D, scr, lane); return; }
    r -= 512;
    if (r < 768) { const int w = r >> 8; r &= 255; const int rb = r >> 3, kb = r & 7;
        transpose_item((w == 0 ? p.in[22] : (w == 1 ? p.in[23] : p.in[24])) + (size_t)l * 512 * D, D, rb * 32, kb * 64, Wl + (w == 0 ? OFF_WBF : (w == 1 ? OFF_WBM : OFF_WBN)) + (size_t)rb * 32 * 512, 512, scr, lane); return; }
    r -= 768;
    if (r < 144) { const int rb = r / 6, kb = r % 6; transpose_item(p.in[18] + (size_t)l * 384 * 768, 768, rb * 32, kb * 64, Wl + OFF_WUQ + (size_t)rb * 32 * 384, 384, scr, lane); return; }
    r -= 144;
    { const int rb = r >> 2, kb = r & 3; transpose_item(p.in[20] + (size_t)l * 256 * 1024, 1024, rb * 32, kb * 64, Wl + OFF_WUKV + (size_t)rb * 32 * 256, 256, scr, lane); }
}

DEVI void phase_prep(const P& p, unsigned char* smem, int tid) {
    const int lane = tid & 63, wave = tid >> 6;
    const int gw = blockIdx.x * NWAVES + wave, ngw = gridDim.x * NWAVES;
    const size_t gt = (size_t)blockIdx.x * NTHREADS + tid, ngt = (size_t)gridDim.x * NTHREADS;
    {
        float* sil = (float*)smem;
        const float* wada = p.in[8];
        float* MODP = (float*)(p.ws + WS_MODP);
        for (int item = blockIdx.x; item < 1152; item += gridDim.x) {
            const int l = item / 288, rem = item % 288, kc = rem / 18, cb = rem % 18;
            __syncthreads();
            if (tid < 192) {
                const int g = tid >> 6, k = kc * 64 + (tid & 63);
                const float cv = (g == 0) ? p.in[7][k] : p.in[6][(g - 1) * D + k];
                sil[tid] = cv * sigmoidf_(cv);
            }
            __syncthreads();
            const int col = cb * NTHREADS + tid;
            const float* w = wada + ((size_t)l * D + kc * 64) * 9216 + col;
            float a0 = 0.f, a1 = 0.f, a2 = 0.f;
#pragma unroll 16
            for (int k = 0; k < 64; ++k) { const float wv = w[(size_t)k * 9216]; a0 += sil[k] * wv; a1 += sil[64 + k] * wv; a2 += sil[128 + k] * wv; }
            float* o = MODP + ((size_t)(l * 16 + kc) * 3) * 9216 + col;
            o[0] = a0; o[9216] = a1; o[2 * 9216] = a2;
        }
        __syncthreads();
    }
    {
        float* scr = (float*)smem + wave * (64 * 33);
        for (int item = gw; item < 4 * 12944; item += ngw) prep_weight_item(p, item, scr, lane);
    }
    {
        bf16_t* TABL = (bf16_t*)(p.ws + WS_TABL);
        for (size_t e = gt; e < (size_t)2048 * 4096; e += ngt) {
            const int k = (int)(e >> 12), kk = (int)(e & 4095), lidx = kk & 2047;
            const int idx = (k * lidx) & 2047;
            float sn, cs; sincospif((float)idx * (2.f / 2048.f), &sn, &cs);
            TABL[e] = f2bf((kk < 2048 ? cs : -sn) * 0.022097086912079608f);
        }
        bf16_t* TABC = (bf16_t*)(p.ws + WS_TABC);
        for (size_t e = gt; e < (size_t)256 * 512; e += ngt) {
            const int k = (int)(e >> 9), kk = (int)(e & 511), lidx = kk & 255;
            const int idx = (k * lidx) & 255;
            float sn, cs; sincospif((float)idx * (2.f / 256.f), &sn, &cs);
            TABC[e] = f2bf((kk < 256 ? cs : -sn) * 0.0625f);
        }
        bf16_t* WCS = (bf16_t*)(p.ws + WS_WCS);
        for (size_t e = gt; e < (size_t)256 * 128; e += ngt) {
            const int i = (int)(e >> 7), c = (int)(e & 127), m = i >> 1, cs_ = i & 1;
            const int idx = (m * c) & 127;
            float sn, cs; sincospif((float)idx * (2.f / 128.f), &sn, &cs);
            WCS[e] = f2bf((cs_ ? sn : cs) * 0.08838834764831845f);
        }
        float* ROPE = (float*)(p.ws + WS_ROPE);
        for (size_t e = gt; e < 512; e += ngt) {
            const int pos = (int)(e >> 3), i = (int)(e & 7);
            const float inv_freq = powf(10000.f, -(float)i / 8.f);
            const float ang = (float)pos * inv_freq;
            ROPE[e] = cosf(ang); ROPE[512 + e] = sinf(ang);
        }
    }
    {
        bf16_t* CCKV = (bf16_t*)(p.ws + WS_CCKV);
        for (size_t e = gt; e < (size_t)NL * 1024 * 256; e += ngt) {
            const int c = (int)(e & 255), i = (int)((e >> 8) & 511), b = (int)((e >> 17) & 1), l = (int)(e >> 18);
            CCKV[e] = f2bf(p.in[2][((size_t)(b * 4 + l) * 512 + i) * 256 + c]);
        }
        bf16_t* CKR = (bf16_t*)(p.ws + WS_CKR);
        for (size_t e = gt; e < (size_t)NL * 1024 * 32; e += ngt) {
            const int c = (int)(e & 31), i = (int)((e >> 5) & 511), b = (int)((e >> 14) & 1), l = (int)(e >> 15);
            CKR[e] = f2bf(p.in[3][((size_t)(b * 4 + l) * 512 + i) * 32 + c]);
        }
        bf16_t* CNAK = (bf16_t*)(p.ws + WS_CNAK);
        for (size_t e = gt; e < (size_t)NL * 1024 * 512; e += ngt) {
            const int c = (int)(e & 511), i = (int)((e >> 9) & 511), b = (int)((e >> 18) & 1), l = (int)(e >> 19);
            CNAK[e] = f2bf(p.in[4][((size_t)(b * 4 + l) * 512 + i) * 512 + c]);
        }
        bf16_t* CNAVT = (bf16_t*)(p.ws + WS_CNAVT);
        for (size_t e = gt; e < (size_t)NL * 1024 * 512; e += ngt) {
            const int key = (int)(e & 511), hd = (int)((e >> 9) & 511), b = (int)((e >> 18) & 1), l = (int)(e >> 19);
            CNAVT[e] = f2bf(p.in[5][((size_t)(b * 4 + l) * 512 + key) * 512 + hd]);
        }
    }
}

DEVI void phase_modreduce(const P& p, int tid) {
    const float* MODP = (const float*)(p.ws + WS_MODP);
    float* MOD = (float*)(p.ws + WS_MOD);
    for (int e = blockIdx.x * NTHREADS + tid; e < NL * 3 * 9216; e += gridDim.x * NTHREADS) {
        const int l = e / (3 * 9216), rem = e % (3 * 9216);
        float a = p.in[9][l * 9216 + (rem % 9216)];
#pragma unroll
        for (int kc = 0; kc < 16; ++kc) a += MODP[((size_t)(l * 16 + kc) * 3) * 9216 + rem];
        MOD[e] = a;
    }
}

#define XB_TMO      128
#define XB_XCNT(j)  (256  + 64 * (j))
#define XB_XSUB(j)  (1280 + 64 * (j))
#define XB_XGEN(j)  (2304 + 64 * (j))
#define XB_TOP      3328
#define XB_TOPGEN   3392
#define XCD_BAR_WORDS 3456
#define XB_SPIN_CAP (1u << 20)
#define LAS __attribute__((address_space(3)))
DEVI unsigned xb_ld(unsigned* p)              { return __hip_atomic_load(p, __ATOMIC_RELAXED, __HIP_MEMORY_SCOPE_AGENT); }
DEVI unsigned xb_add(unsigned* p, unsigned v) { return __hip_atomic_fetch_add(p, v, __ATOMIC_RELAXED, __HIP_MEMORY_SCOPE_AGENT); }
DEVI unsigned xb_xcc_id() { return (unsigned)__builtin_amdgcn_s_getreg((3 << 11) | 20) & 0xFu; }
#define XB_SPIN(cond, bar) do { unsigned _sp = 0; while (cond) { __builtin_amdgcn_s_sleep(1); \
    if ((++_sp & 255u) == 0u) { if (xb_ld(&(bar)[XB_TMO])) break; if (_sp > XB_SPIN_CAP) { atomicAdd(&(bar)[XB_TMO], 1u); break; } } } } while (0)
struct XcdBarrier { unsigned* bar; unsigned x; volatile LAS unsigned* st; };
DEVI XcdBarrier xcd_barrier_post(unsigned* bar, volatile LAS unsigned* st) {
    XcdBarrier b; b.bar = bar; b.x = xb_xcc_id(); b.st = st;
    if (threadIdx.x == 0) (void)xb_add(&bar[XB_XCNT(b.x)], 1u);
    return b;
}
DEVI void xcd_barrier_complete(unsigned* bar, unsigned x, unsigned& nloc, unsigned& nx) {
    const unsigned G = gridDim.x * gridDim.y * gridDim.z;
    unsigned sum, cnt, mine, sp = 0u;
    for (;;) {
        sum = 0u; cnt = 0u; mine = 0u;
#pragma unroll
        for (unsigned j = 0; j < 16; ++j) { const unsigned c = xb_ld(&bar[XB_XCNT(j)]); sum += c; cnt += (c > 0u) ? 1u : 0u; mine = (j == x) ? c : mine; }
        if (sum == G) break;
        __builtin_amdgcn_s_sleep(1);
        if ((++sp & 255u) == 0u) { if (xb_ld(&bar[XB_TMO])) break; if (sp > XB_SPIN_CAP) { atomicAdd(&bar[XB_TMO], 1u); break; } }
    }
    nloc = mine > 0u ? mine : 1u; nx = cnt > 0u ? cnt : 1u;
}
DEVI void xcd_barrier(const XcdBarrier& b) {
    asm volatile("s_waitcnt vmcnt(0)" ::: "memory");
    __syncthreads();
    if (threadIdx.x == 0) {
        unsigned* bar = b.bar;
        __builtin_amdgcn_s_waitcnt(0);
        unsigned nloc = b.st[0], nx = b.st[1];
        if (nloc == 0u) { xcd_barrier_complete(bar, b.x, nloc, nx); b.st[0] = nloc; b.st[1] = nx; }
        const unsigned old = xb_add(&bar[XB_XSUB(b.x)], 1u);
        const unsigned gen = old / nloc;
        if (old + 1u == (gen + 1u) * nloc) {
            __builtin_amdgcn_fence(__ATOMIC_RELEASE, "agent");
            asm volatile("s_waitcnt vmcnt(0)" ::: "memory");
            const unsigned og = xb_add(&bar[XB_TOP], 1u);
            const unsigned tg = og / nx;
            if (og + 1u == (tg + 1u) * nx) xb_add(&bar[XB_TOPGEN], 1u);
            else XB_SPIN(xb_ld(&bar[XB_TOPGEN]) == tg, bar);
            __builtin_amdgcn_fence(__ATOMIC_ACQUIRE, "agent");
            xb_add(&bar[XB_XGEN(b.x)], 1u);
            asm volatile("s_waitcnt vmcnt(0)" ::: "memory");
        } else {
            XB_SPIN(xb_ld(&bar[XB_XGEN(b.x)]) == gen, bar);
            __builtin_amdgcn_fence(__ATOMIC_ACQUIRE, "agent");
            asm volatile("s_waitcnt vmcnt(0)" ::: "memory");
        }
    }
    __syncthreads();
}

DEVI void run_phase(const P& p, int ph, unsigned char* smem, int tid) {
    const int lane = tid & 63, wave = tid >> 6;
    const int gw = blockIdx.x * NWAVES + wave, ngw = gridDim.x * NWAVES;
    const int nb = gridDim.x, bid = blockIdx.x;
    const int grp = tid >> 8, ltid = tid & 255;
    bf16_t* sm = (bf16_t*)smem + grp * (SMEM_BYTES / 2);
    if (ph == 0) { phase_prep(p, smem, tid); return; }
    if (ph == 1) { phase_modreduce(p, tid); return; }
    if (ph == 2) { phase_rows(p, 0, -1, 0, 0, false, gw, ngw, lane); return; }
    const int l = (ph - 3) / 13, s = (ph - 3) % 13;
    const bf16_t* Wl = (const bf16_t*)(p.ws + WS_W) + (size_t)l * LAYER_W;
    const float* MODl = (const float*)(p.ws + WS_MOD) + (size_t)l * 3 * 9216;
    switch (s) {
    case 0: case 10:
        {
            pg8::Gemm g{(const bf16_t*)(p.ws + WS_H), Wl + (s == 10 ? OFF_W13_2 : OFF_W13_1), M, 2 * DFF, D};
            pg8::StaticOrder S; S.init(M, 2 * DFF, nb, bid);
            pg8::EpiSwiGLU E{(bf16_t*)(p.ws + WS_ACT)};
            pg8::gemm_phase<pg8::EpiSwiGLU, pg8::StaticOrder, true, true>((PG8_LAS unsigned char*)smem, g, S, E, tid);
        }
        break;
    case 1: case 11:
        {
            pg8::Gemm g{(const bf16_t*)(p.ws + WS_ACT), Wl + (s == 11 ? OFF_W2_2 : OFF_W2_1), M, D, DFF};
            pg8::StaticOrder S; S.init(M, D, nb, bid);
            pg8::EpiResid E{(float*)(p.ws + WS_X), MODl + (s == 11 ? 8 : 2) * D, 0.5f};
            pg8::gemm_phase<pg8::EpiResid, pg8::StaticOrder, false, true>((PG8_LAS unsigned char*)smem, g, S, E, tid);
        }
        break;
    case 2: phase_rows(p, l, 0, l, 3, false, gw, ngw, lane); break;
    case 3:
        for (int u = bid; u < 96 * 46 / 2; u += nb) job_in(p, l, 2 * u + grp, sm, ltid);
        break;
    case 4: phase_rowmix(p, l, gw, ngw, lane); break;
    case 5: {
        int u = bid;
        for (; u < 128; u += nb) {
            const int wi = u * 8 + wave;
            attn_na_lat(p, l, wi >> 9, (wi >> 6) & 7, (wi >> 1) & 31, wi & 1, lane);
        }
        for (; u < 128 + 416; u += nb) job_ukv(p, l, 2 * (u - 128) + grp, sm, ltid);
        for (; u < 128 + 416 + 288; u += nb) job_uq(p, l, 2 * (u - 128 - 416) + grp, sm, ltid);
        for (; u < 128 + 416 + 288 + 384; u += nb) job_f1(p, 2 * (u - 128 - 416 - 288) + grp, sm, ltid);
        for (; u < 128 + 416 + 288 + 384 + 256; u += nb) {
            const int wi = (u - 128 - 416 - 288 - 384) * 8 + wave;
            attn_na_ctx(p, wi >> 6, (wi >> 3) & 7, wi & 7, lane);
        }
    } break;
    case 6: {
        int u = bid;
        for (; u < 128; u += nb) {
            const int wi = u * 8 + wave;
            attn_mla(p, l, true, wi >> 9, (wi >> 6) & 7, wi & 63, lane);
        }
        for (; u < 128 + 64; u += nb) job_f2_lat(p, 2 * (u - 128) + grp, sm, ltid);
        for (; u < 128 + 64 + 128; u += nb) job_f2_ctx(p, 2 * (u - 128 - 64) + grp, sm, ltid);
        for (; u < 128 + 64 + 128 + 256; u += nb) {
            const int wi = (u - 128 - 64 - 128) * 8 + wave;
            attn_mla(p, l, false, wi >> 6, (wi >> 3) & 7, wi & 7, lane);
        }
    } break;
    case 7:
        for (int u = bid; u < 96 * 8 / 2; u += nb) job_merge(p, l, 2 * u + grp, sm, ltid);
        break;
    case 8:
        {
            pg8::Gemm g{(const bf16_t*)(p.ws + WS_MERGED), Wl + OFF_WOUT, M, D, D};
            pg8::StaticOrder S; S.init(M, D, nb, bid);
            pg8::EpiResid E{(float*)(p.ws + WS_X), MODl + 5 * D, 1.0f};
            pg8::gemm_phase<pg8::EpiResid, pg8::StaticOrder, false, true>((PG8_LAS unsigned char*)smem, g, S, E, tid);
        }
        break;
    case 9: phase_rows(p, l, 1, l, 6, false, gw, ngw, lane); break;
    case 12:
        if (l == NL - 1) phase_rows(p, l, 2, 0, 0, true, gw, ngw, lane);
        else phase_rows(p, l, 2, l + 1, 0, false, gw, ngw, lane);
        break;
    default: break;
    }
}

__global__ void __launch_bounds__(NTHREADS, 2) mega_kernel(P p) {
    extern __shared__ __attribute__((aligned(16))) unsigned char smem[];
    __shared__ uint4 xb_words;
    cg::grid_group grid = cg::this_grid();
    const int tid = threadIdx.x;
    unsigned* bar = (unsigned*)(p.ws + WS_BAR);
    if (tid == 0) xb_words = make_uint4(0u, 0u, 0u, 0u);
    if (p.ph_lo == 0 && blockIdx.x == 0) for (int i = tid; i < XCD_BAR_WORDS; i += NTHREADS) bar[i] = 0u;
    __syncthreads();
    XcdBarrier xb; xb.bar = bar; xb.x = 0; xb.st = (volatile LAS unsigned*)&xb_words;
#pragma nounroll
    for (int ph = p.ph_lo; ph < p.ph_hi; ++ph) {
        int tid2 = tid; asm volatile("" : "+v"(tid2));
        run_phase(p, ph, smem, tid2);
        if (ph + 1 < p.ph_hi) {
            if (ph == p.ph_lo) { grid.sync(); xb = xcd_barrier_post(bar, (volatile LAS unsigned*)&xb_words); }
            else xcd_barrier(xb);
        }
    }
}

extern "C" void kernel_launch(void* const* d_in, const int* in_sizes, int n_in, void* d_out, int out_size, void* d_ws, size_t ws_size,
                              hipStream_t stream) {
    static int grid_blocks = 0;
    if (grid_blocks == 0) {
        if (n_in != 30 || ws_size < WS_END) { fprintf(stderr, "kernel_launch: n_in %d ws %zu need %zu\n", n_in, ws_size, (size_t)WS_END); grid_blocks = -1; return; }
        int dev = 0, cus = 0, per_cu = 0;
        hipGetDevice(&dev);
        hipDeviceGetAttribute(&cus, hipDeviceAttributeMultiprocessorCount, dev);
        hipFuncSetAttribute((const void*)mega_kernel, hipFuncAttributeMaxDynamicSharedMemorySize, LDS_TOTAL);
        hipOccupancyMaxActiveBlocksPerMultiprocessor(&per_cu, (const void*)mega_kernel, NTHREADS, LDS_TOTAL);
        if (per_cu < 1) per_cu = 1;
        if (per_cu > 1) per_cu = 1;
        grid_blocks = cus * per_cu;
    }
    if (grid_blocks < 0) return;
    P p{};
    for (int i = 0; i < 30; ++i) p.in[i] = (const float*)d_in[i];
    p.out = (float*)d_out; p.ws = (unsigned char*)d_ws; p.ph_lo = 0; p.ph_hi = NPHASE;
#ifndef MULTI_LAUNCH
#define MULTI_LAUNCH 0
#endif
#if MULTI_LAUNCH
    for (int ph = 0; ph < NPHASE; ++ph) {
        p.ph_lo = ph; p.ph_hi = ph + 1;
        hipLaunchKernelGGL(mega_kernel, dim3(grid_blocks), dim3(NTHREADS), LDS_TOTAL, stream, p);
    }
#else
    void* args[] = {&p};
    hipError_t e = hipLaunchCooperativeKernel((const void*)mega_kernel, dim3(grid_blocks), dim3(NTHREADS), args, LDS_TOTAL, stream);
    if (e != hipSuccess) fprintf(stderr, "cooperative launch failed: %s (grid %d)\n", hipGetErrorString(e), grid_blocks);
#endif
}
```

```cpp
#include <hip/hip_runtime.h>
#include <hip/hip_cooperative_groups.h>
#include <cstdint>
#include <cstdio>
namespace cg = cooperative_groups;

typedef unsigned short bf16_t;
typedef short bf16x8 __attribute__((ext_vector_type(8)));
typedef float f32x16 __attribute__((ext_vector_type(16)));
typedef float f32x4 __attribute__((ext_vector_type(4)));
typedef unsigned u32x4 __attribute__((ext_vector_type(4)));
typedef unsigned u32x2 __attribute__((ext_vector_type(2)));
#define DEVI __device__ __forceinline__

constexpr int D = 1024, NCTX = 8192, NLAT = 4096, M = 12288, MX = 13312, DFF = 2816, NL = 4;
constexpr float ALPHA_F = 1.6817928305074290f;
constexpr float LOG2E = 1.4426950408889634f;
constexpr float MLA_QS = 0.10206207261596575f * LOG2E;
constexpr float NA_QS = 0.125f * LOG2E;
constexpr size_t OUT_CKV = 12582912, OUT_KR = 20971520, OUT_NAK = 22020096, OUT_NAV = 38797312;

constexpr size_t al256(size_t x) { return (x + 255) & ~(size_t)255; }
constexpr size_t WS_BAR = 0;
constexpr size_t WS_X = 16384;
constexpr size_t WS_H = WS_X + (size_t)M * D * 4;
constexpr size_t WS_MOD = WS_H + (size_t)M * D * 2;
constexpr size_t WS_MODP = WS_MOD + al256((size_t)NL * 3 * 9216 * 4);
constexpr size_t WS_ROPE = WS_MODP + al256((size_t)NL * 16 * 3 * 9216 * 4);
constexpr size_t WS_TABC = WS_ROPE + 4096;
constexpr size_t WS_TABL = WS_TABC + (size_t)256 * 512 * 2;
constexpr size_t WS_WCS = WS_TABL + (size_t)2048 * 4096 * 2;
constexpr size_t WS_CCKV = WS_WCS + (size_t)256 * 128 * 2;
constexpr size_t WS_CKR = WS_CCKV + (size_t)NL * 1024 * 256 * 2;
constexpr size_t WS_CNAK = WS_CKR + (size_t)NL * 1024 * 32 * 2;
constexpr size_t WS_CNAVT = WS_CNAK + (size_t)NL * 1024 * 512 * 2;
constexpr size_t WS_W = WS_CNAVT + (size_t)NL * 1024 * 512 * 2;
constexpr size_t OFF_W13_1 = 0, OFF_W2_1 = 5767168, OFF_W13_2 = 8650752, OFF_W2_2 = 14417920, OFF_WIN = 17301504,
                 OFF_WOUT = 23330816, OFF_WBF = 24379392, OFF_WBM = 24903680, OFF_WBN = 25427968, OFF_WUQ = 25952256,
                 OFF_WUKV = 26247168, LAYER_W = 26509312;
constexpr size_t WS_R1 = WS_W + (size_t)NL * LAYER_W * 2;
constexpr size_t WS_ACT = WS_R1;
constexpr size_t WS_UF = WS_R1;
constexpr size_t WS_UQ = WS_UF + (size_t)M * 512 * 2;
constexpr size_t WS_UKV = WS_UQ + (size_t)M * 384 * 2;
constexpr size_t WS_KRF = WS_UKV + (size_t)M * 256 * 4;
constexpr size_t WS_CKV = WS_KRF + (size_t)M * 32 * 4;
constexpr size_t WS_KR = WS_CKV + (size_t)M * 256 * 2;
constexpr size_t WS_NAQ = WS_KR + (size_t)M * 32 * 2;
constexpr size_t WS_NAK = WS_NAQ + (size_t)M * 512 * 2;
constexpr size_t WS_NAVT = WS_NAK + (size_t)M * 512 * 2;
constexpr size_t WS_GATE = WS_NAVT + (size_t)M * 512 * 2;
constexpr size_t WS_Q = WS_GATE + (size_t)M * 3072 * 2;
constexpr size_t WS_KN = WS_Q + (size_t)M * 768 * 2;
constexpr size_t WS_VTM = WS_KN + (size_t)MX * 512 * 2;
constexpr size_t WS_F1T = WS_VTM + (size_t)MX * 512 * 2;
constexpr size_t WS_YF = WS_F1T + (size_t)M * 1024 * 2;
constexpr size_t WS_YM = WS_YF + (size_t)M * 512 * 2;
constexpr size_t WS_YN = WS_YM + (size_t)M * 512 * 2;
constexpr size_t WS_MERGED = WS_YN + (size_t)M * 512 * 2;
constexpr size_t WS_END = WS_MERGED + (size_t)M * 1024 * 2;
static_assert(WS_END - WS_R1 >= (size_t)M * DFF * 2, "ACT must fit in R1");

constexpr int NPHASE = 3 + 13 * NL;

struct P {
    const float* in[30];
    float* out;
    unsigned char* ws;
    int ph_lo, ph_hi;
};

__device__ __forceinline__ const float* pin(const P& p, int i) { int j = i; asm volatile("" : "+s"(j)); return p.in[j]; }
typedef __bf16 bf16v2 __attribute__((ext_vector_type(2)));
typedef float f32x2 __attribute__((ext_vector_type(2)));
DEVI unsigned pk2(float lo, float hi) { f32x2 v = {lo, hi}; bf16v2 b = __builtin_convertvector(v, bf16v2); return __builtin_bit_cast(unsigned, b); }
DEVI bf16_t f2bf(float x) { return (bf16_t)(pk2(x, 0.f) & 0xffffu); }
DEVI float bf2f(unsigned v) { return __uint_as_float(v << 16); }
DEVI float wave_sum(float v) {
#pragma unroll
    for (int o = 1; o < 64; o <<= 1) v += __shfl_xor(v, o);
    return v;
}
DEVI float fast_exp2(float x) { return __builtin_amdgcn_exp2f(x); }
DEVI float sigmoidf_(float x) { return 1.f / (1.f + __expf(-x)); }

constexpr int LDT = 72;
constexpr int TILE_E = 128 * LDT;
constexpr int SMEM_BYTES = 4 * TILE_E * 2;
constexpr int NTHREADS = 512, NWAVES = 8, LDS_TOTAL = 2 * SMEM_BYTES;

DEVI void gemm_ldg(const bf16_t* ga, const bf16_t* gb, int lda, int ldb, u32x4 (&ra)[4], u32x4 (&rb)[4]) {
#pragma unroll
    for (int i = 0; i < 4; ++i) {
        ra[i] = *(const u32x4*)(ga + (size_t)(32 * i) * lda);
        rb[i] = *(const u32x4*)(gb + (size_t)(32 * i) * ldb);
    }
}
DEVI void gemm_sts(bf16_t* buf, int soff, const u32x4 (&ra)[4], const u32x4 (&rb)[4]) {
#pragma unroll
    for (int i = 0; i < 4; ++i) {
        *(u32x4*)(buf + soff + 32 * i * LDT) = ra[i];
        *(u32x4*)(buf + TILE_E + soff + 32 * i * LDT) = rb[i];
    }
}
DEVI void gemm_mma(const bf16_t* cur, int aoff, int boff, f32x16 (&acc)[2][2]) {
#pragma unroll
    for (int ks = 0; ks < 4; ++ks) {
        bf16x8 a0 = *(const bf16x8*)(cur + aoff + ks * 16);
        bf16x8 a1 = *(const bf16x8*)(cur + aoff + 32 * LDT + ks * 16);
        bf16x8 b0 = *(const bf16x8*)(cur + boff + ks * 16);
        bf16x8 b1 = *(const bf16x8*)(cur + boff + 32 * LDT + ks * 16);
        acc[0][0] = __builtin_amdgcn_mfma_f32_32x32x16_bf16(a0, b0, acc[0][0], 0, 0, 0);
        acc[0][1] = __builtin_amdgcn_mfma_f32_32x32x16_bf16(a0, b1, acc[0][1], 0, 0, 0);
        acc[1][0] = __builtin_amdgcn_mfma_f32_32x32x16_bf16(a1, b0, acc[1][0], 0, 0, 0);
        acc[1][1] = __builtin_amdgcn_mfma_f32_32x32x16_bf16(a1, b1, acc[1][1], 0, 0, 0);
    }
}

template <bool DEEP = true>
DEVI void gemm_core(const bf16_t* __restrict__ A, int lda, const bf16_t* __restrict__ B, int ldb, int K,
                    f32x16 (&acc)[2][2], bf16_t* smem, int tid) {
    const int lane = tid & 63, wave = tid >> 6, wr = wave >> 1, wc = wave & 1;
    const int lr = tid >> 3, lc = (tid & 7) * 8;
    const bf16_t* ga = A + (size_t)lr * lda + lc;
    const bf16_t* gb = B + (size_t)lr * ldb + lc;
    const int soff = lr * LDT + lc;
    const int nk = K >> 6;
    const int aoff = (wr * 64 + (lane & 31)) * LDT + (lane >> 5) * 8;
    const int boff = TILE_E + (wc * 64 + (lane & 31)) * LDT + (lane >> 5) * 8;
    bf16_t* buf0 = smem; bf16_t* buf1 = smem + 2 * TILE_E;
    if constexpr (DEEP) {
        u32x4 ra0[4], rb0[4], ra1[4], rb1[4];
        gemm_ldg(ga, gb, lda, ldb, ra0, rb0);
        gemm_ldg(ga + 64, gb + 64, lda, ldb, ra1, rb1);
        gemm_sts(buf0, soff, ra0, rb0);
        __syncthreads();
        for (int kt = 0; kt < nk; kt += 2) {
            if (kt + 2 < nk) gemm_ldg(ga + (size_t)(kt + 2) * 64, gb + (size_t)(kt + 2) * 64, lda, ldb, ra0, rb0);
            gemm_mma(buf0, aoff, boff, acc);
            gemm_sts(buf1, soff, ra1, rb1);
            __syncthreads();
            if (kt + 3 < nk) gemm_ldg(ga + (size_t)(kt + 3) * 64, gb + (size_t)(kt + 3) * 64, lda, ldb, ra1, rb1);
            gemm_mma(buf1, aoff, boff, acc);
            if (kt + 2 < nk) gemm_sts(buf0, soff, ra0, rb0);
            __syncthreads();
        }
    } else {
        u32x4 ra[4], rb[4];
        gemm_ldg(ga, gb, lda, ldb, ra, rb);
        gemm_sts(buf0, soff, ra, rb);
        __syncthreads();
        for (int kt = 0; kt < nk; ++kt) {
            bf16_t* cur = (kt & 1) ? buf1 : buf0;
            bf16_t* nxt = (kt & 1) ? buf0 : buf1;
            const bool more = (kt + 1 < nk);
            if (more) { ga += 64; gb += 64; gemm_ldg(ga, gb, lda, ldb, ra, rb); }
            gemm_mma(cur, aoff, boff, acc);
            if (more) gemm_sts(nxt, soff, ra, rb);
            __syncthreads();
        }
    }
}

DEVI void zero_acc(f32x16 (&acc)[2][2]) {
#pragma unroll
    for (int i = 0; i < 2; ++i)
#pragma unroll
        for (int j = 0; j < 2; ++j)
#pragma unroll
            for (int r = 0; r < 16; ++r) acc[i][j][r] = 0.f;
}

#define EPI_SETUP const int lane = tid & 63, wave = tid >> 6, wr = wave >> 1, wc = wave & 1, hl = lane >> 5, c32 = lane & 31; (void)wr; (void)wc; (void)hl; (void)c32;

DEVI int mod_group(int row) { return row < NCTX ? 0 : 1 + ((row - NCTX) >> 11); }

namespace pg8 {
#define PG8_LAS __attribute__((address_space(3)))
constexpr int BM = 256, BK = 64, HALF = 128, HTB = HALF * BK * 2, NXCD = 8, WGM = 8;
DEVI int lds_byte(int r, int c) { const int st = (r >> 4) * 2 + (c >> 5), rr = r & 15, cc = c & 31, ob = rr * 64 + cc * 2; return st * 1024 + (ob ^ (((ob >> 9) & 1) << 5)); }
DEVI void stage_rc(int b, int& R, int& C) { const int st = b / 1024, sb = b % 1024, swz = sb ^ (((sb >> 9) & 1) << 5); R = (st >> 1) * 16 + swz / 64; C = (st & 1) * 32 + (swz % 64) / 2; }
DEVI int perm32(int rho) { const int n = rho >> 4, i = rho & 15; return 8 * (i >> 2) + 4 * n + (i & 3); }
struct Unit { int pm, pn; };
struct Gemm { const bf16_t* A; const bf16_t* Bt; int M, N, K; };
struct StaticOrder {
    int nM, nN, nwg, G, c;
    DEVI void init(int M, int N, int G_, int c_) { nM = M / BM; nN = N / BM; nwg = nM * nN; G = G_; c = c_; }
    DEVI bool next(int i, Unit& u) const {
        const long L = (long)i * G + c; if (L >= nwg) return false;
        int wgid = (int)L; { const int q = nwg / NXCD, r = nwg % NXCD, xcd = wgid % NXCD, off = wgid / NXCD; wgid = (xcd < r ? xcd * (q + 1) : r * (q + 1) + (xcd - r) * q) + off; }
        const int nig = WGM * nN, gid = wgid / nig, fm = gid * WGM, gsz = (nM - fm) < WGM ? (nM - fm) : WGM;
        u.pm = fm + ((wgid % nig) % gsz); u.pn = (wgid % nig) / gsz; return true;
    }
    DEVI void a_ready(const Unit&) const {}
    DEVI void done(const Unit&) const {}
};
template <class Epi, class Sched, bool ALIGN_EPI = false, bool SP2 = false>
DEVI void gemm_phase(PG8_LAS unsigned char* lds, const Gemm g, const Sched& S, const Epi& E, const int tid) {
    const int wid = __builtin_amdgcn_readfirstlane(tid >> 6), lane = tid & 63, wr = wid >> 2, wc = wid & 3, fr = lane & 15, fq = lane >> 4;
    const int K = g.K, nt = K / BK;
    unsigned voffA[2], voffB[2];
#pragma unroll
    for (int i = 0; i < 2; ++i) { int R, C; stage_rc(tid * 16 + i * 8192, R, C); const int Rb = Epi::PERM ? ((R & ~31) + perm32(R & 31)) : R;
        voffA[i] = (unsigned)(R * K + C) * 2u; voffB[i] = (unsigned)(Rb * K + C) * 2u; }
    const size_t kstep = (size_t)(BK * 2);
    const size_t hstep = (size_t)HALF * K * 2;
    const size_t tstep = 2 * hstep;
    const unsigned ldsw = (unsigned)wid * 1024u;
    const int aoff = lds_byte(wr * 64 + fr, fq * 8), boff = lds_byte(wc * 32 + fr, fq * 8);
#define PG8_SA(b, h) (((b) * 2 + (h)) * HTB)
#define PG8_SB(b, h) ((4 + (b) * 2 + (h)) * HTB)
#define PG8_STAGE(bufoff, gbase, voff) do { _Pragma("unroll") for (int _i = 0; _i < 2; ++_i) \
        __builtin_amdgcn_global_load_lds((const unsigned*)((const char*)(gbase) + (voff)[_i]), (PG8_LAS unsigned*)(lds + (bufoff) + ldsw + _i * 8192), 16, 0, 0); } while (0)
#define PG8_LDA(dst, b, h) do { _Pragma("unroll") for (int m = 0; m < 4; ++m) _Pragma("unroll") for (int k = 0; k < 2; ++k) dst[m][k] = *(const PG8_LAS bf16x8*)(lds + PG8_SA(b, h) + aoff + m * 2048 + k * 1024); } while (0)
#define PG8_LDB(dst, b, h) do { _Pragma("unroll") for (int n = 0; n < 2; ++n) _Pragma("unroll") for (int k = 0; k < 2; ++k) dst[n][k] = *(const PG8_LAS bf16x8*)(lds + PG8_SB(b, h) + boff + n * 2048 + k * 1024); } while (0)
#define PG8_MMA(ai, bj, At, Bt) do { __builtin_amdgcn_s_setprio(1); _Pragma("unroll") for (int m = 0; m < 4; ++m) _Pragma("unroll") for (int n = 0; n < 2; ++n) _Pragma("unroll") for (int k = 0; k < 2; ++k) \
        acc[ai][bj][m][n] = __builtin_amdgcn_mfma_f32_16x16x32_bf16(Bt[n][k], At[m][k], acc[ai][bj][m][n], 0, 0, 0); __builtin_amdgcn_s_setprio(0); } while (0)
#define PG8_WAIT_V(n) asm volatile("s_waitcnt vmcnt(" #n ")" ::: "memory")
#define PG8_WAIT_L(n) asm volatile("s_waitcnt lgkmcnt(" #n ")" ::: "memory")
#define PG8_BAR __builtin_amdgcn_s_barrier()
#define PG8_SCHED __builtin_amdgcn_sched_barrier(0)
    Unit cur, nxt; int ui = 0;
    if (!S.next(0, cur)) return;
    f32x4 acc[2][2][4][2];
#pragma unroll
    for (int a = 0; a < 2; ++a)
#pragma unroll
        for (int b = 0; b < 2; ++b)
#pragma unroll
            for (int m = 0; m < 4; ++m)
#pragma unroll
                for (int n = 0; n < 2; ++n) acc[a][b][m][n] = (f32x4){0.f, 0.f, 0.f, 0.f};
    bf16x8 At[4][2], B0[2][2], B1[2][2];
    const char* cA = (const char*)g.A + (size_t)cur.pm * tstep; const char* cB = (const char*)g.Bt + (size_t)cur.pn * tstep;
    S.a_ready(cur);
    if constexpr (SP2) {
        PG8_STAGE(PG8_SB(0, 0), cB, voffB); PG8_STAGE(PG8_SB(0, 1), cB + hstep, voffB); PG8_STAGE(PG8_SA(0, 0), cA, voffA); PG8_STAGE(PG8_SA(0, 1), cA + hstep, voffA);
        if (wr == 1) PG8_BAR;
        PG8_WAIT_V(2); PG8_BAR;
        PG8_STAGE(PG8_SB(1, 0), cB + kstep, voffB); PG8_STAGE(PG8_SA(1, 0), cA + kstep, voffA); PG8_STAGE(PG8_SB(1, 1), cB + hstep + kstep, voffB);
        PG8_WAIT_V(6); PG8_BAR;
    } else {
        PG8_STAGE(PG8_SB(0, 0), cB, voffB); PG8_STAGE(PG8_SA(0, 0), cA, voffA); PG8_STAGE(PG8_SB(0, 1), cB + hstep, voffB); PG8_STAGE(PG8_SA(0, 1), cA + hstep, voffA);
        if (wr == 1) PG8_BAR;
        PG8_WAIT_V(4); PG8_BAR;
        PG8_STAGE(PG8_SB(1, 0), cB + kstep, voffB); PG8_STAGE(PG8_SA(1, 0), cA + kstep, voffA); PG8_STAGE(PG8_SB(1, 1), cB + hstep + kstep, voffB);
        PG8_WAIT_V(6); PG8_BAR;
    }
    for (;;) {
        const bool has_next = S.next(ui + 1, nxt);
        const char* nA = has_next ? (const char*)g.A + (size_t)nxt.pm * tstep : cA; const char* nB = has_next ? (const char*)g.Bt + (size_t)nxt.pn * tstep : cB;
        for (int t = 0; t < nt; t += 2) {
            const bool last = (t == nt - 2);
            const char* a1 = cA + (size_t)(t + 1) * kstep;
            const char* a2 = last ? nA : cA + (size_t)(t + 2) * kstep; const char* b2 = last ? nB : cB + (size_t)(t + 2) * kstep;
            const char* a3 = a2 + kstep; const char* b3 = b2 + kstep;
            if (last && has_next) S.a_ready(nxt);
            if constexpr (SP2) {
            PG8_LDB(B0, 0, 0); PG8_LDB(B1, 0, 1); PG8_SCHED; PG8_LDA(At, 0, 0); PG8_STAGE(PG8_SA(1, 1), a1 + hstep, voffA);
            PG8_WAIT_V(8); PG8_WAIT_L(0); PG8_BAR; PG8_MMA(0, 0, At, B0); PG8_MMA(0, 1, At, B1); PG8_BAR; PG8_SCHED;
            PG8_LDA(At, 0, 1); PG8_STAGE(PG8_SB(0, 0), b2, voffB); PG8_STAGE(PG8_SB(0, 1), b2 + hstep, voffB); PG8_STAGE(PG8_SA(0, 0), a2, voffA);
            PG8_WAIT_V(8); PG8_WAIT_L(0); PG8_BAR; PG8_MMA(1, 0, At, B0); PG8_MMA(1, 1, At, B1); PG8_BAR; PG8_SCHED;
            PG8_LDB(B0, 1, 0); PG8_LDB(B1, 1, 1); PG8_SCHED; PG8_LDA(At, 1, 0); PG8_STAGE(PG8_SA(0, 1), a2 + hstep, voffA);
            PG8_WAIT_V(8); PG8_WAIT_L(0); PG8_BAR; PG8_MMA(0, 0, At, B0); PG8_MMA(0, 1, At, B1); PG8_BAR; PG8_SCHED;
            PG8_LDA(At, 1, 1); PG8_STAGE(PG8_SB(1, 0), b3, voffB); PG8_STAGE(PG8_SB(1, 1), b3 + hstep, voffB); PG8_STAGE(PG8_SA(1, 0), a3, voffA);
            PG8_WAIT_V(8); PG8_WAIT_L(0); PG8_BAR; PG8_MMA(1, 0, At, B0); PG8_MMA(1, 1, At, B1); PG8_BAR; PG8_SCHED;
            } else {
            PG8_LDB(B0, 0, 0); PG8_SCHED; PG8_LDA(At, 0, 0); PG8_STAGE(PG8_SA(1, 1), a1 + hstep, voffA);
            PG8_WAIT_L(8); PG8_BAR; PG8_WAIT_L(0); PG8_MMA(0, 0, At, B0); PG8_BAR; PG8_SCHED;
            PG8_LDB(B1, 0, 1); PG8_STAGE(PG8_SB(0, 0), b2, voffB);
            PG8_BAR; PG8_WAIT_L(0); PG8_MMA(0, 1, At, B1); PG8_BAR;
            PG8_LDA(At, 0, 1); PG8_STAGE(PG8_SA(0, 0), a2, voffA);
            PG8_BAR; PG8_WAIT_L(0); PG8_MMA(1, 0, At, B0); PG8_BAR; PG8_SCHED;
            PG8_STAGE(PG8_SB(0, 1), b2 + hstep, voffB);
            PG8_WAIT_V(6); PG8_BAR; PG8_MMA(1, 1, At, B1); PG8_BAR;
            PG8_LDB(B0, 1, 0); PG8_SCHED; PG8_LDA(At, 1, 0); PG8_STAGE(PG8_SA(0, 1), a2 + hstep, voffA);
            PG8_WAIT_L(8); PG8_BAR; PG8_WAIT_L(0); PG8_MMA(0, 0, At, B0); PG8_BAR; PG8_SCHED;
            PG8_LDB(B1, 1, 1); PG8_STAGE(PG8_SB(1, 0), b3, voffB);
            PG8_BAR; PG8_WAIT_L(0); PG8_MMA(0, 1, At, B1); PG8_BAR;
            PG8_LDA(At, 1, 1); PG8_STAGE(PG8_SA(1, 0), a3, voffA);
            PG8_BAR; PG8_WAIT_L(0); PG8_MMA(1, 0, At, B0); PG8_BAR; PG8_SCHED;
            PG8_STAGE(PG8_SB(1, 1), b3 + hstep, voffB);
            PG8_WAIT_V(6); PG8_BAR; PG8_MMA(1, 1, At, B1); PG8_BAR;
            }
        }
        if constexpr (ALIGN_EPI) { if (wr == 0) PG8_BAR; }
        E(acc, cur, wr, wc, fr, fq); S.done(cur);
        if (!has_next) break;
#pragma unroll
        for (int a = 0; a < 2; ++a)
#pragma unroll
            for (int b = 0; b < 2; ++b)
#pragma unroll
                for (int m = 0; m < 4; ++m)
#pragma unroll
                    for (int n = 0; n < 2; ++n) acc[a][b][m][n] = (f32x4){0.f, 0.f, 0.f, 0.f};
        cur = nxt; cA = nA; cB = nB; ++ui;
        if constexpr (ALIGN_EPI) { if (wr == 1) PG8_BAR; }
    }
    PG8_WAIT_V(0);
    if constexpr (!ALIGN_EPI) { if (wr == 0) PG8_BAR; }
    PG8_BAR;
#undef PG8_SA
#undef PG8_SB
#undef PG8_STAGE
#undef PG8_LDA
#undef PG8_LDB
#undef PG8_MMA
#undef PG8_WAIT_V
#undef PG8_WAIT_L
#undef PG8_BAR
#undef PG8_SCHED
}

struct EpiSwiGLU {
    static constexpr bool PERM = false;
    bf16_t* ACT;
    DEVI void operator()(const f32x4 (&acc)[2][2][4][2], const Unit& u, int wr, int wc, int fr, int fq) const {
#pragma unroll
        for (int ai = 0; ai < 2; ++ai)
#pragma unroll
            for (int m = 0; m < 4; ++m) {
                const int row = u.pm * BM + ai * HALF + wr * 64 + m * 16 + fr;
                bf16_t* rp = ACT + (size_t)row * DFF + 16 * (8 * u.pn + wc) + 4 * fq;
#pragma unroll
                for (int bj = 0; bj < 2; ++bj) {
                    const f32x4 a = acc[ai][bj][m][0], b = acc[ai][bj][m][1];
                    u32x2 pk;
                    pk.x = pk2(a[0] * sigmoidf_(a[0]) * b[0], a[1] * sigmoidf_(a[1]) * b[1]);
                    pk.y = pk2(a[2] * sigmoidf_(a[2]) * b[2], a[3] * sigmoidf_(a[3]) * b[3]);
                    *(u32x2*)(rp + 64 * bj) = pk;
                }
            }
    }
};
struct EpiResid {
    static constexpr bool PERM = false;
    float* X; const float* gate_base; float coef;
    DEVI void operator()(const f32x4 (&acc)[2][2][4][2], const Unit& u, int wr, int wc, int fr, int fq) const {
        const float* gate = gate_base + (size_t)mod_group(u.pm * BM) * 9216;
        const int col0 = u.pn * BM + wc * 32 + 4 * fq;
        f32x4 gv[2][2];
#pragma unroll
        for (int bj = 0; bj < 2; ++bj)
#pragma unroll
            for (int n = 0; n < 2; ++n) gv[bj][n] = *(const f32x4*)(gate + col0 + bj * HALF + 16 * n) * coef;
#pragma unroll
        for (int ai = 0; ai < 2; ++ai)
#pragma unroll
            for (int m = 0; m < 4; ++m) {
                const int row = u.pm * BM + ai * HALF + wr * 64 + m * 16 + fr;
                float* rp = X + (size_t)row * D + col0;
#pragma unroll
                for (int bj = 0; bj < 2; ++bj)
#pragma unroll
                    for (int n = 0; n < 2; ++n) {
                        f32x4* xp = (f32x4*)(rp + bj * HALF + 16 * n);
                        *xp = (*xp) * ALPHA_F + gv[bj][n] * acc[ai][bj][m][n];
                    }
                __builtin_amdgcn_sched_barrier(0);
            }
    }
};
struct EpiIn {
    static constexpr bool PERM = true;
    unsigned char* ws; float* out; const float* b_gate; int l;
    static DEVI u32x4 pack8(const f32x4& a, const f32x4& b, float s) {
        u32x4 w; w.x = pk2(a[0] * s, a[1] * s); w.y = pk2(a[2] * s, a[3] * s); w.z = pk2(b[0] * s, b[1] * s); w.w = pk2(b[2] * s, b[3] * s); return w;
    }
    DEVI void operator()(const f32x4 (&acc)[2][2][4][2], const Unit& u, int wr, int wc, int fr_, int fq_) const {
        int fr = fr_, fq = fq_; asm volatile("" : "+v"(fr), "+v"(fq));
        unsigned char* ws = this->ws; float* out = this->out; const float* b_gate = this->b_gate;
        asm volatile("" : "+s"(ws), "+s"(out), "+s"(b_gate));
        const bool ctx = u.pm * BM < NCTX;
#pragma unroll
        for (int bj = 0; bj < 2; ++bj) {
            const int n0 = u.pn * BM + bj * HALF;
            const int c8 = n0 + wc * 32 + 8 * fq;
            f32x4 bg0 = (f32x4){0.f, 0.f, 0.f, 0.f}, bg1 = bg0;
            if (n0 >= 2816) { bg0 = *(const f32x4*)(b_gate + l * 3072 + c8 - 2816); bg1 = *(const f32x4*)(b_gate + l * 3072 + c8 - 2816 + 4); }
#pragma unroll
            for (int ai = 0; ai < 2; ++ai)
#pragma unroll
                for (int m = 0; m < 4; ++m) {
                    const int row = u.pm * BM + ai * HALF + wr * 64 + m * 16 + fr;
                    const f32x4 v0 = acc[ai][bj][m][0], v1 = acc[ai][bj][m][1];
                    if (n0 < 512) {
                        *(u32x4*)((bf16_t*)(ws + WS_UF) + (size_t)row * 512 + c8) = pack8(v0, v1, 1.f);
                    } else if (n0 < 896) {
                        *(u32x4*)((bf16_t*)(ws + WS_UQ) + (size_t)row * 384 + (c8 - 512)) = pack8(v0, v1, 1.f);
                    } else if (n0 < 1152) {
                        float* o = (float*)(ws + WS_UKV) + (size_t)row * 256 + (c8 - 896);
                        *(f32x4*)o = v0; *(f32x4*)(o + 4) = v1;
                    } else if (n0 < 1280) {
                        if (wc == 0) { float* o = (float*)(ws + WS_KRF) + (size_t)row * 32 + 8 * fq; *(f32x4*)o = v0; *(f32x4*)(o + 4) = v1; }
                    } else if (n0 < 1792) {
                        *(u32x4*)((bf16_t*)(ws + WS_NAQ) + (size_t)row * 512 + (c8 - 1280)) = pack8(v0, v1, NA_QS);
                    } else if (n0 < 2304) {
                        const int cc = c8 - 1792;
                        *(u32x4*)((bf16_t*)(ws + WS_NAK) + (size_t)row * 512 + cc) = pack8(v0, v1, 1.f);
                        if (ctx) { float* o = out + OUT_NAK + ((size_t)((row >> 8) * 4 + l) * 256 + (row & 255)) * 512 + cc; *(f32x4*)o = v0; *(f32x4*)(o + 4) = v1; }
                    } else if (n0 < 2816) {
                        const int cc = c8 - 2304, h = cc >> 6, d0 = cc & 63;
                        bf16_t* VT = (bf16_t*)(ws + WS_NAVT);
                        bf16_t* vp;
                        size_t cstride;
                        if (ctx) {
                            const int b = row >> 8, s = row & 255;
                            float* o = out + OUT_NAV + ((size_t)(b * 4 + l) * 256 + s) * 512 + cc; *(f32x4*)o = v0; *(f32x4*)(o + 4) = v1;
                            vp = VT + ((size_t)((b * 8 + h) * 64 + d0)) * 256 + s; cstride = 256;
                        } else {
                            const int rr = row - NCTX, b = rr >> 11, n = rr & 2047;
                            vp = VT + (size_t)4194304 + ((size_t)((b * 8 + h) * 64 + d0)) * 2048 + n; cstride = 2048;
                        }
#pragma unroll
                        for (int e = 0; e < 4; ++e) { vp[(size_t)e * cstride] = f2bf(v0[e]); vp[(size_t)(4 + e) * cstride] = f2bf(v1[e]); }
                    } else {
                        f32x4 g0, g1;
#pragma unroll
                        for (int e = 0; e < 4; ++e) { g0[e] = sigmoidf_(v0[e] + bg0[e]); g1[e] = sigmoidf_(v1[e] + bg1[e]); }
                        *(u32x4*)((bf16_t*)(ws + WS_GATE) + (size_t)row * 3072 + (c8 - 2816)) = pack8(g0, g1, 1.f);
                    }
                    __builtin_amdgcn_sched_barrier(0);
                }
        }
    }
};
}

DEVI void job_ffn_up(const P& p, unsigned char* ws_b, int l, int which, int t, bf16_t* sm, int tid) {
    const int nN = 44; const int m0 = (t / nN) * 128, n0 = (t % nN) * 128;
    const bf16_t* H = (const bf16_t*)(ws_b + WS_H);
    const bf16_t* W = (const bf16_t*)(ws_b + WS_W) + (size_t)l * LAYER_W + (which ? OFF_W13_2 : OFF_W13_1);
    bf16_t* ACT = (bf16_t*)(ws_b + WS_ACT);
    f32x16 acc[2][2]; zero_acc(acc);
    gemm_core(H + (size_t)m0 * D, D, W + (size_t)n0 * D, D, D, acc, sm, tid);
    EPI_SETUP
    const int oc = (n0 >> 1) + wc * 32 + c32;
#pragma unroll
    for (int i = 0; i < 2; ++i) {
        const int rb = m0 + wr * 64 + i * 32 + 4 * hl;
#pragma unroll
        for (int r = 0; r < 16; ++r) {
            const int row = rb + (r & 3) + 8 * (r >> 2);
            const float a = acc[i][0][r], b = acc[i][1][r];
            const float v = a * sigmoidf_(a) * b;
            ACT[(size_t)row * DFF + oc] = f2bf(v);
        }
    }
}

DEVI void job_resid(const P& p, unsigned char* ws_b, const bf16_t* A, int lda, const bf16_t* Bt, int K, const float* gate_base, float coef, int t, bf16_t* sm, int tid) {
    const int nN = 8; const int m0 = (t / nN) * 128, n0 = (t % nN) * 128;
    float* X = (float*)(ws_b + WS_X);
    f32x16 acc[2][2]; zero_acc(acc);
    gemm_core(A + (size_t)m0 * lda, lda, Bt + (size_t)n0 * K, K, K, acc, sm, tid);
    EPI_SETUP
    const float* gate = gate_base + (size_t)mod_group(m0) * 9216;
#pragma unroll
    for (int j = 0; j < 2; ++j) {
        const int col = n0 + wc * 64 + j * 32 + c32;
        const float gv = coef * gate[col];
#pragma unroll
        for (int i = 0; i < 2; ++i) {
            const int rb = m0 + wr * 64 + i * 32 + 4 * hl;
#pragma unroll
            for (int r = 0; r < 16; ++r) {
                const int row = rb + (r & 3) + 8 * (r >> 2);
                float* xp = X + (size_t)row * D + col;
                *xp = ALPHA_F * (*xp) + gv * acc[i][j][r];
            }
        }
    }
}

DEVI void job_in(const P& p, unsigned char* ws_b, int l, int t, bf16_t* sm, int tid) {
    const int nN = 46; const int m0 = (t / nN) * 128, n0 = (t % nN) * 128;
    const bf16_t* H = (const bf16_t*)(ws_b + WS_H);
    const bf16_t* W = (const bf16_t*)(ws_b + WS_W) + (size_t)l * LAYER_W + OFF_WIN;
    f32x16 acc[2][2]; zero_acc(acc);
    gemm_core(H + (size_t)m0 * D, D, W + (size_t)n0 * D, D, D, acc, sm, tid);
    EPI_SETUP
    const bool ctx = m0 < NCTX;
#pragma unroll
    for (int j = 0; j < 2; ++j) {
        const int col = n0 + wc * 64 + j * 32 + c32;
#pragma unroll
        for (int i = 0; i < 2; ++i) {
            const int rb = m0 + wr * 64 + i * 32 + 4 * hl;
            if (n0 < 512) {
                bf16_t* O = (bf16_t*)(ws_b + WS_UF);
#pragma unroll
                for (int r = 0; r < 16; ++r) O[(size_t)(rb + (r & 3) + 8 * (r >> 2)) * 512 + col] = f2bf(acc[i][j][r]);
            } else if (n0 < 896) {
                bf16_t* O = (bf16_t*)(ws_b + WS_UQ);
#pragma unroll
                for (int r = 0; r < 16; ++r) O[(size_t)(rb + (r & 3) + 8 * (r >> 2)) * 384 + (col - 512)] = f2bf(acc[i][j][r]);
            } else if (n0 < 1152) {
                float* O = (float*)(ws_b + WS_UKV);
#pragma unroll
                for (int r = 0; r < 16; ++r) O[(size_t)(rb + (r & 3) + 8 * (r >> 2)) * 256 + (col - 896)] = acc[i][j][r];
            } else if (n0 < 1280) {
                if (col < 1184) {
                    float* O = (float*)(ws_b + WS_KRF);
#pragma unroll
                    for (int r = 0; r < 16; ++r) O[(size_t)(rb + (r & 3) + 8 * (r >> 2)) * 32 + (col - 1152)] = acc[i][j][r];
                }
            } else if (n0 < 1792) {
                bf16_t* O = (bf16_t*)(ws_b + WS_NAQ);
#pragma unroll
                for (int r = 0; r < 16; ++r) O[(size_t)(rb + (r & 3) + 8 * (r >> 2)) * 512 + (col - 1280)] = f2bf(acc[i][j][r] * NA_QS);
            } else if (n0 < 2304) {
                bf16_t* O = (bf16_t*)(ws_b + WS_NAK);
                const int cc = col - 1792;
#pragma unroll
                for (int r = 0; r < 16; ++r) {
                    const int row = rb + (r & 3) + 8 * (r >> 2);
                    O[(size_t)row * 512 + cc] = f2bf(acc[i][j][r]);
                    if (ctx) p.out[OUT_NAK + ((size_t)((row >> 8) * 4 + l) * 256 + (row & 255)) * 512 + cc] = acc[i][j][r];
                }
            } else if (n0 < 2816) {
                bf16_t* VT = (bf16_t*)(ws_b + WS_NAVT);
                const int cc = col - 2304, h = cc >> 6, d = cc & 63;
#pragma unroll
                for (int qd = 0; qd < 4; ++qd) {
                    const int row = rb + 8 * qd;
                    u32x2 pk; pk.x = pk2(acc[i][j][4 * qd], acc[i][j][4 * qd + 1]); pk.y = pk2(acc[i][j][4 * qd + 2], acc[i][j][4 * qd + 3]);
                    if (ctx) {
                        const int b = row >> 8, s = row & 255;
                        *(u32x2*)(VT + ((size_t)((b * 8 + h) * 64 + d)) * 256 + s) = pk;
#pragma unroll
                        for (int e = 0; e < 4; ++e)
                            p.out[OUT_NAV + ((size_t)(b * 4 + l) * 256 + (s + e)) * 512 + cc] = acc[i][j][4 * qd + e];
                    } else {
                        const int rr = row - NCTX, b = rr >> 11, n = rr & 2047;
                        *(u32x2*)(VT + (size_t)4194304 + ((size_t)((b * 8 + h) * 64 + d)) * 2048 + n) = pk;
                    }
                }
            } else {
                bf16_t* O = (bf16_t*)(ws_b + WS_GATE);
                const int gc = col - 2816;
                const float bg = pin(p, 26)[l * 3072 + gc];
                bf16_t* gp = O + (size_t)gc * M + rb;
#pragma unroll
                for (int qd = 0; qd < 4; ++qd) {
                    u32x2 pk;
                    pk.x = pk2(sigmoidf_(acc[i][j][4 * qd] + bg), sigmoidf_(acc[i][j][4 * qd + 1] + bg));
                    pk.y = pk2(sigmoidf_(acc[i][j][4 * qd + 2] + bg), sigmoidf_(acc[i][j][4 * qd + 3] + bg));
                    *(u32x2*)(gp + 8 * qd) = pk;
                }
            }
        }
    }
}

DEVI void job_uq(const P& p, unsigned char* ws_b, int l, int t, bf16_t* sm, int tid) {
    const int nN = 6; const int m0 = (t / nN) * 128, n0 = (t % nN) * 128;
    const bf16_t* A = (const bf16_t*)(ws_b + WS_UQ);
    const bf16_t* W = (const bf16_t*)(ws_b + WS_W) + (size_t)l * LAYER_W + OFF_WUQ;
    bf16_t* Q = (bf16_t*)(ws_b + WS_Q);
    const float* ropec = (const float*)(ws_b + WS_ROPE);
    const float* ropes = ropec + 512;
    f32x16 acc[2][2]; zero_acc(acc);
    gemm_core(A + (size_t)m0 * 384, 384, W + (size_t)n0 * 384, 384, 384, acc, sm, tid);
    EPI_SETUP
    const bool lat = m0 >= NCTX;
#pragma unroll
    for (int j = 0; j < 2; ++j) {
        const int c0 = n0 + wc * 64 + j * 32;
        const int col = c0 + c32;
        const bool rope = lat && (((c0 >> 5) % 3) == 2);
        const int axis = c32 >> 4, ii = c32 & 15;
#pragma unroll
        for (int i = 0; i < 2; ++i) {
            const int rb = m0 + wr * 64 + i * 32 + 4 * hl;
#pragma unroll
            for (int r = 0; r < 16; ++r) {
                const int row = rb + (r & 3) + 8 * (r >> 2);
                float v = acc[i][j][r];
                const float pr = __shfl_xor(v, 8);
                if (rope) {
                    const int n = (row - NCTX) & 2047;
                    const int pos = axis ? (n & 63) : (n >> 6);
                    const float cs = ropec[pos * 8 + (ii & 7)], sn = ropes[pos * 8 + (ii & 7)];
                    const float rot = (ii < 8) ? -pr : pr;
                    v = v * cs + rot * sn;
                }
                Q[(size_t)row * 768 + col] = f2bf(v * MLA_QS);
            }
        }
    }
}

DEVI void job_ukv(const P& p, unsigned char* ws_b, int l, int t, bf16_t* sm, int tid) {
    const int nN = 8; const int m0 = (t / nN) * 128, h = t % nN, n0 = h * 128;
    const bf16_t* A = (m0 < M) ? (const bf16_t*)(ws_b + WS_CKV) + (size_t)m0 * 256
                               : (const bf16_t*)(ws_b + WS_CCKV) + ((size_t)l * 1024 + (m0 - M)) * 256;
    const bf16_t* W = (const bf16_t*)(ws_b + WS_W) + (size_t)l * LAYER_W + OFF_WUKV;
    bf16_t* KN = (bf16_t*)(ws_b + WS_KN);
    bf16_t* VT = (bf16_t*)(ws_b + WS_VTM);
    f32x16 acc[2][2]; zero_acc(acc);
    gemm_core(A, 256, W + (size_t)n0 * 256, 256, 256, acc, sm, tid);
    EPI_SETUP
#pragma unroll
    for (int j = 0; j < 2; ++j) {
        const int d = j * 32 + c32;
#pragma unroll
        for (int i = 0; i < 2; ++i) {
            const int rb = m0 + wr * 64 + i * 32 + 4 * hl;
            if (wc == 0) {
#pragma unroll
                for (int r = 0; r < 16; ++r) KN[(size_t)(rb + (r & 3) + 8 * (r >> 2)) * 512 + h * 64 + d] = f2bf(acc[i][j][r]);
            } else {
#pragma unroll
                for (int qd = 0; qd < 4; ++qd) {
                    const int row = rb + 8 * qd;
                    u32x2 pk; pk.x = pk2(acc[i][j][4 * qd], acc[i][j][4 * qd + 1]); pk.y = pk2(acc[i][j][4 * qd + 2], acc[i][j][4 * qd + 3]);
                    size_t addr;
                    if (m0 < NCTX) { const int b = row >> 8, s = row & 255; addr = ((size_t)((b * 8 + h) * 64 + d)) * 256 + s; }
                    else if (m0 < M) { const int rr = row - NCTX, b = rr >> 11, n = rr & 2047; addr = (size_t)4194304 + ((size_t)((b * 8 + h) * 64 + d)) * 2560 + n; }
                    else { const int rr = row - M, b = rr >> 9, n = rr & 511; addr = (size_t)4194304 + ((size_t)((b * 8 + h) * 64 + d)) * 2560 + 2048 + n; }
                    *(u32x2*)(VT + addr) = pk;
                }
            }
        }
    }
}

template <int ldo>
DEVI void job_store(const bf16_t* A, int lda, const bf16_t* Bt, int ldb, int K, bf16_t* Out, bf16_t* sm, int tid) {
    f32x16 acc[2][2]; zero_acc(acc);
    gemm_core(A, lda, Bt, ldb, K, acc, sm, tid);
    EPI_SETUP
    bf16_t* st = sm + (wr * 64 + 4 * hl) * 136 + wc * 64 + c32;
#pragma unroll
    for (int i = 0; i < 2; ++i)
#pragma unroll
        for (int j = 0; j < 2; ++j)
#pragma unroll
            for (int r = 0; r < 16; ++r) st[(i * 32 + (r & 3) + 8 * (r >> 2)) * 136 + j * 32] = f2bf(acc[i][j][r]);
    __syncthreads();
    const int orow = tid >> 4, oc = (tid & 15) * 8;
#pragma unroll
    for (int k = 0; k < 8; ++k) {
        const u32x4 v = *(const u32x4*)(sm + (orow + 16 * k) * 136 + oc);
        *(u32x4*)(Out + (size_t)(orow + 16 * k) * ldo + oc) = v;
    }
    __syncthreads();
}

DEVI void job_f1(const P& p, unsigned char* ws_b, int t, bf16_t* sm, int tid) {
    const bf16_t* WCS = (const bf16_t*)(ws_b + WS_WCS);
    const bf16_t* UF = (const bf16_t*)(ws_b + WS_UF);
    bf16_t* F1T = (bf16_t*)(ws_b + WS_F1T);
    if (t < 512) {
        const int bs = t >> 4, g = (t >> 2) & 3, mi = (t >> 1) & 1, ni = t & 1;
        job_store<256>(WCS + mi * 128 * 128, 128, UF + ((size_t)bs * 256 + ni * 128) * 512 + g * 128, 512, 128,
                  F1T + ((size_t)(bs * 4 + g) * 256 + mi * 128) * 256 + ni * 128, sm, tid);
    } else {
        t -= 512;
        const int bs = t >> 7, g = (t >> 5) & 3, mi = (t >> 4) & 1, ni = t & 15;
        job_store<2048>(WCS + mi * 128 * 128, 128, UF + ((size_t)NCTX + bs * 2048 + ni * 128) * 512 + g * 128, 512, 128,
                  F1T + (size_t)8388608 + ((size_t)(bs * 4 + g) * 256 + mi * 128) * 2048 + ni * 128, sm, tid);
    }
}
DEVI void job_f2_lat(const P& p, unsigned char* ws_b, int t, bf16_t* sm, int tid) {
    const int bs = t >> 6, mi = (t >> 2) & 15, ni = t & 3;
    const bf16_t* TAB = (const bf16_t*)(ws_b + WS_TABL);
    const bf16_t* F1T = (const bf16_t*)(ws_b + WS_F1T) + (size_t)8388608;
    bf16_t* YF = (bf16_t*)(ws_b + WS_YF);
    job_store<512>(TAB + (size_t)mi * 128 * 4096, 4096, F1T + (size_t)bs * 512 * 4096 + (size_t)ni * 128 * 4096, 4096, 4096,
              YF + ((size_t)NCTX + bs * 2048 + mi * 128) * 512 + ni * 128, sm, tid);
}
DEVI void job_f2_ctx(const P& p, unsigned char* ws_b, int t, bf16_t* sm, int tid) {
    const int bs = t >> 3, mi = (t >> 2) & 1, ni = t & 3;
    const bf16_t* TAB = (const bf16_t*)(ws_b + WS_TABC);
    const bf16_t* F1T = (const bf16_t*)(ws_b + WS_F1T);
    bf16_t* YF = (bf16_t*)(ws_b + WS_YF);
    job_store<512>(TAB + (size_t)mi * 128 * 512, 512, F1T + (size_t)bs * 512 * 512 + (size_t)ni * 128 * 512, 512, 512,
              YF + ((size_t)bs * 256 + mi * 128) * 512 + ni * 128, sm, tid);
}

DEVI void job_merge(const P& p, unsigned char* ws_b, int l, int t, bf16_t* sm, int tid) {
    const int nN = 8; const int m0 = (t / nN) * 128, n0 = (t % nN) * 128;
    const bf16_t* Wl = (const bf16_t*)(ws_b + WS_W) + (size_t)l * LAYER_W;
    const bf16_t* GATE = (const bf16_t*)(ws_b + WS_GATE);
    bf16_t* MG = (bf16_t*)(ws_b + WS_MERGED);
    EPI_SETUP
    f32x16 acc[2][2]; zero_acc(acc);
#pragma unroll 1
    for (int s = 0; s < 3; ++s) {
        const bf16_t* A = (const bf16_t*)(ws_b + (s == 0 ? WS_YF : (s == 1 ? WS_YM : WS_YN)));
        const bf16_t* W = Wl + (s == 0 ? OFF_WBF : (s == 1 ? OFF_WBM : OFF_WBN));
        gemm_core<false>(A + (size_t)m0 * 512, 512, W + (size_t)n0 * 512, 512, 512, acc, sm, tid);
        {
            const int gr = tid >> 4, gc = (tid & 15) * 8;
            const int s1 = s < 2 ? s + 1 : s;
#pragma unroll
            for (int k = 0; k < 8; ++k) {
                const bf16_t* gsrc = GATE + (size_t)(m0 + gr + 16 * k) * 3072 + n0 + gc;
                *(u32x4*)(sm + (gr + 16 * k) * 136 + gc) = *(const u32x4*)(gsrc + s * 1024);
                *(u32x4*)(sm + 128 * 136 + (gr + 16 * k) * 136 + gc) = *(const u32x4*)(gsrc + s1 * 1024);
                if ((k & 1) == 1) __builtin_amdgcn_sched_barrier(0);
            }
        }
        __syncthreads();
#pragma unroll
        for (int j = 0; j < 2; ++j)
#pragma unroll
            for (int i = 0; i < 2; ++i) {
                const bf16_t* gp = sm + (wr * 64 + i * 32 + 4 * hl) * 136 + wc * 64 + j * 32 + c32;
#pragma unroll
                for (int r = 0; r < 16; ++r) {
                    const int o = ((r & 3) + 8 * (r >> 2)) * 136;
                    const float g = bf2f(gp[o]);
                    const float f = (s < 2) ? g * __builtin_amdgcn_rcpf(bf2f(gp[128 * 136 + o])) : g;
                    acc[i][j][r] *= f;
                }
            }
        __syncthreads();
    }
#pragma unroll
    for (int j = 0; j < 2; ++j) {
        const int col = n0 + wc * 64 + j * 32 + c32;
#pragma unroll
        for (int i = 0; i < 2; ++i) {
            const int rb = m0 + wr * 64 + i * 32 + 4 * hl;
#pragma unroll
            for (int r = 0; r < 16; ++r) MG[(size_t)(rb + (r & 3) + 8 * (r >> 2)) * 1024 + col] = f2bf(acc[i][j][r]);
        }
    }
}

struct TileSrc { const bf16_t* k; const bf16_t* k2; const bf16_t* v; const bf16_t* vhi; };
DEVI int pi_row(int r) { return (r & 0x13) | ((r & 4) << 1) | ((r & 8) >> 1); }

template <int NKS>
DEVI void attn_load(const TileSrc& s, bf16x8 (&kf)[NKS], bf16x8 (&vf)[4]) {
#pragma unroll
    for (int ks = 0; ks < NKS; ++ks) kf[ks] = (ks < 4) ? *(const bf16x8*)(s.k + ks * 16) : *(const bf16x8*)(s.k2 + (ks - 4) * 16);
    vf[0] = *(const bf16x8*)(s.v);
    vf[1] = *(const bf16x8*)(s.v + 16);
    vf[2] = *(const bf16x8*)(s.vhi);
    vf[3] = *(const bf16x8*)(s.vhi + 16);
}

template <int NKS, class Src, class Mask>
DEVI void attn_wave(const bf16_t* qptr, int nt, Src src, Mask mask, bf16_t* optr, int lane) {
    bf16x8 q[NKS];
#pragma unroll
    for (int ks = 0; ks < NKS; ++ks) q[ks] = *(const bf16x8*)(qptr + ks * 16);
    f32x16 o0, o1;
#pragma unroll
    for (int r = 0; r < 16; ++r) { o0[r] = 0.f; o1[r] = 0.f; }
    float m = -1e30f, lsum = 0.f;
    bf16x8 kf[NKS], vf[4];
    { TileSrc s0 = src(0); attn_load<NKS>(s0, kf, vf); }
    for (int t = 0; t < nt; ++t) {
        bf16x8 kn[NKS], vn[4];
        { TileSrc s1 = src(t + 1 < nt ? t + 1 : t); attn_load<NKS>(s1, kn, vn); }
        f32x16 s;
#pragma unroll
        for (int r = 0; r < 16; ++r) s[r] = 0.f;
#pragma unroll
        for (int ks = 0; ks < NKS; ++ks) s = __builtin_amdgcn_mfma_f32_32x32x16_bf16(kf[ks], q[ks], s, 0, 0, 0);
        mask(t, s);
        float mx = s[0];
#pragma unroll
        for (int r = 1; r < 16; ++r) mx = fmaxf(mx, s[r]);
        mx = fmaxf(mx, __shfl_xor(mx, 32));
        const float mn = fmaxf(m, mx);
        const float alpha = fast_exp2(m - mn);
        m = mn;
        float rs = 0.f;
#pragma unroll
        for (int r = 0; r < 16; ++r) { s[r] = fast_exp2(s[r] - mn); rs += s[r]; }
        lsum = lsum * alpha + rs;
#pragma unroll
        for (int r = 0; r < 16; ++r) { o0[r] *= alpha; o1[r] *= alpha; }
        bf16x8 p0, p1;
        {
            u32x4 a, b;
            a.x = pk2(s[0], s[1]); a.y = pk2(s[2], s[3]); a.z = pk2(s[4], s[5]); a.w = pk2(s[6], s[7]);
            b.x = pk2(s[8], s[9]); b.y = pk2(s[10], s[11]); b.z = pk2(s[12], s[13]); b.w = pk2(s[14], s[15]);
            p0 = __builtin_bit_cast(bf16x8, a); p1 = __builtin_bit_cast(bf16x8, b);
        }
        o0 = __builtin_amdgcn_mfma_f32_32x32x16_bf16(vf[0], p0, o0, 0, 0, 0);
        o0 = __builtin_amdgcn_mfma_f32_32x32x16_bf16(vf[1], p1, o0, 0, 0, 0);
        o1 = __builtin_amdgcn_mfma_f32_32x32x16_bf16(vf[2], p0, o1, 0, 0, 0);
        o1 = __builtin_amdgcn_mfma_f32_32x32x16_bf16(vf[3], p1, o1, 0, 0, 0);
#pragma unroll
        for (int ks = 0; ks < NKS; ++ks) kf[ks] = kn[ks];
#pragma unroll
        for (int x = 0; x < 4; ++x) vf[x] = vn[x];
    }
    lsum += __shfl_xor(lsum, 32);
    const float inv = 1.f / lsum;
    const int hl = lane >> 5;
#pragma unroll
    for (int qd = 0; qd < 4; ++qd) {
        u32x2 a, b;
        a.x = pk2(o0[4 * qd] * inv, o0[4 * qd + 1] * inv); a.y = pk2(o0[4 * qd + 2] * inv, o0[4 * qd + 3] * inv);
        b.x = pk2(o1[4 * qd] * inv, o1[4 * qd + 1] * inv); b.y = pk2(o1[4 * qd + 2] * inv, o1[4 * qd + 3] * inv);
        *(u32x2*)(optr + 8 * qd + 4 * hl) = a;
        *(u32x2*)(optr + 32 + 8 * qd + 4 * hl) = b;
    }
}

struct NoMask { DEVI void operator()(int, f32x16&) const {} };

DEVI void attn_mla(const P& p, unsigned char* ws_b, int l, bool lat, int b, int h, int qg, int lane) {
    const int hl = lane >> 5, c32 = lane & 31, pr = pi_row(c32);
    const bf16_t* Q = (const bf16_t*)(ws_b + WS_Q);
    const bf16_t* KN = (const bf16_t*)(ws_b + WS_KN);
    const bf16_t* KR = (const bf16_t*)(ws_b + WS_KR);
    const bf16_t* CKR = (const bf16_t*)(ws_b + WS_CKR) + (size_t)l * 1024 * 32;
    const bf16_t* VT = (const bf16_t*)(ws_b + WS_VTM);
    bf16_t* YM = (bf16_t*)(ws_b + WS_YM);
    if (!lat) {
        const int row0 = b * 256;
        const int qrow = row0 + qg * 32 + c32;
        const bf16_t* k0 = KN + (size_t)(row0 + pr) * 512 + h * 64 + hl * 8;
        const bf16_t* r0 = KR + (size_t)(row0 + pr) * 32 + hl * 8;
        const bf16_t* v0 = VT + ((size_t)((b * 8 + h) * 64 + c32)) * 256 + hl * 8;
        auto src = [=](int t) { TileSrc s; s.k = k0 + (size_t)t * 32 * 512; s.k2 = r0 + (size_t)t * 32 * 32; s.v = v0 + t * 32; s.vhi = s.v + 32 * 256; return s; };
        attn_wave<6>(Q + (size_t)qrow * 768 + h * 96 + hl * 8, 8, src, NoMask(), YM + (size_t)qrow * 512 + h * 64, lane);
    } else {
        const int row0 = NCTX + b * 2048;
        const int qrow = row0 + qg * 32 + c32;
        const bf16_t* k0 = KN + (size_t)(row0 + pr) * 512 + h * 64 + hl * 8;
        const bf16_t* r0 = KR + (size_t)(row0 + pr) * 32 + hl * 8;
        const bf16_t* k1 = KN + (size_t)(M + b * 512 + pr) * 512 + h * 64 + hl * 8;
        const bf16_t* r1 = CKR + (size_t)(b * 512 + pr) * 32 + hl * 8;
        const bf16_t* v0 = VT + (size_t)4194304 + ((size_t)((b * 8 + h) * 64 + c32)) * 2560 + hl * 8;
        auto src = [=](int t) {
            TileSrc s;
            if (t < 64) { s.k = k0 + (size_t)t * 32 * 512; s.k2 = r0 + (size_t)t * 32 * 32; }
            else { s.k = k1 + (size_t)(t - 64) * 32 * 512; s.k2 = r1 + (size_t)(t - 64) * 32 * 32; }
            s.v = v0 + t * 32; s.vhi = s.v + 32 * 2560; return s; };
        attn_wave<6>(Q + (size_t)qrow * 768 + h * 96 + hl * 8, 80, src, NoMask(), YM + (size_t)qrow * 512 + h * 64, lane);
    }
}

DEVI void attn_na_ctx(const P& p, unsigned char* ws_b, int b, int h, int qg, int lane) {
    const int hl = lane >> 5, c32 = lane & 31, pr = pi_row(c32);
    const bf16_t* Qn = (const bf16_t*)(ws_b + WS_NAQ);
    const bf16_t* Kn = (const bf16_t*)(ws_b + WS_NAK);
    const bf16_t* VT = (const bf16_t*)(ws_b + WS_NAVT);
    bf16_t* YN = (bf16_t*)(ws_b + WS_YN);
    const int row0 = b * 256, qrow = row0 + qg * 32 + c32;
    const bf16_t* k0 = Kn + (size_t)(row0 + pr) * 512 + h * 64 + hl * 8;
    const bf16_t* v0 = VT + ((size_t)((b * 8 + h) * 64 + c32)) * 256 + hl * 8;
    auto src = [=](int t) { TileSrc s; s.k = k0 + (size_t)t * 32 * 512; s.k2 = s.k; s.v = v0 + t * 32; s.vhi = s.v + 32 * 256; return s; };
    attn_wave<4>(Qn + (size_t)qrow * 512 + h * 64 + hl * 8, 8, src, NoMask(), YN + (size_t)qrow * 512 + h * 64, lane);
}

struct NaMask {
    const float* rpb;
    int rs, rq, qc, hl;
    DEVI void operator()(int t, f32x16& s) const {
        if (t >= 16) return;
        const int kr = t >> 1, kh = t & 1;
        const int cs = min(max(qc - 8, 0), 48);
        const float* rp = rpb + (rs + kr - rq + 7) * 31;
#pragma unroll
        for (int r = 0; r < 16; ++r) {
            const int kk = (r & 3) + 4 * ((r >> 2) & 1) + 8 * hl + 16 * (r >> 3);
            const int kc = kh * 32 + kk;
            const bool ok = (kc >= cs) && (kc < cs + 16);
            const int dc = min(max(kc - qc + 15, 0), 30);
            const float bias = rp[dc] * LOG2E;
            s[r] = ok ? s[r] + bias : -1e30f;
        }
    }
};
DEVI void attn_na_lat(const P& p, unsigned char* ws_b, int l, int b, int h, int rq, int qh, int lane) {
    const int hl = lane >> 5, c32 = lane & 31, pr = pi_row(c32);
    const bf16_t* Qn = (const bf16_t*)(ws_b + WS_NAQ);
    const bf16_t* Kn = (const bf16_t*)(ws_b + WS_NAK);
    const bf16_t* VT = (const bf16_t*)(ws_b + WS_NAVT) + (size_t)4194304;
    const bf16_t* CK = (const bf16_t*)(ws_b + WS_CNAK) + (size_t)l * 1024 * 512;
    const bf16_t* CV = (const bf16_t*)(ws_b + WS_CNAVT) + (size_t)l * 1024 * 512;
    bf16_t* YN = (bf16_t*)(ws_b + WS_YN);
    const int row0 = NCTX + b * 2048;
    const int qrow = row0 + rq * 64 + qh * 32 + c32;
    const int rs = min(max(rq - 4, 0), 24);
    const bf16_t* k0 = Kn + (size_t)(row0 + rs * 64 + pr) * 512 + h * 64 + hl * 8;
    const bf16_t* v0 = VT + ((size_t)((b * 8 + h) * 64 + c32)) * 2048 + rs * 64 + hl * 8;
    const bf16_t* k1 = CK + (size_t)(b * 512 + pr) * 512 + h * 64 + hl * 8;
    const bf16_t* v1 = CV + ((size_t)((b * 8 + h) * 64 + c32)) * 512 + hl * 8;
    auto src = [=](int t) {
        TileSrc s;
        if (t < 16) { s.k = k0 + (size_t)t * 32 * 512; s.v = v0 + t * 32; s.vhi = s.v + 32 * 2048; }
        else { s.k = k1 + (size_t)(t - 16) * 32 * 512; s.v = v1 + (t - 16) * 32; s.vhi = s.v + 32 * 512; }
        s.k2 = s.k; return s; };
    NaMask mk; mk.rpb = pin(p, 21) + (size_t)(l * 8 + h) * 15 * 31; mk.rs = rs; mk.rq = rq; mk.qc = qh * 32 + c32; mk.hl = hl;
    attn_wave<4>(Qn + (size_t)qrow * 512 + h * 64 + hl * 8, 32, src, mk, YN + (size_t)qrow * 512 + h * 64, lane);
}

DEVI void row_ln_mod(const float* src, float* xdst, bf16_t* hdst, const float* lng, const float* lnb, const float* shift, const float* scale, int lane) {
    f32x4 v[4];
#pragma unroll
    for (int j = 0; j < 4; ++j) v[j] = *(const f32x4*)(src + 4 * lane + 256 * j);
    if (lng) {
        float s = 0.f;
#pragma unroll
        for (int j = 0; j < 4; ++j) s += (v[j].x + v[j].y) + (v[j].z + v[j].w);
        const float mu = wave_sum(s) * (1.f / D);
        float q = 0.f;
#pragma unroll
        for (int j = 0; j < 4; ++j) { v[j] = v[j] - mu; q += (v[j].x * v[j].x + v[j].y * v[j].y) + (v[j].z * v[j].z + v[j].w * v[j].w); }
        const float rstd = rsqrtf(wave_sum(q) * (1.f / D) + 1e-5f);
#pragma unroll
        for (int j = 0; j < 4; ++j) {
            const f32x4 g = *(const f32x4*)(lng + 4 * lane + 256 * j), bb = *(const f32x4*)(lnb + 4 * lane + 256 * j);
            v[j] = v[j] * rstd * g + bb;
        }
    }
    if (xdst) {
#pragma unroll
        for (int j = 0; j < 4; ++j) *(f32x4*)(xdst + 4 * lane + 256 * j) = v[j];
    }
    if (hdst) {
        float s = 0.f;
#pragma unroll
        for (int j = 0; j < 4; ++j) s += (v[j].x + v[j].y) + (v[j].z + v[j].w);
        const float mu = wave_sum(s) * (1.f / D);
        float q = 0.f;
#pragma unroll
        for (int j = 0; j < 4; ++j) { v[j] = v[j] - mu; q += (v[j].x * v[j].x + v[j].y * v[j].y) + (v[j].z * v[j].z + v[j].w * v[j].w); }
        const float rstd = rsqrtf(wave_sum(q) * (1.f / D) + 1e-6f);
#pragma unroll
        for (int j = 0; j < 4; ++j) {
            const f32x4 sc = *(const f32x4*)(scale + 4 * lane + 256 * j), sh = *(const f32x4*)(shift + 4 * lane + 256 * j);
            const f32x4 o = v[j] * rstd * (sc + 1.f) + sh;
            u32x2 pk; pk.x = pk2(o.x, o.y); pk.y = pk2(o.z, o.w);
            *(u32x2*)(hdst + 4 * lane + 256 * j) = pk;
        }
    }
}

DEVI void phase_rows(const P& p, unsigned char* ws_b, int l, int lnidx, int ml, int ms, bool final_, int gw, int ngw, int lane) {
    float* X = (float*)(ws_b + WS_X);
    bf16_t* H = (bf16_t*)(ws_b + WS_H);
    const float* MOD = (const float*)(ws_b + WS_MOD);
    for (int row = gw; row < M; row += ngw) {
        const float* src = (lnidx < 0) ? (row < NCTX ? pin(p, 0) + (size_t)row * D : pin(p, 1) + (size_t)(row - NCTX) * D) : X + (size_t)row * D;
        const float* lng = (lnidx < 0) ? nullptr : pin(p, 28) + (size_t)(l * 3 + lnidx) * D;
        const float* lnb = (lnidx < 0) ? nullptr : pin(p, 29) + (size_t)(l * 3 + lnidx) * D;
        if (final_) { row_ln_mod(src, p.out + (size_t)row * D, nullptr, lng, lnb, nullptr, nullptr, lane); continue; }
        const float* mb = MOD + ((size_t)ml * 3 + mod_group(row)) * 9216;
        row_ln_mod(src, X + (size_t)row * D, H + (size_t)row * D, lng, lnb, mb + ms * D, mb + (ms + 1) * D, lane);
    }
}

DEVI void phase_rowmix(const P& p, unsigned char* ws_b, int l, int gw, int ngw, int lane) {
    bf16_t* UQ = (bf16_t*)(ws_b + WS_UQ);
    const float* UKV = (const float*)(ws_b + WS_UKV);
    const float* KRF = (const float*)(ws_b + WS_KRF);
    bf16_t* CKV = (bf16_t*)(ws_b + WS_CKV);
    bf16_t* KR = (bf16_t*)(ws_b + WS_KR);
    const float* ropec = (const float*)(ws_b + WS_ROPE);
    const float* ropes = ropec + 512;
    const float* gq = pin(p, 17) + l * 384;
    const float* gkv = pin(p, 19) + l * 256;
    for (int row = gw; row < M; row += ngw) {
        {
            unsigned* up = (unsigned*)(UQ + (size_t)row * 384) + lane;
            float x[6]; float ss = 0.f;
#pragma unroll
            for (int j = 0; j < 3; ++j) { const unsigned w = up[64 * j]; x[2 * j] = bf2f(w & 0xffffu); x[2 * j + 1] = bf2f(w >> 16); ss += x[2 * j] * x[2 * j] + x[2 * j + 1] * x[2 * j + 1]; }
            const float rs = rsqrtf(wave_sum(ss) * (1.f / 384.f) + 1e-6f);
#pragma unroll
            for (int j = 0; j < 3; ++j) { const int c = 2 * lane + 128 * j; up[64 * j] = pk2(x[2 * j] * rs * gq[c], x[2 * j + 1] * rs * gq[c + 1]); }
        }
        {
            const f32x4 v = *(const f32x4*)(UKV + (size_t)row * 256 + 4 * lane);
            const float ss = v.x * v.x + v.y * v.y + v.z * v.z + v.w * v.w;
            const float rs = rsqrtf(wave_sum(ss) * (1.f / 256.f) + 1e-6f);
            const f32x4 g = *(const f32x4*)(gkv + 4 * lane);
            const f32x4 o = v * rs * g;
            u32x2 pk; pk.x = pk2(o.x, o.y); pk.y = pk2(o.z, o.w);
            *(u32x2*)(CKV + (size_t)row * 256 + 4 * lane) = pk;
            if (row < NCTX) *(f32x4*)(p.out + OUT_CKV + ((size_t)((row >> 8) * 4 + l) * 256 + (row & 255)) * 256 + 4 * lane) = o;
        }
        {
            const float v = KRF[(size_t)row * 32 + (lane & 31)];
            const float pr = __shfl_xor(v, 8);
            float o = v;
            if (row >= NCTX) {
                const int c = lane & 31, axis = c >> 4, ii = c & 15, n = (row - NCTX) & 2047;
                const int pos = axis ? (n & 63) : (n >> 6);
                const float rot = (ii < 8) ? -pr : pr;
                o = v * ropec[pos * 8 + (ii & 7)] + rot * ropes[pos * 8 + (ii & 7)];
            }
            if (lane < 32) {
                KR[(size_t)row * 32 + lane] = f2bf(o);
                if (row < NCTX) p.out[OUT_KR + ((size_t)((row >> 8) * 4 + l) * 256 + (row & 255)) * 32 + lane] = v;
            }
        }
    }
}

DEVI void transpose_item(const float* __restrict__ src, int N, int c0, int k0, bf16_t* __restrict__ dst, int K, float* scr, int lane) {
#pragma unroll 8
    for (int i = 0; i < 32; ++i) { const int kk = 2 * i + (lane >> 5); scr[kk * 33 + (lane & 31)] = src[(size_t)(k0 + kk) * N + c0 + (lane & 31)]; }
    asm volatile("s_waitcnt lgkmcnt(0)" ::: "memory");
    const int c = lane & 7;
#pragma unroll
    for (int j = 0; j < 4; ++j) {
        const int n = (lane >> 3) + 8 * j; const float* s = scr + (8 * c) * 33 + n;
        u32x4 o; o.x = pk2(s[0], s[33]); o.y = pk2(s[2 * 33], s[3 * 33]); o.z = pk2(s[4 * 33], s[5 * 33]); o.w = pk2(s[6 * 33], s[7 * 33]);
        *(u32x4*)(dst + (size_t)n * K + k0 + 8 * c) = o;
    }
    asm volatile("s_waitcnt lgkmcnt(0)" ::: "memory");
}

DEVI void prep_weight_item(const P& p, unsigned char* ws_b, int item, float* scr, int lane) {
    const int l = item / 12944; int r = item % 12944;
    bf16_t* Wl = (bf16_t*)(ws_b + WS_W) + (size_t)l * LAYER_W;
    if (r < 8448) {
        const int which = r / 4224; r %= 4224;
        if (r < 2816) {
            const int rb = r >> 4, kb = r & 15;
            const float* src = ((lane & 16) ? (which ? pin(p, 14) : pin(p, 11)) : (which ? pin(p, 13) : pin(p, 10))) + (size_t)l * D * DFF;
            transpose_item(src, DFF, rb * 16 - (lane & 16), kb * 64, Wl + (which ? OFF_W13_2 : OFF_W13_1) + (size_t)rb * 32 * D, D, scr, lane);
        } else {
            r -= 2816; const int rb = r / 44, kb = r % 44;
            const float* src = (which ? pin(p, 15) : pin(p, 12)) + (size_t)l * DFF * D;
            transpose_item(src, D, rb * 32, kb * 64, Wl + (which ? OFF_W2_2 : OFF_W2_1) + (size_t)rb * 32 * DFF, DFF, scr, lane);
        }
        return;
    }
    r -= 8448;
    if (r < 2944) {
        const int rb = r >> 4, kb = r & 15, R0 = rb * 32;
        const float* src; int N, c0;
        if (R0 < 1184) { src = pin(p, 16) + (size_t)l * D * 2720; N = 2720; c0 = R0; }
        else if (R0 < 1280) return;
        else if (R0 < 2816) { src = pin(p, 16) + (size_t)l * D * 2720; N = 2720; c0 = R0 - 96; }
        else { src = pin(p, 25) + (size_t)l * D * 3072; N = 3072; c0 = R0 - 2816; }
        transpose_item(src, N, c0, kb * 64, Wl + OFF_WIN + (size_t)R0 * D, D, scr, lane);
        return;
    }
    r -= 2944;
    if (r < 512) { const int rb = r >> 4, kb = r & 15; transpose_item(pin(p, 27) + (size_t)l * D * D, D, rb * 32, kb * 64, Wl + OFF_WOUT + (size_t)rb * 32 * D, D, scr, lane); return; }
    r -= 512;
    if (r < 768) { const int w = r >> 8; r &= 255; const int rb = r >> 3, kb = r & 7;
        transpose_item((w == 0 ? pin(p, 22) : (w == 1 ? pin(p, 23) : pin(p, 24))) + (size_t)l * 512 * D, D, rb * 32, kb * 64, Wl + (w == 0 ? OFF_WBF : (w == 1 ? OFF_WBM : OFF_WBN)) + (size_t)rb * 32 * 512, 512, scr, lane); return; }
    r -= 768;
    if (r < 144) { const int rb = r / 6, kb = r % 6; transpose_item(pin(p, 18) + (size_t)l * 384 * 768, 768, rb * 32, kb * 64, Wl + OFF_WUQ + (size_t)rb * 32 * 384, 384, scr, lane); return; }
    r -= 144;
    { const int rb = r >> 2, kb = r & 3; transpose_item(pin(p, 20) + (size_t)l * 256 * 1024, 1024, rb * 32, kb * 64, Wl + OFF_WUKV + (size_t)rb * 32 * 256, 256, scr, lane); }
}

DEVI void phase_prep(const P& p, unsigned char* ws_b, unsigned char* smem, int tid) {
    const int lane = tid & 63, wave = tid >> 6;
    const int gw = blockIdx.x * NWAVES + wave, ngw = gridDim.x * NWAVES;
    const size_t gt = (size_t)blockIdx.x * NTHREADS + tid, ngt = (size_t)gridDim.x * NTHREADS;
    {
        float* sil = (float*)smem;
        const float* wada = pin(p, 8);
        float* MODP = (float*)(ws_b + WS_MODP);
        for (int item = blockIdx.x; item < 1152; item += gridDim.x) {
            const int l = item / 288, rem = item % 288, kc = rem / 18, cb = rem % 18;
            __syncthreads();
            if (tid < 192) {
                const int g = tid >> 6, k = kc * 64 + (tid & 63);
                const float cv = (g == 0) ? pin(p, 7)[k] : pin(p, 6)[(g - 1) * D + k];
                sil[tid] = cv * sigmoidf_(cv);
            }
            __syncthreads();
            const int col = cb * NTHREADS + tid;
            const float* w = wada + ((size_t)l * D + kc * 64) * 9216 + col;
            float a0 = 0.f, a1 = 0.f, a2 = 0.f;
#pragma unroll 16
            for (int k = 0; k < 64; ++k) { const float wv = w[(size_t)k * 9216]; a0 += sil[k] * wv; a1 += sil[64 + k] * wv; a2 += sil[128 + k] * wv; }
            float* o = MODP + ((size_t)(l * 16 + kc) * 3) * 9216 + col;
            o[0] = a0; o[9216] = a1; o[2 * 9216] = a2;
        }
        __syncthreads();
    }
    {
        float* scr = (float*)smem + wave * (64 * 33);
        for (int item = gw; item < 4 * 12944; item += ngw) prep_weight_item(p, ws_b, item, scr, lane);
    }
    {
        bf16_t* TABL = (bf16_t*)(ws_b + WS_TABL);
        for (size_t e = gt; e < (size_t)2048 * 4096; e += ngt) {
            const int k = (int)(e >> 12), kk = (int)(e & 4095), lidx = kk & 2047;
            const int idx = (k * lidx) & 2047;
            float sn, cs; sincospif((float)idx * (2.f / 2048.f), &sn, &cs);
            TABL[e] = f2bf((kk < 2048 ? cs : -sn) * 0.022097086912079608f);
        }
        bf16_t* TABC = (bf16_t*)(ws_b + WS_TABC);
        for (size_t e = gt; e < (size_t)256 * 512; e += ngt) {
            const int k = (int)(e >> 9), kk = (int)(e & 511), lidx = kk & 255;
            const int idx = (k * lidx) & 255;
            float sn, cs; sincospif((float)idx * (2.f / 256.f), &sn, &cs);
            TABC[e] = f2bf((kk < 256 ? cs : -sn) * 0.0625f);
        }
        bf16_t* WCS = (bf16_t*)(ws_b + WS_WCS);
        for (size_t e = gt; e < (size_t)256 * 128; e += ngt) {
            const int i = (int)(e >> 7), c = (int)(e & 127), m = i >> 1, cs_ = i & 1;
            const int idx = (m * c) & 127;
            float sn, cs; sincospif((float)idx * (2.f / 128.f), &sn, &cs);
            WCS[e] = f2bf((cs_ ? sn : cs) * 0.08838834764831845f);
        }
        float* ROPE = (float*)(ws_b + WS_ROPE);
        for (size_t e = gt; e < 512; e += ngt) {
            const int pos = (int)(e >> 3), i = (int)(e & 7);
            const float inv_freq = powf(10000.f, -(float)i / 8.f);
            const float ang = (float)pos * inv_freq;
            ROPE[e] = cosf(ang); ROPE[512 + e] = sinf(ang);
        }
    }
    {
        bf16_t* CCKV = (bf16_t*)(ws_b + WS_CCKV);
        for (size_t e = gt; e < (size_t)NL * 1024 * 256; e += ngt) {
            const int c = (int)(e & 255), i = (int)((e >> 8) & 511), b = (int)((e >> 17) & 1), l = (int)(e >> 18);
            CCKV[e] = f2bf(pin(p, 2)[((size_t)(b * 4 + l) * 512 + i) * 256 + c]);
        }
        bf16_t* CKR = (bf16_t*)(ws_b + WS_CKR);
        for (size_t e = gt; e < (size_t)NL * 1024 * 32; e += ngt) {
            const int c = (int)(e & 31), i = (int)((e >> 5) & 511), b = (int)((e >> 14) & 1), l = (int)(e >> 15);
            CKR[e] = f2bf(pin(p, 3)[((size_t)(b * 4 + l) * 512 + i) * 32 + c]);
        }
        bf16_t* CNAK = (bf16_t*)(ws_b + WS_CNAK);
        for (size_t e = gt; e < (size_t)NL * 1024 * 512; e += ngt) {
            const int c = (int)(e & 511), i = (int)((e >> 9) & 511), b = (int)((e >> 18) & 1), l = (int)(e >> 19);
            CNAK[e] = f2bf(pin(p, 4)[((size_t)(b * 4 + l) * 512 + i) * 512 + c]);
        }
        bf16_t* CNAVT = (bf16_t*)(ws_b + WS_CNAVT);
        for (size_t e = gt; e < (size_t)NL * 1024 * 512; e += ngt) {
            const int key = (int)(e & 511), hd = (int)((e >> 9) & 511), b = (int)((e >> 18) & 1), l = (int)(e >> 19);
            CNAVT[e] = f2bf(pin(p, 5)[((size_t)(b * 4 + l) * 512 + key) * 512 + hd]);
        }
    }
}

DEVI void phase_modreduce(const P& p, unsigned char* ws_b, int tid) {
    const float* MODP = (const float*)(ws_b + WS_MODP);
    float* MOD = (float*)(ws_b + WS_MOD);
    for (int e = blockIdx.x * NTHREADS + tid; e < NL * 3 * 9216; e += gridDim.x * NTHREADS) {
        const int l = e / (3 * 9216), rem = e % (3 * 9216);
        float a = pin(p, 9)[l * 9216 + (rem % 9216)];
#pragma unroll
        for (int kc = 0; kc < 16; ++kc) a += MODP[((size_t)(l * 16 + kc) * 3) * 9216 + rem];
        MOD[e] = a;
    }
}

#define XB_TMO      128
#define XB_XCNT(j)  (256  + 64 * (j))
#define XB_XSUB(j)  (1280 + 64 * (j))
#define XB_XGEN(j)  (2304 + 64 * (j))
#define XB_TOP      3328
#define XB_TOPGEN   3392
#define XCD_BAR_WORDS 3456
#define XB_SPIN_CAP (1u << 20)
#define LAS __attribute__((address_space(3)))
DEVI unsigned xb_ld(unsigned* p)              { return __hip_atomic_load(p, __ATOMIC_RELAXED, __HIP_MEMORY_SCOPE_AGENT); }
DEVI unsigned xb_add(unsigned* p, unsigned v) { return __hip_atomic_fetch_add(p, v, __ATOMIC_RELAXED, __HIP_MEMORY_SCOPE_AGENT); }
DEVI unsigned xb_xcc_id() { return (unsigned)__builtin_amdgcn_s_getreg((3 << 11) | 20) & 0xFu; }
#define XB_SPIN(cond, bar) do { unsigned _sp = 0; while (cond) { __builtin_amdgcn_s_sleep(1); \
    if ((++_sp & 255u) == 0u) { if (xb_ld(&(bar)[XB_TMO])) break; if (_sp > XB_SPIN_CAP) { atomicAdd(&(bar)[XB_TMO], 1u); break; } } } } while (0)
struct XcdBarrier { unsigned* bar; unsigned x; volatile LAS unsigned* st; };
DEVI XcdBarrier xcd_barrier_post(unsigned* bar, volatile LAS unsigned* st) {
    XcdBarrier b; b.bar = bar; b.x = xb_xcc_id(); b.st = st;
    if (threadIdx.x == 0) (void)xb_add(&bar[XB_XCNT(b.x)], 1u);
    return b;
}
DEVI void xcd_barrier_complete(unsigned* bar, unsigned x, unsigned& nloc, unsigned& nx) {
    const unsigned G = gridDim.x * gridDim.y * gridDim.z;
    unsigned sum, cnt, mine, sp = 0u;
    for (;;) {
        sum = 0u; cnt = 0u; mine = 0u;
#pragma unroll
        for (unsigned j = 0; j < 16; ++j) { const unsigned c = xb_ld(&bar[XB_XCNT(j)]); sum += c; cnt += (c > 0u) ? 1u : 0u; mine = (j == x) ? c : mine; }
        if (sum == G) break;
        __builtin_amdgcn_s_sleep(1);
        if ((++sp & 255u) == 0u) { if (xb_ld(&bar[XB_TMO])) break; if (sp > XB_SPIN_CAP) { atomicAdd(&bar[XB_TMO], 1u); break; } }
    }
    nloc = mine > 0u ? mine : 1u; nx = cnt > 0u ? cnt : 1u;
}
DEVI void xcd_barrier(const XcdBarrier& b) {
    asm volatile("s_waitcnt vmcnt(0)" ::: "memory");
    __syncthreads();
    if (threadIdx.x == 0) {
        unsigned* bar = b.bar;
        __builtin_amdgcn_s_waitcnt(0);
        unsigned nloc = b.st[0], nx = b.st[1];
        if (nloc == 0u) { xcd_barrier_complete(bar, b.x, nloc, nx); b.st[0] = nloc; b.st[1] = nx; }
        const unsigned old = xb_add(&bar[XB_XSUB(b.x)], 1u);
        const unsigned gen = old / nloc;
        if (old + 1u == (gen + 1u) * nloc) {
            __builtin_amdgcn_fence(__ATOMIC_RELEASE, "agent");
            asm volatile("s_waitcnt vmcnt(0)" ::: "memory");
            const unsigned og = xb_add(&bar[XB_TOP], 1u);
            const unsigned tg = og / nx;
            if (og + 1u == (tg + 1u) * nx) xb_add(&bar[XB_TOPGEN], 1u);
            else XB_SPIN(xb_ld(&bar[XB_TOPGEN]) == tg, bar);
            __builtin_amdgcn_fence(__ATOMIC_ACQUIRE, "agent");
            xb_add(&bar[XB_XGEN(b.x)], 1u);
            asm volatile("s_waitcnt vmcnt(0)" ::: "memory");
        } else {
            XB_SPIN(xb_ld(&bar[XB_XGEN(b.x)]) == gen, bar);
            __builtin_amdgcn_fence(__ATOMIC_ACQUIRE, "agent");
            asm volatile("s_waitcnt vmcnt(0)" ::: "memory");
        }
    }
    __syncthreads();
}

DEVI void run_phase(const P& p, unsigned char* ws_b, int ph, unsigned char* smem, int tid) {
    const int lane = tid & 63, wave = tid >> 6;
    const int gw = blockIdx.x * NWAVES + wave, ngw = gridDim.x * NWAVES;
    const int nb = gridDim.x, bid = blockIdx.x;
    const int grp = tid >> 8, ltid = tid & 255;
    bf16_t* sm = (bf16_t*)smem + grp * (SMEM_BYTES / 2);
    if (ph == 0) { phase_prep(p, ws_b, smem, tid); return; }
    if (ph == 1) { phase_modreduce(p, ws_b, tid); return; }
    if (ph == 2) { phase_rows(p, ws_b, 0, -1, 0, 0, false, gw, ngw, lane); return; }
    const int l = (ph - 3) / 13, s = (ph - 3) % 13;
    const bf16_t* Wl = (const bf16_t*)(ws_b + WS_W) + (size_t)l * LAYER_W;
    const float* MODl = (const float*)(ws_b + WS_MOD) + (size_t)l * 3 * 9216;
    switch (s) {
    case 0: case 10:
        {
            pg8::Gemm g{(const bf16_t*)(ws_b + WS_H), Wl + (s == 10 ? OFF_W13_2 : OFF_W13_1), M, 2 * DFF, D};
            pg8::StaticOrder S; S.init(M, 2 * DFF, nb, bid);
            pg8::EpiSwiGLU E{(bf16_t*)(ws_b + WS_ACT)};
            pg8::gemm_phase<pg8::EpiSwiGLU, pg8::StaticOrder, true, true>((PG8_LAS unsigned char*)smem, g, S, E, tid);
        }
        break;
    case 1: case 11:
        {
            pg8::Gemm g{(const bf16_t*)(ws_b + WS_ACT), Wl + (s == 11 ? OFF_W2_2 : OFF_W2_1), M, D, DFF};
            pg8::StaticOrder S; S.init(M, D, nb, bid);
            pg8::EpiResid E{(float*)(ws_b + WS_X), MODl + (s == 11 ? 8 : 2) * D, 0.5f};
            pg8::gemm_phase<pg8::EpiResid, pg8::StaticOrder, false, true>((PG8_LAS unsigned char*)smem, g, S, E, tid);
        }
        break;
    case 2: phase_rows(p, ws_b, l, 0, l, 3, false, gw, ngw, lane); break;
    case 3:
        {
            pg8::Gemm g{(const bf16_t*)(ws_b + WS_H), Wl + OFF_WIN, M, 5888, D};
            pg8::StaticOrder S; S.init(M, 5888, nb, bid);
            pg8::EpiIn E{ws_b, p.out, pin(p, 26), l};
            pg8::gemm_phase<pg8::EpiIn, pg8::StaticOrder, true, true>((PG8_LAS unsigned char*)smem, g, S, E, tid);
        }
        break;
    case 4: phase_rowmix(p, ws_b, l, gw, ngw, lane); break;
    case 5: {
        int u = bid;
        for (; u < 128; u += nb) {
            const int wi = u * 8 + wave;
            attn_na_lat(p, ws_b, l, wi >> 9, (wi >> 6) & 7, (wi >> 1) & 31, wi & 1, lane);
        }
        for (; u < 128 + 416; u += nb) job_ukv(p, ws_b, l, 2 * (u - 128) + grp, sm, ltid);
        for (; u < 128 + 416 + 288; u += nb) job_uq(p, ws_b, l, 2 * (u - 128 - 416) + grp, sm, ltid);
        for (; u < 128 + 416 + 288 + 384; u += nb) job_f1(p, ws_b, 2 * (u - 128 - 416 - 288) + grp, sm, ltid);
        for (; u < 128 + 416 + 288 + 384 + 256; u += nb) {
            const int wi = (u - 128 - 416 - 288 - 384) * 8 + wave;
            attn_na_ctx(p, ws_b, wi >> 6, (wi >> 3) & 7, wi & 7, lane);
        }
    } break;
    case 6: {
        int u = bid;
        for (; u < 128; u += nb) {
            const int wi = u * 8 + wave;
            attn_mla(p, ws_b, l, true, wi >> 9, (wi >> 6) & 7, wi & 63, lane);
        }
        for (; u < 128 + 64; u += nb) job_f2_lat(p, ws_b, 2 * (u - 128) + grp, sm, ltid);
        for (; u < 128 + 64 + 128; u += nb) job_f2_ctx(p, ws_b, 2 * (u - 128 - 64) + grp, sm, ltid);
        for (; u < 128 + 64 + 128 + 256; u += nb) {
            const int wi = (u - 128 - 64 - 128) * 8 + wave;
            attn_mla(p, ws_b, l, false, wi >> 6, (wi >> 3) & 7, wi & 7, lane);
        }
    } break;
    case 7:
        for (int u = bid; u < 96 * 8 / 2; u += nb) job_merge(p, ws_b, l, 2 * u + grp, sm, ltid);
        break;
    case 8:
        {
            pg8::Gemm g{(const bf16_t*)(ws_b + WS_MERGED), Wl + OFF_WOUT, M, D, D};
            pg8::StaticOrder S; S.init(M, D, nb, bid);
            pg8::EpiResid E{(float*)(ws_b + WS_X), MODl + 5 * D, 1.0f};
            pg8::gemm_phase<pg8::EpiResid, pg8::StaticOrder, false, true>((PG8_LAS unsigned char*)smem, g, S, E, tid);
        }
        break;
    case 9: phase_rows(p, ws_b, l, 1, l, 6, false, gw, ngw, lane); break;
    case 12:
        if (l == NL - 1) phase_rows(p, ws_b, l, 2, 0, 0, true, gw, ngw, lane);
        else phase_rows(p, ws_b, l, 2, l + 1, 0, false, gw, ngw, lane);
        break;
    default: break;
    }
}

__global__ void __launch_bounds__(NTHREADS, 2) mega_kernel(P p) {
    extern __shared__ __attribute__((aligned(16))) unsigned char smem[];
    __shared__ uint4 xb_words;
    cg::grid_group grid = cg::this_grid();
    const int tid = threadIdx.x;
    unsigned* bar = (unsigned*)(p.ws + WS_BAR);
    if (tid == 0) xb_words = make_uint4(0u, 0u, 0u, 0u);
    if (p.ph_lo == 0 && blockIdx.x == 0) for (int i = tid; i < XCD_BAR_WORDS; i += NTHREADS) bar[i] = 0u;
    __syncthreads();
    XcdBarrier xb; xb.bar = bar; xb.x = 0; xb.st = (volatile LAS unsigned*)&xb_words;
#pragma nounroll
    for (int ph = p.ph_lo; ph < p.ph_hi; ++ph) {
        int tid2 = tid; asm volatile("" : "+v"(tid2));
        unsigned char* ws_b = p.ws; asm volatile("" : "+s"(ws_b));
        run_phase(p, ws_b, ph, smem, tid2);
        if (ph + 1 < p.ph_hi) {
            if (ph == p.ph_lo) { grid.sync(); xb = xcd_barrier_post(bar, (volatile LAS unsigned*)&xb_words); }
            else xcd_barrier(xb);
        }
    }
}

extern "C" void kernel_launch(void* const* d_in, const int* in_sizes, int n_in, void* d_out, int out_size, void* d_ws, size_t ws_size,
                              hipStream_t stream) {
    static int grid_blocks = 0;
    if (grid_blocks == 0) {
        if (n_in != 30 || ws_size < WS_END) { fprintf(stderr, "kernel_launch: n_in %d ws %zu need %zu\n", n_in, ws_size, (size_t)WS_END); grid_blocks = -1; return; }
        int dev = 0, cus = 0, per_cu = 0;
        hipGetDevice(&dev);
        hipDeviceGetAttribute(&cus, hipDeviceAttributeMultiprocessorCount, dev);
        hipFuncSetAttribute((const void*)mega_kernel, hipFuncAttributeMaxDynamicSharedMemorySize, LDS_TOTAL);
        hipOccupancyMaxActiveBlocksPerMultiprocessor(&per_cu, (const void*)mega_kernel, NTHREADS, LDS_TOTAL);
        if (per_cu < 1) per_cu = 1;
        if (per_cu > 1) per_cu = 1;
        grid_blocks = cus * per_cu;
    }
    if (grid_blocks < 0) return;
    P p{};
    for (int i = 0; i < 30; ++i) p.in[i] = (const float*)d_in[i];
    p.out = (float*)d_out; p.ws = (unsigned char*)d_ws; p.ph_lo = 0; p.ph_hi = NPHASE;
#ifndef MULTI_LAUNCH
#define MULTI_LAUNCH 0
#endif
#if MULTI_LAUNCH
    for (int ph = 0; ph < NPHASE; ++ph) {
        p.ph_lo = ph; p.ph_hi = ph + 1;
        hipLaunchKernelGGL(mega_kernel, dim3(grid_blocks), dim3(NTHREADS), LDS_TOTAL, stream, p);
    }
#else
    void* args[] = {&p};
    hipError_t e = hipLaunchCooperativeKernel((const void*)mega_kernel, dim3(grid_blocks), dim3(NTHREADS), args, LDS_TOTAL, stream);
    if (e != hipSuccess) fprintf(stderr, "cooperative launch failed: %s (grid %d)\n", hipGetErrorString(e), grid_blocks);
#endif
}
```

```cpp
#include <hip/hip_runtime.h>
#include <hip/hip_cooperative_groups.h>
#include <cstdint>
#include <cstdio>
namespace cg = cooperative_groups;

typedef unsigned short bf16_t;
typedef short bf16x8 __attribute__((ext_vector_type(8)));
typedef float f32x16 __attribute__((ext_vector_type(16)));
typedef float f32x4 __attribute__((ext_vector_type(4)));
typedef unsigned u32x4 __attribute__((ext_vector_type(4)));
typedef unsigned u32x2 __attribute__((ext_vector_type(2)));
#define DEVI __device__ __forceinline__

constexpr int D = 1024, NCTX = 8192, NLAT = 4096, M = 12288, MX = 13312, DFF = 2816, NL = 4;
constexpr float ALPHA_F = 1.6817928305074290f;
constexpr float LOG2E = 1.4426950408889634f;
constexpr float MLA_QS = 0.10206207261596575f * LOG2E;
constexpr float NA_QS = 0.125f * LOG2E;
constexpr size_t OUT_CKV = 12582912, OUT_KR = 20971520, OUT_NAK = 22020096, OUT_NAV = 38797312;

constexpr size_t al256(size_t x) { return (x + 255) & ~(size_t)255; }
constexpr size_t WS_BAR = 0;
constexpr size_t WS_X = 16384;
constexpr size_t WS_H = WS_X + (size_t)M * D * 4;
constexpr size_t WS_MOD = WS_H + (size_t)M * D * 2;
constexpr size_t WS_MODP = WS_MOD + al256((size_t)NL * 3 * 9216 * 4);
constexpr size_t WS_ROPE = WS_MODP + al256((size_t)NL * 16 * 3 * 9216 * 4);
constexpr size_t WS_TABC = WS_ROPE + 4096;
constexpr size_t WS_TABL = WS_TABC + (size_t)256 * 512 * 2;
constexpr size_t WS_WCS = WS_TABL + (size_t)2048 * 4096 * 2;
constexpr size_t WS_CCKV = WS_WCS + (size_t)256 * 128 * 2;
constexpr size_t WS_CKR = WS_CCKV + (size_t)NL * 1024 * 256 * 2;
constexpr size_t WS_CNAK = WS_CKR + (size_t)NL * 1024 * 32 * 2;
constexpr size_t WS_CNAVT = WS_CNAK + (size_t)NL * 1024 * 512 * 2;
constexpr size_t WS_W = WS_CNAVT + (size_t)NL * 1024 * 512 * 2;
constexpr size_t OFF_W13_1 = 0, OFF_W2_1 = 5767168, OFF_W13_2 = 8650752, OFF_W2_2 = 14417920, OFF_WIN = 17301504,
                 OFF_WOUT = 23330816, OFF_WBF = 24379392, OFF_WBM = 24903680, OFF_WBN = 25427968, OFF_WUQ = 25952256,
                 OFF_WUKV = 26247168, LAYER_W = 26509312;
constexpr size_t WS_R1 = WS_W + (size_t)NL * LAYER_W * 2;
constexpr size_t WS_ACT = WS_R1;
constexpr size_t WS_UF = WS_R1;
constexpr size_t WS_UQ = WS_UF + (size_t)M * 512 * 2;
constexpr size_t WS_UKV = WS_UQ + (size_t)M * 384 * 2;
constexpr size_t WS_KRF = WS_UKV + (size_t)M * 256 * 4;
constexpr size_t WS_CKV = WS_KRF + (size_t)M * 32 * 4;
constexpr size_t WS_KR = WS_CKV + (size_t)M * 256 * 2;
constexpr size_t WS_NAQ = WS_KR + (size_t)M * 32 * 2;
constexpr size_t WS_NAK = WS_NAQ + (size_t)M * 512 * 2;
constexpr size_t WS_NAVT = WS_NAK + (size_t)M * 512 * 2;
constexpr size_t WS_GATE = WS_NAVT + (size_t)M * 512 * 2;
constexpr size_t WS_Q = WS_GATE + (size_t)M * 3072 * 2;
constexpr size_t WS_KN = WS_Q + (size_t)M * 768 * 2;
constexpr size_t WS_VTM = WS_KN + (size_t)MX * 512 * 2;
constexpr size_t WS_F1T = WS_VTM + (size_t)MX * 512 * 2;
constexpr size_t WS_YF = WS_F1T + (size_t)M * 1024 * 2;
constexpr size_t WS_YM = WS_YF + (size_t)M * 512 * 2;
constexpr size_t WS_YN = WS_YM + (size_t)M * 512 * 2;
constexpr size_t WS_MERGED = WS_YN + (size_t)M * 512 * 2;
constexpr size_t WS_END = WS_MERGED + (size_t)M * 1024 * 2;
static_assert(WS_END - WS_R1 >= (size_t)M * DFF * 2, "ACT must fit in R1");
static_assert(WS_NAK - WS_UF >= (size_t)M * D * 4, "merge T32 must fit in the dead UF..NAQ buffers");

constexpr int NPHASE = 3 + 13 * NL;

struct P {
    const float* in[30];
    float* out;
    unsigned char* ws;
    int ph_lo, ph_hi;
};

__device__ __forceinline__ const float* pin(const P& p, int i) { int j = i; asm volatile("" : "+s"(j)); return p.in[j]; }
typedef __bf16 bf16v2 __attribute__((ext_vector_type(2)));
typedef float f32x2 __attribute__((ext_vector_type(2)));
DEVI unsigned pk2(float lo, float hi) { f32x2 v = {lo, hi}; bf16v2 b = __builtin_convertvector(v, bf16v2); return __builtin_bit_cast(unsigned, b); }
DEVI bf16_t f2bf(float x) { return (bf16_t)(pk2(x, 0.f) & 0xffffu); }
DEVI float bf2f(unsigned v) { return __uint_as_float(v << 16); }
DEVI float wave_sum(float v) {
#pragma unroll
    for (int o = 1; o < 64; o <<= 1) v += __shfl_xor(v, o);
    return v;
}
DEVI float fast_exp2(float x) { return __builtin_amdgcn_exp2f(x); }
DEVI float sigmoidf_(float x) { return 1.f / (1.f + __expf(-x)); }

constexpr int LDT = 72;
constexpr int TILE_E = 128 * LDT;
constexpr int SMEM_BYTES = 4 * TILE_E * 2;
constexpr int NTHREADS = 512, NWAVES = 8, LDS_TOTAL = 2 * SMEM_BYTES;

DEVI void gemm_ldg(const bf16_t* ga, const bf16_t* gb, int lda, int ldb, u32x4 (&ra)[4], u32x4 (&rb)[4]) {
#pragma unroll
    for (int i = 0; i < 4; ++i) {
        ra[i] = *(const u32x4*)(ga + (size_t)(32 * i) * lda);
        rb[i] = *(const u32x4*)(gb + (size_t)(32 * i) * ldb);
    }
}
DEVI void gemm_sts(bf16_t* buf, int soff, const u32x4 (&ra)[4], const u32x4 (&rb)[4]) {
#pragma unroll
    for (int i = 0; i < 4; ++i) {
        *(u32x4*)(buf + soff + 32 * i * LDT) = ra[i];
        *(u32x4*)(buf + TILE_E + soff + 32 * i * LDT) = rb[i];
    }
}
DEVI void gemm_mma(const bf16_t* cur, int aoff, int boff, f32x16 (&acc)[2][2]) {
#pragma unroll
    for (int ks = 0; ks < 4; ++ks) {
        bf16x8 a0 = *(const bf16x8*)(cur + aoff + ks * 16);
        bf16x8 a1 = *(const bf16x8*)(cur + aoff + 32 * LDT + ks * 16);
        bf16x8 b0 = *(const bf16x8*)(cur + boff + ks * 16);
        bf16x8 b1 = *(const bf16x8*)(cur + boff + 32 * LDT + ks * 16);
        acc[0][0] = __builtin_amdgcn_mfma_f32_32x32x16_bf16(a0, b0, acc[0][0], 0, 0, 0);
        acc[0][1] = __builtin_amdgcn_mfma_f32_32x32x16_bf16(a0, b1, acc[0][1], 0, 0, 0);
        acc[1][0] = __builtin_amdgcn_mfma_f32_32x32x16_bf16(a1, b0, acc[1][0], 0, 0, 0);
        acc[1][1] = __builtin_amdgcn_mfma_f32_32x32x16_bf16(a1, b1, acc[1][1], 0, 0, 0);
    }
}

template <bool DEEP = true>
DEVI void gemm_core(const bf16_t* __restrict__ A, int lda, const bf16_t* __restrict__ B, int ldb, int K,
                    f32x16 (&acc)[2][2], bf16_t* smem, int tid) {
    const int lane = tid & 63, wave = tid >> 6, wr = wave >> 1, wc = wave & 1;
    const int lr = tid >> 3, lc = (tid & 7) * 8;
    const bf16_t* ga = A + (size_t)lr * lda + lc;
    const bf16_t* gb = B + (size_t)lr * ldb + lc;
    const int soff = lr * LDT + lc;
    const int nk = K >> 6;
    const int aoff = (wr * 64 + (lane & 31)) * LDT + (lane >> 5) * 8;
    const int boff = TILE_E + (wc * 64 + (lane & 31)) * LDT + (lane >> 5) * 8;
    bf16_t* buf0 = smem; bf16_t* buf1 = smem + 2 * TILE_E;
    if constexpr (DEEP) {
        u32x4 ra0[4], rb0[4], ra1[4], rb1[4];
        gemm_ldg(ga, gb, lda, ldb, ra0, rb0);
        gemm_ldg(ga + 64, gb + 64, lda, ldb, ra1, rb1);
        gemm_sts(buf0, soff, ra0, rb0);
        __syncthreads();
        for (int kt = 0; kt < nk; kt += 2) {
            if (kt + 2 < nk) gemm_ldg(ga + (size_t)(kt + 2) * 64, gb + (size_t)(kt + 2) * 64, lda, ldb, ra0, rb0);
            gemm_mma(buf0, aoff, boff, acc);
            gemm_sts(buf1, soff, ra1, rb1);
            __syncthreads();
            if (kt + 3 < nk) gemm_ldg(ga + (size_t)(kt + 3) * 64, gb + (size_t)(kt + 3) * 64, lda, ldb, ra1, rb1);
            gemm_mma(buf1, aoff, boff, acc);
            if (kt + 2 < nk) gemm_sts(buf0, soff, ra0, rb0);
            __syncthreads();
        }
    } else {
        u32x4 ra[4], rb[4];
        gemm_ldg(ga, gb, lda, ldb, ra, rb);
        gemm_sts(buf0, soff, ra, rb);
        __syncthreads();
        for (int kt = 0; kt < nk; ++kt) {
            bf16_t* cur = (kt & 1) ? buf1 : buf0;
            bf16_t* nxt = (kt & 1) ? buf0 : buf1;
            const bool more = (kt + 1 < nk);
            if (more) { ga += 64; gb += 64; gemm_ldg(ga, gb, lda, ldb, ra, rb); }
            gemm_mma(cur, aoff, boff, acc);
            if (more) gemm_sts(nxt, soff, ra, rb);
            __syncthreads();
        }
    }
}

DEVI void zero_acc(f32x16 (&acc)[2][2]) {
#pragma unroll
    for (int i = 0; i < 2; ++i)
#pragma unroll
        for (int j = 0; j < 2; ++j)
#pragma unroll
            for (int r = 0; r < 16; ++r) acc[i][j][r] = 0.f;
}

#define EPI_SETUP const int lane = tid & 63, wave = tid >> 6, wr = wave >> 1, wc = wave & 1, hl = lane >> 5, c32 = lane & 31; (void)wr; (void)wc; (void)hl; (void)c32;

DEVI int mod_group(int row) { return row < NCTX ? 0 : 1 + ((row - NCTX) >> 11); }

namespace pg8 {
#define PG8_LAS __attribute__((address_space(3)))
constexpr int BM = 256, BK = 64, HALF = 128, HTB = HALF * BK * 2, NXCD = 8, WGM = 8;
DEVI int lds_byte(int r, int c) { const int st = (r >> 4) * 2 + (c >> 5), rr = r & 15, cc = c & 31, ob = rr * 64 + cc * 2; return st * 1024 + (ob ^ (((ob >> 9) & 1) << 5)); }
DEVI void stage_rc(int b, int& R, int& C) { const int st = b / 1024, sb = b % 1024, swz = sb ^ (((sb >> 9) & 1) << 5); R = (st >> 1) * 16 + swz / 64; C = (st & 1) * 32 + (swz % 64) / 2; }
DEVI int perm32(int rho) { const int n = rho >> 4, i = rho & 15; return 8 * (i >> 2) + 4 * n + (i & 3); }
struct Unit { int pm, pn; };
struct Gemm { const bf16_t* A; const bf16_t* Bt; int M, N, K; };
struct StaticOrder {
    int nM, nN, nwg, G, c;
    DEVI void init(int M, int N, int G_, int c_) { nM = M / BM; nN = N / BM; nwg = nM * nN; G = G_; c = c_; }
    DEVI bool next(int i, Unit& u) const {
        const long L = (long)i * G + c; if (L >= nwg) return false;
        int wgid = (int)L; { const int q = nwg / NXCD, r = nwg % NXCD, xcd = wgid % NXCD, off = wgid / NXCD; wgid = (xcd < r ? xcd * (q + 1) : r * (q + 1) + (xcd - r) * q) + off; }
        const int nig = WGM * nN, gid = wgid / nig, fm = gid * WGM, gsz = (nM - fm) < WGM ? (nM - fm) : WGM;
        u.pm = fm + ((wgid % nig) % gsz); u.pn = (wgid % nig) / gsz; return true;
    }
    DEVI void a_ready(const Unit&) const {}
    DEVI void done(const Unit&) const {}
};
template <class Epi, class Sched, bool ALIGN_EPI = false, bool SP2 = false>
DEVI void gemm_phase(PG8_LAS unsigned char* lds, const Gemm g, const Sched& S, const Epi& E, const int tid) {
    const int wid = __builtin_amdgcn_readfirstlane(tid >> 6), lane = tid & 63, wr = wid >> 2, wc = wid & 3, fr = lane & 15, fq = lane >> 4;
    const int K = g.K, nt = K / BK;
    unsigned voffA[2], voffB[2];
#pragma unroll
    for (int i = 0; i < 2; ++i) { int R, C; stage_rc(tid * 16 + i * 8192, R, C); const int Rb = Epi::PERM ? ((R & ~31) + perm32(R & 31)) : R;
        voffA[i] = (unsigned)(R * K + C) * 2u; voffB[i] = (unsigned)(Rb * K + C) * 2u; }
    const size_t kstep = (size_t)(BK * 2);
    const size_t hstep = (size_t)HALF * K * 2;
    const size_t tstep = 2 * hstep;
    const unsigned ldsw = (unsigned)wid * 1024u;
    const int aoff = lds_byte(wr * 64 + fr, fq * 8), boff = lds_byte(wc * 32 + fr, fq * 8);
#define PG8_SA(b, h) (((b) * 2 + (h)) * HTB)
#define PG8_SB(b, h) ((4 + (b) * 2 + (h)) * HTB)
#define PG8_STAGE(bufoff, gbase, voff) do { _Pragma("unroll") for (int _i = 0; _i < 2; ++_i) \
        __builtin_amdgcn_global_load_lds((const unsigned*)((const char*)(gbase) + (voff)[_i]), (PG8_LAS unsigned*)(lds + (bufoff) + ldsw + _i * 8192), 16, 0, 0); } while (0)
#define PG8_LDA(dst, b, h) do { _Pragma("unroll") for (int m = 0; m < 4; ++m) _Pragma("unroll") for (int k = 0; k < 2; ++k) dst[m][k] = *(const PG8_LAS bf16x8*)(lds + PG8_SA(b, h) + aoff + m * 2048 + k * 1024); } while (0)
#define PG8_LDB(dst, b, h) do { _Pragma("unroll") for (int n = 0; n < 2; ++n) _Pragma("unroll") for (int k = 0; k < 2; ++k) dst[n][k] = *(const PG8_LAS bf16x8*)(lds + PG8_SB(b, h) + boff + n * 2048 + k * 1024); } while (0)
#define PG8_MMA(ai, bj, At, Bt) do { __builtin_amdgcn_s_setprio(1); _Pragma("unroll") for (int m = 0; m < 4; ++m) _Pragma("unroll") for (int n = 0; n < 2; ++n) _Pragma("unroll") for (int k = 0; k < 2; ++k) \
        acc[ai][bj][m][n] = __builtin_amdgcn_mfma_f32_16x16x32_bf16(Bt[n][k], At[m][k], acc[ai][bj][m][n], 0, 0, 0); __builtin_amdgcn_s_setprio(0); } while (0)
#define PG8_WAIT_V(n) asm volatile("s_waitcnt vmcnt(" #n ")" ::: "memory")
#define PG8_WAIT_L(n) asm volatile("s_waitcnt lgkmcnt(" #n ")" ::: "memory")
#define PG8_BAR __builtin_amdgcn_s_barrier()
#define PG8_SCHED __builtin_amdgcn_sched_barrier(0)
    Unit cur, nxt; int ui = 0;
    if (!S.next(0, cur)) return;
    f32x4 acc[2][2][4][2];
#pragma unroll
    for (int a = 0; a < 2; ++a)
#pragma unroll
        for (int b = 0; b < 2; ++b)
#pragma unroll
            for (int m = 0; m < 4; ++m)
#pragma unroll
                for (int n = 0; n < 2; ++n) acc[a][b][m][n] = (f32x4){0.f, 0.f, 0.f, 0.f};
    bf16x8 At[4][2], B0[2][2], B1[2][2];
    const char* cA = (const char*)g.A + (size_t)cur.pm * tstep; const char* cB = (const char*)g.Bt + (size_t)cur.pn * tstep;
    S.a_ready(cur);
    if constexpr (SP2) {
        PG8_STAGE(PG8_SB(0, 0), cB, voffB); PG8_STAGE(PG8_SB(0, 1), cB + hstep, voffB); PG8_STAGE(PG8_SA(0, 0), cA, voffA); PG8_STAGE(PG8_SA(0, 1), cA + hstep, voffA);
        if (wr == 1) PG8_BAR;
        PG8_WAIT_V(2); PG8_BAR;
        PG8_STAGE(PG8_SB(1, 0), cB + kstep, voffB); PG8_STAGE(PG8_SA(1, 0), cA + kstep, voffA); PG8_STAGE(PG8_SB(1, 1), cB + hstep + kstep, voffB);
        PG8_WAIT_V(6); PG8_BAR;
    } else {
        PG8_STAGE(PG8_SB(0, 0), cB, voffB); PG8_STAGE(PG8_SA(0, 0), cA, voffA); PG8_STAGE(PG8_SB(0, 1), cB + hstep, voffB); PG8_STAGE(PG8_SA(0, 1), cA + hstep, voffA);
        if (wr == 1) PG8_BAR;
        PG8_WAIT_V(4); PG8_BAR;
        PG8_STAGE(PG8_SB(1, 0), cB + kstep, voffB); PG8_STAGE(PG8_SA(1, 0), cA + kstep, voffA); PG8_STAGE(PG8_SB(1, 1), cB + hstep + kstep, voffB);
        PG8_WAIT_V(6); PG8_BAR;
    }
    for (;;) {
        const bool has_next = S.next(ui + 1, nxt);
        const char* nA = has_next ? (const char*)g.A + (size_t)nxt.pm * tstep : cA; const char* nB = has_next ? (const char*)g.Bt + (size_t)nxt.pn * tstep : cB;
        for (int t = 0; t < nt; t += 2) {
            const bool last = (t == nt - 2);
            const char* a1 = cA + (size_t)(t + 1) * kstep;
            const char* a2 = last ? nA : cA + (size_t)(t + 2) * kstep; const char* b2 = last ? nB : cB + (size_t)(t + 2) * kstep;
            const char* a3 = a2 + kstep; const char* b3 = b2 + kstep;
            if (last && has_next) S.a_ready(nxt);
            if constexpr (SP2) {
            PG8_LDB(B0, 0, 0); PG8_LDB(B1, 0, 1); PG8_SCHED; PG8_LDA(At, 0, 0); PG8_STAGE(PG8_SA(1, 1), a1 + hstep, voffA);
            PG8_WAIT_V(8); PG8_WAIT_L(0); PG8_BAR; PG8_MMA(0, 0, At, B0); PG8_MMA(0, 1, At, B1); PG8_BAR; PG8_SCHED;
            PG8_LDA(At, 0, 1); PG8_STAGE(PG8_SB(0, 0), b2, voffB); PG8_STAGE(PG8_SB(0, 1), b2 + hstep, voffB); PG8_STAGE(PG8_SA(0, 0), a2, voffA);
            PG8_WAIT_V(8); PG8_WAIT_L(0); PG8_BAR; PG8_MMA(1, 0, At, B0); PG8_MMA(1, 1, At, B1); PG8_BAR; PG8_SCHED;
            PG8_LDB(B0, 1, 0); PG8_LDB(B1, 1, 1); PG8_SCHED; PG8_LDA(At, 1, 0); PG8_STAGE(PG8_SA(0, 1), a2 + hstep, voffA);
            PG8_WAIT_V(8); PG8_WAIT_L(0); PG8_BAR; PG8_MMA(0, 0, At, B0); PG8_MMA(0, 1, At, B1); PG8_BAR; PG8_SCHED;
            PG8_LDA(At, 1, 1); PG8_STAGE(PG8_SB(1, 0), b3, voffB); PG8_STAGE(PG8_SB(1, 1), b3 + hstep, voffB); PG8_STAGE(PG8_SA(1, 0), a3, voffA);
            PG8_WAIT_V(8); PG8_WAIT_L(0); PG8_BAR; PG8_MMA(1, 0, At, B0); PG8_MMA(1, 1, At, B1); PG8_BAR; PG8_SCHED;
            } else {
            PG8_LDB(B0, 0, 0); PG8_SCHED; PG8_LDA(At, 0, 0); PG8_STAGE(PG8_SA(1, 1), a1 + hstep, voffA);
            PG8_WAIT_L(8); PG8_BAR; PG8_WAIT_L(0); PG8_MMA(0, 0, At, B0); PG8_BAR; PG8_SCHED;
            PG8_LDB(B1, 0, 1); PG8_STAGE(PG8_SB(0, 0), b2, voffB);
            PG8_BAR; PG8_WAIT_L(0); PG8_MMA(0, 1, At, B1); PG8_BAR;
            PG8_LDA(At, 0, 1); PG8_STAGE(PG8_SA(0, 0), a2, voffA);
            PG8_BAR; PG8_WAIT_L(0); PG8_MMA(1, 0, At, B0); PG8_BAR; PG8_SCHED;
            PG8_STAGE(PG8_SB(0, 1), b2 + hstep, voffB);
            PG8_WAIT_V(6); PG8_BAR; PG8_MMA(1, 1, At, B1); PG8_BAR;
            PG8_LDB(B0, 1, 0); PG8_SCHED; PG8_LDA(At, 1, 0); PG8_STAGE(PG8_SA(0, 1), a2 + hstep, voffA);
            PG8_WAIT_L(8); PG8_BAR; PG8_WAIT_L(0); PG8_MMA(0, 0, At, B0); PG8_BAR; PG8_SCHED;
            PG8_LDB(B1, 1, 1); PG8_STAGE(PG8_SB(1, 0), b3, voffB);
            PG8_BAR; PG8_WAIT_L(0); PG8_MMA(0, 1, At, B1); PG8_BAR;
            PG8_LDA(At, 1, 1); PG8_STAGE(PG8_SA(1, 0), a3, voffA);
            PG8_BAR; PG8_WAIT_L(0); PG8_MMA(1, 0, At, B0); PG8_BAR; PG8_SCHED;
            PG8_STAGE(PG8_SB(1, 1), b3 + hstep, voffB);
            PG8_WAIT_V(6); PG8_BAR; PG8_MMA(1, 1, At, B1); PG8_BAR;
            }
        }
        if constexpr (ALIGN_EPI) { if (wr == 0) PG8_BAR; }
        E(acc, cur, wr, wc, fr, fq); S.done(cur);
        if (!has_next) break;
#pragma unroll
        for (int a = 0; a < 2; ++a)
#pragma unroll
            for (int b = 0; b < 2; ++b)
#pragma unroll
                for (int m = 0; m < 4; ++m)
#pragma unroll
                    for (int n = 0; n < 2; ++n) acc[a][b][m][n] = (f32x4){0.f, 0.f, 0.f, 0.f};
        cur = nxt; cA = nA; cB = nB; ++ui;
        if constexpr (ALIGN_EPI) { if (wr == 1) PG8_BAR; }
    }
    PG8_WAIT_V(0);
    if constexpr (!ALIGN_EPI) { if (wr == 0) PG8_BAR; }
    PG8_BAR;
#undef PG8_SA
#undef PG8_SB
#undef PG8_STAGE
#undef PG8_LDA
#undef PG8_LDB
#undef PG8_MMA
#undef PG8_WAIT_V
#undef PG8_WAIT_L
#undef PG8_BAR
#undef PG8_SCHED
}

struct EpiSwiGLU {
    static constexpr bool PERM = false;
    bf16_t* ACT;
    DEVI void operator()(const f32x4 (&acc)[2][2][4][2], const Unit& u, int wr, int wc, int fr, int fq) const {
#pragma unroll
        for (int ai = 0; ai < 2; ++ai)
#pragma unroll
            for (int m = 0; m < 4; ++m) {
                const int row = u.pm * BM + ai * HALF + wr * 64 + m * 16 + fr;
                bf16_t* rp = ACT + (size_t)row * DFF + 16 * (8 * u.pn + wc) + 4 * fq;
#pragma unroll
                for (int bj = 0; bj < 2; ++bj) {
                    const f32x4 a = acc[ai][bj][m][0], b = acc[ai][bj][m][1];
                    u32x2 pk;
                    pk.x = pk2(a[0] * sigmoidf_(a[0]) * b[0], a[1] * sigmoidf_(a[1]) * b[1]);
                    pk.y = pk2(a[2] * sigmoidf_(a[2]) * b[2], a[3] * sigmoidf_(a[3]) * b[3]);
                    *(u32x2*)(rp + 64 * bj) = pk;
                }
            }
    }
};
struct EpiResid {
    static constexpr bool PERM = false;
    float* X; const float* gate_base; float coef;
    DEVI void operator()(const f32x4 (&acc)[2][2][4][2], const Unit& u, int wr, int wc, int fr, int fq) const {
        const float* gate = gate_base + (size_t)mod_group(u.pm * BM) * 9216;
        const int col0 = u.pn * BM + wc * 32 + 4 * fq;
        f32x4 gv[2][2];
#pragma unroll
        for (int bj = 0; bj < 2; ++bj)
#pragma unroll
            for (int n = 0; n < 2; ++n) gv[bj][n] = *(const f32x4*)(gate + col0 + bj * HALF + 16 * n) * coef;
#pragma unroll
        for (int ai = 0; ai < 2; ++ai)
#pragma unroll
            for (int m = 0; m < 4; ++m) {
                const int row = u.pm * BM + ai * HALF + wr * 64 + m * 16 + fr;
                float* rp = X + (size_t)row * D + col0;
#pragma unroll
                for (int bj = 0; bj < 2; ++bj)
#pragma unroll
                    for (int n = 0; n < 2; ++n) {
                        f32x4* xp = (f32x4*)(rp + bj * HALF + 16 * n);
                        *xp = (*xp) * ALPHA_F + gv[bj][n] * acc[ai][bj][m][n];
                    }
                if (m == 3) __builtin_amdgcn_sched_barrier(0);
            }
    }
};
struct EpiIn {
    static constexpr bool PERM = true;
    unsigned char* ws; float* out; const float* b_gate; int l;
    static DEVI u32x4 pack8(const f32x4& a, const f32x4& b, float s) {
        u32x4 w; w.x = pk2(a[0] * s, a[1] * s); w.y = pk2(a[2] * s, a[3] * s); w.z = pk2(b[0] * s, b[1] * s); w.w = pk2(b[2] * s, b[3] * s); return w;
    }
    DEVI void operator()(const f32x4 (&acc)[2][2][4][2], const Unit& u, int wr, int wc, int fr_, int fq_) const {
        int fr = fr_, fq = fq_; asm volatile("" : "+v"(fr), "+v"(fq));
        unsigned char* ws = this->ws; float* out = this->out; const float* b_gate = this->b_gate;
        asm volatile("" : "+s"(ws), "+s"(out), "+s"(b_gate));
        const bool ctx = u.pm * BM < NCTX;
#pragma unroll
        for (int bj = 0; bj < 2; ++bj) {
            const int n0 = u.pn * BM + bj * HALF;
            const int c8 = n0 + wc * 32 + 8 * fq;
            f32x4 bg0 = (f32x4){0.f, 0.f, 0.f, 0.f}, bg1 = bg0;
            if (n0 >= 2816) { bg0 = *(const f32x4*)(b_gate + l * 3072 + c8 - 2816); bg1 = *(const f32x4*)(b_gate + l * 3072 + c8 - 2816 + 4); }
#pragma unroll
            for (int ai = 0; ai < 2; ++ai)
#pragma unroll
                for (int m = 0; m < 4; ++m) {
                    const int row = u.pm * BM + ai * HALF + wr * 64 + m * 16 + fr;
                    const f32x4 v0 = acc[ai][bj][m][0], v1 = acc[ai][bj][m][1];
                    if (n0 < 512) {
                        *(u32x4*)((bf16_t*)(ws + WS_UF) + (size_t)row * 512 + c8) = pack8(v0, v1, 1.f);
                    } else if (n0 < 896) {
                        *(u32x4*)((bf16_t*)(ws + WS_UQ) + (size_t)row * 384 + (c8 - 512)) = pack8(v0, v1, 1.f);
                    } else if (n0 < 1152) {
                        float* o = (float*)(ws + WS_UKV) + (size_t)row * 256 + (c8 - 896);
                        *(f32x4*)o = v0; *(f32x4*)(o + 4) = v1;
                    } else if (n0 < 1280) {
                        if (wc == 0) { float* o = (float*)(ws + WS_KRF) + (size_t)row * 32 + 8 * fq; *(f32x4*)o = v0; *(f32x4*)(o + 4) = v1; }
                    } else if (n0 < 1792) {
                        *(u32x4*)((bf16_t*)(ws + WS_NAQ) + (size_t)row * 512 + (c8 - 1280)) = pack8(v0, v1, NA_QS);
                    } else if (n0 < 2304) {
                        const int cc = c8 - 1792;
                        *(u32x4*)((bf16_t*)(ws + WS_NAK) + (size_t)row * 512 + cc) = pack8(v0, v1, 1.f);
                        if (ctx) { float* o = out + OUT_NAK + ((size_t)((row >> 8) * 4 + l) * 256 + (row & 255)) * 512 + cc; *(f32x4*)o = v0; *(f32x4*)(o + 4) = v1; }
                    } else if (n0 < 2816) {
                        const int cc = c8 - 2304, h = cc >> 6, d0 = cc & 63;
                        bf16_t* VT = (bf16_t*)(ws + WS_NAVT);
                        bf16_t* vp;
                        size_t cstride;
                        if (ctx) {
                            const int b = row >> 8, s = row & 255;
                            float* o = out + OUT_NAV + ((size_t)(b * 4 + l) * 256 + s) * 512 + cc; *(f32x4*)o = v0; *(f32x4*)(o + 4) = v1;
                            vp = VT + ((size_t)((b * 8 + h) * 64 + d0)) * 256 + s; cstride = 256;
                        } else {
                            const int rr = row - NCTX, b = rr >> 11, n = rr & 2047;
                            vp = VT + (size_t)4194304 + ((size_t)((b * 8 + h) * 64 + d0)) * 2048 + n; cstride = 2048;
                        }
#pragma unroll
                        for (int e = 0; e < 4; ++e) { vp[(size_t)e * cstride] = f2bf(v0[e]); vp[(size_t)(4 + e) * cstride] = f2bf(v1[e]); }
                    } else {
                        f32x4 g0, g1;
#pragma unroll
                        for (int e = 0; e < 4; ++e) { g0[e] = sigmoidf_(v0[e] + bg0[e]); g1[e] = sigmoidf_(v1[e] + bg1[e]); }
                        *(u32x4*)((bf16_t*)(ws + WS_GATE) + (size_t)row * 3072 + (c8 - 2816)) = pack8(g0, g1, 1.f);
                    }
                    __builtin_amdgcn_sched_barrier(0);
                }
        }
    }
};
struct EpiMerge {
    static constexpr bool PERM = true;
    const bf16_t* GATE; float* T; bf16_t* MG; int s;
    DEVI void operator()(const f32x4 (&acc)[2][2][4][2], const Unit& u, int wr, int wc, int fr_, int fq_) const {
        int fr = fr_, fq = fq_; asm volatile("" : "+v"(fr), "+v"(fq));
#pragma unroll
        for (int ai = 0; ai < 2; ++ai)
#pragma unroll
            for (int m = 0; m < 4; ++m) {
                const int row = u.pm * BM + ai * HALF + wr * 64 + m * 16 + fr;
#pragma unroll
                for (int bj = 0; bj < 2; ++bj) {
                    const int c8 = u.pn * BM + bj * HALF + wc * 32 + 8 * fq;
                    const u32x4 g = *(const u32x4*)(GATE + (size_t)row * 3072 + s * 1024 + c8);
                    f32x4 v0 = acc[ai][bj][m][0], v1 = acc[ai][bj][m][1];
                    v0[0] *= bf2f(g.x & 0xffffu); v0[1] *= bf2f(g.x >> 16); v0[2] *= bf2f(g.y & 0xffffu); v0[3] *= bf2f(g.y >> 16);
                    v1[0] *= bf2f(g.z & 0xffffu); v1[1] *= bf2f(g.z >> 16); v1[2] *= bf2f(g.w & 0xffffu); v1[3] *= bf2f(g.w >> 16);
                    float* tp = T + (size_t)row * D + c8;
                    if (s > 0) { v0 += *(const f32x4*)tp; v1 += *(const f32x4*)(tp + 4); }
                    if (s < 2) { *(f32x4*)tp = v0; *(f32x4*)(tp + 4) = v1; }
                    else *(u32x4*)(MG + (size_t)row * D + c8) = EpiIn::pack8(v0, v1, 1.f);
                }
                if (m & 1) __builtin_amdgcn_sched_barrier(0);
            }
    }
};
}

DEVI void job_ffn_up(const P& p, unsigned char* ws_b, int l, int which, int t, bf16_t* sm, int tid) {
    const int nN = 44; const int m0 = (t / nN) * 128, n0 = (t % nN) * 128;
    const bf16_t* H = (const bf16_t*)(ws_b + WS_H);
    const bf16_t* W = (const bf16_t*)(ws_b + WS_W) + (size_t)l * LAYER_W + (which ? OFF_W13_2 : OFF_W13_1);
    bf16_t* ACT = (bf16_t*)(ws_b + WS_ACT);
    f32x16 acc[2][2]; zero_acc(acc);
    gemm_core(H + (size_t)m0 * D, D, W + (size_t)n0 * D, D, D, acc, sm, tid);
    EPI_SETUP
    const int oc = (n0 >> 1) + wc * 32 + c32;
#pragma unroll
    for (int i = 0; i < 2; ++i) {
        const int rb = m0 + wr * 64 + i * 32 + 4 * hl;
#pragma unroll
        for (int r = 0; r < 16; ++r) {
            const int row = rb + (r & 3) + 8 * (r >> 2);
            const float a = acc[i][0][r], b = acc[i][1][r];
            const float v = a * sigmoidf_(a) * b;
            ACT[(size_t)row * DFF + oc] = f2bf(v);
        }
    }
}

DEVI void job_resid(const P& p, unsigned char* ws_b, const bf16_t* A, int lda, const bf16_t* Bt, int K, const float* gate_base, float coef, int t, bf16_t* sm, int tid) {
    const int nN = 8; const int m0 = (t / nN) * 128, n0 = (t % nN) * 128;
    float* X = (float*)(ws_b + WS_X);
    f32x16 acc[2][2]; zero_acc(acc);
    gemm_core(A + (size_t)m0 * lda, lda, Bt + (size_t)n0 * K, K, K, acc, sm, tid);
    EPI_SETUP
    const float* gate = gate_base + (size_t)mod_group(m0) * 9216;
#pragma unroll
    for (int j = 0; j < 2; ++j) {
        const int col = n0 + wc * 64 + j * 32 + c32;
        const float gv = coef * gate[col];
#pragma unroll
        for (int i = 0; i < 2; ++i) {
            const int rb = m0 + wr * 64 + i * 32 + 4 * hl;
#pragma unroll
            for (int r = 0; r < 16; ++r) {
                const int row = rb + (r & 3) + 8 * (r >> 2);
                float* xp = X + (size_t)row * D + col;
                *xp = ALPHA_F * (*xp) + gv * acc[i][j][r];
            }
        }
    }
}

DEVI void job_in(const P& p, unsigned char* ws_b, int l, int t, bf16_t* sm, int tid) {
    const int nN = 46; const int m0 = (t / nN) * 128, n0 = (t % nN) * 128;
    const bf16_t* H = (const bf16_t*)(ws_b + WS_H);
    const bf16_t* W = (const bf16_t*)(ws_b + WS_W) + (size_t)l * LAYER_W + OFF_WIN;
    f32x16 acc[2][2]; zero_acc(acc);
    gemm_core(H + (size_t)m0 * D, D, W + (size_t)n0 * D, D, D, acc, sm, tid);
    EPI_SETUP
    const bool ctx = m0 < NCTX;
#pragma unroll
    for (int j = 0; j < 2; ++j) {
        const int col = n0 + wc * 64 + j * 32 + c32;
#pragma unroll
        for (int i = 0; i < 2; ++i) {
            const int rb = m0 + wr * 64 + i * 32 + 4 * hl;
            if (n0 < 512) {
                bf16_t* O = (bf16_t*)(ws_b + WS_UF);
#pragma unroll
                for (int r = 0; r < 16; ++r) O[(size_t)(rb + (r & 3) + 8 * (r >> 2)) * 512 + col] = f2bf(acc[i][j][r]);
            } else if (n0 < 896) {
                bf16_t* O = (bf16_t*)(ws_b + WS_UQ);
#pragma unroll
                for (int r = 0; r < 16; ++r) O[(size_t)(rb + (r & 3) + 8 * (r >> 2)) * 384 + (col - 512)] = f2bf(acc[i][j][r]);
            } else if (n0 < 1152) {
                float* O = (float*)(ws_b + WS_UKV);
#pragma unroll
                for (int r = 0; r < 16; ++r) O[(size_t)(rb + (r & 3) + 8 * (r >> 2)) * 256 + (col - 896)] = acc[i][j][r];
            } else if (n0 < 1280) {
                if (col < 1184) {
                    float* O = (float*)(ws_b + WS_KRF);
#pragma unroll
                    for (int r = 0; r < 16; ++r) O[(size_t)(rb + (r & 3) + 8 * (r >> 2)) * 32 + (col - 1152)] = acc[i][j][r];
                }
            } else if (n0 < 1792) {
                bf16_t* O = (bf16_t*)(ws_b + WS_NAQ);
#pragma unroll
                for (int r = 0; r < 16; ++r) O[(size_t)(rb + (r & 3) + 8 * (r >> 2)) * 512 + (col - 1280)] = f2bf(acc[i][j][r] * NA_QS);
            } else if (n0 < 2304) {
                bf16_t* O = (bf16_t*)(ws_b + WS_NAK);
                const int cc = col - 1792;
#pragma unroll
                for (int r = 0; r < 16; ++r) {
                    const int row = rb + (r & 3) + 8 * (r >> 2);
                    O[(size_t)row * 512 + cc] = f2bf(acc[i][j][r]);
                    if (ctx) p.out[OUT_NAK + ((size_t)((row >> 8) * 4 + l) * 256 + (row & 255)) * 512 + cc] = acc[i][j][r];
                }
            } else if (n0 < 2816) {
                bf16_t* VT = (bf16_t*)(ws_b + WS_NAVT);
                const int cc = col - 2304, h = cc >> 6, d = cc & 63;
#pragma unroll
                for (int qd = 0; qd < 4; ++qd) {
                    const int row = rb + 8 * qd;
                    u32x2 pk; pk.x = pk2(acc[i][j][4 * qd], acc[i][j][4 * qd + 1]); pk.y = pk2(acc[i][j][4 * qd + 2], acc[i][j][4 * qd + 3]);
                    if (ctx) {
                        const int b = row >> 8, s = row & 255;
                        *(u32x2*)(VT + ((size_t)((b * 8 + h) * 64 + d)) * 256 + s) = pk;
#pragma unroll
                        for (int e = 0; e < 4; ++e)
                            p.out[OUT_NAV + ((size_t)(b * 4 + l) * 256 + (s + e)) * 512 + cc] = acc[i][j][4 * qd + e];
                    } else {
                        const int rr = row - NCTX, b = rr >> 11, n = rr & 2047;
                        *(u32x2*)(VT + (size_t)4194304 + ((size_t)((b * 8 + h) * 64 + d)) * 2048 + n) = pk;
                    }
                }
            } else {
                bf16_t* O = (bf16_t*)(ws_b + WS_GATE);
                const int gc = col - 2816;
                const float bg = pin(p, 26)[l * 3072 + gc];
                bf16_t* gp = O + (size_t)gc * M + rb;
#pragma unroll
                for (int qd = 0; qd < 4; ++qd) {
                    u32x2 pk;
                    pk.x = pk2(sigmoidf_(acc[i][j][4 * qd] + bg), sigmoidf_(acc[i][j][4 * qd + 1] + bg));
                    pk.y = pk2(sigmoidf_(acc[i][j][4 * qd + 2] + bg), sigmoidf_(acc[i][j][4 * qd + 3] + bg));
                    *(u32x2*)(gp + 8 * qd) = pk;
                }
            }
        }
    }
}

DEVI void job_uq(const P& p, unsigned char* ws_b, int l, int t, bf16_t* sm, int tid) {
    const int nN = 6; const int m0 = (t / nN) * 128, n0 = (t % nN) * 128;
    const bf16_t* A = (const bf16_t*)(ws_b + WS_UQ);
    const bf16_t* W = (const bf16_t*)(ws_b + WS_W) + (size_t)l * LAYER_W + OFF_WUQ;
    bf16_t* Q = (bf16_t*)(ws_b + WS_Q);
    const float* ropec = (const float*)(ws_b + WS_ROPE);
    const float* ropes = ropec + 512;
    f32x16 acc[2][2]; zero_acc(acc);
    gemm_core(A + (size_t)m0 * 384, 384, W + (size_t)n0 * 384, 384, 384, acc, sm, tid);
    EPI_SETUP
    const bool lat = m0 >= NCTX;
#pragma unroll
    for (int j = 0; j < 2; ++j) {
        const int c0 = n0 + wc * 64 + j * 32;
        const int col = c0 + c32;
        const bool rope = lat && (((c0 >> 5) % 3) == 2);
        const int axis = c32 >> 4, ii = c32 & 15;
#pragma unroll
        for (int i = 0; i < 2; ++i) {
            const int rb = m0 + wr * 64 + i * 32 + 4 * hl;
#pragma unroll
            for (int r = 0; r < 16; ++r) {
                const int row = rb + (r & 3) + 8 * (r >> 2);
                float v = acc[i][j][r];
                const float pr = __shfl_xor(v, 8);
                if (rope) {
                    const int n = (row - NCTX) & 2047;
                    const int pos = axis ? (n & 63) : (n >> 6);
                    const float cs = ropec[pos * 8 + (ii & 7)], sn = ropes[pos * 8 + (ii & 7)];
                    const float rot = (ii < 8) ? -pr : pr;
                    v = v * cs + rot * sn;
                }
                Q[(size_t)row * 768 + col] = f2bf(v * MLA_QS);
            }
        }
    }
}

DEVI void job_ukv(const P& p, unsigned char* ws_b, int l, int t, bf16_t* sm, int tid) {
    const int nN = 8; const int m0 = (t / nN) * 128, h = t % nN, n0 = h * 128;
    const bf16_t* A = (m0 < M) ? (const bf16_t*)(ws_b + WS_CKV) + (size_t)m0 * 256
                               : (const bf16_t*)(ws_b + WS_CCKV) + ((size_t)l * 1024 + (m0 - M)) * 256;
    const bf16_t* W = (const bf16_t*)(ws_b + WS_W) + (size_t)l * LAYER_W + OFF_WUKV;
    bf16_t* KN = (bf16_t*)(ws_b + WS_KN);
    bf16_t* VT = (bf16_t*)(ws_b + WS_VTM);
    f32x16 acc[2][2]; zero_acc(acc);
    gemm_core(A, 256, W + (size_t)n0 * 256, 256, 256, acc, sm, tid);
    EPI_SETUP
#pragma unroll
    for (int j = 0; j < 2; ++j) {
        const int d = j * 32 + c32;
#pragma unroll
        for (int i = 0; i < 2; ++i) {
            const int rb = m0 + wr * 64 + i * 32 + 4 * hl;
            if (wc == 0) {
#pragma unroll
                for (int r = 0; r < 16; ++r) KN[(size_t)(rb + (r & 3) + 8 * (r >> 2)) * 512 + h * 64 + d] = f2bf(acc[i][j][r]);
            } else {
#pragma unroll
                for (int qd = 0; qd < 4; ++qd) {
                    const int row = rb + 8 * qd;
                    u32x2 pk; pk.x = pk2(acc[i][j][4 * qd], acc[i][j][4 * qd + 1]); pk.y = pk2(acc[i][j][4 * qd + 2], acc[i][j][4 * qd + 3]);
                    size_t addr;
                    if (m0 < NCTX) { const int b = row >> 8, s = row & 255; addr = ((size_t)((b * 8 + h) * 64 + d)) * 256 + s; }
                    else if (m0 < M) { const int rr = row - NCTX, b = rr >> 11, n = rr & 2047; addr = (size_t)4194304 + ((size_t)((b * 8 + h) * 64 + d)) * 2560 + n; }
                    else { const int rr = row - M, b = rr >> 9, n = rr & 511; addr = (size_t)4194304 + ((size_t)((b * 8 + h) * 64 + d)) * 2560 + 2048 + n; }
                    *(u32x2*)(VT + addr) = pk;
                }
            }
        }
    }
}

template <int ldo, bool SPLITK = false>
DEVI void job_store(const bf16_t* A, int lda, const bf16_t* Bt, int ldb, int K, bf16_t* Out, bf16_t* sm, int tid, int grp = 0, float* xch = nullptr) {
    f32x16 acc[2][2]; zero_acc(acc);
    if constexpr (SPLITK) { K >>= 1; A += grp * K; Bt += grp * K; }
    gemm_core(A, lda, Bt, ldb, K, acc, sm, tid);
    EPI_SETUP
    if constexpr (SPLITK) {
        if (grp == 1) {
#pragma unroll
            for (int i = 0; i < 2; ++i)
#pragma unroll
                for (int j = 0; j < 2; ++j)
#pragma unroll
                    for (int r = 0; r < 16; ++r) xch[((i * 2 + j) * 16 + r) * 256 + tid] = acc[i][j][r];
        }
        __syncthreads();
        if (grp == 0) {
#pragma unroll
            for (int i = 0; i < 2; ++i)
#pragma unroll
                for (int j = 0; j < 2; ++j)
#pragma unroll
                    for (int r = 0; r < 16; ++r) acc[i][j][r] += xch[((i * 2 + j) * 16 + r) * 256 + tid];
        }
        __syncthreads();
    }
    const bool active = !SPLITK || grp == 0;
    bf16_t* st = sm + (wr * 64 + 4 * hl) * 136 + wc * 64 + c32;
    if (active) {
#pragma unroll
        for (int i = 0; i < 2; ++i)
#pragma unroll
            for (int j = 0; j < 2; ++j)
#pragma unroll
                for (int r = 0; r < 16; ++r) st[(i * 32 + (r & 3) + 8 * (r >> 2)) * 136 + j * 32] = f2bf(acc[i][j][r]);
    }
    __syncthreads();
    if (active) {
        const int orow = tid >> 4, oc = (tid & 15) * 8;
#pragma unroll
        for (int k = 0; k < 8; ++k) {
            const u32x4 v = *(const u32x4*)(sm + (orow + 16 * k) * 136 + oc);
            *(u32x4*)(Out + (size_t)(orow + 16 * k) * ldo + oc) = v;
        }
    }
    __syncthreads();
}

DEVI void job_f1(const P& p, unsigned char* ws_b, int t, bf16_t* sm, int tid) {
    const bf16_t* WCS = (const bf16_t*)(ws_b + WS_WCS);
    const bf16_t* UF = (const bf16_t*)(ws_b + WS_UF);
    bf16_t* F1T = (bf16_t*)(ws_b + WS_F1T);
    if (t < 512) {
        const int bs = t >> 4, g = (t >> 2) & 3, mi = (t >> 1) & 1, ni = t & 1;
        job_store<256>(WCS + mi * 128 * 128, 128, UF + ((size_t)bs * 256 + ni * 128) * 512 + g * 128, 512, 128,
                  F1T + ((size_t)(bs * 4 + g) * 256 + mi * 128) * 256 + ni * 128, sm, tid);
    } else {
        t -= 512;
        const int bs = t >> 7, g = (t >> 5) & 3, mi = (t >> 4) & 1, ni = t & 15;
        job_store<2048>(WCS + mi * 128 * 128, 128, UF + ((size_t)NCTX + bs * 2048 + ni * 128) * 512 + g * 128, 512, 128,
                  F1T + (size_t)8388608 + ((size_t)(bs * 4 + g) * 256 + mi * 128) * 2048 + ni * 128, sm, tid);
    }
}
DEVI void job_f2_lat(const P& p, unsigned char* ws_b, int t, bf16_t* sm, int tid, int grp, float* xch) {
    const int bs = t >> 6, mi = (t >> 2) & 15, ni = t & 3;
    const bf16_t* TAB = (const bf16_t*)(ws_b + WS_TABL);
    const bf16_t* F1T = (const bf16_t*)(ws_b + WS_F1T) + (size_t)8388608;
    bf16_t* YF = (bf16_t*)(ws_b + WS_YF);
    job_store<512, true>(TAB + (size_t)mi * 128 * 4096, 4096, F1T + (size_t)bs * 512 * 4096 + (size_t)ni * 128 * 4096, 4096, 4096,
              YF + ((size_t)NCTX + bs * 2048 + mi * 128) * 512 + ni * 128, sm, tid, grp, xch);
}
DEVI void job_f2_ctx(const P& p, unsigned char* ws_b, int t, bf16_t* sm, int tid) {
    const int bs = t >> 3, mi = (t >> 2) & 1, ni = t & 3;
    const bf16_t* TAB = (const bf16_t*)(ws_b + WS_TABC);
    const bf16_t* F1T = (const bf16_t*)(ws_b + WS_F1T);
    bf16_t* YF = (bf16_t*)(ws_b + WS_YF);
    job_store<512>(TAB + (size_t)mi * 128 * 512, 512, F1T + (size_t)bs * 512 * 512 + (size_t)ni * 128 * 512, 512, 512,
              YF + ((size_t)bs * 256 + mi * 128) * 512 + ni * 128, sm, tid);
}

DEVI void job_merge(const P& p, unsigned char* ws_b, int l, int t, bf16_t* sm, int tid) {
    const int nN = 8; const int m0 = (t / nN) * 128, n0 = (t % nN) * 128;
    const bf16_t* Wl = (const bf16_t*)(ws_b + WS_W) + (size_t)l * LAYER_W;
    const bf16_t* GATE = (const bf16_t*)(ws_b + WS_GATE);
    bf16_t* MG = (bf16_t*)(ws_b + WS_MERGED);
    EPI_SETUP
    f32x16 acc[2][2]; zero_acc(acc);
#pragma unroll 1
    for (int s = 0; s < 3; ++s) {
        const bf16_t* A = (const bf16_t*)(ws_b + (s == 0 ? WS_YF : (s == 1 ? WS_YM : WS_YN)));
        const bf16_t* W = Wl + (s == 0 ? OFF_WBF : (s == 1 ? OFF_WBM : OFF_WBN));
        gemm_core<false>(A + (size_t)m0 * 512, 512, W + (size_t)n0 * 512, 512, 512, acc, sm, tid);
        {
            const int gr = tid >> 4, gc = (tid & 15) * 8;
            const int s1 = s < 2 ? s + 1 : s;
#pragma unroll
            for (int k = 0; k < 8; ++k) {
                const bf16_t* gsrc = GATE + (size_t)(m0 + gr + 16 * k) * 3072 + n0 + gc;
                *(u32x4*)(sm + (gr + 16 * k) * 136 + gc) = *(const u32x4*)(gsrc + s * 1024);
                *(u32x4*)(sm + 128 * 136 + (gr + 16 * k) * 136 + gc) = *(const u32x4*)(gsrc + s1 * 1024);
                if ((k & 1) == 1) __builtin_amdgcn_sched_barrier(0);
            }
        }
        __syncthreads();
#pragma unroll
        for (int j = 0; j < 2; ++j)
#pragma unroll
            for (int i = 0; i < 2; ++i) {
                const bf16_t* gp = sm + (wr * 64 + i * 32 + 4 * hl) * 136 + wc * 64 + j * 32 + c32;
#pragma unroll
                for (int r = 0; r < 16; ++r) {
                    const int o = ((r & 3) + 8 * (r >> 2)) * 136;
                    const float g = bf2f(gp[o]);
                    const float f = (s < 2) ? g * __builtin_amdgcn_rcpf(bf2f(gp[128 * 136 + o])) : g;
                    acc[i][j][r] *= f;
                }
            }
        __syncthreads();
    }
#pragma unroll
    for (int j = 0; j < 2; ++j) {
        const int col = n0 + wc * 64 + j * 32 + c32;
#pragma unroll
        for (int i = 0; i < 2; ++i) {
            const int rb = m0 + wr * 64 + i * 32 + 4 * hl;
#pragma unroll
            for (int r = 0; r < 16; ++r) MG[(size_t)(rb + (r & 3) + 8 * (r >> 2)) * 1024 + col] = f2bf(acc[i][j][r]);
        }
    }
}

struct TileSrc { const bf16_t* k; const bf16_t* k2; const bf16_t* v; const bf16_t* vhi; };
DEVI int pi_row(int r) { return (r & 0x13) | ((r & 4) << 1) | ((r & 8) >> 1); }

template <int NKS>
DEVI void attn_load(const TileSrc& s, bf16x8 (&kf)[NKS], bf16x8 (&vf)[4]) {
#pragma unroll
    for (int ks = 0; ks < NKS; ++ks) kf[ks] = (ks < 4) ? *(const bf16x8*)(s.k + ks * 16) : *(const bf16x8*)(s.k2 + (ks - 4) * 16);
    vf[0] = *(const bf16x8*)(s.v);
    vf[1] = *(const bf16x8*)(s.v + 16);
    vf[2] = *(const bf16x8*)(s.vhi);
    vf[3] = *(const bf16x8*)(s.vhi + 16);
}

template <int NKS, bool SPLIT, class Src, class Mask>
DEVI void attn_wave(const bf16_t* qptr, int t0, int nt, Src src, Mask mask, bf16_t* optr, int lane, float* ex = nullptr, int half = 0) {
    bf16x8 q[NKS];
#pragma unroll
    for (int ks = 0; ks < NKS; ++ks) q[ks] = *(const bf16x8*)(qptr + ks * 16);
    f32x16 o0, o1;
#pragma unroll
    for (int r = 0; r < 16; ++r) { o0[r] = 0.f; o1[r] = 0.f; }
    float m = -1e30f, lsum = 0.f;
    bf16x8 kf[NKS], vf[4];
    nt += t0;
    { TileSrc s0 = src(t0); attn_load<NKS>(s0, kf, vf); }
    for (int t = t0; t < nt; ++t) {
        bf16x8 kn[NKS], vn[4];
        { TileSrc s1 = src(t + 1 < nt ? t + 1 : t); attn_load<NKS>(s1, kn, vn); }
        f32x16 s;
#pragma unroll
        for (int r = 0; r < 16; ++r) s[r] = 0.f;
#pragma unroll
        for (int ks = 0; ks < NKS; ++ks) s = __builtin_amdgcn_mfma_f32_32x32x16_bf16(kf[ks], q[ks], s, 0, 0, 0);
        mask(t, s);
        float mx = s[0];
#pragma unroll
        for (int r = 1; r < 16; ++r) mx = fmaxf(mx, s[r]);
        mx = fmaxf(mx, __shfl_xor(mx, 32));
        const float mn = fmaxf(m, mx);
        const float alpha = fast_exp2(m - mn);
        m = mn;
        float rs = 0.f;
#pragma unroll
        for (int r = 0; r < 16; ++r) { s[r] = fast_exp2(s[r] - mn); rs += s[r]; }
        lsum = lsum * alpha + rs;
#pragma unroll
        for (int r = 0; r < 16; ++r) { o0[r] *= alpha; o1[r] *= alpha; }
        bf16x8 p0, p1;
        {
            u32x4 a, b;
            a.x = pk2(s[0], s[1]); a.y = pk2(s[2], s[3]); a.z = pk2(s[4], s[5]); a.w = pk2(s[6], s[7]);
            b.x = pk2(s[8], s[9]); b.y = pk2(s[10], s[11]); b.z = pk2(s[12], s[13]); b.w = pk2(s[14], s[15]);
            p0 = __builtin_bit_cast(bf16x8, a); p1 = __builtin_bit_cast(bf16x8, b);
        }
        o0 = __builtin_amdgcn_mfma_f32_32x32x16_bf16(vf[0], p0, o0, 0, 0, 0);
        o0 = __builtin_amdgcn_mfma_f32_32x32x16_bf16(vf[1], p1, o0, 0, 0, 0);
        o1 = __builtin_amdgcn_mfma_f32_32x32x16_bf16(vf[2], p0, o1, 0, 0, 0);
        o1 = __builtin_amdgcn_mfma_f32_32x32x16_bf16(vf[3], p1, o1, 0, 0, 0);
#pragma unroll
        for (int ks = 0; ks < NKS; ++ks) kf[ks] = kn[ks];
#pragma unroll
        for (int x = 0; x < 4; ++x) vf[x] = vn[x];
    }
    if constexpr (SPLIT) {
        if (half == 1) {
#pragma unroll
            for (int r = 0; r < 16; ++r) { ex[r * 64 + lane] = o0[r]; ex[(16 + r) * 64 + lane] = o1[r]; }
            ex[32 * 64 + lane] = m; ex[33 * 64 + lane] = lsum;
        }
        __syncthreads();
        if (half == 0) {
            const float m2 = ex[32 * 64 + lane], l2 = ex[33 * 64 + lane];
            const float mn = fmaxf(m, m2), a1 = fast_exp2(m - mn), a2 = fast_exp2(m2 - mn);
            lsum = lsum * a1 + l2 * a2;
#pragma unroll
            for (int r = 0; r < 16; ++r) { o0[r] = o0[r] * a1 + ex[r * 64 + lane] * a2; o1[r] = o1[r] * a1 + ex[(16 + r) * 64 + lane] * a2; }
        }
        __syncthreads();
        if (half == 1) return;
    }
    lsum += __shfl_xor(lsum, 32);
    const float inv = 1.f / lsum;
    const int hl = lane >> 5;
#pragma unroll
    for (int qd = 0; qd < 4; ++qd) {
        u32x2 a, b;
        a.x = pk2(o0[4 * qd] * inv, o0[4 * qd + 1] * inv); a.y = pk2(o0[4 * qd + 2] * inv, o0[4 * qd + 3] * inv);
        b.x = pk2(o1[4 * qd] * inv, o1[4 * qd + 1] * inv); b.y = pk2(o1[4 * qd + 2] * inv, o1[4 * qd + 3] * inv);
        *(u32x2*)(optr + 8 * qd + 4 * hl) = a;
        *(u32x2*)(optr + 32 + 8 * qd + 4 * hl) = b;
    }
}

struct NoMask { DEVI void operator()(int, f32x16&) const {} };

DEVI void attn_mla(const P& p, unsigned char* ws_b, int l, bool lat, int b, int h, int qg, int lane, float* ex = nullptr, int half = 0) {
    const int hl = lane >> 5, c32 = lane & 31, pr = pi_row(c32);
    const bf16_t* Q = (const bf16_t*)(ws_b + WS_Q);
    const bf16_t* KN = (const bf16_t*)(ws_b + WS_KN);
    const bf16_t* KR = (const bf16_t*)(ws_b + WS_KR);
    const bf16_t* CKR = (const bf16_t*)(ws_b + WS_CKR) + (size_t)l * 1024 * 32;
    const bf16_t* VT = (const bf16_t*)(ws_b + WS_VTM);
    bf16_t* YM = (bf16_t*)(ws_b + WS_YM);
    if (!lat) {
        const int row0 = b * 256;
        const int qrow = row0 + qg * 32 + c32;
        const bf16_t* k0 = KN + (size_t)(row0 + pr) * 512 + h * 64 + hl * 8;
        const bf16_t* r0 = KR + (size_t)(row0 + pr) * 32 + hl * 8;
        const bf16_t* v0 = VT + ((size_t)((b * 8 + h) * 64 + c32)) * 256 + hl * 8;
        auto src = [=](int t) { TileSrc s; s.k = k0 + (size_t)t * 32 * 512; s.k2 = r0 + (size_t)t * 32 * 32; s.v = v0 + t * 32; s.vhi = s.v + 32 * 256; return s; };
        attn_wave<6, false>(Q + (size_t)qrow * 768 + h * 96 + hl * 8, 0, 8, src, NoMask(), YM + (size_t)qrow * 512 + h * 64, lane);
    } else {
        const int row0 = NCTX + b * 2048;
        const int qrow = row0 + qg * 32 + c32;
        const bf16_t* k0 = KN + (size_t)(row0 + pr) * 512 + h * 64 + hl * 8;
        const bf16_t* r0 = KR + (size_t)(row0 + pr) * 32 + hl * 8;
        const bf16_t* k1 = KN + (size_t)(M + b * 512 + pr) * 512 + h * 64 + hl * 8;
        const bf16_t* r1 = CKR + (size_t)(b * 512 + pr) * 32 + hl * 8;
        const bf16_t* v0 = VT + (size_t)4194304 + ((size_t)((b * 8 + h) * 64 + c32)) * 2560 + hl * 8;
        auto src = [=](int t) {
            TileSrc s;
            if (t < 64) { s.k = k0 + (size_t)t * 32 * 512; s.k2 = r0 + (size_t)t * 32 * 32; }
            else { s.k = k1 + (size_t)(t - 64) * 32 * 512; s.k2 = r1 + (size_t)(t - 64) * 32 * 32; }
            s.v = v0 + t * 32; s.vhi = s.v + 32 * 2560; return s; };
        attn_wave<6, true>(Q + (size_t)qrow * 768 + h * 96 + hl * 8, half * 40, 40, src, NoMask(), YM + (size_t)qrow * 512 + h * 64, lane, ex, half);
    }
}

DEVI void attn_na_ctx(const P& p, unsigned char* ws_b, int b, int h, int qg, int lane) {
    const int hl = lane >> 5, c32 = lane & 31, pr = pi_row(c32);
    const bf16_t* Qn = (const bf16_t*)(ws_b + WS_NAQ);
    const bf16_t* Kn = (const bf16_t*)(ws_b + WS_NAK);
    const bf16_t* VT = (const bf16_t*)(ws_b + WS_NAVT);
    bf16_t* YN = (bf16_t*)(ws_b + WS_YN);
    const int row0 = b * 256, qrow = row0 + qg * 32 + c32;
    const bf16_t* k0 = Kn + (size_t)(row0 + pr) * 512 + h * 64 + hl * 8;
    const bf16_t* v0 = VT + ((size_t)((b * 8 + h) * 64 + c32)) * 256 + hl * 8;
    auto src = [=](int t) { TileSrc s; s.k = k0 + (size_t)t * 32 * 512; s.k2 = s.k; s.v = v0 + t * 32; s.vhi = s.v + 32 * 256; return s; };
    attn_wave<4, false>(Qn + (size_t)qrow * 512 + h * 64 + hl * 8, 0, 8, src, NoMask(), YN + (size_t)qrow * 512 + h * 64, lane);
}

struct NaMask {
    const float* rpb;
    int rs, rq, qc, hl;
    DEVI void operator()(int t, f32x16& s) const {
        if (t >= 16) return;
        const int kr = t >> 1, kh = t & 1;
        const int cs = min(max(qc - 8, 0), 48);
        const float* rp = rpb + (rs + kr - rq + 7) * 31;
#pragma unroll
        for (int r = 0; r < 16; ++r) {
            const int kk = (r & 3) + 4 * ((r >> 2) & 1) + 8 * hl + 16 * (r >> 3);
            const int kc = kh * 32 + kk;
            const bool ok = (kc >= cs) && (kc < cs + 16);
            const int dc = min(max(kc - qc + 15, 0), 30);
            const float bias = rp[dc] * LOG2E;
            s[r] = ok ? s[r] + bias : -1e30f;
        }
    }
};
DEVI void attn_na_lat(const P& p, unsigned char* ws_b, int l, int b, int h, int rq, int qh, int lane, float* ex, int half) {
    const int hl = lane >> 5, c32 = lane & 31, pr = pi_row(c32);
    const bf16_t* Qn = (const bf16_t*)(ws_b + WS_NAQ);
    const bf16_t* Kn = (const bf16_t*)(ws_b + WS_NAK);
    const bf16_t* VT = (const bf16_t*)(ws_b + WS_NAVT) + (size_t)4194304;
    const bf16_t* CK = (const bf16_t*)(ws_b + WS_CNAK) + (size_t)l * 1024 * 512;
    const bf16_t* CV = (const bf16_t*)(ws_b + WS_CNAVT) + (size_t)l * 1024 * 512;
    bf16_t* YN = (bf16_t*)(ws_b + WS_YN);
    const int row0 = NCTX + b * 2048;
    const int qrow = row0 + rq * 64 + qh * 32 + c32;
    const int rs = min(max(rq - 4, 0), 24);
    const bf16_t* k0 = Kn + (size_t)(row0 + rs * 64 + pr) * 512 + h * 64 + hl * 8;
    const bf16_t* v0 = VT + ((size_t)((b * 8 + h) * 64 + c32)) * 2048 + rs * 64 + hl * 8;
    const bf16_t* k1 = CK + (size_t)(b * 512 + pr) * 512 + h * 64 + hl * 8;
    const bf16_t* v1 = CV + ((size_t)((b * 8 + h) * 64 + c32)) * 512 + hl * 8;
    auto src = [=](int t) {
        TileSrc s;
        if (t < 16) { s.k = k0 + (size_t)t * 32 * 512; s.v = v0 + t * 32; s.vhi = s.v + 32 * 2048; }
        else { s.k = k1 + (size_t)(t - 16) * 32 * 512; s.v = v1 + (t - 16) * 32; s.vhi = s.v + 32 * 512; }
        s.k2 = s.k; return s; };
    NaMask mk; mk.rpb = pin(p, 21) + (size_t)(l * 8 + h) * 15 * 31; mk.rs = rs; mk.rq = rq; mk.qc = qh * 32 + c32; mk.hl = hl;
    attn_wave<4, true>(Qn + (size_t)qrow * 512 + h * 64 + hl * 8, half * 16, 16, src, mk, YN + (size_t)qrow * 512 + h * 64, lane, ex, half);
}

DEVI void row_ln_mod(const float* src, float* xdst, bf16_t* hdst, const float* lng, const float* lnb, const float* shift, const float* scale, int lane) {
    f32x4 v[4];
#pragma unroll
    for (int j = 0; j < 4; ++j) v[j] = *(const f32x4*)(src + 4 * lane + 256 * j);
    if (lng) {
        float s = 0.f;
#pragma unroll
        for (int j = 0; j < 4; ++j) s += (v[j].x + v[j].y) + (v[j].z + v[j].w);
        const float mu = wave_sum(s) * (1.f / D);
        float q = 0.f;
#pragma unroll
        for (int j = 0; j < 4; ++j) { v[j] = v[j] - mu; q += (v[j].x * v[j].x + v[j].y * v[j].y) + (v[j].z * v[j].z + v[j].w * v[j].w); }
        const float rstd = rsqrtf(wave_sum(q) * (1.f / D) + 1e-5f);
#pragma unroll
        for (int j = 0; j < 4; ++j) {
            const f32x4 g = *(const f32x4*)(lng + 4 * lane + 256 * j), bb = *(const f32x4*)(lnb + 4 * lane + 256 * j);
            v[j] = v[j] * rstd * g + bb;
        }
    }
    if (xdst) {
#pragma unroll
        for (int j = 0; j < 4; ++j) *(f32x4*)(xdst + 4 * lane + 256 * j) = v[j];
    }
    if (hdst) {
        float s = 0.f;
#pragma unroll
        for (int j = 0; j < 4; ++j) s += (v[j].x + v[j].y) + (v[j].z + v[j].w);
        const float mu = wave_sum(s) * (1.f / D);
        float q = 0.f;
#pragma unroll
        for (int j = 0; j < 4; ++j) { v[j] = v[j] - mu; q += (v[j].x * v[j].x + v[j].y * v[j].y) + (v[j].z * v[j].z + v[j].w * v[j].w); }
        const float rstd = rsqrtf(wave_sum(q) * (1.f / D) + 1e-6f);
#pragma unroll
        for (int j = 0; j < 4; ++j) {
            const f32x4 sc = *(const f32x4*)(scale + 4 * lane + 256 * j), sh = *(const f32x4*)(shift + 4 * lane + 256 * j);
            const f32x4 o = v[j] * rstd * (sc + 1.f) + sh;
            u32x2 pk; pk.x = pk2(o.x, o.y); pk.y = pk2(o.z, o.w);
            *(u32x2*)(hdst + 4 * lane + 256 * j) = pk;
        }
    }
}

DEVI void phase_rows(const P& p, unsigned char* ws_b, int l, int lnidx, int ml, int ms, bool final_, int gw, int ngw, int lane) {
    float* X = (float*)(ws_b + WS_X);
    bf16_t* H = (bf16_t*)(ws_b + WS_H);
    const float* MOD = (const float*)(ws_b + WS_MOD);
    for (int row = gw; row < M; row += ngw) {
        const float* src = (lnidx < 0) ? (row < NCTX ? pin(p, 0) + (size_t)row * D : pin(p, 1) + (size_t)(row - NCTX) * D) : X + (size_t)row * D;
        const float* lng = (lnidx < 0) ? nullptr : pin(p, 28) + (size_t)(l * 3 + lnidx) * D;
        const float* lnb = (lnidx < 0) ? nullptr : pin(p, 29) + (size_t)(l * 3 + lnidx) * D;
        if (final_) { row_ln_mod(src, p.out + (size_t)row * D, nullptr, lng, lnb, nullptr, nullptr, lane); continue; }
        const float* mb = MOD + ((size_t)ml * 3 + mod_group(row)) * 9216;
        row_ln_mod(src, X + (size_t)row * D, H + (size_t)row * D, lng, lnb, mb + ms * D, mb + (ms + 1) * D, lane);
    }
}

DEVI void phase_rowmix(const P& p, unsigned char* ws_b, int l, int gw, int ngw, int lane) {
    bf16_t* UQ = (bf16_t*)(ws_b + WS_UQ);
    const float* UKV = (const float*)(ws_b + WS_UKV);
    const float* KRF = (const float*)(ws_b + WS_KRF);
    bf16_t* CKV = (bf16_t*)(ws_b + WS_CKV);
    bf16_t* KR = (bf16_t*)(ws_b + WS_KR);
    const float* ropec = (const float*)(ws_b + WS_ROPE);
    const float* ropes = ropec + 512;
    const float* gq = pin(p, 17) + l * 384;
    const float* gkv = pin(p, 19) + l * 256;
    for (int row = gw; row < M; row += ngw) {
        {
            unsigned* up = (unsigned*)(UQ + (size_t)row * 384) + lane;
            float x[6]; float ss = 0.f;
#pragma unroll
            for (int j = 0; j < 3; ++j) { const unsigned w = up[64 * j]; x[2 * j] = bf2f(w & 0xffffu); x[2 * j + 1] = bf2f(w >> 16); ss += x[2 * j] * x[2 * j] + x[2 * j + 1] * x[2 * j + 1]; }
            const float rs = rsqrtf(wave_sum(ss) * (1.f / 384.f) + 1e-6f);
#pragma unroll
            for (int j = 0; j < 3; ++j) { const int c = 2 * lane + 128 * j; up[64 * j] = pk2(x[2 * j] * rs * gq[c], x[2 * j + 1] * rs * gq[c + 1]); }
        }
        {
            const f32x4 v = *(const f32x4*)(UKV + (size_t)row * 256 + 4 * lane);
            const float ss = v.x * v.x + v.y * v.y + v.z * v.z + v.w * v.w;
            const float rs = rsqrtf(wave_sum(ss) * (1.f / 256.f) + 1e-6f);
            const f32x4 g = *(const f32x4*)(gkv + 4 * lane);
            const f32x4 o = v * rs * g;
            u32x2 pk; pk.x = pk2(o.x, o.y); pk.y = pk2(o.z, o.w);
            *(u32x2*)(CKV + (size_t)row * 256 + 4 * lane) = pk;
            if (row < NCTX) *(f32x4*)(p.out + OUT_CKV + ((size_t)((row >> 8) * 4 + l) * 256 + (row & 255)) * 256 + 4 * lane) = o;
        }
        {
            const float v = KRF[(size_t)row * 32 + (lane & 31)];
            const float pr = __shfl_xor(v, 8);
            float o = v;
            if (row >= NCTX) {
                const int c = lane & 31, axis = c >> 4, ii = c & 15, n = (row - NCTX) & 2047;
                const int pos = axis ? (n & 63) : (n >> 6);
                const float rot = (ii < 8) ? -pr : pr;
                o = v * ropec[pos * 8 + (ii & 7)] + rot * ropes[pos * 8 + (ii & 7)];
            }
            if (lane < 32) {
                KR[(size_t)row * 32 + lane] = f2bf(o);
                if (row < NCTX) p.out[OUT_KR + ((size_t)((row >> 8) * 4 + l) * 256 + (row & 255)) * 32 + lane] = v;
            }
        }
    }
}

DEVI void transpose_item(const float* __restrict__ src, int N, int c0, int k0, bf16_t* __restrict__ dst, int K, float* scr, int lane) {
#pragma unroll 8
    for (int i = 0; i < 32; ++i) { const int kk = 2 * i + (lane >> 5); scr[kk * 33 + (lane & 31)] = src[(size_t)(k0 + kk) * N + c0 + (lane & 31)]; }
    asm volatile("s_waitcnt lgkmcnt(0)" ::: "memory");
    const int c = lane & 7;
#pragma unroll
    for (int j = 0; j < 4; ++j) {
        const int n = (lane >> 3) + 8 * j; const float* s = scr + (8 * c) * 33 + n;
        u32x4 o; o.x = pk2(s[0], s[33]); o.y = pk2(s[2 * 33], s[3 * 33]); o.z = pk2(s[4 * 33], s[5 * 33]); o.w = pk2(s[6 * 33], s[7 * 33]);
        *(u32x4*)(dst + (size_t)n * K + k0 + 8 * c) = o;
    }
    asm volatile("s_waitcnt lgkmcnt(0)" ::: "memory");
}

DEVI void prep_weight_item(const P& p, unsigned char* ws_b, int item, float* scr, int lane) {
    const int l = item / 12944; int r = item % 12944;
    bf16_t* Wl = (bf16_t*)(ws_b + WS_W) + (size_t)l * LAYER_W;
    if (r < 8448) {
        const int which = r / 4224; r %= 4224;
        if (r < 2816) {
            const int rb = r >> 4, kb = r & 15;
            const float* src = ((lane & 16) ? (which ? pin(p, 14) : pin(p, 11)) : (which ? pin(p, 13) : pin(p, 10))) + (size_t)l * D * DFF;
            transpose_item(src, DFF, rb * 16 - (lane & 16), kb * 64, Wl + (which ? OFF_W13_2 : OFF_W13_1) + (size_t)rb * 32 * D, D, scr, lane);
        } else {
            r -= 2816; const int rb = r / 44, kb = r % 44;
            const float* src = (which ? pin(p, 15) : pin(p, 12)) + (size_t)l * DFF * D;
            transpose_item(src, D, rb * 32, kb * 64, Wl + (which ? OFF_W2_2 : OFF_W2_1) + (size_t)rb * 32 * DFF, DFF, scr, lane);
        }
        return;
    }
    r -= 8448;
    if (r < 2944) {
        const int rb = r >> 4, kb = r & 15, R0 = rb * 32;
        const float* src; int N, c0;
        if (R0 < 1184) { src = pin(p, 16) + (size_t)l * D * 2720; N = 2720; c0 = R0; }
        else if (R0 < 1280) return;
        else if (R0 < 2816) { src = pin(p, 16) + (size_t)l * D * 2720; N = 2720; c0 = R0 - 96; }
        else { src = pin(p, 25) + (size_t)l * D * 3072; N = 3072; c0 = R0 - 2816; }
        transpose_item(src, N, c0, kb * 64, Wl + OFF_WIN + (size_t)R0 * D, D, scr, lane);
        return;
    }
    r -= 2944;
    if (r < 512) { const int rb = r >> 4, kb = r & 15; transpose_item(pin(p, 27) + (size_t)l * D * D, D, rb * 32, kb * 64, Wl + OFF_WOUT + (size_t)rb * 32 * D, D, scr, lane); return; }
    r -= 512;
    if (r < 768) { const int w = r >> 8; r &= 255; const int rb = r >> 3, kb = r & 7;
        transpose_item((w == 0 ? pin(p, 22) : (w == 1 ? pin(p, 23) : pin(p, 24))) + (size_t)l * 512 * D, D, rb * 32, kb * 64, Wl + (w == 0 ? OFF_WBF : (w == 1 ? OFF_WBM : OFF_WBN)) + (size_t)rb * 32 * 512, 512, scr, lane); return; }
    r -= 768;
    if (r < 144) { const int rb = r / 6, kb = r % 6; transpose_item(pin(p, 18) + (size_t)l * 384 * 768, 768, rb * 32, kb * 64, Wl + OFF_WUQ + (size_t)rb * 32 * 384, 384, scr, lane); return; }
    r -= 144;
    { const int rb = r >> 2, kb = r & 3; transpose_item(pin(p, 20) + (size_t)l * 256 * 1024, 1024, rb * 32, kb * 64, Wl + OFF_WUKV + (size_t)rb * 32 * 256, 256, scr, lane); }
}

DEVI void phase_prep(const P& p, unsigned char* ws_b, unsigned char* smem, int tid) {
    const int lane = tid & 63, wave = tid >> 6;
    const int gw = blockIdx.x * NWAVES + wave, ngw = gridDim.x * NWAVES;
    const size_t gt = (size_t)blockIdx.x * NTHREADS + tid, ngt = (size_t)gridDim.x * NTHREADS;
    {
        float* sil = (float*)smem;
        const float* wada = pin(p, 8);
        float* MODP = (float*)(ws_b + WS_MODP);
        for (int item = blockIdx.x; item < 1152; item += gridDim.x) {
            const int l = item / 288, rem = item % 288, kc = rem / 18, cb = rem % 18;
            __syncthreads();
            if (tid < 192) {
                const int g = tid >> 6, k = kc * 64 + (tid & 63);
                const float cv = (g == 0) ? pin(p, 7)[k] : pin(p, 6)[(g - 1) * D + k];
                sil[tid] = cv * sigmoidf_(cv);
            }
            __syncthreads();
            const int col = cb * NTHREADS + tid;
            const float* w = wada + ((size_t)l * D + kc * 64) * 9216 + col;
            float a0 = 0.f, a1 = 0.f, a2 = 0.f;
#pragma unroll 16
            for (int k = 0; k < 64; ++k) { const float wv = w[(size_t)k * 9216]; a0 += sil[k] * wv; a1 += sil[64 + k] * wv; a2 += sil[128 + k] * wv; }
            float* o = MODP + ((size_t)(l * 16 + kc) * 3) * 9216 + col;
            o[0] = a0; o[9216] = a1; o[2 * 9216] = a2;
        }
        __syncthreads();
    }
    {
        float* scr = (float*)smem + wave * (64 * 33);
        for (int item = gw; item < 4 * 12944; item += ngw) prep_weight_item(p, ws_b, item, scr, lane);
    }
    {
        bf16_t* TABL = (bf16_t*)(ws_b + WS_TABL);
        for (size_t e = gt; e < (size_t)2048 * 4096; e += ngt) {
            const int k = (int)(e >> 12), kk = (int)(e & 4095), lidx = kk & 2047;
            const int idx = (k * lidx) & 2047;
            float sn, cs; sincospif((float)idx * (2.f / 2048.f), &sn, &cs);
            TABL[e] = f2bf((kk < 2048 ? cs : -sn) * 0.022097086912079608f);
        }
        bf16_t* TABC = (bf16_t*)(ws_b + WS_TABC);
        for (size_t e = gt; e < (size_t)256 * 512; e += ngt) {
            const int k = (int)(e >> 9), kk = (int)(e & 511), lidx = kk & 255;
            const int idx = (k * lidx) & 255;
            float sn, cs; sincospif((float)idx * (2.f / 256.f), &sn, &cs);
            TABC[e] = f2bf((kk < 256 ? cs : -sn) * 0.0625f);
        }
        bf16_t* WCS = (bf16_t*)(ws_b + WS_WCS);
        for (size_t e = gt; e < (size_t)256 * 128; e += ngt) {
            const int i = (int)(e >> 7), c = (int)(e & 127), m = i >> 1, cs_ = i & 1;
            const int idx = (m * c) & 127;
            float sn, cs; sincospif((float)idx * (2.f / 128.f), &sn, &cs);
            WCS[e] = f2bf((cs_ ? sn : cs) * 0.08838834764831845f);
        }
        float* ROPE = (float*)(ws_b + WS_ROPE);
        for (size_t e = gt; e < 512; e += ngt) {
            const int pos = (int)(e >> 3), i = (int)(e & 7);
            const float inv_freq = powf(10000.f, -(float)i / 8.f);
            const float ang = (float)pos * inv_freq;
            ROPE[e] = cosf(ang); ROPE[512 + e] = sinf(ang);
        }
    }
    {
        bf16_t* CCKV = (bf16_t*)(ws_b + WS_CCKV);
        for (size_t e = gt; e < (size_t)NL * 1024 * 256; e += ngt) {
            const int c = (int)(e & 255), i = (int)((e >> 8) & 511), b = (int)((e >> 17) & 1), l = (int)(e >> 18);
            CCKV[e] = f2bf(pin(p, 2)[((size_t)(b * 4 + l) * 512 + i) * 256 + c]);
        }
        bf16_t* CKR = (bf16_t*)(ws_b + WS_CKR);
        for (size_t e = gt; e < (size_t)NL * 1024 * 32; e += ngt) {
            const int c = (int)(e & 31), i = (int)((e >> 5) & 511), b = (int)((e >> 14) & 1), l = (int)(e >> 15);
            CKR[e] = f2bf(pin(p, 3)[((size_t)(b * 4 + l) * 512 + i) * 32 + c]);
        }
        bf16_t* CNAK = (bf16_t*)(ws_b + WS_CNAK);
        for (size_t e = gt; e < (size_t)NL * 1024 * 512; e += ngt) {
            const int c = (int)(e & 511), i = (int)((e >> 9) & 511), b = (int)((e >> 18) & 1), l = (int)(e >> 19);
            CNAK[e] = f2bf(pin(p, 4)[((size_t)(b * 4 + l) * 512 + i) * 512 + c]);
        }
        bf16_t* CNAVT = (bf16_t*)(ws_b + WS_CNAVT);
        for (size_t e = gt; e < (size_t)NL * 1024 * 512; e += ngt) {
            const int key = (int)(e & 511), hd = (int)((e >> 9) & 511), b = (int)((e >> 18) & 1), l = (int)(e >> 19);
            CNAVT[e] = f2bf(pin(p, 5)[((size_t)(b * 4 + l) * 512 + key) * 512 + hd]);
        }
    }
}

DEVI void phase_modreduce(const P& p, unsigned char* ws_b, int tid) {
    const float* MODP = (const float*)(ws_b + WS_MODP);
    float* MOD = (float*)(ws_b + WS_MOD);
    for (int e = blockIdx.x * NTHREADS + tid; e < NL * 3 * 9216; e += gridDim.x * NTHREADS) {
        const int l = e / (3 * 9216), rem = e % (3 * 9216);
        float a = pin(p, 9)[l * 9216 + (rem % 9216)];
#pragma unroll
        for (int kc = 0; kc < 16; ++kc) a += MODP[((size_t)(l * 16 + kc) * 3) * 9216 + rem];
        MOD[e] = a;
    }
}

#define XB_TMO      128
#define XB_XCNT(j)  (256  + 64 * (j))
#define XB_XSUB(j)  (1280 + 64 * (j))
#define XB_XGEN(j)  (2304 + 64 * (j))
#define XB_TOP      3328
#define XB_TOPGEN   3392
#define XCD_BAR_WORDS 3456
#define XB_SPIN_CAP (1u << 20)
#define LAS __attribute__((address_space(3)))
DEVI unsigned xb_ld(unsigned* p)              { return __hip_atomic_load(p, __ATOMIC_RELAXED, __HIP_MEMORY_SCOPE_AGENT); }
DEVI unsigned xb_add(unsigned* p, unsigned v) { return __hip_atomic_fetch_add(p, v, __ATOMIC_RELAXED, __HIP_MEMORY_SCOPE_AGENT); }
DEVI unsigned xb_xcc_id() { return (unsigned)__builtin_amdgcn_s_getreg((3 << 11) | 20) & 0xFu; }
#define XB_SPIN(cond, bar) do { unsigned _sp = 0; while (cond) { __builtin_amdgcn_s_sleep(1); \
    if ((++_sp & 255u) == 0u) { if (xb_ld(&(bar)[XB_TMO])) break; if (_sp > XB_SPIN_CAP) { atomicAdd(&(bar)[XB_TMO], 1u); break; } } } } while (0)
struct XcdBarrier { unsigned* bar; unsigned x; volatile LAS unsigned* st; };
DEVI XcdBarrier xcd_barrier_post(unsigned* bar, volatile LAS unsigned* st) {
    XcdBarrier b; b.bar = bar; b.x = xb_xcc_id(); b.st = st;
    if (threadIdx.x == 0) (void)xb_add(&bar[XB_XCNT(b.x)], 1u);
    return b;
}
DEVI void xcd_barrier_complete(unsigned* bar, unsigned x, unsigned& nloc, unsigned& nx) {
    const unsigned G = gridDim.x * gridDim.y * gridDim.z;
    unsigned sum, cnt, mine, sp = 0u;
    for (;;) {
        sum = 0u; cnt = 0u; mine = 0u;
#pragma unroll
        for (unsigned j = 0; j < 16; ++j) { const unsigned c = xb_ld(&bar[XB_XCNT(j)]); sum += c; cnt += (c > 0u) ? 1u : 0u; mine = (j == x) ? c : mine; }
        if (sum == G) break;
        __builtin_amdgcn_s_sleep(1);
        if ((++sp & 255u) == 0u) { if (xb_ld(&bar[XB_TMO])) break; if (sp > XB_SPIN_CAP) { atomicAdd(&bar[XB_TMO], 1u); break; } }
    }
    nloc = mine > 0u ? mine : 1u; nx = cnt > 0u ? cnt : 1u;
}
DEVI void xcd_barrier(const XcdBarrier& b) {
    asm volatile("s_waitcnt vmcnt(0)" ::: "memory");
    __syncthreads();
    if (threadIdx.x == 0) {
        unsigned* bar = b.bar;
        __builtin_amdgcn_s_waitcnt(0);
        unsigned nloc = b.st[0], nx = b.st[1];
        if (nloc == 0u) { xcd_barrier_complete(bar, b.x, nloc, nx); b.st[0] = nloc; b.st[1] = nx; }
        const unsigned old = xb_add(&bar[XB_XSUB(b.x)], 1u);
        const unsigned gen = old / nloc;
        if (old + 1u == (gen + 1u) * nloc) {
            __builtin_amdgcn_fence(__ATOMIC_RELEASE, "agent");
            asm volatile("s_waitcnt vmcnt(0)" ::: "memory");
            const unsigned og = xb_add(&bar[XB_TOP], 1u);
            const unsigned tg = og / nx;
            if (og + 1u == (tg + 1u) * nx) xb_add(&bar[XB_TOPGEN], 1u);
            else XB_SPIN(xb_ld(&bar[XB_TOPGEN]) == tg, bar);
            __builtin_amdgcn_fence(__ATOMIC_ACQUIRE, "agent");
            xb_add(&bar[XB_XGEN(b.x)], 1u);
            asm volatile("s_waitcnt vmcnt(0)" ::: "memory");
        } else {
            XB_SPIN(xb_ld(&bar[XB_XGEN(b.x)]) == gen, bar);
            __builtin_amdgcn_fence(__ATOMIC_ACQUIRE, "agent");
            asm volatile("s_waitcnt vmcnt(0)" ::: "memory");
        }
    }
    __syncthreads();
}

DEVI void run_phase(const P& p, unsigned char* ws_b, int ph, unsigned char* smem, int tid) {
    const int lane = tid & 63, wave = tid >> 6;
    const int gw = blockIdx.x * NWAVES + wave, ngw = gridDim.x * NWAVES;
    const int nb = gridDim.x, bid = blockIdx.x;
    const int grp = tid >> 8, ltid = tid & 255;
    bf16_t* sm = (bf16_t*)smem + grp * (SMEM_BYTES / 2);
    if (ph == 0) { phase_prep(p, ws_b, smem, tid); return; }
    if (ph == 1) { phase_modreduce(p, ws_b, tid); return; }
    if (ph == 2) { phase_rows(p, ws_b, 0, -1, 0, 0, false, gw, ngw, lane); return; }
    const int l = (ph - 3) / 13, s = (ph - 3) % 13;
    const bf16_t* Wl = (const bf16_t*)(ws_b + WS_W) + (size_t)l * LAYER_W;
    const float* MODl = (const float*)(ws_b + WS_MOD) + (size_t)l * 3 * 9216;
    switch (s) {
    case 0: case 10:
        {
            pg8::Gemm g{(const bf16_t*)(ws_b + WS_H), Wl + (s == 10 ? OFF_W13_2 : OFF_W13_1), M, 2 * DFF, D};
            pg8::StaticOrder S; S.init(M, 2 * DFF, nb, bid);
            pg8::EpiSwiGLU E{(bf16_t*)(ws_b + WS_ACT)};
            pg8::gemm_phase<pg8::EpiSwiGLU, pg8::StaticOrder, true, true>((PG8_LAS unsigned char*)smem, g, S, E, tid);
        }
        break;
    case 1: case 11:
        {
            pg8::Gemm g{(const bf16_t*)(ws_b + WS_ACT), Wl + (s == 11 ? OFF_W2_2 : OFF_W2_1), M, D, DFF};
            pg8::StaticOrder S; S.init(M, D, nb, bid);
            pg8::EpiResid E{(float*)(ws_b + WS_X), MODl + (s == 11 ? 8 : 2) * D, 0.5f};
            pg8::gemm_phase<pg8::EpiResid, pg8::StaticOrder, false, true>((PG8_LAS unsigned char*)smem, g, S, E, tid);
        }
        break;
    case 2: phase_rows(p, ws_b, l, 0, l, 3, false, gw, ngw, lane); break;
    case 3:
        {
            pg8::Gemm g{(const bf16_t*)(ws_b + WS_H), Wl + OFF_WIN, M, 5888, D};
            pg8::StaticOrder S; S.init(M, 5888, nb, bid);
            pg8::EpiIn E{ws_b, p.out, pin(p, 26), l};
            pg8::gemm_phase<pg8::EpiIn, pg8::StaticOrder, true, true>((PG8_LAS unsigned char*)smem, g, S, E, tid);
        }
        break;
    case 4: phase_rowmix(p, ws_b, l, gw, ngw, lane); break;
    case 5: {
        float* ex = (float*)smem + (wave & 3) * (34 * 64);
        int u = bid;
        for (; u < 256; u += nb) {
            const int wi = u * 4 + (wave & 3);
            attn_na_lat(p, ws_b, l, wi >> 9, (wi >> 6) & 7, (wi >> 1) & 31, wi & 1, lane, ex, wave >> 2);
        }
        for (; u < 256 + 416; u += nb) job_ukv(p, ws_b, l, 2 * (u - 256) + grp, sm, ltid);
        for (; u < 256 + 416 + 288; u += nb) job_uq(p, ws_b, l, 2 * (u - 256 - 416) + grp, sm, ltid);
        for (; u < 256 + 416 + 288 + 384; u += nb) job_f1(p, ws_b, 2 * (u - 256 - 416 - 288) + grp, sm, ltid);
        for (; u < 256 + 416 + 288 + 384 + 256; u += nb) {
            const int wi = (u - 256 - 416 - 288 - 384) * 8 + wave;
            attn_na_ctx(p, ws_b, wi >> 6, (wi >> 3) & 7, wi & 7, lane);
        }
    } break;
    case 6: {
        float* ex = (float*)smem + (wave & 3) * (34 * 64);
        int u = bid;
        for (; u < 256; u += nb) {
            const int wi = u * 4 + (wave & 3);
            attn_mla(p, ws_b, l, true, wi >> 9, (wi >> 6) & 7, wi & 63, lane, ex, wave >> 2);
        }
        for (; u < 256 + 128; u += nb) job_f2_lat(p, ws_b, u - 256, sm, ltid, grp, (float*)(smem + SMEM_BYTES));
        for (; u < 256 + 128 + 128; u += nb) job_f2_ctx(p, ws_b, 2 * (u - 256 - 128) + grp, sm, ltid);
        for (; u < 256 + 128 + 128 + 256; u += nb) {
            const int wi = (u - 256 - 128 - 128) * 8 + wave;
            attn_mla(p, ws_b, l, false, wi >> 6, (wi >> 3) & 7, wi & 7, lane);
        }
    } break;
    case 7:

#pragma nounroll
        for (int sg = 0; sg < 3; ++sg) {
            int tid3 = tid; asm volatile("" : "+v"(tid3));
            pg8::Gemm g{(const bf16_t*)(ws_b + (sg == 0 ? WS_YF : (sg == 1 ? WS_YM : WS_YN))), Wl + (sg == 0 ? OFF_WBF : (sg == 1 ? OFF_WBM : OFF_WBN)), M, D, 512};
            pg8::StaticOrder S; S.init(M, D, nb, bid);
            pg8::EpiMerge E{(const bf16_t*)(ws_b + WS_GATE), (float*)(ws_b + WS_UF)  , (bf16_t*)(ws_b + WS_MERGED), sg};
            pg8::gemm_phase<pg8::EpiMerge, pg8::StaticOrder, false, true>((PG8_LAS unsigned char*)smem, g, S, E, tid3);
        }
        break;
    case 8:
        {
            pg8::Gemm g{(const bf16_t*)(ws_b + WS_MERGED), Wl + OFF_WOUT, M, D, D};
            pg8::StaticOrder S; S.init(M, D, nb, bid);
            pg8::EpiResid E{(float*)(ws_b + WS_X), MODl + 5 * D, 1.0f};
            pg8::gemm_phase<pg8::EpiResid, pg8::StaticOrder, false, true>((PG8_LAS unsigned char*)smem, g, S, E, tid);
        }
        break;
    case 9: phase_rows(p, ws_b, l, 1, l, 6, false, gw, ngw, lane); break;
    case 12:
        if (l == NL - 1) phase_rows(p, ws_b, l, 2, 0, 0, true, gw, ngw, lane);
        else phase_rows(p, ws_b, l, 2, l + 1, 0, false, gw, ngw, lane);
        break;
    default: break;
    }
}

__global__ void __launch_bounds__(NTHREADS, 2) mega_kernel(P p) {
    extern __shared__ __attribute__((aligned(16))) unsigned char smem[];
    __shared__ uint4 xb_words;
    cg::grid_group grid = cg::this_grid();
    const int tid = threadIdx.x;
    unsigned* bar = (unsigned*)(p.ws + WS_BAR);
    if (tid == 0) xb_words = make_uint4(0u, 0u, 0u, 0u);
    if (p.ph_lo == 0 && blockIdx.x == 0) for (int i = tid; i < XCD_BAR_WORDS; i += NTHREADS) bar[i] = 0u;
    __syncthreads();
    XcdBarrier xb; xb.bar = bar; xb.x = 0; xb.st = (volatile LAS unsigned*)&xb_words;
#pragma nounroll
    for (int ph = p.ph_lo; ph < p.ph_hi; ++ph) {
        int tid2 = tid; asm volatile("" : "+v"(tid2));
        unsigned char* ws_b = p.ws; asm volatile("" : "+s"(ws_b));
        run_phase(p, ws_b, ph, smem, tid2);
        if (ph + 1 < p.ph_hi) {
            if (ph == p.ph_lo) { grid.sync(); xb = xcd_barrier_post(bar, (volatile LAS unsigned*)&xb_words); }
            else xcd_barrier(xb);
        }
    }
}

extern "C" void kernel_launch(void* const* d_in, const int* in_sizes, int n_in, void* d_out, int out_size, void* d_ws, size_t ws_size,
                              hipStream_t stream) {
    static int grid_blocks = 0;
    if (grid_blocks == 0) {
        if (n_in != 30 || ws_size < WS_END) { fprintf(stderr, "kernel_launch: n_in %d ws %zu need %zu\n", n_in, ws_size, (size_t)WS_END); grid_blocks = -1; return; }
        int dev = 0, cus = 0, per_cu = 0;
        hipGetDevice(&dev);
        hipDeviceGetAttribute(&cus, hipDeviceAttributeMultiprocessorCount, dev);
        hipFuncSetAttribute((const void*)mega_kernel, hipFuncAttributeMaxDynamicSharedMemorySize, LDS_TOTAL);
        hipOccupancyMaxActiveBlocksPerMultiprocessor(&per_cu, (const void*)mega_kernel, NTHREADS, LDS_TOTAL);
        if (per_cu < 1) per_cu = 1;
        if (per_cu > 1) per_cu = 1;
        grid_blocks = cus * per_cu;
    }
    if (grid_blocks < 0) return;
    P p{};
    for (int i = 0; i < 30; ++i) p.in[i] = (const float*)d_in[i];
    p.out = (float*)d_out; p.ws = (unsigned char*)d_ws; p.ph_lo = 0; p.ph_hi = NPHASE;
#ifndef MULTI_LAUNCH
#define MULTI_LAUNCH 0
#endif
#if MULTI_LAUNCH
    for (int ph = 0; ph < NPHASE; ++ph) {
        p.ph_lo = ph; p.ph_hi = ph + 1;
        hipLaunchKernelGGL(mega_kernel, dim3(grid_blocks), dim3(NTHREADS), LDS_TOTAL, stream, p);
    }
#else
    void* args[] = {&p};
    hipError_t e = hipLaunchCooperativeKernel((const void*)mega_kernel, dim3(grid_blocks), dim3(NTHREADS), args, LDS_TOTAL, stream);
    if (e != hipSuccess) fprintf(stderr, "cooperative launch failed: %s (grid %d)\n", hipGetErrorString(e), grid_blocks);
#endif
}
```

```cpp
#include <hip/hip_runtime.h>
#include <hip/hip_cooperative_groups.h>
#include <cstdint>
#include <cstdio>
namespace cg = cooperative_groups;

typedef unsigned short bf16_t;
typedef short bf16x8 __attribute__((ext_vector_type(8)));
typedef float f32x16 __attribute__((ext_vector_type(16)));
typedef float f32x4 __attribute__((ext_vector_type(4)));
typedef unsigned u32x4 __attribute__((ext_vector_type(4)));
typedef unsigned u32x2 __attribute__((ext_vector_type(2)));
#define DEVI __device__ __forceinline__

constexpr int D = 1024, NCTX = 8192, NLAT = 4096, M = 12288, MX = 13312, DFF = 2816, NL = 4;
constexpr float ALPHA_F = 1.6817928305074290f;
constexpr float LOG2E = 1.4426950408889634f;
constexpr float MLA_QS = 0.10206207261596575f * LOG2E;
constexpr float NA_QS = 0.125f * LOG2E;
constexpr size_t OUT_CKV = 12582912, OUT_KR = 20971520, OUT_NAK = 22020096, OUT_NAV = 38797312;

constexpr size_t al256(size_t x) { return (x + 255) & ~(size_t)255; }
constexpr size_t WS_BAR = 0;
constexpr size_t WS_X = 16384;
constexpr size_t WS_H = WS_X + (size_t)M * D * 4;
constexpr size_t WS_MOD = WS_H + (size_t)M * D * 2;
constexpr size_t WS_MODP = WS_MOD + al256((size_t)NL * 3 * 9216 * 4);
constexpr size_t WS_ROPE = WS_MODP + al256((size_t)NL * 16 * 3 * 9216 * 4);
constexpr size_t WS_TABC = WS_ROPE + 4096;
constexpr size_t WS_TABL = WS_TABC + (size_t)256 * 512 * 2;
constexpr size_t WS_WCS = WS_TABL + (size_t)2048 * 4096 * 2;
constexpr size_t WS_CCKV = WS_WCS + (size_t)256 * 128 * 2;
constexpr size_t WS_CKR = WS_CCKV + (size_t)NL * 1024 * 256 * 2;
constexpr size_t WS_CNAK = WS_CKR + (size_t)NL * 1024 * 32 * 2;
constexpr size_t WS_CNAVT = WS_CNAK + (size_t)NL * 1024 * 512 * 2;
constexpr size_t WS_W = WS_CNAVT + (size_t)NL * 1024 * 512 * 2;
constexpr size_t OFF_W13_1 = 0, OFF_W2_1 = 5767168, OFF_W13_2 = 8650752, OFF_W2_2 = 14417920, OFF_WIN = 17301504,
                 OFF_WOUT = 23330816, OFF_WBF = 24379392, OFF_WBM = 24903680, OFF_WBN = 25427968, OFF_WUQ = 25952256,
                 OFF_WUKV = 26247168, LAYER_W = 26509312;
constexpr size_t WS_R1 = WS_W + (size_t)NL * LAYER_W * 2;
constexpr size_t WS_ACT = WS_R1;
constexpr size_t WS_UF = WS_R1;
constexpr size_t WS_UQ = WS_UF + (size_t)M * 512 * 2;
constexpr size_t WS_UKV = WS_UQ + (size_t)M * 384 * 2;
constexpr size_t WS_KRF = WS_UKV + (size_t)M * 256 * 4;
constexpr size_t WS_CKV = WS_KRF + (size_t)M * 32 * 4;
constexpr size_t WS_KR = WS_CKV + (size_t)M * 256 * 2;
constexpr size_t WS_NAQ = WS_KR + (size_t)M * 32 * 2;
constexpr size_t WS_NAK = WS_NAQ + (size_t)M * 512 * 2;
constexpr size_t WS_NAVT = WS_NAK + (size_t)M * 512 * 2;
constexpr size_t WS_GATE = WS_NAVT + (size_t)M * 512 * 2;
constexpr size_t WS_Q = WS_GATE + (size_t)M * 3072 * 2;
constexpr size_t WS_KN = WS_Q + (size_t)M * 768 * 2;
constexpr size_t WS_VTM = WS_KN + (size_t)MX * 512 * 2;
constexpr size_t WS_F1T = WS_VTM + (size_t)MX * 512 * 2;
constexpr size_t WS_YF = WS_F1T + (size_t)M * 1024 * 2;
constexpr size_t WS_YM = WS_YF + (size_t)M * 512 * 2;
constexpr size_t WS_YN = WS_YM + (size_t)M * 512 * 2;
constexpr size_t WS_MERGED = WS_YN + (size_t)M * 512 * 2;
constexpr size_t WS_END = WS_MERGED + (size_t)M * 1024 * 2;
static_assert(WS_END - WS_R1 >= (size_t)M * DFF * 2, "ACT must fit in R1");
static_assert(WS_NAK - WS_UF >= (size_t)M * D * 4, "merge T32 must fit in the dead UF..NAQ buffers");

constexpr int NPHASE = 3 + 13 * NL;

struct P {
    const float* in[30];
    float* out;
    unsigned char* ws;
    int ph_lo, ph_hi;
};

__device__ __forceinline__ const float* pin(const P& p, int i) { int j = i; asm volatile("" : "+s"(j)); return p.in[j]; }
typedef __bf16 bf16v2 __attribute__((ext_vector_type(2)));
typedef float f32x2 __attribute__((ext_vector_type(2)));
DEVI unsigned pk2(float lo, float hi) { f32x2 v = {lo, hi}; bf16v2 b = __builtin_convertvector(v, bf16v2); return __builtin_bit_cast(unsigned, b); }
DEVI bf16_t f2bf(float x) { return (bf16_t)(pk2(x, 0.f) & 0xffffu); }
DEVI float bf2f(unsigned v) { return __uint_as_float(v << 16); }
DEVI float wave_sum(float v) {
#pragma unroll
    for (int o = 1; o < 64; o <<= 1) v += __shfl_xor(v, o);
    return v;
}
DEVI float fast_exp2(float x) { return __builtin_amdgcn_exp2f(x); }
DEVI float sigmoidf_(float x) { return 1.f / (1.f + __expf(-x)); }

constexpr int LDT = 72;
constexpr int TILE_E = 128 * LDT;
constexpr int SMEM_BYTES = 4 * TILE_E * 2;
constexpr int NTHREADS = 512, NWAVES = 8, LDS_TOTAL = 2 * SMEM_BYTES;

DEVI void gemm_ldg(const bf16_t* ga, const bf16_t* gb, int lda, int ldb, u32x4 (&ra)[4], u32x4 (&rb)[4]) {
#pragma unroll
    for (int i = 0; i < 4; ++i) {
        ra[i] = *(const u32x4*)(ga + (size_t)(32 * i) * lda);
        rb[i] = *(const u32x4*)(gb + (size_t)(32 * i) * ldb);
    }
}
DEVI void gemm_sts(bf16_t* buf, int soff, const u32x4 (&ra)[4], const u32x4 (&rb)[4]) {
#pragma unroll
    for (int i = 0; i < 4; ++i) {
        *(u32x4*)(buf + soff + 32 * i * LDT) = ra[i];
        *(u32x4*)(buf + TILE_E + soff + 32 * i * LDT) = rb[i];
    }
}
DEVI void gemm_mma(const bf16_t* cur, int aoff, int boff, f32x16 (&acc)[2][2]) {
#pragma unroll
    for (int ks = 0; ks < 4; ++ks) {
        bf16x8 a0 = *(const bf16x8*)(cur + aoff + ks * 16);
        bf16x8 a1 = *(const bf16x8*)(cur + aoff + 32 * LDT + ks * 16);
        bf16x8 b0 = *(const bf16x8*)(cur + boff + ks * 16);
        bf16x8 b1 = *(const bf16x8*)(cur + boff + 32 * LDT + ks * 16);
        acc[0][0] = __builtin_amdgcn_mfma_f32_32x32x16_bf16(a0, b0, acc[0][0], 0, 0, 0);
        acc[0][1] = __builtin_amdgcn_mfma_f32_32x32x16_bf16(a0, b1, acc[0][1], 0, 0, 0);
        acc[1][0] = __builtin_amdgcn_mfma_f32_32x32x16_bf16(a1, b0, acc[1][0], 0, 0, 0);
        acc[1][1] = __builtin_amdgcn_mfma_f32_32x32x16_bf16(a1, b1, acc[1][1], 0, 0, 0);
    }
}

template <bool DEEP = true>
DEVI void gemm_core(const bf16_t* __restrict__ A, int lda, const bf16_t* __restrict__ B, int ldb, int K,
                    f32x16 (&acc)[2][2], bf16_t* smem, int tid) {
    const int lane = tid & 63, wave = tid >> 6, wr = wave >> 1, wc = wave & 1;
    const int lr = tid >> 3, lc = (tid & 7) * 8;
    const bf16_t* ga = A + (size_t)lr * lda + lc;
    const bf16_t* gb = B + (size_t)lr * ldb + lc;
    const int soff = lr * LDT + lc;
    const int nk = K >> 6;
    const int aoff = (wr * 64 + (lane & 31)) * LDT + (lane >> 5) * 8;
    const int boff = TILE_E + (wc * 64 + (lane & 31)) * LDT + (lane >> 5) * 8;
    bf16_t* buf0 = smem; bf16_t* buf1 = smem + 2 * TILE_E;
    if constexpr (DEEP) {
        u32x4 ra0[4], rb0[4], ra1[4], rb1[4];
        gemm_ldg(ga, gb, lda, ldb, ra0, rb0);
        gemm_ldg(ga + 64, gb + 64, lda, ldb, ra1, rb1);
        gemm_sts(buf0, soff, ra0, rb0);
        __syncthreads();
        for (int kt = 0; kt < nk; kt += 2) {
            if (kt + 2 < nk) gemm_ldg(ga + (size_t)(kt + 2) * 64, gb + (size_t)(kt + 2) * 64, lda, ldb, ra0, rb0);
            gemm_mma(buf0, aoff, boff, acc);
            gemm_sts(buf1, soff, ra1, rb1);
            __syncthreads();
            if (kt + 3 < nk) gemm_ldg(ga + (size_t)(kt + 3) * 64, gb + (size_t)(kt + 3) * 64, lda, ldb, ra1, rb1);
            gemm_mma(buf1, aoff, boff, acc);
            if (kt + 2 < nk) gemm_sts(buf0, soff, ra0, rb0);
            __syncthreads();
        }
    } else {
        u32x4 ra[4], rb[4];
        gemm_ldg(ga, gb, lda, ldb, ra, rb);
        gemm_sts(buf0, soff, ra, rb);
        __syncthreads();
        for (int kt = 0; kt < nk; ++kt) {
            bf16_t* cur = (kt & 1) ? buf1 : buf0;
            bf16_t* nxt = (kt & 1) ? buf0 : buf1;
            const bool more = (kt + 1 < nk);
            if (more) { ga += 64; gb += 64; gemm_ldg(ga, gb, lda, ldb, ra, rb); }
            gemm_mma(cur, aoff, boff, acc);
            if (more) gemm_sts(nxt, soff, ra, rb);
            __syncthreads();
        }
    }
}

DEVI void zero_acc(f32x16 (&acc)[2][2]) {
#pragma unroll
    for (int i = 0; i < 2; ++i)
#pragma unroll
        for (int j = 0; j < 2; ++j)
#pragma unroll
            for (int r = 0; r < 16; ++r) acc[i][j][r] = 0.f;
}

#define EPI_SETUP const int lane = tid & 63, wave = tid >> 6, wr = wave >> 1, wc = wave & 1, hl = lane >> 5, c32 = lane & 31; (void)wr; (void)wc; (void)hl; (void)c32;

DEVI int mod_group(int row) { return row < NCTX ? 0 : 1 + ((row - NCTX) >> 11); }

namespace pg8 {
#define PG8_LAS __attribute__((address_space(3)))
constexpr int BM = 256, BK = 64, HALF = 128, HTB = HALF * BK * 2, NXCD = 8, WGM = 8;
DEVI int lds_byte(int r, int c) { const int st = (r >> 4) * 2 + (c >> 5), rr = r & 15, cc = c & 31, ob = rr * 64 + cc * 2; return st * 1024 + (ob ^ (((ob >> 9) & 1) << 5)); }
DEVI void stage_rc(int b, int& R, int& C) { const int st = b / 1024, sb = b % 1024, swz = sb ^ (((sb >> 9) & 1) << 5); R = (st >> 1) * 16 + swz / 64; C = (st & 1) * 32 + (swz % 64) / 2; }
DEVI int perm32(int rho) { const int n = rho >> 4, i = rho & 15; return 8 * (i >> 2) + 4 * n + (i & 3); }
struct Unit { int pm, pn; };
struct Gemm { const bf16_t* A; const bf16_t* Bt; int M, N, K; };
struct StaticOrder {
    int nM, nN, nwg, G, c;
    DEVI void init(int M, int N, int G_, int c_) { nM = M / BM; nN = N / BM; nwg = nM * nN; G = G_; c = c_; }
    DEVI bool next(int i, Unit& u) const {
        const long L = (long)i * G + c; if (L >= nwg) return false;
        int wgid = (int)L; { const int q = nwg / NXCD, r = nwg % NXCD, xcd = wgid % NXCD, off = wgid / NXCD; wgid = (xcd < r ? xcd * (q + 1) : r * (q + 1) + (xcd - r) * q) + off; }
        const int nig = WGM * nN, gid = wgid / nig, fm = gid * WGM, gsz = (nM - fm) < WGM ? (nM - fm) : WGM;
        u.pm = fm + ((wgid % nig) % gsz); u.pn = (wgid % nig) / gsz; return true;
    }
    DEVI void a_ready(const Unit&) const {}
    DEVI void done(const Unit&) const {}
};
template <class Epi, class Sched, bool ALIGN_EPI = false, bool SP2 = false>
DEVI void gemm_phase(PG8_LAS unsigned char* lds, const Gemm g, const Sched& S, const Epi& E, const int tid) {
    const int wid = __builtin_amdgcn_readfirstlane(tid >> 6), lane = tid & 63, wr = wid >> 2, wc = wid & 3, fr = lane & 15, fq = lane >> 4;
    const int K = g.K, nt = K / BK;
    unsigned voffA[2], voffB[2];
#pragma unroll
    for (int i = 0; i < 2; ++i) { int R, C; stage_rc(tid * 16 + i * 8192, R, C); const int Rb = Epi::PERM ? ((R & ~31) + perm32(R & 31)) : R;
        voffA[i] = (unsigned)(R * K + C) * 2u; voffB[i] = (unsigned)(Rb * K + C) * 2u; }
    const size_t kstep = (size_t)(BK * 2);
    const size_t hstep = (size_t)HALF * K * 2;
    const size_t tstep = 2 * hstep;
    const unsigned ldsw = (unsigned)wid * 1024u;
    const int aoff = lds_byte(wr * 64 + fr, fq * 8), boff = lds_byte(wc * 32 + fr, fq * 8);
#define PG8_SA(b, h) (((b) * 2 + (h)) * HTB)
#define PG8_SB(b, h) ((4 + (b) * 2 + (h)) * HTB)
#define PG8_STAGE(bufoff, gbase, voff) do { _Pragma("unroll") for (int _i = 0; _i < 2; ++_i) \
        __builtin_amdgcn_global_load_lds((const unsigned*)((const char*)(gbase) + (voff)[_i]), (PG8_LAS unsigned*)(lds + (bufoff) + ldsw + _i * 8192), 16, 0, 0); } while (0)
#define PG8_LDA(dst, b, h) do { _Pragma("unroll") for (int m = 0; m < 4; ++m) _Pragma("unroll") for (int k = 0; k < 2; ++k) dst[m][k] = *(const PG8_LAS bf16x8*)(lds + PG8_SA(b, h) + aoff + m * 2048 + k * 1024); } while (0)
#define PG8_LDB(dst, b, h) do { _Pragma("unroll") for (int n = 0; n < 2; ++n) _Pragma("unroll") for (int k = 0; k < 2; ++k) dst[n][k] = *(const PG8_LAS bf16x8*)(lds + PG8_SB(b, h) + boff + n * 2048 + k * 1024); } while (0)
#define PG8_MMA(ai, bj, At, Bt) do { __builtin_amdgcn_s_setprio(1); _Pragma("unroll") for (int m = 0; m < 4; ++m) _Pragma("unroll") for (int n = 0; n < 2; ++n) _Pragma("unroll") for (int k = 0; k < 2; ++k) \
        acc[ai][bj][m][n] = __builtin_amdgcn_mfma_f32_16x16x32_bf16(Bt[n][k], At[m][k], acc[ai][bj][m][n], 0, 0, 0); __builtin_amdgcn_s_setprio(0); } while (0)
#define PG8_WAIT_V(n) asm volatile("s_waitcnt vmcnt(" #n ")" ::: "memory")
#define PG8_WAIT_L(n) asm volatile("s_waitcnt lgkmcnt(" #n ")" ::: "memory")
#define PG8_BAR __builtin_amdgcn_s_barrier()
#define PG8_SCHED __builtin_amdgcn_sched_barrier(0)
    Unit cur, nxt; int ui = 0;
    if (!S.next(0, cur)) return;
    f32x4 acc[2][2][4][2];
#pragma unroll
    for (int a = 0; a < 2; ++a)
#pragma unroll
        for (int b = 0; b < 2; ++b)
#pragma unroll
            for (int m = 0; m < 4; ++m)
#pragma unroll
                for (int n = 0; n < 2; ++n) acc[a][b][m][n] = (f32x4){0.f, 0.f, 0.f, 0.f};
    bf16x8 At[4][2], B0[2][2], B1[2][2];
    const char* cA = (const char*)g.A + (size_t)cur.pm * tstep; const char* cB = (const char*)g.Bt + (size_t)cur.pn * tstep;
    S.a_ready(cur);
    if constexpr (SP2) {
        PG8_STAGE(PG8_SB(0, 0), cB, voffB); PG8_STAGE(PG8_SB(0, 1), cB + hstep, voffB); PG8_STAGE(PG8_SA(0, 0), cA, voffA); PG8_STAGE(PG8_SA(0, 1), cA + hstep, voffA);
        if (wr == 1) PG8_BAR;
        PG8_WAIT_V(2); PG8_BAR;
        PG8_STAGE(PG8_SB(1, 0), cB + kstep, voffB); PG8_STAGE(PG8_SA(1, 0), cA + kstep, voffA); PG8_STAGE(PG8_SB(1, 1), cB + hstep + kstep, voffB);
        PG8_WAIT_V(6); PG8_BAR;
    } else {
        PG8_STAGE(PG8_SB(0, 0), cB, voffB); PG8_STAGE(PG8_SA(0, 0), cA, voffA); PG8_STAGE(PG8_SB(0, 1), cB + hstep, voffB); PG8_STAGE(PG8_SA(0, 1), cA + hstep, voffA);
        if (wr == 1) PG8_BAR;
        PG8_WAIT_V(4); PG8_BAR;
        PG8_STAGE(PG8_SB(1, 0), cB + kstep, voffB); PG8_STAGE(PG8_SA(1, 0), cA + kstep, voffA); PG8_STAGE(PG8_SB(1, 1), cB + hstep + kstep, voffB);
        PG8_WAIT_V(6); PG8_BAR;
    }
    for (;;) {
        const bool has_next = S.next(ui + 1, nxt);
        const char* nA = has_next ? (const char*)g.A + (size_t)nxt.pm * tstep : cA; const char* nB = has_next ? (const char*)g.Bt + (size_t)nxt.pn * tstep : cB;
        for (int t = 0; t < nt; t += 2) {
            const bool last = (t == nt - 2);
            const char* a1 = cA + (size_t)(t + 1) * kstep;
            const char* a2 = last ? nA : cA + (size_t)(t + 2) * kstep; const char* b2 = last ? nB : cB + (size_t)(t + 2) * kstep;
            const char* a3 = a2 + kstep; const char* b3 = b2 + kstep;
            if (last && has_next) S.a_ready(nxt);
            if constexpr (SP2) {
            PG8_LDB(B0, 0, 0); PG8_LDB(B1, 0, 1); PG8_SCHED; PG8_LDA(At, 0, 0); PG8_STAGE(PG8_SA(1, 1), a1 + hstep, voffA);
            PG8_WAIT_V(8); PG8_WAIT_L(0); PG8_BAR; PG8_MMA(0, 0, At, B0); PG8_MMA(0, 1, At, B1); PG8_BAR; PG8_SCHED;
            PG8_LDA(At, 0, 1); PG8_STAGE(PG8_SB(0, 0), b2, voffB); PG8_STAGE(PG8_SB(0, 1), b2 + hstep, voffB); PG8_STAGE(PG8_SA(0, 0), a2, voffA);
            PG8_WAIT_V(8); PG8_WAIT_L(0); PG8_BAR; PG8_MMA(1, 0, At, B0); PG8_MMA(1, 1, At, B1); PG8_BAR; PG8_SCHED;
            PG8_LDB(B0, 1, 0); PG8_LDB(B1, 1, 1); PG8_SCHED; PG8_LDA(At, 1, 0); PG8_STAGE(PG8_SA(0, 1), a2 + hstep, voffA);
            PG8_WAIT_V(8); PG8_WAIT_L(0); PG8_BAR; PG8_MMA(0, 0, At, B0); PG8_MMA(0, 1, At, B1); PG8_BAR; PG8_SCHED;
            PG8_LDA(At, 1, 1); PG8_STAGE(PG8_SB(1, 0), b3, voffB); PG8_STAGE(PG8_SB(1, 1), b3 + hstep, voffB); PG8_STAGE(PG8_SA(1, 0), a3, voffA);
            PG8_WAIT_V(8); PG8_WAIT_L(0); PG8_BAR; PG8_MMA(1, 0, At, B0); PG8_MMA(1, 1, At, B1); PG8_BAR; PG8_SCHED;
            } else {
            PG8_LDB(B0, 0, 0); PG8_SCHED; PG8_LDA(At, 0, 0); PG8_STAGE(PG8_SA(1, 1), a1 + hstep, voffA);
            PG8_WAIT_L(8); PG8_BAR; PG8_WAIT_L(0); PG8_MMA(0, 0, At, B0); PG8_BAR; PG8_SCHED;
            PG8_LDB(B1, 0, 1); PG8_STAGE(PG8_SB(0, 0), b2, voffB);
            PG8_BAR; PG8_WAIT_L(0); PG8_MMA(0, 1, At, B1); PG8_BAR;
            PG8_LDA(At, 0, 1); PG8_STAGE(PG8_SA(0, 0), a2, voffA);
            PG8_BAR; PG8_WAIT_L(0); PG8_MMA(1, 0, At, B0); PG8_BAR; PG8_SCHED;
            PG8_STAGE(PG8_SB(0, 1), b2 + hstep, voffB);
            PG8_WAIT_V(6); PG8_BAR; PG8_MMA(1, 1, At, B1); PG8_BAR;
            PG8_LDB(B0, 1, 0); PG8_SCHED; PG8_LDA(At, 1, 0); PG8_STAGE(PG8_SA(0, 1), a2 + hstep, voffA);
            PG8_WAIT_L(8); PG8_BAR; PG8_WAIT_L(0); PG8_MMA(0, 0, At, B0); PG8_BAR; PG8_SCHED;
            PG8_LDB(B1, 1, 1); PG8_STAGE(PG8_SB(1, 0), b3, voffB);
            PG8_BAR; PG8_WAIT_L(0); PG8_MMA(0, 1, At, B1); PG8_BAR;
            PG8_LDA(At, 1, 1); PG8_STAGE(PG8_SA(1, 0), a3, voffA);
            PG8_BAR; PG8_WAIT_L(0); PG8_MMA(1, 0, At, B0); PG8_BAR; PG8_SCHED;
            PG8_STAGE(PG8_SB(1, 1), b3 + hstep, voffB);
            PG8_WAIT_V(6); PG8_BAR; PG8_MMA(1, 1, At, B1); PG8_BAR;
            }
        }
        if constexpr (ALIGN_EPI) { if (wr == 0) PG8_BAR; }
        E(acc, cur, wr, wc, fr, fq); S.done(cur);
        if (!has_next) break;
#pragma unroll
        for (int a = 0; a < 2; ++a)
#pragma unroll
            for (int b = 0; b < 2; ++b)
#pragma unroll
                for (int m = 0; m < 4; ++m)
#pragma unroll
                    for (int n = 0; n < 2; ++n) acc[a][b][m][n] = (f32x4){0.f, 0.f, 0.f, 0.f};
        cur = nxt; cA = nA; cB = nB; ++ui;
        if constexpr (ALIGN_EPI) { if (wr == 1) PG8_BAR; }
    }
    PG8_WAIT_V(0);
    if constexpr (!ALIGN_EPI) { if (wr == 0) PG8_BAR; }
    PG8_BAR;
#undef PG8_SA
#undef PG8_SB
#undef PG8_STAGE
#undef PG8_LDA
#undef PG8_LDB
#undef PG8_MMA
#undef PG8_WAIT_V
#undef PG8_WAIT_L
#undef PG8_BAR
#undef PG8_SCHED
}

struct EpiSwiGLU {
    static constexpr bool PERM = false;
    bf16_t* ACT;
    DEVI void operator()(const f32x4 (&acc)[2][2][4][2], const Unit& u, int wr, int wc, int fr, int fq) const {
#pragma unroll
        for (int ai = 0; ai < 2; ++ai)
#pragma unroll
            for (int m = 0; m < 4; ++m) {
                const int row = u.pm * BM + ai * HALF + wr * 64 + m * 16 + fr;
                bf16_t* rp = ACT + (size_t)row * DFF + 16 * (8 * u.pn + wc) + 4 * fq;
#pragma unroll
                for (int bj = 0; bj < 2; ++bj) {
                    const f32x4 a = acc[ai][bj][m][0], b = acc[ai][bj][m][1];
                    u32x2 pk;
                    pk.x = pk2(a[0] * sigmoidf_(a[0]) * b[0], a[1] * sigmoidf_(a[1]) * b[1]);
                    pk.y = pk2(a[2] * sigmoidf_(a[2]) * b[2], a[3] * sigmoidf_(a[3]) * b[3]);
                    *(u32x2*)(rp + 64 * bj) = pk;
                }
            }
    }
};
struct EpiResid {
    static constexpr bool PERM = false;
    float* X; const float* gate_base; float coef;
    DEVI void operator()(const f32x4 (&acc)[2][2][4][2], const Unit& u, int wr, int wc, int fr, int fq) const {
        const float* gate = gate_base + (size_t)mod_group(u.pm * BM) * 9216;
        const int col0 = u.pn * BM + wc * 32 + 4 * fq;
        f32x4 gv[2][2];
#pragma unroll
        for (int bj = 0; bj < 2; ++bj)
#pragma unroll
            for (int n = 0; n < 2; ++n) gv[bj][n] = *(const f32x4*)(gate + col0 + bj * HALF + 16 * n) * coef;
#pragma unroll
        for (int ai = 0; ai < 2; ++ai)
#pragma unroll
            for (int m = 0; m < 4; ++m) {
                const int row = u.pm * BM + ai * HALF + wr * 64 + m * 16 + fr;
                float* rp = X + (size_t)row * D + col0;
#pragma unroll
                for (int bj = 0; bj < 2; ++bj)
#pragma unroll
                    for (int n = 0; n < 2; ++n) {
                        f32x4* xp = (f32x4*)(rp + bj * HALF + 16 * n);
                        *xp = (*xp) * ALPHA_F + gv[bj][n] * acc[ai][bj][m][n];
                    }
                if (m == 3) __builtin_amdgcn_sched_barrier(0);
            }
    }
};
struct EpiIn {
    static constexpr bool PERM = true;
    unsigned char* ws; float* out; const float* b_gate; int l;
    static DEVI u32x4 pack8(const f32x4& a, const f32x4& b, float s) {
        u32x4 w; w.x = pk2(a[0] * s, a[1] * s); w.y = pk2(a[2] * s, a[3] * s); w.z = pk2(b[0] * s, b[1] * s); w.w = pk2(b[2] * s, b[3] * s); return w;
    }
    DEVI void operator()(const f32x4 (&acc)[2][2][4][2], const Unit& u, int wr, int wc, int fr_, int fq_) const {
        int fr = fr_, fq = fq_; asm volatile("" : "+v"(fr), "+v"(fq));
        unsigned char* ws = this->ws; float* out = this->out; const float* b_gate = this->b_gate;
        asm volatile("" : "+s"(ws), "+s"(out), "+s"(b_gate));
        const bool ctx = u.pm * BM < NCTX;
#pragma unroll
        for (int bj = 0; bj < 2; ++bj) {
            const int n0 = u.pn * BM + bj * HALF;
            const int c8 = n0 + wc * 32 + 8 * fq;
            f32x4 bg0 = (f32x4){0.f, 0.f, 0.f, 0.f}, bg1 = bg0;
            if (n0 >= 2816) { bg0 = *(const f32x4*)(b_gate + l * 3072 + c8 - 2816); bg1 = *(const f32x4*)(b_gate + l * 3072 + c8 - 2816 + 4); }
#pragma unroll
            for (int ai = 0; ai < 2; ++ai)
#pragma unroll
                for (int m = 0; m < 4; ++m) {
                    const int row = u.pm * BM + ai * HALF + wr * 64 + m * 16 + fr;
                    const f32x4 v0 = acc[ai][bj][m][0], v1 = acc[ai][bj][m][1];
                    if (n0 < 512) {
                        *(u32x4*)((bf16_t*)(ws + WS_UF) + (size_t)row * 512 + c8) = pack8(v0, v1, 1.f);
                    } else if (n0 < 896) {
                        *(u32x4*)((bf16_t*)(ws + WS_UQ) + (size_t)row * 384 + (c8 - 512)) = pack8(v0, v1, 1.f);
                    } else if (n0 < 1152) {
                        float* o = (float*)(ws + WS_UKV) + (size_t)row * 256 + (c8 - 896);
                        *(f32x4*)o = v0; *(f32x4*)(o + 4) = v1;
                    } else if (n0 < 1280) {
                        if (wc == 0) { float* o = (float*)(ws + WS_KRF) + (size_t)row * 32 + 8 * fq; *(f32x4*)o = v0; *(f32x4*)(o + 4) = v1; }
                    } else if (n0 < 1792) {
                        *(u32x4*)((bf16_t*)(ws + WS_NAQ) + (size_t)row * 512 + (c8 - 1280)) = pack8(v0, v1, NA_QS);
                    } else if (n0 < 2304) {
                        const int cc = c8 - 1792;
                        *(u32x4*)((bf16_t*)(ws + WS_NAK) + (size_t)row * 512 + cc) = pack8(v0, v1, 1.f);
                        if (ctx) { float* o = out + OUT_NAK + ((size_t)((row >> 8) * 4 + l) * 256 + (row & 255)) * 512 + cc; *(f32x4*)o = v0; *(f32x4*)(o + 4) = v1; }
                    } else if (n0 < 2816) {
                        const int cc = c8 - 2304, h = cc >> 6, d0 = cc & 63;
                        bf16_t* VT = (bf16_t*)(ws + WS_NAVT);
                        bf16_t* vp;
                        size_t cstride;
                        if (ctx) {
                            const int b = row >> 8, s = row & 255;
                            float* o = out + OUT_NAV + ((size_t)(b * 4 + l) * 256 + s) * 512 + cc; *(f32x4*)o = v0; *(f32x4*)(o + 4) = v1;
                            vp = VT + ((size_t)((b * 8 + h) * 64 + d0)) * 256 + s; cstride = 256;
                        } else {
                            const int rr = row - NCTX, b = rr >> 11, n = rr & 2047;
                            vp = VT + (size_t)4194304 + ((size_t)((b * 8 + h) * 64 + d0)) * 2048 + n; cstride = 2048;
                        }
#pragma unroll
                        for (int e = 0; e < 4; ++e) { vp[(size_t)e * cstride] = f2bf(v0[e]); vp[(size_t)(4 + e) * cstride] = f2bf(v1[e]); }
                    } else {
                        f32x4 g0, g1;
#pragma unroll
                        for (int e = 0; e < 4; ++e) { g0[e] = sigmoidf_(v0[e] + bg0[e]); g1[e] = sigmoidf_(v1[e] + bg1[e]); }
                        *(u32x4*)((bf16_t*)(ws + WS_GATE) + (size_t)row * 3072 + (c8 - 2816)) = pack8(g0, g1, 1.f);
                    }
                    __builtin_amdgcn_sched_barrier(0);
                }
        }
    }
};
struct EpiMerge {
    static constexpr bool PERM = true;
    const bf16_t* GATE; bf16_t* T; bf16_t* MG; int s;
    DEVI void operator()(const f32x4 (&acc)[2][2][4][2], const Unit& u, int wr, int wc, int fr_, int fq_) const {
        int fr = fr_, fq = fq_; asm volatile("" : "+v"(fr), "+v"(fq));
#pragma unroll
        for (int ai = 0; ai < 2; ++ai)
#pragma unroll
            for (int m = 0; m < 4; ++m) {
                const int row = u.pm * BM + ai * HALF + wr * 64 + m * 16 + fr;
#pragma unroll
                for (int bj = 0; bj < 2; ++bj) {
                    const int c8 = u.pn * BM + bj * HALF + wc * 32 + 8 * fq;
                    const u32x4 g = *(const u32x4*)(GATE + (size_t)row * 3072 + s * 1024 + c8);
                    f32x4 v0 = acc[ai][bj][m][0], v1 = acc[ai][bj][m][1];
                    v0[0] *= bf2f(g.x & 0xffffu); v0[1] *= bf2f(g.x >> 16); v0[2] *= bf2f(g.y & 0xffffu); v0[3] *= bf2f(g.y >> 16);
                    v1[0] *= bf2f(g.z & 0xffffu); v1[1] *= bf2f(g.z >> 16); v1[2] *= bf2f(g.w & 0xffffu); v1[3] *= bf2f(g.w >> 16);
                    bf16_t* tp = T + (size_t)row * D + c8;
                    if (s > 0) {
                        const u32x4 tv = *(const u32x4*)tp;
                        v0[0] += bf2f(tv.x & 0xffffu); v0[1] += bf2f(tv.x >> 16); v0[2] += bf2f(tv.y & 0xffffu); v0[3] += bf2f(tv.y >> 16);
                        v1[0] += bf2f(tv.z & 0xffffu); v1[1] += bf2f(tv.z >> 16); v1[2] += bf2f(tv.w & 0xffffu); v1[3] += bf2f(tv.w >> 16);
                    }
                    *(u32x4*)((s < 2 ? tp : MG + (size_t)row * D + c8)) = EpiIn::pack8(v0, v1, 1.f);
                }
                if (m & 1) __builtin_amdgcn_sched_barrier(0);
            }
    }
};
}

DEVI void job_ffn_up(const P& p, unsigned char* ws_b, int l, int which, int t, bf16_t* sm, int tid) {
    const int nN = 44; const int m0 = (t / nN) * 128, n0 = (t % nN) * 128;
    const bf16_t* H = (const bf16_t*)(ws_b + WS_H);
    const bf16_t* W = (const bf16_t*)(ws_b + WS_W) + (size_t)l * LAYER_W + (which ? OFF_W13_2 : OFF_W13_1);
    bf16_t* ACT = (bf16_t*)(ws_b + WS_ACT);
    f32x16 acc[2][2]; zero_acc(acc);
    gemm_core(H + (size_t)m0 * D, D, W + (size_t)n0 * D, D, D, acc, sm, tid);
    EPI_SETUP
    const int oc = (n0 >> 1) + wc * 32 + c32;
#pragma unroll
    for (int i = 0; i < 2; ++i) {
        const int rb = m0 + wr * 64 + i * 32 + 4 * hl;
#pragma unroll
        for (int r = 0; r < 16; ++r) {
            const int row = rb + (r & 3) + 8 * (r >> 2);
            const float a = acc[i][0][r], b = acc[i][1][r];
            const float v = a * sigmoidf_(a) * b;
            ACT[(size_t)row * DFF + oc] = f2bf(v);
        }
    }
}

DEVI void job_resid(const P& p, unsigned char* ws_b, const bf16_t* A, int lda, const bf16_t* Bt, int K, const float* gate_base, float coef, int t, bf16_t* sm, int tid) {
    const int nN = 8; const int m0 = (t / nN) * 128, n0 = (t % nN) * 128;
    float* X = (float*)(ws_b + WS_X);
    f32x16 acc[2][2]; zero_acc(acc);
    gemm_core(A + (size_t)m0 * lda, lda, Bt + (size_t)n0 * K, K, K, acc, sm, tid);
    EPI_SETUP
    const float* gate = gate_base + (size_t)mod_group(m0) * 9216;
#pragma unroll
    for (int j = 0; j < 2; ++j) {
        const int col = n0 + wc * 64 + j * 32 + c32;
        const float gv = coef * gate[col];
#pragma unroll
        for (int i = 0; i < 2; ++i) {
            const int rb = m0 + wr * 64 + i * 32 + 4 * hl;
#pragma unroll
            for (int r = 0; r < 16; ++r) {
                const int row = rb + (r & 3) + 8 * (r >> 2);
                float* xp = X + (size_t)row * D + col;
                *xp = ALPHA_F * (*xp) + gv * acc[i][j][r];
            }
        }
    }
}

DEVI void job_in(const P& p, unsigned char* ws_b, int l, int t, bf16_t* sm, int tid) {
    const int nN = 46; const int m0 = (t / nN) * 128, n0 = (t % nN) * 128;
    const bf16_t* H = (const bf16_t*)(ws_b + WS_H);
    const bf16_t* W = (const bf16_t*)(ws_b + WS_W) + (size_t)l * LAYER_W + OFF_WIN;
    f32x16 acc[2][2]; zero_acc(acc);
    gemm_core(H + (size_t)m0 * D, D, W + (size_t)n0 * D, D, D, acc, sm, tid);
    EPI_SETUP
    const bool ctx = m0 < NCTX;
#pragma unroll
    for (int j = 0; j < 2; ++j) {
        const int col = n0 + wc * 64 + j * 32 + c32;
#pragma unroll
        for (int i = 0; i < 2; ++i) {
            const int rb = m0 + wr * 64 + i * 32 + 4 * hl;
            if (n0 < 512) {
                bf16_t* O = (bf16_t*)(ws_b + WS_UF);
#pragma unroll
                for (int r = 0; r < 16; ++r) O[(size_t)(rb + (r & 3) + 8 * (r >> 2)) * 512 + col] = f2bf(acc[i][j][r]);
            } else if (n0 < 896) {
                bf16_t* O = (bf16_t*)(ws_b + WS_UQ);
#pragma unroll
                for (int r = 0; r < 16; ++r) O[(size_t)(rb + (r & 3) + 8 * (r >> 2)) * 384 + (col - 512)] = f2bf(acc[i][j][r]);
            } else if (n0 < 1152) {
                float* O = (float*)(ws_b + WS_UKV);
#pragma unroll
                for (int r = 0; r < 16; ++r) O[(size_t)(rb + (r & 3) + 8 * (r >> 2)) * 256 + (col - 896)] = acc[i][j][r];
            } else if (n0 < 1280) {
                if (col < 1184) {
                    float* O = (float*)(ws_b + WS_KRF);
#pragma unroll
                    for (int r = 0; r < 16; ++r) O[(size_t)(rb + (r & 3) + 8 * (r >> 2)) * 32 + (col - 1152)] = acc[i][j][r];
                }
            } else if (n0 < 1792) {
                bf16_t* O = (bf16_t*)(ws_b + WS_NAQ);
#pragma unroll
                for (int r = 0; r < 16; ++r) O[(size_t)(rb + (r & 3) + 8 * (r >> 2)) * 512 + (col - 1280)] = f2bf(acc[i][j][r] * NA_QS);
            } else if (n0 < 2304) {
                bf16_t* O = (bf16_t*)(ws_b + WS_NAK);
                const int cc = col - 1792;
#pragma unroll
                for (int r = 0; r < 16; ++r) {
                    const int row = rb + (r & 3) + 8 * (r >> 2);
                    O[(size_t)row * 512 + cc] = f2bf(acc[i][j][r]);
                    if (ctx) p.out[OUT_NAK + ((size_t)((row >> 8) * 4 + l) * 256 + (row & 255)) * 512 + cc] = acc[i][j][r];
                }
            } else if (n0 < 2816) {
                bf16_t* VT = (bf16_t*)(ws_b + WS_NAVT);
                const int cc = col - 2304, h = cc >> 6, d = cc & 63;
#pragma unroll
                for (int qd = 0; qd < 4; ++qd) {
                    const int row = rb + 8 * qd;
                    u32x2 pk; pk.x = pk2(acc[i][j][4 * qd], acc[i][j][4 * qd + 1]); pk.y = pk2(acc[i][j][4 * qd + 2], acc[i][j][4 * qd + 3]);
                    if (ctx) {
                        const int b = row >> 8, s = row & 255;
                        *(u32x2*)(VT + ((size_t)((b * 8 + h) * 64 + d)) * 256 + s) = pk;
#pragma unroll
                        for (int e = 0; e < 4; ++e)
                            p.out[OUT_NAV + ((size_t)(b * 4 + l) * 256 + (s + e)) * 512 + cc] = acc[i][j][4 * qd + e];
                    } else {
                        const int rr = row - NCTX, b = rr >> 11, n = rr & 2047;
                        *(u32x2*)(VT + (size_t)4194304 + ((size_t)((b * 8 + h) * 64 + d)) * 2048 + n) = pk;
                    }
                }
            } else {
                bf16_t* O = (bf16_t*)(ws_b + WS_GATE);
                const int gc = col - 2816;
                const float bg = pin(p, 26)[l * 3072 + gc];
                bf16_t* gp = O + (size_t)gc * M + rb;
#pragma unroll
                for (int qd = 0; qd < 4; ++qd) {
                    u32x2 pk;
                    pk.x = pk2(sigmoidf_(acc[i][j][4 * qd] + bg), sigmoidf_(acc[i][j][4 * qd + 1] + bg));
                    pk.y = pk2(sigmoidf_(acc[i][j][4 * qd + 2] + bg), sigmoidf_(acc[i][j][4 * qd + 3] + bg));
                    *(u32x2*)(gp + 8 * qd) = pk;
                }
            }
        }
    }
}

DEVI void job_uq(const P& p, unsigned char* ws_b, int l, int t, bf16_t* sm, int tid) {
    const int nN = 6; const int m0 = (t / nN) * 128, n0 = (t % nN) * 128;
    const bf16_t* A = (const bf16_t*)(ws_b + WS_UQ);
    const bf16_t* W = (const bf16_t*)(ws_b + WS_W) + (size_t)l * LAYER_W + OFF_WUQ;
    bf16_t* Q = (bf16_t*)(ws_b + WS_Q);
    const float* ropec = (const float*)(ws_b + WS_ROPE);
    const float* ropes = ropec + 512;
    f32x16 acc[2][2]; zero_acc(acc);
    gemm_core(A + (size_t)m0 * 384, 384, W + (size_t)n0 * 384, 384, 384, acc, sm, tid);
    EPI_SETUP
    const bool lat = m0 >= NCTX;
#pragma unroll
    for (int j = 0; j < 2; ++j) {
        const int c0 = n0 + wc * 64 + j * 32;
        const int col = c0 + c32;
        const bool rope = lat && (((c0 >> 5) % 3) == 2);
        const int axis = c32 >> 4, ii = c32 & 15;
#pragma unroll
        for (int i = 0; i < 2; ++i) {
            const int rb = m0 + wr * 64 + i * 32 + 4 * hl;
#pragma unroll
            for (int r = 0; r < 16; ++r) {
                const int row = rb + (r & 3) + 8 * (r >> 2);
                float v = acc[i][j][r];
                const float pr = __shfl_xor(v, 8);
                if (rope) {
                    const int n = (row - NCTX) & 2047;
                    const int pos = axis ? (n & 63) : (n >> 6);
                    const float cs = ropec[pos * 8 + (ii & 7)], sn = ropes[pos * 8 + (ii & 7)];
                    const float rot = (ii < 8) ? -pr : pr;
                    v = v * cs + rot * sn;
                }
                Q[(size_t)row * 768 + col] = f2bf(v * MLA_QS);
            }
        }
    }
}

DEVI void job_ukv(const P& p, unsigned char* ws_b, int l, int t, bf16_t* sm, int tid) {
    const int nN = 8; const int m0 = (t / nN) * 128, h = t % nN, n0 = h * 128;
    const bf16_t* A = (m0 < M) ? (const bf16_t*)(ws_b + WS_CKV) + (size_t)m0 * 256
                               : (const bf16_t*)(ws_b + WS_CCKV) + ((size_t)l * 1024 + (m0 - M)) * 256;
    const bf16_t* W = (const bf16_t*)(ws_b + WS_W) + (size_t)l * LAYER_W + OFF_WUKV;
    bf16_t* KN = (bf16_t*)(ws_b + WS_KN);
    bf16_t* VT = (bf16_t*)(ws_b + WS_VTM);
    f32x16 acc[2][2]; zero_acc(acc);
    gemm_core(A, 256, W + (size_t)n0 * 256, 256, 256, acc, sm, tid);
    EPI_SETUP
#pragma unroll
    for (int j = 0; j < 2; ++j) {
        const int d = j * 32 + c32;
#pragma unroll
        for (int i = 0; i < 2; ++i) {
            const int rb = m0 + wr * 64 + i * 32 + 4 * hl;
            if (wc == 0) {
#pragma unroll
                for (int r = 0; r < 16; ++r) KN[(size_t)(rb + (r & 3) + 8 * (r >> 2)) * 512 + h * 64 + d] = f2bf(acc[i][j][r]);
            } else {
#pragma unroll
                for (int qd = 0; qd < 4; ++qd) {
                    const int row = rb + 8 * qd;
                    u32x2 pk; pk.x = pk2(acc[i][j][4 * qd], acc[i][j][4 * qd + 1]); pk.y = pk2(acc[i][j][4 * qd + 2], acc[i][j][4 * qd + 3]);
                    size_t addr;
                    if (m0 < NCTX) { const int b = row >> 8, s = row & 255; addr = ((size_t)((b * 8 + h) * 64 + d)) * 256 + s; }
                    else if (m0 < M) { const int rr = row - NCTX, b = rr >> 11, n = rr & 2047; addr = (size_t)4194304 + ((size_t)((b * 8 + h) * 64 + d)) * 2560 + n; }
                    else { const int rr = row - M, b = rr >> 9, n = rr & 511; addr = (size_t)4194304 + ((size_t)((b * 8 + h) * 64 + d)) * 2560 + 2048 + n; }
                    *(u32x2*)(VT + addr) = pk;
                }
            }
        }
    }
}

template <int ldo, bool SPLITK = false>
DEVI void job_store(const bf16_t* A, int lda, const bf16_t* Bt, int ldb, int K, bf16_t* Out, bf16_t* sm, int tid, int grp = 0, float* xch = nullptr) {
    f32x16 acc[2][2]; zero_acc(acc);
    if constexpr (SPLITK) { K >>= 1; A += grp * K; Bt += grp * K; }
    gemm_core(A, lda, Bt, ldb, K, acc, sm, tid);
    EPI_SETUP
    if constexpr (SPLITK) {
        if (grp == 1) {
#pragma unroll
            for (int i = 0; i < 2; ++i)
#pragma unroll
                for (int j = 0; j < 2; ++j)
#pragma unroll
                    for (int r = 0; r < 16; ++r) xch[((i * 2 + j) * 16 + r) * 256 + tid] = acc[i][j][r];
        }
        __syncthreads();
        if (grp == 0) {
#pragma unroll
            for (int i = 0; i < 2; ++i)
#pragma unroll
                for (int j = 0; j < 2; ++j)
#pragma unroll
                    for (int r = 0; r < 16; ++r) acc[i][j][r] += xch[((i * 2 + j) * 16 + r) * 256 + tid];
        }
        __syncthreads();
    }
    const bool active = !SPLITK || grp == 0;
    bf16_t* st = sm + (wr * 64 + 4 * hl) * 136 + wc * 64 + c32;
    if (active) {
#pragma unroll
        for (int i = 0; i < 2; ++i)
#pragma unroll
            for (int j = 0; j < 2; ++j)
#pragma unroll
                for (int r = 0; r < 16; ++r) st[(i * 32 + (r & 3) + 8 * (r >> 2)) * 136 + j * 32] = f2bf(acc[i][j][r]);
    }
    __syncthreads();
    if (active) {
        const int orow = tid >> 4, oc = (tid & 15) * 8;
#pragma unroll
        for (int k = 0; k < 8; ++k) {
            const u32x4 v = *(const u32x4*)(sm + (orow + 16 * k) * 136 + oc);
            *(u32x4*)(Out + (size_t)(orow + 16 * k) * ldo + oc) = v;
        }
    }
    __syncthreads();
}

DEVI void job_f1(const P& p, unsigned char* ws_b, int t, bf16_t* sm, int tid) {
    const bf16_t* WCS = (const bf16_t*)(ws_b + WS_WCS);
    const bf16_t* UF = (const bf16_t*)(ws_b + WS_UF);
    bf16_t* F1T = (bf16_t*)(ws_b + WS_F1T);
    if (t < 512) {
        const int bs = t >> 4, g = (t >> 2) & 3, mi = (t >> 1) & 1, ni = t & 1;
        job_store<256>(WCS + mi * 128 * 128, 128, UF + ((size_t)bs * 256 + ni * 128) * 512 + g * 128, 512, 128,
                  F1T + ((size_t)(bs * 4 + g) * 256 + mi * 128) * 256 + ni * 128, sm, tid);
    } else {
        t -= 512;
        const int bs = t >> 7, g = (t >> 5) & 3, mi = (t >> 4) & 1, ni = t & 15;
        job_store<2048>(WCS + mi * 128 * 128, 128, UF + ((size_t)NCTX + bs * 2048 + ni * 128) * 512 + g * 128, 512, 128,
                  F1T + (size_t)8388608 + ((size_t)(bs * 4 + g) * 256 + mi * 128) * 2048 + ni * 128, sm, tid);
    }
}
DEVI void job_f2_lat(const P& p, unsigned char* ws_b, int t, bf16_t* sm, int tid, int grp, float* xch) {
    const int bs = t >> 6, mi = (t >> 2) & 15, ni = t & 3;
    const bf16_t* TAB = (const bf16_t*)(ws_b + WS_TABL);
    const bf16_t* F1T = (const bf16_t*)(ws_b + WS_F1T) + (size_t)8388608;
    bf16_t* YF = (bf16_t*)(ws_b + WS_YF);
    job_store<512, true>(TAB + (size_t)mi * 128 * 4096, 4096, F1T + (size_t)bs * 512 * 4096 + (size_t)ni * 128 * 4096, 4096, 4096,
              YF + ((size_t)NCTX + bs * 2048 + mi * 128) * 512 + ni * 128, sm, tid, grp, xch);
}
DEVI void job_f2_ctx(const P& p, unsigned char* ws_b, int t, bf16_t* sm, int tid) {
    const int bs = t >> 3, mi = (t >> 2) & 1, ni = t & 3;
    const bf16_t* TAB = (const bf16_t*)(ws_b + WS_TABC);
    const bf16_t* F1T = (const bf16_t*)(ws_b + WS_F1T);
    bf16_t* YF = (bf16_t*)(ws_b + WS_YF);
    job_store<512>(TAB + (size_t)mi * 128 * 512, 512, F1T + (size_t)bs * 512 * 512 + (size_t)ni * 128 * 512, 512, 512,
              YF + ((size_t)bs * 256 + mi * 128) * 512 + ni * 128, sm, tid);
}

DEVI void job_merge(const P& p, unsigned char* ws_b, int l, int t, bf16_t* sm, int tid) {
    const int nN = 8; const int m0 = (t / nN) * 128, n0 = (t % nN) * 128;
    const bf16_t* Wl = (const bf16_t*)(ws_b + WS_W) + (size_t)l * LAYER_W;
    const bf16_t* GATE = (const bf16_t*)(ws_b + WS_GATE);
    bf16_t* MG = (bf16_t*)(ws_b + WS_MERGED);
    EPI_SETUP
    f32x16 acc[2][2]; zero_acc(acc);
#pragma unroll 1
    for (int s = 0; s < 3; ++s) {
        const bf16_t* A = (const bf16_t*)(ws_b + (s == 0 ? WS_YF : (s == 1 ? WS_YM : WS_YN)));
        const bf16_t* W = Wl + (s == 0 ? OFF_WBF : (s == 1 ? OFF_WBM : OFF_WBN));
        gemm_core<false>(A + (size_t)m0 * 512, 512, W + (size_t)n0 * 512, 512, 512, acc, sm, tid);
        {
            const int gr = tid >> 4, gc = (tid & 15) * 8;
            const int s1 = s < 2 ? s + 1 : s;
#pragma unroll
            for (int k = 0; k < 8; ++k) {
                const bf16_t* gsrc = GATE + (size_t)(m0 + gr + 16 * k) * 3072 + n0 + gc;
                *(u32x4*)(sm + (gr + 16 * k) * 136 + gc) = *(const u32x4*)(gsrc + s * 1024);
                *(u32x4*)(sm + 128 * 136 + (gr + 16 * k) * 136 + gc) = *(const u32x4*)(gsrc + s1 * 1024);
                if ((k & 1) == 1) __builtin_amdgcn_sched_barrier(0);
            }
        }
        __syncthreads();
#pragma unroll
        for (int j = 0; j < 2; ++j)
#pragma unroll
            for (int i = 0; i < 2; ++i) {
                const bf16_t* gp = sm + (wr * 64 + i * 32 + 4 * hl) * 136 + wc * 64 + j * 32 + c32;
#pragma unroll
                for (int r = 0; r < 16; ++r) {
                    const int o = ((r & 3) + 8 * (r >> 2)) * 136;
                    const float g = bf2f(gp[o]);
                    const float f = (s < 2) ? g * __builtin_amdgcn_rcpf(bf2f(gp[128 * 136 + o])) : g;
                    acc[i][j][r] *= f;
                }
            }
        __syncthreads();
    }
#pragma unroll
    for (int j = 0; j < 2; ++j) {
        const int col = n0 + wc * 64 + j * 32 + c32;
#pragma unroll
        for (int i = 0; i < 2; ++i) {
            const int rb = m0 + wr * 64 + i * 32 + 4 * hl;
#pragma unroll
            for (int r = 0; r < 16; ++r) MG[(size_t)(rb + (r & 3) + 8 * (r >> 2)) * 1024 + col] = f2bf(acc[i][j][r]);
        }
    }
}

struct TileSrc { const bf16_t* k; const bf16_t* k2; const bf16_t* v; const bf16_t* vhi; };
DEVI int pi_row(int r) { return (r & 0x13) | ((r & 4) << 1) | ((r & 8) >> 1); }

template <int NKS>
DEVI void attn_load(const TileSrc& s, bf16x8 (&kf)[NKS], bf16x8 (&vf)[4]) {
#pragma unroll
    for (int ks = 0; ks < NKS; ++ks) kf[ks] = (ks < 4) ? *(const bf16x8*)(s.k + ks * 16) : *(const bf16x8*)(s.k2 + (ks - 4) * 16);
    vf[0] = *(const bf16x8*)(s.v);
    vf[1] = *(const bf16x8*)(s.v + 16);
    vf[2] = *(const bf16x8*)(s.vhi);
    vf[3] = *(const bf16x8*)(s.vhi + 16);
}

template <int NKS, bool SPLIT, class Src, class Mask>
DEVI void attn_wave(const bf16_t* qptr, int t0, int nt, Src src, Mask mask, bf16_t* optr, int lane, float* ex = nullptr, int half = 0) {
    bf16x8 q[NKS];
#pragma unroll
    for (int ks = 0; ks < NKS; ++ks) q[ks] = *(const bf16x8*)(qptr + ks * 16);
    f32x16 o0, o1;
#pragma unroll
    for (int r = 0; r < 16; ++r) { o0[r] = 0.f; o1[r] = 0.f; }
    float m = -1e30f, lsum = 0.f;
    bf16x8 kf[NKS], vf[4];
    nt += t0;
    { TileSrc s0 = src(t0); attn_load<NKS>(s0, kf, vf); }
    for (int t = t0; t < nt; ++t) {
        bf16x8 kn[NKS], vn[4];
        { TileSrc s1 = src(t + 1 < nt ? t + 1 : t); attn_load<NKS>(s1, kn, vn); }
        f32x16 s;
#pragma unroll
        for (int r = 0; r < 16; ++r) s[r] = 0.f;
#pragma unroll
        for (int ks = 0; ks < NKS; ++ks) s = __builtin_amdgcn_mfma_f32_32x32x16_bf16(kf[ks], q[ks], s, 0, 0, 0);
        mask(t, s);
        float mx = s[0];
#pragma unroll
        for (int r = 1; r < 16; ++r) mx = fmaxf(mx, s[r]);
        mx = fmaxf(mx, __shfl_xor(mx, 32));
        const float mn = fmaxf(m, mx);
        const float alpha = fast_exp2(m - mn);
        m = mn;
        float rs = 0.f;
#pragma unroll
        for (int r = 0; r < 16; ++r) { s[r] = fast_exp2(s[r] - mn); rs += s[r]; }
        lsum = lsum * alpha + rs;
#pragma unroll
        for (int r = 0; r < 16; ++r) { o0[r] *= alpha; o1[r] *= alpha; }
        bf16x8 p0, p1;
        {
            u32x4 a, b;
            a.x = pk2(s[0], s[1]); a.y = pk2(s[2], s[3]); a.z = pk2(s[4], s[5]); a.w = pk2(s[6], s[7]);
            b.x = pk2(s[8], s[9]); b.y = pk2(s[10], s[11]); b.z = pk2(s[12], s[13]); b.w = pk2(s[14], s[15]);
            p0 = __builtin_bit_cast(bf16x8, a); p1 = __builtin_bit_cast(bf16x8, b);
        }
        o0 = __builtin_amdgcn_mfma_f32_32x32x16_bf16(vf[0], p0, o0, 0, 0, 0);
        o0 = __builtin_amdgcn_mfma_f32_32x32x16_bf16(vf[1], p1, o0, 0, 0, 0);
        o1 = __builtin_amdgcn_mfma_f32_32x32x16_bf16(vf[2], p0, o1, 0, 0, 0);
        o1 = __builtin_amdgcn_mfma_f32_32x32x16_bf16(vf[3], p1, o1, 0, 0, 0);
#pragma unroll
        for (int ks = 0; ks < NKS; ++ks) kf[ks] = kn[ks];
#pragma unroll
        for (int x = 0; x < 4; ++x) vf[x] = vn[x];
    }
    if constexpr (SPLIT) {
        if (half == 1) {
#pragma unroll
            for (int r = 0; r < 16; ++r) { ex[r * 64 + lane] = o0[r]; ex[(16 + r) * 64 + lane] = o1[r]; }
            ex[32 * 64 + lane] = m; ex[33 * 64 + lane] = lsum;
        }
        __syncthreads();
        if (half == 0) {
            const float m2 = ex[32 * 64 + lane], l2 = ex[33 * 64 + lane];
            const float mn = fmaxf(m, m2), a1 = fast_exp2(m - mn), a2 = fast_exp2(m2 - mn);
            lsum = lsum * a1 + l2 * a2;
#pragma unroll
            for (int r = 0; r < 16; ++r) { o0[r] = o0[r] * a1 + ex[r * 64 + lane] * a2; o1[r] = o1[r] * a1 + ex[(16 + r) * 64 + lane] * a2; }
        }
        __syncthreads();
        if (half == 1) return;
    }
    lsum += __shfl_xor(lsum, 32);
    const float inv = 1.f / lsum;
    const int hl = lane >> 5;
#pragma unroll
    for (int qd = 0; qd < 4; ++qd) {
        u32x2 a, b;
        a.x = pk2(o0[4 * qd] * inv, o0[4 * qd + 1] * inv); a.y = pk2(o0[4 * qd + 2] * inv, o0[4 * qd + 3] * inv);
        b.x = pk2(o1[4 * qd] * inv, o1[4 * qd + 1] * inv); b.y = pk2(o1[4 * qd + 2] * inv, o1[4 * qd + 3] * inv);
        *(u32x2*)(optr + 8 * qd + 4 * hl) = a;
        *(u32x2*)(optr + 32 + 8 * qd + 4 * hl) = b;
    }
}

struct NoMask { DEVI void operator()(int, f32x16&) const {} };

DEVI void attn_mla(const P& p, unsigned char* ws_b, int l, bool lat, int b, int h, int qg, int lane, float* ex = nullptr, int half = 0) {
    const int hl = lane >> 5, c32 = lane & 31, pr = pi_row(c32);
    const bf16_t* Q = (const bf16_t*)(ws_b + WS_Q);
    const bf16_t* KN = (const bf16_t*)(ws_b + WS_KN);
    const bf16_t* KR = (const bf16_t*)(ws_b + WS_KR);
    const bf16_t* CKR = (const bf16_t*)(ws_b + WS_CKR) + (size_t)l * 1024 * 32;
    const bf16_t* VT = (const bf16_t*)(ws_b + WS_VTM);
    bf16_t* YM = (bf16_t*)(ws_b + WS_YM);
    if (!lat) {
        const int row0 = b * 256;
        const int qrow = row0 + qg * 32 + c32;
        const bf16_t* k0 = KN + (size_t)(row0 + pr) * 512 + h * 64 + hl * 8;
        const bf16_t* r0 = KR + (size_t)(row0 + pr) * 32 + hl * 8;
        const bf16_t* v0 = VT + ((size_t)((b * 8 + h) * 64 + c32)) * 256 + hl * 8;
        auto src = [=](int t) { TileSrc s; s.k = k0 + (size_t)t * 32 * 512; s.k2 = r0 + (size_t)t * 32 * 32; s.v = v0 + t * 32; s.vhi = s.v + 32 * 256; return s; };
        attn_wave<6, false>(Q + (size_t)qrow * 768 + h * 96 + hl * 8, 0, 8, src, NoMask(), YM + (size_t)qrow * 512 + h * 64, lane);
    } else {
        const int row0 = NCTX + b * 2048;
        const int qrow = row0 + qg * 32 + c32;
        const bf16_t* k0 = KN + (size_t)(row0 + pr) * 512 + h * 64 + hl * 8;
        const bf16_t* r0 = KR + (size_t)(row0 + pr) * 32 + hl * 8;
        const bf16_t* k1 = KN + (size_t)(M + b * 512 + pr) * 512 + h * 64 + hl * 8;
        const bf16_t* r1 = CKR + (size_t)(b * 512 + pr) * 32 + hl * 8;
        const bf16_t* v0 = VT + (size_t)4194304 + ((size_t)((b * 8 + h) * 64 + c32)) * 2560 + hl * 8;
        auto src = [=](int t) {
            TileSrc s;
            if (t < 64) { s.k = k0 + (size_t)t * 32 * 512; s.k2 = r0 + (size_t)t * 32 * 32; }
            else { s.k = k1 + (size_t)(t - 64) * 32 * 512; s.k2 = r1 + (size_t)(t - 64) * 32 * 32; }
            s.v = v0 + t * 32; s.vhi = s.v + 32 * 2560; return s; };
        attn_wave<6, true>(Q + (size_t)qrow * 768 + h * 96 + hl * 8, half * 40, 40, src, NoMask(), YM + (size_t)qrow * 512 + h * 64, lane, ex, half);
    }
}

DEVI void attn_na_ctx(const P& p, unsigned char* ws_b, int b, int h, int qg, int lane) {
    const int hl = lane >> 5, c32 = lane & 31, pr = pi_row(c32);
    const bf16_t* Qn = (const bf16_t*)(ws_b + WS_NAQ);
    const bf16_t* Kn = (const bf16_t*)(ws_b + WS_NAK);
    const bf16_t* VT = (const bf16_t*)(ws_b + WS_NAVT);
    bf16_t* YN = (bf16_t*)(ws_b + WS_YN);
    const int row0 = b * 256, qrow = row0 + qg * 32 + c32;
    const bf16_t* k0 = Kn + (size_t)(row0 + pr) * 512 + h * 64 + hl * 8;
    const bf16_t* v0 = VT + ((size_t)((b * 8 + h) * 64 + c32)) * 256 + hl * 8;
    auto src = [=](int t) { TileSrc s; s.k = k0 + (size_t)t * 32 * 512; s.k2 = s.k; s.v = v0 + t * 32; s.vhi = s.v + 32 * 256; return s; };
    attn_wave<4, false>(Qn + (size_t)qrow * 512 + h * 64 + hl * 8, 0, 8, src, NoMask(), YN + (size_t)qrow * 512 + h * 64, lane);
}

struct NaMask {
    const float* rpb;
    int rs, rq, qc, hl;
    DEVI void operator()(int t, f32x16& s) const {
        if (t >= 16) return;
        const int kr = t >> 1, kh = t & 1;
        const int cs = min(max(qc - 8, 0), 48);
        const float* rp = rpb + (rs + kr - rq + 7) * 31;
#pragma unroll
        for (int r = 0; r < 16; ++r) {
            const int kk = (r & 3) + 4 * ((r >> 2) & 1) + 8 * hl + 16 * (r >> 3);
            const int kc = kh * 32 + kk;
            const bool ok = (kc >= cs) && (kc < cs + 16);
            const int dc = min(max(kc - qc + 15, 0), 30);
            const float bias = rp[dc] * LOG2E;
            s[r] = ok ? s[r] + bias : -1e30f;
        }
    }
};
DEVI void attn_na_lat(const P& p, unsigned char* ws_b, int l, int b, int h, int rq, int qh, int lane, float* ex, int half) {
    const int hl = lane >> 5, c32 = lane & 31, pr = pi_row(c32);
    const bf16_t* Qn = (const bf16_t*)(ws_b + WS_NAQ);
    const bf16_t* Kn = (const bf16_t*)(ws_b + WS_NAK);
    const bf16_t* VT = (const bf16_t*)(ws_b + WS_NAVT) + (size_t)4194304;
    const bf16_t* CK = (const bf16_t*)(ws_b + WS_CNAK) + (size_t)l * 1024 * 512;
    const bf16_t* CV = (const bf16_t*)(ws_b + WS_CNAVT) + (size_t)l * 1024 * 512;
    bf16_t* YN = (bf16_t*)(ws_b + WS_YN);
    const int row0 = NCTX + b * 2048;
    const int qrow = row0 + rq * 64 + qh * 32 + c32;
    const int rs = min(max(rq - 4, 0), 24);
    const bf16_t* k0 = Kn + (size_t)(row0 + rs * 64 + pr) * 512 + h * 64 + hl * 8;
    const bf16_t* v0 = VT + ((size_t)((b * 8 + h) * 64 + c32)) * 2048 + rs * 64 + hl * 8;
    const bf16_t* k1 = CK + (size_t)(b * 512 + pr) * 512 + h * 64 + hl * 8;
    const bf16_t* v1 = CV + ((size_t)((b * 8 + h) * 64 + c32)) * 512 + hl * 8;
    auto src = [=](int t) {
        TileSrc s;
        if (t < 16) { s.k = k0 + (size_t)t * 32 * 512; s.v = v0 + t * 32; s.vhi = s.v + 32 * 2048; }
        else { s.k = k1 + (size_t)(t - 16) * 32 * 512; s.v = v1 + (t - 16) * 32; s.vhi = s.v + 32 * 512; }
        s.k2 = s.k; return s; };
    NaMask mk; mk.rpb = pin(p, 21) + (size_t)(l * 8 + h) * 15 * 31; mk.rs = rs; mk.rq = rq; mk.qc = qh * 32 + c32; mk.hl = hl;
    attn_wave<4, true>(Qn + (size_t)qrow * 512 + h * 64 + hl * 8, half * 16, 16, src, mk, YN + (size_t)qrow * 512 + h * 64, lane, ex, half);
}

DEVI void row_ln_mod(const float* src, float* xdst, bf16_t* hdst, const float* lng, const float* lnb, const float* shift, const float* scale, int lane) {
    f32x4 v[4];
#pragma unroll
    for (int j = 0; j < 4; ++j) v[j] = *(const f32x4*)(src + 4 * lane + 256 * j);
    if (lng) {
        float s = 0.f;
#pragma unroll
        for (int j = 0; j < 4; ++j) s += (v[j].x + v[j].y) + (v[j].z + v[j].w);
        const float mu = wave_sum(s) * (1.f / D);
        float q = 0.f;
#pragma unroll
        for (int j = 0; j < 4; ++j) { v[j] = v[j] - mu; q += (v[j].x * v[j].x + v[j].y * v[j].y) + (v[j].z * v[j].z + v[j].w * v[j].w); }
        const float rstd = rsqrtf(wave_sum(q) * (1.f / D) + 1e-5f);
#pragma unroll
        for (int j = 0; j < 4; ++j) {
            const f32x4 g = *(const f32x4*)(lng + 4 * lane + 256 * j), bb = *(const f32x4*)(lnb + 4 * lane + 256 * j);
            v[j] = v[j] * rstd * g + bb;
        }
    }
    if (xdst) {
#pragma unroll
        for (int j = 0; j < 4; ++j) *(f32x4*)(xdst + 4 * lane + 256 * j) = v[j];
    }
    if (hdst) {
        float s = 0.f;
#pragma unroll
        for (int j = 0; j < 4; ++j) s += (v[j].x + v[j].y) + (v[j].z + v[j].w);
        const float mu = wave_sum(s) * (1.f / D);
        float q = 0.f;
#pragma unroll
        for (int j = 0; j < 4; ++j) { v[j] = v[j] - mu; q += (v[j].x * v[j].x + v[j].y * v[j].y) + (v[j].z * v[j].z + v[j].w * v[j].w); }
        const float rstd = rsqrtf(wave_sum(q) * (1.f / D) + 1e-6f);
#pragma unroll
        for (int j = 0; j < 4; ++j) {
            const f32x4 sc = *(const f32x4*)(scale + 4 * lane + 256 * j), sh = *(const f32x4*)(shift + 4 * lane + 256 * j);
            const f32x4 o = v[j] * rstd * (sc + 1.f) + sh;
            u32x2 pk; pk.x = pk2(o.x, o.y); pk.y = pk2(o.z, o.w);
            *(u32x2*)(hdst + 4 * lane + 256 * j) = pk;
        }
    }
}

DEVI void phase_rows(const P& p, unsigned char* ws_b, int l, int lnidx, int ml, int ms, bool final_, int gw, int ngw, int lane) {
    float* X = (float*)(ws_b + WS_X);
    bf16_t* H = (bf16_t*)(ws_b + WS_H);
    const float* MOD = (const float*)(ws_b + WS_MOD);
    for (int row = gw; row < M; row += ngw) {
        const float* src = (lnidx < 0) ? (row < NCTX ? pin(p, 0) + (size_t)row * D : pin(p, 1) + (size_t)(row - NCTX) * D) : X + (size_t)row * D;
        const float* lng = (lnidx < 0) ? nullptr : pin(p, 28) + (size_t)(l * 3 + lnidx) * D;
        const float* lnb = (lnidx < 0) ? nullptr : pin(p, 29) + (size_t)(l * 3 + lnidx) * D;
        if (final_) { row_ln_mod(src, p.out + (size_t)row * D, nullptr, lng, lnb, nullptr, nullptr, lane); continue; }
        const float* mb = MOD + ((size_t)ml * 3 + mod_group(row)) * 9216;
        row_ln_mod(src, X + (size_t)row * D, H + (size_t)row * D, lng, lnb, mb + ms * D, mb + (ms + 1) * D, lane);
    }
}

DEVI void phase_rowmix(const P& p, unsigned char* ws_b, int l, int gw, int ngw, int lane) {
    bf16_t* UQ = (bf16_t*)(ws_b + WS_UQ);
    const float* UKV = (const float*)(ws_b + WS_UKV);
    const float* KRF = (const float*)(ws_b + WS_KRF);
    bf16_t* CKV = (bf16_t*)(ws_b + WS_CKV);
    bf16_t* KR = (bf16_t*)(ws_b + WS_KR);
    const float* ropec = (const float*)(ws_b + WS_ROPE);
    const float* ropes = ropec + 512;
    const float* gq = pin(p, 17) + l * 384;
    const float* gkv = pin(p, 19) + l * 256;
    for (int row = gw; row < M; row += ngw) {
        {
            unsigned* up = (unsigned*)(UQ + (size_t)row * 384) + lane;
            float x[6]; float ss = 0.f;
#pragma unroll
            for (int j = 0; j < 3; ++j) { const unsigned w = up[64 * j]; x[2 * j] = bf2f(w & 0xffffu); x[2 * j + 1] = bf2f(w >> 16); ss += x[2 * j] * x[2 * j] + x[2 * j + 1] * x[2 * j + 1]; }
            const float rs = rsqrtf(wave_sum(ss) * (1.f / 384.f) + 1e-6f);
#pragma unroll
            for (int j = 0; j < 3; ++j) { const int c = 2 * lane + 128 * j; up[64 * j] = pk2(x[2 * j] * rs * gq[c], x[2 * j + 1] * rs * gq[c + 1]); }
        }
        {
            const f32x4 v = *(const f32x4*)(UKV + (size_t)row * 256 + 4 * lane);
            const float ss = v.x * v.x + v.y * v.y + v.z * v.z + v.w * v.w;
            const float rs = rsqrtf(wave_sum(ss) * (1.f / 256.f) + 1e-6f);
            const f32x4 g = *(const f32x4*)(gkv + 4 * lane);
            const f32x4 o = v * rs * g;
            u32x2 pk; pk.x = pk2(o.x, o.y); pk.y = pk2(o.z, o.w);
            *(u32x2*)(CKV + (size_t)row * 256 + 4 * lane) = pk;
            if (row < NCTX) *(f32x4*)(p.out + OUT_CKV + ((size_t)((row >> 8) * 4 + l) * 256 + (row & 255)) * 256 + 4 * lane) = o;
        }
        {
            const float v = KRF[(size_t)row * 32 + (lane & 31)];
            const float pr = __shfl_xor(v, 8);
            float o = v;
            if (row >= NCTX) {
                const int c = lane & 31, axis = c >> 4, ii = c & 15, n = (row - NCTX) & 2047;
                const int pos = axis ? (n & 63) : (n >> 6);
                const float rot = (ii < 8) ? -pr : pr;
                o = v * ropec[pos * 8 + (ii & 7)] + rot * ropes[pos * 8 + (ii & 7)];
            }
            if (lane < 32) {
                KR[(size_t)row * 32 + lane] = f2bf(o);
                if (row < NCTX) p.out[OUT_KR + ((size_t)((row >> 8) * 4 + l) * 256 + (row & 255)) * 32 + lane] = v;
            }
        }
    }
}

DEVI void transpose_item(const float* __restrict__ src, int N, int c0, int k0, bf16_t* __restrict__ dst, int K, float* scr, int lane) {
#pragma unroll 8
    for (int i = 0; i < 32; ++i) { const int kk = 2 * i + (lane >> 5); scr[kk * 33 + (lane & 31)] = src[(size_t)(k0 + kk) * N + c0 + (lane & 31)]; }
    asm volatile("s_waitcnt lgkmcnt(0)" ::: "memory");
    const int c = lane & 7;
#pragma unroll
    for (int j = 0; j < 4; ++j) {
        const int n = (lane >> 3) + 8 * j; const float* s = scr + (8 * c) * 33 + n;
        u32x4 o; o.x = pk2(s[0], s[33]); o.y = pk2(s[2 * 33], s[3 * 33]); o.z = pk2(s[4 * 33], s[5 * 33]); o.w = pk2(s[6 * 33], s[7 * 33]);
        *(u32x4*)(dst + (size_t)n * K + k0 + 8 * c) = o;
    }
    asm volatile("s_waitcnt lgkmcnt(0)" ::: "memory");
}

DEVI void prep_weight_item(const P& p, unsigned char* ws_b, int item, float* scr, int lane) {
    const int l = item / 12944; int r = item % 12944;
    bf16_t* Wl = (bf16_t*)(ws_b + WS_W) + (size_t)l * LAYER_W;
    if (r < 8448) {
        const int which = r / 4224; r %= 4224;
        if (r < 2816) {
            const int rb = r >> 4, kb = r & 15;
            const float* src = ((lane & 16) ? (which ? pin(p, 14) : pin(p, 11)) : (which ? pin(p, 13) : pin(p, 10))) + (size_t)l * D * DFF;
            transpose_item(src, DFF, rb * 16 - (lane & 16), kb * 64, Wl + (which ? OFF_W13_2 : OFF_W13_1) + (size_t)rb * 32 * D, D, scr, lane);
        } else {
            r -= 2816; const int rb = r / 44, kb = r % 44;
            const float* src = (which ? pin(p, 15) : pin(p, 12)) + (size_t)l * DFF * D;
            transpose_item(src, D, rb * 32, kb * 64, Wl + (which ? OFF_W2_2 : OFF_W2_1) + (size_t)rb * 32 * DFF, DFF, scr, lane);
        }
        return;
    }
    r -= 8448;
    if (r < 2944) {
        const int rb = r >> 4, kb = r & 15, R0 = rb * 32;
        const float* src; int N, c0;
        if (R0 < 1184) { src = pin(p, 16) + (size_t)l * D * 2720; N = 2720; c0 = R0; }
        else if (R0 < 1280) return;
        else if (R0 < 2816) { src = pin(p, 16) + (size_t)l * D * 2720; N = 2720; c0 = R0 - 96; }
        else { src = pin(p, 25) + (size_t)l * D * 3072; N = 3072; c0 = R0 - 2816; }
        transpose_item(src, N, c0, kb * 64, Wl + OFF_WIN + (size_t)R0 * D, D, scr, lane);
        return;
    }
    r -= 2944;
    if (r < 512) { const int rb = r >> 4, kb = r & 15; transpose_item(pin(p, 27) + (size_t)l * D * D, D, rb * 32, kb * 64, Wl + OFF_WOUT + (size_t)rb * 32 * D, D, scr, lane); return; }
    r -= 512;
    if (r < 768) { const int w = r >> 8; r &= 255; const int rb = r >> 3, kb = r & 7;
        transpose_item((w == 0 ? pin(p, 22) : (w == 1 ? pin(p, 23) : pin(p, 24))) + (size_t)l * 512 * D, D, rb * 32, kb * 64, Wl + (w == 0 ? OFF_WBF : (w == 1 ? OFF_WBM : OFF_WBN)) + (size_t)rb * 32 * 512, 512, scr, lane); return; }
    r -= 768;
    if (r < 144) { const int rb = r / 6, kb = r % 6; transpose_item(pin(p, 18) + (size_t)l * 384 * 768, 768, rb * 32, kb * 64, Wl + OFF_WUQ + (size_t)rb * 32 * 384, 384, scr, lane); return; }
    r -= 144;
    { const int rb = r >> 2, kb = r & 3; transpose_item(pin(p, 20) + (size_t)l * 256 * 1024, 1024, rb * 32, kb * 64, Wl + OFF_WUKV + (size_t)rb * 32 * 256, 256, scr, lane); }
}

DEVI void phase_prep(const P& p, unsigned char* ws_b, unsigned char* smem, int tid) {
    const int lane = tid & 63, wave = tid >> 6;
    const int gw = blockIdx.x * NWAVES + wave, ngw = gridDim.x * NWAVES;
    const size_t gt = (size_t)blockIdx.x * NTHREADS + tid, ngt = (size_t)gridDim.x * NTHREADS;
    {
        float* sil = (float*)smem;
        const float* wada = pin(p, 8);
        float* MODP = (float*)(ws_b + WS_MODP);
        for (int item = blockIdx.x; item < 1152; item += gridDim.x) {
            const int l = item / 288, rem = item % 288, kc = rem / 18, cb = rem % 18;
            __syncthreads();
            if (tid < 192) {
                const int g = tid >> 6, k = kc * 64 + (tid & 63);
                const float cv = (g == 0) ? pin(p, 7)[k] : pin(p, 6)[(g - 1) * D + k];
                sil[tid] = cv * sigmoidf_(cv);
            }
            __syncthreads();
            const int col = cb * NTHREADS + tid;
            const float* w = wada + ((size_t)l * D + kc * 64) * 9216 + col;
            float a0 = 0.f, a1 = 0.f, a2 = 0.f;
#pragma unroll 16
            for (int k = 0; k < 64; ++k) { const float wv = w[(size_t)k * 9216]; a0 += sil[k] * wv; a1 += sil[64 + k] * wv; a2 += sil[128 + k] * wv; }
            float* o = MODP + ((size_t)(l * 16 + kc) * 3) * 9216 + col;
            o[0] = a0; o[9216] = a1; o[2 * 9216] = a2;
        }
        __syncthreads();
    }
    {
        float* scr = (float*)smem + wave * (64 * 33);
        for (int item = gw; item < 4 * 12944; item += ngw) prep_weight_item(p, ws_b, item, scr, lane);
    }
    {
        bf16_t* TABL = (bf16_t*)(ws_b + WS_TABL);
        for (size_t e = gt; e < (size_t)2048 * 4096; e += ngt) {
            const int k = (int)(e >> 12), kk = (int)(e & 4095), lidx = kk & 2047;
            const int idx = (k * lidx) & 2047;
            float sn, cs; sincospif((float)idx * (2.f / 2048.f), &sn, &cs);
            TABL[e] = f2bf((kk < 2048 ? cs : -sn) * 0.022097086912079608f);
        }
        bf16_t* TABC = (bf16_t*)(ws_b + WS_TABC);
        for (size_t e = gt; e < (size_t)256 * 512; e += ngt) {
            const int k = (int)(e >> 9), kk = (int)(e & 511), lidx = kk & 255;
            const int idx = (k * lidx) & 255;
            float sn, cs; sincospif((float)idx * (2.f / 256.f), &sn, &cs);
            TABC[e] = f2bf((kk < 256 ? cs : -sn) * 0.0625f);
        }
        bf16_t* WCS = (bf16_t*)(ws_b + WS_WCS);
        for (size_t e = gt; e < (size_t)256 * 128; e += ngt) {
            const int i = (int)(e >> 7), c = (int)(e & 127), m = i >> 1, cs_ = i & 1;
            const int idx = (m * c) & 127;
            float sn, cs; sincospif((float)idx * (2.f / 128.f), &sn, &cs);
            WCS[e] = f2bf((cs_ ? sn : cs) * 0.08838834764831845f);
        }
        float* ROPE = (float*)(ws_b + WS_ROPE);
        for (size_t e = gt; e < 512; e += ngt) {
            const int pos = (int)(e >> 3), i = (int)(e & 7);
            const float inv_freq = powf(10000.f, -(float)i / 8.f);
            const float ang = (float)pos * inv_freq;
            ROPE[e] = cosf(ang); ROPE[512 + e] = sinf(ang);
        }
    }
    {
        bf16_t* CCKV = (bf16_t*)(ws_b + WS_CCKV);
        for (size_t e = gt; e < (size_t)NL * 1024 * 256; e += ngt) {
            const int c = (int)(e & 255), i = (int)((e >> 8) & 511), b = (int)((e >> 17) & 1), l = (int)(e >> 18);
            CCKV[e] = f2bf(pin(p, 2)[((size_t)(b * 4 + l) * 512 + i) * 256 + c]);
        }
        bf16_t* CKR = (bf16_t*)(ws_b + WS_CKR);
        for (size_t e = gt; e < (size_t)NL * 1024 * 32; e += ngt) {
            const int c = (int)(e & 31), i = (int)((e >> 5) & 511), b = (int)((e >> 14) & 1), l = (int)(e >> 15);
            CKR[e] = f2bf(pin(p, 3)[((size_t)(b * 4 + l) * 512 + i) * 32 + c]);
        }
        bf16_t* CNAK = (bf16_t*)(ws_b + WS_CNAK);
        for (size_t e = gt; e < (size_t)NL * 1024 * 512; e += ngt) {
            const int c = (int)(e & 511), i = (int)((e >> 9) & 511), b = (int)((e >> 18) & 1), l = (int)(e >> 19);
            CNAK[e] = f2bf(pin(p, 4)[((size_t)(b * 4 + l) * 512 + i) * 512 + c]);
        }
        bf16_t* CNAVT = (bf16_t*)(ws_b + WS_CNAVT);
        for (size_t e = gt; e < (size_t)NL * 1024 * 512; e += ngt) {
            const int key = (int)(e & 511), hd = (int)((e >> 9) & 511), b = (int)((e >> 18) & 1), l = (int)(e >> 19);
            CNAVT[e] = f2bf(pin(p, 5)[((size_t)(b * 4 + l) * 512 + key) * 512 + hd]);
        }
    }
}

DEVI void phase_modreduce(const P& p, unsigned char* ws_b, int tid) {
    const float* MODP = (const float*)(ws_b + WS_MODP);
    float* MOD = (float*)(ws_b + WS_MOD);
    for (int e = blockIdx.x * NTHREADS + tid; e < NL * 3 * 9216; e += gridDim.x * NTHREADS) {
        const int l = e / (3 * 9216), rem = e % (3 * 9216);
        float a = pin(p, 9)[l * 9216 + (rem % 9216)];
#pragma unroll
        for (int kc = 0; kc < 16; ++kc) a += MODP[((size_t)(l * 16 + kc) * 3) * 9216 + rem];
        MOD[e] = a;
    }
}

#define XB_TMO      128
#define XB_XCNT(j)  (256  + 64 * (j))
#define XB_XSUB(j)  (1280 + 64 * (j))
#define XB_XGEN(j)  (2304 + 64 * (j))
#define XB_TOP      3328
#define XB_TOPGEN   3392
#define XCD_BAR_WORDS 3456
#define XB_SPIN_CAP (1u << 20)
#define LAS __attribute__((address_space(3)))
DEVI unsigned xb_ld(unsigned* p)              { return __hip_atomic_load(p, __ATOMIC_RELAXED, __HIP_MEMORY_SCOPE_AGENT); }
DEVI unsigned xb_add(unsigned* p, unsigned v) { return __hip_atomic_fetch_add(p, v, __ATOMIC_RELAXED, __HIP_MEMORY_SCOPE_AGENT); }
DEVI unsigned xb_xcc_id() { return (unsigned)__builtin_amdgcn_s_getreg((3 << 11) | 20) & 0xFu; }
#define XB_SPIN(cond, bar) do { unsigned _sp = 0; while (cond) { __builtin_amdgcn_s_sleep(1); \
    if ((++_sp & 255u) == 0u) { if (xb_ld(&(bar)[XB_TMO])) break; if (_sp > XB_SPIN_CAP) { atomicAdd(&(bar)[XB_TMO], 1u); break; } } } } while (0)
struct XcdBarrier { unsigned* bar; unsigned x; volatile LAS unsigned* st; };
DEVI XcdBarrier xcd_barrier_post(unsigned* bar, volatile LAS unsigned* st) {
    XcdBarrier b; b.bar = bar; b.x = xb_xcc_id(); b.st = st;
    if (threadIdx.x == 0) (void)xb_add(&bar[XB_XCNT(b.x)], 1u);
    return b;
}
DEVI void xcd_barrier_complete(unsigned* bar, unsigned x, unsigned& nloc, unsigned& nx) {
    const unsigned G = gridDim.x * gridDim.y * gridDim.z;
    unsigned sum, cnt, mine, sp = 0u;
    for (;;) {
        sum = 0u; cnt = 0u; mine = 0u;
#pragma unroll
        for (unsigned j = 0; j < 16; ++j) { const unsigned c = xb_ld(&bar[XB_XCNT(j)]); sum += c; cnt += (c > 0u) ? 1u : 0u; mine = (j == x) ? c : mine; }
        if (sum == G) break;
        __builtin_amdgcn_s_sleep(1);
        if ((++sp & 255u) == 0u) { if (xb_ld(&bar[XB_TMO])) break; if (sp > XB_SPIN_CAP) { atomicAdd(&bar[XB_TMO], 1u); break; } }
    }
    nloc = mine > 0u ? mine : 1u; nx = cnt > 0u ? cnt : 1u;
}
DEVI void xcd_barrier(const XcdBarrier& b) {
    asm volatile("s_waitcnt vmcnt(0)" ::: "memory");
    __syncthreads();
    if (threadIdx.x == 0) {
        unsigned* bar = b.bar;
        __builtin_amdgcn_s_waitcnt(0);
        unsigned nloc = b.st[0], nx = b.st[1];
        if (nloc == 0u) { xcd_barrier_complete(bar, b.x, nloc, nx); b.st[0] = nloc; b.st[1] = nx; }
        const unsigned old = xb_add(&bar[XB_XSUB(b.x)], 1u);
        const unsigned gen = old / nloc;
        if (old + 1u == (gen + 1u) * nloc) {
            __builtin_amdgcn_fence(__ATOMIC_RELEASE, "agent");
            asm volatile("s_waitcnt vmcnt(0)" ::: "memory");
            const unsigned og = xb_add(&bar[XB_TOP], 1u);
            const unsigned tg = og / nx;
            if (og + 1u == (tg + 1u) * nx) xb_add(&bar[XB_TOPGEN], 1u);
            else XB_SPIN(xb_ld(&bar[XB_TOPGEN]) == tg, bar);
            __builtin_amdgcn_fence(__ATOMIC_ACQUIRE, "agent");
            xb_add(&bar[XB_XGEN(b.x)], 1u);
            asm volatile("s_waitcnt vmcnt(0)" ::: "memory");
        } else {
            XB_SPIN(xb_ld(&bar[XB_XGEN(b.x)]) == gen, bar);
            __builtin_amdgcn_fence(__ATOMIC_ACQUIRE, "agent");
            asm volatile("s_waitcnt vmcnt(0)" ::: "memory");
        }
    }
    __syncthreads();
}

DEVI void run_phase(const P& p, unsigned char* ws_b, int ph, unsigned char* smem, int tid) {
    const int lane = tid & 63, wave = tid >> 6;
    const int gw = blockIdx.x * NWAVES + wave, ngw = gridDim.x * NWAVES;
    const int nb = gridDim.x, bid = blockIdx.x;
    const int grp = tid >> 8, ltid = tid & 255;
    bf16_t* sm = (bf16_t*)smem + grp * (SMEM_BYTES / 2);
    if (ph == 0) { phase_prep(p, ws_b, smem, tid); return; }
    if (ph == 1) { phase_modreduce(p, ws_b, tid); return; }
    if (ph == 2) { phase_rows(p, ws_b, 0, -1, 0, 0, false, gw, ngw, lane); return; }
    const int l = (ph - 3) / 13, s = (ph - 3) % 13;
    const bf16_t* Wl = (const bf16_t*)(ws_b + WS_W) + (size_t)l * LAYER_W;
    const float* MODl = (const float*)(ws_b + WS_MOD) + (size_t)l * 3 * 9216;
    switch (s) {
    case 0: case 10:
        {
            pg8::Gemm g{(const bf16_t*)(ws_b + WS_H), Wl + (s == 10 ? OFF_W13_2 : OFF_W13_1), M, 2 * DFF, D};
            pg8::StaticOrder S; S.init(M, 2 * DFF, nb, bid);
            pg8::EpiSwiGLU E{(bf16_t*)(ws_b + WS_ACT)};
            pg8::gemm_phase<pg8::EpiSwiGLU, pg8::StaticOrder, true, true>((PG8_LAS unsigned char*)smem, g, S, E, tid);
        }
        break;
    case 1: case 11:
        {
            pg8::Gemm g{(const bf16_t*)(ws_b + WS_ACT), Wl + (s == 11 ? OFF_W2_2 : OFF_W2_1), M, D, DFF};
            pg8::StaticOrder S; S.init(M, D, nb, bid);
            pg8::EpiResid E{(float*)(ws_b + WS_X), MODl + (s == 11 ? 8 : 2) * D, 0.5f};
            pg8::gemm_phase<pg8::EpiResid, pg8::StaticOrder, false, true>((PG8_LAS unsigned char*)smem, g, S, E, tid);
        }
        break;
    case 2: phase_rows(p, ws_b, l, 0, l, 3, false, gw, ngw, lane); break;
    case 3:
        {
            pg8::Gemm g{(const bf16_t*)(ws_b + WS_H), Wl + OFF_WIN, M, 5888, D};
            pg8::StaticOrder S; S.init(M, 5888, nb, bid);
            pg8::EpiIn E{ws_b, p.out, pin(p, 26), l};
            pg8::gemm_phase<pg8::EpiIn, pg8::StaticOrder, true, true>((PG8_LAS unsigned char*)smem, g, S, E, tid);
        }
        break;
    case 4: phase_rowmix(p, ws_b, l, gw, ngw, lane); break;
    case 5: {
        float* ex = (float*)smem + (wave & 3) * (34 * 64);
        int u = bid;
        for (; u < 256; u += nb) {
            const int wi = u * 4 + (wave & 3);
            attn_na_lat(p, ws_b, l, wi >> 9, (wi >> 6) & 7, (wi >> 1) & 31, wi & 1, lane, ex, wave >> 2);
        }
        for (; u < 256 + 416; u += nb) job_ukv(p, ws_b, l, 2 * (u - 256) + grp, sm, ltid);
        for (; u < 256 + 416 + 288; u += nb) job_uq(p, ws_b, l, 2 * (u - 256 - 416) + grp, sm, ltid);
        for (; u < 256 + 416 + 288 + 384; u += nb) job_f1(p, ws_b, 2 * (u - 256 - 416 - 288) + grp, sm, ltid);
        for (; u < 256 + 416 + 288 + 384 + 256; u += nb) {
            const int wi = (u - 256 - 416 - 288 - 384) * 8 + wave;
            attn_na_ctx(p, ws_b, wi >> 6, (wi >> 3) & 7, wi & 7, lane);
        }
    } break;
    case 6: {
        float* ex = (float*)smem + (wave & 3) * (34 * 64);
        int u = bid;
        for (; u < 256; u += nb) {
            const int wi = u * 4 + (wave & 3);
            attn_mla(p, ws_b, l, true, wi >> 9, (wi >> 6) & 7, wi & 63, lane, ex, wave >> 2);
        }
        for (; u < 256 + 128; u += nb) job_f2_lat(p, ws_b, u - 256, sm, ltid, grp, (float*)(smem + SMEM_BYTES));
        for (; u < 256 + 128 + 128; u += nb) job_f2_ctx(p, ws_b, 2 * (u - 256 - 128) + grp, sm, ltid);
        for (; u < 256 + 128 + 128 + 256; u += nb) {
            const int wi = (u - 256 - 128 - 128) * 8 + wave;
            attn_mla(p, ws_b, l, false, wi >> 6, (wi >> 3) & 7, wi & 7, lane);
        }
    } break;
    case 7:

#pragma nounroll
        for (int sg = 0; sg < 3; ++sg) {
            int tid3 = tid; asm volatile("" : "+v"(tid3));
            pg8::Gemm g{(const bf16_t*)(ws_b + (sg == 0 ? WS_YF : (sg == 1 ? WS_YM : WS_YN))), Wl + (sg == 0 ? OFF_WBF : (sg == 1 ? OFF_WBM : OFF_WBN)), M, D, 512};
            pg8::StaticOrder S; S.init(M, D, nb, bid);
            pg8::EpiMerge E{(const bf16_t*)(ws_b + WS_GATE), (bf16_t*)(ws_b + WS_UF)  , (bf16_t*)(ws_b + WS_MERGED), sg};
            pg8::gemm_phase<pg8::EpiMerge, pg8::StaticOrder, false, true>((PG8_LAS unsigned char*)smem, g, S, E, tid3);
        }
        break;
    case 8:
        {
            pg8::Gemm g{(const bf16_t*)(ws_b + WS_MERGED), Wl + OFF_WOUT, M, D, D};
            pg8::StaticOrder S; S.init(M, D, nb, bid);
            pg8::EpiResid E{(float*)(ws_b + WS_X), MODl + 5 * D, 1.0f};
            pg8::gemm_phase<pg8::EpiResid, pg8::StaticOrder, false, true>((PG8_LAS unsigned char*)smem, g, S, E, tid);
        }
        break;
    case 9: phase_rows(p, ws_b, l, 1, l, 6, false, gw, ngw, lane); break;
    case 12:
        if (l == NL - 1) phase_rows(p, ws_b, l, 2, 0, 0, true, gw, ngw, lane);
        else phase_rows(p, ws_b, l, 2, l + 1, 0, false, gw, ngw, lane);
        break;
    default: break;
    }
}

__global__ void __launch_bounds__(NTHREADS, 2) mega_kernel(P p) {
    extern __shared__ __attribute__((aligned(16))) unsigned char smem[];
    __shared__ uint4 xb_words;
    cg::grid_group grid = cg::this_grid();
    const int tid = threadIdx.x;
    unsigned* bar = (unsigned*)(p.ws + WS_BAR);
    if (tid == 0) xb_words = make_uint4(0u, 0u, 0u, 0u);
    if (p.ph_lo == 0 && blockIdx.x == 0) for (int i = tid; i < XCD_BAR_WORDS; i += NTHREADS) bar[i] = 0u;
    __syncthreads();
    XcdBarrier xb; xb.bar = bar; xb.x = 0; xb.st = (volatile LAS unsigned*)&xb_words;
#pragma nounroll
    for (int ph = p.ph_lo; ph < p.ph_hi; ++ph) {
        int tid2 = tid; asm volatile("" : "+v"(tid2));
        unsigned char* ws_b = p.ws; asm volatile("" : "+s"(ws_b));
        run_phase(p, ws_b, ph, smem, tid2);
        if (ph + 1 < p.ph_hi) {
            if (ph == p.ph_lo) { grid.sync(); xb = xcd_barrier_post(bar, (volatile LAS unsigned*)&xb_words); }
            else xcd_barrier(xb);
        }
    }
}

extern "C" void kernel_launch(void* const* d_in, const int* in_sizes, int n_in, void* d_out, int out_size, void* d_ws, size_t ws_size,
                              hipStream_t stream) {
    static int grid_blocks = 0;
    if (grid_blocks == 0) {
        if (n_in != 30 || ws_size < WS_END) { fprintf(stderr, "kernel_launch: n_in %d ws %zu need %zu\n", n_in, ws_size, (size_t)WS_END); grid_blocks = -1; return; }
        int dev = 0, cus = 0, per_cu = 0;
        hipGetDevice(&dev);
        hipDeviceGetAttribute(&cus, hipDeviceAttributeMultiprocessorCount, dev);
        hipFuncSetAttribute((const void*)mega_kernel, hipFuncAttributeMaxDynamicSharedMemorySize, LDS_TOTAL);
        hipOccupancyMaxActiveBlocksPerMultiprocessor(&per_cu, (const void*)mega_kernel, NTHREADS, LDS_TOTAL);
        if (per_cu < 1) per_cu = 1;
        if (per_cu > 1) per_cu = 1;
        grid_blocks = cus * per_cu;
    }
    if (grid_blocks < 0) return;
    P p{};
    for (int i = 0; i < 30; ++i) p.in[i] = (const float*)d_in[i];
    p.out = (float*)d_out; p.ws = (unsigned char*)d_ws; p.ph_lo = 0; p.ph_hi = NPHASE;
#ifndef MULTI_LAUNCH
#define MULTI_LAUNCH 0
#endif
#if MULTI_LAUNCH
    for (int ph = 0; ph < NPHASE; ++ph) {
        p.ph_lo = ph; p.ph_hi = ph + 1;
        hipLaunchKernelGGL(mega_kernel, dim3(grid_blocks), dim3(NTHREADS), LDS_TOTAL, stream, p);
    }
#else
    void* args[] = {&p};
    hipError_t e = hipLaunchCooperativeKernel((const void*)mega_kernel, dim3(grid_blocks), dim3(NTHREADS), args, LDS_TOTAL, stream);
    if (e != hipSuccess) fprintf(stderr, "cooperative launch failed: %s (grid %d)\n", hipGetErrorString(e), grid_blocks);
#endif
}
```

```cpp
#include <hip/hip_runtime.h>
#include <hip/hip_cooperative_groups.h>
#include <cstdint>
#include <cstdio>
namespace cg = cooperative_groups;

typedef unsigned short bf16_t;
typedef short bf16x8 __attribute__((ext_vector_type(8)));
typedef float f32x16 __attribute__((ext_vector_type(16)));
typedef float f32x4 __attribute__((ext_vector_type(4)));
typedef unsigned u32x4 __attribute__((ext_vector_type(4)));
typedef unsigned u32x2 __attribute__((ext_vector_type(2)));
#define DEVI __device__ __forceinline__

constexpr int D = 1024, NCTX = 8192, NLAT = 4096, M = 12288, MX = 13312, DFF = 2816, NL = 4;
constexpr float ALPHA_F = 1.6817928305074290f;
constexpr float LOG2E = 1.4426950408889634f;
constexpr float MLA_QS = 0.10206207261596575f * LOG2E;
constexpr float NA_QS = 0.125f * LOG2E;
constexpr size_t OUT_CKV = 12582912, OUT_KR = 20971520, OUT_NAK = 22020096, OUT_NAV = 38797312;

constexpr size_t al256(size_t x) { return (x + 255) & ~(size_t)255; }
constexpr size_t WS_BAR = 0;
constexpr size_t WS_X = 16384;
constexpr size_t WS_H = WS_X + (size_t)M * D * 4;
constexpr size_t WS_MOD = WS_H + (size_t)M * D * 2;
constexpr size_t WS_MODP = WS_MOD + al256((size_t)NL * 3 * 9216 * 4);
constexpr size_t WS_ROPE = WS_MODP + al256((size_t)NL * 16 * 3 * 9216 * 4);
constexpr size_t WS_TABC = WS_ROPE + 4096;
constexpr size_t WS_TABL = WS_TABC + (size_t)256 * 512 * 2;
constexpr size_t WS_WCS = WS_TABL + (size_t)2048 * 4096 * 2;
constexpr size_t WS_CCKV = WS_WCS + (size_t)256 * 128 * 2;
constexpr size_t WS_CKR = WS_CCKV + (size_t)NL * 1024 * 256 * 2;
constexpr size_t WS_CNAK = WS_CKR + (size_t)NL * 1024 * 32 * 2;
constexpr size_t WS_CNAVT = WS_CNAK + (size_t)NL * 1024 * 512 * 2;
constexpr size_t WS_W = WS_CNAVT + (size_t)NL * 1024 * 512 * 2;
constexpr size_t OFF_W13_1 = 0, OFF_W2_1 = 5767168, OFF_W13_2 = 8650752, OFF_W2_2 = 14417920, OFF_WIN = 17301504,
                 OFF_WOUT = 23330816, OFF_WBF = 24379392, OFF_WBM = 24903680, OFF_WBN = 25427968, OFF_WUQ = 25952256,
                 OFF_WUKV = 26247168, LAYER_W = 26509312;
constexpr size_t WS_R1 = WS_W + (size_t)NL * LAYER_W * 2;
constexpr size_t WS_ACT = WS_R1;
constexpr size_t WS_UF = WS_R1;
constexpr size_t WS_UQ = WS_UF + (size_t)M * 512 * 2;
constexpr size_t WS_UKV = WS_UQ + (size_t)M * 384 * 2;
constexpr size_t WS_KRF = WS_UKV + (size_t)M * 256 * 4;
constexpr size_t WS_CKV = WS_KRF + (size_t)M * 32 * 4;
constexpr size_t WS_KR = WS_CKV + (size_t)M * 256 * 2;
constexpr size_t WS_NAQ = WS_KR + (size_t)M * 32 * 2;
constexpr size_t WS_NAK = WS_NAQ + (size_t)M * 512 * 2;
constexpr size_t WS_NAVT = WS_NAK + (size_t)M * 512 * 2;
constexpr size_t WS_GATE = WS_NAVT + (size_t)M * 512 * 2;
constexpr size_t WS_Q = WS_GATE + (size_t)M * 3072 * 2;
constexpr size_t WS_KN = WS_Q + (size_t)M * 768 * 2;
constexpr size_t WS_VTM = WS_KN + (size_t)MX * 512 * 2;
constexpr size_t WS_F1T = WS_VTM + (size_t)MX * 512 * 2;
constexpr size_t WS_YF = WS_F1T + (size_t)M * 1024 * 2;
constexpr size_t WS_YM = WS_YF + (size_t)M * 512 * 2;
constexpr size_t WS_YN = WS_YM + (size_t)M * 512 * 2;
constexpr size_t WS_MERGED = WS_YN + (size_t)M * 512 * 2;
constexpr size_t WS_END = WS_MERGED + (size_t)M * 1024 * 2;
static_assert(WS_END - WS_R1 >= (size_t)M * DFF * 2, "ACT must fit in R1");
static_assert(WS_NAK - WS_UF >= (size_t)M * D * 4, "merge T32 must fit in the dead UF..NAQ buffers");

constexpr int NPHASE = 3 + 13 * NL;

struct P {
    const float* in[30];
    float* out;
    unsigned char* ws;
    int ph_lo, ph_hi;
};

__device__ __forceinline__ const float* pin(const P& p, int i) { int j = i; asm volatile("" : "+s"(j)); return p.in[j]; }
typedef __bf16 bf16v2 __attribute__((ext_vector_type(2)));
typedef float f32x2 __attribute__((ext_vector_type(2)));
DEVI unsigned pk2(float lo, float hi) { f32x2 v = {lo, hi}; bf16v2 b = __builtin_convertvector(v, bf16v2); return __builtin_bit_cast(unsigned, b); }
DEVI bf16_t f2bf(float x) { return (bf16_t)(pk2(x, 0.f) & 0xffffu); }
DEVI float bf2f(unsigned v) { return __uint_as_float(v << 16); }
DEVI float wave_sum(float v) {
#pragma unroll
    for (int o = 1; o < 64; o <<= 1) v += __shfl_xor(v, o);
    return v;
}
DEVI float fast_exp2(float x) { return __builtin_amdgcn_exp2f(x); }
DEVI float sigmoidf_(float x) { return 1.f / (1.f + __expf(-x)); }

constexpr int LDT = 72;
constexpr int TILE_E = 128 * LDT;
constexpr int SMEM_BYTES = 4 * TILE_E * 2;
constexpr int NTHREADS = 512, NWAVES = 8, LDS_TOTAL = 2 * SMEM_BYTES;

DEVI void gemm_ldg(const bf16_t* ga, const bf16_t* gb, int lda, int ldb, u32x4 (&ra)[4], u32x4 (&rb)[4]) {
#pragma unroll
    for (int i = 0; i < 4; ++i) {
        ra[i] = *(const u32x4*)(ga + (size_t)(32 * i) * lda);
        rb[i] = *(const u32x4*)(gb + (size_t)(32 * i) * ldb);
    }
}
DEVI void gemm_sts(bf16_t* buf, int soff, const u32x4 (&ra)[4], const u32x4 (&rb)[4]) {
#pragma unroll
    for (int i = 0; i < 4; ++i) {
        *(u32x4*)(buf + soff + 32 * i * LDT) = ra[i];
        *(u32x4*)(buf + TILE_E + soff + 32 * i * LDT) = rb[i];
    }
}
DEVI void gemm_mma(const bf16_t* cur, int aoff, int boff, f32x16 (&acc)[2][2]) {
#pragma unroll
    for (int ks = 0; ks < 4; ++ks) {
        bf16x8 a0 = *(const bf16x8*)(cur + aoff + ks * 16);
        bf16x8 a1 = *(const bf16x8*)(cur + aoff + 32 * LDT + ks * 16);
        bf16x8 b0 = *(const bf16x8*)(cur + boff + ks * 16);
        bf16x8 b1 = *(const bf16x8*)(cur + boff + 32 * LDT + ks * 16);
        acc[0][0] = __builtin_amdgcn_mfma_f32_32x32x16_bf16(a0, b0, acc[0][0], 0, 0, 0);
        acc[0][1] = __builtin_amdgcn_mfma_f32_32x32x16_bf16(a0, b1, acc[0][1], 0, 0, 0);
        acc[1][0] = __builtin_amdgcn_mfma_f32_32x32x16_bf16(a1, b0, acc[1][0], 0, 0, 0);
        acc[1][1] = __builtin_amdgcn_mfma_f32_32x32x16_bf16(a1, b1, acc[1][1], 0, 0, 0);
    }
}

template <bool DEEP = true>
DEVI void gemm_core(const bf16_t* __restrict__ A, int lda, const bf16_t* __restrict__ B, int ldb, int K,
                    f32x16 (&acc)[2][2], bf16_t* smem, int tid) {
    const int lane = tid & 63, wave = tid >> 6, wr = wave >> 1, wc = wave & 1;
    const int lr = tid >> 3, lc = (tid & 7) * 8;
    const bf16_t* ga = A + (size_t)lr * lda + lc;
    const bf16_t* gb = B + (size_t)lr * ldb + lc;
    const int soff = lr * LDT + lc;
    const int nk = K >> 6;
    const int aoff = (wr * 64 + (lane & 31)) * LDT + (lane >> 5) * 8;
    const int boff = TILE_E + (wc * 64 + (lane & 31)) * LDT + (lane >> 5) * 8;
    bf16_t* buf0 = smem; bf16_t* buf1 = smem + 2 * TILE_E;
    if constexpr (DEEP) {
        u32x4 ra0[4], rb0[4], ra1[4], rb1[4];
        gemm_ldg(ga, gb, lda, ldb, ra0, rb0);
        gemm_ldg(ga + 64, gb + 64, lda, ldb, ra1, rb1);
        gemm_sts(buf0, soff, ra0, rb0);
        __syncthreads();
        for (int kt = 0; kt < nk; kt += 2) {
            if (kt + 2 < nk) gemm_ldg(ga + (size_t)(kt + 2) * 64, gb + (size_t)(kt + 2) * 64, lda, ldb, ra0, rb0);
            gemm_mma(buf0, aoff, boff, acc);
            gemm_sts(buf1, soff, ra1, rb1);
            __syncthreads();
            if (kt + 3 < nk) gemm_ldg(ga + (size_t)(kt + 3) * 64, gb + (size_t)(kt + 3) * 64, lda, ldb, ra1, rb1);
            gemm_mma(buf1, aoff, boff, acc);
            if (kt + 2 < nk) gemm_sts(buf0, soff, ra0, rb0);
            __syncthreads();
        }
    } else {
        u32x4 ra[4], rb[4];
        gemm_ldg(ga, gb, lda, ldb, ra, rb);
        gemm_sts(buf0, soff, ra, rb);
        __syncthreads();
        for (int kt = 0; kt < nk; ++kt) {
            bf16_t* cur = (kt & 1) ? buf1 : buf0;
            bf16_t* nxt = (kt & 1) ? buf0 : buf1;
            const bool more = (kt + 1 < nk);
            if (more) { ga += 64; gb += 64; gemm_ldg(ga, gb, lda, ldb, ra, rb); }
            gemm_mma(cur, aoff, boff, acc);
            if (more) gemm_sts(nxt, soff, ra, rb);
            __syncthreads();
        }
    }
}

DEVI void zero_acc(f32x16 (&acc)[2][2]) {
#pragma unroll
    for (int i = 0; i < 2; ++i)
#pragma unroll
        for (int j = 0; j < 2; ++j)
#pragma unroll
            for (int r = 0; r < 16; ++r) acc[i][j][r] = 0.f;
}

#define EPI_SETUP const int lane = tid & 63, wave = tid >> 6, wr = wave >> 1, wc = wave & 1, hl = lane >> 5, c32 = lane & 31; (void)wr; (void)wc; (void)hl; (void)c32;

DEVI int mod_group(int row) { return row < NCTX ? 0 : 1 + ((row - NCTX) >> 11); }

namespace pg8 {
#define PG8_LAS __attribute__((address_space(3)))
constexpr int BM = 256, BK = 64, HALF = 128, HTB = HALF * BK * 2, NXCD = 8, WGM = 8;
DEVI int lds_byte(int r, int c) { const int st = (r >> 4) * 2 + (c >> 5), rr = r & 15, cc = c & 31, ob = rr * 64 + cc * 2; return st * 1024 + (ob ^ (((ob >> 9) & 1) << 5)); }
DEVI void stage_rc(int b, int& R, int& C) { const int st = b / 1024, sb = b % 1024, swz = sb ^ (((sb >> 9) & 1) << 5); R = (st >> 1) * 16 + swz / 64; C = (st & 1) * 32 + (swz % 64) / 2; }
DEVI int perm32(int rho) { const int n = rho >> 4, i = rho & 15; return 8 * (i >> 2) + 4 * n + (i & 3); }
struct Unit { int pm, pn; };
struct Gemm { const bf16_t* A; const bf16_t* Bt; int M, N, K; };
struct StaticOrder {
    int nM, nN, nwg, G, c;
    DEVI void init(int M, int N, int G_, int c_) { nM = M / BM; nN = N / BM; nwg = nM * nN; G = G_; c = c_; }
    DEVI bool next(int i, Unit& u) const {
        const long L = (long)i * G + c; if (L >= nwg) return false;
        int wgid = (int)L; { const int q = nwg / NXCD, r = nwg % NXCD, xcd = wgid % NXCD, off = wgid / NXCD; wgid = (xcd < r ? xcd * (q + 1) : r * (q + 1) + (xcd - r) * q) + off; }
        const int nig = WGM * nN, gid = wgid / nig, fm = gid * WGM, gsz = (nM - fm) < WGM ? (nM - fm) : WGM;
        u.pm = fm + ((wgid % nig) % gsz); u.pn = (wgid % nig) / gsz; return true;
    }
    DEVI void a_ready(const Unit&) const {}
    DEVI void done(const Unit&) const {}
};
template <class Epi, class Sched, bool ALIGN_EPI = false, bool SP2 = false>
DEVI void gemm_phase(PG8_LAS unsigned char* lds, const Gemm g, const Sched& S, const Epi& E, const int tid) {
    const int wid = __builtin_amdgcn_readfirstlane(tid >> 6), lane = tid & 63, wr = wid >> 2, wc = wid & 3, fr = lane & 15, fq = lane >> 4;
    const int K = g.K, nt = K / BK;
    unsigned voffA[2], voffB[2];
#pragma unroll
    for (int i = 0; i < 2; ++i) { int R, C; stage_rc(tid * 16 + i * 8192, R, C); const int Rb = Epi::PERM ? ((R & ~31) + perm32(R & 31)) : R;
        voffA[i] = (unsigned)(R * K + C) * 2u; voffB[i] = (unsigned)(Rb * K + C) * 2u; }
    const size_t kstep = (size_t)(BK * 2);
    const size_t hstep = (size_t)HALF * K * 2;
    const size_t tstep = 2 * hstep;
    const unsigned ldsw = (unsigned)wid * 1024u;
    const int aoff = lds_byte(wr * 64 + fr, fq * 8), boff = lds_byte(wc * 32 + fr, fq * 8);
#define PG8_SA(b, h) (((b) * 2 + (h)) * HTB)
#define PG8_SB(b, h) ((4 + (b) * 2 + (h)) * HTB)
#define PG8_STAGE(bufoff, gbase, voff) do { _Pragma("unroll") for (int _i = 0; _i < 2; ++_i) \
        __builtin_amdgcn_global_load_lds((const unsigned*)((const char*)(gbase) + (voff)[_i]), (PG8_LAS unsigned*)(lds + (bufoff) + ldsw + _i * 8192), 16, 0, 0); } while (0)
#define PG8_LDA(dst, b, h) do { _Pragma("unroll") for (int m = 0; m < 4; ++m) _Pragma("unroll") for (int k = 0; k < 2; ++k) dst[m][k] = *(const PG8_LAS bf16x8*)(lds + PG8_SA(b, h) + aoff + m * 2048 + k * 1024); } while (0)
#define PG8_LDB(dst, b, h) do { _Pragma("unroll") for (int n = 0; n < 2; ++n) _Pragma("unroll") for (int k = 0; k < 2; ++k) dst[n][k] = *(const PG8_LAS bf16x8*)(lds + PG8_SB(b, h) + boff + n * 2048 + k * 1024); } while (0)
#define PG8_MMA(ai, bj, At, Bt) do { __builtin_amdgcn_s_setprio(1); _Pragma("unroll") for (int m = 0; m < 4; ++m) _Pragma("unroll") for (int n = 0; n < 2; ++n) _Pragma("unroll") for (int k = 0; k < 2; ++k) \
        acc[ai][bj][m][n] = __builtin_amdgcn_mfma_f32_16x16x32_bf16(Bt[n][k], At[m][k], acc[ai][bj][m][n], 0, 0, 0); __builtin_amdgcn_s_setprio(0); } while (0)
#define PG8_WAIT_V(n) asm volatile("s_waitcnt vmcnt(" #n ")" ::: "memory")
#define PG8_WAIT_L(n) asm volatile("s_waitcnt lgkmcnt(" #n ")" ::: "memory")
#define PG8_BAR __builtin_amdgcn_s_barrier()
#define PG8_SCHED __builtin_amdgcn_sched_barrier(0)
    Unit cur, nxt; int ui = 0;
    if (!S.next(0, cur)) return;
    f32x4 acc[2][2][4][2];
#pragma unroll
    for (int a = 0; a < 2; ++a)
#pragma unroll
        for (int b = 0; b < 2; ++b)
#pragma unroll
            for (int m = 0; m < 4; ++m)
#pragma unroll
                for (int n = 0; n < 2; ++n) acc[a][b][m][n] = (f32x4){0.f, 0.f, 0.f, 0.f};
    bf16x8 At[4][2], B0[2][2], B1[2][2];
    const char* cA = (const char*)g.A + (size_t)cur.pm * tstep; const char* cB = (const char*)g.Bt + (size_t)cur.pn * tstep;
    S.a_ready(cur);
    if constexpr (SP2) {
        PG8_STAGE(PG8_SB(0, 0), cB, voffB); PG8_STAGE(PG8_SB(0, 1), cB + hstep, voffB); PG8_STAGE(PG8_SA(0, 0), cA, voffA); PG8_STAGE(PG8_SA(0, 1), cA + hstep, voffA);
        if (wr == 1) PG8_BAR;
        PG8_WAIT_V(2); PG8_BAR;
        PG8_STAGE(PG8_SB(1, 0), cB + kstep, voffB); PG8_STAGE(PG8_SA(1, 0), cA + kstep, voffA); PG8_STAGE(PG8_SB(1, 1), cB + hstep + kstep, voffB);
        PG8_WAIT_V(6); PG8_BAR;
    } else {
        PG8_STAGE(PG8_SB(0, 0), cB, voffB); PG8_STAGE(PG8_SA(0, 0), cA, voffA); PG8_STAGE(PG8_SB(0, 1), cB + hstep, voffB); PG8_STAGE(PG8_SA(0, 1), cA + hstep, voffA);
        if (wr == 1) PG8_BAR;
        PG8_WAIT_V(4); PG8_BAR;
        PG8_STAGE(PG8_SB(1, 0), cB + kstep, voffB); PG8_STAGE(PG8_SA(1, 0), cA + kstep, voffA); PG8_STAGE(PG8_SB(1, 1), cB + hstep + kstep, voffB);
        PG8_WAIT_V(6); PG8_BAR;
    }
    for (;;) {
        const bool has_next = S.next(ui + 1, nxt);
        const char* nA = has_next ? (const char*)g.A + (size_t)nxt.pm * tstep : cA; const char* nB = has_next ? (const char*)g.Bt + (size_t)nxt.pn * tstep : cB;
        for (int t = 0; t < nt; t += 2) {
            const bool last = (t == nt - 2);
            const char* a1 = cA + (size_t)(t + 1) * kstep;
            const char* a2 = last ? nA : cA + (size_t)(t + 2) * kstep; const char* b2 = last ? nB : cB + (size_t)(t + 2) * kstep;
            const char* a3 = a2 + kstep; const char* b3 = b2 + kstep;
            if (last && has_next) S.a_ready(nxt);
            if constexpr (SP2) {
            PG8_LDB(B0, 0, 0); PG8_LDB(B1, 0, 1); PG8_SCHED; PG8_LDA(At, 0, 0); PG8_STAGE(PG8_SA(1, 1), a1 + hstep, voffA);
            PG8_WAIT_V(8); PG8_WAIT_L(0); PG8_BAR; PG8_MMA(0, 0, At, B0); PG8_MMA(0, 1, At, B1); PG8_BAR; PG8_SCHED;
            PG8_LDA(At, 0, 1); PG8_STAGE(PG8_SB(0, 0), b2, voffB); PG8_STAGE(PG8_SB(0, 1), b2 + hstep, voffB); PG8_STAGE(PG8_SA(0, 0), a2, voffA);
            PG8_WAIT_V(8); PG8_WAIT_L(0); PG8_BAR; PG8_MMA(1, 0, At, B0); PG8_MMA(1, 1, At, B1); PG8_BAR; PG8_SCHED;
            PG8_LDB(B0, 1, 0); PG8_LDB(B1, 1, 1); PG8_SCHED; PG8_LDA(At, 1, 0); PG8_STAGE(PG8_SA(0, 1), a2 + hstep, voffA);
            PG8_WAIT_V(8); PG8_WAIT_L(0); PG8_BAR; PG8_MMA(0, 0, At, B0); PG8_MMA(0, 1, At, B1); PG8_BAR; PG8_SCHED;
            PG8_LDA(At, 1, 1); PG8_STAGE(PG8_SB(1, 0), b3, voffB); PG8_STAGE(PG8_SB(1, 1), b3 + hstep, voffB); PG8_STAGE(PG8_SA(1, 0), a3, voffA);
            PG8_WAIT_V(8); PG8_WAIT_L(0); PG8_BAR; PG8_MMA(1, 0, At, B0); PG8_MMA(1, 1, At, B1); PG8_BAR; PG8_SCHED;
            } else {
            PG8_LDB(B0, 0, 0); PG8_SCHED; PG8_LDA(At, 0, 0); PG8_STAGE(PG8_SA(1, 1), a1 + hstep, voffA);
            PG8_WAIT_L(8); PG8_BAR; PG8_WAIT_L(0); PG8_MMA(0, 0, At, B0); PG8_BAR; PG8_SCHED;
            PG8_LDB(B1, 0, 1); PG8_STAGE(PG8_SB(0, 0), b2, voffB);
            PG8_BAR; PG8_WAIT_L(0); PG8_MMA(0, 1, At, B1); PG8_BAR;
            PG8_LDA(At, 0, 1); PG8_STAGE(PG8_SA(0, 0), a2, voffA);
            PG8_BAR; PG8_WAIT_L(0); PG8_MMA(1, 0, At, B0); PG8_BAR; PG8_SCHED;
            PG8_STAGE(PG8_SB(0, 1), b2 + hstep, voffB);
            PG8_WAIT_V(6); PG8_BAR; PG8_MMA(1, 1, At, B1); PG8_BAR;
            PG8_LDB(B0, 1, 0); PG8_SCHED; PG8_LDA(At, 1, 0); PG8_STAGE(PG8_SA(0, 1), a2 + hstep, voffA);
            PG8_WAIT_L(8); PG8_BAR; PG8_WAIT_L(0); PG8_MMA(0, 0, At, B0); PG8_BAR; PG8_SCHED;
            PG8_LDB(B1, 1, 1); PG8_STAGE(PG8_SB(1, 0), b3, voffB);
            PG8_BAR; PG8_WAIT_L(0); PG8_MMA(0, 1, At, B1); PG8_BAR;
            PG8_LDA(At, 1, 1); PG8_STAGE(PG8_SA(1, 0), a3, voffA);
            PG8_BAR; PG8_WAIT_L(0); PG8_MMA(1, 0, At, B0); PG8_BAR; PG8_SCHED;
            PG8_STAGE(PG8_SB(1, 1), b3 + hstep, voffB);
            PG8_WAIT_V(6); PG8_BAR; PG8_MMA(1, 1, At, B1); PG8_BAR;
            }
        }
        if constexpr (ALIGN_EPI) { if (wr == 0) PG8_BAR; }
        E(acc, cur, wr, wc, fr, fq); S.done(cur);
        if (!has_next) break;
#pragma unroll
        for (int a = 0; a < 2; ++a)
#pragma unroll
            for (int b = 0; b < 2; ++b)
#pragma unroll
                for (int m = 0; m < 4; ++m)
#pragma unroll
                    for (int n = 0; n < 2; ++n) acc[a][b][m][n] = (f32x4){0.f, 0.f, 0.f, 0.f};
        cur = nxt; cA = nA; cB = nB; ++ui;
        if constexpr (ALIGN_EPI) { if (wr == 1) PG8_BAR; }
    }
    PG8_WAIT_V(0);
    if constexpr (!ALIGN_EPI) { if (wr == 0) PG8_BAR; }
    PG8_BAR;
#undef PG8_SA
#undef PG8_SB
#undef PG8_STAGE
#undef PG8_LDA
#undef PG8_LDB
#undef PG8_MMA
#undef PG8_WAIT_V
#undef PG8_WAIT_L
#undef PG8_BAR
#undef PG8_SCHED
}

struct EpiSwiGLU {
    static constexpr bool PERM = false;
    bf16_t* ACT;
    DEVI void operator()(const f32x4 (&acc)[2][2][4][2], const Unit& u, int wr, int wc, int fr, int fq) const {
#pragma unroll
        for (int ai = 0; ai < 2; ++ai)
#pragma unroll
            for (int m = 0; m < 4; ++m) {
                const int row = u.pm * BM + ai * HALF + wr * 64 + m * 16 + fr;
                bf16_t* rp = ACT + (size_t)row * DFF + 16 * (8 * u.pn + wc) + 4 * fq;
#pragma unroll
                for (int bj = 0; bj < 2; ++bj) {
                    const f32x4 a = acc[ai][bj][m][0], b = acc[ai][bj][m][1];
                    u32x2 pk;
                    pk.x = pk2(a[0] * sigmoidf_(a[0]) * b[0], a[1] * sigmoidf_(a[1]) * b[1]);
                    pk.y = pk2(a[2] * sigmoidf_(a[2]) * b[2], a[3] * sigmoidf_(a[3]) * b[3]);
                    *(u32x2*)(rp + 64 * bj) = pk;
                }
            }
    }
};
struct EpiResid {
    static constexpr bool PERM = false;
    float* X; const float* gate_base; float coef;
    DEVI void operator()(const f32x4 (&acc)[2][2][4][2], const Unit& u, int wr, int wc, int fr_, int fq_) const {
        int fr = fr_, fq = fq_; asm volatile("" : "+v"(fr), "+v"(fq));
        const float* gate = gate_base + (size_t)mod_group(u.pm * BM) * 9216;
        const int col0 = u.pn * BM + wc * 32 + 4 * fq;
        f32x4 gv[2][2];
#pragma unroll
        for (int bj = 0; bj < 2; ++bj)
#pragma unroll
            for (int n = 0; n < 2; ++n) gv[bj][n] = *(const f32x4*)(gate + col0 + bj * HALF + 16 * n) * coef;
#pragma unroll
        for (int ah = 0; ah < 4; ++ah) {
            const int ai = ah >> 1, mb = (ah & 1) * 2;
            f32x4 xv[4][2][2];
#pragma unroll
            for (int m = mb; m < mb + 2; ++m)
#pragma unroll
                for (int bj = 0; bj < 2; ++bj)
#pragma unroll
                    for (int n = 0; n < 2; ++n)
                        xv[m][bj][n] = *(const f32x4*)(X + (size_t)(u.pm * BM + ai * HALF + wr * 64 + m * 16 + fr) * D + col0 + bj * HALF + 16 * n);
            __builtin_amdgcn_sched_barrier(0);
#pragma unroll
            for (int m = mb; m < mb + 2; ++m)
#pragma unroll
                for (int bj = 0; bj < 2; ++bj)
#pragma unroll
                    for (int n = 0; n < 2; ++n)
                        *(f32x4*)(X + (size_t)(u.pm * BM + ai * HALF + wr * 64 + m * 16 + fr) * D + col0 + bj * HALF + 16 * n) =
                            xv[m][bj][n] * ALPHA_F + gv[bj][n] * acc[ai][bj][m][n];
            __builtin_amdgcn_sched_barrier(0);
        }
    }
};
struct EpiIn {
    static constexpr bool PERM = true;
    unsigned char* ws; float* out; const float* b_gate; int l;
    static DEVI u32x4 pack8(const f32x4& a, const f32x4& b, float s) {
        u32x4 w; w.x = pk2(a[0] * s, a[1] * s); w.y = pk2(a[2] * s, a[3] * s); w.z = pk2(b[0] * s, b[1] * s); w.w = pk2(b[2] * s, b[3] * s); return w;
    }
    DEVI void operator()(const f32x4 (&acc)[2][2][4][2], const Unit& u, int wr, int wc, int fr_, int fq_) const {
        int fr = fr_, fq = fq_; asm volatile("" : "+v"(fr), "+v"(fq));
        unsigned char* ws = this->ws; float* out = this->out; const float* b_gate = this->b_gate;
        asm volatile("" : "+s"(ws), "+s"(out), "+s"(b_gate));
        const bool ctx = u.pm * BM < NCTX;
#pragma unroll
        for (int bj = 0; bj < 2; ++bj) {
            const int n0 = u.pn * BM + bj * HALF;
            const int c8 = n0 + wc * 32 + 8 * fq;
            f32x4 bg0 = (f32x4){0.f, 0.f, 0.f, 0.f}, bg1 = bg0;
            if (n0 >= 2816) { bg0 = *(const f32x4*)(b_gate + l * 3072 + c8 - 2816); bg1 = *(const f32x4*)(b_gate + l * 3072 + c8 - 2816 + 4); }
#pragma unroll
            for (int ai = 0; ai < 2; ++ai)
#pragma unroll
                for (int m = 0; m < 4; ++m) {
                    const int row = u.pm * BM + ai * HALF + wr * 64 + m * 16 + fr;
                    const f32x4 v0 = acc[ai][bj][m][0], v1 = acc[ai][bj][m][1];
                    if (n0 < 512) {
                        *(u32x4*)((bf16_t*)(ws + WS_UF) + (size_t)row * 512 + c8) = pack8(v0, v1, 1.f);
                    } else if (n0 < 896) {
                        *(u32x4*)((bf16_t*)(ws + WS_UQ) + (size_t)row * 384 + (c8 - 512)) = pack8(v0, v1, 1.f);
                    } else if (n0 < 1152) {
                        float* o = (float*)(ws + WS_UKV) + (size_t)row * 256 + (c8 - 896);
                        *(f32x4*)o = v0; *(f32x4*)(o + 4) = v1;
                    } else if (n0 < 1280) {
                        if (wc == 0) { float* o = (float*)(ws + WS_KRF) + (size_t)row * 32 + 8 * fq; *(f32x4*)o = v0; *(f32x4*)(o + 4) = v1; }
                    } else if (n0 < 1792) {
                        *(u32x4*)((bf16_t*)(ws + WS_NAQ) + (size_t)row * 512 + (c8 - 1280)) = pack8(v0, v1, NA_QS);
                    } else if (n0 < 2304) {
                        const int cc = c8 - 1792;
                        *(u32x4*)((bf16_t*)(ws + WS_NAK) + (size_t)row * 512 + cc) = pack8(v0, v1, 1.f);
                        if (ctx) { float* o = out + OUT_NAK + ((size_t)((row >> 8) * 4 + l) * 256 + (row & 255)) * 512 + cc; *(f32x4*)o = v0; *(f32x4*)(o + 4) = v1; }
                    } else if (n0 < 2816) {
                        const int cc = c8 - 2304, h = cc >> 6, d0 = cc & 63;
                        bf16_t* VT = (bf16_t*)(ws + WS_NAVT);
                        bf16_t* vp;
                        size_t cstride;
                        if (ctx) {
                            const int b = row >> 8, s = row & 255;
                            float* o = out + OUT_NAV + ((size_t)(b * 4 + l) * 256 + s) * 512 + cc; *(f32x4*)o = v0; *(f32x4*)(o + 4) = v1;
                            vp = VT + ((size_t)((b * 8 + h) * 64 + d0)) * 256 + s; cstride = 256;
                        } else {
                            const int rr = row - NCTX, b = rr >> 11, n = rr & 2047;
                            vp = VT + (size_t)4194304 + ((size_t)((b * 8 + h) * 64 + d0)) * 2048 + n; cstride = 2048;
                        }
#pragma unroll
                        for (int e = 0; e < 4; ++e) { vp[(size_t)e * cstride] = f2bf(v0[e]); vp[(size_t)(4 + e) * cstride] = f2bf(v1[e]); }
                    } else {
                        f32x4 g0, g1;
#pragma unroll
                        for (int e = 0; e < 4; ++e) { g0[e] = sigmoidf_(v0[e] + bg0[e]); g1[e] = sigmoidf_(v1[e] + bg1[e]); }
                        *(u32x4*)((bf16_t*)(ws + WS_GATE) + (size_t)row * 3072 + (c8 - 2816)) = pack8(g0, g1, 1.f);
                    }
                    __builtin_amdgcn_sched_barrier(0);
                }
        }
    }
};
struct EpiMerge {
    static constexpr bool PERM = true;
    const bf16_t* GATE; bf16_t* T; bf16_t* MG; int s;
    DEVI void operator()(const f32x4 (&acc)[2][2][4][2], const Unit& u, int wr, int wc, int fr_, int fq_) const {
        int fr = fr_, fq = fq_; asm volatile("" : "+v"(fr), "+v"(fq));
#pragma unroll
        for (int ah = 0; ah < 4; ++ah) {
            const int ai = ah >> 1, mb = (ah & 1) * 2;
            u32x4 gv[4][2], tv[4][2];
#pragma unroll
            for (int m = mb; m < mb + 2; ++m)
#pragma unroll
                for (int bj = 0; bj < 2; ++bj) {
                    const int row = u.pm * BM + ai * HALF + wr * 64 + m * 16 + fr;
                    const int c8 = u.pn * BM + bj * HALF + wc * 32 + 8 * fq;
                    gv[m][bj] = *(const u32x4*)(GATE + (size_t)row * 3072 + s * 1024 + c8);
                    if (s > 0) tv[m][bj] = *(const u32x4*)(T + (size_t)row * D + c8);
                }
            __builtin_amdgcn_sched_barrier(0);
#pragma unroll
            for (int m = mb; m < mb + 2; ++m)
#pragma unroll
                for (int bj = 0; bj < 2; ++bj) {
                    const int row = u.pm * BM + ai * HALF + wr * 64 + m * 16 + fr;
                    const int c8 = u.pn * BM + bj * HALF + wc * 32 + 8 * fq;
                    const u32x4 g = gv[m][bj];
                    f32x4 v0 = acc[ai][bj][m][0], v1 = acc[ai][bj][m][1];
                    v0[0] *= bf2f(g.x & 0xffffu); v0[1] *= bf2f(g.x >> 16); v0[2] *= bf2f(g.y & 0xffffu); v0[3] *= bf2f(g.y >> 16);
                    v1[0] *= bf2f(g.z & 0xffffu); v1[1] *= bf2f(g.z >> 16); v1[2] *= bf2f(g.w & 0xffffu); v1[3] *= bf2f(g.w >> 16);
                    if (s > 0) {
                        const u32x4 t = tv[m][bj];
                        v0[0] += bf2f(t.x & 0xffffu); v0[1] += bf2f(t.x >> 16); v0[2] += bf2f(t.y & 0xffffu); v0[3] += bf2f(t.y >> 16);
                        v1[0] += bf2f(t.z & 0xffffu); v1[1] += bf2f(t.z >> 16); v1[2] += bf2f(t.w & 0xffffu); v1[3] += bf2f(t.w >> 16);
                    }
                    *(u32x4*)((s < 2 ? T : MG) + (size_t)row * D + c8) = EpiIn::pack8(v0, v1, 1.f);
                }
            __builtin_amdgcn_sched_barrier(0);
        }
    }
};
}

DEVI void job_ffn_up(const P& p, unsigned char* ws_b, int l, int which, int t, bf16_t* sm, int tid) {
    const int nN = 44; const int m0 = (t / nN) * 128, n0 = (t % nN) * 128;
    const bf16_t* H = (const bf16_t*)(ws_b + WS_H);
    const bf16_t* W = (const bf16_t*)(ws_b + WS_W) + (size_t)l * LAYER_W + (which ? OFF_W13_2 : OFF_W13_1);
    bf16_t* ACT = (bf16_t*)(ws_b + WS_ACT);
    f32x16 acc[2][2]; zero_acc(acc);
    gemm_core(H + (size_t)m0 * D, D, W + (size_t)n0 * D, D, D, acc, sm, tid);
    EPI_SETUP
    const int oc = (n0 >> 1) + wc * 32 + c32;
#pragma unroll
    for (int i = 0; i < 2; ++i) {
        const int rb = m0 + wr * 64 + i * 32 + 4 * hl;
#pragma unroll
        for (int r = 0; r < 16; ++r) {
            const int row = rb + (r & 3) + 8 * (r >> 2);
            const float a = acc[i][0][r], b = acc[i][1][r];
            const float v = a * sigmoidf_(a) * b;
            ACT[(size_t)row * DFF + oc] = f2bf(v);
        }
    }
}

DEVI void job_resid(const P& p, unsigned char* ws_b, const bf16_t* A, int lda, const bf16_t* Bt, int K, const float* gate_base, float coef, int t, bf16_t* sm, int tid) {
    const int nN = 8; const int m0 = (t / nN) * 128, n0 = (t % nN) * 128;
    float* X = (float*)(ws_b + WS_X);
    f32x16 acc[2][2]; zero_acc(acc);
    gemm_core(A + (size_t)m0 * lda, lda, Bt + (size_t)n0 * K, K, K, acc, sm, tid);
    EPI_SETUP
    const float* gate = gate_base + (size_t)mod_group(m0) * 9216;
#pragma unroll
    for (int j = 0; j < 2; ++j) {
        const int col = n0 + wc * 64 + j * 32 + c32;
        const float gv = coef * gate[col];
#pragma unroll
        for (int i = 0; i < 2; ++i) {
            const int rb = m0 + wr * 64 + i * 32 + 4 * hl;
#pragma unroll
            for (int r = 0; r < 16; ++r) {
                const int row = rb + (r & 3) + 8 * (r >> 2);
                float* xp = X + (size_t)row * D + col;
                *xp = ALPHA_F * (*xp) + gv * acc[i][j][r];
            }
        }
    }
}

DEVI void job_in(const P& p, unsigned char* ws_b, int l, int t, bf16_t* sm, int tid) {
    const int nN = 46; const int m0 = (t / nN) * 128, n0 = (t % nN) * 128;
    const bf16_t* H = (const bf16_t*)(ws_b + WS_H);
    const bf16_t* W = (const bf16_t*)(ws_b + WS_W) + (size_t)l * LAYER_W + OFF_WIN;
    f32x16 acc[2][2]; zero_acc(acc);
    gemm_core(H + (size_t)m0 * D, D, W + (size_t)n0 * D, D, D, acc, sm, tid);
    EPI_SETUP
    const bool ctx = m0 < NCTX;
#pragma unroll
    for (int j = 0; j < 2; ++j) {
        const int col = n0 + wc * 64 + j * 32 + c32;
#pragma unroll
        for (int i = 0; i < 2; ++i) {
            const int rb = m0 + wr * 64 + i * 32 + 4 * hl;
            if (n0 < 512) {
                bf16_t* O = (bf16_t*)(ws_b + WS_UF);
#pragma unroll
                for (int r = 0; r < 16; ++r) O[(size_t)(rb + (r & 3) + 8 * (r >> 2)) * 512 + col] = f2bf(acc[i][j][r]);
            } else if (n0 < 896) {
                bf16_t* O = (bf16_t*)(ws_b + WS_UQ);
#pragma unroll
                for (int r = 0; r < 16; ++r) O[(size_t)(rb + (r & 3) + 8 * (r >> 2)) * 384 + (col - 512)] = f2bf(acc[i][j][r]);
            } else if (n0 < 1152) {
                float* O = (float*)(ws_b + WS_UKV);
#pragma unroll
                for (int r = 0; r < 16; ++r) O[(size_t)(rb + (r & 3) + 8 * (r >> 2)) * 256 + (col - 896)] = acc[i][j][r];
            } else if (n0 < 1280) {
                if (col < 1184) {
                    float* O = (float*)(ws_b + WS_KRF);
#pragma unroll
                    for (int r = 0; r < 16; ++r) O[(size_t)(rb + (r & 3) + 8 * (r >> 2)) * 32 + (col - 1152)] = acc[i][j][r];
                }
            } else if (n0 < 1792) {
                bf16_t* O = (bf16_t*)(ws_b + WS_NAQ);
#pragma unroll
                for (int r = 0; r < 16; ++r) O[(size_t)(rb + (r & 3) + 8 * (r >> 2)) * 512 + (col - 1280)] = f2bf(acc[i][j][r] * NA_QS);
            } else if (n0 < 2304) {
                bf16_t* O = (bf16_t*)(ws_b + WS_NAK);
                const int cc = col - 1792;
#pragma unroll
                for (int r = 0; r < 16; ++r) {
                    const int row = rb + (r & 3) + 8 * (r >> 2);
                    O[(size_t)row * 512 + cc] = f2bf(acc[i][j][r]);
                    if (ctx) p.out[OUT_NAK + ((size_t)((row >> 8) * 4 + l) * 256 + (row & 255)) * 512 + cc] = acc[i][j][r];
                }
            } else if (n0 < 2816) {
                bf16_t* VT = (bf16_t*)(ws_b + WS_NAVT);
                const int cc = col - 2304, h = cc >> 6, d = cc & 63;
#pragma unroll
                for (int qd = 0; qd < 4; ++qd) {
                    const int row = rb + 8 * qd;
                    u32x2 pk; pk.x = pk2(acc[i][j][4 * qd], acc[i][j][4 * qd + 1]); pk.y = pk2(acc[i][j][4 * qd + 2], acc[i][j][4 * qd + 3]);
                    if (ctx) {
                        const int b = row >> 8, s = row & 255;
                        *(u32x2*)(VT + ((size_t)((b * 8 + h) * 64 + d)) * 256 + s) = pk;
#pragma unroll
                        for (int e = 0; e < 4; ++e)
                            p.out[OUT_NAV + ((size_t)(b * 4 + l) * 256 + (s + e)) * 512 + cc] = acc[i][j][4 * qd + e];
                    } else {
                        const int rr = row - NCTX, b = rr >> 11, n = rr & 2047;
                        *(u32x2*)(VT + (size_t)4194304 + ((size_t)((b * 8 + h) * 64 + d)) * 2048 + n) = pk;
                    }
                }
            } else {
                bf16_t* O = (bf16_t*)(ws_b + WS_GATE);
                const int gc = col - 2816;
                const float bg = pin(p, 26)[l * 3072 + gc];
                bf16_t* gp = O + (size_t)gc * M + rb;
#pragma unroll
                for (int qd = 0; qd < 4; ++qd) {
                    u32x2 pk;
                    pk.x = pk2(sigmoidf_(acc[i][j][4 * qd] + bg), sigmoidf_(acc[i][j][4 * qd + 1] + bg));
                    pk.y = pk2(sigmoidf_(acc[i][j][4 * qd + 2] + bg), sigmoidf_(acc[i][j][4 * qd + 3] + bg));
                    *(u32x2*)(gp + 8 * qd) = pk;
                }
            }
        }
    }
}

DEVI void job_uq(const P& p, unsigned char* ws_b, int l, int t, bf16_t* sm, int tid) {
    const int nN = 6; const int m0 = (t / nN) * 128, n0 = (t % nN) * 128;
    const bf16_t* A = (const bf16_t*)(ws_b + WS_UQ);
    const bf16_t* W = (const bf16_t*)(ws_b + WS_W) + (size_t)l * LAYER_W + OFF_WUQ;
    bf16_t* Q = (bf16_t*)(ws_b + WS_Q);
    const float* ropec = (const float*)(ws_b + WS_ROPE);
    const float* ropes = ropec + 512;
    f32x16 acc[2][2]; zero_acc(acc);
    gemm_core(A + (size_t)m0 * 384, 384, W + (size_t)n0 * 384, 384, 384, acc, sm, tid);
    EPI_SETUP
    const bool lat = m0 >= NCTX;
#pragma unroll
    for (int j = 0; j < 2; ++j) {
        const int c0 = n0 + wc * 64 + j * 32;
        const int col = c0 + c32;
        const bool rope = lat && (((c0 >> 5) % 3) == 2);
        const int axis = c32 >> 4, ii = c32 & 15;
#pragma unroll
        for (int i = 0; i < 2; ++i) {
            const int rb = m0 + wr * 64 + i * 32 + 4 * hl;
#pragma unroll
            for (int r = 0; r < 16; ++r) {
                const int row = rb + (r & 3) + 8 * (r >> 2);
                float v = acc[i][j][r];
                const float pr = __shfl_xor(v, 8);
                if (rope) {
                    const int n = (row - NCTX) & 2047;
                    const int pos = axis ? (n & 63) : (n >> 6);
                    const float cs = ropec[pos * 8 + (ii & 7)], sn = ropes[pos * 8 + (ii & 7)];
                    const float rot = (ii < 8) ? -pr : pr;
                    v = v * cs + rot * sn;
                }
                Q[(size_t)row * 768 + col] = f2bf(v * MLA_QS);
            }
        }
    }
}

DEVI void job_ukv(const P& p, unsigned char* ws_b, int l, int t, bf16_t* sm, int tid) {
    const int nN = 8; const int m0 = (t / nN) * 128, h = t % nN, n0 = h * 128;
    const bf16_t* A = (m0 < M) ? (const bf16_t*)(ws_b + WS_CKV) + (size_t)m0 * 256
                               : (const bf16_t*)(ws_b + WS_CCKV) + ((size_t)l * 1024 + (m0 - M)) * 256;
    const bf16_t* W = (const bf16_t*)(ws_b + WS_W) + (size_t)l * LAYER_W + OFF_WUKV;
    bf16_t* KN = (bf16_t*)(ws_b + WS_KN);
    bf16_t* VT = (bf16_t*)(ws_b + WS_VTM);
    f32x16 acc[2][2]; zero_acc(acc);
    gemm_core(A, 256, W + (size_t)n0 * 256, 256, 256, acc, sm, tid);
    EPI_SETUP
#pragma unroll
    for (int j = 0; j < 2; ++j) {
        const int d = j * 32 + c32;
#pragma unroll
        for (int i = 0; i < 2; ++i) {
            const int rb = m0 + wr * 64 + i * 32 + 4 * hl;
            if (wc == 0) {
#pragma unroll
                for (int r = 0; r < 16; ++r) KN[(size_t)(rb + (r & 3) + 8 * (r >> 2)) * 512 + h * 64 + d] = f2bf(acc[i][j][r]);
            } else {
#pragma unroll
                for (int qd = 0; qd < 4; ++qd) {
                    const int row = rb + 8 * qd;
                    u32x2 pk; pk.x = pk2(acc[i][j][4 * qd], acc[i][j][4 * qd + 1]); pk.y = pk2(acc[i][j][4 * qd + 2], acc[i][j][4 * qd + 3]);
                    size_t addr;
                    if (m0 < NCTX) { const int b = row >> 8, s = row & 255; addr = ((size_t)((b * 8 + h) * 64 + d)) * 256 + s; }
                    else if (m0 < M) { const int rr = row - NCTX, b = rr >> 11, n = rr & 2047; addr = (size_t)4194304 + ((size_t)((b * 8 + h) * 64 + d)) * 2560 + n; }
                    else { const int rr = row - M, b = rr >> 9, n = rr & 511; addr = (size_t)4194304 + ((size_t)((b * 8 + h) * 64 + d)) * 2560 + 2048 + n; }
                    *(u32x2*)(VT + addr) = pk;
                }
            }
        }
    }
}

template <int ldo, bool SPLITK = false>
DEVI void job_store(const bf16_t* A, int lda, const bf16_t* Bt, int ldb, int K, bf16_t* Out, bf16_t* sm, int tid, int grp = 0, float* xch = nullptr) {
    f32x16 acc[2][2]; zero_acc(acc);
    if constexpr (SPLITK) { K >>= 1; A += grp * K; Bt += grp * K; }
    gemm_core(A, lda, Bt, ldb, K, acc, sm, tid);
    EPI_SETUP
    if constexpr (SPLITK) {
        if (grp == 1) {
#pragma unroll
            for (int i = 0; i < 2; ++i)
#pragma unroll
                for (int j = 0; j < 2; ++j)
#pragma unroll
                    for (int r = 0; r < 16; ++r) xch[((i * 2 + j) * 16 + r) * 256 + tid] = acc[i][j][r];
        }
        __syncthreads();
        if (grp == 0) {
#pragma unroll
            for (int i = 0; i < 2; ++i)
#pragma unroll
                for (int j = 0; j < 2; ++j)
#pragma unroll
                    for (int r = 0; r < 16; ++r) acc[i][j][r] += xch[((i * 2 + j) * 16 + r) * 256 + tid];
        }
        __syncthreads();
    }
    const bool active = !SPLITK || grp == 0;
    bf16_t* st = sm + (wr * 64 + 4 * hl) * 136 + wc * 64 + c32;
    if (active) {
#pragma unroll
        for (int i = 0; i < 2; ++i)
#pragma unroll
            for (int j = 0; j < 2; ++j)
#pragma unroll
                for (int r = 0; r < 16; ++r) st[(i * 32 + (r & 3) + 8 * (r >> 2)) * 136 + j * 32] = f2bf(acc[i][j][r]);
    }
    __syncthreads();
    if (active) {
        const int orow = tid >> 4, oc = (tid & 15) * 8;
#pragma unroll
        for (int k = 0; k < 8; ++k) {
            const u32x4 v = *(const u32x4*)(sm + (orow + 16 * k) * 136 + oc);
            *(u32x4*)(Out + (size_t)(orow + 16 * k) * ldo + oc) = v;
        }
    }
    __syncthreads();
}

DEVI void job_f1(const P& p, unsigned char* ws_b, int t, bf16_t* sm, int tid) {
    const bf16_t* WCS = (const bf16_t*)(ws_b + WS_WCS);
    const bf16_t* UF = (const bf16_t*)(ws_b + WS_UF);
    bf16_t* F1T = (bf16_t*)(ws_b + WS_F1T);
    if (t < 512) {
        const int bs = t >> 4, g = (t >> 2) & 3, mi = (t >> 1) & 1, ni = t & 1;
        job_store<256>(WCS + mi * 128 * 128, 128, UF + ((size_t)bs * 256 + ni * 128) * 512 + g * 128, 512, 128,
                  F1T + ((size_t)(bs * 4 + g) * 256 + mi * 128) * 256 + ni * 128, sm, tid);
    } else {
        t -= 512;
        const int bs = t >> 7, g = (t >> 5) & 3, mi = (t >> 4) & 1, ni = t & 15;
        job_store<2048>(WCS + mi * 128 * 128, 128, UF + ((size_t)NCTX + bs * 2048 + ni * 128) * 512 + g * 128, 512, 128,
                  F1T + (size_t)8388608 + ((size_t)(bs * 4 + g) * 256 + mi * 128) * 2048 + ni * 128, sm, tid);
    }
}
DEVI void job_f2_lat(const P& p, unsigned char* ws_b, int t, bf16_t* sm, int tid, int grp, float* xch) {
    const int bs = t >> 6, mi = (t >> 2) & 15, ni = t & 3;
    const bf16_t* TAB = (const bf16_t*)(ws_b + WS_TABL);
    const bf16_t* F1T = (const bf16_t*)(ws_b + WS_F1T) + (size_t)8388608;
    bf16_t* YF = (bf16_t*)(ws_b + WS_YF);
    job_store<512, true>(TAB + (size_t)mi * 128 * 4096, 4096, F1T + (size_t)bs * 512 * 4096 + (size_t)ni * 128 * 4096, 4096, 4096,
              YF + ((size_t)NCTX + bs * 2048 + mi * 128) * 512 + ni * 128, sm, tid, grp, xch);
}
DEVI void job_f2_ctx(const P& p, unsigned char* ws_b, int t, bf16_t* sm, int tid) {
    const int bs = t >> 3, mi = (t >> 2) & 1, ni = t & 3;
    const bf16_t* TAB = (const bf16_t*)(ws_b + WS_TABC);
    const bf16_t* F1T = (const bf16_t*)(ws_b + WS_F1T);
    bf16_t* YF = (bf16_t*)(ws_b + WS_YF);
    job_store<512>(TAB + (size_t)mi * 128 * 512, 512, F1T + (size_t)bs * 512 * 512 + (size_t)ni * 128 * 512, 512, 512,
              YF + ((size_t)bs * 256 + mi * 128) * 512 + ni * 128, sm, tid);
}

DEVI void job_merge(const P& p, unsigned char* ws_b, int l, int t, bf16_t* sm, int tid) {
    const int nN = 8; const int m0 = (t / nN) * 128, n0 = (t % nN) * 128;
    const bf16_t* Wl = (const bf16_t*)(ws_b + WS_W) + (size_t)l * LAYER_W;
    const bf16_t* GATE = (const bf16_t*)(ws_b + WS_GATE);
    bf16_t* MG = (bf16_t*)(ws_b + WS_MERGED);
    EPI_SETUP
    f32x16 acc[2][2]; zero_acc(acc);
#pragma unroll 1
    for (int s = 0; s < 3; ++s) {
        const bf16_t* A = (const bf16_t*)(ws_b + (s == 0 ? WS_YF : (s == 1 ? WS_YM : WS_YN)));
        const bf16_t* W = Wl + (s == 0 ? OFF_WBF : (s == 1 ? OFF_WBM : OFF_WBN));
        gemm_core<false>(A + (size_t)m0 * 512, 512, W + (size_t)n0 * 512, 512, 512, acc, sm, tid);
        {
            const int gr = tid >> 4, gc = (tid & 15) * 8;
            const int s1 = s < 2 ? s + 1 : s;
#pragma unroll
            for (int k = 0; k < 8; ++k) {
                const bf16_t* gsrc = GATE + (size_t)(m0 + gr + 16 * k) * 3072 + n0 + gc;
                *(u32x4*)(sm + (gr + 16 * k) * 136 + gc) = *(const u32x4*)(gsrc + s * 1024);
                *(u32x4*)(sm + 128 * 136 + (gr + 16 * k) * 136 + gc) = *(const u32x4*)(gsrc + s1 * 1024);
                if ((k & 1) == 1) __builtin_amdgcn_sched_barrier(0);
            }
        }
        __syncthreads();
#pragma unroll
        for (int j = 0; j < 2; ++j)
#pragma unroll
            for (int i = 0; i < 2; ++i) {
                const bf16_t* gp = sm + (wr * 64 + i * 32 + 4 * hl) * 136 + wc * 64 + j * 32 + c32;
#pragma unroll
                for (int r = 0; r < 16; ++r) {
                    const int o = ((r & 3) + 8 * (r >> 2)) * 136;
                    const float g = bf2f(gp[o]);
                    const float f = (s < 2) ? g * __builtin_amdgcn_rcpf(bf2f(gp[128 * 136 + o])) : g;
                    acc[i][j][r] *= f;
                }
            }
        __syncthreads();
    }
#pragma unroll
    for (int j = 0; j < 2; ++j) {
        const int col = n0 + wc * 64 + j * 32 + c32;
#pragma unroll
        for (int i = 0; i < 2; ++i) {
            const int rb = m0 + wr * 64 + i * 32 + 4 * hl;
#pragma unroll
            for (int r = 0; r < 16; ++r) MG[(size_t)(rb + (r & 3) + 8 * (r >> 2)) * 1024 + col] = f2bf(acc[i][j][r]);
        }
    }
}

struct TileSrc { const bf16_t* k; const bf16_t* k2; const bf16_t* v; const bf16_t* vhi; };
DEVI int pi_row(int r) { return (r & 0x13) | ((r & 4) << 1) | ((r & 8) >> 1); }

template <int NKS>
DEVI void attn_load(const TileSrc& s, bf16x8 (&kf)[NKS], bf16x8 (&vf)[4]) {
#pragma unroll
    for (int ks = 0; ks < NKS; ++ks) kf[ks] = (ks < 4) ? *(const bf16x8*)(s.k + ks * 16) : *(const bf16x8*)(s.k2 + (ks - 4) * 16);
    vf[0] = *(const bf16x8*)(s.v);
    vf[1] = *(const bf16x8*)(s.v + 16);
    vf[2] = *(const bf16x8*)(s.vhi);
    vf[3] = *(const bf16x8*)(s.vhi + 16);
}

template <int NKS, bool SPLIT, class Src, class Mask>
DEVI void attn_wave(const bf16_t* qptr, int t0, int nt, Src src, Mask mask, bf16_t* optr, int lane, float* ex = nullptr, int half = 0) {
    bf16x8 q[NKS];
#pragma unroll
    for (int ks = 0; ks < NKS; ++ks) q[ks] = *(const bf16x8*)(qptr + ks * 16);
    f32x16 o0, o1;
#pragma unroll
    for (int r = 0; r < 16; ++r) { o0[r] = 0.f; o1[r] = 0.f; }
    float m = -1e30f, lsum = 0.f;
    bf16x8 kf[NKS], vf[4];
    nt += t0;
    { TileSrc s0 = src(t0); attn_load<NKS>(s0, kf, vf); }
    for (int t = t0; t < nt; ++t) {
        bf16x8 kn[NKS], vn[4];
        { TileSrc s1 = src(t + 1 < nt ? t + 1 : t); attn_load<NKS>(s1, kn, vn); }
        f32x16 s;
#pragma unroll
        for (int r = 0; r < 16; ++r) s[r] = 0.f;
#pragma unroll
        for (int ks = 0; ks < NKS; ++ks) s = __builtin_amdgcn_mfma_f32_32x32x16_bf16(kf[ks], q[ks], s, 0, 0, 0);
        mask(t, s);
        float mx = s[0];
#pragma unroll
        for (int r = 1; r < 16; ++r) mx = fmaxf(mx, s[r]);
        mx = fmaxf(mx, __shfl_xor(mx, 32));
        const float mn = fmaxf(m, mx);
        const float alpha = fast_exp2(m - mn);
        m = mn;
        float rs = 0.f;
#pragma unroll
        for (int r = 0; r < 16; ++r) { s[r] = fast_exp2(s[r] - mn); rs += s[r]; }
        lsum = lsum * alpha + rs;
#pragma unroll
        for (int r = 0; r < 16; ++r) { o0[r] *= alpha; o1[r] *= alpha; }
        bf16x8 p0, p1;
        {
            u32x4 a, b;
            a.x = pk2(s[0], s[1]); a.y = pk2(s[2], s[3]); a.z = pk2(s[4], s[5]); a.w = pk2(s[6], s[7]);
            b.x = pk2(s[8], s[9]); b.y = pk2(s[10], s[11]); b.z = pk2(s[12], s[13]); b.w = pk2(s[14], s[15]);
            p0 = __builtin_bit_cast(bf16x8, a); p1 = __builtin_bit_cast(bf16x8, b);
        }
        o0 = __builtin_amdgcn_mfma_f32_32x32x16_bf16(vf[0], p0, o0, 0, 0, 0);
        o0 = __builtin_amdgcn_mfma_f32_32x32x16_bf16(vf[1], p1, o0, 0, 0, 0);
        o1 = __builtin_amdgcn_mfma_f32_32x32x16_bf16(vf[2], p0, o1, 0, 0, 0);
        o1 = __builtin_amdgcn_mfma_f32_32x32x16_bf16(vf[3], p1, o1, 0, 0, 0);
#pragma unroll
        for (int ks = 0; ks < NKS; ++ks) kf[ks] = kn[ks];
#pragma unroll
        for (int x = 0; x < 4; ++x) vf[x] = vn[x];
    }
    if constexpr (SPLIT) {
        if (half == 1) {
#pragma unroll
            for (int r = 0; r < 16; ++r) { ex[r * 64 + lane] = o0[r]; ex[(16 + r) * 64 + lane] = o1[r]; }
            ex[32 * 64 + lane] = m; ex[33 * 64 + lane] = lsum;
        }
        __syncthreads();
        if (half == 0) {
            const float m2 = ex[32 * 64 + lane], l2 = ex[33 * 64 + lane];
            const float mn = fmaxf(m, m2), a1 = fast_exp2(m - mn), a2 = fast_exp2(m2 - mn);
            lsum = lsum * a1 + l2 * a2;
#pragma unroll
            for (int r = 0; r < 16; ++r) { o0[r] = o0[r] * a1 + ex[r * 64 + lane] * a2; o1[r] = o1[r] * a1 + ex[(16 + r) * 64 + lane] * a2; }
        }
        __syncthreads();
        if (half == 1) return;
    }
    lsum += __shfl_xor(lsum, 32);
    const float inv = 1.f / lsum;
    const int hl = lane >> 5;
#pragma unroll
    for (int qd = 0; qd < 4; ++qd) {
        u32x2 a, b;
        a.x = pk2(o0[4 * qd] * inv, o0[4 * qd + 1] * inv); a.y = pk2(o0[4 * qd + 2] * inv, o0[4 * qd + 3] * inv);
        b.x = pk2(o1[4 * qd] * inv, o1[4 * qd + 1] * inv); b.y = pk2(o1[4 * qd + 2] * inv, o1[4 * qd + 3] * inv);
        *(u32x2*)(optr + 8 * qd + 4 * hl) = a;
        *(u32x2*)(optr + 32 + 8 * qd + 4 * hl) = b;
    }
}

struct NoMask { DEVI void operator()(int, f32x16&) const {} };

DEVI void attn_mla(const P& p, unsigned char* ws_b, int l, bool lat, int b, int h, int qg, int lane, float* ex = nullptr, int half = 0) {
    const int hl = lane >> 5, c32 = lane & 31, pr = pi_row(c32);
    const bf16_t* Q = (const bf16_t*)(ws_b + WS_Q);
    const bf16_t* KN = (const bf16_t*)(ws_b + WS_KN);
    const bf16_t* KR = (const bf16_t*)(ws_b + WS_KR);
    const bf16_t* CKR = (const bf16_t*)(ws_b + WS_CKR) + (size_t)l * 1024 * 32;
    const bf16_t* VT = (const bf16_t*)(ws_b + WS_VTM);
    bf16_t* YM = (bf16_t*)(ws_b + WS_YM);
    if (!lat) {
        const int row0 = b * 256;
        const int qrow = row0 + qg * 32 + c32;
        const bf16_t* k0 = KN + (size_t)(row0 + pr) * 512 + h * 64 + hl * 8;
        const bf16_t* r0 = KR + (size_t)(row0 + pr) * 32 + hl * 8;
        const bf16_t* v0 = VT + ((size_t)((b * 8 + h) * 64 + c32)) * 256 + hl * 8;
        auto src = [=](int t) { TileSrc s; s.k = k0 + (size_t)t * 32 * 512; s.k2 = r0 + (size_t)t * 32 * 32; s.v = v0 + t * 32; s.vhi = s.v + 32 * 256; return s; };
        attn_wave<6, false>(Q + (size_t)qrow * 768 + h * 96 + hl * 8, 0, 8, src, NoMask(), YM + (size_t)qrow * 512 + h * 64, lane);
    } else {
        const int row0 = NCTX + b * 2048;
        const int qrow = row0 + qg * 32 + c32;
        const bf16_t* k0 = KN + (size_t)(row0 + pr) * 512 + h * 64 + hl * 8;
        const bf16_t* r0 = KR + (size_t)(row0 + pr) * 32 + hl * 8;
        const bf16_t* k1 = KN + (size_t)(M + b * 512 + pr) * 512 + h * 64 + hl * 8;
        const bf16_t* r1 = CKR + (size_t)(b * 512 + pr) * 32 + hl * 8;
        const bf16_t* v0 = VT + (size_t)4194304 + ((size_t)((b * 8 + h) * 64 + c32)) * 2560 + hl * 8;
        auto src = [=](int t) {
            TileSrc s;
            if (t < 64) { s.k = k0 + (size_t)t * 32 * 512; s.k2 = r0 + (size_t)t * 32 * 32; }
            else { s.k = k1 + (size_t)(t - 64) * 32 * 512; s.k2 = r1 + (size_t)(t - 64) * 32 * 32; }
            s.v = v0 + t * 32; s.vhi = s.v + 32 * 2560; return s; };
        attn_wave<6, true>(Q + (size_t)qrow * 768 + h * 96 + hl * 8, half * 40, 40, src, NoMask(), YM + (size_t)qrow * 512 + h * 64, lane, ex, half);
    }
}

DEVI void attn_na_ctx(const P& p, unsigned char* ws_b, int b, int h, int qg, int lane) {
    const int hl = lane >> 5, c32 = lane & 31, pr = pi_row(c32);
    const bf16_t* Qn = (const bf16_t*)(ws_b + WS_NAQ);
    const bf16_t* Kn = (const bf16_t*)(ws_b + WS_NAK);
    const bf16_t* VT = (const bf16_t*)(ws_b + WS_NAVT);
    bf16_t* YN = (bf16_t*)(ws_b + WS_YN);
    const int row0 = b * 256, qrow = row0 + qg * 32 + c32;
    const bf16_t* k0 = Kn + (size_t)(row0 + pr) * 512 + h * 64 + hl * 8;
    const bf16_t* v0 = VT + ((size_t)((b * 8 + h) * 64 + c32)) * 256 + hl * 8;
    auto src = [=](int t) { TileSrc s; s.k = k0 + (size_t)t * 32 * 512; s.k2 = s.k; s.v = v0 + t * 32; s.vhi = s.v + 32 * 256; return s; };
    attn_wave<4, false>(Qn + (size_t)qrow * 512 + h * 64 + hl * 8, 0, 8, src, NoMask(), YN + (size_t)qrow * 512 + h * 64, lane);
}

struct NaMask {
    const float* rpb;
    int rs, rq, qc, hl;
    DEVI void operator()(int t, f32x16& s) const {
        if (t >= 16) return;
        const int kr = t >> 1, kh = t & 1;
        const int cs = min(max(qc - 8, 0), 48);
        const float* rp = rpb + (rs + kr - rq + 7) * 31;
#pragma unroll
        for (int r = 0; r < 16; ++r) {
            const int kk = (r & 3) + 4 * ((r >> 2) & 1) + 8 * hl + 16 * (r >> 3);
            const int kc = kh * 32 + kk;
            const bool ok = (kc >= cs) && (kc < cs + 16);
            const int dc = min(max(kc - qc + 15, 0), 30);
            const float bias = rp[dc] * LOG2E;
            s[r] = ok ? s[r] + bias : -1e30f;
        }
    }
};
DEVI void attn_na_lat(const P& p, unsigned char* ws_b, int l, int b, int h, int rq, int qh, int lane, float* ex, int half) {
    const int hl = lane >> 5, c32 = lane & 31, pr = pi_row(c32);
    const bf16_t* Qn = (const bf16_t*)(ws_b + WS_NAQ);
    const bf16_t* Kn = (const bf16_t*)(ws_b + WS_NAK);
    const bf16_t* VT = (const bf16_t*)(ws_b + WS_NAVT) + (size_t)4194304;
    const bf16_t* CK = (const bf16_t*)(ws_b + WS_CNAK) + (size_t)l * 1024 * 512;
    const bf16_t* CV = (const bf16_t*)(ws_b + WS_CNAVT) + (size_t)l * 1024 * 512;
    bf16_t* YN = (bf16_t*)(ws_b + WS_YN);
    const int row0 = NCTX + b * 2048;
    const int qrow = row0 + rq * 64 + qh * 32 + c32;
    const int rs = min(max(rq - 4, 0), 24);
    const bf16_t* k0 = Kn + (size_t)(row0 + rs * 64 + pr) * 512 + h * 64 + hl * 8;
    const bf16_t* v0 = VT + ((size_t)((b * 8 + h) * 64 + c32)) * 2048 + rs * 64 + hl * 8;
    const bf16_t* k1 = CK + (size_t)(b * 512 + pr) * 512 + h * 64 + hl * 8;
    const bf16_t* v1 = CV + ((size_t)((b * 8 + h) * 64 + c32)) * 512 + hl * 8;
    auto src = [=](int t) {
        TileSrc s;
        if (t < 16) { s.k = k0 + (size_t)t * 32 * 512; s.v = v0 + t * 32; s.vhi = s.v + 32 * 2048; }
        else { s.k = k1 + (size_t)(t - 16) * 32 * 512; s.v = v1 + (t - 16) * 32; s.vhi = s.v + 32 * 512; }
        s.k2 = s.k; return s; };
    NaMask mk; mk.rpb = pin(p, 21) + (size_t)(l * 8 + h) * 15 * 31; mk.rs = rs; mk.rq = rq; mk.qc = qh * 32 + c32; mk.hl = hl;
    attn_wave<4, true>(Qn + (size_t)qrow * 512 + h * 64 + hl * 8, half * 16, 16, src, mk, YN + (size_t)qrow * 512 + h * 64, lane, ex, half);
}

DEVI void row_ln_mod(const float* src, float* xdst, bf16_t* hdst, const float* lng, const float* lnb, const float* shift, const float* scale, int lane) {
    f32x4 v[4];
#pragma unroll
    for (int j = 0; j < 4; ++j) v[j] = *(const f32x4*)(src + 4 * lane + 256 * j);
    if (lng) {
        float s = 0.f;
#pragma unroll
        for (int j = 0; j < 4; ++j) s += (v[j].x + v[j].y) + (v[j].z + v[j].w);
        const float mu = wave_sum(s) * (1.f / D);
        float q = 0.f;
#pragma unroll
        for (int j = 0; j < 4; ++j) { v[j] = v[j] - mu; q += (v[j].x * v[j].x + v[j].y * v[j].y) + (v[j].z * v[j].z + v[j].w * v[j].w); }
        const float rstd = rsqrtf(wave_sum(q) * (1.f / D) + 1e-5f);
#pragma unroll
        for (int j = 0; j < 4; ++j) {
            const f32x4 g = *(const f32x4*)(lng + 4 * lane + 256 * j), bb = *(const f32x4*)(lnb + 4 * lane + 256 * j);
            v[j] = v[j] * rstd * g + bb;
        }
    }
    if (xdst) {
#pragma unroll
        for (int j = 0; j < 4; ++j) *(f32x4*)(xdst + 4 * lane + 256 * j) = v[j];
    }
    if (hdst) {
        float s = 0.f;
#pragma unroll
        for (int j = 0; j < 4; ++j) s += (v[j].x + v[j].y) + (v[j].z + v[j].w);
        const float mu = wave_sum(s) * (1.f / D);
        float q = 0.f;
#pragma unroll
        for (int j = 0; j < 4; ++j) { v[j] = v[j] - mu; q += (v[j].x * v[j].x + v[j].y * v[j].y) + (v[j].z * v[j].z + v[j].w * v[j].w); }
        const float rstd = rsqrtf(wave_sum(q) * (1.f / D) + 1e-6f);
#pragma unroll
        for (int j = 0; j < 4; ++j) {
            const f32x4 sc = *(const f32x4*)(scale + 4 * lane + 256 * j), sh = *(const f32x4*)(shift + 4 * lane + 256 * j);
            const f32x4 o = v[j] * rstd * (sc + 1.f) + sh;
            u32x2 pk; pk.x = pk2(o.x, o.y); pk.y = pk2(o.z, o.w);
            *(u32x2*)(hdst + 4 * lane + 256 * j) = pk;
        }
    }
}

DEVI void phase_rows(const P& p, unsigned char* ws_b, int l, int lnidx, int ml, int ms, bool final_, int gw, int ngw, int lane) {
    float* X = (float*)(ws_b + WS_X);
    bf16_t* H = (bf16_t*)(ws_b + WS_H);
    const float* MOD = (const float*)(ws_b + WS_MOD);
    for (int row = gw; row < M; row += ngw) {
        const float* src = (lnidx < 0) ? (row < NCTX ? pin(p, 0) + (size_t)row * D : pin(p, 1) + (size_t)(row - NCTX) * D) : X + (size_t)row * D;
        const float* lng = (lnidx < 0) ? nullptr : pin(p, 28) + (size_t)(l * 3 + lnidx) * D;
        const float* lnb = (lnidx < 0) ? nullptr : pin(p, 29) + (size_t)(l * 3 + lnidx) * D;
        if (final_) { row_ln_mod(src, p.out + (size_t)row * D, nullptr, lng, lnb, nullptr, nullptr, lane); continue; }
        const float* mb = MOD + ((size_t)ml * 3 + mod_group(row)) * 9216;
        row_ln_mod(src, X + (size_t)row * D, H + (size_t)row * D, lng, lnb, mb + ms * D, mb + (ms + 1) * D, lane);
    }
}

DEVI void phase_rowmix(const P& p, unsigned char* ws_b, int l, int gw, int ngw, int lane) {
    bf16_t* UQ = (bf16_t*)(ws_b + WS_UQ);
    const float* UKV = (const float*)(ws_b + WS_UKV);
    const float* KRF = (const float*)(ws_b + WS_KRF);
    bf16_t* CKV = (bf16_t*)(ws_b + WS_CKV);
    bf16_t* KR = (bf16_t*)(ws_b + WS_KR);
    const float* ropec = (const float*)(ws_b + WS_ROPE);
    const float* ropes = ropec + 512;
    const float* gq = pin(p, 17) + l * 384;
    const float* gkv = pin(p, 19) + l * 256;
    for (int row = gw; row < M; row += ngw) {
        {
            unsigned* up = (unsigned*)(UQ + (size_t)row * 384) + lane;
            float x[6]; float ss = 0.f;
#pragma unroll
            for (int j = 0; j < 3; ++j) { const unsigned w = up[64 * j]; x[2 * j] = bf2f(w & 0xffffu); x[2 * j + 1] = bf2f(w >> 16); ss += x[2 * j] * x[2 * j] + x[2 * j + 1] * x[2 * j + 1]; }
            const float rs = rsqrtf(wave_sum(ss) * (1.f / 384.f) + 1e-6f);
#pragma unroll
            for (int j = 0; j < 3; ++j) { const int c = 2 * lane + 128 * j; up[64 * j] = pk2(x[2 * j] * rs * gq[c], x[2 * j + 1] * rs * gq[c + 1]); }
        }
        {
            const f32x4 v = *(const f32x4*)(UKV + (size_t)row * 256 + 4 * lane);
            const float ss = v.x * v.x + v.y * v.y + v.z * v.z + v.w * v.w;
            const float rs = rsqrtf(wave_sum(ss) * (1.f / 256.f) + 1e-6f);
            const f32x4 g = *(const f32x4*)(gkv + 4 * lane);
            const f32x4 o = v * rs * g;
            u32x2 pk; pk.x = pk2(o.x, o.y); pk.y = pk2(o.z, o.w);
            *(u32x2*)(CKV + (size_t)row * 256 + 4 * lane) = pk;
            if (row < NCTX) *(f32x4*)(p.out + OUT_CKV + ((size_t)((row >> 8) * 4 + l) * 256 + (row & 255)) * 256 + 4 * lane) = o;
        }
        {
            const float v = KRF[(size_t)row * 32 + (lane & 31)];
            const float pr = __shfl_xor(v, 8);
            float o = v;
            if (row >= NCTX) {
                const int c = lane & 31, axis = c >> 4, ii = c & 15, n = (row - NCTX) & 2047;
                const int pos = axis ? (n & 63) : (n >> 6);
                const float rot = (ii < 8) ? -pr : pr;
                o = v * ropec[pos * 8 + (ii & 7)] + rot * ropes[pos * 8 + (ii & 7)];
            }
            if (lane < 32) {
                KR[(size_t)row * 32 + lane] = f2bf(o);
                if (row < NCTX) p.out[OUT_KR + ((size_t)((row >> 8) * 4 + l) * 256 + (row & 255)) * 32 + lane] = v;
            }
        }
    }
}

DEVI void transpose_item(const float* __restrict__ src, int N, int c0, int k0, bf16_t* __restrict__ dst, int K, float* scr, int lane) {
#pragma unroll 8
    for (int i = 0; i < 32; ++i) { const int kk = 2 * i + (lane >> 5); scr[kk * 33 + (lane & 31)] = src[(size_t)(k0 + kk) * N + c0 + (lane & 31)]; }
    asm volatile("s_waitcnt lgkmcnt(0)" ::: "memory");
    const int c = lane & 7;
#pragma unroll
    for (int j = 0; j < 4; ++j) {
        const int n = (lane >> 3) + 8 * j; const float* s = scr + (8 * c) * 33 + n;
        u32x4 o; o.x = pk2(s[0], s[33]); o.y = pk2(s[2 * 33], s[3 * 33]); o.z = pk2(s[4 * 33], s[5 * 33]); o.w = pk2(s[6 * 33], s[7 * 33]);
        *(u32x4*)(dst + (size_t)n * K + k0 + 8 * c) = o;
    }
    asm volatile("s_waitcnt lgkmcnt(0)" ::: "memory");
}

DEVI void prep_weight_item(const P& p, unsigned char* ws_b, int item, float* scr, int lane) {
    const int l = item / 12944; int r = item % 12944;
    bf16_t* Wl = (bf16_t*)(ws_b + WS_W) + (size_t)l * LAYER_W;
    if (r < 8448) {
        const int which = r / 4224; r %= 4224;
        if (r < 2816) {
            const int rb = r >> 4, kb = r & 15;
            const float* src = ((lane & 16) ? (which ? pin(p, 14) : pin(p, 11)) : (which ? pin(p, 13) : pin(p, 10))) + (size_t)l * D * DFF;
            transpose_item(src, DFF, rb * 16 - (lane & 16), kb * 64, Wl + (which ? OFF_W13_2 : OFF_W13_1) + (size_t)rb * 32 * D, D, scr, lane);
        } else {
            r -= 2816; const int rb = r / 44, kb = r % 44;
            const float* src = (which ? pin(p, 15) : pin(p, 12)) + (size_t)l * DFF * D;
            transpose_item(src, D, rb * 32, kb * 64, Wl + (which ? OFF_W2_2 : OFF_W2_1) + (size_t)rb * 32 * DFF, DFF, scr, lane);
        }
        return;
    }
    r -= 8448;
    if (r < 2944) {
        const int rb = r >> 4, kb = r & 15, R0 = rb * 32;
        const float* src; int N, c0;
        if (R0 < 1184) { src = pin(p, 16) + (size_t)l * D * 2720; N = 2720; c0 = R0; }
        else if (R0 < 1280) return;
        else if (R0 < 2816) { src = pin(p, 16) + (size_t)l * D * 2720; N = 2720; c0 = R0 - 96; }
        else { src = pin(p, 25) + (size_t)l * D * 3072; N = 3072; c0 = R0 - 2816; }
        transpose_item(src, N, c0, kb * 64, Wl + OFF_WIN + (size_t)R0 * D, D, scr, lane);
        return;
    }
    r -= 2944;
    if (r < 512) { const int rb = r >> 4, kb = r & 15; transpose_item(pin(p, 27) + (size_t)l * D * D, D, rb * 32, kb * 64, Wl + OFF_WOUT + (size_t)rb * 32 * D, D, scr, lane); return; }
    r -= 512;
    if (r < 768) { const int w = r >> 8; r &= 255; const int rb = r >> 3, kb = r & 7;
        transpose_item((w == 0 ? pin(p, 22) : (w == 1 ? pin(p, 23) : pin(p, 24))) + (size_t)l * 512 * D, D, rb * 32, kb * 64, Wl + (w == 0 ? OFF_WBF : (w == 1 ? OFF_WBM : OFF_WBN)) + (size_t)rb * 32 * 512, 512, scr, lane); return; }
    r -= 768;
    if (r < 144) { const int rb = r / 6, kb = r % 6; transpose_item(pin(p, 18) + (size_t)l * 384 * 768, 768, rb * 32, kb * 64, Wl + OFF_WUQ + (size_t)rb * 32 * 384, 384, scr, lane); return; }
    r -= 144;
    { const int rb = r >> 2, kb = r & 3; transpose_item(pin(p, 20) + (size_t)l * 256 * 1024, 1024, rb * 32, kb * 64, Wl + OFF_WUKV + (size_t)rb * 32 * 256, 256, scr, lane); }
}

DEVI void phase_prep(const P& p, unsigned char* ws_b, unsigned char* smem, int tid) {
    const int lane = tid & 63, wave = tid >> 6;
    const int gw = blockIdx.x * NWAVES + wave, ngw = gridDim.x * NWAVES;
    const size_t gt = (size_t)blockIdx.x * NTHREADS + tid, ngt = (size_t)gridDim.x * NTHREADS;
    {
        float* sil = (float*)smem;
        const float* wada = pin(p, 8);
        float* MODP = (float*)(ws_b + WS_MODP);
        for (int item = blockIdx.x; item < 1152; item += gridDim.x) {
            const int l = item / 288, rem = item % 288, kc = rem / 18, cb = rem % 18;
            __syncthreads();
            if (tid < 192) {
                const int g = tid >> 6, k = kc * 64 + (tid & 63);
                const float cv = (g == 0) ? pin(p, 7)[k] : pin(p, 6)[(g - 1) * D + k];
                sil[tid] = cv * sigmoidf_(cv);
            }
            __syncthreads();
            const int col = cb * NTHREADS + tid;
            const float* w = wada + ((size_t)l * D + kc * 64) * 9216 + col;
            float a0 = 0.f, a1 = 0.f, a2 = 0.f;
#pragma unroll 16
            for (int k = 0; k < 64; ++k) { const float wv = w[(size_t)k * 9216]; a0 += sil[k] * wv; a1 += sil[64 + k] * wv; a2 += sil[128 + k] * wv; }
            float* o = MODP + ((size_t)(l * 16 + kc) * 3) * 9216 + col;
            o[0] = a0; o[9216] = a1; o[2 * 9216] = a2;
        }
        __syncthreads();
    }
    {
        float* scr = (float*)smem + wave * (64 * 33);
        for (int item = gw; item < 4 * 12944; item += ngw) prep_weight_item(p, ws_b, item, scr, lane);
    }
    {
        bf16_t* TABL = (bf16_t*)(ws_b + WS_TABL);
        for (size_t e = gt; e < (size_t)2048 * 4096; e += ngt) {
            const int k = (int)(e >> 12), kk = (int)(e & 4095), lidx = kk & 2047;
            const int idx = (k * lidx) & 2047;
            float sn, cs; sincospif((float)idx * (2.f / 2048.f), &sn, &cs);
            TABL[e] = f2bf((kk < 2048 ? cs : -sn) * 0.022097086912079608f);
        }
        bf16_t* TABC = (bf16_t*)(ws_b + WS_TABC);
        for (size_t e = gt; e < (size_t)256 * 512; e += ngt) {
            const int k = (int)(e >> 9), kk = (int)(e & 511), lidx = kk & 255;
            const int idx = (k * lidx) & 255;
            float sn, cs; sincospif((float)idx * (2.f / 256.f), &sn, &cs);
            TABC[e] = f2bf((kk < 256 ? cs : -sn) * 0.0625f);
        }
        bf16_t* WCS = (bf16_t*)(ws_b + WS_WCS);
        for (size_t e = gt; e < (size_t)256 * 128; e += ngt) {
            const int i = (int)(e >> 7), c = (int)(e & 127), m = i >> 1, cs_ = i & 1;
            const int idx = (m * c) & 127;
            float sn, cs; sincospif((float)idx * (2.f / 128.f), &sn, &cs);
            WCS[e] = f2bf((cs_ ? sn : cs) * 0.08838834764831845f);
        }
        float* ROPE = (float*)(ws_b + WS_ROPE);
        for (size_t e = gt; e < 512; e += ngt) {
            const int pos = (int)(e >> 3), i = (int)(e & 7);
            const float inv_freq = powf(10000.f, -(float)i / 8.f);
            const float ang = (float)pos * inv_freq;
            ROPE[e] = cosf(ang); ROPE[512 + e] = sinf(ang);
        }
    }
    {
        bf16_t* CCKV = (bf16_t*)(ws_b + WS_CCKV);
        for (size_t e = gt; e < (size_t)NL * 1024 * 256; e += ngt) {
            const int c = (int)(e & 255), i = (int)((e >> 8) & 511), b = (int)((e >> 17) & 1), l = (int)(e >> 18);
            CCKV[e] = f2bf(pin(p, 2)[((size_t)(b * 4 + l) * 512 + i) * 256 + c]);
        }
        bf16_t* CKR = (bf16_t*)(ws_b + WS_CKR);
        for (size_t e = gt; e < (size_t)NL * 1024 * 32; e += ngt) {
            const int c = (int)(e & 31), i = (int)((e >> 5) & 511), b = (int)((e >> 14) & 1), l = (int)(e >> 15);
            CKR[e] = f2bf(pin(p, 3)[((size_t)(b * 4 + l) * 512 + i) * 32 + c]);
        }
        bf16_t* CNAK = (bf16_t*)(ws_b + WS_CNAK);
        for (size_t e = gt; e < (size_t)NL * 1024 * 512; e += ngt) {
            const int c = (int)(e & 511), i = (int)((e >> 9) & 511), b = (int)((e >> 18) & 1), l = (int)(e >> 19);
            CNAK[e] = f2bf(pin(p, 4)[((size_t)(b * 4 + l) * 512 + i) * 512 + c]);
        }
        bf16_t* CNAVT = (bf16_t*)(ws_b + WS_CNAVT);
        for (size_t e = gt; e < (size_t)NL * 1024 * 512; e += ngt) {
            const int key = (int)(e & 511), hd = (int)((e >> 9) & 511), b = (int)((e >> 18) & 1), l = (int)(e >> 19);
            CNAVT[e] = f2bf(pin(p, 5)[((size_t)(b * 4 + l) * 512 + key) * 512 + hd]);
        }
    }
}

DEVI void phase_modreduce(const P& p, unsigned char* ws_b, int tid) {
    const float* MODP = (const float*)(ws_b + WS_MODP);
    float* MOD = (float*)(ws_b + WS_MOD);
    for (int e = blockIdx.x * NTHREADS + tid; e < NL * 3 * 9216; e += gridDim.x * NTHREADS) {
        const int l = e / (3 * 9216), rem = e % (3 * 9216);
        float a = pin(p, 9)[l * 9216 + (rem % 9216)];
#pragma unroll
        for (int kc = 0; kc < 16; ++kc) a += MODP[((size_t)(l * 16 + kc) * 3) * 9216 + rem];
        MOD[e] = a;
    }
}

#define XB_TMO      128
#define XB_XCNT(j)  (256  + 64 * (j))
#define XB_XSUB(j)  (1280 + 64 * (j))
#define XB_XGEN(j)  (2304 + 64 * (j))
#define XB_TOP      3328
#define XB_TOPGEN   3392
#define XCD_BAR_WORDS 3456
#define XB_SPIN_CAP (1u << 20)
#define LAS __attribute__((address_space(3)))
DEVI unsigned xb_ld(unsigned* p)              { return __hip_atomic_load(p, __ATOMIC_RELAXED, __HIP_MEMORY_SCOPE_AGENT); }
DEVI unsigned xb_add(unsigned* p, unsigned v) { return __hip_atomic_fetch_add(p, v, __ATOMIC_RELAXED, __HIP_MEMORY_SCOPE_AGENT); }
DEVI unsigned xb_xcc_id() { return (unsigned)__builtin_amdgcn_s_getreg((3 << 11) | 20) & 0xFu; }
#define XB_SPIN(cond, bar) do { unsigned _sp = 0; while (cond) { __builtin_amdgcn_s_sleep(1); \
    if ((++_sp & 255u) == 0u) { if (xb_ld(&(bar)[XB_TMO])) break; if (_sp > XB_SPIN_CAP) { atomicAdd(&(bar)[XB_TMO], 1u); break; } } } } while (0)
struct XcdBarrier { unsigned* bar; unsigned x; volatile LAS unsigned* st; };
DEVI XcdBarrier xcd_barrier_post(unsigned* bar, volatile LAS unsigned* st) {
    XcdBarrier b; b.bar = bar; b.x = xb_xcc_id(); b.st = st;
    if (threadIdx.x == 0) (void)xb_add(&bar[XB_XCNT(b.x)], 1u);
    return b;
}
DEVI void xcd_barrier_complete(unsigned* bar, unsigned x, unsigned& nloc, unsigned& nx) {
    const unsigned G = gridDim.x * gridDim.y * gridDim.z;
    unsigned sum, cnt, mine, sp = 0u;
    for (;;) {
        sum = 0u; cnt = 0u; mine = 0u;
#pragma unroll
        for (unsigned j = 0; j < 16; ++j) { const unsigned c = xb_ld(&bar[XB_XCNT(j)]); sum += c; cnt += (c > 0u) ? 1u : 0u; mine = (j == x) ? c : mine; }
        if (sum == G) break;
        __builtin_amdgcn_s_sleep(1);
        if ((++sp & 255u) == 0u) { if (xb_ld(&bar[XB_TMO])) break; if (sp > XB_SPIN_CAP) { atomicAdd(&bar[XB_TMO], 1u); break; } }
    }
    nloc = mine > 0u ? mine : 1u; nx = cnt > 0u ? cnt : 1u;
}
DEVI void xcd_barrier(const XcdBarrier& b) {
    asm volatile("s_waitcnt vmcnt(0)" ::: "memory");
    __syncthreads();
    if (threadIdx.x == 0) {
        unsigned* bar = b.bar;
        __builtin_amdgcn_s_waitcnt(0);
        unsigned nloc = b.st[0], nx = b.st[1];
        if (nloc == 0u) { xcd_barrier_complete(bar, b.x, nloc, nx); b.st[0] = nloc; b.st[1] = nx; }
        const unsigned old = xb_add(&bar[XB_XSUB(b.x)], 1u);
        const unsigned gen = old / nloc;
        if (old + 1u == (gen + 1u) * nloc) {
            __builtin_amdgcn_fence(__ATOMIC_RELEASE, "agent");
            asm volatile("s_waitcnt vmcnt(0)" ::: "memory");
            const unsigned og = xb_add(&bar[XB_TOP], 1u);
            const unsigned tg = og / nx;
            if (og + 1u == (tg + 1u) * nx) xb_add(&bar[XB_TOPGEN], 1u);
            else XB_SPIN(xb_ld(&bar[XB_TOPGEN]) == tg, bar);
            __builtin_amdgcn_fence(__ATOMIC_ACQUIRE, "agent");
            xb_add(&bar[XB_XGEN(b.x)], 1u);
            asm volatile("s_waitcnt vmcnt(0)" ::: "memory");
        } else {
            XB_SPIN(xb_ld(&bar[XB_XGEN(b.x)]) == gen, bar);
            __builtin_amdgcn_fence(__ATOMIC_ACQUIRE, "agent");
            asm volatile("s_waitcnt vmcnt(0)" ::: "memory");
        }
    }
    __syncthreads();
}

DEVI void run_phase(const P& p, unsigned char* ws_b, int ph, unsigned char* smem, int tid) {
    const int lane = tid & 63, wave = tid >> 6;
    const int gw = blockIdx.x * NWAVES + wave, ngw = gridDim.x * NWAVES;
    const int nb = gridDim.x, bid = blockIdx.x;
    const int grp = tid >> 8, ltid = tid & 255;
    bf16_t* sm = (bf16_t*)smem + grp * (SMEM_BYTES / 2);
    if (ph == 0) { phase_prep(p, ws_b, smem, tid); return; }
    if (ph == 1) { phase_modreduce(p, ws_b, tid); return; }
    if (ph == 2) { phase_rows(p, ws_b, 0, -1, 0, 0, false, gw, ngw, lane); return; }
    const int l = (ph - 3) / 13, s = (ph - 3) % 13;
    const bf16_t* Wl = (const bf16_t*)(ws_b + WS_W) + (size_t)l * LAYER_W;
    const float* MODl = (const float*)(ws_b + WS_MOD) + (size_t)l * 3 * 9216;
    switch (s) {
    case 0: case 10:
        {
            pg8::Gemm g{(const bf16_t*)(ws_b + WS_H), Wl + (s == 10 ? OFF_W13_2 : OFF_W13_1), M, 2 * DFF, D};
            pg8::StaticOrder S; S.init(M, 2 * DFF, nb, bid);
            pg8::EpiSwiGLU E{(bf16_t*)(ws_b + WS_ACT)};
            pg8::gemm_phase<pg8::EpiSwiGLU, pg8::StaticOrder, true, true>((PG8_LAS unsigned char*)smem, g, S, E, tid);
        }
        break;
    case 1: case 11:
        {
            pg8::Gemm g{(const bf16_t*)(ws_b + WS_ACT), Wl + (s == 11 ? OFF_W2_2 : OFF_W2_1), M, D, DFF};
            pg8::StaticOrder S; S.init(M, D, nb, bid);
            pg8::EpiResid E{(float*)(ws_b + WS_X), MODl + (s == 11 ? 8 : 2) * D, 0.5f};
            pg8::gemm_phase<pg8::EpiResid, pg8::StaticOrder, false, true>((PG8_LAS unsigned char*)smem, g, S, E, tid);
        }
        break;
    case 2: phase_rows(p, ws_b, l, 0, l, 3, false, gw, ngw, lane); break;
    case 3:
        {
            pg8::Gemm g{(const bf16_t*)(ws_b + WS_H), Wl + OFF_WIN, M, 5888, D};
            pg8::StaticOrder S; S.init(M, 5888, nb, bid);
            pg8::EpiIn E{ws_b, p.out, pin(p, 26), l};
            pg8::gemm_phase<pg8::EpiIn, pg8::StaticOrder, true, true>((PG8_LAS unsigned char*)smem, g, S, E, tid);
        }
        break;
    case 4: phase_rowmix(p, ws_b, l, gw, ngw, lane); break;
    case 5: {
        float* ex = (float*)smem + (wave & 3) * (34 * 64);
        int u = bid;
        for (; u < 256; u += nb) {
            const int wi = u * 4 + (wave & 3);
            attn_na_lat(p, ws_b, l, wi >> 9, (wi >> 6) & 7, (wi >> 1) & 31, wi & 1, lane, ex, wave >> 2);
        }
        for (; u < 256 + 416; u += nb) job_ukv(p, ws_b, l, 2 * (u - 256) + grp, sm, ltid);
        for (; u < 256 + 416 + 288; u += nb) job_uq(p, ws_b, l, 2 * (u - 256 - 416) + grp, sm, ltid);
        for (; u < 256 + 416 + 288 + 384; u += nb) job_f1(p, ws_b, 2 * (u - 256 - 416 - 288) + grp, sm, ltid);
        for (; u < 256 + 416 + 288 + 384 + 256; u += nb) {
            const int wi = (u - 256 - 416 - 288 - 384) * 8 + wave;
            attn_na_ctx(p, ws_b, wi >> 6, (wi >> 3) & 7, wi & 7, lane);
        }
    } break;
    case 6: {
        float* ex = (float*)smem + (wave & 3) * (34 * 64);
        int u = bid;
        for (; u < 256; u += nb) {
            const int wi = u * 4 + (wave & 3);
            attn_mla(p, ws_b, l, true, wi >> 9, (wi >> 6) & 7, wi & 63, lane, ex, wave >> 2);
        }
        for (; u < 256 + 128; u += nb) job_f2_lat(p, ws_b, u - 256, sm, ltid, grp, (float*)(smem + SMEM_BYTES));
        for (; u < 256 + 128 + 128; u += nb) job_f2_ctx(p, ws_b, 2 * (u - 256 - 128) + grp, sm, ltid);
        for (; u < 256 + 128 + 128 + 256; u += nb) {
            const int wi = (u - 256 - 128 - 128) * 8 + wave;
            attn_mla(p, ws_b, l, false, wi >> 6, (wi >> 3) & 7, wi & 7, lane);
        }
    } break;
    case 7:

#pragma nounroll
        for (int sg = 0; sg < 3; ++sg) {
            int tid3 = tid; asm volatile("" : "+v"(tid3));
            pg8::Gemm g{(const bf16_t*)(ws_b + (sg == 0 ? WS_YF : (sg == 1 ? WS_YM : WS_YN))), Wl + (sg == 0 ? OFF_WBF : (sg == 1 ? OFF_WBM : OFF_WBN)), M, D, 512};
            pg8::StaticOrder S; S.init(M, D, nb, bid);
            pg8::EpiMerge E{(const bf16_t*)(ws_b + WS_GATE), (bf16_t*)(ws_b + WS_UF)  , (bf16_t*)(ws_b + WS_MERGED), sg};
            pg8::gemm_phase<pg8::EpiMerge, pg8::StaticOrder, false, true>((PG8_LAS unsigned char*)smem, g, S, E, tid3);
        }
        break;
    case 8:
        {
            pg8::Gemm g{(const bf16_t*)(ws_b + WS_MERGED), Wl + OFF_WOUT, M, D, D};
            pg8::StaticOrder S; S.init(M, D, nb, bid);
            pg8::EpiResid E{(float*)(ws_b + WS_X), MODl + 5 * D, 1.0f};
            pg8::gemm_phase<pg8::EpiResid, pg8::StaticOrder, false, true>((PG8_LAS unsigned char*)smem, g, S, E, tid);
        }
        break;
    case 9: phase_rows(p, ws_b, l, 1, l, 6, false, gw, ngw, lane); break;
    case 12:
        if (l == NL - 1) phase_rows(p, ws_b, l, 2, 0, 0, true, gw, ngw, lane);
        else phase_rows(p, ws_b, l, 2, l + 1, 0, false, gw, ngw, lane);
        break;
    default: break;
    }
}

__global__ void __launch_bounds__(NTHREADS, 2) mega_kernel(P p) {
    extern __shared__ __attribute__((aligned(16))) unsigned char smem[];
    __shared__ uint4 xb_words;
    cg::grid_group grid = cg::this_grid();
    const int tid = threadIdx.x;
    unsigned* bar = (unsigned*)(p.ws + WS_BAR);
    if (tid == 0) xb_words = make_uint4(0u, 0u, 0u, 0u);
    if (p.ph_lo == 0 && blockIdx.x == 0) for (int i = tid; i < XCD_BAR_WORDS; i += NTHREADS) bar[i] = 0u;
    __syncthreads();
    XcdBarrier xb; xb.bar = bar; xb.x = 0; xb.st = (volatile LAS unsigned*)&xb_words;
#pragma nounroll
    for (int ph = p.ph_lo; ph < p.ph_hi; ++ph) {
        int tid2 = tid; asm volatile("" : "+v"(tid2));
        unsigned char* ws_b = p.ws; asm volatile("" : "+s"(ws_b));
        run_phase(p, ws_b, ph, smem, tid2);
        if (ph + 1 < p.ph_hi) {
            if (ph == p.ph_lo) { grid.sync(); xb = xcd_barrier_post(bar, (volatile LAS unsigned*)&xb_words); }
            else xcd_barrier(xb);
        }
    }
}

extern "C" void kernel_launch(void* const* d_in, const int* in_sizes, int n_in, void* d_out, int out_size, void* d_ws, size_t ws_size,
                              hipStream_t stream) {
    static int grid_blocks = 0;
    if (grid_blocks == 0) {
        if (n_in != 30 || ws_size < WS_END) { fprintf(stderr, "kernel_launch: n_in %d ws %zu need %zu\n", n_in, ws_size, (size_t)WS_END); grid_blocks = -1; return; }
        int dev = 0, cus = 0, per_cu = 0;
        hipGetDevice(&dev);
        hipDeviceGetAttribute(&cus, hipDeviceAttributeMultiprocessorCount, dev);
        hipFuncSetAttribute((const void*)mega_kernel, hipFuncAttributeMaxDynamicSharedMemorySize, LDS_TOTAL);
        hipOccupancyMaxActiveBlocksPerMultiprocessor(&per_cu, (const void*)mega_kernel, NTHREADS, LDS_TOTAL);
        if (per_cu < 1) per_cu = 1;
        if (per_cu > 1) per_cu = 1;
        grid_blocks = cus * per_cu;
    }
    if (grid_blocks < 0) return;
    P p{};
    for (int i = 0; i < 30; ++i) p.in[i] = (const float*)d_in[i];
    p.out = (float*)d_out; p.ws = (unsigned char*)d_ws; p.ph_lo = 0; p.ph_hi = NPHASE;
#ifndef MULTI_LAUNCH
#define MULTI_LAUNCH 0
#endif
#if MULTI_LAUNCH
    for (int ph = 0; ph < NPHASE; ++ph) {
        p.ph_lo = ph; p.ph_hi = ph + 1;
        hipLaunchKernelGGL(mega_kernel, dim3(grid_blocks), dim3(NTHREADS), LDS_TOTAL, stream, p);
    }
#else
    void* args[] = {&p};
    hipError_t e = hipLaunchCooperativeKernel((const void*)mega_kernel, dim3(grid_blocks), dim3(NTHREADS), args, LDS_TOTAL, stream);
    if (e != hipSuccess) fprintf(stderr, "cooperative launch failed: %s (grid %d)\n", hipGetErrorString(e), grid_blocks);
#endif
}
```

```cpp
#include <hip/hip_runtime.h>
#include <hip/hip_cooperative_groups.h>
#include <cstdint>
#include <cstdio>
namespace cg = cooperative_groups;

typedef unsigned short bf16_t;
typedef short bf16x8 __attribute__((ext_vector_type(8)));
typedef float f32x16 __attribute__((ext_vector_type(16)));
typedef float f32x4 __attribute__((ext_vector_type(4)));
typedef unsigned u32x4 __attribute__((ext_vector_type(4)));
typedef unsigned u32x2 __attribute__((ext_vector_type(2)));
#define DEVI __device__ __forceinline__

constexpr int D = 1024, NCTX = 8192, NLAT = 4096, M = 12288, MX = 13312, DFF = 2816, NL = 4;
constexpr float ALPHA_F = 1.6817928305074290f;
constexpr float LOG2E = 1.4426950408889634f;
constexpr float MLA_QS = 0.10206207261596575f * LOG2E;
constexpr float NA_QS = 0.125f * LOG2E;
constexpr size_t OUT_CKV = 12582912, OUT_KR = 20971520, OUT_NAK = 22020096, OUT_NAV = 38797312;

constexpr size_t al256(size_t x) { return (x + 255) & ~(size_t)255; }
constexpr size_t WS_BAR = 0;
constexpr size_t WS_X = 16384;
constexpr size_t WS_H = WS_X + (size_t)M * D * 4;
constexpr size_t WS_MOD = WS_H + (size_t)M * D * 2;
constexpr size_t WS_MODP = WS_MOD + al256((size_t)NL * 3 * 9216 * 4);
constexpr size_t WS_ROPE = WS_MODP + al256((size_t)NL * 16 * 3 * 9216 * 4);
constexpr size_t WS_TABC = WS_ROPE + 4096;
constexpr size_t WS_TABL = WS_TABC + (size_t)256 * 512 * 2;
constexpr size_t WS_WCS = WS_TABL + (size_t)2048 * 4096 * 2;
constexpr size_t WS_CCKV = WS_WCS + (size_t)256 * 128 * 2;
constexpr size_t WS_CKR = WS_CCKV + (size_t)NL * 1024 * 256 * 2;
constexpr size_t WS_CNAK = WS_CKR + (size_t)NL * 1024 * 32 * 2;
constexpr size_t WS_CNAVT = WS_CNAK + (size_t)NL * 1024 * 512 * 2;
constexpr size_t WS_W = WS_CNAVT + (size_t)NL * 1024 * 512 * 2;
constexpr size_t OFF_W13_1 = 0, OFF_W2_1 = 5767168, OFF_W13_2 = 8650752, OFF_W2_2 = 14417920, OFF_WIN = 17301504,
                 OFF_WOUT = 23330816, OFF_WBF = 24379392, OFF_WBM = 24903680, OFF_WBN = 25427968, OFF_WUQ = 25952256,
                 OFF_WUKV = 26247168, LAYER_W = 26509312;
constexpr size_t WS_R1 = WS_W + (size_t)NL * LAYER_W * 2;
constexpr size_t WS_ACT = WS_R1;
constexpr size_t WS_UF = WS_R1;
constexpr size_t WS_UQ = WS_UF + (size_t)M * 512 * 2;
constexpr size_t WS_UKV = WS_UQ + (size_t)M * 384 * 2;
constexpr size_t WS_KRF = WS_UKV + (size_t)M * 256 * 4;
constexpr size_t WS_CKV = WS_KRF + (size_t)M * 32 * 4;
constexpr size_t WS_KR = WS_CKV + (size_t)M * 256 * 2;
constexpr size_t WS_NAQ = WS_KR + (size_t)M * 32 * 2;
constexpr size_t WS_NAK = WS_NAQ + (size_t)M * 512 * 2;
constexpr size_t WS_NAVT = WS_NAK + (size_t)M * 512 * 2;
constexpr size_t WS_GATE = WS_NAVT + (size_t)M * 512 * 2;
constexpr size_t WS_Q = WS_GATE + (size_t)M * 3072 * 2;
constexpr size_t WS_KN = WS_Q + (size_t)M * 768 * 2;
constexpr size_t WS_VTM = WS_KN + (size_t)MX * 512 * 2;
constexpr size_t WS_F1T = WS_VTM + (size_t)MX * 512 * 2;
constexpr size_t WS_YF = WS_F1T + (size_t)M * 1024 * 2;
constexpr size_t WS_YM = WS_YF + (size_t)M * 512 * 2;
constexpr size_t WS_YN = WS_YM + (size_t)M * 512 * 2;
constexpr size_t WS_MERGED = WS_YN + (size_t)M * 512 * 2;
constexpr size_t WS_END = WS_MERGED + (size_t)M * 1024 * 2;
static_assert(WS_END - WS_R1 >= (size_t)M * DFF * 2, "ACT must fit in R1");
static_assert(WS_NAK - WS_UF >= (size_t)M * D * 4, "merge T32 must fit in the dead UF..NAQ buffers");

constexpr int NPHASE = 3 + 13 * NL;

struct P {
    const float* in[30];
    float* out;
    unsigned char* ws;
    int ph_lo, ph_hi;
};

__device__ __forceinline__ const float* pin(const P& p, int i) { int j = i; asm volatile("" : "+s"(j)); return p.in[j]; }
typedef __bf16 bf16v2 __attribute__((ext_vector_type(2)));
typedef float f32x2 __attribute__((ext_vector_type(2)));
DEVI unsigned pk2(float lo, float hi) { f32x2 v = {lo, hi}; bf16v2 b = __builtin_convertvector(v, bf16v2); return __builtin_bit_cast(unsigned, b); }
DEVI bf16_t f2bf(float x) { return (bf16_t)(pk2(x, 0.f) & 0xffffu); }
DEVI float bf2f(unsigned v) { return __uint_as_float(v << 16); }
DEVI float wave_sum(float v) {
#pragma unroll
    for (int o = 1; o < 64; o <<= 1) v += __shfl_xor(v, o);
    return v;
}
DEVI float fast_exp2(float x) { return __builtin_amdgcn_exp2f(x); }
DEVI float sigmoidf_(float x) { return 1.f / (1.f + __expf(-x)); }

constexpr int LDT = 72;
constexpr int TILE_E = 128 * LDT;
constexpr int SMEM_BYTES = 4 * TILE_E * 2;
constexpr int NTHREADS = 512, NWAVES = 8, LDS_TOTAL = 2 * SMEM_BYTES;

DEVI void gemm_ldg(const bf16_t* ga, const bf16_t* gb, int lda, int ldb, u32x4 (&ra)[4], u32x4 (&rb)[4]) {
#pragma unroll
    for (int i = 0; i < 4; ++i) {
        ra[i] = *(const u32x4*)(ga + (size_t)(32 * i) * lda);
        rb[i] = *(const u32x4*)(gb + (size_t)(32 * i) * ldb);
    }
}
DEVI void gemm_sts(bf16_t* buf, int soff, const u32x4 (&ra)[4], const u32x4 (&rb)[4]) {
#pragma unroll
    for (int i = 0; i < 4; ++i) {
        *(u32x4*)(buf + soff + 32 * i * LDT) = ra[i];
        *(u32x4*)(buf + TILE_E + soff + 32 * i * LDT) = rb[i];
    }
}
DEVI void gemm_mma(const bf16_t* cur, int aoff, int boff, f32x16 (&acc)[2][2]) {
#pragma unroll
    for (int ks = 0; ks < 4; ++ks) {
        bf16x8 a0 = *(const bf16x8*)(cur + aoff + ks * 16);
        bf16x8 a1 = *(const bf16x8*)(cur + aoff + 32 * LDT + ks * 16);
        bf16x8 b0 = *(const bf16x8*)(cur + boff + ks * 16);
        bf16x8 b1 = *(const bf16x8*)(cur + boff + 32 * LDT + ks * 16);
        acc[0][0] = __builtin_amdgcn_mfma_f32_32x32x16_bf16(a0, b0, acc[0][0], 0, 0, 0);
        acc[0][1] = __builtin_amdgcn_mfma_f32_32x32x16_bf16(a0, b1, acc[0][1], 0, 0, 0);
        acc[1][0] = __builtin_amdgcn_mfma_f32_32x32x16_bf16(a1, b0, acc[1][0], 0, 0, 0);
        acc[1][1] = __builtin_amdgcn_mfma_f32_32x32x16_bf16(a1, b1, acc[1][1], 0, 0, 0);
    }
}

template <bool DEEP = true>
DEVI void gemm_core(const bf16_t* __restrict__ A, int lda, const bf16_t* __restrict__ B, int ldb, int K,
                    f32x16 (&acc)[2][2], bf16_t* smem, int tid) {
    const int lane = tid & 63, wave = tid >> 6, wr = wave >> 1, wc = wave & 1;
    const int lr = tid >> 3, lc = (tid & 7) * 8;
    const bf16_t* ga = A + (size_t)lr * lda + lc;
    const bf16_t* gb = B + (size_t)lr * ldb + lc;
    const int soff = lr * LDT + lc;
    const int nk = K >> 6;
    const int aoff = (wr * 64 + (lane & 31)) * LDT + (lane >> 5) * 8;
    const int boff = TILE_E + (wc * 64 + (lane & 31)) * LDT + (lane >> 5) * 8;
    bf16_t* buf0 = smem; bf16_t* buf1 = smem + 2 * TILE_E;
    if constexpr (DEEP) {
        u32x4 ra0[4], rb0[4], ra1[4], rb1[4];
        gemm_ldg(ga, gb, lda, ldb, ra0, rb0);
        gemm_ldg(ga + 64, gb + 64, lda, ldb, ra1, rb1);
        gemm_sts(buf0, soff, ra0, rb0);
        __syncthreads();
        for (int kt = 0; kt < nk; kt += 2) {
            if (kt + 2 < nk) gemm_ldg(ga + (size_t)(kt + 2) * 64, gb + (size_t)(kt + 2) * 64, lda, ldb, ra0, rb0);
            gemm_mma(buf0, aoff, boff, acc);
            gemm_sts(buf1, soff, ra1, rb1);
            __syncthreads();
            if (kt + 3 < nk) gemm_ldg(ga + (size_t)(kt + 3) * 64, gb + (size_t)(kt + 3) * 64, lda, ldb, ra1, rb1);
            gemm_mma(buf1, aoff, boff, acc);
            if (kt + 2 < nk) gemm_sts(buf0, soff, ra0, rb0);
            __syncthreads();
        }
    } else {
        u32x4 ra[4], rb[4];
        gemm_ldg(ga, gb, lda, ldb, ra, rb);
        gemm_sts(buf0, soff, ra, rb);
        __syncthreads();
        for (int kt = 0; kt < nk; ++kt) {
            bf16_t* cur = (kt & 1) ? buf1 : buf0;
            bf16_t* nxt = (kt & 1) ? buf0 : buf1;
            const bool more = (kt + 1 < nk);
            if (more) { ga += 64; gb += 64; gemm_ldg(ga, gb, lda, ldb, ra, rb); }
            gemm_mma(cur, aoff, boff, acc);
            if (more) gemm_sts(nxt, soff, ra, rb);
            __syncthreads();
        }
    }
}

DEVI void zero_acc(f32x16 (&acc)[2][2]) {
#pragma unroll
    for (int i = 0; i < 2; ++i)
#pragma unroll
        for (int j = 0; j < 2; ++j)
#pragma unroll
            for (int r = 0; r < 16; ++r) acc[i][j][r] = 0.f;
}

#define EPI_SETUP const int lane = tid & 63, wave = tid >> 6, wr = wave >> 1, wc = wave & 1, hl = lane >> 5, c32 = lane & 31; (void)wr; (void)wc; (void)hl; (void)c32;

DEVI int mod_group(int row) { return row < NCTX ? 0 : 1 + ((row - NCTX) >> 11); }

namespace pg8 {
#define PG8_LAS __attribute__((address_space(3)))
constexpr int BM = 256, BK = 64, HALF = 128, HTB = HALF * BK * 2, NXCD = 8, WGM = 8;
DEVI int lds_byte(int r, int c) { const int st = (r >> 4) * 2 + (c >> 5), rr = r & 15, cc = c & 31, ob = rr * 64 + cc * 2; return st * 1024 + (ob ^ (((ob >> 9) & 1) << 5)); }
DEVI void stage_rc(int b, int& R, int& C) { const int st = b / 1024, sb = b % 1024, swz = sb ^ (((sb >> 9) & 1) << 5); R = (st >> 1) * 16 + swz / 64; C = (st & 1) * 32 + (swz % 64) / 2; }
DEVI int perm32(int rho) { const int n = rho >> 4, i = rho & 15; return 8 * (i >> 2) + 4 * n + (i & 3); }
struct Unit { int pm, pn; };
struct Gemm { const bf16_t* A; const bf16_t* Bt; int M, N, K; };
struct StaticOrder {
    int nM, nN, nwg, G, c;
    DEVI void init(int M, int N, int G_, int c_) { nM = M / BM; nN = N / BM; nwg = nM * nN; G = G_; c = c_; }
    DEVI bool next(int i, Unit& u) const {
        const long L = (long)i * G + c; if (L >= nwg) return false;
        int wgid = (int)L; { const int q = nwg / NXCD, r = nwg % NXCD, xcd = wgid % NXCD, off = wgid / NXCD; wgid = (xcd < r ? xcd * (q + 1) : r * (q + 1) + (xcd - r) * q) + off; }
        const int nig = WGM * nN, gid = wgid / nig, fm = gid * WGM, gsz = (nM - fm) < WGM ? (nM - fm) : WGM;
        u.pm = fm + ((wgid % nig) % gsz); u.pn = (wgid % nig) / gsz; return true;
    }
    DEVI void a_ready(const Unit&) const {}
    DEVI void done(const Unit&) const {}
};
template <class Epi, class Sched, bool ALIGN_EPI = false, bool SP2 = false>
DEVI void gemm_phase(PG8_LAS unsigned char* lds, const Gemm g, const Sched& S, const Epi& E, const int tid) {
    const int wid = __builtin_amdgcn_readfirstlane(tid >> 6), lane = tid & 63, wr = wid >> 2, wc = wid & 3, fr = lane & 15, fq = lane >> 4;
    const int K = g.K, nt = K / BK;
    unsigned voffA[2], voffB[2];
#pragma unroll
    for (int i = 0; i < 2; ++i) { int R, C; stage_rc(tid * 16 + i * 8192, R, C); const int Rb = Epi::PERM ? ((R & ~31) + perm32(R & 31)) : R;
        voffA[i] = (unsigned)(R * K + C) * 2u; voffB[i] = (unsigned)(Rb * K + C) * 2u; }
    const size_t kstep = (size_t)(BK * 2);
    const size_t hstep = (size_t)HALF * K * 2;
    const size_t tstep = 2 * hstep;
    const unsigned ldsw = (unsigned)wid * 1024u;
    const int aoff = lds_byte(wr * 64 + fr, fq * 8), boff = lds_byte(wc * 32 + fr, fq * 8);
#define PG8_SA(b, h) (((b) * 2 + (h)) * HTB)
#define PG8_SB(b, h) ((4 + (b) * 2 + (h)) * HTB)
#define PG8_STAGE(bufoff, gbase, voff) do { _Pragma("unroll") for (int _i = 0; _i < 2; ++_i) \
        __builtin_amdgcn_global_load_lds((const unsigned*)((const char*)(gbase) + (voff)[_i]), (PG8_LAS unsigned*)(lds + (bufoff) + ldsw + _i * 8192), 16, 0, 0); } while (0)
#define PG8_LDA(dst, b, h) do { _Pragma("unroll") for (int m = 0; m < 4; ++m) _Pragma("unroll") for (int k = 0; k < 2; ++k) dst[m][k] = *(const PG8_LAS bf16x8*)(lds + PG8_SA(b, h) + aoff + m * 2048 + k * 1024); } while (0)
#define PG8_LDB(dst, b, h) do { _Pragma("unroll") for (int n = 0; n < 2; ++n) _Pragma("unroll") for (int k = 0; k < 2; ++k) dst[n][k] = *(const PG8_LAS bf16x8*)(lds + PG8_SB(b, h) + boff + n * 2048 + k * 1024); } while (0)
#define PG8_MMA(ai, bj, At, Bt) do { __builtin_amdgcn_s_setprio(1); _Pragma("unroll") for (int m = 0; m < 4; ++m) _Pragma("unroll") for (int n = 0; n < 2; ++n) _Pragma("unroll") for (int k = 0; k < 2; ++k) \
        acc[ai][bj][m][n] = __builtin_amdgcn_mfma_f32_16x16x32_bf16(Bt[n][k], At[m][k], acc[ai][bj][m][n], 0, 0, 0); __builtin_amdgcn_s_setprio(0); } while (0)
#define PG8_WAIT_V(n) asm volatile("s_waitcnt vmcnt(" #n ")" ::: "memory")
#define PG8_WAIT_L(n) asm volatile("s_waitcnt lgkmcnt(" #n ")" ::: "memory")
#define PG8_BAR __builtin_amdgcn_s_barrier()
#define PG8_SCHED __builtin_amdgcn_sched_barrier(0)
    Unit cur, nxt; int ui = 0;
    if (!S.next(0, cur)) return;
    f32x4 acc[2][2][4][2];
#pragma unroll
    for (int a = 0; a < 2; ++a)
#pragma unroll
        for (int b = 0; b < 2; ++b)
#pragma unroll
            for (int m = 0; m < 4; ++m)
#pragma unroll
                for (int n = 0; n < 2; ++n) acc[a][b][m][n] = (f32x4){0.f, 0.f, 0.f, 0.f};
    bf16x8 At[4][2], B0[2][2], B1[2][2];
    const char* cA = (const char*)g.A + (size_t)cur.pm * tstep; const char* cB = (const char*)g.Bt + (size_t)cur.pn * tstep;
    S.a_ready(cur);
    if constexpr (SP2) {
        PG8_STAGE(PG8_SB(0, 0), cB, voffB); PG8_STAGE(PG8_SB(0, 1), cB + hstep, voffB); PG8_STAGE(PG8_SA(0, 0), cA, voffA); PG8_STAGE(PG8_SA(0, 1), cA + hstep, voffA);
        if (wr == 1) PG8_BAR;
        PG8_WAIT_V(2); PG8_BAR;
        PG8_STAGE(PG8_SB(1, 0), cB + kstep, voffB); PG8_STAGE(PG8_SA(1, 0), cA + kstep, voffA); PG8_STAGE(PG8_SB(1, 1), cB + hstep + kstep, voffB);
        PG8_WAIT_V(6); PG8_BAR;
    } else {
        PG8_STAGE(PG8_SB(0, 0), cB, voffB); PG8_STAGE(PG8_SA(0, 0), cA, voffA); PG8_STAGE(PG8_SB(0, 1), cB + hstep, voffB); PG8_STAGE(PG8_SA(0, 1), cA + hstep, voffA);
        if (wr == 1) PG8_BAR;
        PG8_WAIT_V(4); PG8_BAR;
        PG8_STAGE(PG8_SB(1, 0), cB + kstep, voffB); PG8_STAGE(PG8_SA(1, 0), cA + kstep, voffA); PG8_STAGE(PG8_SB(1, 1), cB + hstep + kstep, voffB);
        PG8_WAIT_V(6); PG8_BAR;
    }
    for (;;) {
        const bool has_next = S.next(ui + 1, nxt);
        const char* nA = has_next ? (const char*)g.A + (size_t)nxt.pm * tstep : cA; const char* nB = has_next ? (const char*)g.Bt + (size_t)nxt.pn * tstep : cB;
        for (int t = 0; t < nt; t += 2) {
            const bool last = (t == nt - 2);
            const char* a1 = cA + (size_t)(t + 1) * kstep;
            const char* a2 = last ? nA : cA + (size_t)(t + 2) * kstep; const char* b2 = last ? nB : cB + (size_t)(t + 2) * kstep;
            const char* a3 = a2 + kstep; const char* b3 = b2 + kstep;
            if (last && has_next) S.a_ready(nxt);
            if constexpr (SP2) {
            PG8_LDB(B0, 0, 0); PG8_LDB(B1, 0, 1); PG8_SCHED; PG8_LDA(At, 0, 0); PG8_STAGE(PG8_SA(1, 1), a1 + hstep, voffA);
            PG8_WAIT_V(8); PG8_WAIT_L(0); PG8_BAR; PG8_MMA(0, 0, At, B0); PG8_MMA(0, 1, At, B1); PG8_BAR; PG8_SCHED;
            PG8_LDA(At, 0, 1); PG8_STAGE(PG8_SB(0, 0), b2, voffB); PG8_STAGE(PG8_SB(0, 1), b2 + hstep, voffB); PG8_STAGE(PG8_SA(0, 0), a2, voffA);
            PG8_WAIT_V(8); PG8_WAIT_L(0); PG8_BAR; PG8_MMA(1, 0, At, B0); PG8_MMA(1, 1, At, B1); PG8_BAR; PG8_SCHED;
            PG8_LDB(B0, 1, 0); PG8_LDB(B1, 1, 1); PG8_SCHED; PG8_LDA(At, 1, 0); PG8_STAGE(PG8_SA(0, 1), a2 + hstep, voffA);
            PG8_WAIT_V(8); PG8_WAIT_L(0); PG8_BAR; PG8_MMA(0, 0, At, B0); PG8_MMA(0, 1, At, B1); PG8_BAR; PG8_SCHED;
            PG8_LDA(At, 1, 1); PG8_STAGE(PG8_SB(1, 0), b3, voffB); PG8_STAGE(PG8_SB(1, 1), b3 + hstep, voffB); PG8_STAGE(PG8_SA(1, 0), a3, voffA);
            PG8_WAIT_V(8); PG8_WAIT_L(0); PG8_BAR; PG8_MMA(1, 0, At, B0); PG8_MMA(1, 1, At, B1); PG8_BAR; PG8_SCHED;
            } else {
            PG8_LDB(B0, 0, 0); PG8_SCHED; PG8_LDA(At, 0, 0); PG8_STAGE(PG8_SA(1, 1), a1 + hstep, voffA);
            PG8_WAIT_L(8); PG8_BAR; PG8_WAIT_L(0); PG8_MMA(0, 0, At, B0); PG8_BAR; PG8_SCHED;
            PG8_LDB(B1, 0, 1); PG8_STAGE(PG8_SB(0, 0), b2, voffB);
            PG8_BAR; PG8_WAIT_L(0); PG8_MMA(0, 1, At, B1); PG8_BAR;
            PG8_LDA(At, 0, 1); PG8_STAGE(PG8_SA(0, 0), a2, voffA);
            PG8_BAR; PG8_WAIT_L(0); PG8_MMA(1, 0, At, B0); PG8_BAR; PG8_SCHED;
            PG8_STAGE(PG8_SB(0, 1), b2 + hstep, voffB);
            PG8_WAIT_V(6); PG8_BAR; PG8_MMA(1, 1, At, B1); PG8_BAR;
            PG8_LDB(B0, 1, 0); PG8_SCHED; PG8_LDA(At, 1, 0); PG8_STAGE(PG8_SA(0, 1), a2 + hstep, voffA);
            PG8_WAIT_L(8); PG8_BAR; PG8_WAIT_L(0); PG8_MMA(0, 0, At, B0); PG8_BAR; PG8_SCHED;
            PG8_LDB(B1, 1, 1); PG8_STAGE(PG8_SB(1, 0), b3, voffB);
            PG8_BAR; PG8_WAIT_L(0); PG8_MMA(0, 1, At, B1); PG8_BAR;
            PG8_LDA(At, 1, 1); PG8_STAGE(PG8_SA(1, 0), a3, voffA);
            PG8_BAR; PG8_WAIT_L(0); PG8_MMA(1, 0, At, B0); PG8_BAR; PG8_SCHED;
            PG8_STAGE(PG8_SB(1, 1), b3 + hstep, voffB);
            PG8_WAIT_V(6); PG8_BAR; PG8_MMA(1, 1, At, B1); PG8_BAR;
            }
        }
        if constexpr (ALIGN_EPI) { if (wr == 0) PG8_BAR; }
        E(acc, cur, wr, wc, fr, fq); S.done(cur);
        if (!has_next) break;
#pragma unroll
        for (int a = 0; a < 2; ++a)
#pragma unroll
            for (int b = 0; b < 2; ++b)
#pragma unroll
                for (int m = 0; m < 4; ++m)
#pragma unroll
                    for (int n = 0; n < 2; ++n) acc[a][b][m][n] = (f32x4){0.f, 0.f, 0.f, 0.f};
        cur = nxt; cA = nA; cB = nB; ++ui;
        if constexpr (ALIGN_EPI) { if (wr == 1) PG8_BAR; }
    }
    PG8_WAIT_V(0);
    if constexpr (!ALIGN_EPI) { if (wr == 0) PG8_BAR; }
    PG8_BAR;
#undef PG8_SA
#undef PG8_SB
#undef PG8_STAGE
#undef PG8_LDA
#undef PG8_LDB
#undef PG8_MMA
#undef PG8_WAIT_V
#undef PG8_WAIT_L
#undef PG8_BAR
#undef PG8_SCHED
}

struct EpiSwiGLU {
    static constexpr bool PERM = false;
    bf16_t* ACT;
    DEVI void operator()(const f32x4 (&acc)[2][2][4][2], const Unit& u, int wr, int wc, int fr, int fq) const {
#pragma unroll
        for (int ai = 0; ai < 2; ++ai)
#pragma unroll
            for (int m = 0; m < 4; ++m) {
                const int row = u.pm * BM + ai * HALF + wr * 64 + m * 16 + fr;
                bf16_t* rp = ACT + (size_t)row * DFF + 16 * (8 * u.pn + wc) + 4 * fq;
#pragma unroll
                for (int bj = 0; bj < 2; ++bj) {
                    const f32x4 a = acc[ai][bj][m][0], b = acc[ai][bj][m][1];
                    u32x2 pk;
                    pk.x = pk2(a[0] * sigmoidf_(a[0]) * b[0], a[1] * sigmoidf_(a[1]) * b[1]);
                    pk.y = pk2(a[2] * sigmoidf_(a[2]) * b[2], a[3] * sigmoidf_(a[3]) * b[3]);
                    *(u32x2*)(rp + 64 * bj) = pk;
                }
            }
    }
};
struct EpiResid {
    static constexpr bool PERM = false;
    float* X; const float* gate_base; float coef;
    DEVI void operator()(const f32x4 (&acc)[2][2][4][2], const Unit& u, int wr, int wc, int fr_, int fq_) const {
        int fr = fr_, fq = fq_; asm volatile("" : "+v"(fr), "+v"(fq));
        const float* gate = gate_base + (size_t)mod_group(u.pm * BM) * 9216;
        const int col0 = u.pn * BM + wc * 32 + 4 * fq;
        f32x4 gv[2][2];
#pragma unroll
        for (int bj = 0; bj < 2; ++bj)
#pragma unroll
            for (int n = 0; n < 2; ++n) gv[bj][n] = *(const f32x4*)(gate + col0 + bj * HALF + 16 * n) * coef;
#pragma unroll
        for (int ah = 0; ah < 4; ++ah) {
            const int ai = ah >> 1, mb = (ah & 1) * 2;
            f32x4 xv[4][2][2];
#pragma unroll
            for (int m = mb; m < mb + 2; ++m)
#pragma unroll
                for (int bj = 0; bj < 2; ++bj)
#pragma unroll
                    for (int n = 0; n < 2; ++n)
                        xv[m][bj][n] = *(const f32x4*)(X + (size_t)(u.pm * BM + ai * HALF + wr * 64 + m * 16 + fr) * D + col0 + bj * HALF + 16 * n);
            __builtin_amdgcn_sched_barrier(0);
#pragma unroll
            for (int m = mb; m < mb + 2; ++m)
#pragma unroll
                for (int bj = 0; bj < 2; ++bj)
#pragma unroll
                    for (int n = 0; n < 2; ++n)
                        *(f32x4*)(X + (size_t)(u.pm * BM + ai * HALF + wr * 64 + m * 16 + fr) * D + col0 + bj * HALF + 16 * n) =
                            xv[m][bj][n] * ALPHA_F + gv[bj][n] * acc[ai][bj][m][n];
            __builtin_amdgcn_sched_barrier(0);
        }
    }
};
struct EpiIn {
    static constexpr bool PERM = true;
    unsigned char* ws; float* out; const float* b_gate; int l;
    static DEVI u32x4 pack8(const f32x4& a, const f32x4& b, float s) {
        u32x4 w; w.x = pk2(a[0] * s, a[1] * s); w.y = pk2(a[2] * s, a[3] * s); w.z = pk2(b[0] * s, b[1] * s); w.w = pk2(b[2] * s, b[3] * s); return w;
    }
    DEVI void operator()(const f32x4 (&acc)[2][2][4][2], const Unit& u, int wr, int wc, int fr_, int fq_) const {
        int fr = fr_, fq = fq_; asm volatile("" : "+v"(fr), "+v"(fq));
        unsigned char* ws = this->ws; float* out = this->out; const float* b_gate = this->b_gate;
        asm volatile("" : "+s"(ws), "+s"(out), "+s"(b_gate));
        const bool ctx = u.pm * BM < NCTX;
#pragma unroll
        for (int bj = 0; bj < 2; ++bj) {
            const int n0 = u.pn * BM + bj * HALF;
            const int c8 = n0 + wc * 32 + 8 * fq;
            f32x4 bg0 = (f32x4){0.f, 0.f, 0.f, 0.f}, bg1 = bg0;
            if (n0 >= 2816) { bg0 = *(const f32x4*)(b_gate + l * 3072 + c8 - 2816); bg1 = *(const f32x4*)(b_gate + l * 3072 + c8 - 2816 + 4); }
#pragma unroll
            for (int ai = 0; ai < 2; ++ai)
#pragma unroll
                for (int m = 0; m < 4; ++m) {
                    const int row = u.pm * BM + ai * HALF + wr * 64 + m * 16 + fr;
                    const f32x4 v0 = acc[ai][bj][m][0], v1 = acc[ai][bj][m][1];
                    if (n0 < 512) {
                        *(u32x4*)((bf16_t*)(ws + WS_UF) + (size_t)row * 512 + c8) = pack8(v0, v1, 1.f);
                    } else if (n0 < 896) {
                        *(u32x4*)((bf16_t*)(ws + WS_UQ) + (size_t)row * 384 + (c8 - 512)) = pack8(v0, v1, 1.f);
                    } else if (n0 < 1152) {
                        float* o = (float*)(ws + WS_UKV) + (size_t)row * 256 + (c8 - 896);
                        *(f32x4*)o = v0; *(f32x4*)(o + 4) = v1;
                    } else if (n0 < 1280) {
                        if (wc == 0) { float* o = (float*)(ws + WS_KRF) + (size_t)row * 32 + 8 * fq; *(f32x4*)o = v0; *(f32x4*)(o + 4) = v1; }
                    } else if (n0 < 1792) {
                        *(u32x4*)((bf16_t*)(ws + WS_NAQ) + (size_t)row * 512 + (c8 - 1280)) = pack8(v0, v1, NA_QS);
                    } else if (n0 < 2304) {
                        const int cc = c8 - 1792;
                        *(u32x4*)((bf16_t*)(ws + WS_NAK) + (size_t)row * 512 + cc) = pack8(v0, v1, 1.f);
                        if (ctx) { float* o = out + OUT_NAK + ((size_t)((row >> 8) * 4 + l) * 256 + (row & 255)) * 512 + cc; *(f32x4*)o = v0; *(f32x4*)(o + 4) = v1; }
                    } else if (n0 < 2816) {
                        const int cc = c8 - 2304, h = cc >> 6, d0 = cc & 63;
                        bf16_t* VT = (bf16_t*)(ws + WS_NAVT);
                        bf16_t* vp;
                        size_t cstride;
                        if (ctx) {
                            const int b = row >> 8, s = row & 255;
                            float* o = out + OUT_NAV + ((size_t)(b * 4 + l) * 256 + s) * 512 + cc; *(f32x4*)o = v0; *(f32x4*)(o + 4) = v1;
                            vp = VT + ((size_t)((b * 8 + h) * 64 + d0)) * 256 + s; cstride = 256;
                        } else {
                            const int rr = row - NCTX, b = rr >> 11, n = rr & 2047;
                            vp = VT + (size_t)4194304 + ((size_t)((b * 8 + h) * 64 + d0)) * 2048 + n; cstride = 2048;
                        }
#pragma unroll
                        for (int e = 0; e < 4; ++e) { vp[(size_t)e * cstride] = f2bf(v0[e]); vp[(size_t)(4 + e) * cstride] = f2bf(v1[e]); }
                    } else {
                        f32x4 g0, g1;
#pragma unroll
                        for (int e = 0; e < 4; ++e) { g0[e] = sigmoidf_(v0[e] + bg0[e]); g1[e] = sigmoidf_(v1[e] + bg1[e]); }
                        *(u32x4*)((bf16_t*)(ws + WS_GATE) + (size_t)row * 3072 + (c8 - 2816)) = pack8(g0, g1, 1.f);
                    }
                    __builtin_amdgcn_sched_barrier(0);
                }
        }
    }
};
struct EpiMerge {
    static constexpr bool PERM = true;
    const bf16_t* GATE; bf16_t* T; bf16_t* MG; int s;
    DEVI void operator()(const f32x4 (&acc)[2][2][4][2], const Unit& u, int wr, int wc, int fr_, int fq_) const {
        int fr = fr_, fq = fq_; asm volatile("" : "+v"(fr), "+v"(fq));
#pragma unroll
        for (int ah = 0; ah < 4; ++ah) {
            const int ai = ah >> 1, mb = (ah & 1) * 2;
            u32x4 gv[4][2], tv[4][2];
#pragma unroll
            for (int m = mb; m < mb + 2; ++m)
#pragma unroll
                for (int bj = 0; bj < 2; ++bj) {
                    const int row = u.pm * BM + ai * HALF + wr * 64 + m * 16 + fr;
                    const int c8 = u.pn * BM + bj * HALF + wc * 32 + 8 * fq;
                    gv[m][bj] = *(const u32x4*)(GATE + (size_t)row * 3072 + s * 1024 + c8);
                    if (s > 0) tv[m][bj] = *(const u32x4*)(T + (size_t)row * D + c8);
                }
            __builtin_amdgcn_sched_barrier(0);
#pragma unroll
            for (int m = mb; m < mb + 2; ++m)
#pragma unroll
                for (int bj = 0; bj < 2; ++bj) {
                    const int row = u.pm * BM + ai * HALF + wr * 64 + m * 16 + fr;
                    const int c8 = u.pn * BM + bj * HALF + wc * 32 + 8 * fq;
                    const u32x4 g = gv[m][bj];
                    f32x4 v0 = acc[ai][bj][m][0], v1 = acc[ai][bj][m][1];
                    v0[0] *= bf2f(g.x & 0xffffu); v0[1] *= bf2f(g.x >> 16); v0[2] *= bf2f(g.y & 0xffffu); v0[3] *= bf2f(g.y >> 16);
                    v1[0] *= bf2f(g.z & 0xffffu); v1[1] *= bf2f(g.z >> 16); v1[2] *= bf2f(g.w & 0xffffu); v1[3] *= bf2f(g.w >> 16);
                    if (s > 0) {
                        const u32x4 t = tv[m][bj];
                        v0[0] += bf2f(t.x & 0xffffu); v0[1] += bf2f(t.x >> 16); v0[2] += bf2f(t.y & 0xffffu); v0[3] += bf2f(t.y >> 16);
                        v1[0] += bf2f(t.z & 0xffffu); v1[1] += bf2f(t.z >> 16); v1[2] += bf2f(t.w & 0xffffu); v1[3] += bf2f(t.w >> 16);
                    }
                    *(u32x4*)((s < 2 ? T : MG) + (size_t)row * D + c8) = EpiIn::pack8(v0, v1, 1.f);
                }
            __builtin_amdgcn_sched_barrier(0);
        }
    }
};
}

DEVI void job_ffn_up(const P& p, unsigned char* ws_b, int l, int which, int t, bf16_t* sm, int tid) {
    const int nN = 44; const int m0 = (t / nN) * 128, n0 = (t % nN) * 128;
    const bf16_t* H = (const bf16_t*)(ws_b + WS_H);
    const bf16_t* W = (const bf16_t*)(ws_b + WS_W) + (size_t)l * LAYER_W + (which ? OFF_W13_2 : OFF_W13_1);
    bf16_t* ACT = (bf16_t*)(ws_b + WS_ACT);
    f32x16 acc[2][2]; zero_acc(acc);
    gemm_core(H + (size_t)m0 * D, D, W + (size_t)n0 * D, D, D, acc, sm, tid);
    EPI_SETUP
    const int oc = (n0 >> 1) + wc * 32 + c32;
#pragma unroll
    for (int i = 0; i < 2; ++i) {
        const int rb = m0 + wr * 64 + i * 32 + 4 * hl;
#pragma unroll
        for (int r = 0; r < 16; ++r) {
            const int row = rb + (r & 3) + 8 * (r >> 2);
            const float a = acc[i][0][r], b = acc[i][1][r];
            const float v = a * sigmoidf_(a) * b;
            ACT[(size_t)row * DFF + oc] = f2bf(v);
        }
    }
}

DEVI void job_resid(const P& p, unsigned char* ws_b, const bf16_t* A, int lda, const bf16_t* Bt, int K, const float* gate_base, float coef, int t, bf16_t* sm, int tid) {
    const int nN = 8; const int m0 = (t / nN) * 128, n0 = (t % nN) * 128;
    float* X = (float*)(ws_b + WS_X);
    f32x16 acc[2][2]; zero_acc(acc);
    gemm_core(A + (size_t)m0 * lda, lda, Bt + (size_t)n0 * K, K, K, acc, sm, tid);
    EPI_SETUP
    const float* gate = gate_base + (size_t)mod_group(m0) * 9216;
#pragma unroll
    for (int j = 0; j < 2; ++j) {
        const int col = n0 + wc * 64 + j * 32 + c32;
        const float gv = coef * gate[col];
#pragma unroll
        for (int i = 0; i < 2; ++i) {
            const int rb = m0 + wr * 64 + i * 32 + 4 * hl;
#pragma unroll
            for (int r = 0; r < 16; ++r) {
                const int row = rb + (r & 3) + 8 * (r >> 2);
                float* xp = X + (size_t)row * D + col;
                *xp = ALPHA_F * (*xp) + gv * acc[i][j][r];
            }
        }
    }
}

DEVI void job_in(const P& p, unsigned char* ws_b, int l, int t, bf16_t* sm, int tid) {
    const int nN = 46; const int m0 = (t / nN) * 128, n0 = (t % nN) * 128;
    const bf16_t* H = (const bf16_t*)(ws_b + WS_H);
    const bf16_t* W = (const bf16_t*)(ws_b + WS_W) + (size_t)l * LAYER_W + OFF_WIN;
    f32x16 acc[2][2]; zero_acc(acc);
    gemm_core(H + (size_t)m0 * D, D, W + (size_t)n0 * D, D, D, acc, sm, tid);
    EPI_SETUP
    const bool ctx = m0 < NCTX;
#pragma unroll
    for (int j = 0; j < 2; ++j) {
        const int col = n0 + wc * 64 + j * 32 + c32;
#pragma unroll
        for (int i = 0; i < 2; ++i) {
            const int rb = m0 + wr * 64 + i * 32 + 4 * hl;
            if (n0 < 512) {
                bf16_t* O = (bf16_t*)(ws_b + WS_UF);
#pragma unroll
                for (int r = 0; r < 16; ++r) O[(size_t)(rb + (r & 3) + 8 * (r >> 2)) * 512 + col] = f2bf(acc[i][j][r]);
            } else if (n0 < 896) {
                bf16_t* O = (bf16_t*)(ws_b + WS_UQ);
#pragma unroll
                for (int r = 0; r < 16; ++r) O[(size_t)(rb + (r & 3) + 8 * (r >> 2)) * 384 + (col - 512)] = f2bf(acc[i][j][r]);
            } else if (n0 < 1152) {
                float* O = (float*)(ws_b + WS_UKV);
#pragma unroll
                for (int r = 0; r < 16; ++r) O[(size_t)(rb + (r & 3) + 8 * (r >> 2)) * 256 + (col - 896)] = acc[i][j][r];
            } else if (n0 < 1280) {
                if (col < 1184) {
                    float* O = (float*)(ws_b + WS_KRF);
#pragma unroll
                    for (int r = 0; r < 16; ++r) O[(size_t)(rb + (r & 3) + 8 * (r >> 2)) * 32 + (col - 1152)] = acc[i][j][r];
                }
            } else if (n0 < 1792) {
                bf16_t* O = (bf16_t*)(ws_b + WS_NAQ);
#pragma unroll
                for (int r = 0; r < 16; ++r) O[(size_t)(rb + (r & 3) + 8 * (r >> 2)) * 512 + (col - 1280)] = f2bf(acc[i][j][r] * NA_QS);
            } else if (n0 < 2304) {
                bf16_t* O = (bf16_t*)(ws_b + WS_NAK);
                const int cc = col - 1792;
#pragma unroll
                for (int r = 0; r < 16; ++r) {
                    const int row = rb + (r & 3) + 8 * (r >> 2);
                    O[(size_t)row * 512 + cc] = f2bf(acc[i][j][r]);
                    if (ctx) p.out[OUT_NAK + ((size_t)((row >> 8) * 4 + l) * 256 + (row & 255)) * 512 + cc] = acc[i][j][r];
                }
            } else if (n0 < 2816) {
                bf16_t* VT = (bf16_t*)(ws_b + WS_NAVT);
                const int cc = col - 2304, h = cc >> 6, d = cc & 63;
#pragma unroll
                for (int qd = 0; qd < 4; ++qd) {
                    const int row = rb + 8 * qd;
                    u32x2 pk; pk.x = pk2(acc[i][j][4 * qd], acc[i][j][4 * qd + 1]); pk.y = pk2(acc[i][j][4 * qd + 2], acc[i][j][4 * qd + 3]);
                    if (ctx) {
                        const int b = row >> 8, s = row & 255;
                        *(u32x2*)(VT + ((size_t)((b * 8 + h) * 64 + d)) * 256 + s) = pk;
#pragma unroll
                        for (int e = 0; e < 4; ++e)
                            p.out[OUT_NAV + ((size_t)(b * 4 + l) * 256 + (s + e)) * 512 + cc] = acc[i][j][4 * qd + e];
                    } else {
                        const int rr = row - NCTX, b = rr >> 11, n = rr & 2047;
                        *(u32x2*)(VT + (size_t)4194304 + ((size_t)((b * 8 + h) * 64 + d)) * 2048 + n) = pk;
                    }
                }
            } else {
                bf16_t* O = (bf16_t*)(ws_b + WS_GATE);
                const int gc = col - 2816;
                const float bg = pin(p, 26)[l * 3072 + gc];
                bf16_t* gp = O + (size_t)gc * M + rb;
#pragma unroll
                for (int qd = 0; qd < 4; ++qd) {
                    u32x2 pk;
                    pk.x = pk2(sigmoidf_(acc[i][j][4 * qd] + bg), sigmoidf_(acc[i][j][4 * qd + 1] + bg));
                    pk.y = pk2(sigmoidf_(acc[i][j][4 * qd + 2] + bg), sigmoidf_(acc[i][j][4 * qd + 3] + bg));
                    *(u32x2*)(gp + 8 * qd) = pk;
                }
            }
        }
    }
}

DEVI void job_uq(const P& p, unsigned char* ws_b, int l, int t, bf16_t* sm, int tid) {
    const int nN = 6; const int m0 = (t / nN) * 128, n0 = (t % nN) * 128;
    const bf16_t* A = (const bf16_t*)(ws_b + WS_UQ);
    const bf16_t* W = (const bf16_t*)(ws_b + WS_W) + (size_t)l * LAYER_W + OFF_WUQ;
    bf16_t* Q = (bf16_t*)(ws_b + WS_Q);
    const float* ropec = (const float*)(ws_b + WS_ROPE);
    const float* ropes = ropec + 512;
    f32x16 acc[2][2]; zero_acc(acc);
    gemm_core(A + (size_t)m0 * 384, 384, W + (size_t)n0 * 384, 384, 384, acc, sm, tid);
    EPI_SETUP
    const bool lat = m0 >= NCTX;
#pragma unroll
    for (int j = 0; j < 2; ++j) {
        const int c0 = n0 + wc * 64 + j * 32;
        const int col = c0 + c32;
        const bool rope = lat && (((c0 >> 5) % 3) == 2);
        const int axis = c32 >> 4, ii = c32 & 15;
#pragma unroll
        for (int i = 0; i < 2; ++i) {
            const int rb = m0 + wr * 64 + i * 32 + 4 * hl;
#pragma unroll
            for (int r = 0; r < 16; ++r) {
                const int row = rb + (r & 3) + 8 * (r >> 2);
                float v = acc[i][j][r];
                const float pr = __shfl_xor(v, 8);
                if (rope) {
                    const int n = (row - NCTX) & 2047;
                    const int pos = axis ? (n & 63) : (n >> 6);
                    const float cs = ropec[pos * 8 + (ii & 7)], sn = ropes[pos * 8 + (ii & 7)];
                    const float rot = (ii < 8) ? -pr : pr;
                    v = v * cs + rot * sn;
                }
                Q[(size_t)row * 768 + col] = f2bf(v * MLA_QS);
            }
        }
    }
}

DEVI void job_ukv(const P& p, unsigned char* ws_b, int l, int t, bf16_t* sm, int tid) {
    const int nN = 8; const int m0 = (t / nN) * 128, h = t % nN, n0 = h * 128;
    const bf16_t* A = (m0 < M) ? (const bf16_t*)(ws_b + WS_CKV) + (size_t)m0 * 256
                               : (const bf16_t*)(ws_b + WS_CCKV) + ((size_t)l * 1024 + (m0 - M)) * 256;
    const bf16_t* W = (const bf16_t*)(ws_b + WS_W) + (size_t)l * LAYER_W + OFF_WUKV;
    bf16_t* KN = (bf16_t*)(ws_b + WS_KN);
    bf16_t* VT = (bf16_t*)(ws_b + WS_VTM);
    f32x16 acc[2][2]; zero_acc(acc);
    gemm_core(A, 256, W + (size_t)n0 * 256, 256, 256, acc, sm, tid);
    EPI_SETUP
#pragma unroll
    for (int j = 0; j < 2; ++j) {
        const int d = j * 32 + c32;
#pragma unroll
        for (int i = 0; i < 2; ++i) {
            const int rb = m0 + wr * 64 + i * 32 + 4 * hl;
            if (wc == 0) {
#pragma unroll
                for (int r = 0; r < 16; ++r) KN[(size_t)(rb + (r & 3) + 8 * (r >> 2)) * 512 + h * 64 + d] = f2bf(acc[i][j][r]);
            } else {
#pragma unroll
                for (int qd = 0; qd < 4; ++qd) {
                    const int row = rb + 8 * qd;
                    u32x2 pk; pk.x = pk2(acc[i][j][4 * qd], acc[i][j][4 * qd + 1]); pk.y = pk2(acc[i][j][4 * qd + 2], acc[i][j][4 * qd + 3]);
                    size_t addr;
                    if (m0 < NCTX) { const int b = row >> 8, s = row & 255; addr = ((size_t)((b * 8 + h) * 64 + d)) * 256 + s; }
                    else if (m0 < M) { const int rr = row - NCTX, b = rr >> 11, n = rr & 2047; addr = (size_t)4194304 + ((size_t)((b * 8 + h) * 64 + d)) * 2560 + n; }
                    else { const int rr = row - M, b = rr >> 9, n = rr & 511; addr = (size_t)4194304 + ((size_t)((b * 8 + h) * 64 + d)) * 2560 + 2048 + n; }
                    *(u32x2*)(VT + addr) = pk;
                }
            }
        }
    }
}

template <int ldo, bool SPLITK = false>
DEVI void job_store(const bf16_t* A, int lda, const bf16_t* Bt, int ldb, int K, bf16_t* Out, bf16_t* sm, int tid, int grp = 0, float* xch = nullptr) {
    f32x16 acc[2][2]; zero_acc(acc);
    if constexpr (SPLITK) { K >>= 1; A += grp * K; Bt += grp * K; }
    gemm_core(A, lda, Bt, ldb, K, acc, sm, tid);
    EPI_SETUP
    if constexpr (SPLITK) {
        if (grp == 1) {
#pragma unroll
            for (int i = 0; i < 2; ++i)
#pragma unroll
                for (int j = 0; j < 2; ++j)
#pragma unroll
                    for (int r = 0; r < 16; ++r) xch[((i * 2 + j) * 16 + r) * 256 + tid] = acc[i][j][r];
        }
        __syncthreads();
        if (grp == 0) {
#pragma unroll
            for (int i = 0; i < 2; ++i)
#pragma unroll
                for (int j = 0; j < 2; ++j)
#pragma unroll
                    for (int r = 0; r < 16; ++r) acc[i][j][r] += xch[((i * 2 + j) * 16 + r) * 256 + tid];
        }
        __syncthreads();
    }
    const bool active = !SPLITK || grp == 0;
    bf16_t* st = sm + (wr * 64 + 4 * hl) * 136 + wc * 64 + c32;
    if (active) {
#pragma unroll
        for (int i = 0; i < 2; ++i)
#pragma unroll
            for (int j = 0; j < 2; ++j)
#pragma unroll
                for (int r = 0; r < 16; ++r) st[(i * 32 + (r & 3) + 8 * (r >> 2)) * 136 + j * 32] = f2bf(acc[i][j][r]);
    }
    __syncthreads();
    if (active) {
        const int orow = tid >> 4, oc = (tid & 15) * 8;
#pragma unroll
        for (int k = 0; k < 8; ++k) {
            const u32x4 v = *(const u32x4*)(sm + (orow + 16 * k) * 136 + oc);
            *(u32x4*)(Out + (size_t)(orow + 16 * k) * ldo + oc) = v;
        }
    }
    __syncthreads();
}

DEVI void job_f1(const P& p, unsigned char* ws_b, int t, bf16_t* sm, int tid) {
    const bf16_t* WCS = (const bf16_t*)(ws_b + WS_WCS);
    const bf16_t* UF = (const bf16_t*)(ws_b + WS_UF);
    bf16_t* F1T = (bf16_t*)(ws_b + WS_F1T);
    if (t < 512) {
        const int bs = t >> 4, g = (t >> 2) & 3, mi = (t >> 1) & 1, ni = t & 1;
        job_store<256>(WCS + mi * 128 * 128, 128, UF + ((size_t)bs * 256 + ni * 128) * 512 + g * 128, 512, 128,
                  F1T + ((size_t)(bs * 4 + g) * 256 + mi * 128) * 256 + ni * 128, sm, tid);
    } else {
        t -= 512;
        const int bs = t >> 7, g = (t >> 5) & 3, mi = (t >> 4) & 1, ni = t & 15;
        job_store<2048>(WCS + mi * 128 * 128, 128, UF + ((size_t)NCTX + bs * 2048 + ni * 128) * 512 + g * 128, 512, 128,
                  F1T + (size_t)8388608 + ((size_t)(bs * 4 + g) * 256 + mi * 128) * 2048 + ni * 128, sm, tid);
    }
}
DEVI void job_f2_lat(const P& p, unsigned char* ws_b, int t, bf16_t* sm, int tid, int grp, float* xch) {
    const int bs = t >> 6, mi = (t >> 2) & 15, ni = t & 3;
    const bf16_t* TAB = (const bf16_t*)(ws_b + WS_TABL);
    const bf16_t* F1T = (const bf16_t*)(ws_b + WS_F1T) + (size_t)8388608;
    bf16_t* YF = (bf16_t*)(ws_b + WS_YF);
    job_store<512, true>(TAB + (size_t)mi * 128 * 4096, 4096, F1T + (size_t)bs * 512 * 4096 + (size_t)ni * 128 * 4096, 4096, 4096,
              YF + ((size_t)NCTX + bs * 2048 + mi * 128) * 512 + ni * 128, sm, tid, grp, xch);
}
DEVI void job_f2_ctx(const P& p, unsigned char* ws_b, int t, bf16_t* sm, int tid) {
    const int bs = t >> 3, mi = (t >> 2) & 1, ni = t & 3;
    const bf16_t* TAB = (const bf16_t*)(ws_b + WS_TABC);
    const bf16_t* F1T = (const bf16_t*)(ws_b + WS_F1T);
    bf16_t* YF = (bf16_t*)(ws_b + WS_YF);
    job_store<512>(TAB + (size_t)mi * 128 * 512, 512, F1T + (size_t)bs * 512 * 512 + (size_t)ni * 128 * 512, 512, 512,
              YF + ((size_t)bs * 256 + mi * 128) * 512 + ni * 128, sm, tid);
}

DEVI void job_merge(const P& p, unsigned char* ws_b, int l, int t, bf16_t* sm, int tid) {
    const int nN = 8; const int m0 = (t / nN) * 128, n0 = (t % nN) * 128;
    const bf16_t* Wl = (const bf16_t*)(ws_b + WS_W) + (size_t)l * LAYER_W;
    const bf16_t* GATE = (const bf16_t*)(ws_b + WS_GATE);
    bf16_t* MG = (bf16_t*)(ws_b + WS_MERGED);
    EPI_SETUP
    f32x16 acc[2][2]; zero_acc(acc);
#pragma unroll 1
    for (int s = 0; s < 3; ++s) {
        const bf16_t* A = (const bf16_t*)(ws_b + (s == 0 ? WS_YF : (s == 1 ? WS_YM : WS_YN)));
        const bf16_t* W = Wl + (s == 0 ? OFF_WBF : (s == 1 ? OFF_WBM : OFF_WBN));
        gemm_core<false>(A + (size_t)m0 * 512, 512, W + (size_t)n0 * 512, 512, 512, acc, sm, tid);
        {
            const int gr = tid >> 4, gc = (tid & 15) * 8;
            const int s1 = s < 2 ? s + 1 : s;
#pragma unroll
            for (int k = 0; k < 8; ++k) {
                const bf16_t* gsrc = GATE + (size_t)(m0 + gr + 16 * k) * 3072 + n0 + gc;
                *(u32x4*)(sm + (gr + 16 * k) * 136 + gc) = *(const u32x4*)(gsrc + s * 1024);
                *(u32x4*)(sm + 128 * 136 + (gr + 16 * k) * 136 + gc) = *(const u32x4*)(gsrc + s1 * 1024);
                if ((k & 1) == 1) __builtin_amdgcn_sched_barrier(0);
            }
        }
        __syncthreads();
#pragma unroll
        for (int j = 0; j < 2; ++j)
#pragma unroll
            for (int i = 0; i < 2; ++i) {
                const bf16_t* gp = sm + (wr * 64 + i * 32 + 4 * hl) * 136 + wc * 64 + j * 32 + c32;
#pragma unroll
                for (int r = 0; r < 16; ++r) {
                    const int o = ((r & 3) + 8 * (r >> 2)) * 136;
                    const float g = bf2f(gp[o]);
                    const float f = (s < 2) ? g * __builtin_amdgcn_rcpf(bf2f(gp[128 * 136 + o])) : g;
                    acc[i][j][r] *= f;
                }
            }
        __syncthreads();
    }
#pragma unroll
    for (int j = 0; j < 2; ++j) {
        const int col = n0 + wc * 64 + j * 32 + c32;
#pragma unroll
        for (int i = 0; i < 2; ++i) {
            const int rb = m0 + wr * 64 + i * 32 + 4 * hl;
#pragma unroll
            for (int r = 0; r < 16; ++r) MG[(size_t)(rb + (r & 3) + 8 * (r >> 2)) * 1024 + col] = f2bf(acc[i][j][r]);
        }
    }
}

struct TileSrc { const bf16_t* k; const bf16_t* k2; const bf16_t* v; const bf16_t* vhi; };
DEVI int pi_row(int r) { return (r & 0x13) | ((r & 4) << 1) | ((r & 8) >> 1); }

template <int NKS>
DEVI void attn_load(const TileSrc& s, bf16x8 (&kf)[NKS], bf16x8 (&vf)[4]) {
#pragma unroll
    for (int ks = 0; ks < NKS; ++ks) kf[ks] = (ks < 4) ? *(const bf16x8*)(s.k + ks * 16) : *(const bf16x8*)(s.k2 + (ks - 4) * 16);
    vf[0] = *(const bf16x8*)(s.v);
    vf[1] = *(const bf16x8*)(s.v + 16);
    vf[2] = *(const bf16x8*)(s.vhi);
    vf[3] = *(const bf16x8*)(s.vhi + 16);
}

template <int NKS, bool SPLIT, class Src, class Mask>
DEVI void attn_wave(const bf16_t* qptr, int t0, int nt, Src src, Mask mask, bf16_t* optr, int lane, float* ex = nullptr, int half = 0) {
    bf16x8 q[NKS];
#pragma unroll
    for (int ks = 0; ks < NKS; ++ks) q[ks] = *(const bf16x8*)(qptr + ks * 16);
    f32x16 o0, o1;
#pragma unroll
    for (int r = 0; r < 16; ++r) { o0[r] = 0.f; o1[r] = 0.f; }
    float m = -1e30f, lsum = 0.f;
    bf16x8 kf[NKS], vf[4];
    nt += t0;
    { TileSrc s0 = src(t0); attn_load<NKS>(s0, kf, vf); }
    for (int t = t0; t < nt; ++t) {
        bf16x8 kn[NKS], vn[4];
        { TileSrc s1 = src(t + 1 < nt ? t + 1 : t); attn_load<NKS>(s1, kn, vn); }
        f32x16 s;
#pragma unroll
        for (int r = 0; r < 16; ++r) s[r] = 0.f;
#pragma unroll
        for (int ks = 0; ks < NKS; ++ks) s = __builtin_amdgcn_mfma_f32_32x32x16_bf16(kf[ks], q[ks], s, 0, 0, 0);
        mask(t, s);
        float mx = s[0];
#pragma unroll
        for (int r = 1; r < 16; ++r) mx = fmaxf(mx, s[r]);
        mx = fmaxf(mx, __shfl_xor(mx, 32));
        const float mn = fmaxf(m, mx);
        const float alpha = fast_exp2(m - mn);
        m = mn;
        float rs = 0.f;
#pragma unroll
        for (int r = 0; r < 16; ++r) { s[r] = fast_exp2(s[r] - mn); rs += s[r]; }
        lsum = lsum * alpha + rs;
#pragma unroll
        for (int r = 0; r < 16; ++r) { o0[r] *= alpha; o1[r] *= alpha; }
        bf16x8 p0, p1;
        {
            u32x4 a, b;
            a.x = pk2(s[0], s[1]); a.y = pk2(s[2], s[3]); a.z = pk2(s[4], s[5]); a.w = pk2(s[6], s[7]);
            b.x = pk2(s[8], s[9]); b.y = pk2(s[10], s[11]); b.z = pk2(s[12], s[13]); b.w = pk2(s[14], s[15]);
            p0 = __builtin_bit_cast(bf16x8, a); p1 = __builtin_bit_cast(bf16x8, b);
        }
        o0 = __builtin_amdgcn_mfma_f32_32x32x16_bf16(vf[0], p0, o0, 0, 0, 0);
        o0 = __builtin_amdgcn_mfma_f32_32x32x16_bf16(vf[1], p1, o0, 0, 0, 0);
        o1 = __builtin_amdgcn_mfma_f32_32x32x16_bf16(vf[2], p0, o1, 0, 0, 0);
        o1 = __builtin_amdgcn_mfma_f32_32x32x16_bf16(vf[3], p1, o1, 0, 0, 0);
#pragma unroll
        for (int ks = 0; ks < NKS; ++ks) kf[ks] = kn[ks];
#pragma unroll
        for (int x = 0; x < 4; ++x) vf[x] = vn[x];
    }
    if constexpr (SPLIT) {
        if (half == 1) {
#pragma unroll
            for (int r = 0; r < 16; ++r) { ex[r * 64 + lane] = o0[r]; ex[(16 + r) * 64 + lane] = o1[r]; }
            ex[32 * 64 + lane] = m; ex[33 * 64 + lane] = lsum;
        }
        __syncthreads();
        if (half == 0) {
            const float m2 = ex[32 * 64 + lane], l2 = ex[33 * 64 + lane];
            const float mn = fmaxf(m, m2), a1 = fast_exp2(m - mn), a2 = fast_exp2(m2 - mn);
            lsum = lsum * a1 + l2 * a2;
#pragma unroll
            for (int r = 0; r < 16; ++r) { o0[r] = o0[r] * a1 + ex[r * 64 + lane] * a2; o1[r] = o1[r] * a1 + ex[(16 + r) * 64 + lane] * a2; }
        }
        __syncthreads();
        if (half == 1) return;
    }
    lsum += __shfl_xor(lsum, 32);
    const float inv = 1.f / lsum;
    const int hl = lane >> 5;
#pragma unroll
    for (int qd = 0; qd < 4; ++qd) {
        u32x2 a, b;
        a.x = pk2(o0[4 * qd] * inv, o0[4 * qd + 1] * inv); a.y = pk2(o0[4 * qd + 2] * inv, o0[4 * qd + 3] * inv);
        b.x = pk2(o1[4 * qd] * inv, o1[4 * qd + 1] * inv); b.y = pk2(o1[4 * qd + 2] * inv, o1[4 * qd + 3] * inv);
        *(u32x2*)(optr + 8 * qd + 4 * hl) = a;
        *(u32x2*)(optr + 32 + 8 * qd + 4 * hl) = b;
    }
}

struct NoMask { DEVI void operator()(int, f32x16&) const {} };

DEVI void attn_mla(const P& p, unsigned char* ws_b, int l, bool lat, int b, int h, int qg, int lane, float* ex = nullptr, int half = 0) {
    const int hl = lane >> 5, c32 = lane & 31, pr = pi_row(c32);
    const bf16_t* Q = (const bf16_t*)(ws_b + WS_Q);
    const bf16_t* KN = (const bf16_t*)(ws_b + WS_KN);
    const bf16_t* KR = (const bf16_t*)(ws_b + WS_KR);
    const bf16_t* CKR = (const bf16_t*)(ws_b + WS_CKR) + (size_t)l * 1024 * 32;
    const bf16_t* VT = (const bf16_t*)(ws_b + WS_VTM);
    bf16_t* YM = (bf16_t*)(ws_b + WS_YM);
    if (!lat) {
        const int row0 = b * 256;
        const int qrow = row0 + qg * 32 + c32;
        const bf16_t* k0 = KN + (size_t)(row0 + pr) * 512 + h * 64 + hl * 8;
        const bf16_t* r0 = KR + (size_t)(row0 + pr) * 32 + hl * 8;
        const bf16_t* v0 = VT + ((size_t)((b * 8 + h) * 64 + c32)) * 256 + hl * 8;
        auto src = [=](int t) { TileSrc s; s.k = k0 + (size_t)t * 32 * 512; s.k2 = r0 + (size_t)t * 32 * 32; s.v = v0 + t * 32; s.vhi = s.v + 32 * 256; return s; };
        attn_wave<6, false>(Q + (size_t)qrow * 768 + h * 96 + hl * 8, 0, 8, src, NoMask(), YM + (size_t)qrow * 512 + h * 64, lane);
    } else {
        const int row0 = NCTX + b * 2048;
        const int qrow = row0 + qg * 32 + c32;
        const bf16_t* k0 = KN + (size_t)(row0 + pr) * 512 + h * 64 + hl * 8;
        const bf16_t* r0 = KR + (size_t)(row0 + pr) * 32 + hl * 8;
        const bf16_t* k1 = KN + (size_t)(M + b * 512 + pr) * 512 + h * 64 + hl * 8;
        const bf16_t* r1 = CKR + (size_t)(b * 512 + pr) * 32 + hl * 8;
        const bf16_t* v0 = VT + (size_t)4194304 + ((size_t)((b * 8 + h) * 64 + c32)) * 2560 + hl * 8;
        auto src = [=](int t) {
            TileSrc s;
            if (t < 64) { s.k = k0 + (size_t)t * 32 * 512; s.k2 = r0 + (size_t)t * 32 * 32; }
            else { s.k = k1 + (size_t)(t - 64) * 32 * 512; s.k2 = r1 + (size_t)(t - 64) * 32 * 32; }
            s.v = v0 + t * 32; s.vhi = s.v + 32 * 2560; return s; };
        attn_wave<6, true>(Q + (size_t)qrow * 768 + h * 96 + hl * 8, half * 40, 40, src, NoMask(), YM + (size_t)qrow * 512 + h * 64, lane, ex, half);
    }
}

DEVI void attn_na_ctx(const P& p, unsigned char* ws_b, int b, int h, int qg, int lane) {
    const int hl = lane >> 5, c32 = lane & 31, pr = pi_row(c32);
    const bf16_t* Qn = (const bf16_t*)(ws_b + WS_NAQ);
    const bf16_t* Kn = (const bf16_t*)(ws_b + WS_NAK);
    const bf16_t* VT = (const bf16_t*)(ws_b + WS_NAVT);
    bf16_t* YN = (bf16_t*)(ws_b + WS_YN);
    const int row0 = b * 256, qrow = row0 + qg * 32 + c32;
    const bf16_t* k0 = Kn + (size_t)(row0 + pr) * 512 + h * 64 + hl * 8;
    const bf16_t* v0 = VT + ((size_t)((b * 8 + h) * 64 + c32)) * 256 + hl * 8;
    auto src = [=](int t) { TileSrc s; s.k = k0 + (size_t)t * 32 * 512; s.k2 = s.k; s.v = v0 + t * 32; s.vhi = s.v + 32 * 256; return s; };
    attn_wave<4, false>(Qn + (size_t)qrow * 512 + h * 64 + hl * 8, 0, 8, src, NoMask(), YN + (size_t)qrow * 512 + h * 64, lane);
}

struct NaMask {
    const float* rpb;
    int rs, rq, qc, hl;
    DEVI void operator()(int t, f32x16& s) const {
        if (t >= 16) return;
        const int kr = t >> 1, kh = t & 1;
        const int cs = min(max(qc - 8, 0), 48);
        const float* rp = rpb + (rs + kr - rq + 7) * 31;
#pragma unroll
        for (int r = 0; r < 16; ++r) {
            const int kk = (r & 3) + 4 * ((r >> 2) & 1) + 8 * hl + 16 * (r >> 3);
            const int kc = kh * 32 + kk;
            const bool ok = (kc >= cs) && (kc < cs + 16);
            const int dc = min(max(kc - qc + 15, 0), 30);
            const float bias = rp[dc] * LOG2E;
            s[r] = ok ? s[r] + bias : -1e30f;
        }
    }
};
DEVI void attn_na_lat(const P& p, unsigned char* ws_b, int l, int b, int h, int rq, int qh, int lane, float* ex, int half) {
    const int hl = lane >> 5, c32 = lane & 31, pr = pi_row(c32);
    const bf16_t* Qn = (const bf16_t*)(ws_b + WS_NAQ);
    const bf16_t* Kn = (const bf16_t*)(ws_b + WS_NAK);
    const bf16_t* VT = (const bf16_t*)(ws_b + WS_NAVT) + (size_t)4194304;
    const bf16_t* CK = (const bf16_t*)(ws_b + WS_CNAK) + (size_t)l * 1024 * 512;
    const bf16_t* CV = (const bf16_t*)(ws_b + WS_CNAVT) + (size_t)l * 1024 * 512;
    bf16_t* YN = (bf16_t*)(ws_b + WS_YN);
    const int row0 = NCTX + b * 2048;
    const int qrow = row0 + rq * 64 + qh * 32 + c32;
    const int rs = min(max(rq - 4, 0), 24);
    const bf16_t* k0 = Kn + (size_t)(row0 + rs * 64 + pr) * 512 + h * 64 + hl * 8;
    const bf16_t* v0 = VT + ((size_t)((b * 8 + h) * 64 + c32)) * 2048 + rs * 64 + hl * 8;
    const bf16_t* k1 = CK + (size_t)(b * 512 + pr) * 512 + h * 64 + hl * 8;
    const bf16_t* v1 = CV + ((size_t)((b * 8 + h) * 64 + c32)) * 512 + hl * 8;
    auto src = [=](int t) {
        TileSrc s;
        if (t < 16) { s.k = k0 + (size_t)t * 32 * 512; s.v = v0 + t * 32; s.vhi = s.v + 32 * 2048; }
        else { s.k = k1 + (size_t)(t - 16) * 32 * 512; s.v = v1 + (t - 16) * 32; s.vhi = s.v + 32 * 512; }
        s.k2 = s.k; return s; };
    NaMask mk; mk.rpb = pin(p, 21) + (size_t)(l * 8 + h) * 15 * 31; mk.rs = rs; mk.rq = rq; mk.qc = qh * 32 + c32; mk.hl = hl;
    attn_wave<4, true>(Qn + (size_t)qrow * 512 + h * 64 + hl * 8, half * 16, 16, src, mk, YN + (size_t)qrow * 512 + h * 64, lane, ex, half);
}

DEVI void row_load(const float* src, f32x4 (&v)[4], int lane) {
#pragma unroll
    for (int j = 0; j < 4; ++j) v[j] = *(const f32x4*)(src + 4 * lane + 256 * j);
}
DEVI void row_ln_mod(f32x4 (&v)[4], float* xdst, bf16_t* hdst, const float* lng, const float* lnb, const float* shift, const float* scale, int lane) {
    if (lng) {
        float s = 0.f;
#pragma unroll
        for (int j = 0; j < 4; ++j) s += (v[j].x + v[j].y) + (v[j].z + v[j].w);
        const float mu = wave_sum(s) * (1.f / D);
        float q = 0.f;
#pragma unroll
        for (int j = 0; j < 4; ++j) { v[j] = v[j] - mu; q += (v[j].x * v[j].x + v[j].y * v[j].y) + (v[j].z * v[j].z + v[j].w * v[j].w); }
        const float rstd = rsqrtf(wave_sum(q) * (1.f / D) + 1e-5f);
#pragma unroll
        for (int j = 0; j < 4; ++j) {
            const f32x4 g = *(const f32x4*)(lng + 4 * lane + 256 * j), bb = *(const f32x4*)(lnb + 4 * lane + 256 * j);
            v[j] = v[j] * rstd * g + bb;
        }
    }
    if (xdst) {
#pragma unroll
        for (int j = 0; j < 4; ++j) *(f32x4*)(xdst + 4 * lane + 256 * j) = v[j];
    }
    if (hdst) {
        float s = 0.f;
#pragma unroll
        for (int j = 0; j < 4; ++j) s += (v[j].x + v[j].y) + (v[j].z + v[j].w);
        const float mu = wave_sum(s) * (1.f / D);
        float q = 0.f;
#pragma unroll
        for (int j = 0; j < 4; ++j) { v[j] = v[j] - mu; q += (v[j].x * v[j].x + v[j].y * v[j].y) + (v[j].z * v[j].z + v[j].w * v[j].w); }
        const float rstd = rsqrtf(wave_sum(q) * (1.f / D) + 1e-6f);
#pragma unroll
        for (int j = 0; j < 4; ++j) {
            const f32x4 sc = *(const f32x4*)(scale + 4 * lane + 256 * j), sh = *(const f32x4*)(shift + 4 * lane + 256 * j);
            const f32x4 o = v[j] * rstd * (sc + 1.f) + sh;
            u32x2 pk; pk.x = pk2(o.x, o.y); pk.y = pk2(o.z, o.w);
            *(u32x2*)(hdst + 4 * lane + 256 * j) = pk;
        }
    }
}

DEVI const float* phase_rows_src(const P& p, unsigned char* ws_b, int row, int lnidx) {
    return (lnidx < 0) ? (row < NCTX ? pin(p, 0) + (size_t)row * D : pin(p, 1) + (size_t)(row - NCTX) * D) : (const float*)(ws_b + WS_X) + (size_t)row * D;
}
DEVI void phase_rows_one(const P& p, unsigned char* ws_b, f32x4 (&v)[4], int row, int l, int lnidx, int ml, int ms, bool final_, int lane) {
    float* X = (float*)(ws_b + WS_X);
    bf16_t* H = (bf16_t*)(ws_b + WS_H);
    const float* MOD = (const float*)(ws_b + WS_MOD);
    const float* lng = (lnidx < 0) ? nullptr : pin(p, 28) + (size_t)(l * 3 + lnidx) * D;
    const float* lnb = (lnidx < 0) ? nullptr : pin(p, 29) + (size_t)(l * 3 + lnidx) * D;
    if (final_) { row_ln_mod(v, p.out + (size_t)row * D, nullptr, lng, lnb, nullptr, nullptr, lane); return; }
    const float* mb = MOD + ((size_t)ml * 3 + mod_group(row)) * 9216;
    row_ln_mod(v, X + (size_t)row * D, H + (size_t)row * D, lng, lnb, mb + ms * D, mb + (ms + 1) * D, lane);
}
DEVI void phase_rows(const P& p, unsigned char* ws_b, int l, int lnidx, int ml, int ms, bool final_, int gw, int ngw, int lane) {
    int row = gw;
    for (; row + ngw < M; row += 2 * ngw) {
        f32x4 va[4], vb[4];
        row_load(phase_rows_src(p, ws_b, row, lnidx), va, lane);
        row_load(phase_rows_src(p, ws_b, row + ngw, lnidx), vb, lane);
        phase_rows_one(p, ws_b, va, row, l, lnidx, ml, ms, final_, lane);
        phase_rows_one(p, ws_b, vb, row + ngw, l, lnidx, ml, ms, final_, lane);
    }
    if (row < M) { f32x4 va[4]; row_load(phase_rows_src(p, ws_b, row, lnidx), va, lane); phase_rows_one(p, ws_b, va, row, l, lnidx, ml, ms, final_, lane); }
}

DEVI void phase_rowmix(const P& p, unsigned char* ws_b, int l, int gw, int ngw, int lane) {
    bf16_t* UQ = (bf16_t*)(ws_b + WS_UQ);
    const float* UKV = (const float*)(ws_b + WS_UKV);
    const float* KRF = (const float*)(ws_b + WS_KRF);
    bf16_t* CKV = (bf16_t*)(ws_b + WS_CKV);
    bf16_t* KR = (bf16_t*)(ws_b + WS_KR);
    const float* ropec = (const float*)(ws_b + WS_ROPE);
    const float* ropes = ropec + 512;
    const float* gq = pin(p, 17) + l * 384;
    const float* gkv = pin(p, 19) + l * 256;
    for (int row = gw; row < M; row += ngw) {
        {
            unsigned* up = (unsigned*)(UQ + (size_t)row * 384) + lane;
            float x[6]; float ss = 0.f;
#pragma unroll
            for (int j = 0; j < 3; ++j) { const unsigned w = up[64 * j]; x[2 * j] = bf2f(w & 0xffffu); x[2 * j + 1] = bf2f(w >> 16); ss += x[2 * j] * x[2 * j] + x[2 * j + 1] * x[2 * j + 1]; }
            const float rs = rsqrtf(wave_sum(ss) * (1.f / 384.f) + 1e-6f);
#pragma unroll
            for (int j = 0; j < 3; ++j) { const int c = 2 * lane + 128 * j; up[64 * j] = pk2(x[2 * j] * rs * gq[c], x[2 * j + 1] * rs * gq[c + 1]); }
        }
        {
            const f32x4 v = *(const f32x4*)(UKV + (size_t)row * 256 + 4 * lane);
            const float ss = v.x * v.x + v.y * v.y + v.z * v.z + v.w * v.w;
            const float rs = rsqrtf(wave_sum(ss) * (1.f / 256.f) + 1e-6f);
            const f32x4 g = *(const f32x4*)(gkv + 4 * lane);
            const f32x4 o = v * rs * g;
            u32x2 pk; pk.x = pk2(o.x, o.y); pk.y = pk2(o.z, o.w);
            *(u32x2*)(CKV + (size_t)row * 256 + 4 * lane) = pk;
            if (row < NCTX) *(f32x4*)(p.out + OUT_CKV + ((size_t)((row >> 8) * 4 + l) * 256 + (row & 255)) * 256 + 4 * lane) = o;
        }
        {
            const float v = KRF[(size_t)row * 32 + (lane & 31)];
            const float pr = __shfl_xor(v, 8);
            float o = v;
            if (row >= NCTX) {
                const int c = lane & 31, axis = c >> 4, ii = c & 15, n = (row - NCTX) & 2047;
                const int pos = axis ? (n & 63) : (n >> 6);
                const float rot = (ii < 8) ? -pr : pr;
                o = v * ropec[pos * 8 + (ii & 7)] + rot * ropes[pos * 8 + (ii & 7)];
            }
            if (lane < 32) {
                KR[(size_t)row * 32 + lane] = f2bf(o);
                if (row < NCTX) p.out[OUT_KR + ((size_t)((row >> 8) * 4 + l) * 256 + (row & 255)) * 32 + lane] = v;
            }
        }
    }
}

DEVI void transpose_item(const float* __restrict__ src, int N, int c0, int k0, bf16_t* __restrict__ dst, int K, float* scr, int lane) {
#pragma unroll 8
    for (int i = 0; i < 32; ++i) { const int kk = 2 * i + (lane >> 5); scr[kk * 33 + (lane & 31)] = src[(size_t)(k0 + kk) * N + c0 + (lane & 31)]; }
    asm volatile("s_waitcnt lgkmcnt(0)" ::: "memory");
    const int c = lane & 7;
#pragma unroll
    for (int j = 0; j < 4; ++j) {
        const int n = (lane >> 3) + 8 * j; const float* s = scr + (8 * c) * 33 + n;
        u32x4 o; o.x = pk2(s[0], s[33]); o.y = pk2(s[2 * 33], s[3 * 33]); o.z = pk2(s[4 * 33], s[5 * 33]); o.w = pk2(s[6 * 33], s[7 * 33]);
        *(u32x4*)(dst + (size_t)n * K + k0 + 8 * c) = o;
    }
    asm volatile("s_waitcnt lgkmcnt(0)" ::: "memory");
}

DEVI void prep_weight_item(const P& p, unsigned char* ws_b, int item, float* scr, int lane) {
    const int l = item / 12944; int r = item % 12944;
    bf16_t* Wl = (bf16_t*)(ws_b + WS_W) + (size_t)l * LAYER_W;
    if (r < 8448) {
        const int which = r / 4224; r %= 4224;
        if (r < 2816) {
            const int rb = r >> 4, kb = r & 15;
            const float* src = ((lane & 16) ? (which ? pin(p, 14) : pin(p, 11)) : (which ? pin(p, 13) : pin(p, 10))) + (size_t)l * D * DFF;
            transpose_item(src, DFF, rb * 16 - (lane & 16), kb * 64, Wl + (which ? OFF_W13_2 : OFF_W13_1) + (size_t)rb * 32 * D, D, scr, lane);
        } else {
            r -= 2816; const int rb = r / 44, kb = r % 44;
            const float* src = (which ? pin(p, 15) : pin(p, 12)) + (size_t)l * DFF * D;
            transpose_item(src, D, rb * 32, kb * 64, Wl + (which ? OFF_W2_2 : OFF_W2_1) + (size_t)rb * 32 * DFF, DFF, scr, lane);
        }
        return;
    }
    r -= 8448;
    if (r < 2944) {
        const int rb = r >> 4, kb = r & 15, R0 = rb * 32;
        const float* src; int N, c0;
        if (R0 < 1184) { src = pin(p, 16) + (size_t)l * D * 2720; N = 2720; c0 = R0; }
        else if (R0 < 1280) return;
        else if (R0 < 2816) { src = pin(p, 16) + (size_t)l * D * 2720; N = 2720; c0 = R0 - 96; }
        else { src = pin(p, 25) + (size_t)l * D * 3072; N = 3072; c0 = R0 - 2816; }
        transpose_item(src, N, c0, kb * 64, Wl + OFF_WIN + (size_t)R0 * D, D, scr, lane);
        return;
    }
    r -= 2944;
    if (r < 512) { const int rb = r >> 4, kb = r & 15; transpose_item(pin(p, 27) + (size_t)l * D * D, D, rb * 32, kb * 64, Wl + OFF_WOUT + (size_t)rb * 32 * D, D, scr, lane); return; }
    r -= 512;
    if (r < 768) { const int w = r >> 8; r &= 255; const int rb = r >> 3, kb = r & 7;
        transpose_item((w == 0 ? pin(p, 22) : (w == 1 ? pin(p, 23) : pin(p, 24))) + (size_t)l * 512 * D, D, rb * 32, kb * 64, Wl + (w == 0 ? OFF_WBF : (w == 1 ? OFF_WBM : OFF_WBN)) + (size_t)rb * 32 * 512, 512, scr, lane); return; }
    r -= 768;
    if (r < 144) { const int rb = r / 6, kb = r % 6; transpose_item(pin(p, 18) + (size_t)l * 384 * 768, 768, rb * 32, kb * 64, Wl + OFF_WUQ + (size_t)rb * 32 * 384, 384, scr, lane); return; }
    r -= 144;
    { const int rb = r >> 2, kb = r & 3; transpose_item(pin(p, 20) + (size_t)l * 256 * 1024, 1024, rb * 32, kb * 64, Wl + OFF_WUKV + (size_t)rb * 32 * 256, 256, scr, lane); }
}

DEVI void phase_prep(const P& p, unsigned char* ws_b, unsigned char* smem, int tid) {
    const int lane = tid & 63, wave = tid >> 6;
    const int gw = blockIdx.x * NWAVES + wave, ngw = gridDim.x * NWAVES;
    const size_t gt = (size_t)blockIdx.x * NTHREADS + tid, ngt = (size_t)gridDim.x * NTHREADS;
    {
        float* sil = (float*)smem;
        const float* wada = pin(p, 8);
        float* MODP = (float*)(ws_b + WS_MODP);
        for (int item = blockIdx.x; item < 1152; item += gridDim.x) {
            const int l = item / 288, rem = item % 288, kc = rem / 18, cb = rem % 18;
            __syncthreads();
            if (tid < 192) {
                const int g = tid >> 6, k = kc * 64 + (tid & 63);
                const float cv = (g == 0) ? pin(p, 7)[k] : pin(p, 6)[(g - 1) * D + k];
                sil[tid] = cv * sigmoidf_(cv);
            }
            __syncthreads();
            const int col = cb * NTHREADS + tid;
            const float* w = wada + ((size_t)l * D + kc * 64) * 9216 + col;
            float a0 = 0.f, a1 = 0.f, a2 = 0.f;
#pragma unroll 16
            for (int k = 0; k < 64; ++k) { const float wv = w[(size_t)k * 9216]; a0 += sil[k] * wv; a1 += sil[64 + k] * wv; a2 += sil[128 + k] * wv; }
            float* o = MODP + ((size_t)(l * 16 + kc) * 3) * 9216 + col;
            o[0] = a0; o[9216] = a1; o[2 * 9216] = a2;
        }
        __syncthreads();
    }
    {
        float* scr = (float*)smem + wave * (64 * 33);
        for (int item = gw; item < 4 * 12944; item += ngw) prep_weight_item(p, ws_b, item, scr, lane);
    }
    {
        bf16_t* TABL = (bf16_t*)(ws_b + WS_TABL);
        for (size_t e = gt; e < (size_t)2048 * 4096; e += ngt) {
            const int k = (int)(e >> 12), kk = (int)(e & 4095), lidx = kk & 2047;
            const int idx = (k * lidx) & 2047;
            float sn, cs; sincospif((float)idx * (2.f / 2048.f), &sn, &cs);
            TABL[e] = f2bf((kk < 2048 ? cs : -sn) * 0.022097086912079608f);
        }
        bf16_t* TABC = (bf16_t*)(ws_b + WS_TABC);
        for (size_t e = gt; e < (size_t)256 * 512; e += ngt) {
            const int k = (int)(e >> 9), kk = (int)(e & 511), lidx = kk & 255;
            const int idx = (k * lidx) & 255;
            float sn, cs; sincospif((float)idx * (2.f / 256.f), &sn, &cs);
            TABC[e] = f2bf((kk < 256 ? cs : -sn) * 0.0625f);
        }
        bf16_t* WCS = (bf16_t*)(ws_b + WS_WCS);
        for (size_t e = gt; e < (size_t)256 * 128; e += ngt) {
            const int i = (int)(e >> 7), c = (int)(e & 127), m = i >> 1, cs_ = i & 1;
            const int idx = (m * c) & 127;
            float sn, cs; sincospif((float)idx * (2.f / 128.f), &sn, &cs);
            WCS[e] = f2bf((cs_ ? sn : cs) * 0.08838834764831845f);
        }
        float* ROPE = (float*)(ws_b + WS_ROPE);
        for (size_t e = gt; e < 512; e += ngt) {
            const int pos = (int)(e >> 3), i = (int)(e & 7);
            const float inv_freq = powf(10000.f, -(float)i / 8.f);
            const float ang = (float)pos * inv_freq;
            ROPE[e] = cosf(ang); ROPE[512 + e] = sinf(ang);
        }
    }
    {
        bf16_t* CCKV = (bf16_t*)(ws_b + WS_CCKV);
        for (size_t e = gt; e < (size_t)NL * 1024 * 256; e += ngt) {
            const int c = (int)(e & 255), i = (int)((e >> 8) & 511), b = (int)((e >> 17) & 1), l = (int)(e >> 18);
            CCKV[e] = f2bf(pin(p, 2)[((size_t)(b * 4 + l) * 512 + i) * 256 + c]);
        }
        bf16_t* CKR = (bf16_t*)(ws_b + WS_CKR);
        for (size_t e = gt; e < (size_t)NL * 1024 * 32; e += ngt) {
            const int c = (int)(e & 31), i = (int)((e >> 5) & 511), b = (int)((e >> 14) & 1), l = (int)(e >> 15);
            CKR[e] = f2bf(pin(p, 3)[((size_t)(b * 4 + l) * 512 + i) * 32 + c]);
        }
        bf16_t* CNAK = (bf16_t*)(ws_b + WS_CNAK);
        for (size_t e = gt; e < (size_t)NL * 1024 * 512; e += ngt) {
            const int c = (int)(e & 511), i = (int)((e >> 9) & 511), b = (int)((e >> 18) & 1), l = (int)(e >> 19);
            CNAK[e] = f2bf(pin(p, 4)[((size_t)(b * 4 + l) * 512 + i) * 512 + c]);
        }
        bf16_t* CNAVT = (bf16_t*)(ws_b + WS_CNAVT);
        for (size_t e = gt; e < (size_t)NL * 1024 * 512; e += ngt) {
            const int key = (int)(e & 511), hd = (int)((e >> 9) & 511), b = (int)((e >> 18) & 1), l = (int)(e >> 19);
            CNAVT[e] = f2bf(pin(p, 5)[((size_t)(b * 4 + l) * 512 + key) * 512 + hd]);
        }
    }
}

DEVI void phase_modreduce(const P& p, unsigned char* ws_b, int tid) {
    const float* MODP = (const float*)(ws_b + WS_MODP);
    float* MOD = (float*)(ws_b + WS_MOD);
    for (int e = blockIdx.x * NTHREADS + tid; e < NL * 3 * 9216; e += gridDim.x * NTHREADS) {
        const int l = e / (3 * 9216), rem = e % (3 * 9216);
        float a = pin(p, 9)[l * 9216 + (rem % 9216)];
#pragma unroll
        for (int kc = 0; kc < 16; ++kc) a += MODP[((size_t)(l * 16 + kc) * 3) * 9216 + rem];
        MOD[e] = a;
    }
}

#define XB_TMO      128
#define XB_XCNT(j)  (256  + 64 * (j))
#define XB_XSUB(j)  (1280 + 64 * (j))
#define XB_XGEN(j)  (2304 + 64 * (j))
#define XB_TOP      3328
#define XB_TOPGEN   3392
#define XCD_BAR_WORDS 3456
#define XB_SPIN_CAP (1u << 20)
#define LAS __attribute__((address_space(3)))
DEVI unsigned xb_ld(unsigned* p)              { return __hip_atomic_load(p, __ATOMIC_RELAXED, __HIP_MEMORY_SCOPE_AGENT); }
DEVI unsigned xb_add(unsigned* p, unsigned v) { return __hip_atomic_fetch_add(p, v, __ATOMIC_RELAXED, __HIP_MEMORY_SCOPE_AGENT); }
DEVI unsigned xb_xcc_id() { return (unsigned)__builtin_amdgcn_s_getreg((3 << 11) | 20) & 0xFu; }
#define XB_SPIN(cond, bar) do { unsigned _sp = 0; while (cond) { __builtin_amdgcn_s_sleep(1); \
    if ((++_sp & 255u) == 0u) { if (xb_ld(&(bar)[XB_TMO])) break; if (_sp > XB_SPIN_CAP) { atomicAdd(&(bar)[XB_TMO], 1u); break; } } } } while (0)
struct XcdBarrier { unsigned* bar; unsigned x; volatile LAS unsigned* st; };
DEVI XcdBarrier xcd_barrier_post(unsigned* bar, volatile LAS unsigned* st) {
    XcdBarrier b; b.bar = bar; b.x = xb_xcc_id(); b.st = st;
    if (threadIdx.x == 0) (void)xb_add(&bar[XB_XCNT(b.x)], 1u);
    return b;
}
DEVI void xcd_barrier_complete(unsigned* bar, unsigned x, unsigned& nloc, unsigned& nx) {
    const unsigned G = gridDim.x * gridDim.y * gridDim.z;
    unsigned sum, cnt, mine, sp = 0u;
    for (;;) {
        sum = 0u; cnt = 0u; mine = 0u;
#pragma unroll
        for (unsigned j = 0; j < 16; ++j) { const unsigned c = xb_ld(&bar[XB_XCNT(j)]); sum += c; cnt += (c > 0u) ? 1u : 0u; mine = (j == x) ? c : mine; }
        if (sum == G) break;
        __builtin_amdgcn_s_sleep(1);
        if ((++sp & 255u) == 0u) { if (xb_ld(&bar[XB_TMO])) break; if (sp > XB_SPIN_CAP) { atomicAdd(&bar[XB_TMO], 1u); break; } }
    }
    nloc = mine > 0u ? mine : 1u; nx = cnt > 0u ? cnt : 1u;
}
DEVI void xcd_barrier(const XcdBarrier& b) {
    asm volatile("s_waitcnt vmcnt(0)" ::: "memory");
    __syncthreads();
    if (threadIdx.x == 0) {
        unsigned* bar = b.bar;
        __builtin_amdgcn_s_waitcnt(0);
        unsigned nloc = b.st[0], nx = b.st[1];
        if (nloc == 0u) { xcd_barrier_complete(bar, b.x, nloc, nx); b.st[0] = nloc; b.st[1] = nx; }
        const unsigned old = xb_add(&bar[XB_XSUB(b.x)], 1u);
        const unsigned gen = old / nloc;
        if (old + 1u == (gen + 1u) * nloc) {
            __builtin_amdgcn_fence(__ATOMIC_RELEASE, "agent");
            asm volatile("s_waitcnt vmcnt(0)" ::: "memory");
            const unsigned og = xb_add(&bar[XB_TOP], 1u);
            const unsigned tg = og / nx;
            if (og + 1u == (tg + 1u) * nx) xb_add(&bar[XB_TOPGEN], 1u);
            else XB_SPIN(xb_ld(&bar[XB_TOPGEN]) == tg, bar);
            __builtin_amdgcn_fence(__ATOMIC_ACQUIRE, "agent");
            xb_add(&bar[XB_XGEN(b.x)], 1u);
            asm volatile("s_waitcnt vmcnt(0)" ::: "memory");
        } else {
            XB_SPIN(xb_ld(&bar[XB_XGEN(b.x)]) == gen, bar);
            __builtin_amdgcn_fence(__ATOMIC_ACQUIRE, "agent");
            asm volatile("s_waitcnt vmcnt(0)" ::: "memory");
        }
    }
    __syncthreads();
}

DEVI void run_phase(const P& p, unsigned char* ws_b, int ph, unsigned char* smem, int tid) {
    const int lane = tid & 63, wave = tid >> 6;
    const int gw = blockIdx.x * NWAVES + wave, ngw = gridDim.x * NWAVES;
    const int nb = gridDim.x, bid = blockIdx.x;
    const int grp = tid >> 8, ltid = tid & 255;
    bf16_t* sm = (bf16_t*)smem + grp * (SMEM_BYTES / 2);
    if (ph == 0) { phase_prep(p, ws_b, smem, tid); return; }
    if (ph == 1) { phase_modreduce(p, ws_b, tid); return; }
    if (ph == 2) { phase_rows(p, ws_b, 0, -1, 0, 0, false, gw, ngw, lane); return; }
    const int l = (ph - 3) / 13, s = (ph - 3) % 13;
    const bf16_t* Wl = (const bf16_t*)(ws_b + WS_W) + (size_t)l * LAYER_W;
    const float* MODl = (const float*)(ws_b + WS_MOD) + (size_t)l * 3 * 9216;
    switch (s) {
    case 0: case 10:
        {
            pg8::Gemm g{(const bf16_t*)(ws_b + WS_H), Wl + (s == 10 ? OFF_W13_2 : OFF_W13_1), M, 2 * DFF, D};
            pg8::StaticOrder S; S.init(M, 2 * DFF, nb, bid);
            pg8::EpiSwiGLU E{(bf16_t*)(ws_b + WS_ACT)};
            pg8::gemm_phase<pg8::EpiSwiGLU, pg8::StaticOrder, true, true>((PG8_LAS unsigned char*)smem, g, S, E, tid);
        }
        break;
    case 1: case 11:
        {
            pg8::Gemm g{(const bf16_t*)(ws_b + WS_ACT), Wl + (s == 11 ? OFF_W2_2 : OFF_W2_1), M, D, DFF};
            pg8::StaticOrder S; S.init(M, D, nb, bid);
            pg8::EpiResid E{(float*)(ws_b + WS_X), MODl + (s == 11 ? 8 : 2) * D, 0.5f};
            pg8::gemm_phase<pg8::EpiResid, pg8::StaticOrder, false, true>((PG8_LAS unsigned char*)smem, g, S, E, tid);
        }
        break;
    case 2: phase_rows(p, ws_b, l, 0, l, 3, false, gw, ngw, lane); break;
    case 3:
        {
            pg8::Gemm g{(const bf16_t*)(ws_b + WS_H), Wl + OFF_WIN, M, 5888, D};
            pg8::StaticOrder S; S.init(M, 5888, nb, bid);
            pg8::EpiIn E{ws_b, p.out, pin(p, 26), l};
            pg8::gemm_phase<pg8::EpiIn, pg8::StaticOrder, true, true>((PG8_LAS unsigned char*)smem, g, S, E, tid);
        }
        break;
    case 4: phase_rowmix(p, ws_b, l, gw, ngw, lane); break;
    case 5: {
        float* ex = (float*)smem + (wave & 3) * (34 * 64);
        int u = bid;
        for (; u < 256; u += nb) {
            const int wi = u * 4 + (wave & 3);
            attn_na_lat(p, ws_b, l, wi >> 9, (wi >> 6) & 7, (wi >> 1) & 31, wi & 1, lane, ex, wave >> 2);
        }
        for (; u < 256 + 416; u += nb) job_ukv(p, ws_b, l, 2 * (u - 256) + grp, sm, ltid);
        for (; u < 256 + 416 + 288; u += nb) job_uq(p, ws_b, l, 2 * (u - 256 - 416) + grp, sm, ltid);
        for (; u < 256 + 416 + 288 + 384; u += nb) job_f1(p, ws_b, 2 * (u - 256 - 416 - 288) + grp, sm, ltid);
        for (; u < 256 + 416 + 288 + 384 + 256; u += nb) {
            const int wi = (u - 256 - 416 - 288 - 384) * 8 + wave;
            attn_na_ctx(p, ws_b, wi >> 6, (wi >> 3) & 7, wi & 7, lane);
        }
    } break;
    case 6: {
        float* ex = (float*)smem + (wave & 3) * (34 * 64);
        int u = bid;
        for (; u < 256; u += nb) {
            const int wi = u * 4 + (wave & 3);
            attn_mla(p, ws_b, l, true, wi >> 9, (wi >> 6) & 7, wi & 63, lane, ex, wave >> 2);
        }
        for (; u < 256 + 128; u += nb) job_f2_lat(p, ws_b, u - 256, sm, ltid, grp, (float*)(smem + SMEM_BYTES));
        for (; u < 256 + 128 + 128; u += nb) job_f2_ctx(p, ws_b, 2 * (u - 256 - 128) + grp, sm, ltid);
        for (; u < 256 + 128 + 128 + 256; u += nb) {
            const int wi = (u - 256 - 128 - 128) * 8 + wave;
            attn_mla(p, ws_b, l, false, wi >> 6, (wi >> 3) & 7, wi & 7, lane);
        }
    } break;
    case 7:

#pragma nounroll
        for (int sg = 0; sg < 3; ++sg) {
            int tid3 = tid; asm volatile("" : "+v"(tid3));
            pg8::Gemm g{(const bf16_t*)(ws_b + (sg == 0 ? WS_YF : (sg == 1 ? WS_YM : WS_YN))), Wl + (sg == 0 ? OFF_WBF : (sg == 1 ? OFF_WBM : OFF_WBN)), M, D, 512};
            pg8::StaticOrder S; S.init(M, D, nb, bid);
            pg8::EpiMerge E{(const bf16_t*)(ws_b + WS_GATE), (bf16_t*)(ws_b + WS_UF)  , (bf16_t*)(ws_b + WS_MERGED), sg};
            pg8::gemm_phase<pg8::EpiMerge, pg8::StaticOrder, false, true>((PG8_LAS unsigned char*)smem, g, S, E, tid3);
        }
        break;
    case 8:
        {
            pg8::Gemm g{(const bf16_t*)(ws_b + WS_MERGED), Wl + OFF_WOUT, M, D, D};
            pg8::StaticOrder S; S.init(M, D, nb, bid);
            pg8::EpiResid E{(float*)(ws_b + WS_X), MODl + 5 * D, 1.0f};
            pg8::gemm_phase<pg8::EpiResid, pg8::StaticOrder, false, true>((PG8_LAS unsigned char*)smem, g, S, E, tid);
        }
        break;
    case 9: phase_rows(p, ws_b, l, 1, l, 6, false, gw, ngw, lane); break;
    case 12:
        if (l == NL - 1) phase_rows(p, ws_b, l, 2, 0, 0, true, gw, ngw, lane);
        else phase_rows(p, ws_b, l, 2, l + 1, 0, false, gw, ngw, lane);
        break;
    default: break;
    }
}

__global__ void __launch_bounds__(NTHREADS, 2) mega_kernel(P p) {
    extern __shared__ __attribute__((aligned(16))) unsigned char smem[];
    __shared__ uint4 xb_words;
    cg::grid_group grid = cg::this_grid();
    const int tid = threadIdx.x;
    unsigned* bar = (unsigned*)(p.ws + WS_BAR);
    if (tid == 0) xb_words = make_uint4(0u, 0u, 0u, 0u);
    if (p.ph_lo == 0 && blockIdx.x == 0) for (int i = tid; i < XCD_BAR_WORDS; i += NTHREADS) bar[i] = 0u;
    __syncthreads();
    XcdBarrier xb; xb.bar = bar; xb.x = 0; xb.st = (volatile LAS unsigned*)&xb_words;
#pragma nounroll
    for (int ph = p.ph_lo; ph < p.ph_hi; ++ph) {
        int tid2 = tid; asm volatile("" : "+v"(tid2));
        unsigned char* ws_b = p.ws; asm volatile("" : "+s"(ws_b));
        run_phase(p, ws_b, ph, smem, tid2);
        if (ph + 1 < p.ph_hi) {
            if (ph == p.ph_lo) { grid.sync(); xb = xcd_barrier_post(bar, (volatile LAS unsigned*)&xb_words); }
            else xcd_barrier(xb);
        }
    }
}

extern "C" void kernel_launch(void* const* d_in, const int* in_sizes, int n_in, void* d_out, int out_size, void* d_ws, size_t ws_size,
                              hipStream_t stream) {
    static int grid_blocks = 0;
    if (grid_blocks == 0) {
        if (n_in != 30 || ws_size < WS_END) { fprintf(stderr, "kernel_launch: n_in %d ws %zu need %zu\n", n_in, ws_size, (size_t)WS_END); grid_blocks = -1; return; }
        int dev = 0, cus = 0, per_cu = 0;
        hipGetDevice(&dev);
        hipDeviceGetAttribute(&cus, hipDeviceAttributeMultiprocessorCount, dev);
        hipFuncSetAttribute((const void*)mega_kernel, hipFuncAttributeMaxDynamicSharedMemorySize, LDS_TOTAL);
        hipOccupancyMaxActiveBlocksPerMultiprocessor(&per_cu, (const void*)mega_kernel, NTHREADS, LDS_TOTAL);
        if (per_cu < 1) per_cu = 1;
        if (per_cu > 1) per_cu = 1;
        grid_blocks = cus * per_cu;
    }
    if (grid_blocks < 0) return;
    P p{};
    for (int i = 0; i < 30; ++i) p.in[i] = (const float*)d_in[i];
    p.out = (float*)d_out; p.ws = (unsigned char*)d_ws; p.ph_lo = 0; p.ph_hi = NPHASE;
#ifndef MULTI_LAUNCH
#define MULTI_LAUNCH 0
#endif
#if MULTI_LAUNCH
    for (int ph = 0; ph < NPHASE; ++ph) {
        p.ph_lo = ph; p.ph_hi = ph + 1;
        hipLaunchKernelGGL(mega_kernel, dim3(grid_blocks), dim3(NTHREADS), LDS_TOTAL, stream, p);
    }
#else
    void* args[] = {&p};
    hipError_t e = hipLaunchCooperativeKernel((const void*)mega_kernel, dim3(grid_blocks), dim3(NTHREADS), args, LDS_TOTAL, stream);
    if (e != hipSuccess) fprintf(stderr, "cooperative launch failed: %s (grid %d)\n", hipGetErrorString(e), grid_blocks);
#endif
}
```

```cpp
#include <hip/hip_runtime.h>
#include <hip/hip_cooperative_groups.h>
#include <cstdint>
#include <cstdio>
namespace cg = cooperative_groups;

typedef unsigned short bf16_t;
typedef short bf16x8 __attribute__((ext_vector_type(8)));
typedef float f32x16 __attribute__((ext_vector_type(16)));
typedef float f32x4 __attribute__((ext_vector_type(4)));
typedef unsigned u32x4 __attribute__((ext_vector_type(4)));
typedef unsigned u32x2 __attribute__((ext_vector_type(2)));
#define DEVI __device__ __forceinline__

constexpr int D = 1024, NCTX = 8192, NLAT = 4096, M = 12288, MX = 13312, DFF = 2816, NL = 4;
constexpr float ALPHA_F = 1.6817928305074290f;
constexpr float LOG2E = 1.4426950408889634f;
constexpr float MLA_QS = 0.10206207261596575f * LOG2E;
constexpr float NA_QS = 0.125f * LOG2E;
constexpr size_t OUT_CKV = 12582912, OUT_KR = 20971520, OUT_NAK = 22020096, OUT_NAV = 38797312;

constexpr size_t al256(size_t x) { return (x + 255) & ~(size_t)255; }
constexpr size_t WS_BAR = 0;
constexpr size_t WS_X = 16384;
constexpr size_t WS_H = WS_X + (size_t)M * D * 4;
constexpr size_t WS_MOD = WS_H + (size_t)M * D * 2;
constexpr size_t WS_MODP = WS_MOD + al256((size_t)NL * 3 * 9216 * 4);
constexpr size_t WS_ROPE = WS_MODP + al256((size_t)NL * 16 * 3 * 9216 * 4);
constexpr size_t WS_TABC = WS_ROPE + 4096;
constexpr size_t WS_TABL = WS_TABC + (size_t)256 * 512 * 2;
constexpr size_t WS_WCS = WS_TABL + (size_t)2048 * 4096 * 2;
constexpr size_t WS_CCKV = WS_WCS + (size_t)256 * 128 * 2;
constexpr size_t WS_CKR = WS_CCKV + (size_t)NL * 1024 * 256 * 2;
constexpr size_t WS_CNAK = WS_CKR + (size_t)NL * 1024 * 32 * 2;
constexpr size_t WS_CNAVT = WS_CNAK + (size_t)NL * 1024 * 512 * 2;
constexpr size_t WS_W = WS_CNAVT + (size_t)NL * 1024 * 512 * 2;
constexpr size_t OFF_W13_1 = 0, OFF_W2_1 = 5767168, OFF_W13_2 = 8650752, OFF_W2_2 = 14417920, OFF_WIN = 17301504,
                 OFF_WOUT = 23330816, OFF_WBF = 24379392, OFF_WBM = 24903680, OFF_WBN = 25427968, OFF_WUQ = 25952256,
                 OFF_WUKV = 26247168, LAYER_W = 26509312;
constexpr size_t WS_R1 = WS_W + (size_t)NL * LAYER_W * 2;
constexpr size_t WS_ACT = WS_R1;
constexpr size_t WS_UF = WS_R1;
constexpr size_t WS_UQ = WS_UF + (size_t)M * 512 * 2;
constexpr size_t WS_UKV = WS_UQ + (size_t)M * 384 * 2;
constexpr size_t WS_KRF = WS_UKV + (size_t)M * 256 * 4;
constexpr size_t WS_CKV = WS_KRF + (size_t)M * 32 * 4;
constexpr size_t WS_KR = WS_CKV + (size_t)M * 256 * 2;
constexpr size_t WS_NAQ = WS_KR + (size_t)M * 32 * 2;
constexpr size_t WS_NAK = WS_NAQ + (size_t)M * 512 * 2;
constexpr size_t WS_NAVT = WS_NAK + (size_t)M * 512 * 2;
constexpr size_t WS_GATE = WS_NAVT + (size_t)M * 512 * 2;
constexpr size_t WS_Q = WS_GATE + (size_t)M * 3072 * 2;
constexpr size_t WS_KN = WS_Q + (size_t)M * 768 * 2;
constexpr size_t WS_VTM = WS_KN + (size_t)MX * 512 * 2;
constexpr size_t WS_F1T = WS_VTM + (size_t)MX * 512 * 2;
constexpr size_t WS_YF = WS_F1T + (size_t)M * 1024 * 2;
constexpr size_t WS_YM = WS_YF + (size_t)M * 512 * 2;
constexpr size_t WS_YN = WS_YM + (size_t)M * 512 * 2;
constexpr size_t WS_MERGED = WS_YN + (size_t)M * 512 * 2;
constexpr size_t WS_END = WS_MERGED + (size_t)M * 1024 * 2;
static_assert(WS_END - WS_R1 >= (size_t)M * DFF * 2, "ACT must fit in R1");
static_assert(WS_NAK - WS_UF >= (size_t)M * D * 4, "merge T32 must fit in the dead UF..NAQ buffers");

constexpr int NPHASE = 3 + 13 * NL;

struct P {
    const float* in[30];
    float* out;
    unsigned char* ws;
    int ph_lo, ph_hi;
};

__device__ __forceinline__ const float* pin(const P& p, int i) { int j = i; asm volatile("" : "+s"(j)); return p.in[j]; }
typedef __bf16 bf16v2 __attribute__((ext_vector_type(2)));
typedef float f32x2 __attribute__((ext_vector_type(2)));
DEVI unsigned pk2(float lo, float hi) { f32x2 v = {lo, hi}; bf16v2 b = __builtin_convertvector(v, bf16v2); return __builtin_bit_cast(unsigned, b); }
DEVI bf16_t f2bf(float x) { return (bf16_t)(pk2(x, 0.f) & 0xffffu); }
DEVI float bf2f(unsigned v) { return __uint_as_float(v << 16); }
DEVI float wave_sum(float v) {
#pragma unroll
    for (int o = 1; o < 64; o <<= 1) v += __shfl_xor(v, o);
    return v;
}
DEVI float fast_exp2(float x) { return __builtin_amdgcn_exp2f(x); }
DEVI float sigmoidf_(float x) { return 1.f / (1.f + __expf(-x)); }

constexpr int LDT = 72;
constexpr int TILE_E = 128 * LDT;
constexpr int SMEM_BYTES = 4 * TILE_E * 2;
constexpr int NTHREADS = 512, NWAVES = 8, LDS_TOTAL = 2 * SMEM_BYTES;

DEVI void gemm_ldg(const bf16_t* ga, const bf16_t* gb, int lda, int ldb, u32x4 (&ra)[4], u32x4 (&rb)[4]) {
#pragma unroll
    for (int i = 0; i < 4; ++i) {
        ra[i] = *(const u32x4*)(ga + (size_t)(32 * i) * lda);
        rb[i] = *(const u32x4*)(gb + (size_t)(32 * i) * ldb);
    }
}
DEVI void gemm_sts(bf16_t* buf, int soff, const u32x4 (&ra)[4], const u32x4 (&rb)[4]) {
#pragma unroll
    for (int i = 0; i < 4; ++i) {
        *(u32x4*)(buf + soff + 32 * i * LDT) = ra[i];
        *(u32x4*)(buf + TILE_E + soff + 32 * i * LDT) = rb[i];
    }
}
DEVI void gemm_mma(const bf16_t* cur, int aoff, int boff, f32x16 (&acc)[2][2]) {
#pragma unroll
    for (int ks = 0; ks < 4; ++ks) {
        bf16x8 a0 = *(const bf16x8*)(cur + aoff + ks * 16);
        bf16x8 a1 = *(const bf16x8*)(cur + aoff + 32 * LDT + ks * 16);
        bf16x8 b0 = *(const bf16x8*)(cur + boff + ks * 16);
        bf16x8 b1 = *(const bf16x8*)(cur + boff + 32 * LDT + ks * 16);
        acc[0][0] = __builtin_amdgcn_mfma_f32_32x32x16_bf16(a0, b0, acc[0][0], 0, 0, 0);
        acc[0][1] = __builtin_amdgcn_mfma_f32_32x32x16_bf16(a0, b1, acc[0][1], 0, 0, 0);
        acc[1][0] = __builtin_amdgcn_mfma_f32_32x32x16_bf16(a1, b0, acc[1][0], 0, 0, 0);
        acc[1][1] = __builtin_amdgcn_mfma_f32_32x32x16_bf16(a1, b1, acc[1][1], 0, 0, 0);
    }
}

template <bool DEEP = true>
DEVI void gemm_core(const bf16_t* __restrict__ A, int lda, const bf16_t* __restrict__ B, int ldb, int K,
                    f32x16 (&acc)[2][2], bf16_t* smem, int tid) {
    const int lane = tid & 63, wave = tid >> 6, wr = wave >> 1, wc = wave & 1;
    const int lr = tid >> 3, lc = (tid & 7) * 8;
    const bf16_t* ga = A + (size_t)lr * lda + lc;
    const bf16_t* gb = B + (size_t)lr * ldb + lc;
    const int soff = lr * LDT + lc;
    const int nk = K >> 6;
    const int aoff = (wr * 64 + (lane & 31)) * LDT + (lane >> 5) * 8;
    const int boff = TILE_E + (wc * 64 + (lane & 31)) * LDT + (lane >> 5) * 8;
    bf16_t* buf0 = smem; bf16_t* buf1 = smem + 2 * TILE_E;
    if constexpr (DEEP) {
        u32x4 ra0[4], rb0[4], ra1[4], rb1[4];
        gemm_ldg(ga, gb, lda, ldb, ra0, rb0);
        gemm_ldg(ga + 64, gb + 64, lda, ldb, ra1, rb1);
        gemm_sts(buf0, soff, ra0, rb0);
        __syncthreads();
        for (int kt = 0; kt < nk; kt += 2) {
            if (kt + 2 < nk) gemm_ldg(ga + (size_t)(kt + 2) * 64, gb + (size_t)(kt + 2) * 64, lda, ldb, ra0, rb0);
            gemm_mma(buf0, aoff, boff, acc);
            gemm_sts(buf1, soff, ra1, rb1);
            __syncthreads();
            if (kt + 3 < nk) gemm_ldg(ga + (size_t)(kt + 3) * 64, gb + (size_t)(kt + 3) * 64, lda, ldb, ra1, rb1);
            gemm_mma(buf1, aoff, boff, acc);
            if (kt + 2 < nk) gemm_sts(buf0, soff, ra0, rb0);
            __syncthreads();
        }
    } else {
        u32x4 ra[4], rb[4];
        gemm_ldg(ga, gb, lda, ldb, ra, rb);
        gemm_sts(buf0, soff, ra, rb);
        __syncthreads();
        for (int kt = 0; kt < nk; ++kt) {
            bf16_t* cur = (kt & 1) ? buf1 : buf0;
            bf16_t* nxt = (kt & 1) ? buf0 : buf1;
            const bool more = (kt + 1 < nk);
            if (more) { ga += 64; gb += 64; gemm_ldg(ga, gb, lda, ldb, ra, rb); }
            gemm_mma(cur, aoff, boff, acc);
            if (more) gemm_sts(nxt, soff, ra, rb);
            __syncthreads();
        }
    }
}

DEVI void zero_acc(f32x16 (&acc)[2][2]) {
#pragma unroll
    for (int i = 0; i < 2; ++i)
#pragma unroll
        for (int j = 0; j < 2; ++j)
#pragma unroll
            for (int r = 0; r < 16; ++r) acc[i][j][r] = 0.f;
}

#define EPI_SETUP const int lane = tid & 63, wave = tid >> 6, wr = wave >> 1, wc = wave & 1, hl = lane >> 5, c32 = lane & 31; (void)wr; (void)wc; (void)hl; (void)c32;

DEVI int mod_group(int row) { return row < NCTX ? 0 : 1 + ((row - NCTX) >> 11); }

namespace pg8 {
#define PG8_LAS __attribute__((address_space(3)))
constexpr int BM = 256, BK = 64, HALF = 128, HTB = HALF * BK * 2, NXCD = 8, WGM = 8;
DEVI int lds_byte(int r, int c) { const int st = (r >> 4) * 2 + (c >> 5), rr = r & 15, cc = c & 31, ob = rr * 64 + cc * 2; return st * 1024 + (ob ^ (((ob >> 9) & 1) << 5)); }
DEVI void stage_rc(int b, int& R, int& C) { const int st = b / 1024, sb = b % 1024, swz = sb ^ (((sb >> 9) & 1) << 5); R = (st >> 1) * 16 + swz / 64; C = (st & 1) * 32 + (swz % 64) / 2; }
DEVI int perm32(int rho) { const int n = rho >> 4, i = rho & 15; return 8 * (i >> 2) + 4 * n + (i & 3); }
struct Unit { int pm, pn; };
struct Gemm { const bf16_t* A; const bf16_t* Bt; int M, N, K; };
struct StaticOrder {
    int nM, nN, nwg, G, c;
    DEVI void init(int M, int N, int G_, int c_) { nM = M / BM; nN = N / BM; nwg = nM * nN; G = G_; c = c_; }
    DEVI bool next(int i, Unit& u) const {
        const long L = (long)i * G + c; if (L >= nwg) return false;
        int wgid = (int)L; { const int q = nwg / NXCD, r = nwg % NXCD, xcd = wgid % NXCD, off = wgid / NXCD; wgid = (xcd < r ? xcd * (q + 1) : r * (q + 1) + (xcd - r) * q) + off; }
        const int nig = WGM * nN, gid = wgid / nig, fm = gid * WGM, gsz = (nM - fm) < WGM ? (nM - fm) : WGM;
        u.pm = fm + ((wgid % nig) % gsz); u.pn = (wgid % nig) / gsz; return true;
    }
    DEVI void a_ready(const Unit&) const {}
    DEVI void done(const Unit&) const {}
};
template <class Epi, class Sched, bool ALIGN_EPI = false, bool SP2 = false>
DEVI void gemm_phase(PG8_LAS unsigned char* lds, const Gemm g, const Sched& S, const Epi& E, const int tid) {
    const int wid = __builtin_amdgcn_readfirstlane(tid >> 6), lane = tid & 63, wr = wid >> 2, wc = wid & 3, fr = lane & 15, fq = lane >> 4;
    const int K = g.K, nt = K / BK;
    unsigned voffA[2], voffB[2];
#pragma unroll
    for (int i = 0; i < 2; ++i) { int R, C; stage_rc(tid * 16 + i * 8192, R, C); const int Rb = Epi::PERM ? ((R & ~31) + perm32(R & 31)) : R;
        voffA[i] = (unsigned)(R * K + C) * 2u; voffB[i] = (unsigned)(Rb * K + C) * 2u; }
    const size_t kstep = (size_t)(BK * 2);
    const size_t hstep = (size_t)HALF * K * 2;
    const size_t tstep = 2 * hstep;
    const unsigned ldsw = (unsigned)wid * 1024u;
    const int aoff = lds_byte(wr * 64 + fr, fq * 8), boff = lds_byte(wc * 32 + fr, fq * 8);
#define PG8_SA(b, h) (((b) * 2 + (h)) * HTB)
#define PG8_SB(b, h) ((4 + (b) * 2 + (h)) * HTB)
#define PG8_STAGE(bufoff, gbase, voff) do { _Pragma("unroll") for (int _i = 0; _i < 2; ++_i) \
        __builtin_amdgcn_global_load_lds((const unsigned*)((const char*)(gbase) + (voff)[_i]), (PG8_LAS unsigned*)(lds + (bufoff) + ldsw + _i * 8192), 16, 0, 0); } while (0)
#define PG8_LDA(dst, b, h) do { _Pragma("unroll") for (int m = 0; m < 4; ++m) _Pragma("unroll") for (int k = 0; k < 2; ++k) dst[m][k] = *(const PG8_LAS bf16x8*)(lds + PG8_SA(b, h) + aoff + m * 2048 + k * 1024); } while (0)
#define PG8_LDB(dst, b, h) do { _Pragma("unroll") for (int n = 0; n < 2; ++n) _Pragma("unroll") for (int k = 0; k < 2; ++k) dst[n][k] = *(const PG8_LAS bf16x8*)(lds + PG8_SB(b, h) + boff + n * 2048 + k * 1024); } while (0)
#define PG8_MMA(ai, bj, At, Bt) do { __builtin_amdgcn_s_setprio(1); _Pragma("unroll") for (int m = 0; m < 4; ++m) _Pragma("unroll") for (int n = 0; n < 2; ++n) _Pragma("unroll") for (int k = 0; k < 2; ++k) \
        acc[ai][bj][m][n] = __builtin_amdgcn_mfma_f32_16x16x32_bf16(Bt[n][k], At[m][k], acc[ai][bj][m][n], 0, 0, 0); __builtin_amdgcn_s_setprio(0); } while (0)
#define PG8_WAIT_V(n) asm volatile("s_waitcnt vmcnt(" #n ")" ::: "memory")
#define PG8_WAIT_L(n) asm volatile("s_waitcnt lgkmcnt(" #n ")" ::: "memory")
#define PG8_BAR __builtin_amdgcn_s_barrier()
#define PG8_SCHED __builtin_amdgcn_sched_barrier(0)
    Unit cur, nxt; int ui = 0;
    if (!S.next(0, cur)) return;
    f32x4 acc[2][2][4][2];
#pragma unroll
    for (int a = 0; a < 2; ++a)
#pragma unroll
        for (int b = 0; b < 2; ++b)
#pragma unroll
            for (int m = 0; m < 4; ++m)
#pragma unroll
                for (int n = 0; n < 2; ++n) acc[a][b][m][n] = (f32x4){0.f, 0.f, 0.f, 0.f};
    bf16x8 At[4][2], B0[2][2], B1[2][2];
    const char* cA = (const char*)g.A + (size_t)cur.pm * tstep; const char* cB = (const char*)g.Bt + (size_t)cur.pn * tstep;
    S.a_ready(cur);
    if constexpr (SP2) {
        PG8_STAGE(PG8_SB(0, 0), cB, voffB); PG8_STAGE(PG8_SB(0, 1), cB + hstep, voffB); PG8_STAGE(PG8_SA(0, 0), cA, voffA); PG8_STAGE(PG8_SA(0, 1), cA + hstep, voffA);
        if (wr == 1) PG8_BAR;
        PG8_WAIT_V(2); PG8_BAR;
        PG8_STAGE(PG8_SB(1, 0), cB + kstep, voffB); PG8_STAGE(PG8_SA(1, 0), cA + kstep, voffA); PG8_STAGE(PG8_SB(1, 1), cB + hstep + kstep, voffB);
        PG8_WAIT_V(6); PG8_BAR;
    } else {
        PG8_STAGE(PG8_SB(0, 0), cB, voffB); PG8_STAGE(PG8_SA(0, 0), cA, voffA); PG8_STAGE(PG8_SB(0, 1), cB + hstep, voffB); PG8_STAGE(PG8_SA(0, 1), cA + hstep, voffA);
        if (wr == 1) PG8_BAR;
        PG8_WAIT_V(4); PG8_BAR;
        PG8_STAGE(PG8_SB(1, 0), cB + kstep, voffB); PG8_STAGE(PG8_SA(1, 0), cA + kstep, voffA); PG8_STAGE(PG8_SB(1, 1), cB + hstep + kstep, voffB);
        PG8_WAIT_V(6); PG8_BAR;
    }
    for (;;) {
        const bool has_next = S.next(ui + 1, nxt);
        const char* nA = has_next ? (const char*)g.A + (size_t)nxt.pm * tstep : cA; const char* nB = has_next ? (const char*)g.Bt + (size_t)nxt.pn * tstep : cB;
        for (int t = 0; t < nt; t += 2) {
            const bool last = (t == nt - 2);
            const char* a1 = cA + (size_t)(t + 1) * kstep;
            const char* a2 = last ? nA : cA + (size_t)(t + 2) * kstep; const char* b2 = last ? nB : cB + (size_t)(t + 2) * kstep;
            const char* a3 = a2 + kstep; const char* b3 = b2 + kstep;
            if (last && has_next) S.a_ready(nxt);
            if constexpr (SP2) {
            PG8_LDB(B0, 0, 0); PG8_LDB(B1, 0, 1); PG8_SCHED; PG8_LDA(At, 0, 0); PG8_STAGE(PG8_SA(1, 1), a1 + hstep, voffA);
            PG8_WAIT_V(8); PG8_WAIT_L(0); PG8_BAR; PG8_MMA(0, 0, At, B0); PG8_MMA(0, 1, At, B1); PG8_BAR; PG8_SCHED;
            PG8_LDA(At, 0, 1); PG8_STAGE(PG8_SB(0, 0), b2, voffB); PG8_STAGE(PG8_SB(0, 1), b2 + hstep, voffB); PG8_STAGE(PG8_SA(0, 0), a2, voffA);
            PG8_WAIT_V(8); PG8_WAIT_L(0); PG8_BAR; PG8_MMA(1, 0, At, B0); PG8_MMA(1, 1, At, B1); PG8_BAR; PG8_SCHED;
            PG8_LDB(B0, 1, 0); PG8_LDB(B1, 1, 1); PG8_SCHED; PG8_LDA(At, 1, 0); PG8_STAGE(PG8_SA(0, 1), a2 + hstep, voffA);
            PG8_WAIT_V(8); PG8_WAIT_L(0); PG8_BAR; PG8_MMA(0, 0, At, B0); PG8_MMA(0, 1, At, B1); PG8_BAR; PG8_SCHED;
            PG8_LDA(At, 1, 1); PG8_STAGE(PG8_SB(1, 0), b3, voffB); PG8_STAGE(PG8_SB(1, 1), b3 + hstep, voffB); PG8_STAGE(PG8_SA(1, 0), a3, voffA);
            PG8_WAIT_V(8); PG8_WAIT_L(0); PG8_BAR; PG8_MMA(1, 0, At, B0); PG8_MMA(1, 1, At, B1); PG8_BAR; PG8_SCHED;
            } else {
            PG8_LDB(B0, 0, 0); PG8_SCHED; PG8_LDA(At, 0, 0); PG8_STAGE(PG8_SA(1, 1), a1 + hstep, voffA);
            PG8_WAIT_L(8); PG8_BAR; PG8_WAIT_L(0); PG8_MMA(0, 0, At, B0); PG8_BAR; PG8_SCHED;
            PG8_LDB(B1, 0, 1); PG8_STAGE(PG8_SB(0, 0), b2, voffB);
            PG8_BAR; PG8_WAIT_L(0); PG8_MMA(0, 1, At, B1); PG8_BAR;
            PG8_LDA(At, 0, 1); PG8_STAGE(PG8_SA(0, 0), a2, voffA);
            PG8_BAR; PG8_WAIT_L(0); PG8_MMA(1, 0, At, B0); PG8_BAR; PG8_SCHED;
            PG8_STAGE(PG8_SB(0, 1), b2 + hstep, voffB);
            PG8_WAIT_V(6); PG8_BAR; PG8_MMA(1, 1, At, B1); PG8_BAR;
            PG8_LDB(B0, 1, 0); PG8_SCHED; PG8_LDA(At, 1, 0); PG8_STAGE(PG8_SA(0, 1), a2 + hstep, voffA);
            PG8_WAIT_L(8); PG8_BAR; PG8_WAIT_L(0); PG8_MMA(0, 0, At, B0); PG8_BAR; PG8_SCHED;
            PG8_LDB(B1, 1, 1); PG8_STAGE(PG8_SB(1, 0), b3, voffB);
            PG8_BAR; PG8_WAIT_L(0); PG8_MMA(0, 1, At, B1); PG8_BAR;
            PG8_LDA(At, 1, 1); PG8_STAGE(PG8_SA(1, 0), a3, voffA);
            PG8_BAR; PG8_WAIT_L(0); PG8_MMA(1, 0, At, B0); PG8_BAR; PG8_SCHED;
            PG8_STAGE(PG8_SB(1, 1), b3 + hstep, voffB);
            PG8_WAIT_V(6); PG8_BAR; PG8_MMA(1, 1, At, B1); PG8_BAR;
            }
        }
        if constexpr (ALIGN_EPI) { if (wr == 0) PG8_BAR; }
        E(acc, cur, wr, wc, fr, fq); S.done(cur);
        if (!has_next) break;
#pragma unroll
        for (int a = 0; a < 2; ++a)
#pragma unroll
            for (int b = 0; b < 2; ++b)
#pragma unroll
                for (int m = 0; m < 4; ++m)
#pragma unroll
                    for (int n = 0; n < 2; ++n) acc[a][b][m][n] = (f32x4){0.f, 0.f, 0.f, 0.f};
        cur = nxt; cA = nA; cB = nB; ++ui;
        if constexpr (ALIGN_EPI) { if (wr == 1) PG8_BAR; }
    }
    PG8_WAIT_V(0);
    if constexpr (!ALIGN_EPI) { if (wr == 0) PG8_BAR; }
    PG8_BAR;
#undef PG8_SA
#undef PG8_SB
#undef PG8_STAGE
#undef PG8_LDA
#undef PG8_LDB
#undef PG8_MMA
#undef PG8_WAIT_V
#undef PG8_WAIT_L
#undef PG8_BAR
#undef PG8_SCHED
}

struct EpiSwiGLU {
    static constexpr bool PERM = false;
    bf16_t* ACT;
    DEVI void operator()(const f32x4 (&acc)[2][2][4][2], const Unit& u, int wr, int wc, int fr, int fq) const {
#pragma unroll
        for (int ai = 0; ai < 2; ++ai)
#pragma unroll
            for (int m = 0; m < 4; ++m) {
                const int row = u.pm * BM + ai * HALF + wr * 64 + m * 16 + fr;
                bf16_t* rp = ACT + (size_t)row * DFF + 16 * (8 * u.pn + wc) + 4 * fq;
#pragma unroll
                for (int bj = 0; bj < 2; ++bj) {
                    const f32x4 a = acc[ai][bj][m][0], b = acc[ai][bj][m][1];
                    u32x2 pk;
                    pk.x = pk2(a[0] * sigmoidf_(a[0]) * b[0], a[1] * sigmoidf_(a[1]) * b[1]);
                    pk.y = pk2(a[2] * sigmoidf_(a[2]) * b[2], a[3] * sigmoidf_(a[3]) * b[3]);
                    *(u32x2*)(rp + 64 * bj) = pk;
                }
            }
    }
};
struct EpiResid {
    static constexpr bool PERM = false;
    float* X; const float* gate_base; float coef;
    DEVI void operator()(const f32x4 (&acc)[2][2][4][2], const Unit& u, int wr, int wc, int fr_, int fq_) const {
        int fr = fr_, fq = fq_; asm volatile("" : "+v"(fr), "+v"(fq));
        const float* gate = gate_base + (size_t)mod_group(u.pm * BM) * 9216;
        const int col0 = u.pn * BM + wc * 32 + 4 * fq;
        f32x4 gv[2][2];
#pragma unroll
        for (int bj = 0; bj < 2; ++bj)
#pragma unroll
            for (int n = 0; n < 2; ++n) gv[bj][n] = *(const f32x4*)(gate + col0 + bj * HALF + 16 * n) * coef;
#pragma unroll
        for (int ah = 0; ah < 4; ++ah) {
            const int ai = ah >> 1, mb = (ah & 1) * 2;
            f32x4 xv[4][2][2];
#pragma unroll
            for (int m = mb; m < mb + 2; ++m)
#pragma unroll
                for (int bj = 0; bj < 2; ++bj)
#pragma unroll
                    for (int n = 0; n < 2; ++n)
                        xv[m][bj][n] = *(const f32x4*)(X + (size_t)(u.pm * BM + ai * HALF + wr * 64 + m * 16 + fr) * D + col0 + bj * HALF + 16 * n);
            __builtin_amdgcn_sched_barrier(0);
#pragma unroll
            for (int m = mb; m < mb + 2; ++m)
#pragma unroll
                for (int bj = 0; bj < 2; ++bj)
#pragma unroll
                    for (int n = 0; n < 2; ++n)
                        *(f32x4*)(X + (size_t)(u.pm * BM + ai * HALF + wr * 64 + m * 16 + fr) * D + col0 + bj * HALF + 16 * n) =
                            xv[m][bj][n] * ALPHA_F + gv[bj][n] * acc[ai][bj][m][n];
            __builtin_amdgcn_sched_barrier(0);
        }
    }
};
struct EpiIn {
    static constexpr bool PERM = true;
    unsigned char* ws; float* out; const float* b_gate; int l;
    static DEVI u32x4 pack8(const f32x4& a, const f32x4& b, float s) {
        u32x4 w; w.x = pk2(a[0] * s, a[1] * s); w.y = pk2(a[2] * s, a[3] * s); w.z = pk2(b[0] * s, b[1] * s); w.w = pk2(b[2] * s, b[3] * s); return w;
    }
    DEVI void operator()(const f32x4 (&acc)[2][2][4][2], const Unit& u, int wr, int wc, int fr_, int fq_) const {
        int fr = fr_, fq = fq_; asm volatile("" : "+v"(fr), "+v"(fq));
        unsigned char* ws = this->ws; float* out = this->out; const float* b_gate = this->b_gate;
        asm volatile("" : "+s"(ws), "+s"(out), "+s"(b_gate));
        const bool ctx = u.pm * BM < NCTX;
#pragma unroll
        for (int bj = 0; bj < 2; ++bj) {
            const int n0 = u.pn * BM + bj * HALF;
            const int c8 = n0 + wc * 32 + 8 * fq;
            f32x4 bg0 = (f32x4){0.f, 0.f, 0.f, 0.f}, bg1 = bg0;
            if (n0 >= 2816) { bg0 = *(const f32x4*)(b_gate + l * 3072 + c8 - 2816); bg1 = *(const f32x4*)(b_gate + l * 3072 + c8 - 2816 + 4); }
#pragma unroll
            for (int ai = 0; ai < 2; ++ai)
#pragma unroll
                for (int m = 0; m < 4; ++m) {
                    const int row = u.pm * BM + ai * HALF + wr * 64 + m * 16 + fr;
                    const f32x4 v0 = acc[ai][bj][m][0], v1 = acc[ai][bj][m][1];
                    if (n0 < 512) {
                        *(u32x4*)((bf16_t*)(ws + WS_UF) + (size_t)row * 512 + c8) = pack8(v0, v1, 1.f);
                    } else if (n0 < 896) {
                        *(u32x4*)((bf16_t*)(ws + WS_UQ) + (size_t)row * 384 + (c8 - 512)) = pack8(v0, v1, 1.f);
                    } else if (n0 < 1152) {
                        float* o = (float*)(ws + WS_UKV) + (size_t)row * 256 + (c8 - 896);
                        *(f32x4*)o = v0; *(f32x4*)(o + 4) = v1;
                    } else if (n0 < 1280) {
                        if (wc == 0) { float* o = (float*)(ws + WS_KRF) + (size_t)row * 32 + 8 * fq; *(f32x4*)o = v0; *(f32x4*)(o + 4) = v1; }
                    } else if (n0 < 1792) {
                        *(u32x4*)((bf16_t*)(ws + WS_NAQ) + (size_t)row * 512 + (c8 - 1280)) = pack8(v0, v1, NA_QS);
                    } else if (n0 < 2304) {
                        const int cc = c8 - 1792;
                        *(u32x4*)((bf16_t*)(ws + WS_NAK) + (size_t)row * 512 + cc) = pack8(v0, v1, 1.f);
                        if (ctx) { float* o = out + OUT_NAK + ((size_t)((row >> 8) * 4 + l) * 256 + (row & 255)) * 512 + cc; *(f32x4*)o = v0; *(f32x4*)(o + 4) = v1; }
                    } else if (n0 < 2816) {
                        const int cc = c8 - 2304, h = cc >> 6, d0 = cc & 63;
                        bf16_t* VT = (bf16_t*)(ws + WS_NAVT);
                        bf16_t* vp;
                        size_t cstride;
                        if (ctx) {
                            const int b = row >> 8, s = row & 255;
                            float* o = out + OUT_NAV + ((size_t)(b * 4 + l) * 256 + s) * 512 + cc; *(f32x4*)o = v0; *(f32x4*)(o + 4) = v1;
                            vp = VT + ((size_t)((b * 8 + h) * 64 + d0)) * 256 + s; cstride = 256;
                        } else {
                            const int rr = row - NCTX, b = rr >> 11, n = rr & 2047;
                            vp = VT + (size_t)4194304 + ((size_t)((b * 8 + h) * 64 + d0)) * 2048 + n; cstride = 2048;
                        }
#pragma unroll
                        for (int e = 0; e < 4; ++e) { vp[(size_t)e * cstride] = f2bf(v0[e]); vp[(size_t)(4 + e) * cstride] = f2bf(v1[e]); }
                    } else {
                        f32x4 g0, g1;
#pragma unroll
                        for (int e = 0; e < 4; ++e) { g0[e] = sigmoidf_(v0[e] + bg0[e]); g1[e] = sigmoidf_(v1[e] + bg1[e]); }
                        *(u32x4*)((bf16_t*)(ws + WS_GATE) + (size_t)row * 3072 + (c8 - 2816)) = pack8(g0, g1, 1.f);
                    }
                    __builtin_amdgcn_sched_barrier(0);
                }
        }
    }
};
struct EpiMerge {
    static constexpr bool PERM = true;
    const bf16_t* GATE; bf16_t* T; bf16_t* MG; int s;
    DEVI void operator()(const f32x4 (&acc)[2][2][4][2], const Unit& u, int wr, int wc, int fr_, int fq_) const {
        int fr = fr_, fq = fq_; asm volatile("" : "+v"(fr), "+v"(fq));
#pragma unroll
        for (int ah = 0; ah < 4; ++ah) {
            const int ai = ah >> 1, mb = (ah & 1) * 2;
            u32x4 gv[4][2], tv[4][2];
#pragma unroll
            for (int m = mb; m < mb + 2; ++m)
#pragma unroll
                for (int bj = 0; bj < 2; ++bj) {
                    const int row = u.pm * BM + ai * HALF + wr * 64 + m * 16 + fr;
                    const int c8 = u.pn * BM + bj * HALF + wc * 32 + 8 * fq;
                    gv[m][bj] = *(const u32x4*)(GATE + (size_t)row * 3072 + s * 1024 + c8);
                    if (s > 0) tv[m][bj] = *(const u32x4*)(T + (size_t)row * D + c8);
                }
            __builtin_amdgcn_sched_barrier(0);
#pragma unroll
            for (int m = mb; m < mb + 2; ++m)
#pragma unroll
                for (int bj = 0; bj < 2; ++bj) {
                    const int row = u.pm * BM + ai * HALF + wr * 64 + m * 16 + fr;
                    const int c8 = u.pn * BM + bj * HALF + wc * 32 + 8 * fq;
                    const u32x4 g = gv[m][bj];
                    f32x4 v0 = acc[ai][bj][m][0], v1 = acc[ai][bj][m][1];
                    v0[0] *= bf2f(g.x & 0xffffu); v0[1] *= bf2f(g.x >> 16); v0[2] *= bf2f(g.y & 0xffffu); v0[3] *= bf2f(g.y >> 16);
                    v1[0] *= bf2f(g.z & 0xffffu); v1[1] *= bf2f(g.z >> 16); v1[2] *= bf2f(g.w & 0xffffu); v1[3] *= bf2f(g.w >> 16);
                    if (s > 0) {
                        const u32x4 t = tv[m][bj];
                        v0[0] += bf2f(t.x & 0xffffu); v0[1] += bf2f(t.x >> 16); v0[2] += bf2f(t.y & 0xffffu); v0[3] += bf2f(t.y >> 16);
                        v1[0] += bf2f(t.z & 0xffffu); v1[1] += bf2f(t.z >> 16); v1[2] += bf2f(t.w & 0xffffu); v1[3] += bf2f(t.w >> 16);
                    }
                    *(u32x4*)((s < 2 ? T : MG) + (size_t)row * D + c8) = EpiIn::pack8(v0, v1, 1.f);
                }
            __builtin_amdgcn_sched_barrier(0);
        }
    }
};
}

DEVI void job_ffn_up(const P& p, unsigned char* ws_b, int l, int which, int t, bf16_t* sm, int tid) {
    const int nN = 44; const int m0 = (t / nN) * 128, n0 = (t % nN) * 128;
    const bf16_t* H = (const bf16_t*)(ws_b + WS_H);
    const bf16_t* W = (const bf16_t*)(ws_b + WS_W) + (size_t)l * LAYER_W + (which ? OFF_W13_2 : OFF_W13_1);
    bf16_t* ACT = (bf16_t*)(ws_b + WS_ACT);
    f32x16 acc[2][2]; zero_acc(acc);
    gemm_core(H + (size_t)m0 * D, D, W + (size_t)n0 * D, D, D, acc, sm, tid);
    EPI_SETUP
    const int oc = (n0 >> 1) + wc * 32 + c32;
#pragma unroll
    for (int i = 0; i < 2; ++i) {
        const int rb = m0 + wr * 64 + i * 32 + 4 * hl;
#pragma unroll
        for (int r = 0; r < 16; ++r) {
            const int row = rb + (r & 3) + 8 * (r >> 2);
            const float a = acc[i][0][r], b = acc[i][1][r];
            const float v = a * sigmoidf_(a) * b;
            ACT[(size_t)row * DFF + oc] = f2bf(v);
        }
    }
}

DEVI void job_resid(const P& p, unsigned char* ws_b, const bf16_t* A, int lda, const bf16_t* Bt, int K, const float* gate_base, float coef, int t, bf16_t* sm, int tid) {
    const int nN = 8; const int m0 = (t / nN) * 128, n0 = (t % nN) * 128;
    float* X = (float*)(ws_b + WS_X);
    f32x16 acc[2][2]; zero_acc(acc);
    gemm_core(A + (size_t)m0 * lda, lda, Bt + (size_t)n0 * K, K, K, acc, sm, tid);
    EPI_SETUP
    const float* gate = gate_base + (size_t)mod_group(m0) * 9216;
#pragma unroll
    for (int j = 0; j < 2; ++j) {
        const int col = n0 + wc * 64 + j * 32 + c32;
        const float gv = coef * gate[col];
#pragma unroll
        for (int i = 0; i < 2; ++i) {
            const int rb = m0 + wr * 64 + i * 32 + 4 * hl;
#pragma unroll
            for (int r = 0; r < 16; ++r) {
                const int row = rb + (r & 3) + 8 * (r >> 2);
                float* xp = X + (size_t)row * D + col;
                *xp = ALPHA_F * (*xp) + gv * acc[i][j][r];
            }
        }
    }
}

DEVI void job_in(const P& p, unsigned char* ws_b, int l, int t, bf16_t* sm, int tid) {
    const int nN = 46; const int m0 = (t / nN) * 128, n0 = (t % nN) * 128;
    const bf16_t* H = (const bf16_t*)(ws_b + WS_H);
    const bf16_t* W = (const bf16_t*)(ws_b + WS_W) + (size_t)l * LAYER_W + OFF_WIN;
    f32x16 acc[2][2]; zero_acc(acc);
    gemm_core(H + (size_t)m0 * D, D, W + (size_t)n0 * D, D, D, acc, sm, tid);
    EPI_SETUP
    const bool ctx = m0 < NCTX;
#pragma unroll
    for (int j = 0; j < 2; ++j) {
        const int col = n0 + wc * 64 + j * 32 + c32;
#pragma unroll
        for (int i = 0; i < 2; ++i) {
            const int rb = m0 + wr * 64 + i * 32 + 4 * hl;
            if (n0 < 512) {
                bf16_t* O = (bf16_t*)(ws_b + WS_UF);
#pragma unroll
                for (int r = 0; r < 16; ++r) O[(size_t)(rb + (r & 3) + 8 * (r >> 2)) * 512 + col] = f2bf(acc[i][j][r]);
            } else if (n0 < 896) {
                bf16_t* O = (bf16_t*)(ws_b + WS_UQ);
#pragma unroll
                for (int r = 0; r < 16; ++r) O[(size_t)(rb + (r & 3) + 8 * (r >> 2)) * 384 + (col - 512)] = f2bf(acc[i][j][r]);
            } else if (n0 < 1152) {
                float* O = (float*)(ws_b + WS_UKV);
#pragma unroll
                for (int r = 0; r < 16; ++r) O[(size_t)(rb + (r & 3) + 8 * (r >> 2)) * 256 + (col - 896)] = acc[i][j][r];
            } else if (n0 < 1280) {
                if (col < 1184) {
                    float* O = (float*)(ws_b + WS_KRF);
#pragma unroll
                    for (int r = 0; r < 16; ++r) O[(size_t)(rb + (r & 3) + 8 * (r >> 2)) * 32 + (col - 1152)] = acc[i][j][r];
                }
            } else if (n0 < 1792) {
                bf16_t* O = (bf16_t*)(ws_b + WS_NAQ);
#pragma unroll
                for (int r = 0; r < 16; ++r) O[(size_t)(rb + (r & 3) + 8 * (r >> 2)) * 512 + (col - 1280)] = f2bf(acc[i][j][r] * NA_QS);
            } else if (n0 < 2304) {
                bf16_t* O = (bf16_t*)(ws_b + WS_NAK);
                const int cc = col - 1792;
#pragma unroll
                for (int r = 0; r < 16; ++r) {
                    const int row = rb + (r & 3) + 8 * (r >> 2);
                    O[(size_t)row * 512 + cc] = f2bf(acc[i][j][r]);
                    if (ctx) p.out[OUT_NAK + ((size_t)((row >> 8) * 4 + l) * 256 + (row & 255)) * 512 + cc] = acc[i][j][r];
                }
            } else if (n0 < 2816) {
                bf16_t* VT = (bf16_t*)(ws_b + WS_NAVT);
                const int cc = col - 2304, h = cc >> 6, d = cc & 63;
#pragma unroll
                for (int qd = 0; qd < 4; ++qd) {
                    const int row = rb + 8 * qd;
                    u32x2 pk; pk.x = pk2(acc[i][j][4 * qd], acc[i][j][4 * qd + 1]); pk.y = pk2(acc[i][j][4 * qd + 2], acc[i][j][4 * qd + 3]);
                    if (ctx) {
                        const int b = row >> 8, s = row & 255;
                        *(u32x2*)(VT + ((size_t)((b * 8 + h) * 64 + d)) * 256 + s) = pk;
#pragma unroll
                        for (int e = 0; e < 4; ++e)
                            p.out[OUT_NAV + ((size_t)(b * 4 + l) * 256 + (s + e)) * 512 + cc] = acc[i][j][4 * qd + e];
                    } else {
                        const int rr = row - NCTX, b = rr >> 11, n = rr & 2047;
                        *(u32x2*)(VT + (size_t)4194304 + ((size_t)((b * 8 + h) * 64 + d)) * 2048 + n) = pk;
                    }
                }
            } else {
                bf16_t* O = (bf16_t*)(ws_b + WS_GATE);
                const int gc = col - 2816;
                const float bg = pin(p, 26)[l * 3072 + gc];
                bf16_t* gp = O + (size_t)gc * M + rb;
#pragma unroll
                for (int qd = 0; qd < 4; ++qd) {
                    u32x2 pk;
                    pk.x = pk2(sigmoidf_(acc[i][j][4 * qd] + bg), sigmoidf_(acc[i][j][4 * qd + 1] + bg));
                    pk.y = pk2(sigmoidf_(acc[i][j][4 * qd + 2] + bg), sigmoidf_(acc[i][j][4 * qd + 3] + bg));
                    *(u32x2*)(gp + 8 * qd) = pk;
                }
            }
        }
    }
}

DEVI void job_uq(const P& p, unsigned char* ws_b, int l, int t, bf16_t* sm, int tid) {
    const int nN = 6; const int m0 = (t / nN) * 128, n0 = (t % nN) * 128;
    const bf16_t* A = (const bf16_t*)(ws_b + WS_UQ);
    const bf16_t* W = (const bf16_t*)(ws_b + WS_W) + (size_t)l * LAYER_W + OFF_WUQ;
    bf16_t* Q = (bf16_t*)(ws_b + WS_Q);
    const float* ropec = (const float*)(ws_b + WS_ROPE);
    const float* ropes = ropec + 512;
    f32x16 acc[2][2]; zero_acc(acc);
    gemm_core(A + (size_t)m0 * 384, 384, W + (size_t)n0 * 384, 384, 384, acc, sm, tid);
    EPI_SETUP
    const bool lat = m0 >= NCTX;
#pragma unroll
    for (int j = 0; j < 2; ++j) {
        const int c0 = n0 + wc * 64 + j * 32;
        const int col = c0 + c32;
        const bool rope = lat && (((c0 >> 5) % 3) == 2);
        const int axis = c32 >> 4, ii = c32 & 15;
#pragma unroll
        for (int i = 0; i < 2; ++i) {
            const int rb = m0 + wr * 64 + i * 32 + 4 * hl;
#pragma unroll
            for (int r = 0; r < 16; ++r) {
                const int row = rb + (r & 3) + 8 * (r >> 2);
                float v = acc[i][j][r];
                const float pr = __shfl_xor(v, 8);
                if (rope) {
                    const int n = (row - NCTX) & 2047;
                    const int pos = axis ? (n & 63) : (n >> 6);
                    const float cs = ropec[pos * 8 + (ii & 7)], sn = ropes[pos * 8 + (ii & 7)];
                    const float rot = (ii < 8) ? -pr : pr;
                    v = v * cs + rot * sn;
                }
                Q[(size_t)row * 768 + col] = f2bf(v * MLA_QS);
            }
        }
    }
}

DEVI void job_ukv(const P& p, unsigned char* ws_b, int l, int t, bf16_t* sm, int tid) {
    const int nN = 8; const int m0 = (t / nN) * 128, h = t % nN, n0 = h * 128;
    const bf16_t* A = (m0 < M) ? (const bf16_t*)(ws_b + WS_CKV) + (size_t)m0 * 256
                               : (const bf16_t*)(ws_b + WS_CCKV) + ((size_t)l * 1024 + (m0 - M)) * 256;
    const bf16_t* W = (const bf16_t*)(ws_b + WS_W) + (size_t)l * LAYER_W + OFF_WUKV;
    bf16_t* KN = (bf16_t*)(ws_b + WS_KN);
    bf16_t* VT = (bf16_t*)(ws_b + WS_VTM);
    f32x16 acc[2][2]; zero_acc(acc);
    gemm_core(A, 256, W + (size_t)n0 * 256, 256, 256, acc, sm, tid);
    EPI_SETUP
#pragma unroll
    for (int j = 0; j < 2; ++j) {
        const int d = j * 32 + c32;
#pragma unroll
        for (int i = 0; i < 2; ++i) {
            const int rb = m0 + wr * 64 + i * 32 + 4 * hl;
            if (wc == 0) {
#pragma unroll
                for (int r = 0; r < 16; ++r) KN[(size_t)(rb + (r & 3) + 8 * (r >> 2)) * 512 + h * 64 + d] = f2bf(acc[i][j][r]);
            } else {
#pragma unroll
                for (int qd = 0; qd < 4; ++qd) {
                    const int row = rb + 8 * qd;
                    u32x2 pk; pk.x = pk2(acc[i][j][4 * qd], acc[i][j][4 * qd + 1]); pk.y = pk2(acc[i][j][4 * qd + 2], acc[i][j][4 * qd + 3]);
                    size_t addr;
                    if (m0 < NCTX) { const int b = row >> 8, s = row & 255; addr = ((size_t)((b * 8 + h) * 64 + d)) * 256 + s; }
                    else if (m0 < M) { const int rr = row - NCTX, b = rr >> 11, n = rr & 2047; addr = (size_t)4194304 + ((size_t)((b * 8 + h) * 64 + d)) * 2560 + n; }
                    else { const int rr = row - M, b = rr >> 9, n = rr & 511; addr = (size_t)4194304 + ((size_t)((b * 8 + h) * 64 + d)) * 2560 + 2048 + n; }
                    *(u32x2*)(VT + addr) = pk;
                }
            }
        }
    }
}

template <int ldo, bool SPLITK = false>
DEVI void job_store(const bf16_t* A, int lda, const bf16_t* Bt, int ldb, int K, bf16_t* Out, bf16_t* sm, int tid, int grp = 0, float* xch = nullptr) {
    f32x16 acc[2][2]; zero_acc(acc);
    if constexpr (SPLITK) { K >>= 1; A += grp * K; Bt += grp * K; }
    gemm_core(A, lda, Bt, ldb, K, acc, sm, tid);
    EPI_SETUP
    if constexpr (SPLITK) {
        if (grp == 1) {
#pragma unroll
            for (int i = 0; i < 2; ++i)
#pragma unroll
                for (int j = 0; j < 2; ++j)
#pragma unroll
                    for (int r = 0; r < 16; ++r) xch[((i * 2 + j) * 16 + r) * 256 + tid] = acc[i][j][r];
        }
        __syncthreads();
        if (grp == 0) {
#pragma unroll
            for (int i = 0; i < 2; ++i)
#pragma unroll
                for (int j = 0; j < 2; ++j)
#pragma unroll
                    for (int r = 0; r < 16; ++r) acc[i][j][r] += xch[((i * 2 + j) * 16 + r) * 256 + tid];
        }
        __syncthreads();
    }
    const bool active = !SPLITK || grp == 0;
    bf16_t* st = sm + (wr * 64 + 4 * hl) * 136 + wc * 64 + c32;
    if (active) {
#pragma unroll
        for (int i = 0; i < 2; ++i)
#pragma unroll
            for (int j = 0; j < 2; ++j)
#pragma unroll
                for (int r = 0; r < 16; ++r) st[(i * 32 + (r & 3) + 8 * (r >> 2)) * 136 + j * 32] = f2bf(acc[i][j][r]);
    }
    __syncthreads();
    if (active) {
        const int orow = tid >> 4, oc = (tid & 15) * 8;
#pragma unroll
        for (int k = 0; k < 8; ++k) {
            const u32x4 v = *(const u32x4*)(sm + (orow + 16 * k) * 136 + oc);
            *(u32x4*)(Out + (size_t)(orow + 16 * k) * ldo + oc) = v;
        }
    }
    __syncthreads();
}

DEVI void job_f1(const P& p, unsigned char* ws_b, int t, bf16_t* sm, int tid) {
    const bf16_t* WCS = (const bf16_t*)(ws_b + WS_WCS);
    const bf16_t* UF = (const bf16_t*)(ws_b + WS_UF);
    bf16_t* F1T = (bf16_t*)(ws_b + WS_F1T);
    if (t < 512) {
        const int bs = t >> 4, g = (t >> 2) & 3, mi = (t >> 1) & 1, ni = t & 1;
        job_store<256>(WCS + mi * 128 * 128, 128, UF + ((size_t)bs * 256 + ni * 128) * 512 + g * 128, 512, 128,
                  F1T + ((size_t)(bs * 4 + g) * 256 + mi * 128) * 256 + ni * 128, sm, tid);
    } else {
        t -= 512;
        const int bs = t >> 7, g = (t >> 5) & 3, mi = (t >> 4) & 1, ni = t & 15;
        job_store<2048>(WCS + mi * 128 * 128, 128, UF + ((size_t)NCTX + bs * 2048 + ni * 128) * 512 + g * 128, 512, 128,
                  F1T + (size_t)8388608 + ((size_t)(bs * 4 + g) * 256 + mi * 128) * 2048 + ni * 128, sm, tid);
    }
}
DEVI void job_f2_lat(const P& p, unsigned char* ws_b, int t, bf16_t* sm, int tid, int grp, float* xch) {
    const int bs = t >> 6, mi = (t >> 2) & 15, ni = t & 3;
    const bf16_t* TAB = (const bf16_t*)(ws_b + WS_TABL);
    const bf16_t* F1T = (const bf16_t*)(ws_b + WS_F1T) + (size_t)8388608;
    bf16_t* YF = (bf16_t*)(ws_b + WS_YF);
    job_store<512, true>(TAB + (size_t)mi * 128 * 4096, 4096, F1T + (size_t)bs * 512 * 4096 + (size_t)ni * 128 * 4096, 4096, 4096,
              YF + ((size_t)NCTX + bs * 2048 + mi * 128) * 512 + ni * 128, sm, tid, grp, xch);
}
DEVI void job_f2_ctx(const P& p, unsigned char* ws_b, int t, bf16_t* sm, int tid) {
    const int bs = t >> 3, mi = (t >> 2) & 1, ni = t & 3;
    const bf16_t* TAB = (const bf16_t*)(ws_b + WS_TABC);
    const bf16_t* F1T = (const bf16_t*)(ws_b + WS_F1T);
    bf16_t* YF = (bf16_t*)(ws_b + WS_YF);
    job_store<512>(TAB + (size_t)mi * 128 * 512, 512, F1T + (size_t)bs * 512 * 512 + (size_t)ni * 128 * 512, 512, 512,
              YF + ((size_t)bs * 256 + mi * 128) * 512 + ni * 128, sm, tid);
}

DEVI void job_merge(const P& p, unsigned char* ws_b, int l, int t, bf16_t* sm, int tid) {
    const int nN = 8; const int m0 = (t / nN) * 128, n0 = (t % nN) * 128;
    const bf16_t* Wl = (const bf16_t*)(ws_b + WS_W) + (size_t)l * LAYER_W;
    const bf16_t* GATE = (const bf16_t*)(ws_b + WS_GATE);
    bf16_t* MG = (bf16_t*)(ws_b + WS_MERGED);
    EPI_SETUP
    f32x16 acc[2][2]; zero_acc(acc);
#pragma unroll 1
    for (int s = 0; s < 3; ++s) {
        const bf16_t* A = (const bf16_t*)(ws_b + (s == 0 ? WS_YF : (s == 1 ? WS_YM : WS_YN)));
        const bf16_t* W = Wl + (s == 0 ? OFF_WBF : (s == 1 ? OFF_WBM : OFF_WBN));
        gemm_core<false>(A + (size_t)m0 * 512, 512, W + (size_t)n0 * 512, 512, 512, acc, sm, tid);
        {
            const int gr = tid >> 4, gc = (tid & 15) * 8;
            const int s1 = s < 2 ? s + 1 : s;
#pragma unroll
            for (int k = 0; k < 8; ++k) {
                const bf16_t* gsrc = GATE + (size_t)(m0 + gr + 16 * k) * 3072 + n0 + gc;
                *(u32x4*)(sm + (gr + 16 * k) * 136 + gc) = *(const u32x4*)(gsrc + s * 1024);
                *(u32x4*)(sm + 128 * 136 + (gr + 16 * k) * 136 + gc) = *(const u32x4*)(gsrc + s1 * 1024);
                if ((k & 1) == 1) __builtin_amdgcn_sched_barrier(0);
            }
        }
        __syncthreads();
#pragma unroll
        for (int j = 0; j < 2; ++j)
#pragma unroll
            for (int i = 0; i < 2; ++i) {
                const bf16_t* gp = sm + (wr * 64 + i * 32 + 4 * hl) * 136 + wc * 64 + j * 32 + c32;
#pragma unroll
                for (int r = 0; r < 16; ++r) {
                    const int o = ((r & 3) + 8 * (r >> 2)) * 136;
                    const float g = bf2f(gp[o]);
                    const float f = (s < 2) ? g * __builtin_amdgcn_rcpf(bf2f(gp[128 * 136 + o])) : g;
                    acc[i][j][r] *= f;
                }
            }
        __syncthreads();
    }
#pragma unroll
    for (int j = 0; j < 2; ++j) {
        const int col = n0 + wc * 64 + j * 32 + c32;
#pragma unroll
        for (int i = 0; i < 2; ++i) {
            const int rb = m0 + wr * 64 + i * 32 + 4 * hl;
#pragma unroll
            for (int r = 0; r < 16; ++r) MG[(size_t)(rb + (r & 3) + 8 * (r >> 2)) * 1024 + col] = f2bf(acc[i][j][r]);
        }
    }
}

struct TileSrc { const bf16_t* k; const bf16_t* k2; const bf16_t* v; const bf16_t* vhi; };
DEVI int pi_row(int r) { return (r & 0x13) | ((r & 4) << 1) | ((r & 8) >> 1); }

template <int NKS>
DEVI void attn_load(const TileSrc& s, bf16x8 (&kf)[NKS], bf16x8 (&vf)[4]) {
#pragma unroll
    for (int ks = 0; ks < NKS; ++ks) kf[ks] = (ks < 4) ? *(const bf16x8*)(s.k + ks * 16) : *(const bf16x8*)(s.k2 + (ks - 4) * 16);
    vf[0] = *(const bf16x8*)(s.v);
    vf[1] = *(const bf16x8*)(s.v + 16);
    vf[2] = *(const bf16x8*)(s.vhi);
    vf[3] = *(const bf16x8*)(s.vhi + 16);
}

template <int NKS, bool SPLIT, class Src, class Mask>
DEVI void attn_wave(const bf16_t* qptr, int t0, int nt, Src src, Mask mask, bf16_t* optr, int lane, float* ex = nullptr, int half = 0) {
    bf16x8 q[NKS];
#pragma unroll
    for (int ks = 0; ks < NKS; ++ks) q[ks] = *(const bf16x8*)(qptr + ks * 16);
    f32x16 o0, o1;
#pragma unroll
    for (int r = 0; r < 16; ++r) { o0[r] = 0.f; o1[r] = 0.f; }
    float m = -1e30f, lsum = 0.f;
    bf16x8 kf[NKS], vf[4];
    nt += t0;
    { TileSrc s0 = src(t0); attn_load<NKS>(s0, kf, vf); }
    for (int t = t0; t < nt; ++t) {
        bf16x8 kn[NKS], vn[4];
        { TileSrc s1 = src(t + 1 < nt ? t + 1 : t); attn_load<NKS>(s1, kn, vn); }
        f32x16 s;
#pragma unroll
        for (int r = 0; r < 16; ++r) s[r] = 0.f;
#pragma unroll
        for (int ks = 0; ks < NKS; ++ks) s = __builtin_amdgcn_mfma_f32_32x32x16_bf16(kf[ks], q[ks], s, 0, 0, 0);
        mask(t, s);
        float mx = s[0];
#pragma unroll
        for (int r = 1; r < 16; ++r) mx = fmaxf(mx, s[r]);
        mx = fmaxf(mx, __shfl_xor(mx, 32));
        const float mn = fmaxf(m, mx);
        const float alpha = fast_exp2(m - mn);
        m = mn;
        float rs = 0.f;
#pragma unroll
        for (int r = 0; r < 16; ++r) { s[r] = fast_exp2(s[r] - mn); rs += s[r]; }
        lsum = lsum * alpha + rs;
#pragma unroll
        for (int r = 0; r < 16; ++r) { o0[r] *= alpha; o1[r] *= alpha; }
        bf16x8 p0, p1;
        {
            u32x4 a, b;
            a.x = pk2(s[0], s[1]); a.y = pk2(s[2], s[3]); a.z = pk2(s[4], s[5]); a.w = pk2(s[6], s[7]);
            b.x = pk2(s[8], s[9]); b.y = pk2(s[10], s[11]); b.z = pk2(s[12], s[13]); b.w = pk2(s[14], s[15]);
            p0 = __builtin_bit_cast(bf16x8, a); p1 = __builtin_bit_cast(bf16x8, b);
        }
        o0 = __builtin_amdgcn_mfma_f32_32x32x16_bf16(vf[0], p0, o0, 0, 0, 0);
        o0 = __builtin_amdgcn_mfma_f32_32x32x16_bf16(vf[1], p1, o0, 0, 0, 0);
        o1 = __builtin_amdgcn_mfma_f32_32x32x16_bf16(vf[2], p0, o1, 0, 0, 0);
        o1 = __builtin_amdgcn_mfma_f32_32x32x16_bf16(vf[3], p1, o1, 0, 0, 0);
#pragma unroll
        for (int ks = 0; ks < NKS; ++ks) kf[ks] = kn[ks];
#pragma unroll
        for (int x = 0; x < 4; ++x) vf[x] = vn[x];
    }
    if constexpr (SPLIT) {
        if (half == 1) {
#pragma unroll
            for (int r = 0; r < 16; ++r) { ex[r * 64 + lane] = o0[r]; ex[(16 + r) * 64 + lane] = o1[r]; }
            ex[32 * 64 + lane] = m; ex[33 * 64 + lane] = lsum;
        }
        __syncthreads();
        if (half == 0) {
            const float m2 = ex[32 * 64 + lane], l2 = ex[33 * 64 + lane];
            const float mn = fmaxf(m, m2), a1 = fast_exp2(m - mn), a2 = fast_exp2(m2 - mn);
            lsum = lsum * a1 + l2 * a2;
#pragma unroll
            for (int r = 0; r < 16; ++r) { o0[r] = o0[r] * a1 + ex[r * 64 + lane] * a2; o1[r] = o1[r] * a1 + ex[(16 + r) * 64 + lane] * a2; }
        }
        __syncthreads();
        if (half == 1) return;
    }
    lsum += __shfl_xor(lsum, 32);
    const float inv = 1.f / lsum;
    const int hl = lane >> 5;
#pragma unroll
    for (int qd = 0; qd < 4; ++qd) {
        u32x2 a, b;
        a.x = pk2(o0[4 * qd] * inv, o0[4 * qd + 1] * inv); a.y = pk2(o0[4 * qd + 2] * inv, o0[4 * qd + 3] * inv);
        b.x = pk2(o1[4 * qd] * inv, o1[4 * qd + 1] * inv); b.y = pk2(o1[4 * qd + 2] * inv, o1[4 * qd + 3] * inv);
        *(u32x2*)(optr + 8 * qd + 4 * hl) = a;
        *(u32x2*)(optr + 32 + 8 * qd + 4 * hl) = b;
    }
}

struct NoMask { DEVI void operator()(int, f32x16&) const {} };

DEVI void attn_mla(const P& p, unsigned char* ws_b, int l, bool lat, int b, int h, int qg, int lane, float* ex = nullptr, int half = 0) {
    const int hl = lane >> 5, c32 = lane & 31, pr = pi_row(c32);
    const bf16_t* Q = (const bf16_t*)(ws_b + WS_Q);
    const bf16_t* KN = (const bf16_t*)(ws_b + WS_KN);
    const bf16_t* KR = (const bf16_t*)(ws_b + WS_KR);
    const bf16_t* CKR = (const bf16_t*)(ws_b + WS_CKR) + (size_t)l * 1024 * 32;
    const bf16_t* VT = (const bf16_t*)(ws_b + WS_VTM);
    bf16_t* YM = (bf16_t*)(ws_b + WS_YM);
    if (!lat) {
        const int row0 = b * 256;
        const int qrow = row0 + qg * 32 + c32;
        const bf16_t* k0 = KN + (size_t)(row0 + pr) * 512 + h * 64 + hl * 8;
        const bf16_t* r0 = KR + (size_t)(row0 + pr) * 32 + hl * 8;
        const bf16_t* v0 = VT + ((size_t)((b * 8 + h) * 64 + c32)) * 256 + hl * 8;
        auto src = [=](int t) { TileSrc s; s.k = k0 + (size_t)t * 32 * 512; s.k2 = r0 + (size_t)t * 32 * 32; s.v = v0 + t * 32; s.vhi = s.v + 32 * 256; return s; };
        attn_wave<6, false>(Q + (size_t)qrow * 768 + h * 96 + hl * 8, 0, 8, src, NoMask(), YM + (size_t)qrow * 512 + h * 64, lane);
    } else {
        const int row0 = NCTX + b * 2048;
        const int qrow = row0 + qg * 32 + c32;
        const bf16_t* k0 = KN + (size_t)(row0 + pr) * 512 + h * 64 + hl * 8;
        const bf16_t* r0 = KR + (size_t)(row0 + pr) * 32 + hl * 8;
        const bf16_t* k1 = KN + (size_t)(M + b * 512 + pr) * 512 + h * 64 + hl * 8;
        const bf16_t* r1 = CKR + (size_t)(b * 512 + pr) * 32 + hl * 8;
        const bf16_t* v0 = VT + (size_t)4194304 + ((size_t)((b * 8 + h) * 64 + c32)) * 2560 + hl * 8;
        auto src = [=](int t) {
            TileSrc s;
            if (t < 64) { s.k = k0 + (size_t)t * 32 * 512; s.k2 = r0 + (size_t)t * 32 * 32; }
            else { s.k = k1 + (size_t)(t - 64) * 32 * 512; s.k2 = r1 + (size_t)(t - 64) * 32 * 32; }
            s.v = v0 + t * 32; s.vhi = s.v + 32 * 2560; return s; };
        attn_wave<6, true>(Q + (size_t)qrow * 768 + h * 96 + hl * 8, half * 40, 40, src, NoMask(), YM + (size_t)qrow * 512 + h * 64, lane, ex, half);
    }
}

template <int NKS, class Mask>
DEVI void attn_step(const bf16x8 (&kf)[NKS], const bf16x8 (&vf)[4], const bf16x8 (&q)[NKS], f32x16& o0, f32x16& o1, float& m, float& lsum, const Mask& mask, int t) {
    f32x16 s;
#pragma unroll
    for (int r = 0; r < 16; ++r) s[r] = 0.f;
#pragma unroll
    for (int ks = 0; ks < NKS; ++ks) s = __builtin_amdgcn_mfma_f32_32x32x16_bf16(kf[ks], q[ks], s, 0, 0, 0);
    mask(t, s);
    float mx = s[0];
#pragma unroll
    for (int r = 1; r < 16; ++r) mx = fmaxf(mx, s[r]);
    mx = fmaxf(mx, __shfl_xor(mx, 32));
    const float mn = fmaxf(m, mx);
    const float alpha = fast_exp2(m - mn);
    m = mn;
    float rs = 0.f;
#pragma unroll
    for (int r = 0; r < 16; ++r) { s[r] = fast_exp2(s[r] - mn); rs += s[r]; }
    lsum = lsum * alpha + rs;
#pragma unroll
    for (int r = 0; r < 16; ++r) { o0[r] *= alpha; o1[r] *= alpha; }
    bf16x8 p0, p1;
    {
        u32x4 a, b;
        a.x = pk2(s[0], s[1]); a.y = pk2(s[2], s[3]); a.z = pk2(s[4], s[5]); a.w = pk2(s[6], s[7]);
        b.x = pk2(s[8], s[9]); b.y = pk2(s[10], s[11]); b.z = pk2(s[12], s[13]); b.w = pk2(s[14], s[15]);
        p0 = __builtin_bit_cast(bf16x8, a); p1 = __builtin_bit_cast(bf16x8, b);
    }
    o0 = __builtin_amdgcn_mfma_f32_32x32x16_bf16(vf[0], p0, o0, 0, 0, 0);
    o0 = __builtin_amdgcn_mfma_f32_32x32x16_bf16(vf[1], p1, o0, 0, 0, 0);
    o1 = __builtin_amdgcn_mfma_f32_32x32x16_bf16(vf[2], p0, o1, 0, 0, 0);
    o1 = __builtin_amdgcn_mfma_f32_32x32x16_bf16(vf[3], p1, o1, 0, 0, 0);
}
struct MlaStage { u32x4 k, v; u32x2 r; };
DEVI void attn_mla_lat_shared(const P& p, unsigned char* ws_b, int l, int b, int h, int qg, int tid, unsigned char* smem, float* ex) {
    const int lane = tid & 63, wave = tid >> 6, half = wave >> 2, htid = tid & 255;
    const int hl = lane >> 5, c32 = lane & 31, pr = pi_row(c32);
    const bf16_t* Q = (const bf16_t*)(ws_b + WS_Q);
    const bf16_t* KN = (const bf16_t*)(ws_b + WS_KN);
    const bf16_t* KR = (const bf16_t*)(ws_b + WS_KR);
    const bf16_t* CKR = (const bf16_t*)(ws_b + WS_CKR) + (size_t)l * 1024 * 32;
    const bf16_t* VT = (const bf16_t*)(ws_b + WS_VTM) + (size_t)4194304 + (size_t)((b * 8 + h) * 64) * 2560;
    bf16_t* YM = (bf16_t*)(ws_b + WS_YM);
    const int row0 = NCTX + b * 2048;
    const int qrow = row0 + qg * 32 + c32;
    bf16_t* ring = (bf16_t*)(smem + 36864 + half * 36864);
    const int kkey = htid >> 3, kch = (htid & 7) * 8, vd = htid >> 2, vch = (htid & 3) * 8;
    const int rch = (htid & 7) * 4;
    const int tb = half * 40, tend = tb + 40;
    bf16x8 q[6];
    {
        const bf16_t* qptr = Q + (size_t)qrow * 768 + h * 96 + hl * 8;
#pragma unroll
        for (int ks = 0; ks < 6; ++ks) q[ks] = *(const bf16x8*)(qptr + ks * 16);
    }
    f32x16 o0, o1;
#pragma unroll
    for (int r = 0; r < 16; ++r) { o0[r] = 0.f; o1[r] = 0.f; }
    float m = -1e30f, lsum = 0.f;
#define MLA_LD(S, T) do { const int t_ = (T) < tend ? (T) : tend - 1; \
        const int krow_ = t_ < 64 ? row0 + t_ * 32 : M + b * 512 + (t_ - 64) * 32; \
        (S).k = *(const u32x4*)(KN + (size_t)(krow_ + kkey) * 512 + h * 64 + kch); \
        (S).v = *(const u32x4*)(VT + (size_t)vd * 2560 + t_ * 32 + vch); \
        (S).r = *(const u32x2*)((t_ < 64 ? KR + (size_t)(krow_ + kkey) * 32 : CKR + (size_t)(b * 512 + (t_ - 64) * 32 + kkey) * 32) + rch); } while (0)
#define MLA_ST(S, SLOT) do { bf16_t* sl_ = ring + (SLOT) * 6144; \
        *(u32x4*)(sl_ + kkey * 72 + kch) = (S).k; *(u32x4*)(sl_ + 3584 + vd * 40 + vch) = (S).v; \
        *(u32x2*)(sl_ + 2304 + kkey * 40 + rch) = (S).r; } while (0)
#define MLA_COMPUTE(SLOT, T) do { const bf16_t* sl_ = ring + (SLOT) * 6144; bf16x8 kf[6], vf[4]; \
        _Pragma("unroll") for (int ks = 0; ks < 4; ++ks) kf[ks] = *(const bf16x8*)(sl_ + pr * 72 + ks * 16 + hl * 8); \
        kf[4] = *(const bf16x8*)(sl_ + 2304 + pr * 40 + hl * 8); kf[5] = *(const bf16x8*)(sl_ + 2304 + pr * 40 + 16 + hl * 8); \
        vf[0] = *(const bf16x8*)(sl_ + 3584 + c32 * 40 + hl * 8); vf[1] = *(const bf16x8*)(sl_ + 3584 + c32 * 40 + 16 + hl * 8); \
        vf[2] = *(const bf16x8*)(sl_ + 3584 + (c32 + 32) * 40 + hl * 8); vf[3] = *(const bf16x8*)(sl_ + 3584 + (c32 + 32) * 40 + 16 + hl * 8); \
        attn_step<6>(kf, vf, q, o0, o1, m, lsum, NoMask(), (T)); } while (0)
    MlaStage s0, s1, s2;
    MLA_LD(s0, tb); MLA_LD(s1, tb + 1); MLA_LD(s2, tb + 2);
    MLA_ST(s0, 0); MLA_LD(s0, tb + 3);
    __syncthreads();
#pragma unroll 1
    for (int i = tb; i < tend; i += 3) {
        MLA_ST(s1, 1); MLA_LD(s1, i + 4); MLA_COMPUTE(0, i); __syncthreads();
        MLA_ST(s2, 2); MLA_LD(s2, i + 5); if (i + 1 < tend) MLA_COMPUTE(1, i + 1); __syncthreads();
        MLA_ST(s0, 0); MLA_LD(s0, i + 6); if (i + 2 < tend) MLA_COMPUTE(2, i + 2); __syncthreads();
    }
#undef MLA_LD
#undef MLA_ST
#undef MLA_COMPUTE
    if (half == 1) {
#pragma unroll
        for (int r = 0; r < 16; ++r) { ex[r * 64 + lane] = o0[r]; ex[(16 + r) * 64 + lane] = o1[r]; }
        ex[32 * 64 + lane] = m; ex[33 * 64 + lane] = lsum;
    }
    __syncthreads();
    if (half == 0) {
        const float m2 = ex[32 * 64 + lane], l2 = ex[33 * 64 + lane];
        const float mn = fmaxf(m, m2), a1 = fast_exp2(m - mn), a2 = fast_exp2(m2 - mn);
        lsum = lsum * a1 + l2 * a2;
#pragma unroll
        for (int r = 0; r < 16; ++r) { o0[r] = o0[r] * a1 + ex[r * 64 + lane] * a2; o1[r] = o1[r] * a1 + ex[(16 + r) * 64 + lane] * a2; }
    }
    __syncthreads();
    if (half == 1) return;
    lsum += __shfl_xor(lsum, 32);
    const float inv = 1.f / lsum;
    bf16_t* optr = YM + (size_t)qrow * 512 + h * 64;
#pragma unroll
    for (int qd = 0; qd < 4; ++qd) {
        u32x2 a, bb;
        a.x = pk2(o0[4 * qd] * inv, o0[4 * qd + 1] * inv); a.y = pk2(o0[4 * qd + 2] * inv, o0[4 * qd + 3] * inv);
        bb.x = pk2(o1[4 * qd] * inv, o1[4 * qd + 1] * inv); bb.y = pk2(o1[4 * qd + 2] * inv, o1[4 * qd + 3] * inv);
        *(u32x2*)(optr + 8 * qd + 4 * hl) = a;
        *(u32x2*)(optr + 32 + 8 * qd + 4 * hl) = bb;
    }
}

DEVI void attn_na_ctx(const P& p, unsigned char* ws_b, int b, int h, int qg, int lane) {
    const int hl = lane >> 5, c32 = lane & 31, pr = pi_row(c32);
    const bf16_t* Qn = (const bf16_t*)(ws_b + WS_NAQ);
    const bf16_t* Kn = (const bf16_t*)(ws_b + WS_NAK);
    const bf16_t* VT = (const bf16_t*)(ws_b + WS_NAVT);
    bf16_t* YN = (bf16_t*)(ws_b + WS_YN);
    const int row0 = b * 256, qrow = row0 + qg * 32 + c32;
    const bf16_t* k0 = Kn + (size_t)(row0 + pr) * 512 + h * 64 + hl * 8;
    const bf16_t* v0 = VT + ((size_t)((b * 8 + h) * 64 + c32)) * 256 + hl * 8;
    auto src = [=](int t) { TileSrc s; s.k = k0 + (size_t)t * 32 * 512; s.k2 = s.k; s.v = v0 + t * 32; s.vhi = s.v + 32 * 256; return s; };
    attn_wave<4, false>(Qn + (size_t)qrow * 512 + h * 64 + hl * 8, 0, 8, src, NoMask(), YN + (size_t)qrow * 512 + h * 64, lane);
}

struct NaMask {
    const float* rpb;
    int rs, rq, qc, hl;
    DEVI void operator()(int t, f32x16& s) const {
        if (t >= 16) return;
        const int kr = t >> 1, kh = t & 1;
        const int cs = min(max(qc - 8, 0), 48);
        const float* rp = rpb + (rs + kr - rq + 7) * 31;
#pragma unroll
        for (int r = 0; r < 16; ++r) {
            const int kk = (r & 3) + 4 * ((r >> 2) & 1) + 8 * hl + 16 * (r >> 3);
            const int kc = kh * 32 + kk;
            const bool ok = (kc >= cs) && (kc < cs + 16);
            const int dc = min(max(kc - qc + 15, 0), 30);
            const float bias = rp[dc];
            s[r] = ok ? s[r] + bias : -1e30f;
        }
    }
};
DEVI void attn_na_lat(const P& p, unsigned char* ws_b, int l, int b, int h, int rq, int qh, int lane, float* ex, int half, const float* rpb_lds) {
    const int hl = lane >> 5, c32 = lane & 31, pr = pi_row(c32);
    const bf16_t* Qn = (const bf16_t*)(ws_b + WS_NAQ);
    const bf16_t* Kn = (const bf16_t*)(ws_b + WS_NAK);
    const bf16_t* VT = (const bf16_t*)(ws_b + WS_NAVT) + (size_t)4194304;
    const bf16_t* CK = (const bf16_t*)(ws_b + WS_CNAK) + (size_t)l * 1024 * 512;
    const bf16_t* CV = (const bf16_t*)(ws_b + WS_CNAVT) + (size_t)l * 1024 * 512;
    bf16_t* YN = (bf16_t*)(ws_b + WS_YN);
    const int row0 = NCTX + b * 2048;
    const int qrow = row0 + rq * 64 + qh * 32 + c32;
    const int rs = min(max(rq - 4, 0), 24);
    const bf16_t* k0 = Kn + (size_t)(row0 + rs * 64 + pr) * 512 + h * 64 + hl * 8;
    const bf16_t* v0 = VT + ((size_t)((b * 8 + h) * 64 + c32)) * 2048 + rs * 64 + hl * 8;
    const bf16_t* k1 = CK + (size_t)(b * 512 + pr) * 512 + h * 64 + hl * 8;
    const bf16_t* v1 = CV + ((size_t)((b * 8 + h) * 64 + c32)) * 512 + hl * 8;
    auto src = [=](int t) {
        TileSrc s;
        if (t < 16) { s.k = k0 + (size_t)t * 32 * 512; s.v = v0 + t * 32; s.vhi = s.v + 32 * 2048; }
        else { s.k = k1 + (size_t)(t - 16) * 32 * 512; s.v = v1 + (t - 16) * 32; s.vhi = s.v + 32 * 512; }
        s.k2 = s.k; return s; };
    NaMask mk; mk.rpb = rpb_lds; mk.rs = rs; mk.rq = rq; mk.qc = qh * 32 + c32; mk.hl = hl;
    attn_wave<4, true>(Qn + (size_t)qrow * 512 + h * 64 + hl * 8, half * 16, 16, src, mk, YN + (size_t)qrow * 512 + h * 64, lane, ex, half);
}

DEVI void row_load(const float* src, f32x4 (&v)[4], int lane) {
#pragma unroll
    for (int j = 0; j < 4; ++j) v[j] = *(const f32x4*)(src + 4 * lane + 256 * j);
}
DEVI void row_ln_mod(f32x4 (&v)[4], float* xdst, bf16_t* hdst, const float* lng, const float* lnb, const float* shift, const float* scale, int lane) {
    if (lng) {
        float s = 0.f;
#pragma unroll
        for (int j = 0; j < 4; ++j) s += (v[j].x + v[j].y) + (v[j].z + v[j].w);
        const float mu = wave_sum(s) * (1.f / D);
        float q = 0.f;
#pragma unroll
        for (int j = 0; j < 4; ++j) { v[j] = v[j] - mu; q += (v[j].x * v[j].x + v[j].y * v[j].y) + (v[j].z * v[j].z + v[j].w * v[j].w); }
        const float rstd = rsqrtf(wave_sum(q) * (1.f / D) + 1e-5f);
#pragma unroll
        for (int j = 0; j < 4; ++j) {
            const f32x4 g = *(const f32x4*)(lng + 4 * lane + 256 * j), bb = *(const f32x4*)(lnb + 4 * lane + 256 * j);
            v[j] = v[j] * rstd * g + bb;
        }
    }
    if (xdst) {
#pragma unroll
        for (int j = 0; j < 4; ++j) *(f32x4*)(xdst + 4 * lane + 256 * j) = v[j];
    }
    if (hdst) {
        float s = 0.f;
#pragma unroll
        for (int j = 0; j < 4; ++j) s += (v[j].x + v[j].y) + (v[j].z + v[j].w);
        const float mu = wave_sum(s) * (1.f / D);
        float q = 0.f;
#pragma unroll
        for (int j = 0; j < 4; ++j) { v[j] = v[j] - mu; q += (v[j].x * v[j].x + v[j].y * v[j].y) + (v[j].z * v[j].z + v[j].w * v[j].w); }
        const float rstd = rsqrtf(wave_sum(q) * (1.f / D) + 1e-6f);
#pragma unroll
        for (int j = 0; j < 4; ++j) {
            const f32x4 sc = *(const f32x4*)(scale + 4 * lane + 256 * j), sh = *(const f32x4*)(shift + 4 * lane + 256 * j);
            const f32x4 o = v[j] * rstd * (sc + 1.f) + sh;
            u32x2 pk; pk.x = pk2(o.x, o.y); pk.y = pk2(o.z, o.w);
            *(u32x2*)(hdst + 4 * lane + 256 * j) = pk;
        }
    }
}

DEVI const float* phase_rows_src(const P& p, unsigned char* ws_b, int row, int lnidx) {
    return (lnidx < 0) ? (row < NCTX ? pin(p, 0) + (size_t)row * D : pin(p, 1) + (size_t)(row - NCTX) * D) : (const float*)(ws_b + WS_X) + (size_t)row * D;
}
DEVI void phase_rows_one(const P& p, unsigned char* ws_b, f32x4 (&v)[4], int row, int l, int lnidx, int ml, int ms, bool final_, int lane) {
    float* X = (float*)(ws_b + WS_X);
    bf16_t* H = (bf16_t*)(ws_b + WS_H);
    const float* MOD = (const float*)(ws_b + WS_MOD);
    const float* lng = (lnidx < 0) ? nullptr : pin(p, 28) + (size_t)(l * 3 + lnidx) * D;
    const float* lnb = (lnidx < 0) ? nullptr : pin(p, 29) + (size_t)(l * 3 + lnidx) * D;
    if (final_) { row_ln_mod(v, p.out + (size_t)row * D, nullptr, lng, lnb, nullptr, nullptr, lane); return; }
    const float* mb = MOD + ((size_t)ml * 3 + mod_group(row)) * 9216;
    row_ln_mod(v, X + (size_t)row * D, H + (size_t)row * D, lng, lnb, mb + ms * D, mb + (ms + 1) * D, lane);
}
DEVI void phase_rows(const P& p, unsigned char* ws_b, int l, int lnidx, int ml, int ms, bool final_, int gw, int ngw, int lane) {
    int row = gw;
    for (; row + ngw < M; row += 2 * ngw) {
        f32x4 va[4], vb[4];
        row_load(phase_rows_src(p, ws_b, row, lnidx), va, lane);
        row_load(phase_rows_src(p, ws_b, row + ngw, lnidx), vb, lane);
        phase_rows_one(p, ws_b, va, row, l, lnidx, ml, ms, final_, lane);
        phase_rows_one(p, ws_b, vb, row + ngw, l, lnidx, ml, ms, final_, lane);
    }
    if (row < M) { f32x4 va[4]; row_load(phase_rows_src(p, ws_b, row, lnidx), va, lane); phase_rows_one(p, ws_b, va, row, l, lnidx, ml, ms, final_, lane); }
}

DEVI void phase_rowmix(const P& p, unsigned char* ws_b, int l, int gw, int ngw, int lane) {
    bf16_t* UQ = (bf16_t*)(ws_b + WS_UQ);
    const float* UKV = (const float*)(ws_b + WS_UKV);
    const float* KRF = (const float*)(ws_b + WS_KRF);
    bf16_t* CKV = (bf16_t*)(ws_b + WS_CKV);
    bf16_t* KR = (bf16_t*)(ws_b + WS_KR);
    const float* ropec = (const float*)(ws_b + WS_ROPE);
    const float* ropes = ropec + 512;
    const float* gq = pin(p, 17) + l * 384;
    const float* gkv = pin(p, 19) + l * 256;
    for (int row = gw; row < M; row += ngw) {
        {
            unsigned* up = (unsigned*)(UQ + (size_t)row * 384) + lane;
            float x[6]; float ss = 0.f;
#pragma unroll
            for (int j = 0; j < 3; ++j) { const unsigned w = up[64 * j]; x[2 * j] = bf2f(w & 0xffffu); x[2 * j + 1] = bf2f(w >> 16); ss += x[2 * j] * x[2 * j] + x[2 * j + 1] * x[2 * j + 1]; }
            const float rs = rsqrtf(wave_sum(ss) * (1.f / 384.f) + 1e-6f);
#pragma unroll
            for (int j = 0; j < 3; ++j) { const int c = 2 * lane + 128 * j; up[64 * j] = pk2(x[2 * j] * rs * gq[c], x[2 * j + 1] * rs * gq[c + 1]); }
        }
        {
            const f32x4 v = *(const f32x4*)(UKV + (size_t)row * 256 + 4 * lane);
            const float ss = v.x * v.x + v.y * v.y + v.z * v.z + v.w * v.w;
            const float rs = rsqrtf(wave_sum(ss) * (1.f / 256.f) + 1e-6f);
            const f32x4 g = *(const f32x4*)(gkv + 4 * lane);
            const f32x4 o = v * rs * g;
            u32x2 pk; pk.x = pk2(o.x, o.y); pk.y = pk2(o.z, o.w);
            *(u32x2*)(CKV + (size_t)row * 256 + 4 * lane) = pk;
            if (row < NCTX) *(f32x4*)(p.out + OUT_CKV + ((size_t)((row >> 8) * 4 + l) * 256 + (row & 255)) * 256 + 4 * lane) = o;
        }
        {
            const float v = KRF[(size_t)row * 32 + (lane & 31)];
            const float pr = __shfl_xor(v, 8);
            float o = v;
            if (row >= NCTX) {
                const int c = lane & 31, axis = c >> 4, ii = c & 15, n = (row - NCTX) & 2047;
                const int pos = axis ? (n & 63) : (n >> 6);
                const float rot = (ii < 8) ? -pr : pr;
                o = v * ropec[pos * 8 + (ii & 7)] + rot * ropes[pos * 8 + (ii & 7)];
            }
            if (lane < 32) {
                KR[(size_t)row * 32 + lane] = f2bf(o);
                if (row < NCTX) p.out[OUT_KR + ((size_t)((row >> 8) * 4 + l) * 256 + (row & 255)) * 32 + lane] = v;
            }
        }
    }
}

DEVI void transpose_item(const float* __restrict__ src, int N, int c0, int k0, bf16_t* __restrict__ dst, int K, float* scr, int lane) {
#pragma unroll 8
    for (int i = 0; i < 32; ++i) { const int kk = 2 * i + (lane >> 5); scr[kk * 33 + (lane & 31)] = src[(size_t)(k0 + kk) * N + c0 + (lane & 31)]; }
    asm volatile("s_waitcnt lgkmcnt(0)" ::: "memory");
    const int c = lane & 7;
#pragma unroll
    for (int j = 0; j < 4; ++j) {
        const int n = (lane >> 3) + 8 * j; const float* s = scr + (8 * c) * 33 + n;
        u32x4 o; o.x = pk2(s[0], s[33]); o.y = pk2(s[2 * 33], s[3 * 33]); o.z = pk2(s[4 * 33], s[5 * 33]); o.w = pk2(s[6 * 33], s[7 * 33]);
        *(u32x4*)(dst + (size_t)n * K + k0 + 8 * c) = o;
    }
    asm volatile("s_waitcnt lgkmcnt(0)" ::: "memory");
}

DEVI void prep_weight_item(const P& p, unsigned char* ws_b, int item, float* scr, int lane) {
    const int l = item / 12944; int r = item % 12944;
    bf16_t* Wl = (bf16_t*)(ws_b + WS_W) + (size_t)l * LAYER_W;
    if (r < 8448) {
        const int which = r / 4224; r %= 4224;
        if (r < 2816) {
            const int rb = r >> 4, kb = r & 15;
            const float* src = ((lane & 16) ? (which ? pin(p, 14) : pin(p, 11)) : (which ? pin(p, 13) : pin(p, 10))) + (size_t)l * D * DFF;
            transpose_item(src, DFF, rb * 16 - (lane & 16), kb * 64, Wl + (which ? OFF_W13_2 : OFF_W13_1) + (size_t)rb * 32 * D, D, scr, lane);
        } else {
            r -= 2816; const int rb = r / 44, kb = r % 44;
            const float* src = (which ? pin(p, 15) : pin(p, 12)) + (size_t)l * DFF * D;
            transpose_item(src, D, rb * 32, kb * 64, Wl + (which ? OFF_W2_2 : OFF_W2_1) + (size_t)rb * 32 * DFF, DFF, scr, lane);
        }
        return;
    }
    r -= 8448;
    if (r < 2944) {
        const int rb = r >> 4, kb = r & 15, R0 = rb * 32;
        const float* src; int N, c0;
        if (R0 < 1184) { src = pin(p, 16) + (size_t)l * D * 2720; N = 2720; c0 = R0; }
        else if (R0 < 1280) return;
        else if (R0 < 2816) { src = pin(p, 16) + (size_t)l * D * 2720; N = 2720; c0 = R0 - 96; }
        else { src = pin(p, 25) + (size_t)l * D * 3072; N = 3072; c0 = R0 - 2816; }
        transpose_item(src, N, c0, kb * 64, Wl + OFF_WIN + (size_t)R0 * D, D, scr, lane);
        return;
    }
    r -= 2944;
    if (r < 512) { const int rb = r >> 4, kb = r & 15; transpose_item(pin(p, 27) + (size_t)l * D * D, D, rb * 32, kb * 64, Wl + OFF_WOUT + (size_t)rb * 32 * D, D, scr, lane); return; }
    r -= 512;
    if (r < 768) { const int w = r >> 8; r &= 255; const int rb = r >> 3, kb = r & 7;
        transpose_item((w == 0 ? pin(p, 22) : (w == 1 ? pin(p, 23) : pin(p, 24))) + (size_t)l * 512 * D, D, rb * 32, kb * 64, Wl + (w == 0 ? OFF_WBF : (w == 1 ? OFF_WBM : OFF_WBN)) + (size_t)rb * 32 * 512, 512, scr, lane); return; }
    r -= 768;
    if (r < 144) { const int rb = r / 6, kb = r % 6; transpose_item(pin(p, 18) + (size_t)l * 384 * 768, 768, rb * 32, kb * 64, Wl + OFF_WUQ + (size_t)rb * 32 * 384, 384, scr, lane); return; }
    r -= 144;
    { const int rb = r >> 2, kb = r & 3; transpose_item(pin(p, 20) + (size_t)l * 256 * 1024, 1024, rb * 32, kb * 64, Wl + OFF_WUKV + (size_t)rb * 32 * 256, 256, scr, lane); }
}

DEVI void phase_prep(const P& p, unsigned char* ws_b, unsigned char* smem, int tid) {
    const int lane = tid & 63, wave = tid >> 6;
    const int gw = blockIdx.x * NWAVES + wave, ngw = gridDim.x * NWAVES;
    const size_t gt = (size_t)blockIdx.x * NTHREADS + tid, ngt = (size_t)gridDim.x * NTHREADS;
    {
        float* sil = (float*)smem;
        const float* wada = pin(p, 8);
        float* MODP = (float*)(ws_b + WS_MODP);
        for (int item = blockIdx.x; item < 1152; item += gridDim.x) {
            const int l = item / 288, rem = item % 288, kc = rem / 18, cb = rem % 18;
            __syncthreads();
            if (tid < 192) {
                const int g = tid >> 6, k = kc * 64 + (tid & 63);
                const float cv = (g == 0) ? pin(p, 7)[k] : pin(p, 6)[(g - 1) * D + k];
                sil[tid] = cv * sigmoidf_(cv);
            }
            __syncthreads();
            const int col = cb * NTHREADS + tid;
            const float* w = wada + ((size_t)l * D + kc * 64) * 9216 + col;
            float a0 = 0.f, a1 = 0.f, a2 = 0.f;
#pragma unroll 16
            for (int k = 0; k < 64; ++k) { const float wv = w[(size_t)k * 9216]; a0 += sil[k] * wv; a1 += sil[64 + k] * wv; a2 += sil[128 + k] * wv; }
            float* o = MODP + ((size_t)(l * 16 + kc) * 3) * 9216 + col;
            o[0] = a0; o[9216] = a1; o[2 * 9216] = a2;
        }
        __syncthreads();
    }
    {
        float* scr = (float*)smem + wave * (64 * 33);
        for (int item = gw; item < 4 * 12944; item += ngw) prep_weight_item(p, ws_b, item, scr, lane);
    }
    {
        bf16_t* TABL = (bf16_t*)(ws_b + WS_TABL);
        for (size_t e = gt; e < (size_t)2048 * 4096; e += ngt) {
            const int k = (int)(e >> 12), kk = (int)(e & 4095), lidx = kk & 2047;
            const int idx = (k * lidx) & 2047;
            float sn, cs; sincospif((float)idx * (2.f / 2048.f), &sn, &cs);
            TABL[e] = f2bf((kk < 2048 ? cs : -sn) * 0.022097086912079608f);
        }
        bf16_t* TABC = (bf16_t*)(ws_b + WS_TABC);
        for (size_t e = gt; e < (size_t)256 * 512; e += ngt) {
            const int k = (int)(e >> 9), kk = (int)(e & 511), lidx = kk & 255;
            const int idx = (k * lidx) & 255;
            float sn, cs; sincospif((float)idx * (2.f / 256.f), &sn, &cs);
            TABC[e] = f2bf((kk < 256 ? cs : -sn) * 0.0625f);
        }
        bf16_t* WCS = (bf16_t*)(ws_b + WS_WCS);
        for (size_t e = gt; e < (size_t)256 * 128; e += ngt) {
            const int i = (int)(e >> 7), c = (int)(e & 127), m = i >> 1, cs_ = i & 1;
            const int idx = (m * c) & 127;
            float sn, cs; sincospif((float)idx * (2.f / 128.f), &sn, &cs);
            WCS[e] = f2bf((cs_ ? sn : cs) * 0.08838834764831845f);
        }
        float* ROPE = (float*)(ws_b + WS_ROPE);
        for (size_t e = gt; e < 512; e += ngt) {
            const int pos = (int)(e >> 3), i = (int)(e & 7);
            const float inv_freq = powf(10000.f, -(float)i / 8.f);
            const float ang = (float)pos * inv_freq;
            ROPE[e] = cosf(ang); ROPE[512 + e] = sinf(ang);
        }
    }
    {
        bf16_t* CCKV = (bf16_t*)(ws_b + WS_CCKV);
        for (size_t e = gt; e < (size_t)NL * 1024 * 256; e += ngt) {
            const int c = (int)(e & 255), i = (int)((e >> 8) & 511), b = (int)((e >> 17) & 1), l = (int)(e >> 18);
            CCKV[e] = f2bf(pin(p, 2)[((size_t)(b * 4 + l) * 512 + i) * 256 + c]);
        }
        bf16_t* CKR = (bf16_t*)(ws_b + WS_CKR);
        for (size_t e = gt; e < (size_t)NL * 1024 * 32; e += ngt) {
            const int c = (int)(e & 31), i = (int)((e >> 5) & 511), b = (int)((e >> 14) & 1), l = (int)(e >> 15);
            CKR[e] = f2bf(pin(p, 3)[((size_t)(b * 4 + l) * 512 + i) * 32 + c]);
        }
        bf16_t* CNAK = (bf16_t*)(ws_b + WS_CNAK);
        for (size_t e = gt; e < (size_t)NL * 1024 * 512; e += ngt) {
            const int c = (int)(e & 511), i = (int)((e >> 9) & 511), b = (int)((e >> 18) & 1), l = (int)(e >> 19);
            CNAK[e] = f2bf(pin(p, 4)[((size_t)(b * 4 + l) * 512 + i) * 512 + c]);
        }
        bf16_t* CNAVT = (bf16_t*)(ws_b + WS_CNAVT);
        for (size_t e = gt; e < (size_t)NL * 1024 * 512; e += ngt) {
            const int key = (int)(e & 511), hd = (int)((e >> 9) & 511), b = (int)((e >> 18) & 1), l = (int)(e >> 19);
            CNAVT[e] = f2bf(pin(p, 5)[((size_t)(b * 4 + l) * 512 + key) * 512 + hd]);
        }
    }
}

DEVI void phase_modreduce(const P& p, unsigned char* ws_b, int tid) {
    const float* MODP = (const float*)(ws_b + WS_MODP);
    float* MOD = (float*)(ws_b + WS_MOD);
    for (int e = blockIdx.x * NTHREADS + tid; e < NL * 3 * 9216; e += gridDim.x * NTHREADS) {
        const int l = e / (3 * 9216), rem = e % (3 * 9216);
        float a = pin(p, 9)[l * 9216 + (rem % 9216)];
#pragma unroll
        for (int kc = 0; kc < 16; ++kc) a += MODP[((size_t)(l * 16 + kc) * 3) * 9216 + rem];
        MOD[e] = a;
    }
}

#define XB_TMO      128
#define XB_XCNT(j)  (256  + 64 * (j))
#define XB_XSUB(j)  (1280 + 64 * (j))
#define XB_XGEN(j)  (2304 + 64 * (j))
#define XB_TOP      3328
#define XB_TOPGEN   3392
#define XCD_BAR_WORDS 3456
#define XB_SPIN_CAP (1u << 20)
#define LAS __attribute__((address_space(3)))
DEVI unsigned xb_ld(unsigned* p)              { return __hip_atomic_load(p, __ATOMIC_RELAXED, __HIP_MEMORY_SCOPE_AGENT); }
DEVI unsigned xb_add(unsigned* p, unsigned v) { return __hip_atomic_fetch_add(p, v, __ATOMIC_RELAXED, __HIP_MEMORY_SCOPE_AGENT); }
DEVI unsigned xb_xcc_id() { return (unsigned)__builtin_amdgcn_s_getreg((3 << 11) | 20) & 0xFu; }
#define XB_SPIN(cond, bar) do { unsigned _sp = 0; while (cond) { __builtin_amdgcn_s_sleep(1); \
    if ((++_sp & 255u) == 0u) { if (xb_ld(&(bar)[XB_TMO])) break; if (_sp > XB_SPIN_CAP) { atomicAdd(&(bar)[XB_TMO], 1u); break; } } } } while (0)
struct XcdBarrier { unsigned* bar; unsigned x; volatile LAS unsigned* st; };
DEVI XcdBarrier xcd_barrier_post(unsigned* bar, volatile LAS unsigned* st) {
    XcdBarrier b; b.bar = bar; b.x = xb_xcc_id(); b.st = st;
    if (threadIdx.x == 0) (void)xb_add(&bar[XB_XCNT(b.x)], 1u);
    return b;
}
DEVI void xcd_barrier_complete(unsigned* bar, unsigned x, unsigned& nloc, unsigned& nx) {
    const unsigned G = gridDim.x * gridDim.y * gridDim.z;
    unsigned sum, cnt, mine, sp = 0u;
    for (;;) {
        sum = 0u; cnt = 0u; mine = 0u;
#pragma unroll
        for (unsigned j = 0; j < 16; ++j) { const unsigned c = xb_ld(&bar[XB_XCNT(j)]); sum += c; cnt += (c > 0u) ? 1u : 0u; mine = (j == x) ? c : mine; }
        if (sum == G) break;
        __builtin_amdgcn_s_sleep(1);
        if ((++sp & 255u) == 0u) { if (xb_ld(&bar[XB_TMO])) break; if (sp > XB_SPIN_CAP) { atomicAdd(&bar[XB_TMO], 1u); break; } }
    }
    nloc = mine > 0u ? mine : 1u; nx = cnt > 0u ? cnt : 1u;
}
DEVI void xcd_barrier(const XcdBarrier& b) {
    asm volatile("s_waitcnt vmcnt(0)" ::: "memory");
    __syncthreads();
    if (threadIdx.x == 0) {
        unsigned* bar = b.bar;
        __builtin_amdgcn_s_waitcnt(0);
        unsigned nloc = b.st[0], nx = b.st[1];
        if (nloc == 0u) { xcd_barrier_complete(bar, b.x, nloc, nx); b.st[0] = nloc; b.st[1] = nx; }
        const unsigned old = xb_add(&bar[XB_XSUB(b.x)], 1u);
        const unsigned gen = old / nloc;
        if (old + 1u == (gen + 1u) * nloc) {
            __builtin_amdgcn_fence(__ATOMIC_RELEASE, "agent");
            asm volatile("s_waitcnt vmcnt(0)" ::: "memory");
            const unsigned og = xb_add(&bar[XB_TOP], 1u);
            const unsigned tg = og / nx;
            if (og + 1u == (tg + 1u) * nx) xb_add(&bar[XB_TOPGEN], 1u);
            else XB_SPIN(xb_ld(&bar[XB_TOPGEN]) == tg, bar);
            __builtin_amdgcn_fence(__ATOMIC_ACQUIRE, "agent");
            xb_add(&bar[XB_XGEN(b.x)], 1u);
            asm volatile("s_waitcnt vmcnt(0)" ::: "memory");
        } else {
            XB_SPIN(xb_ld(&bar[XB_XGEN(b.x)]) == gen, bar);
            __builtin_amdgcn_fence(__ATOMIC_ACQUIRE, "agent");
            asm volatile("s_waitcnt vmcnt(0)" ::: "memory");
        }
    }
    __syncthreads();
}

DEVI void run_phase(const P& p, unsigned char* ws_b, int ph, unsigned char* smem, int tid) {
    const int lane = tid & 63, wave = tid >> 6;
    const int gw = blockIdx.x * NWAVES + wave, ngw = gridDim.x * NWAVES;
    const int nb = gridDim.x, bid = blockIdx.x;
    const int grp = tid >> 8, ltid = tid & 255;
    bf16_t* sm = (bf16_t*)smem + grp * (SMEM_BYTES / 2);
    if (ph == 0) { phase_prep(p, ws_b, smem, tid); return; }
    if (ph == 1) { phase_modreduce(p, ws_b, tid); return; }
    if (ph == 2) { phase_rows(p, ws_b, 0, -1, 0, 0, false, gw, ngw, lane); return; }
    const int l = (ph - 3) / 13, s = (ph - 3) % 13;
    const bf16_t* Wl = (const bf16_t*)(ws_b + WS_W) + (size_t)l * LAYER_W;
    const float* MODl = (const float*)(ws_b + WS_MOD) + (size_t)l * 3 * 9216;
    switch (s) {
    case 0: case 10:
        {
            pg8::Gemm g{(const bf16_t*)(ws_b + WS_H), Wl + (s == 10 ? OFF_W13_2 : OFF_W13_1), M, 2 * DFF, D};
            pg8::StaticOrder S; S.init(M, 2 * DFF, nb, bid);
            pg8::EpiSwiGLU E{(bf16_t*)(ws_b + WS_ACT)};
            pg8::gemm_phase<pg8::EpiSwiGLU, pg8::StaticOrder, true, true>((PG8_LAS unsigned char*)smem, g, S, E, tid);
        }
        break;
    case 1: case 11:
        {
            pg8::Gemm g{(const bf16_t*)(ws_b + WS_ACT), Wl + (s == 11 ? OFF_W2_2 : OFF_W2_1), M, D, DFF};
            pg8::StaticOrder S; S.init(M, D, nb, bid);
            pg8::EpiResid E{(float*)(ws_b + WS_X), MODl + (s == 11 ? 8 : 2) * D, 0.5f};
            pg8::gemm_phase<pg8::EpiResid, pg8::StaticOrder, false, true>((PG8_LAS unsigned char*)smem, g, S, E, tid);
        }
        break;
    case 2: phase_rows(p, ws_b, l, 0, l, 3, false, gw, ngw, lane); break;
    case 3:
        {
            pg8::Gemm g{(const bf16_t*)(ws_b + WS_H), Wl + OFF_WIN, M, 5888, D};
            pg8::StaticOrder S; S.init(M, 5888, nb, bid);
            pg8::EpiIn E{ws_b, p.out, pin(p, 26), l};
            pg8::gemm_phase<pg8::EpiIn, pg8::StaticOrder, true, true>((PG8_LAS unsigned char*)smem, g, S, E, tid);
        }
        break;
    case 4: phase_rowmix(p, ws_b, l, gw, ngw, lane); break;
    case 5: {
        float* ex = (float*)smem + (wave & 3) * (34 * 64);
        int u = bid;
        for (; u < 256; u += nb) {
            const int wi = u * 4 + (wave & 3);
            float* rpb_lds = (float*)(smem + 36864);
            {
                const float* rsrc = pin(p, 21) + (size_t)(l * 8 + ((u * 4 >> 6) & 7)) * 465;
                if (tid < 465) rpb_lds[tid] = rsrc[tid] * LOG2E;
                __syncthreads();
            }
            attn_na_lat(p, ws_b, l, wi >> 9, (wi >> 6) & 7, (wi >> 1) & 31, wi & 1, lane, ex, wave >> 2, rpb_lds);
        }
        for (; u < 256 + 416; u += nb) job_ukv(p, ws_b, l, 2 * (u - 256) + grp, sm, ltid);
        for (; u < 256 + 416 + 288; u += nb) job_uq(p, ws_b, l, 2 * (u - 256 - 416) + grp, sm, ltid);
        for (; u < 256 + 416 + 288 + 384; u += nb) job_f1(p, ws_b, 2 * (u - 256 - 416 - 288) + grp, sm, ltid);
        for (; u < 256 + 416 + 288 + 384 + 256; u += nb) {
            const int wi = (u - 256 - 416 - 288 - 384) * 8 + wave;
            attn_na_ctx(p, ws_b, wi >> 6, (wi >> 3) & 7, wi & 7, lane);
        }
    } break;
    case 6: {
        float* ex = (float*)smem + (wave & 3) * (34 * 64);
        int u = bid;
        for (; u < 256; u += nb) {
            const int wi = u * 4 + (wave & 3);
            attn_mla_lat_shared(p, ws_b, l, wi >> 9, (wi >> 6) & 7, wi & 63, tid, smem, ex);
        }
        for (; u < 256 + 128; u += nb) {
            const int t0 = u - 256, tt = ((t0 & 7) + 8 * ((t0 >> 3) >> 2)) * 4 + ((t0 >> 3) & 3);
            job_f2_lat(p, ws_b, tt, sm, ltid, grp, (float*)(smem + SMEM_BYTES));
        }
        for (; u < 256 + 128 + 128; u += nb) job_f2_ctx(p, ws_b, 2 * (u - 256 - 128) + grp, sm, ltid);
        for (; u < 256 + 128 + 128 + 256; u += nb) {
            const int wi = (u - 256 - 128 - 128) * 8 + wave;
            attn_mla(p, ws_b, l, false, wi >> 6, (wi >> 3) & 7, wi & 7, lane);
        }
    } break;
    case 7:

#pragma nounroll
        for (int sg = 0; sg < 3; ++sg) {
            int tid3 = tid; asm volatile("" : "+v"(tid3));
            pg8::Gemm g{(const bf16_t*)(ws_b + (sg == 0 ? WS_YF : (sg == 1 ? WS_YM : WS_YN))), Wl + (sg == 0 ? OFF_WBF : (sg == 1 ? OFF_WBM : OFF_WBN)), M, D, 512};
            pg8::StaticOrder S; S.init(M, D, nb, bid);
            pg8::EpiMerge E{(const bf16_t*)(ws_b + WS_GATE), (bf16_t*)(ws_b + WS_UF)  , (bf16_t*)(ws_b + WS_MERGED), sg};
            pg8::gemm_phase<pg8::EpiMerge, pg8::StaticOrder, false, true>((PG8_LAS unsigned char*)smem, g, S, E, tid3);
        }
        break;
    case 8:
        {
            pg8::Gemm g{(const bf16_t*)(ws_b + WS_MERGED), Wl + OFF_WOUT, M, D, D};
            pg8::StaticOrder S; S.init(M, D, nb, bid);
            pg8::EpiResid E{(float*)(ws_b + WS_X), MODl + 5 * D, 1.0f};
            pg8::gemm_phase<pg8::EpiResid, pg8::StaticOrder, false, true>((PG8_LAS unsigned char*)smem, g, S, E, tid);
        }
        break;
    case 9: phase_rows(p, ws_b, l, 1, l, 6, false, gw, ngw, lane); break;
    case 12:
        if (l == NL - 1) phase_rows(p, ws_b, l, 2, 0, 0, true, gw, ngw, lane);
        else phase_rows(p, ws_b, l, 2, l + 1, 0, false, gw, ngw, lane);
        break;
    default: break;
    }
}

__global__ void __launch_bounds__(NTHREADS, 2) mega_kernel(P p) {
    extern __shared__ __attribute__((aligned(16))) unsigned char smem[];
    __shared__ uint4 xb_words;
    cg::grid_group grid = cg::this_grid();
    const int tid = threadIdx.x;
    unsigned* bar = (unsigned*)(p.ws + WS_BAR);
    if (tid == 0) xb_words = make_uint4(0u, 0u, 0u, 0u);
    if (p.ph_lo == 0 && blockIdx.x == 0) for (int i = tid; i < XCD_BAR_WORDS; i += NTHREADS) bar[i] = 0u;
    __syncthreads();
    XcdBarrier xb; xb.bar = bar; xb.x = 0; xb.st = (volatile LAS unsigned*)&xb_words;
#pragma nounroll
    for (int ph = p.ph_lo; ph < p.ph_hi; ++ph) {
        int tid2 = tid; asm volatile("" : "+v"(tid2));
        unsigned char* ws_b = p.ws; asm volatile("" : "+s"(ws_b));
        run_phase(p, ws_b, ph, smem, tid2);
        if (ph + 1 < p.ph_hi) {
            if (ph == p.ph_lo) { grid.sync(); xb = xcd_barrier_post(bar, (volatile LAS unsigned*)&xb_words); }
            else xcd_barrier(xb);
        }
    }
}

extern "C" void kernel_launch(void* const* d_in, const int* in_sizes, int n_in, void* d_out, int out_size, void* d_ws, size_t ws_size,
                              hipStream_t stream) {
    static int grid_blocks = 0;
    if (grid_blocks == 0) {
        if (n_in != 30 || ws_size < WS_END) { fprintf(stderr, "kernel_launch: n_in %d ws %zu need %zu\n", n_in, ws_size, (size_t)WS_END); grid_blocks = -1; return; }
        int dev = 0, cus = 0, per_cu = 0;
        hipGetDevice(&dev);
        hipDeviceGetAttribute(&cus, hipDeviceAttributeMultiprocessorCount, dev);
        hipFuncSetAttribute((const void*)mega_kernel, hipFuncAttributeMaxDynamicSharedMemorySize, LDS_TOTAL);
        hipOccupancyMaxActiveBlocksPerMultiprocessor(&per_cu, (const void*)mega_kernel, NTHREADS, LDS_TOTAL);
        if (per_cu < 1) per_cu = 1;
        if (per_cu > 1) per_cu = 1;
        grid_blocks = cus * per_cu;
    }
    if (grid_blocks < 0) return;
    P p{};
    for (int i = 0; i < 30; ++i) p.in[i] = (const float*)d_in[i];
    p.out = (float*)d_out; p.ws = (unsigned char*)d_ws; p.ph_lo = 0; p.ph_hi = NPHASE;
#ifndef MULTI_LAUNCH
#define MULTI_LAUNCH 0
#endif
#if MULTI_LAUNCH
    for (int ph = 0; ph < NPHASE; ++ph) {
        p.ph_lo = ph; p.ph_hi = ph + 1;
        hipLaunchKernelGGL(mega_kernel, dim3(grid_blocks), dim3(NTHREADS), LDS_TOTAL, stream, p);
    }
#else
    void* args[] = {&p};
    hipError_t e = hipLaunchCooperativeKernel((const void*)mega_kernel, dim3(grid_blocks), dim3(NTHREADS), args, LDS_TOTAL, stream);
    if (e != hipSuccess) fprintf(stderr, "cooperative launch failed: %s (grid %d)\n", hipGetErrorString(e), grid_blocks);
#endif
}
```

```cpp
#include <hip/hip_runtime.h>
#include <hip/hip_cooperative_groups.h>
#include <cstdint>
#include <cstdio>
namespace cg = cooperative_groups;

typedef unsigned short bf16_t;
typedef short bf16x8 __attribute__((ext_vector_type(8)));
typedef float f32x16 __attribute__((ext_vector_type(16)));
typedef float f32x4 __attribute__((ext_vector_type(4)));
typedef unsigned u32x4 __attribute__((ext_vector_type(4)));
typedef unsigned u32x2 __attribute__((ext_vector_type(2)));
#define DEVI __device__ __forceinline__

constexpr int D = 1024, NCTX = 8192, NLAT = 4096, M = 12288, MX = 13312, DFF = 2816, NL = 4;
constexpr float ALPHA_F = 1.6817928305074290f;
constexpr float LOG2E = 1.4426950408889634f;
constexpr float MLA_QS = 0.10206207261596575f * LOG2E;
constexpr float NA_QS = 0.125f * LOG2E;
constexpr size_t OUT_CKV = 12582912, OUT_KR = 20971520, OUT_NAK = 22020096, OUT_NAV = 38797312;

constexpr size_t al256(size_t x) { return (x + 255) & ~(size_t)255; }
constexpr size_t WS_BAR = 0;
constexpr size_t WS_X = 16384;
constexpr size_t WS_H = WS_X + (size_t)M * D * 4;
constexpr size_t WS_MOD = WS_H + (size_t)M * D * 2;
constexpr size_t WS_MODP = WS_MOD + al256((size_t)NL * 3 * 9216 * 4);
constexpr size_t WS_ROPE = WS_MODP + al256((size_t)NL * 16 * 3 * 9216 * 4);
constexpr size_t WS_TABC = WS_ROPE + 4096;
constexpr size_t WS_TABL = WS_TABC + (size_t)256 * 512 * 2;
constexpr size_t WS_WCS = WS_TABL + (size_t)2048 * 4096 * 2;
constexpr size_t WS_CCKV = WS_WCS + (size_t)256 * 128 * 2;
constexpr size_t WS_CKR = WS_CCKV + (size_t)NL * 1024 * 256 * 2;
constexpr size_t WS_CNAK = WS_CKR + (size_t)NL * 1024 * 32 * 2;
constexpr size_t WS_CNAVT = WS_CNAK + (size_t)NL * 1024 * 512 * 2;
constexpr size_t WS_W = WS_CNAVT + (size_t)NL * 1024 * 512 * 2;
constexpr size_t OFF_W13_1 = 0, OFF_W2_1 = 5767168, OFF_W13_2 = 8650752, OFF_W2_2 = 14417920, OFF_WIN = 17301504,
                 OFF_WOUT = 23330816, OFF_WBF = 24379392, OFF_WBM = 24903680, OFF_WBN = 25427968, OFF_WUQ = 25952256,
                 OFF_WUKV = 26247168, LAYER_W = 26509312;
constexpr size_t WS_R1 = WS_W + (size_t)NL * LAYER_W * 2;
constexpr size_t WS_ACT = WS_R1;
constexpr size_t WS_UF = WS_R1;
constexpr size_t WS_UQ = WS_UF + (size_t)M * 512 * 2;
constexpr size_t WS_UKV = WS_UQ + (size_t)M * 384 * 2;
constexpr size_t WS_KRF = WS_UKV + (size_t)M * 256 * 4;
constexpr size_t WS_CKV = WS_KRF + (size_t)M * 32 * 4;
constexpr size_t WS_KR = WS_CKV + (size_t)M * 256 * 2;
constexpr size_t WS_NAQ = WS_KR + (size_t)M * 32 * 2;
constexpr size_t WS_NAK = WS_NAQ + (size_t)M * 512 * 2;
constexpr size_t WS_NAVT = WS_NAK + (size_t)M * 512 * 2;
constexpr size_t WS_GATE = WS_NAVT + (size_t)M * 512 * 2;
constexpr size_t WS_Q = WS_GATE + (size_t)M * 3072 * 2;
constexpr size_t WS_KN = WS_Q + (size_t)M * 768 * 2;
constexpr size_t WS_VTM = WS_KN + (size_t)MX * 512 * 2;
constexpr size_t WS_F1T = WS_VTM + (size_t)MX * 512 * 2;
constexpr size_t WS_YF = WS_F1T + (size_t)M * 1024 * 2;
constexpr size_t WS_YM = WS_YF + (size_t)M * 512 * 2;
constexpr size_t WS_YN = WS_YM + (size_t)M * 512 * 2;
constexpr size_t WS_MERGED = WS_YN + (size_t)M * 512 * 2;
constexpr size_t WS_END = WS_MERGED + (size_t)M * 1024 * 2;
static_assert(WS_END - WS_R1 >= (size_t)M * DFF * 2, "ACT must fit in R1");
static_assert(WS_NAK - WS_UF >= (size_t)M * D * 4, "merge T32 must fit in the dead UF..NAQ buffers");

constexpr int NPHASE = 3 + 13 * NL;

struct P {
    const float* in[30];
    float* out;
    unsigned char* ws;
    int ph_lo, ph_hi;
};

__device__ __forceinline__ const float* pin(const P& p, int i) { int j = i; asm volatile("" : "+s"(j)); return p.in[j]; }
typedef __bf16 bf16v2 __attribute__((ext_vector_type(2)));
typedef float f32x2 __attribute__((ext_vector_type(2)));
DEVI unsigned pk2(float lo, float hi) { f32x2 v = {lo, hi}; bf16v2 b = __builtin_convertvector(v, bf16v2); return __builtin_bit_cast(unsigned, b); }
DEVI bf16_t f2bf(float x) { return (bf16_t)(pk2(x, 0.f) & 0xffffu); }
DEVI float bf2f(unsigned v) { return __uint_as_float(v << 16); }
DEVI float wave_sum(float v) {
#pragma unroll
    for (int o = 1; o < 64; o <<= 1) v += __shfl_xor(v, o);
    return v;
}
DEVI float fast_exp2(float x) { return __builtin_amdgcn_exp2f(x); }
DEVI float sigmoidf_(float x) { return 1.f / (1.f + __expf(-x)); }

constexpr int LDT = 72;
constexpr int TILE_E = 128 * LDT;
constexpr int SMEM_BYTES = 4 * TILE_E * 2;
constexpr int NTHREADS = 512, NWAVES = 8, LDS_TOTAL = 2 * SMEM_BYTES;

DEVI void gemm_ldg(const bf16_t* ga, const bf16_t* gb, int lda, int ldb, u32x4 (&ra)[4], u32x4 (&rb)[4]) {
#pragma unroll
    for (int i = 0; i < 4; ++i) {
        ra[i] = *(const u32x4*)(ga + (size_t)(32 * i) * lda);
        rb[i] = *(const u32x4*)(gb + (size_t)(32 * i) * ldb);
    }
}
DEVI void gemm_sts(bf16_t* buf, int soff, const u32x4 (&ra)[4], const u32x4 (&rb)[4]) {
#pragma unroll
    for (int i = 0; i < 4; ++i) {
        *(u32x4*)(buf + soff + 32 * i * LDT) = ra[i];
        *(u32x4*)(buf + TILE_E + soff + 32 * i * LDT) = rb[i];
    }
}
DEVI void gemm_mma(const bf16_t* cur, int aoff, int boff, f32x16 (&acc)[2][2]) {
#pragma unroll
    for (int ks = 0; ks < 4; ++ks) {
        bf16x8 a0 = *(const bf16x8*)(cur + aoff + ks * 16);
        bf16x8 a1 = *(const bf16x8*)(cur + aoff + 32 * LDT + ks * 16);
        bf16x8 b0 = *(const bf16x8*)(cur + boff + ks * 16);
        bf16x8 b1 = *(const bf16x8*)(cur + boff + 32 * LDT + ks * 16);
        acc[0][0] = __builtin_amdgcn_mfma_f32_32x32x16_bf16(a0, b0, acc[0][0], 0, 0, 0);
        acc[0][1] = __builtin_amdgcn_mfma_f32_32x32x16_bf16(a0, b1, acc[0][1], 0, 0, 0);
        acc[1][0] = __builtin_amdgcn_mfma_f32_32x32x16_bf16(a1, b0, acc[1][0], 0, 0, 0);
        acc[1][1] = __builtin_amdgcn_mfma_f32_32x32x16_bf16(a1, b1, acc[1][1], 0, 0, 0);
    }
}

template <bool DEEP = true>
DEVI void gemm_core(const bf16_t* __restrict__ A, int lda, const bf16_t* __restrict__ B, int ldb, int K,
                    f32x16 (&acc)[2][2], bf16_t* smem, int tid) {
    const int lane = tid & 63, wave = tid >> 6, wr = wave >> 1, wc = wave & 1;
    const int lr = tid >> 3, lc = (tid & 7) * 8;
    const bf16_t* ga = A + (size_t)lr * lda + lc;
    const bf16_t* gb = B + (size_t)lr * ldb + lc;
    const int soff = lr * LDT + lc;
    const int nk = K >> 6;
    const int aoff = (wr * 64 + (lane & 31)) * LDT + (lane >> 5) * 8;
    const int boff = TILE_E + (wc * 64 + (lane & 31)) * LDT + (lane >> 5) * 8;
    bf16_t* buf0 = smem; bf16_t* buf1 = smem + 2 * TILE_E;
    if constexpr (DEEP) {
        u32x4 ra0[4], rb0[4], ra1[4], rb1[4];
        gemm_ldg(ga, gb, lda, ldb, ra0, rb0);
        gemm_ldg(ga + 64, gb + 64, lda, ldb, ra1, rb1);
        gemm_sts(buf0, soff, ra0, rb0);
        __syncthreads();
        for (int kt = 0; kt < nk; kt += 2) {
            if (kt + 2 < nk) gemm_ldg(ga + (size_t)(kt + 2) * 64, gb + (size_t)(kt + 2) * 64, lda, ldb, ra0, rb0);
            gemm_mma(buf0, aoff, boff, acc);
            gemm_sts(buf1, soff, ra1, rb1);
            __syncthreads();
            if (kt + 3 < nk) gemm_ldg(ga + (size_t)(kt + 3) * 64, gb + (size_t)(kt + 3) * 64, lda, ldb, ra1, rb1);
            gemm_mma(buf1, aoff, boff, acc);
            if (kt + 2 < nk) gemm_sts(buf0, soff, ra0, rb0);
            __syncthreads();
        }
    } else {
        u32x4 ra[4], rb[4];
        gemm_ldg(ga, gb, lda, ldb, ra, rb);
        gemm_sts(buf0, soff, ra, rb);
        __syncthreads();
        for (int kt = 0; kt < nk; ++kt) {
            bf16_t* cur = (kt & 1) ? buf1 : buf0;
            bf16_t* nxt = (kt & 1) ? buf0 : buf1;
            const bool more = (kt + 1 < nk);
            if (more) { ga += 64; gb += 64; gemm_ldg(ga, gb, lda, ldb, ra, rb); }
            gemm_mma(cur, aoff, boff, acc);
            if (more) gemm_sts(nxt, soff, ra, rb);
            __syncthreads();
        }
    }
}

DEVI void zero_acc(f32x16 (&acc)[2][2]) {
#pragma unroll
    for (int i = 0; i < 2; ++i)
#pragma unroll
        for (int j = 0; j < 2; ++j)
#pragma unroll
            for (int r = 0; r < 16; ++r) acc[i][j][r] = 0.f;
}

#define EPI_SETUP const int lane = tid & 63, wave = tid >> 6, wr = wave >> 1, wc = wave & 1, hl = lane >> 5, c32 = lane & 31; (void)wr; (void)wc; (void)hl; (void)c32;

DEVI int mod_group(int row) { return row < NCTX ? 0 : 1 + ((row - NCTX) >> 11); }

namespace pg8 {
#define PG8_LAS __attribute__((address_space(3)))
constexpr int BM = 256, BK = 64, HALF = 128, HTB = HALF * BK * 2, NXCD = 8, WGM = 8;
DEVI int lds_byte(int r, int c) { const int st = (r >> 4) * 2 + (c >> 5), rr = r & 15, cc = c & 31, ob = rr * 64 + cc * 2; return st * 1024 + (ob ^ (((ob >> 9) & 1) << 5)); }
DEVI void stage_rc(int b, int& R, int& C) { const int st = b / 1024, sb = b % 1024, swz = sb ^ (((sb >> 9) & 1) << 5); R = (st >> 1) * 16 + swz / 64; C = (st & 1) * 32 + (swz % 64) / 2; }
DEVI int perm32(int rho) { const int n = rho >> 4, i = rho & 15; return 8 * (i >> 2) + 4 * n + (i & 3); }
struct Unit { int pm, pn; };
struct Gemm { const bf16_t* A; const bf16_t* Bt; int M, N, K; };
struct StaticOrder {
    int nM, nN, nwg, G, c;
    DEVI void init(int M, int N, int G_, int c_) { nM = M / BM; nN = N / BM; nwg = nM * nN; G = G_; c = c_; }
    DEVI bool next(int i, Unit& u) const {
        const long L = (long)i * G + c; if (L >= nwg) return false;
        int wgid = (int)L; { const int q = nwg / NXCD, r = nwg % NXCD, xcd = wgid % NXCD, off = wgid / NXCD; wgid = (xcd < r ? xcd * (q + 1) : r * (q + 1) + (xcd - r) * q) + off; }
        const int nig = WGM * nN, gid = wgid / nig, fm = gid * WGM, gsz = (nM - fm) < WGM ? (nM - fm) : WGM;
        u.pm = fm + ((wgid % nig) % gsz); u.pn = (wgid % nig) / gsz; return true;
    }
    DEVI void a_ready(const Unit&) const {}
    DEVI void done(const Unit&) const {}
};
template <class Epi, class Sched, bool ALIGN_EPI = false, bool SP2 = false>
DEVI void gemm_phase(PG8_LAS unsigned char* lds, const Gemm g, const Sched& S, const Epi& E, const int tid) {
    const int wid = __builtin_amdgcn_readfirstlane(tid >> 6), lane = tid & 63, wr = wid >> 2, wc = wid & 3, fr = lane & 15, fq = lane >> 4;
    const int K = g.K, nt = K / BK;
    unsigned voffA[2], voffB[2];
#pragma unroll
    for (int i = 0; i < 2; ++i) { int R, C; stage_rc(tid * 16 + i * 8192, R, C); const int Rb = Epi::PERM ? ((R & ~31) + perm32(R & 31)) : R;
        voffA[i] = (unsigned)(R * K + C) * 2u; voffB[i] = (unsigned)(Rb * K + C) * 2u; }
    const size_t kstep = (size_t)(BK * 2);
    const size_t hstep = (size_t)HALF * K * 2;
    const size_t tstep = 2 * hstep;
    const unsigned ldsw = (unsigned)wid * 1024u;
    const int aoff = lds_byte(wr * 64 + fr, fq * 8), boff = lds_byte(wc * 32 + fr, fq * 8);
#define PG8_SA(b, h) (((b) * 2 + (h)) * HTB)
#define PG8_SB(b, h) ((4 + (b) * 2 + (h)) * HTB)
#define PG8_STAGE(bufoff, gbase, voff) do { _Pragma("unroll") for (int _i = 0; _i < 2; ++_i) \
        __builtin_amdgcn_global_load_lds((const unsigned*)((const char*)(gbase) + (voff)[_i]), (PG8_LAS unsigned*)(lds + (bufoff) + ldsw + _i * 8192), 16, 0, 0); } while (0)
#define PG8_LDA(dst, b, h) do { _Pragma("unroll") for (int m = 0; m < 4; ++m) _Pragma("unroll") for (int k = 0; k < 2; ++k) dst[m][k] = *(const PG8_LAS bf16x8*)(lds + PG8_SA(b, h) + aoff + m * 2048 + k * 1024); } while (0)
#define PG8_LDB(dst, b, h) do { _Pragma("unroll") for (int n = 0; n < 2; ++n) _Pragma("unroll") for (int k = 0; k < 2; ++k) dst[n][k] = *(const PG8_LAS bf16x8*)(lds + PG8_SB(b, h) + boff + n * 2048 + k * 1024); } while (0)
#define PG8_MMA(ai, bj, At, Bt) do { __builtin_amdgcn_s_setprio(1); _Pragma("unroll") for (int m = 0; m < 4; ++m) _Pragma("unroll") for (int n = 0; n < 2; ++n) _Pragma("unroll") for (int k = 0; k < 2; ++k) \
        acc[ai][bj][m][n] = __builtin_amdgcn_mfma_f32_16x16x32_bf16(Bt[n][k], At[m][k], acc[ai][bj][m][n], 0, 0, 0); __builtin_amdgcn_s_setprio(0); } while (0)
#define PG8_WAIT_V(n) asm volatile("s_waitcnt vmcnt(" #n ")" ::: "memory")
#define PG8_WAIT_L(n) asm volatile("s_waitcnt lgkmcnt(" #n ")" ::: "memory")
#define PG8_BAR __builtin_amdgcn_s_barrier()
#define PG8_SCHED __builtin_amdgcn_sched_barrier(0)
    Unit cur, nxt; int ui = 0;
    if (!S.next(0, cur)) return;
    f32x4 acc[2][2][4][2];
#pragma unroll
    for (int a = 0; a < 2; ++a)
#pragma unroll
        for (int b = 0; b < 2; ++b)
#pragma unroll
            for (int m = 0; m < 4; ++m)
#pragma unroll
                for (int n = 0; n < 2; ++n) acc[a][b][m][n] = (f32x4){0.f, 0.f, 0.f, 0.f};
    bf16x8 At[4][2], B0[2][2], B1[2][2];
    const char* cA = (const char*)g.A + (size_t)cur.pm * tstep; const char* cB = (const char*)g.Bt + (size_t)cur.pn * tstep;
    S.a_ready(cur);
    if constexpr (SP2) {
        PG8_STAGE(PG8_SB(0, 0), cB, voffB); PG8_STAGE(PG8_SB(0, 1), cB + hstep, voffB); PG8_STAGE(PG8_SA(0, 0), cA, voffA); PG8_STAGE(PG8_SA(0, 1), cA + hstep, voffA);
        if (wr == 1) PG8_BAR;
        PG8_WAIT_V(2); PG8_BAR;
        PG8_STAGE(PG8_SB(1, 0), cB + kstep, voffB); PG8_STAGE(PG8_SA(1, 0), cA + kstep, voffA); PG8_STAGE(PG8_SB(1, 1), cB + hstep + kstep, voffB);
        PG8_WAIT_V(6); PG8_BAR;
    } else {
        PG8_STAGE(PG8_SB(0, 0), cB, voffB); PG8_STAGE(PG8_SA(0, 0), cA, voffA); PG8_STAGE(PG8_SB(0, 1), cB + hstep, voffB); PG8_STAGE(PG8_SA(0, 1), cA + hstep, voffA);
        if (wr == 1) PG8_BAR;
        PG8_WAIT_V(4); PG8_BAR;
        PG8_STAGE(PG8_SB(1, 0), cB + kstep, voffB); PG8_STAGE(PG8_SA(1, 0), cA + kstep, voffA); PG8_STAGE(PG8_SB(1, 1), cB + hstep + kstep, voffB);
        PG8_WAIT_V(6); PG8_BAR;
    }
    for (;;) {
        const bool has_next = S.next(ui + 1, nxt);
        const char* nA = has_next ? (const char*)g.A + (size_t)nxt.pm * tstep : cA; const char* nB = has_next ? (const char*)g.Bt + (size_t)nxt.pn * tstep : cB;
        for (int t = 0; t < nt; t += 2) {
            const bool last = (t == nt - 2);
            const char* a1 = cA + (size_t)(t + 1) * kstep;
            const char* a2 = last ? nA : cA + (size_t)(t + 2) * kstep; const char* b2 = last ? nB : cB + (size_t)(t + 2) * kstep;
            const char* a3 = a2 + kstep; const char* b3 = b2 + kstep;
            if (last && has_next) S.a_ready(nxt);
            if constexpr (SP2) {
            PG8_LDB(B0, 0, 0); PG8_LDB(B1, 0, 1); PG8_SCHED; PG8_LDA(At, 0, 0); PG8_STAGE(PG8_SA(1, 1), a1 + hstep, voffA);
            PG8_WAIT_V(8); PG8_WAIT_L(0); PG8_BAR; PG8_MMA(0, 0, At, B0); PG8_MMA(0, 1, At, B1); PG8_BAR; PG8_SCHED;
            PG8_LDA(At, 0, 1); PG8_STAGE(PG8_SB(0, 0), b2, voffB); PG8_STAGE(PG8_SB(0, 1), b2 + hstep, voffB); PG8_STAGE(PG8_SA(0, 0), a2, voffA);
            PG8_WAIT_V(8); PG8_WAIT_L(0); PG8_BAR; PG8_MMA(1, 0, At, B0); PG8_MMA(1, 1, At, B1); PG8_BAR; PG8_SCHED;
            PG8_LDB(B0, 1, 0); PG8_LDB(B1, 1, 1); PG8_SCHED; PG8_LDA(At, 1, 0); PG8_STAGE(PG8_SA(0, 1), a2 + hstep, voffA);
            PG8_WAIT_V(8); PG8_WAIT_L(0); PG8_BAR; PG8_MMA(0, 0, At, B0); PG8_MMA(0, 1, At, B1); PG8_BAR; PG8_SCHED;
            PG8_LDA(At, 1, 1); PG8_STAGE(PG8_SB(1, 0), b3, voffB); PG8_STAGE(PG8_SB(1, 1), b3 + hstep, voffB); PG8_STAGE(PG8_SA(1, 0), a3, voffA);
            PG8_WAIT_V(8); PG8_WAIT_L(0); PG8_BAR; PG8_MMA(1, 0, At, B0); PG8_MMA(1, 1, At, B1); PG8_BAR; PG8_SCHED;
            } else {
            PG8_LDB(B0, 0, 0); PG8_SCHED; PG8_LDA(At, 0, 0); PG8_STAGE(PG8_SA(1, 1), a1 + hstep, voffA);
            PG8_WAIT_L(8); PG8_BAR; PG8_WAIT_L(0); PG8_MMA(0, 0, At, B0); PG8_BAR; PG8_SCHED;
            PG8_LDB(B1, 0, 1); PG8_STAGE(PG8_SB(0, 0), b2, voffB);
            PG8_BAR; PG8_WAIT_L(0); PG8_MMA(0, 1, At, B1); PG8_BAR;
            PG8_LDA(At, 0, 1); PG8_STAGE(PG8_SA(0, 0), a2, voffA);
            PG8_BAR; PG8_WAIT_L(0); PG8_MMA(1, 0, At, B0); PG8_BAR; PG8_SCHED;
            PG8_STAGE(PG8_SB(0, 1), b2 + hstep, voffB);
            PG8_WAIT_V(6); PG8_BAR; PG8_MMA(1, 1, At, B1); PG8_BAR;
            PG8_LDB(B0, 1, 0); PG8_SCHED; PG8_LDA(At, 1, 0); PG8_STAGE(PG8_SA(0, 1), a2 + hstep, voffA);
            PG8_WAIT_L(8); PG8_BAR; PG8_WAIT_L(0); PG8_MMA(0, 0, At, B0); PG8_BAR; PG8_SCHED;
            PG8_LDB(B1, 1, 1); PG8_STAGE(PG8_SB(1, 0), b3, voffB);
            PG8_BAR; PG8_WAIT_L(0); PG8_MMA(0, 1, At, B1); PG8_BAR;
            PG8_LDA(At, 1, 1); PG8_STAGE(PG8_SA(1, 0), a3, voffA);
            PG8_BAR; PG8_WAIT_L(0); PG8_MMA(1, 0, At, B0); PG8_BAR; PG8_SCHED;
            PG8_STAGE(PG8_SB(1, 1), b3 + hstep, voffB);
            PG8_WAIT_V(6); PG8_BAR; PG8_MMA(1, 1, At, B1); PG8_BAR;
            }
        }
        if constexpr (ALIGN_EPI) { if (wr == 0) PG8_BAR; }
        E(acc, cur, wr, wc, fr, fq); S.done(cur);
        if (!has_next) break;
#pragma unroll
        for (int a = 0; a < 2; ++a)
#pragma unroll
            for (int b = 0; b < 2; ++b)
#pragma unroll
                for (int m = 0; m < 4; ++m)
#pragma unroll
                    for (int n = 0; n < 2; ++n) acc[a][b][m][n] = (f32x4){0.f, 0.f, 0.f, 0.f};
        cur = nxt; cA = nA; cB = nB; ++ui;
        if constexpr (ALIGN_EPI) { if (wr == 1) PG8_BAR; }
    }
    PG8_WAIT_V(0);
    if constexpr (!ALIGN_EPI) { if (wr == 0) PG8_BAR; }
    PG8_BAR;
#undef PG8_SA
#undef PG8_SB
#undef PG8_STAGE
#undef PG8_LDA
#undef PG8_LDB
#undef PG8_MMA
#undef PG8_WAIT_V
#undef PG8_WAIT_L
#undef PG8_BAR
#undef PG8_SCHED
}

struct EpiSwiGLU {
    static constexpr bool PERM = false;
    bf16_t* ACT;
    DEVI void operator()(const f32x4 (&acc)[2][2][4][2], const Unit& u, int wr, int wc, int fr, int fq) const {
#pragma unroll
        for (int ai = 0; ai < 2; ++ai)
#pragma unroll
            for (int m = 0; m < 4; ++m) {
                const int row = u.pm * BM + ai * HALF + wr * 64 + m * 16 + fr;
                bf16_t* rp = ACT + (size_t)row * DFF + 16 * (8 * u.pn + wc) + 4 * fq;
#pragma unroll
                for (int bj = 0; bj < 2; ++bj) {
                    const f32x4 a = acc[ai][bj][m][0], b = acc[ai][bj][m][1];
                    u32x2 pk;
                    pk.x = pk2(a[0] * sigmoidf_(a[0]) * b[0], a[1] * sigmoidf_(a[1]) * b[1]);
                    pk.y = pk2(a[2] * sigmoidf_(a[2]) * b[2], a[3] * sigmoidf_(a[3]) * b[3]);
                    *(u32x2*)(rp + 64 * bj) = pk;
                }
            }
    }
};
struct EpiResid {
    static constexpr bool PERM = false;
    float* X; const float* gate_base; float coef;
    DEVI void operator()(const f32x4 (&acc)[2][2][4][2], const Unit& u, int wr, int wc, int fr_, int fq_) const {
        int fr = fr_, fq = fq_; asm volatile("" : "+v"(fr), "+v"(fq));
        const float* gate = gate_base + (size_t)mod_group(u.pm * BM) * 9216;
        const int col0 = u.pn * BM + wc * 32 + 4 * fq;
        f32x4 gv[2][2];
#pragma unroll
        for (int bj = 0; bj < 2; ++bj)
#pragma unroll
            for (int n = 0; n < 2; ++n) gv[bj][n] = *(const f32x4*)(gate + col0 + bj * HALF + 16 * n) * coef;
#pragma unroll
        for (int ah = 0; ah < 4; ++ah) {
            const int ai = ah >> 1, mb = (ah & 1) * 2;
            f32x4 xv[4][2][2];
#pragma unroll
            for (int m = mb; m < mb + 2; ++m)
#pragma unroll
                for (int bj = 0; bj < 2; ++bj)
#pragma unroll
                    for (int n = 0; n < 2; ++n)
                        xv[m][bj][n] = *(const f32x4*)(X + (size_t)(u.pm * BM + ai * HALF + wr * 64 + m * 16 + fr) * D + col0 + bj * HALF + 16 * n);
            __builtin_amdgcn_sched_barrier(0);
#pragma unroll
            for (int m = mb; m < mb + 2; ++m)
#pragma unroll
                for (int bj = 0; bj < 2; ++bj)
#pragma unroll
                    for (int n = 0; n < 2; ++n)
                        *(f32x4*)(X + (size_t)(u.pm * BM + ai * HALF + wr * 64 + m * 16 + fr) * D + col0 + bj * HALF + 16 * n) =
                            xv[m][bj][n] * ALPHA_F + gv[bj][n] * acc[ai][bj][m][n];
            __builtin_amdgcn_sched_barrier(0);
        }
    }
};
struct EpiIn {
    static constexpr bool PERM = true;
    unsigned char* ws; float* out; const float* b_gate; int l;
    static DEVI u32x4 pack8(const f32x4& a, const f32x4& b, float s) {
        u32x4 w; w.x = pk2(a[0] * s, a[1] * s); w.y = pk2(a[2] * s, a[3] * s); w.z = pk2(b[0] * s, b[1] * s); w.w = pk2(b[2] * s, b[3] * s); return w;
    }
    DEVI void operator()(const f32x4 (&acc)[2][2][4][2], const Unit& u, int wr, int wc, int fr_, int fq_) const {
        int fr = fr_, fq = fq_; asm volatile("" : "+v"(fr), "+v"(fq));
        unsigned char* ws = this->ws; float* out = this->out; const float* b_gate = this->b_gate;
        asm volatile("" : "+s"(ws), "+s"(out), "+s"(b_gate));
        const bool ctx = u.pm * BM < NCTX;
#pragma unroll
        for (int bj = 0; bj < 2; ++bj) {
            const int n0 = u.pn * BM + bj * HALF;
            const int c8 = n0 + wc * 32 + 8 * fq;
            f32x4 bg0 = (f32x4){0.f, 0.f, 0.f, 0.f}, bg1 = bg0;
            if (n0 >= 2816) { bg0 = *(const f32x4*)(b_gate + l * 3072 + c8 - 2816); bg1 = *(const f32x4*)(b_gate + l * 3072 + c8 - 2816 + 4); }
#pragma unroll
            for (int ai = 0; ai < 2; ++ai)
#pragma unroll
                for (int m = 0; m < 4; ++m) {
                    const int row = u.pm * BM + ai * HALF + wr * 64 + m * 16 + fr;
                    const f32x4 v0 = acc[ai][bj][m][0], v1 = acc[ai][bj][m][1];
                    if (n0 < 512) {
                        *(u32x4*)((bf16_t*)(ws + WS_UF) + (size_t)row * 512 + c8) = pack8(v0, v1, 1.f);
                    } else if (n0 < 896) {
                        *(u32x4*)((bf16_t*)(ws + WS_UQ) + (size_t)row * 384 + (c8 - 512)) = pack8(v0, v1, 1.f);
                    } else if (n0 < 1152) {
                        float* o = (float*)(ws + WS_UKV) + (size_t)row * 256 + (c8 - 896);
                        *(f32x4*)o = v0; *(f32x4*)(o + 4) = v1;
                    } else if (n0 < 1280) {
                        if (wc == 0) { float* o = (float*)(ws + WS_KRF) + (size_t)row * 32 + 8 * fq; *(f32x4*)o = v0; *(f32x4*)(o + 4) = v1; }
                    } else if (n0 < 1792) {
                        *(u32x4*)((bf16_t*)(ws + WS_NAQ) + (size_t)row * 512 + (c8 - 1280)) = pack8(v0, v1, NA_QS);
                    } else if (n0 < 2304) {
                        const int cc = c8 - 1792;
                        *(u32x4*)((bf16_t*)(ws + WS_NAK) + (size_t)row * 512 + cc) = pack8(v0, v1, 1.f);
                        if (ctx) { float* o = out + OUT_NAK + ((size_t)((row >> 8) * 4 + l) * 256 + (row & 255)) * 512 + cc; *(f32x4*)o = v0; *(f32x4*)(o + 4) = v1; }
                    } else if (n0 < 2816) {
                        const int cc = c8 - 2304, h = cc >> 6, d0 = cc & 63;
                        bf16_t* VT = (bf16_t*)(ws + WS_NAVT);
                        bf16_t* vp;
                        size_t cstride;
                        if (ctx) {
                            const int b = row >> 8, s = row & 255;
                            float* o = out + OUT_NAV + ((size_t)(b * 4 + l) * 256 + s) * 512 + cc; *(f32x4*)o = v0; *(f32x4*)(o + 4) = v1;
                            vp = VT + ((size_t)((b * 8 + h) * 64 + d0)) * 256 + s; cstride = 256;
                        } else {
                            const int rr = row - NCTX, b = rr >> 11, n = rr & 2047;
                            vp = VT + (size_t)4194304 + ((size_t)((b * 8 + h) * 64 + d0)) * 2048 + n; cstride = 2048;
                        }
#pragma unroll
                        for (int e = 0; e < 4; ++e) { vp[(size_t)e * cstride] = f2bf(v0[e]); vp[(size_t)(4 + e) * cstride] = f2bf(v1[e]); }
                    } else {
                        f32x4 g0, g1;
#pragma unroll
                        for (int e = 0; e < 4; ++e) { g0[e] = sigmoidf_(v0[e] + bg0[e]); g1[e] = sigmoidf_(v1[e] + bg1[e]); }
                        *(u32x4*)((bf16_t*)(ws + WS_GATE) + (size_t)row * 3072 + (c8 - 2816)) = pack8(g0, g1, 1.f);
                    }
                    __builtin_amdgcn_sched_barrier(0);
                }
        }
    }
};
struct EpiMerge {
    static constexpr bool PERM = true;
    const bf16_t* GATE; bf16_t* T; bf16_t* MG; int s;
    DEVI void operator()(const f32x4 (&acc)[2][2][4][2], const Unit& u, int wr, int wc, int fr_, int fq_) const {
        int fr = fr_, fq = fq_; asm volatile("" : "+v"(fr), "+v"(fq));
#pragma unroll
        for (int ah = 0; ah < 4; ++ah) {
            const int ai = ah >> 1, mb = (ah & 1) * 2;
            u32x4 gv[4][2], tv[4][2];
#pragma unroll
            for (int m = mb; m < mb + 2; ++m)
#pragma unroll
                for (int bj = 0; bj < 2; ++bj) {
                    const int row = u.pm * BM + ai * HALF + wr * 64 + m * 16 + fr;
                    const int c8 = u.pn * BM + bj * HALF + wc * 32 + 8 * fq;
                    gv[m][bj] = *(const u32x4*)(GATE + (size_t)row * 3072 + s * 1024 + c8);
                    if (s > 0) tv[m][bj] = *(const u32x4*)(T + (size_t)row * D + c8);
                }
            __builtin_amdgcn_sched_barrier(0);
#pragma unroll
            for (int m = mb; m < mb + 2; ++m)
#pragma unroll
                for (int bj = 0; bj < 2; ++bj) {
                    const int row = u.pm * BM + ai * HALF + wr * 64 + m * 16 + fr;
                    const int c8 = u.pn * BM + bj * HALF + wc * 32 + 8 * fq;
                    const u32x4 g = gv[m][bj];
                    f32x4 v0 = acc[ai][bj][m][0], v1 = acc[ai][bj][m][1];
                    v0[0] *= bf2f(g.x & 0xffffu); v0[1] *= bf2f(g.x >> 16); v0[2] *= bf2f(g.y & 0xffffu); v0[3] *= bf2f(g.y >> 16);
                    v1[0] *= bf2f(g.z & 0xffffu); v1[1] *= bf2f(g.z >> 16); v1[2] *= bf2f(g.w & 0xffffu); v1[3] *= bf2f(g.w >> 16);
                    if (s > 0) {
                        const u32x4 t = tv[m][bj];
                        v0[0] += bf2f(t.x & 0xffffu); v0[1] += bf2f(t.x >> 16); v0[2] += bf2f(t.y & 0xffffu); v0[3] += bf2f(t.y >> 16);
                        v1[0] += bf2f(t.z & 0xffffu); v1[1] += bf2f(t.z >> 16); v1[2] += bf2f(t.w & 0xffffu); v1[3] += bf2f(t.w >> 16);
                    }
                    *(u32x4*)((s < 2 ? T : MG) + (size_t)row * D + c8) = EpiIn::pack8(v0, v1, 1.f);
                }
            __builtin_amdgcn_sched_barrier(0);
        }
    }
};
}

DEVI void job_ffn_up(const P& p, unsigned char* ws_b, int l, int which, int t, bf16_t* sm, int tid) {
    const int nN = 44; const int m0 = (t / nN) * 128, n0 = (t % nN) * 128;
    const bf16_t* H = (const bf16_t*)(ws_b + WS_H);
    const bf16_t* W = (const bf16_t*)(ws_b + WS_W) + (size_t)l * LAYER_W + (which ? OFF_W13_2 : OFF_W13_1);
    bf16_t* ACT = (bf16_t*)(ws_b + WS_ACT);
    f32x16 acc[2][2]; zero_acc(acc);
    gemm_core(H + (size_t)m0 * D, D, W + (size_t)n0 * D, D, D, acc, sm, tid);
    EPI_SETUP
    const int oc = (n0 >> 1) + wc * 32 + c32;
#pragma unroll
    for (int i = 0; i < 2; ++i) {
        const int rb = m0 + wr * 64 + i * 32 + 4 * hl;
#pragma unroll
        for (int r = 0; r < 16; ++r) {
            const int row = rb + (r & 3) + 8 * (r >> 2);
            const float a = acc[i][0][r], b = acc[i][1][r];
            const float v = a * sigmoidf_(a) * b;
            ACT[(size_t)row * DFF + oc] = f2bf(v);
        }
    }
}

DEVI void job_resid(const P& p, unsigned char* ws_b, const bf16_t* A, int lda, const bf16_t* Bt, int K, const float* gate_base, float coef, int t, bf16_t* sm, int tid) {
    const int nN = 8; const int m0 = (t / nN) * 128, n0 = (t % nN) * 128;
    float* X = (float*)(ws_b + WS_X);
    f32x16 acc[2][2]; zero_acc(acc);
    gemm_core(A + (size_t)m0 * lda, lda, Bt + (size_t)n0 * K, K, K, acc, sm, tid);
    EPI_SETUP
    const float* gate = gate_base + (size_t)mod_group(m0) * 9216;
#pragma unroll
    for (int j = 0; j < 2; ++j) {
        const int col = n0 + wc * 64 + j * 32 + c32;
        const float gv = coef * gate[col];
#pragma unroll
        for (int i = 0; i < 2; ++i) {
            const int rb = m0 + wr * 64 + i * 32 + 4 * hl;
#pragma unroll
            for (int r = 0; r < 16; ++r) {
                const int row = rb + (r & 3) + 8 * (r >> 2);
                float* xp = X + (size_t)row * D + col;
                *xp = ALPHA_F * (*xp) + gv * acc[i][j][r];
            }
        }
    }
}

DEVI void job_in(const P& p, unsigned char* ws_b, int l, int t, bf16_t* sm, int tid) {
    const int nN = 46; const int m0 = (t / nN) * 128, n0 = (t % nN) * 128;
    const bf16_t* H = (const bf16_t*)(ws_b + WS_H);
    const bf16_t* W = (const bf16_t*)(ws_b + WS_W) + (size_t)l * LAYER_W + OFF_WIN;
    f32x16 acc[2][2]; zero_acc(acc);
    gemm_core(H + (size_t)m0 * D, D, W + (size_t)n0 * D, D, D, acc, sm, tid);
    EPI_SETUP
    const bool ctx = m0 < NCTX;
#pragma unroll
    for (int j = 0; j < 2; ++j) {
        const int col = n0 + wc * 64 + j * 32 + c32;
#pragma unroll
        for (int i = 0; i < 2; ++i) {
            const int rb = m0 + wr * 64 + i * 32 + 4 * hl;
            if (n0 < 512) {
                bf16_t* O = (bf16_t*)(ws_b + WS_UF);
#pragma unroll
                for (int r = 0; r < 16; ++r) O[(size_t)(rb + (r & 3) + 8 * (r >> 2)) * 512 + col] = f2bf(acc[i][j][r]);
            } else if (n0 < 896) {
                bf16_t* O = (bf16_t*)(ws_b + WS_UQ);
#pragma unroll
                for (int r = 0; r < 16; ++r) O[(size_t)(rb + (r & 3) + 8 * (r >> 2)) * 384 + (col - 512)] = f2bf(acc[i][j][r]);
            } else if (n0 < 1152) {
                float* O = (float*)(ws_b + WS_UKV);
#pragma unroll
                for (int r = 0; r < 16; ++r) O[(size_t)(rb + (r & 3) + 8 * (r >> 2)) * 256 + (col - 896)] = acc[i][j][r];
            } else if (n0 < 1280) {
                if (col < 1184) {
                    float* O = (float*)(ws_b + WS_KRF);
#pragma unroll
                    for (int r = 0; r < 16; ++r) O[(size_t)(rb + (r & 3) + 8 * (r >> 2)) * 32 + (col - 1152)] = acc[i][j][r];
                }
            } else if (n0 < 1792) {
                bf16_t* O = (bf16_t*)(ws_b + WS_NAQ);
#pragma unroll
                for (int r = 0; r < 16; ++r) O[(size_t)(rb + (r & 3) + 8 * (r >> 2)) * 512 + (col - 1280)] = f2bf(acc[i][j][r] * NA_QS);
            } else if (n0 < 2304) {
                bf16_t* O = (bf16_t*)(ws_b + WS_NAK);
                const int cc = col - 1792;
#pragma unroll
                for (int r = 0; r < 16; ++r) {
                    const int row = rb + (r & 3) + 8 * (r >> 2);
                    O[(size_t)row * 512 + cc] = f2bf(acc[i][j][r]);
                    if (ctx) p.out[OUT_NAK + ((size_t)((row >> 8) * 4 + l) * 256 + (row & 255)) * 512 + cc] = acc[i][j][r];
                }
            } else if (n0 < 2816) {
                bf16_t* VT = (bf16_t*)(ws_b + WS_NAVT);
                const int cc = col - 2304, h = cc >> 6, d = cc & 63;
#pragma unroll
                for (int qd = 0; qd < 4; ++qd) {
                    const int row = rb + 8 * qd;
                    u32x2 pk; pk.x = pk2(acc[i][j][4 * qd], acc[i][j][4 * qd + 1]); pk.y = pk2(acc[i][j][4 * qd + 2], acc[i][j][4 * qd + 3]);
                    if (ctx) {
                        const int b = row >> 8, s = row & 255;
                        *(u32x2*)(VT + ((size_t)((b * 8 + h) * 64 + d)) * 256 + s) = pk;
#pragma unroll
                        for (int e = 0; e < 4; ++e)
                            p.out[OUT_NAV + ((size_t)(b * 4 + l) * 256 + (s + e)) * 512 + cc] = acc[i][j][4 * qd + e];
                    } else {
                        const int rr = row - NCTX, b = rr >> 11, n = rr & 2047;
                        *(u32x2*)(VT + (size_t)4194304 + ((size_t)((b * 8 + h) * 64 + d)) * 2048 + n) = pk;
                    }
                }
            } else {
                bf16_t* O = (bf16_t*)(ws_b + WS_GATE);
                const int gc = col - 2816;
                const float bg = pin(p, 26)[l * 3072 + gc];
                bf16_t* gp = O + (size_t)gc * M + rb;
#pragma unroll
                for (int qd = 0; qd < 4; ++qd) {
                    u32x2 pk;
                    pk.x = pk2(sigmoidf_(acc[i][j][4 * qd] + bg), sigmoidf_(acc[i][j][4 * qd + 1] + bg));
                    pk.y = pk2(sigmoidf_(acc[i][j][4 * qd + 2] + bg), sigmoidf_(acc[i][j][4 * qd + 3] + bg));
                    *(u32x2*)(gp + 8 * qd) = pk;
                }
            }
        }
    }
}

DEVI void job_uq(const P& p, unsigned char* ws_b, int l, int t, bf16_t* sm, int tid) {
    const int nN = 6; const int m0 = (t / nN) * 128, n0 = (t % nN) * 128;
    const bf16_t* A = (const bf16_t*)(ws_b + WS_UQ);
    const bf16_t* W = (const bf16_t*)(ws_b + WS_W) + (size_t)l * LAYER_W + OFF_WUQ;
    bf16_t* Q = (bf16_t*)(ws_b + WS_Q);
    const float* ropec = (const float*)(ws_b + WS_ROPE);
    const float* ropes = ropec + 512;
    f32x16 acc[2][2]; zero_acc(acc);
    gemm_core(A + (size_t)m0 * 384, 384, W + (size_t)n0 * 384, 384, 384, acc, sm, tid);
    EPI_SETUP
    const bool lat = m0 >= NCTX;
#pragma unroll
    for (int j = 0; j < 2; ++j) {
        const int c0 = n0 + wc * 64 + j * 32;
        const int col = c0 + c32;
        const bool rope = lat && (((c0 >> 5) % 3) == 2);
        const int axis = c32 >> 4, ii = c32 & 15;
#pragma unroll
        for (int i = 0; i < 2; ++i) {
            const int rb = m0 + wr * 64 + i * 32 + 4 * hl;
#pragma unroll
            for (int r = 0; r < 16; ++r) {
                const int row = rb + (r & 3) + 8 * (r >> 2);
                float v = acc[i][j][r];
                const float pr = __shfl_xor(v, 8);
                if (rope) {
                    const int n = (row - NCTX) & 2047;
                    const int pos = axis ? (n & 63) : (n >> 6);
                    const float cs = ropec[pos * 8 + (ii & 7)], sn = ropes[pos * 8 + (ii & 7)];
                    const float rot = (ii < 8) ? -pr : pr;
                    v = v * cs + rot * sn;
                }
                Q[(size_t)row * 768 + col] = f2bf(v * MLA_QS);
            }
        }
    }
}

DEVI void job_ukv(const P& p, unsigned char* ws_b, int l, int t, bf16_t* sm, int tid) {
    const int nN = 8; const int m0 = (t / nN) * 128, h = t % nN, n0 = h * 128;
    const bf16_t* A = (m0 < M) ? (const bf16_t*)(ws_b + WS_CKV) + (size_t)m0 * 256
                               : (const bf16_t*)(ws_b + WS_CCKV) + ((size_t)l * 1024 + (m0 - M)) * 256;
    const bf16_t* W = (const bf16_t*)(ws_b + WS_W) + (size_t)l * LAYER_W + OFF_WUKV;
    bf16_t* KN = (bf16_t*)(ws_b + WS_KN);
    bf16_t* VT = (bf16_t*)(ws_b + WS_VTM);
    f32x16 acc[2][2]; zero_acc(acc);
    gemm_core(A, 256, W + (size_t)n0 * 256, 256, 256, acc, sm, tid);
    EPI_SETUP
#pragma unroll
    for (int j = 0; j < 2; ++j) {
        const int d = j * 32 + c32;
#pragma unroll
        for (int i = 0; i < 2; ++i) {
            const int rb = m0 + wr * 64 + i * 32 + 4 * hl;
            if (wc == 0) {
#pragma unroll
                for (int r = 0; r < 16; ++r) KN[(size_t)(rb + (r & 3) + 8 * (r >> 2)) * 512 + h * 64 + d] = f2bf(acc[i][j][r]);
            } else {
#pragma unroll
                for (int qd = 0; qd < 4; ++qd) {
                    const int row = rb + 8 * qd;
                    u32x2 pk; pk.x = pk2(acc[i][j][4 * qd], acc[i][j][4 * qd + 1]); pk.y = pk2(acc[i][j][4 * qd + 2], acc[i][j][4 * qd + 3]);
                    size_t addr;
                    if (m0 < NCTX) { const int b = row >> 8, s = row & 255; addr = ((size_t)((b * 8 + h) * 64 + d)) * 256 + s; }
                    else if (m0 < M) { const int rr = row - NCTX, b = rr >> 11, n = rr & 2047; addr = (size_t)4194304 + ((size_t)((b * 8 + h) * 64 + d)) * 2560 + n; }
                    else { const int rr = row - M, b = rr >> 9, n = rr & 511; addr = (size_t)4194304 + ((size_t)((b * 8 + h) * 64 + d)) * 2560 + 2048 + n; }
                    *(u32x2*)(VT + addr) = pk;
                }
            }
        }
    }
}

template <int ldo, bool SPLITK = false>
DEVI void job_store(const bf16_t* A, int lda, const bf16_t* Bt, int ldb, int K, bf16_t* Out, bf16_t* sm, int tid, int grp = 0, float* xch = nullptr) {
    f32x16 acc[2][2]; zero_acc(acc);
    if constexpr (SPLITK) { K >>= 1; A += grp * K; Bt += grp * K; }
    gemm_core(A, lda, Bt, ldb, K, acc, sm, tid);
    EPI_SETUP
    if constexpr (SPLITK) {
        if (grp == 1) {
#pragma unroll
            for (int i = 0; i < 2; ++i)
#pragma unroll
                for (int j = 0; j < 2; ++j)
#pragma unroll
                    for (int r = 0; r < 16; ++r) xch[((i * 2 + j) * 16 + r) * 256 + tid] = acc[i][j][r];
        }
        __syncthreads();
        if (grp == 0) {
#pragma unroll
            for (int i = 0; i < 2; ++i)
#pragma unroll
                for (int j = 0; j < 2; ++j)
#pragma unroll
                    for (int r = 0; r < 16; ++r) acc[i][j][r] += xch[((i * 2 + j) * 16 + r) * 256 + tid];
        }
        __syncthreads();
    }
    const bool active = !SPLITK || grp == 0;
    bf16_t* st = sm + (wr * 64 + 4 * hl) * 136 + wc * 64 + c32;
    if (active) {
#pragma unroll
        for (int i = 0; i < 2; ++i)
#pragma unroll
            for (int j = 0; j < 2; ++j)
#pragma unroll
                for (int r = 0; r < 16; ++r) st[(i * 32 + (r & 3) + 8 * (r >> 2)) * 136 + j * 32] = f2bf(acc[i][j][r]);
    }
    __syncthreads();
    if (active) {
        const int orow = tid >> 4, oc = (tid & 15) * 8;
#pragma unroll
        for (int k = 0; k < 8; ++k) {
            const u32x4 v = *(const u32x4*)(sm + (orow + 16 * k) * 136 + oc);
            *(u32x4*)(Out + (size_t)(orow + 16 * k) * ldo + oc) = v;
        }
    }
    __syncthreads();
}

DEVI void job_f1(const P& p, unsigned char* ws_b, int t, bf16_t* sm, int tid) {
    const bf16_t* WCS = (const bf16_t*)(ws_b + WS_WCS);
    const bf16_t* UF = (const bf16_t*)(ws_b + WS_UF);
    bf16_t* F1T = (bf16_t*)(ws_b + WS_F1T);
    if (t < 512) {
        const int bs = t >> 4, g = (t >> 2) & 3, mi = (t >> 1) & 1, ni = t & 1;
        job_store<256>(WCS + mi * 128 * 128, 128, UF + ((size_t)bs * 256 + ni * 128) * 512 + g * 128, 512, 128,
                  F1T + ((size_t)(bs * 4 + g) * 256 + mi * 128) * 256 + ni * 128, sm, tid);
    } else {
        t -= 512;
        const int bs = t >> 7, g = (t >> 5) & 3, mi = (t >> 4) & 1, ni = t & 15;
        job_store<2048>(WCS + mi * 128 * 128, 128, UF + ((size_t)NCTX + bs * 2048 + ni * 128) * 512 + g * 128, 512, 128,
                  F1T + (size_t)8388608 + ((size_t)(bs * 4 + g) * 256 + mi * 128) * 2048 + ni * 128, sm, tid);
    }
}
DEVI void job_f2_lat(const P& p, unsigned char* ws_b, int t, bf16_t* sm, int tid, int grp, float* xch) {
    const int bs = t >> 6, mi = (t >> 2) & 15, ni = t & 3;
    const bf16_t* TAB = (const bf16_t*)(ws_b + WS_TABL);
    const bf16_t* F1T = (const bf16_t*)(ws_b + WS_F1T) + (size_t)8388608;
    bf16_t* YF = (bf16_t*)(ws_b + WS_YF);
    job_store<512, true>(TAB + (size_t)mi * 128 * 4096, 4096, F1T + (size_t)bs * 512 * 4096 + (size_t)ni * 128 * 4096, 4096, 4096,
              YF + ((size_t)NCTX + bs * 2048 + mi * 128) * 512 + ni * 128, sm, tid, grp, xch);
}
DEVI void job_f2_ctx(const P& p, unsigned char* ws_b, int t, bf16_t* sm, int tid) {
    const int bs = t >> 3, mi = (t >> 2) & 1, ni = t & 3;
    const bf16_t* TAB = (const bf16_t*)(ws_b + WS_TABC);
    const bf16_t* F1T = (const bf16_t*)(ws_b + WS_F1T);
    bf16_t* YF = (bf16_t*)(ws_b + WS_YF);
    job_store<512>(TAB + (size_t)mi * 128 * 512, 512, F1T + (size_t)bs * 512 * 512 + (size_t)ni * 128 * 512, 512, 512,
              YF + ((size_t)bs * 256 + mi * 128) * 512 + ni * 128, sm, tid);
}

DEVI void job_merge(const P& p, unsigned char* ws_b, int l, int t, bf16_t* sm, int tid) {
    const int nN = 8; const int m0 = (t / nN) * 128, n0 = (t % nN) * 128;
    const bf16_t* Wl = (const bf16_t*)(ws_b + WS_W) + (size_t)l * LAYER_W;
    const bf16_t* GATE = (const bf16_t*)(ws_b + WS_GATE);
    bf16_t* MG = (bf16_t*)(ws_b + WS_MERGED);
    EPI_SETUP
    f32x16 acc[2][2]; zero_acc(acc);
#pragma unroll 1
    for (int s = 0; s < 3; ++s) {
        const bf16_t* A = (const bf16_t*)(ws_b + (s == 0 ? WS_YF : (s == 1 ? WS_YM : WS_YN)));
        const bf16_t* W = Wl + (s == 0 ? OFF_WBF : (s == 1 ? OFF_WBM : OFF_WBN));
        gemm_core<false>(A + (size_t)m0 * 512, 512, W + (size_t)n0 * 512, 512, 512, acc, sm, tid);
        {
            const int gr = tid >> 4, gc = (tid & 15) * 8;
            const int s1 = s < 2 ? s + 1 : s;
#pragma unroll
            for (int k = 0; k < 8; ++k) {
                const bf16_t* gsrc = GATE + (size_t)(m0 + gr + 16 * k) * 3072 + n0 + gc;
                *(u32x4*)(sm + (gr + 16 * k) * 136 + gc) = *(const u32x4*)(gsrc + s * 1024);
                *(u32x4*)(sm + 128 * 136 + (gr + 16 * k) * 136 + gc) = *(const u32x4*)(gsrc + s1 * 1024);
                if ((k & 1) == 1) __builtin_amdgcn_sched_barrier(0);
            }
        }
        __syncthreads();
#pragma unroll
        for (int j = 0; j < 2; ++j)
#pragma unroll
            for (int i = 0; i < 2; ++i) {
                const bf16_t* gp = sm + (wr * 64 + i * 32 + 4 * hl) * 136 + wc * 64 + j * 32 + c32;
#pragma unroll
                for (int r = 0; r < 16; ++r) {
                    const int o = ((r & 3) + 8 * (r >> 2)) * 136;
                    const float g = bf2f(gp[o]);
                    const float f = (s < 2) ? g * __builtin_amdgcn_rcpf(bf2f(gp[128 * 136 + o])) : g;
                    acc[i][j][r] *= f;
                }
            }
        __syncthreads();
    }
#pragma unroll
    for (int j = 0; j < 2; ++j) {
        const int col = n0 + wc * 64 + j * 32 + c32;
#pragma unroll
        for (int i = 0; i < 2; ++i) {
            const int rb = m0 + wr * 64 + i * 32 + 4 * hl;
#pragma unroll
            for (int r = 0; r < 16; ++r) MG[(size_t)(rb + (r & 3) + 8 * (r >> 2)) * 1024 + col] = f2bf(acc[i][j][r]);
        }
    }
}

struct TileSrc { const bf16_t* k; const bf16_t* k2; const bf16_t* v; const bf16_t* vhi; };
DEVI int pi_row(int r) { return (r & 0x13) | ((r & 4) << 1) | ((r & 8) >> 1); }

template <int NKS>
DEVI void attn_load(const TileSrc& s, bf16x8 (&kf)[NKS], bf16x8 (&vf)[4]) {
#pragma unroll
    for (int ks = 0; ks < NKS; ++ks) kf[ks] = (ks < 4) ? *(const bf16x8*)(s.k + ks * 16) : *(const bf16x8*)(s.k2 + (ks - 4) * 16);
    vf[0] = *(const bf16x8*)(s.v);
    vf[1] = *(const bf16x8*)(s.v + 16);
    vf[2] = *(const bf16x8*)(s.vhi);
    vf[3] = *(const bf16x8*)(s.vhi + 16);
}

template <int NKS, bool SPLIT, class Src, class Mask>
DEVI void attn_wave(const bf16_t* qptr, int t0, int nt, Src src, Mask mask, bf16_t* optr, int lane, float* ex = nullptr, int half = 0) {
    bf16x8 q[NKS];
#pragma unroll
    for (int ks = 0; ks < NKS; ++ks) q[ks] = *(const bf16x8*)(qptr + ks * 16);
    f32x16 o0, o1;
#pragma unroll
    for (int r = 0; r < 16; ++r) { o0[r] = 0.f; o1[r] = 0.f; }
    float m = -1e30f, lsum = 0.f;
    bf16x8 kf[NKS], vf[4];
    nt += t0;
    { TileSrc s0 = src(t0); attn_load<NKS>(s0, kf, vf); }
    for (int t = t0; t < nt; ++t) {
        bf16x8 kn[NKS], vn[4];
        { TileSrc s1 = src(t + 1 < nt ? t + 1 : t); attn_load<NKS>(s1, kn, vn); }
        f32x16 s;
#pragma unroll
        for (int r = 0; r < 16; ++r) s[r] = 0.f;
#pragma unroll
        for (int ks = 0; ks < NKS; ++ks) s = __builtin_amdgcn_mfma_f32_32x32x16_bf16(kf[ks], q[ks], s, 0, 0, 0);
        mask(t, s);
        float mx = s[0];
#pragma unroll
        for (int r = 1; r < 16; ++r) mx = fmaxf(mx, s[r]);
        mx = fmaxf(mx, __shfl_xor(mx, 32));
        const float mn = fmaxf(m, mx);
        const float alpha = fast_exp2(m - mn);
        m = mn;
        float rs = 0.f;
#pragma unroll
        for (int r = 0; r < 16; ++r) { s[r] = fast_exp2(s[r] - mn); rs += s[r]; }
        lsum = lsum * alpha + rs;
#pragma unroll
        for (int r = 0; r < 16; ++r) { o0[r] *= alpha; o1[r] *= alpha; }
        bf16x8 p0, p1;
        {
            u32x4 a, b;
            a.x = pk2(s[0], s[1]); a.y = pk2(s[2], s[3]); a.z = pk2(s[4], s[5]); a.w = pk2(s[6], s[7]);
            b.x = pk2(s[8], s[9]); b.y = pk2(s[10], s[11]); b.z = pk2(s[12], s[13]); b.w = pk2(s[14], s[15]);
            p0 = __builtin_bit_cast(bf16x8, a); p1 = __builtin_bit_cast(bf16x8, b);
        }
        o0 = __builtin_amdgcn_mfma_f32_32x32x16_bf16(vf[0], p0, o0, 0, 0, 0);
        o0 = __builtin_amdgcn_mfma_f32_32x32x16_bf16(vf[1], p1, o0, 0, 0, 0);
        o1 = __builtin_amdgcn_mfma_f32_32x32x16_bf16(vf[2], p0, o1, 0, 0, 0);
        o1 = __builtin_amdgcn_mfma_f32_32x32x16_bf16(vf[3], p1, o1, 0, 0, 0);
#pragma unroll
        for (int ks = 0; ks < NKS; ++ks) kf[ks] = kn[ks];
#pragma unroll
        for (int x = 0; x < 4; ++x) vf[x] = vn[x];
    }
    if constexpr (SPLIT) {
        if (half == 1) {
#pragma unroll
            for (int r = 0; r < 16; ++r) { ex[r * 64 + lane] = o0[r]; ex[(16 + r) * 64 + lane] = o1[r]; }
            ex[32 * 64 + lane] = m; ex[33 * 64 + lane] = lsum;
        }
        __syncthreads();
        if (half == 0) {
            const float m2 = ex[32 * 64 + lane], l2 = ex[33 * 64 + lane];
            const float mn = fmaxf(m, m2), a1 = fast_exp2(m - mn), a2 = fast_exp2(m2 - mn);
            lsum = lsum * a1 + l2 * a2;
#pragma unroll
            for (int r = 0; r < 16; ++r) { o0[r] = o0[r] * a1 + ex[r * 64 + lane] * a2; o1[r] = o1[r] * a1 + ex[(16 + r) * 64 + lane] * a2; }
        }
        __syncthreads();
        if (half == 1) return;
    }
    lsum += __shfl_xor(lsum, 32);
    const float inv = 1.f / lsum;
    const int hl = lane >> 5;
#pragma unroll
    for (int qd = 0; qd < 4; ++qd) {
        u32x2 a, b;
        a.x = pk2(o0[4 * qd] * inv, o0[4 * qd + 1] * inv); a.y = pk2(o0[4 * qd + 2] * inv, o0[4 * qd + 3] * inv);
        b.x = pk2(o1[4 * qd] * inv, o1[4 * qd + 1] * inv); b.y = pk2(o1[4 * qd + 2] * inv, o1[4 * qd + 3] * inv);
        *(u32x2*)(optr + 8 * qd + 4 * hl) = a;
        *(u32x2*)(optr + 32 + 8 * qd + 4 * hl) = b;
    }
}

struct NoMask { DEVI void operator()(int, f32x16&) const {} };

DEVI void attn_mla(const P& p, unsigned char* ws_b, int l, bool lat, int b, int h, int qg, int lane, float* ex = nullptr, int half = 0) {
    const int hl = lane >> 5, c32 = lane & 31, pr = pi_row(c32);
    const bf16_t* Q = (const bf16_t*)(ws_b + WS_Q);
    const bf16_t* KN = (const bf16_t*)(ws_b + WS_KN);
    const bf16_t* KR = (const bf16_t*)(ws_b + WS_KR);
    const bf16_t* CKR = (const bf16_t*)(ws_b + WS_CKR) + (size_t)l * 1024 * 32;
    const bf16_t* VT = (const bf16_t*)(ws_b + WS_VTM);
    bf16_t* YM = (bf16_t*)(ws_b + WS_YM);
    if (!lat) {
        const int row0 = b * 256;
        const int qrow = row0 + qg * 32 + c32;
        const bf16_t* k0 = KN + (size_t)(row0 + pr) * 512 + h * 64 + hl * 8;
        const bf16_t* r0 = KR + (size_t)(row0 + pr) * 32 + hl * 8;
        const bf16_t* v0 = VT + ((size_t)((b * 8 + h) * 64 + c32)) * 256 + hl * 8;
        auto src = [=](int t) { TileSrc s; s.k = k0 + (size_t)t * 32 * 512; s.k2 = r0 + (size_t)t * 32 * 32; s.v = v0 + t * 32; s.vhi = s.v + 32 * 256; return s; };
        attn_wave<6, false>(Q + (size_t)qrow * 768 + h * 96 + hl * 8, 0, 8, src, NoMask(), YM + (size_t)qrow * 512 + h * 64, lane);
    } else {
        const int row0 = NCTX + b * 2048;
        const int qrow = row0 + qg * 32 + c32;
        const bf16_t* k0 = KN + (size_t)(row0 + pr) * 512 + h * 64 + hl * 8;
        const bf16_t* r0 = KR + (size_t)(row0 + pr) * 32 + hl * 8;
        const bf16_t* k1 = KN + (size_t)(M + b * 512 + pr) * 512 + h * 64 + hl * 8;
        const bf16_t* r1 = CKR + (size_t)(b * 512 + pr) * 32 + hl * 8;
        const bf16_t* v0 = VT + (size_t)4194304 + ((size_t)((b * 8 + h) * 64 + c32)) * 2560 + hl * 8;
        auto src = [=](int t) {
            TileSrc s;
            if (t < 64) { s.k = k0 + (size_t)t * 32 * 512; s.k2 = r0 + (size_t)t * 32 * 32; }
            else { s.k = k1 + (size_t)(t - 64) * 32 * 512; s.k2 = r1 + (size_t)(t - 64) * 32 * 32; }
            s.v = v0 + t * 32; s.vhi = s.v + 32 * 2560; return s; };
        attn_wave<6, true>(Q + (size_t)qrow * 768 + h * 96 + hl * 8, half * 40, 40, src, NoMask(), YM + (size_t)qrow * 512 + h * 64, lane, ex, half);
    }
}

template <int NKS, class Mask>
DEVI void attn_step(const bf16x8 (&kf)[NKS], const bf16x8 (&vf)[4], const bf16x8 (&q)[NKS], f32x16& o0, f32x16& o1, float& m, float& lsum, const Mask& mask, int t) {
    f32x16 s;
#pragma unroll
    for (int r = 0; r < 16; ++r) s[r] = 0.f;
#pragma unroll
    for (int ks = 0; ks < NKS; ++ks) s = __builtin_amdgcn_mfma_f32_32x32x16_bf16(kf[ks], q[ks], s, 0, 0, 0);
    mask(t, s);
    float mx = s[0];
#pragma unroll
    for (int r = 1; r < 16; ++r) mx = fmaxf(mx, s[r]);
    mx = fmaxf(mx, __shfl_xor(mx, 32));
    const float mn = fmaxf(m, mx);
    const float alpha = fast_exp2(m - mn);
    m = mn;
    float rs = 0.f;
#pragma unroll
    for (int r = 0; r < 16; ++r) { s[r] = fast_exp2(s[r] - mn); rs += s[r]; }
    lsum = lsum * alpha + rs;
#pragma unroll
    for (int r = 0; r < 16; ++r) { o0[r] *= alpha; o1[r] *= alpha; }
    bf16x8 p0, p1;
    {
        u32x4 a, b;
        a.x = pk2(s[0], s[1]); a.y = pk2(s[2], s[3]); a.z = pk2(s[4], s[5]); a.w = pk2(s[6], s[7]);
        b.x = pk2(s[8], s[9]); b.y = pk2(s[10], s[11]); b.z = pk2(s[12], s[13]); b.w = pk2(s[14], s[15]);
        p0 = __builtin_bit_cast(bf16x8, a); p1 = __builtin_bit_cast(bf16x8, b);
    }
    o0 = __builtin_amdgcn_mfma_f32_32x32x16_bf16(vf[0], p0, o0, 0, 0, 0);
    o0 = __builtin_amdgcn_mfma_f32_32x32x16_bf16(vf[1], p1, o0, 0, 0, 0);
    o1 = __builtin_amdgcn_mfma_f32_32x32x16_bf16(vf[2], p0, o1, 0, 0, 0);
    o1 = __builtin_amdgcn_mfma_f32_32x32x16_bf16(vf[3], p1, o1, 0, 0, 0);
}
struct MlaStage { u32x4 k, v; u32x2 r; };
DEVI void attn_mla_lat_shared(const P& p, unsigned char* ws_b, int l, int b, int h, int qg, int tid, unsigned char* smem, float* ex) {
    const int lane = tid & 63, wave = tid >> 6, half = wave >> 2, htid = tid & 255;
    const int hl = lane >> 5, c32 = lane & 31, pr = pi_row(c32);
    const bf16_t* Q = (const bf16_t*)(ws_b + WS_Q);
    const bf16_t* KN = (const bf16_t*)(ws_b + WS_KN);
    const bf16_t* KR = (const bf16_t*)(ws_b + WS_KR);
    const bf16_t* CKR = (const bf16_t*)(ws_b + WS_CKR) + (size_t)l * 1024 * 32;
    const bf16_t* VT = (const bf16_t*)(ws_b + WS_VTM) + (size_t)4194304 + (size_t)((b * 8 + h) * 64) * 2560;
    bf16_t* YM = (bf16_t*)(ws_b + WS_YM);
    const int row0 = NCTX + b * 2048;
    const int qrow = row0 + qg * 32 + c32;
    bf16_t* ring = (bf16_t*)(smem + 36864 + half * 36864);
    const int kkey = htid >> 3, kch = (htid & 7) * 8, vd = htid >> 2, vch = (htid & 3) * 8;
    const int rch = (htid & 7) * 4;
    const int tb = half * 40, tend = tb + 40;
    bf16x8 q[6];
    {
        const bf16_t* qptr = Q + (size_t)qrow * 768 + h * 96 + hl * 8;
#pragma unroll
        for (int ks = 0; ks < 6; ++ks) q[ks] = *(const bf16x8*)(qptr + ks * 16);
    }
    f32x16 o0, o1;
#pragma unroll
    for (int r = 0; r < 16; ++r) { o0[r] = 0.f; o1[r] = 0.f; }
    float m = -1e30f, lsum = 0.f;
#define MLA_LD(S, T) do { const int t_ = (T) < tend ? (T) : tend - 1; \
        const int krow_ = t_ < 64 ? row0 + t_ * 32 : M + b * 512 + (t_ - 64) * 32; \
        (S).k = *(const u32x4*)(KN + (size_t)(krow_ + kkey) * 512 + h * 64 + kch); \
        (S).v = *(const u32x4*)(VT + (size_t)vd * 2560 + t_ * 32 + vch); \
        (S).r = *(const u32x2*)((t_ < 64 ? KR + (size_t)(krow_ + kkey) * 32 : CKR + (size_t)(b * 512 + (t_ - 64) * 32 + kkey) * 32) + rch); } while (0)
#define MLA_ST(S, SLOT) do { bf16_t* sl_ = ring + (SLOT) * 6144; \
        *(u32x4*)(sl_ + kkey * 72 + kch) = (S).k; *(u32x4*)(sl_ + 3584 + vd * 40 + vch) = (S).v; \
        *(u32x2*)(sl_ + 2304 + kkey * 40 + rch) = (S).r; } while (0)
#define MLA_COMPUTE(SLOT, T) do { const bf16_t* sl_ = ring + (SLOT) * 6144; bf16x8 kf[6], vf[4]; \
        _Pragma("unroll") for (int ks = 0; ks < 4; ++ks) kf[ks] = *(const bf16x8*)(sl_ + pr * 72 + ks * 16 + hl * 8); \
        kf[4] = *(const bf16x8*)(sl_ + 2304 + pr * 40 + hl * 8); kf[5] = *(const bf16x8*)(sl_ + 2304 + pr * 40 + 16 + hl * 8); \
        vf[0] = *(const bf16x8*)(sl_ + 3584 + c32 * 40 + hl * 8); vf[1] = *(const bf16x8*)(sl_ + 3584 + c32 * 40 + 16 + hl * 8); \
        vf[2] = *(const bf16x8*)(sl_ + 3584 + (c32 + 32) * 40 + hl * 8); vf[3] = *(const bf16x8*)(sl_ + 3584 + (c32 + 32) * 40 + 16 + hl * 8); \
        attn_step<6>(kf, vf, q, o0, o1, m, lsum, NoMask(), (T)); } while (0)
    MlaStage s0, s1, s2;
    MLA_LD(s0, tb); MLA_LD(s1, tb + 1); MLA_LD(s2, tb + 2);
    MLA_ST(s0, 0); MLA_LD(s0, tb + 3);
    __syncthreads();
#pragma unroll 1
    for (int i = tb; i < tend; i += 3) {
        MLA_ST(s1, 1); MLA_LD(s1, i + 4); MLA_COMPUTE(0, i); __syncthreads();
        MLA_ST(s2, 2); MLA_LD(s2, i + 5); if (i + 1 < tend) MLA_COMPUTE(1, i + 1); __syncthreads();
        MLA_ST(s0, 0); MLA_LD(s0, i + 6); if (i + 2 < tend) MLA_COMPUTE(2, i + 2); __syncthreads();
    }
#undef MLA_LD
#undef MLA_ST
#undef MLA_COMPUTE
    if (half == 1) {
#pragma unroll
        for (int r = 0; r < 16; ++r) { ex[r * 64 + lane] = o0[r]; ex[(16 + r) * 64 + lane] = o1[r]; }
        ex[32 * 64 + lane] = m; ex[33 * 64 + lane] = lsum;
    }
    __syncthreads();
    if (half == 0) {
        const float m2 = ex[32 * 64 + lane], l2 = ex[33 * 64 + lane];
        const float mn = fmaxf(m, m2), a1 = fast_exp2(m - mn), a2 = fast_exp2(m2 - mn);
        lsum = lsum * a1 + l2 * a2;
#pragma unroll
        for (int r = 0; r < 16; ++r) { o0[r] = o0[r] * a1 + ex[r * 64 + lane] * a2; o1[r] = o1[r] * a1 + ex[(16 + r) * 64 + lane] * a2; }
    }
    __syncthreads();
    if (half == 1) return;
    lsum += __shfl_xor(lsum, 32);
    const float inv = 1.f / lsum;
    bf16_t* optr = YM + (size_t)qrow * 512 + h * 64;
#pragma unroll
    for (int qd = 0; qd < 4; ++qd) {
        u32x2 a, bb;
        a.x = pk2(o0[4 * qd] * inv, o0[4 * qd + 1] * inv); a.y = pk2(o0[4 * qd + 2] * inv, o0[4 * qd + 3] * inv);
        bb.x = pk2(o1[4 * qd] * inv, o1[4 * qd + 1] * inv); bb.y = pk2(o1[4 * qd + 2] * inv, o1[4 * qd + 3] * inv);
        *(u32x2*)(optr + 8 * qd + 4 * hl) = a;
        *(u32x2*)(optr + 32 + 8 * qd + 4 * hl) = bb;
    }
}

template <int NKS>
DEVI void attn_ctx_shared(const bf16_t* Kg, const bf16_t* KRg, const bf16_t* VTg, const bf16_t* qptr, bf16_t* optr, int tid, unsigned char* smem) {
    const int lane = tid & 63, hl = lane >> 5, c32 = lane & 31, pr = pi_row(c32);
    bf16_t* Ks = (bf16_t*)smem;
    bf16_t* Rs = Ks + 256 * 72;
    bf16_t* Vs = Rs + 256 * 40;
    {
        u32x4 kr[4], vr[4], rr[2];
#pragma unroll
        for (int i = 0; i < 4; ++i) { const int c = tid + 512 * i; kr[i] = *(const u32x4*)(Kg + (size_t)(c >> 3) * 512 + (c & 7) * 8); }
#pragma unroll
        for (int i = 0; i < 4; ++i) { const int c = tid + 512 * i; vr[i] = *(const u32x4*)(VTg + (size_t)(c >> 5) * 256 + (c & 31) * 8); }
        if constexpr (NKS == 6) {
#pragma unroll
            for (int i = 0; i < 2; ++i) { const int c = tid + 512 * i; rr[i] = *(const u32x4*)(KRg + (size_t)(c >> 2) * 32 + (c & 3) * 8); }
        }
#pragma unroll
        for (int i = 0; i < 4; ++i) { const int c = tid + 512 * i; *(u32x4*)(Ks + (c >> 3) * 72 + (c & 7) * 8) = kr[i]; }
#pragma unroll
        for (int i = 0; i < 4; ++i) { const int c = tid + 512 * i; *(u32x4*)(Vs + (c >> 5) * 264 + (c & 31) * 8) = vr[i]; }
        if constexpr (NKS == 6) {
#pragma unroll
            for (int i = 0; i < 2; ++i) { const int c = tid + 512 * i; *(u32x4*)(Rs + (c >> 2) * 40 + (c & 3) * 8) = rr[i]; }
        }
    }
    bf16x8 q[NKS];
#pragma unroll
    for (int ks = 0; ks < NKS; ++ks) q[ks] = *(const bf16x8*)(qptr + ks * 16);
    __syncthreads();
    f32x16 o0, o1;
#pragma unroll
    for (int r = 0; r < 16; ++r) { o0[r] = 0.f; o1[r] = 0.f; }
    float m = -1e30f, lsum = 0.f;
#pragma unroll 1
    for (int t = 0; t < 8; ++t) {
        bf16x8 kf[NKS], vf[4];
        const bf16_t* kp = Ks + (t * 32 + pr) * 72 + hl * 8;
#pragma unroll
        for (int ks = 0; ks < 4; ++ks) kf[ks] = *(const bf16x8*)(kp + ks * 16);
        if constexpr (NKS == 6) {
            const bf16_t* rp = Rs + (t * 32 + pr) * 40 + hl * 8;
            kf[4] = *(const bf16x8*)rp; kf[5] = *(const bf16x8*)(rp + 16);
        }
        const bf16_t* vp = Vs + c32 * 264 + t * 32 + hl * 8;
        vf[0] = *(const bf16x8*)vp; vf[1] = *(const bf16x8*)(vp + 16);
        vf[2] = *(const bf16x8*)(vp + 32 * 264); vf[3] = *(const bf16x8*)(vp + 32 * 264 + 16);
        attn_step<NKS>(kf, vf, q, o0, o1, m, lsum, NoMask(), t);
    }
    lsum += __shfl_xor(lsum, 32);
    const float inv = 1.f / lsum;
#pragma unroll
    for (int qd = 0; qd < 4; ++qd) {
        u32x2 a, bb;
        a.x = pk2(o0[4 * qd] * inv, o0[4 * qd + 1] * inv); a.y = pk2(o0[4 * qd + 2] * inv, o0[4 * qd + 3] * inv);
        bb.x = pk2(o1[4 * qd] * inv, o1[4 * qd + 1] * inv); bb.y = pk2(o1[4 * qd + 2] * inv, o1[4 * qd + 3] * inv);
        *(u32x2*)(optr + 8 * qd + 4 * hl) = a;
        *(u32x2*)(optr + 32 + 8 * qd + 4 * hl) = bb;
    }
    __syncthreads();
}

DEVI void attn_na_ctx(const P& p, unsigned char* ws_b, int b, int h, int qg, int lane) {
    const int hl = lane >> 5, c32 = lane & 31, pr = pi_row(c32);
    const bf16_t* Qn = (const bf16_t*)(ws_b + WS_NAQ);
    const bf16_t* Kn = (const bf16_t*)(ws_b + WS_NAK);
    const bf16_t* VT = (const bf16_t*)(ws_b + WS_NAVT);
    bf16_t* YN = (bf16_t*)(ws_b + WS_YN);
    const int row0 = b * 256, qrow = row0 + qg * 32 + c32;
    const bf16_t* k0 = Kn + (size_t)(row0 + pr) * 512 + h * 64 + hl * 8;
    const bf16_t* v0 = VT + ((size_t)((b * 8 + h) * 64 + c32)) * 256 + hl * 8;
    auto src = [=](int t) { TileSrc s; s.k = k0 + (size_t)t * 32 * 512; s.k2 = s.k; s.v = v0 + t * 32; s.vhi = s.v + 32 * 256; return s; };
    attn_wave<4, false>(Qn + (size_t)qrow * 512 + h * 64 + hl * 8, 0, 8, src, NoMask(), YN + (size_t)qrow * 512 + h * 64, lane);
}

struct NaMask {
    const float* rpb;
    int rs, rq, qc, hl;
    DEVI void operator()(int t, f32x16& s) const {
        if (t >= 16) return;
        const int kr = t >> 1, kh = t & 1;
        const int cs = min(max(qc - 8, 0), 48);
        const float* rp = rpb + (rs + kr - rq + 7) * 31;
#pragma unroll
        for (int r = 0; r < 16; ++r) {
            const int kk = (r & 3) + 4 * ((r >> 2) & 1) + 8 * hl + 16 * (r >> 3);
            const int kc = kh * 32 + kk;
            const bool ok = (kc >= cs) && (kc < cs + 16);
            const int dc = min(max(kc - qc + 15, 0), 30);
            const float bias = rp[dc];
            s[r] = ok ? s[r] + bias : -1e30f;
        }
    }
};
DEVI void attn_na_lat(const P& p, unsigned char* ws_b, int l, int b, int h, int rq, int qh, int lane, float* ex, int half, const float* rpb_lds) {
    const int hl = lane >> 5, c32 = lane & 31, pr = pi_row(c32);
    const bf16_t* Qn = (const bf16_t*)(ws_b + WS_NAQ);
    const bf16_t* Kn = (const bf16_t*)(ws_b + WS_NAK);
    const bf16_t* VT = (const bf16_t*)(ws_b + WS_NAVT) + (size_t)4194304;
    const bf16_t* CK = (const bf16_t*)(ws_b + WS_CNAK) + (size_t)l * 1024 * 512;
    const bf16_t* CV = (const bf16_t*)(ws_b + WS_CNAVT) + (size_t)l * 1024 * 512;
    bf16_t* YN = (bf16_t*)(ws_b + WS_YN);
    const int row0 = NCTX + b * 2048;
    const int qrow = row0 + rq * 64 + qh * 32 + c32;
    const int rs = min(max(rq - 4, 0), 24);
    const bf16_t* k0 = Kn + (size_t)(row0 + rs * 64 + pr) * 512 + h * 64 + hl * 8;
    const bf16_t* v0 = VT + ((size_t)((b * 8 + h) * 64 + c32)) * 2048 + rs * 64 + hl * 8;
    const bf16_t* k1 = CK + (size_t)(b * 512 + pr) * 512 + h * 64 + hl * 8;
    const bf16_t* v1 = CV + ((size_t)((b * 8 + h) * 64 + c32)) * 512 + hl * 8;
    auto src = [=](int t) {
        TileSrc s;
        if (t < 16) { s.k = k0 + (size_t)t * 32 * 512; s.v = v0 + t * 32; s.vhi = s.v + 32 * 2048; }
        else { s.k = k1 + (size_t)(t - 16) * 32 * 512; s.v = v1 + (t - 16) * 32; s.vhi = s.v + 32 * 512; }
        s.k2 = s.k; return s; };
    NaMask mk; mk.rpb = rpb_lds; mk.rs = rs; mk.rq = rq; mk.qc = qh * 32 + c32; mk.hl = hl;
    attn_wave<4, true>(Qn + (size_t)qrow * 512 + h * 64 + hl * 8, half * 16, 16, src, mk, YN + (size_t)qrow * 512 + h * 64, lane, ex, half);
}

DEVI void row_load(const float* src, f32x4 (&v)[4], int lane) {
#pragma unroll
    for (int j = 0; j < 4; ++j) v[j] = *(const f32x4*)(src + 4 * lane + 256 * j);
}
DEVI void row_ln_mod(f32x4 (&v)[4], float* xdst, bf16_t* hdst, const float* lng, const float* lnb, const float* shift, const float* scale, int lane) {
    if (lng) {
        float s = 0.f;
#pragma unroll
        for (int j = 0; j < 4; ++j) s += (v[j].x + v[j].y) + (v[j].z + v[j].w);
        const float mu = wave_sum(s) * (1.f / D);
        float q = 0.f;
#pragma unroll
        for (int j = 0; j < 4; ++j) { v[j] = v[j] - mu; q += (v[j].x * v[j].x + v[j].y * v[j].y) + (v[j].z * v[j].z + v[j].w * v[j].w); }
        const float rstd = rsqrtf(wave_sum(q) * (1.f / D) + 1e-5f);
#pragma unroll
        for (int j = 0; j < 4; ++j) {
            const f32x4 g = *(const f32x4*)(lng + 4 * lane + 256 * j), bb = *(const f32x4*)(lnb + 4 * lane + 256 * j);
            v[j] = v[j] * rstd * g + bb;
        }
    }
    if (xdst) {
#pragma unroll
        for (int j = 0; j < 4; ++j) *(f32x4*)(xdst + 4 * lane + 256 * j) = v[j];
    }
    if (hdst) {
        float s = 0.f;
#pragma unroll
        for (int j = 0; j < 4; ++j) s += (v[j].x + v[j].y) + (v[j].z + v[j].w);
        const float mu = wave_sum(s) * (1.f / D);
        float q = 0.f;
#pragma unroll
        for (int j = 0; j < 4; ++j) { v[j] = v[j] - mu; q += (v[j].x * v[j].x + v[j].y * v[j].y) + (v[j].z * v[j].z + v[j].w * v[j].w); }
        const float rstd = rsqrtf(wave_sum(q) * (1.f / D) + 1e-6f);
#pragma unroll
        for (int j = 0; j < 4; ++j) {
            const f32x4 sc = *(const f32x4*)(scale + 4 * lane + 256 * j), sh = *(const f32x4*)(shift + 4 * lane + 256 * j);
            const f32x4 o = v[j] * rstd * (sc + 1.f) + sh;
            u32x2 pk; pk.x = pk2(o.x, o.y); pk.y = pk2(o.z, o.w);
            *(u32x2*)(hdst + 4 * lane + 256 * j) = pk;
        }
    }
}

DEVI const float* phase_rows_src(const P& p, unsigned char* ws_b, int row, int lnidx) {
    return (lnidx < 0) ? (row < NCTX ? pin(p, 0) + (size_t)row * D : pin(p, 1) + (size_t)(row - NCTX) * D) : (const float*)(ws_b + WS_X) + (size_t)row * D;
}
DEVI void phase_rows_one(const P& p, unsigned char* ws_b, f32x4 (&v)[4], int row, int l, int lnidx, int ml, int ms, bool final_, int lane) {
    float* X = (float*)(ws_b + WS_X);
    bf16_t* H = (bf16_t*)(ws_b + WS_H);
    const float* MOD = (const float*)(ws_b + WS_MOD);
    const float* lng = (lnidx < 0) ? nullptr : pin(p, 28) + (size_t)(l * 3 + lnidx) * D;
    const float* lnb = (lnidx < 0) ? nullptr : pin(p, 29) + (size_t)(l * 3 + lnidx) * D;
    if (final_) { row_ln_mod(v, p.out + (size_t)row * D, nullptr, lng, lnb, nullptr, nullptr, lane); return; }
    const float* mb = MOD + ((size_t)ml * 3 + mod_group(row)) * 9216;
    row_ln_mod(v, X + (size_t)row * D, H + (size_t)row * D, lng, lnb, mb + ms * D, mb + (ms + 1) * D, lane);
}
DEVI void phase_rows(const P& p, unsigned char* ws_b, int l, int lnidx, int ml, int ms, bool final_, int gw, int ngw, int lane) {
    int row = gw;
    for (; row + ngw < M; row += 2 * ngw) {
        f32x4 va[4], vb[4];
        row_load(phase_rows_src(p, ws_b, row, lnidx), va, lane);
        row_load(phase_rows_src(p, ws_b, row + ngw, lnidx), vb, lane);
        phase_rows_one(p, ws_b, va, row, l, lnidx, ml, ms, final_, lane);
        phase_rows_one(p, ws_b, vb, row + ngw, l, lnidx, ml, ms, final_, lane);
    }
    if (row < M) { f32x4 va[4]; row_load(phase_rows_src(p, ws_b, row, lnidx), va, lane); phase_rows_one(p, ws_b, va, row, l, lnidx, ml, ms, final_, lane); }
}

DEVI void phase_rowmix(const P& p, unsigned char* ws_b, int l, int gw, int ngw, int lane) {
    bf16_t* UQ = (bf16_t*)(ws_b + WS_UQ);
    const float* UKV = (const float*)(ws_b + WS_UKV);
    const float* KRF = (const float*)(ws_b + WS_KRF);
    bf16_t* CKV = (bf16_t*)(ws_b + WS_CKV);
    bf16_t* KR = (bf16_t*)(ws_b + WS_KR);
    const float* ropec = (const float*)(ws_b + WS_ROPE);
    const float* ropes = ropec + 512;
    const float* gq = pin(p, 17) + l * 384;
    const float* gkv = pin(p, 19) + l * 256;
    for (int row = gw; row < M; row += ngw) {
        {
            unsigned* up = (unsigned*)(UQ + (size_t)row * 384) + lane;
            float x[6]; float ss = 0.f;
#pragma unroll
            for (int j = 0; j < 3; ++j) { const unsigned w = up[64 * j]; x[2 * j] = bf2f(w & 0xffffu); x[2 * j + 1] = bf2f(w >> 16); ss += x[2 * j] * x[2 * j] + x[2 * j + 1] * x[2 * j + 1]; }
            const float rs = rsqrtf(wave_sum(ss) * (1.f / 384.f) + 1e-6f);
#pragma unroll
            for (int j = 0; j < 3; ++j) { const int c = 2 * lane + 128 * j; up[64 * j] = pk2(x[2 * j] * rs * gq[c], x[2 * j + 1] * rs * gq[c + 1]); }
        }
        {
            const f32x4 v = *(const f32x4*)(UKV + (size_t)row * 256 + 4 * lane);
            const float ss = v.x * v.x + v.y * v.y + v.z * v.z + v.w * v.w;
            const float rs = rsqrtf(wave_sum(ss) * (1.f / 256.f) + 1e-6f);
            const f32x4 g = *(const f32x4*)(gkv + 4 * lane);
            const f32x4 o = v * rs * g;
            u32x2 pk; pk.x = pk2(o.x, o.y); pk.y = pk2(o.z, o.w);
            *(u32x2*)(CKV + (size_t)row * 256 + 4 * lane) = pk;
            if (row < NCTX) *(f32x4*)(p.out + OUT_CKV + ((size_t)((row >> 8) * 4 + l) * 256 + (row & 255)) * 256 + 4 * lane) = o;
        }
        {
            const float v = KRF[(size_t)row * 32 + (lane & 31)];
            const float pr = __shfl_xor(v, 8);
            float o = v;
            if (row >= NCTX) {
                const int c = lane & 31, axis = c >> 4, ii = c & 15, n = (row - NCTX) & 2047;
                const int pos = axis ? (n & 63) : (n >> 6);
                const float rot = (ii < 8) ? -pr : pr;
                o = v * ropec[pos * 8 + (ii & 7)] + rot * ropes[pos * 8 + (ii & 7)];
            }
            if (lane < 32) {
                KR[(size_t)row * 32 + lane] = f2bf(o);
                if (row < NCTX) p.out[OUT_KR + ((size_t)((row >> 8) * 4 + l) * 256 + (row & 255)) * 32 + lane] = v;
            }
        }
    }
}

DEVI void transpose_item(const float* __restrict__ src, int N, int c0, int k0, bf16_t* __restrict__ dst, int K, float* scr, int lane) {
#pragma unroll 8
    for (int i = 0; i < 32; ++i) { const int kk = 2 * i + (lane >> 5); scr[kk * 33 + (lane & 31)] = src[(size_t)(k0 + kk) * N + c0 + (lane & 31)]; }
    asm volatile("s_waitcnt lgkmcnt(0)" ::: "memory");
    const int c = lane & 7;
#pragma unroll
    for (int j = 0; j < 4; ++j) {
        const int n = (lane >> 3) + 8 * j; const float* s = scr + (8 * c) * 33 + n;
        u32x4 o; o.x = pk2(s[0], s[33]); o.y = pk2(s[2 * 33], s[3 * 33]); o.z = pk2(s[4 * 33], s[5 * 33]); o.w = pk2(s[6 * 33], s[7 * 33]);
        *(u32x4*)(dst + (size_t)n * K + k0 + 8 * c) = o;
    }
    asm volatile("s_waitcnt lgkmcnt(0)" ::: "memory");
}

DEVI void prep_weight_item(const P& p, unsigned char* ws_b, int item, float* scr, int lane) {
    const int l = item / 12944; int r = item % 12944;
    bf16_t* Wl = (bf16_t*)(ws_b + WS_W) + (size_t)l * LAYER_W;
    if (r < 8448) {
        const int which = r / 4224; r %= 4224;
        if (r < 2816) {
            const int rb = r >> 4, kb = r & 15;
            const float* src = ((lane & 16) ? (which ? pin(p, 14) : pin(p, 11)) : (which ? pin(p, 13) : pin(p, 10))) + (size_t)l * D * DFF;
            transpose_item(src, DFF, rb * 16 - (lane & 16), kb * 64, Wl + (which ? OFF_W13_2 : OFF_W13_1) + (size_t)rb * 32 * D, D, scr, lane);
        } else {
            r -= 2816; const int rb = r / 44, kb = r % 44;
            const float* src = (which ? pin(p, 15) : pin(p, 12)) + (size_t)l * DFF * D;
            transpose_item(src, D, rb * 32, kb * 64, Wl + (which ? OFF_W2_2 : OFF_W2_1) + (size_t)rb * 32 * DFF, DFF, scr, lane);
        }
        return;
    }
    r -= 8448;
    if (r < 2944) {
        const int rb = r >> 4, kb = r & 15, R0 = rb * 32;
        const float* src; int N, c0;
        if (R0 < 1184) { src = pin(p, 16) + (size_t)l * D * 2720; N = 2720; c0 = R0; }
        else if (R0 < 1280) return;
        else if (R0 < 2816) { src = pin(p, 16) + (size_t)l * D * 2720; N = 2720; c0 = R0 - 96; }
        else { src = pin(p, 25) + (size_t)l * D * 3072; N = 3072; c0 = R0 - 2816; }
        transpose_item(src, N, c0, kb * 64, Wl + OFF_WIN + (size_t)R0 * D, D, scr, lane);
        return;
    }
    r -= 2944;
    if (r < 512) { const int rb = r >> 4, kb = r & 15; transpose_item(pin(p, 27) + (size_t)l * D * D, D, rb * 32, kb * 64, Wl + OFF_WOUT + (size_t)rb * 32 * D, D, scr, lane); return; }
    r -= 512;
    if (r < 768) { const int w = r >> 8; r &= 255; const int rb = r >> 3, kb = r & 7;
        transpose_item((w == 0 ? pin(p, 22) : (w == 1 ? pin(p, 23) : pin(p, 24))) + (size_t)l * 512 * D, D, rb * 32, kb * 64, Wl + (w == 0 ? OFF_WBF : (w == 1 ? OFF_WBM : OFF_WBN)) + (size_t)rb * 32 * 512, 512, scr, lane); return; }
    r -= 768;
    if (r < 144) { const int rb = r / 6, kb = r % 6; transpose_item(pin(p, 18) + (size_t)l * 384 * 768, 768, rb * 32, kb * 64, Wl + OFF_WUQ + (size_t)rb * 32 * 384, 384, scr, lane); return; }
    r -= 144;
    { const int rb = r >> 2, kb = r & 3; transpose_item(pin(p, 20) + (size_t)l * 256 * 1024, 1024, rb * 32, kb * 64, Wl + OFF_WUKV + (size_t)rb * 32 * 256, 256, scr, lane); }
}

DEVI void phase_prep(const P& p, unsigned char* ws_b, unsigned char* smem, int tid) {
    const int lane = tid & 63, wave = tid >> 6;
    const int gw = blockIdx.x * NWAVES + wave, ngw = gridDim.x * NWAVES;
    const size_t gt = (size_t)blockIdx.x * NTHREADS + tid, ngt = (size_t)gridDim.x * NTHREADS;
    {
        float* sil = (float*)smem;
        const float* wada = pin(p, 8);
        float* MODP = (float*)(ws_b + WS_MODP);
        for (int item = blockIdx.x; item < 1152; item += gridDim.x) {
            const int l = item / 288, rem = item % 288, kc = rem / 18, cb = rem % 18;
            __syncthreads();
            if (tid < 192) {
                const int g = tid >> 6, k = kc * 64 + (tid & 63);
                const float cv = (g == 0) ? pin(p, 7)[k] : pin(p, 6)[(g - 1) * D + k];
                sil[tid] = cv * sigmoidf_(cv);
            }
            __syncthreads();
            const int col = cb * NTHREADS + tid;
            const float* w = wada + ((size_t)l * D + kc * 64) * 9216 + col;
            float a0 = 0.f, a1 = 0.f, a2 = 0.f;
#pragma unroll 16
            for (int k = 0; k < 64; ++k) { const float wv = w[(size_t)k * 9216]; a0 += sil[k] * wv; a1 += sil[64 + k] * wv; a2 += sil[128 + k] * wv; }
            float* o = MODP + ((size_t)(l * 16 + kc) * 3) * 9216 + col;
            o[0] = a0; o[9216] = a1; o[2 * 9216] = a2;
        }
        __syncthreads();
    }
    {
        float* scr = (float*)smem + wave * (64 * 33);
        for (int item = gw; item < 4 * 12944; item += ngw) prep_weight_item(p, ws_b, item, scr, lane);
    }
    {
        bf16_t* TABL = (bf16_t*)(ws_b + WS_TABL);
        for (size_t e = gt; e < (size_t)2048 * 4096; e += ngt) {
            const int k = (int)(e >> 12), kk = (int)(e & 4095), lidx = kk & 2047;
            const int idx = (k * lidx) & 2047;
            float sn, cs; sincospif((float)idx * (2.f / 2048.f), &sn, &cs);
            TABL[e] = f2bf((kk < 2048 ? cs : -sn) * 0.022097086912079608f);
        }
        bf16_t* TABC = (bf16_t*)(ws_b + WS_TABC);
        for (size_t e = gt; e < (size_t)256 * 512; e += ngt) {
            const int k = (int)(e >> 9), kk = (int)(e & 511), lidx = kk & 255;
            const int idx = (k * lidx) & 255;
            float sn, cs; sincospif((float)idx * (2.f / 256.f), &sn, &cs);
            TABC[e] = f2bf((kk < 256 ? cs : -sn) * 0.0625f);
        }
        bf16_t* WCS = (bf16_t*)(ws_b + WS_WCS);
        for (size_t e = gt; e < (size_t)256 * 128; e += ngt) {
            const int i = (int)(e >> 7), c = (int)(e & 127), m = i >> 1, cs_ = i & 1;
            const int idx = (m * c) & 127;
            float sn, cs; sincospif((float)idx * (2.f / 128.f), &sn, &cs);
            WCS[e] = f2bf((cs_ ? sn : cs) * 0.08838834764831845f);
        }
        float* ROPE = (float*)(ws_b + WS_ROPE);
        for (size_t e = gt; e < 512; e += ngt) {
            const int pos = (int)(e >> 3), i = (int)(e & 7);
            const float inv_freq = powf(10000.f, -(float)i / 8.f);
            const float ang = (float)pos * inv_freq;
            ROPE[e] = cosf(ang); ROPE[512 + e] = sinf(ang);
        }
    }
    {
        bf16_t* CCKV = (bf16_t*)(ws_b + WS_CCKV);
        for (size_t e = gt; e < (size_t)NL * 1024 * 256; e += ngt) {
            const int c = (int)(e & 255), i = (int)((e >> 8) & 511), b = (int)((e >> 17) & 1), l = (int)(e >> 18);
            CCKV[e] = f2bf(pin(p, 2)[((size_t)(b * 4 + l) * 512 + i) * 256 + c]);
        }
        bf16_t* CKR = (bf16_t*)(ws_b + WS_CKR);
        for (size_t e = gt; e < (size_t)NL * 1024 * 32; e += ngt) {
            const int c = (int)(e & 31), i = (int)((e >> 5) & 511), b = (int)((e >> 14) & 1), l = (int)(e >> 15);
            CKR[e] = f2bf(pin(p, 3)[((size_t)(b * 4 + l) * 512 + i) * 32 + c]);
        }
        bf16_t* CNAK = (bf16_t*)(ws_b + WS_CNAK);
        for (size_t e = gt; e < (size_t)NL * 1024 * 512; e += ngt) {
            const int c = (int)(e & 511), i = (int)((e >> 9) & 511), b = (int)((e >> 18) & 1), l = (int)(e >> 19);
            CNAK[e] = f2bf(pin(p, 4)[((size_t)(b * 4 + l) * 512 + i) * 512 + c]);
        }
        bf16_t* CNAVT = (bf16_t*)(ws_b + WS_CNAVT);
        for (size_t e = gt; e < (size_t)NL * 1024 * 512; e += ngt) {
            const int key = (int)(e & 511), hd = (int)((e >> 9) & 511), b = (int)((e >> 18) & 1), l = (int)(e >> 19);
            CNAVT[e] = f2bf(pin(p, 5)[((size_t)(b * 4 + l) * 512 + key) * 512 + hd]);
        }
    }
}

DEVI void phase_modreduce(const P& p, unsigned char* ws_b, int tid) {
    const float* MODP = (const float*)(ws_b + WS_MODP);
    float* MOD = (float*)(ws_b + WS_MOD);
    for (int e = blockIdx.x * NTHREADS + tid; e < NL * 3 * 9216; e += gridDim.x * NTHREADS) {
        const int l = e / (3 * 9216), rem = e % (3 * 9216);
        float a = pin(p, 9)[l * 9216 + (rem % 9216)];
#pragma unroll
        for (int kc = 0; kc < 16; ++kc) a += MODP[((size_t)(l * 16 + kc) * 3) * 9216 + rem];
        MOD[e] = a;
    }
}

#define XB_TMO      128
#define XB_XCNT(j)  (256  + 64 * (j))
#define XB_XSUB(j)  (1280 + 64 * (j))
#define XB_XGEN(j)  (2304 + 64 * (j))
#define XB_TOP      3328
#define XB_TOPGEN   3392
#define XCD_BAR_WORDS 3456
#define XB_SPIN_CAP (1u << 20)
#define LAS __attribute__((address_space(3)))
DEVI unsigned xb_ld(unsigned* p)              { return __hip_atomic_load(p, __ATOMIC_RELAXED, __HIP_MEMORY_SCOPE_AGENT); }
DEVI unsigned xb_add(unsigned* p, unsigned v) { return __hip_atomic_fetch_add(p, v, __ATOMIC_RELAXED, __HIP_MEMORY_SCOPE_AGENT); }
DEVI unsigned xb_xcc_id() { return (unsigned)__builtin_amdgcn_s_getreg((3 << 11) | 20) & 0xFu; }
#define XB_SPIN(cond, bar) do { unsigned _sp = 0; while (cond) { __builtin_amdgcn_s_sleep(1); \
    if ((++_sp & 255u) == 0u) { if (xb_ld(&(bar)[XB_TMO])) break; if (_sp > XB_SPIN_CAP) { atomicAdd(&(bar)[XB_TMO], 1u); break; } } } } while (0)
struct XcdBarrier { unsigned* bar; unsigned x; volatile LAS unsigned* st; };
DEVI XcdBarrier xcd_barrier_post(unsigned* bar, volatile LAS unsigned* st) {
    XcdBarrier b; b.bar = bar; b.x = xb_xcc_id(); b.st = st;
    if (threadIdx.x == 0) (void)xb_add(&bar[XB_XCNT(b.x)], 1u);
    return b;
}
DEVI void xcd_barrier_complete(unsigned* bar, unsigned x, unsigned& nloc, unsigned& nx) {
    const unsigned G = gridDim.x * gridDim.y * gridDim.z;
    unsigned sum, cnt, mine, sp = 0u;
    for (;;) {
        sum = 0u; cnt = 0u; mine = 0u;
#pragma unroll
        for (unsigned j = 0; j < 16; ++j) { const unsigned c = xb_ld(&bar[XB_XCNT(j)]); sum += c; cnt += (c > 0u) ? 1u : 0u; mine = (j == x) ? c : mine; }
        if (sum == G) break;
        __builtin_amdgcn_s_sleep(1);
        if ((++sp & 255u) == 0u) { if (xb_ld(&bar[XB_TMO])) break; if (sp > XB_SPIN_CAP) { atomicAdd(&bar[XB_TMO], 1u); break; } }
    }
    nloc = mine > 0u ? mine : 1u; nx = cnt > 0u ? cnt : 1u;
}
DEVI void xcd_barrier(const XcdBarrier& b) {
    asm volatile("s_waitcnt vmcnt(0)" ::: "memory");
    __syncthreads();
    if (threadIdx.x == 0) {
        unsigned* bar = b.bar;
        __builtin_amdgcn_s_waitcnt(0);
        unsigned nloc = b.st[0], nx = b.st[1];
        if (nloc == 0u) { xcd_barrier_complete(bar, b.x, nloc, nx); b.st[0] = nloc; b.st[1] = nx; }
        const unsigned old = xb_add(&bar[XB_XSUB(b.x)], 1u);
        const unsigned gen = old / nloc;
        if (old + 1u == (gen + 1u) * nloc) {
            __builtin_amdgcn_fence(__ATOMIC_RELEASE, "agent");
            asm volatile("s_waitcnt vmcnt(0)" ::: "memory");
            const unsigned og = xb_add(&bar[XB_TOP], 1u);
            const unsigned tg = og / nx;
            if (og + 1u == (tg + 1u) * nx) xb_add(&bar[XB_TOPGEN], 1u);
            else XB_SPIN(xb_ld(&bar[XB_TOPGEN]) == tg, bar);
            __builtin_amdgcn_fence(__ATOMIC_ACQUIRE, "agent");
            xb_add(&bar[XB_XGEN(b.x)], 1u);
            asm volatile("s_waitcnt vmcnt(0)" ::: "memory");
        } else {
            XB_SPIN(xb_ld(&bar[XB_XGEN(b.x)]) == gen, bar);
            __builtin_amdgcn_fence(__ATOMIC_ACQUIRE, "agent");
            asm volatile("s_waitcnt vmcnt(0)" ::: "memory");
        }
    }
    __syncthreads();
}

DEVI void run_phase(const P& p, unsigned char* ws_b, int ph, unsigned char* smem, int tid) {
    const int lane = tid & 63, wave = tid >> 6;
    const int gw = blockIdx.x * NWAVES + wave, ngw = gridDim.x * NWAVES;
    const int nb = gridDim.x, bid = blockIdx.x;
    const int grp = tid >> 8, ltid = tid & 255;
    bf16_t* sm = (bf16_t*)smem + grp * (SMEM_BYTES / 2);
    if (ph == 0) { phase_prep(p, ws_b, smem, tid); return; }
    if (ph == 1) { phase_modreduce(p, ws_b, tid); return; }
    if (ph == 2) { phase_rows(p, ws_b, 0, -1, 0, 0, false, gw, ngw, lane); return; }
    const int l = (ph - 3) / 13, s = (ph - 3) % 13;
    const bf16_t* Wl = (const bf16_t*)(ws_b + WS_W) + (size_t)l * LAYER_W;
    const float* MODl = (const float*)(ws_b + WS_MOD) + (size_t)l * 3 * 9216;
    switch (s) {
    case 0: case 10:
        {
            pg8::Gemm g{(const bf16_t*)(ws_b + WS_H), Wl + (s == 10 ? OFF_W13_2 : OFF_W13_1), M, 2 * DFF, D};
            pg8::StaticOrder S; S.init(M, 2 * DFF, nb, bid);
            pg8::EpiSwiGLU E{(bf16_t*)(ws_b + WS_ACT)};
            pg8::gemm_phase<pg8::EpiSwiGLU, pg8::StaticOrder, true, true>((PG8_LAS unsigned char*)smem, g, S, E, tid);
        }
        break;
    case 1: case 11:
        {
            pg8::Gemm g{(const bf16_t*)(ws_b + WS_ACT), Wl + (s == 11 ? OFF_W2_2 : OFF_W2_1), M, D, DFF};
            pg8::StaticOrder S; S.init(M, D, nb, bid);
            pg8::EpiResid E{(float*)(ws_b + WS_X), MODl + (s == 11 ? 8 : 2) * D, 0.5f};
            pg8::gemm_phase<pg8::EpiResid, pg8::StaticOrder, false, true>((PG8_LAS unsigned char*)smem, g, S, E, tid);
        }
        break;
    case 2: phase_rows(p, ws_b, l, 0, l, 3, false, gw, ngw, lane); break;
    case 3:
        {
            pg8::Gemm g{(const bf16_t*)(ws_b + WS_H), Wl + OFF_WIN, M, 5888, D};
            pg8::StaticOrder S; S.init(M, 5888, nb, bid);
            pg8::EpiIn E{ws_b, p.out, pin(p, 26), l};
            pg8::gemm_phase<pg8::EpiIn, pg8::StaticOrder, true, true>((PG8_LAS unsigned char*)smem, g, S, E, tid);
        }
        break;
    case 4: phase_rowmix(p, ws_b, l, gw, ngw, lane); break;
    case 5: {
        float* ex = (float*)smem + (wave & 3) * (34 * 64);
        int u = bid;
        for (; u < 256; u += nb) {
            const int wi = u * 4 + (wave & 3);
            float* rpb_lds = (float*)(smem + 36864);
            {
                const float* rsrc = pin(p, 21) + (size_t)(l * 8 + ((u * 4 >> 6) & 7)) * 465;
                if (tid < 465) rpb_lds[tid] = rsrc[tid] * LOG2E;
                __syncthreads();
            }
            attn_na_lat(p, ws_b, l, wi >> 9, (wi >> 6) & 7, (wi >> 1) & 31, wi & 1, lane, ex, wave >> 2, rpb_lds);
        }
        for (; u < 256 + 416; u += nb) job_ukv(p, ws_b, l, 2 * (u - 256) + grp, sm, ltid);
        for (; u < 256 + 416 + 288; u += nb) job_uq(p, ws_b, l, 2 * (u - 256 - 416) + grp, sm, ltid);
        for (; u < 256 + 416 + 288 + 384; u += nb) job_f1(p, ws_b, 2 * (u - 256 - 416 - 288) + grp, sm, ltid);
        for (; u < 256 + 416 + 288 + 384 + 256; u += nb) {
            const int wi = (u - 256 - 416 - 288 - 384) * 8 + wave;
            const int b = wi >> 6, h = (wi >> 3) & 7, qrow = b * 256 + wave * 32 + (lane & 31);
            attn_ctx_shared<4>((const bf16_t*)(ws_b + WS_NAK) + (size_t)(b * 256) * 512 + h * 64, nullptr,
                               (const bf16_t*)(ws_b + WS_NAVT) + (size_t)((b * 8 + h) * 64) * 256,
                               (const bf16_t*)(ws_b + WS_NAQ) + (size_t)qrow * 512 + h * 64 + (lane >> 5) * 8,
                               (bf16_t*)(ws_b + WS_YN) + (size_t)qrow * 512 + h * 64, tid, smem);
        }
    } break;
    case 6: {
        float* ex = (float*)smem + (wave & 3) * (34 * 64);
        int u = bid;
        for (; u < 256; u += nb) {
            const int wi = u * 4 + (wave & 3);
            attn_mla_lat_shared(p, ws_b, l, wi >> 9, (wi >> 6) & 7, wi & 63, tid, smem, ex);
        }
        for (; u < 256 + 128; u += nb) {
            const int t0 = u - 256, tt = ((t0 & 7) + 8 * ((t0 >> 3) >> 2)) * 4 + ((t0 >> 3) & 3);
            job_f2_lat(p, ws_b, tt, sm, ltid, grp, (float*)(smem + SMEM_BYTES));
        }
        for (; u < 256 + 128 + 128; u += nb) job_f2_ctx(p, ws_b, 2 * (u - 256 - 128) + grp, sm, ltid);
        for (; u < 256 + 128 + 128 + 256; u += nb) {
            const int wi = (u - 256 - 128 - 128) * 8 + wave;
            const int b = wi >> 6, h = (wi >> 3) & 7, qrow = b * 256 + wave * 32 + (lane & 31);
            attn_ctx_shared<6>((const bf16_t*)(ws_b + WS_KN) + (size_t)(b * 256) * 512 + h * 64, (const bf16_t*)(ws_b + WS_KR) + (size_t)(b * 256) * 32,
                               (const bf16_t*)(ws_b + WS_VTM) + (size_t)((b * 8 + h) * 64) * 256,
                               (const bf16_t*)(ws_b + WS_Q) + (size_t)qrow * 768 + h * 96 + (lane >> 5) * 8,
                               (bf16_t*)(ws_b + WS_YM) + (size_t)qrow * 512 + h * 64, tid, smem);
        }
    } break;
    case 7:

#pragma nounroll
        for (int sg = 0; sg < 3; ++sg) {
            int tid3 = tid; asm volatile("" : "+v"(tid3));
            pg8::Gemm g{(const bf16_t*)(ws_b + (sg == 0 ? WS_YF : (sg == 1 ? WS_YM : WS_YN))), Wl + (sg == 0 ? OFF_WBF : (sg == 1 ? OFF_WBM : OFF_WBN)), M, D, 512};
            pg8::StaticOrder S; S.init(M, D, nb, bid);
            pg8::EpiMerge E{(const bf16_t*)(ws_b + WS_GATE), (bf16_t*)(ws_b + WS_UF)  , (bf16_t*)(ws_b + WS_MERGED), sg};
            pg8::gemm_phase<pg8::EpiMerge, pg8::StaticOrder, false, true>((PG8_LAS unsigned char*)smem, g, S, E, tid3);
        }
        break;
    case 8:
        {
            pg8::Gemm g{(const bf16_t*)(ws_b + WS_MERGED), Wl + OFF_WOUT, M, D, D};
            pg8::StaticOrder S; S.init(M, D, nb, bid);
            pg8::EpiResid E{(float*)(ws_b + WS_X), MODl + 5 * D, 1.0f};
            pg8::gemm_phase<pg8::EpiResid, pg8::StaticOrder, false, true>((PG8_LAS unsigned char*)smem, g, S, E, tid);
        }
        break;
    case 9: phase_rows(p, ws_b, l, 1, l, 6, false, gw, ngw, lane); break;
    case 12:
        if (l == NL - 1) phase_rows(p, ws_b, l, 2, 0, 0, true, gw, ngw, lane);
        else phase_rows(p, ws_b, l, 2, l + 1, 0, false, gw, ngw, lane);
        break;
    default: break;
    }
}

__global__ void __launch_bounds__(NTHREADS, 2) mega_kernel(P p) {
    extern __shared__ __attribute__((aligned(16))) unsigned char smem[];
    __shared__ uint4 xb_words;
    cg::grid_group grid = cg::this_grid();
    const int tid = threadIdx.x;
    unsigned* bar = (unsigned*)(p.ws + WS_BAR);
    if (tid == 0) xb_words = make_uint4(0u, 0u, 0u, 0u);
    if (p.ph_lo == 0 && blockIdx.x == 0) for (int i = tid; i < XCD_BAR_WORDS; i += NTHREADS) bar[i] = 0u;
    __syncthreads();
    XcdBarrier xb; xb.bar = bar; xb.x = 0; xb.st = (volatile LAS unsigned*)&xb_words;
#pragma nounroll
    for (int ph = p.ph_lo; ph < p.ph_hi; ++ph) {
        int tid2 = tid; asm volatile("" : "+v"(tid2));
        unsigned char* ws_b = p.ws; asm volatile("" : "+s"(ws_b));
        run_phase(p, ws_b, ph, smem, tid2);
        if (ph + 1 < p.ph_hi) {
            if (ph == p.ph_lo) { grid.sync(); xb = xcd_barrier_post(bar, (volatile LAS unsigned*)&xb_words); }
            else xcd_barrier(xb);
        }
    }
}

extern "C" void kernel_launch(void* const* d_in, const int* in_sizes, int n_in, void* d_out, int out_size, void* d_ws, size_t ws_size,
                              hipStream_t stream) {
    static int grid_blocks = 0;
    if (grid_blocks == 0) {
        if (n_in != 30 || ws_size < WS_END) { fprintf(stderr, "kernel_launch: n_in %d ws %zu need %zu\n", n_in, ws_size, (size_t)WS_END); grid_blocks = -1; return; }
        int dev = 0, cus = 0, per_cu = 0;
        hipGetDevice(&dev);
        hipDeviceGetAttribute(&cus, hipDeviceAttributeMultiprocessorCount, dev);
        hipFuncSetAttribute((const void*)mega_kernel, hipFuncAttributeMaxDynamicSharedMemorySize, LDS_TOTAL);
        hipOccupancyMaxActiveBlocksPerMultiprocessor(&per_cu, (const void*)mega_kernel, NTHREADS, LDS_TOTAL);
        if (per_cu < 1) per_cu = 1;
        if (per_cu > 1) per_cu = 1;
        grid_blocks = cus * per_cu;
    }
    if (grid_blocks < 0) return;
    P p{};
    for (int i = 0; i < 30; ++i) p.in[i] = (const float*)d_in[i];
    p.out = (float*)d_out; p.ws = (unsigned char*)d_ws; p.ph_lo = 0; p.ph_hi = NPHASE;
#ifndef MULTI_LAUNCH
#define MULTI_LAUNCH 0
#endif
#if MULTI_LAUNCH
    for (int ph = 0; ph < NPHASE; ++ph) {
        p.ph_lo = ph; p.ph_hi = ph + 1;
        hipLaunchKernelGGL(mega_kernel, dim3(grid_blocks), dim3(NTHREADS), LDS_TOTAL, stream, p);
    }
#else
    void* args[] = {&p};
    hipError_t e = hipLaunchCooperativeKernel((const void*)mega_kernel, dim3(grid_blocks), dim3(NTHREADS), args, LDS_TOTAL, stream);
    if (e != hipSuccess) fprintf(stderr, "cooperative launch failed: %s (grid %d)\n", hipGetErrorString(e), grid_blocks);
#endif
}
```

```cpp
#include <hip/hip_runtime.h>
#include <hip/hip_cooperative_groups.h>
#include <cstdint>
#include <cstdio>
namespace cg = cooperative_groups;

typedef unsigned short bf16_t;
typedef short bf16x8 __attribute__((ext_vector_type(8)));
typedef float f32x16 __attribute__((ext_vector_type(16)));
typedef float f32x4 __attribute__((ext_vector_type(4)));
typedef unsigned u32x4 __attribute__((ext_vector_type(4)));
typedef unsigned u32x2 __attribute__((ext_vector_type(2)));
#define DEVI __device__ __forceinline__

constexpr int D = 1024, NCTX = 8192, NLAT = 4096, M = 12288, MX = 13312, DFF = 2816, NL = 4;
constexpr float ALPHA_F = 1.6817928305074290f;
constexpr float LOG2E = 1.4426950408889634f;
constexpr float MLA_QS = 0.10206207261596575f * LOG2E;
constexpr float NA_QS = 0.125f * LOG2E;
constexpr size_t OUT_CKV = 12582912, OUT_KR = 20971520, OUT_NAK = 22020096, OUT_NAV = 38797312;

constexpr size_t al256(size_t x) { return (x + 255) & ~(size_t)255; }
constexpr size_t WS_BAR = 0;
constexpr size_t WS_X = 16384;
constexpr size_t WS_H = WS_X + (size_t)M * D * 4;
constexpr size_t WS_MOD = WS_H + (size_t)M * D * 2;
constexpr size_t WS_MODP = WS_MOD + al256((size_t)NL * 3 * 9216 * 4);
constexpr size_t WS_ROPE = WS_MODP + al256((size_t)NL * 16 * 3 * 9216 * 4);
constexpr size_t WS_TABC = WS_ROPE + 4096;
constexpr size_t WS_TABL = WS_TABC + (size_t)256 * 512 * 2;
constexpr size_t WS_WCS = WS_TABL + (size_t)2048 * 4096 * 2;
constexpr size_t WS_CCKV = WS_WCS + (size_t)256 * 128 * 2;
constexpr size_t WS_CKR = WS_CCKV + (size_t)NL * 1024 * 256 * 2;
constexpr size_t WS_CNAK = WS_CKR + (size_t)NL * 1024 * 32 * 2;
constexpr size_t WS_CNAVT = WS_CNAK + (size_t)NL * 1024 * 512 * 2;
constexpr size_t WS_W = WS_CNAVT + (size_t)NL * 1024 * 512 * 2;
constexpr size_t OFF_W13_1 = 0, OFF_W2_1 = 5767168, OFF_W13_2 = 8650752, OFF_W2_2 = 14417920, OFF_WIN = 17301504,
                 OFF_WOUT = 23330816, OFF_WBF = 24379392, OFF_WBM = 24903680, OFF_WBN = 25427968, OFF_WUQ = 25952256,
                 OFF_WUKV = 26247168, LAYER_W = 26509312;
constexpr size_t WS_R1 = WS_W + (size_t)NL * LAYER_W * 2;
constexpr size_t WS_ACT = WS_R1;
constexpr size_t WS_UF = WS_R1;
constexpr size_t WS_UQ = WS_UF + (size_t)M * 512 * 2;
constexpr size_t WS_UKV = WS_UQ + (size_t)M * 384 * 2;
constexpr size_t WS_KRF = WS_UKV + (size_t)M * 256 * 4;
constexpr size_t WS_CKV = WS_KRF + (size_t)M * 32 * 4;
constexpr size_t WS_KR = WS_CKV + (size_t)M * 256 * 2;
constexpr size_t WS_NAQ = WS_KR + (size_t)M * 32 * 2;
constexpr size_t WS_NAK = WS_NAQ + (size_t)M * 512 * 2;
constexpr size_t WS_NAVT = WS_NAK + (size_t)M * 512 * 2;
constexpr size_t WS_GATE = WS_NAVT + (size_t)M * 512 * 2;
constexpr size_t WS_Q = WS_GATE + (size_t)M * 3072 * 2;
constexpr size_t WS_KN = WS_Q + (size_t)M * 768 * 2;
constexpr size_t WS_VTM = WS_KN + (size_t)MX * 512 * 2;
constexpr size_t WS_F1T = WS_VTM + (size_t)MX * 512 * 2;
constexpr size_t WS_YF = WS_F1T + (size_t)M * 1024 * 2;
constexpr size_t WS_YM = WS_YF + (size_t)M * 512 * 2;
constexpr size_t WS_YN = WS_YM + (size_t)M * 512 * 2;
constexpr size_t WS_MERGED = WS_YN + (size_t)M * 512 * 2;
constexpr size_t WS_END = WS_MERGED + (size_t)M * 1024 * 2;
static_assert(WS_END - WS_R1 >= (size_t)M * DFF * 2, "ACT must fit in R1");
static_assert(WS_NAK - WS_UF >= (size_t)M * D * 4, "merge T32 must fit in the dead UF..NAQ buffers");

constexpr int NPHASE = 3 + 13 * NL;

struct P {
    const float* in[30];
    float* out;
    unsigned char* ws;
    int ph_lo, ph_hi;
};

__device__ __forceinline__ const float* pin(const P& p, int i) { int j = i; asm volatile("" : "+s"(j)); return p.in[j]; }
typedef __bf16 bf16v2 __attribute__((ext_vector_type(2)));
typedef float f32x2 __attribute__((ext_vector_type(2)));
DEVI unsigned pk2(float lo, float hi) { f32x2 v = {lo, hi}; bf16v2 b = __builtin_convertvector(v, bf16v2); return __builtin_bit_cast(unsigned, b); }
DEVI bf16_t f2bf(float x) { return (bf16_t)(pk2(x, 0.f) & 0xffffu); }
DEVI float bf2f(unsigned v) { return __uint_as_float(v << 16); }
DEVI float wave_sum(float v) {
#pragma unroll
    for (int o = 1; o < 64; o <<= 1) v += __shfl_xor(v, o);
    return v;
}
DEVI float fast_exp2(float x) { return __builtin_amdgcn_exp2f(x); }
DEVI float sigmoidf_(float x) { return 1.f / (1.f + __expf(-x)); }

constexpr int LDT = 72;
constexpr int TILE_E = 128 * LDT;
constexpr int SMEM_BYTES = 4 * TILE_E * 2;
constexpr int NTHREADS = 512, NWAVES = 8, LDS_TOTAL = 2 * SMEM_BYTES;

DEVI void gemm_ldg(const bf16_t* ga, const bf16_t* gb, int lda, int ldb, u32x4 (&ra)[4], u32x4 (&rb)[4]) {
#pragma unroll
    for (int i = 0; i < 4; ++i) {
        ra[i] = *(const u32x4*)(ga + (size_t)(32 * i) * lda);
        rb[i] = *(const u32x4*)(gb + (size_t)(32 * i) * ldb);
    }
}
DEVI void gemm_sts(bf16_t* buf, int soff, const u32x4 (&ra)[4], const u32x4 (&rb)[4]) {
#pragma unroll
    for (int i = 0; i < 4; ++i) {
        *(u32x4*)(buf + soff + 32 * i * LDT) = ra[i];
        *(u32x4*)(buf + TILE_E + soff + 32 * i * LDT) = rb[i];
    }
}
DEVI void gemm_mma(const bf16_t* cur, int aoff, int boff, f32x16 (&acc)[2][2]) {
#pragma unroll
    for (int ks = 0; ks < 4; ++ks) {
        bf16x8 a0 = *(const bf16x8*)(cur + aoff + ks * 16);
        bf16x8 a1 = *(const bf16x8*)(cur + aoff + 32 * LDT + ks * 16);
        bf16x8 b0 = *(const bf16x8*)(cur + boff + ks * 16);
        bf16x8 b1 = *(const bf16x8*)(cur + boff + 32 * LDT + ks * 16);
        acc[0][0] = __builtin_amdgcn_mfma_f32_32x32x16_bf16(a0, b0, acc[0][0], 0, 0, 0);
        acc[0][1] = __builtin_amdgcn_mfma_f32_32x32x16_bf16(a0, b1, acc[0][1], 0, 0, 0);
        acc[1][0] = __builtin_amdgcn_mfma_f32_32x32x16_bf16(a1, b0, acc[1][0], 0, 0, 0);
        acc[1][1] = __builtin_amdgcn_mfma_f32_32x32x16_bf16(a1, b1, acc[1][1], 0, 0, 0);
    }
}

template <bool DEEP = true>
DEVI void gemm_core(const bf16_t* __restrict__ A, int lda, const bf16_t* __restrict__ B, int ldb, int K,
                    f32x16 (&acc)[2][2], bf16_t* smem, int tid) {
    const int lane = tid & 63, wave = tid >> 6, wr = wave >> 1, wc = wave & 1;
    const int lr = tid >> 3, lc = (tid & 7) * 8;
    const bf16_t* ga = A + (size_t)lr * lda + lc;
    const bf16_t* gb = B + (size_t)lr * ldb + lc;
    const int soff = lr * LDT + lc;
    const int nk = K >> 6;
    const int aoff = (wr * 64 + (lane & 31)) * LDT + (lane >> 5) * 8;
    const int boff = TILE_E + (wc * 64 + (lane & 31)) * LDT + (lane >> 5) * 8;
    bf16_t* buf0 = smem; bf16_t* buf1 = smem + 2 * TILE_E;
    if constexpr (DEEP) {
        u32x4 ra0[4], rb0[4], ra1[4], rb1[4];
        gemm_ldg(ga, gb, lda, ldb, ra0, rb0);
        gemm_ldg(ga + 64, gb + 64, lda, ldb, ra1, rb1);
        gemm_sts(buf0, soff, ra0, rb0);
        __syncthreads();
        for (int kt = 0; kt < nk; kt += 2) {
            if (kt + 2 < nk) gemm_ldg(ga + (size_t)(kt + 2) * 64, gb + (size_t)(kt + 2) * 64, lda, ldb, ra0, rb0);
            gemm_mma(buf0, aoff, boff, acc);
            gemm_sts(buf1, soff, ra1, rb1);
            __syncthreads();
            if (kt + 3 < nk) gemm_ldg(ga + (size_t)(kt + 3) * 64, gb + (size_t)(kt + 3) * 64, lda, ldb, ra1, rb1);
            gemm_mma(buf1, aoff, boff, acc);
            if (kt + 2 < nk) gemm_sts(buf0, soff, ra0, rb0);
            __syncthreads();
        }
    } else {
        u32x4 ra[4], rb[4];
        gemm_ldg(ga, gb, lda, ldb, ra, rb);
        gemm_sts(buf0, soff, ra, rb);
        __syncthreads();
        for (int kt = 0; kt < nk; ++kt) {
            bf16_t* cur = (kt & 1) ? buf1 : buf0;
            bf16_t* nxt = (kt & 1) ? buf0 : buf1;
            const bool more = (kt + 1 < nk);
            if (more) { ga += 64; gb += 64; gemm_ldg(ga, gb, lda, ldb, ra, rb); }
            gemm_mma(cur, aoff, boff, acc);
            if (more) gemm_sts(nxt, soff, ra, rb);
            __syncthreads();
        }
    }
}

DEVI void zero_acc(f32x16 (&acc)[2][2]) {
#pragma unroll
    for (int i = 0; i < 2; ++i)
#pragma unroll
        for (int j = 0; j < 2; ++j)
#pragma unroll
            for (int r = 0; r < 16; ++r) acc[i][j][r] = 0.f;
}

#define EPI_SETUP const int lane = tid & 63, wave = tid >> 6, wr = wave >> 1, wc = wave & 1, hl = lane >> 5, c32 = lane & 31; (void)wr; (void)wc; (void)hl; (void)c32;

DEVI int mod_group(int row) { return row < NCTX ? 0 : 1 + ((row - NCTX) >> 11); }

namespace pg8 {
#define PG8_LAS __attribute__((address_space(3)))
constexpr int BM = 256, BK = 64, HALF = 128, HTB = HALF * BK * 2, NXCD = 8, WGM = 8;
DEVI int lds_byte(int r, int c) { const int st = (r >> 4) * 2 + (c >> 5), rr = r & 15, cc = c & 31, ob = rr * 64 + cc * 2; return st * 1024 + (ob ^ (((ob >> 9) & 1) << 5)); }
DEVI void stage_rc(int b, int& R, int& C) { const int st = b / 1024, sb = b % 1024, swz = sb ^ (((sb >> 9) & 1) << 5); R = (st >> 1) * 16 + swz / 64; C = (st & 1) * 32 + (swz % 64) / 2; }
DEVI int perm32(int rho) { const int n = rho >> 4, i = rho & 15; return 8 * (i >> 2) + 4 * n + (i & 3); }
struct Unit { int pm, pn; };
struct Gemm { const bf16_t* A; const bf16_t* Bt; int M, N, K; };
struct StaticOrder {
    int nM, nN, nwg, G, c;
    DEVI void init(int M, int N, int G_, int c_) { nM = M / BM; nN = N / BM; nwg = nM * nN; G = G_; c = c_; }
    DEVI bool next(int i, Unit& u) const {
        const long L = (long)i * G + c; if (L >= nwg) return false;
        int wgid = (int)L; { const int q = nwg / NXCD, r = nwg % NXCD, xcd = wgid % NXCD, off = wgid / NXCD; wgid = (xcd < r ? xcd * (q + 1) : r * (q + 1) + (xcd - r) * q) + off; }
        const int nig = WGM * nN, gid = wgid / nig, fm = gid * WGM, gsz = (nM - fm) < WGM ? (nM - fm) : WGM;
        u.pm = fm + ((wgid % nig) % gsz); u.pn = (wgid % nig) / gsz; return true;
    }
    DEVI void a_ready(const Unit&) const {}
    DEVI void done(const Unit&) const {}
};
struct InGateOrder {
    int G, c, lo, hi;
    static DEVI void so_map(int wgid, int nM, int nN, Unit& u) {
        const int nwg = nM * nN;
        { const int q = nwg / NXCD, r = nwg % NXCD, xcd = wgid % NXCD, off = wgid / NXCD; wgid = (xcd < r ? xcd * (q + 1) : r * (q + 1) + (xcd - r) * q) + off; }
        const int nig = WGM * nN, gid = wgid / nig, fm = gid * WGM, gsz = (nM - fm) < WGM ? (nM - fm) : WGM;
        u.pm = fm + ((wgid % nig) % gsz); u.pn = (wgid % nig) / gsz;
    }
    DEVI bool next(int i, Unit& u) const {
        const long L = (long)i * G + c + lo; if (L >= hi) return false;
        if (L < 528) so_map((int)L, 48, 11, u); else { so_map((int)L - 528, 48, 12, u); u.pn += 11; }
        return true;
    }
    DEVI void a_ready(const Unit&) const {}
    DEVI void done(const Unit&) const {}
};
template <class Epi, class Sched, bool ALIGN_EPI = false, bool SP2 = false>
DEVI void gemm_phase(PG8_LAS unsigned char* lds, const Gemm g, const Sched& S, const Epi& E, const int tid) {
    const int wid = __builtin_amdgcn_readfirstlane(tid >> 6), lane = tid & 63, wr = wid >> 2, wc = wid & 3, fr = lane & 15, fq = lane >> 4;
    const int K = g.K, nt = K / BK;
    unsigned voffA[2], voffB[2];
#pragma unroll
    for (int i = 0; i < 2; ++i) { int R, C; stage_rc(tid * 16 + i * 8192, R, C); const int Rb = Epi::PERM ? ((R & ~31) + perm32(R & 31)) : R;
        voffA[i] = (unsigned)(R * K + C) * 2u; voffB[i] = (unsigned)(Rb * K + C) * 2u; }
    const size_t kstep = (size_t)(BK * 2);
    const size_t hstep = (size_t)HALF * K * 2;
    const size_t tstep = 2 * hstep;
    const unsigned ldsw = (unsigned)wid * 1024u;
    const int aoff = lds_byte(wr * 64 + fr, fq * 8), boff = lds_byte(wc * 32 + fr, fq * 8);
#define PG8_SA(b, h) (((b) * 2 + (h)) * HTB)
#define PG8_SB(b, h) ((4 + (b) * 2 + (h)) * HTB)
#define PG8_STAGE(bufoff, gbase, voff) do { _Pragma("unroll") for (int _i = 0; _i < 2; ++_i) \
        __builtin_amdgcn_global_load_lds((const unsigned*)((const char*)(gbase) + (voff)[_i]), (PG8_LAS unsigned*)(lds + (bufoff) + ldsw + _i * 8192), 16, 0, 0); } while (0)
#define PG8_LDA(dst, b, h) do { _Pragma("unroll") for (int m = 0; m < 4; ++m) _Pragma("unroll") for (int k = 0; k < 2; ++k) dst[m][k] = *(const PG8_LAS bf16x8*)(lds + PG8_SA(b, h) + aoff + m * 2048 + k * 1024); } while (0)
#define PG8_LDB(dst, b, h) do { _Pragma("unroll") for (int n = 0; n < 2; ++n) _Pragma("unroll") for (int k = 0; k < 2; ++k) dst[n][k] = *(const PG8_LAS bf16x8*)(lds + PG8_SB(b, h) + boff + n * 2048 + k * 1024); } while (0)
#define PG8_MMA(ai, bj, At, Bt) do { __builtin_amdgcn_s_setprio(1); _Pragma("unroll") for (int m = 0; m < 4; ++m) _Pragma("unroll") for (int n = 0; n < 2; ++n) _Pragma("unroll") for (int k = 0; k < 2; ++k) \
        acc[ai][bj][m][n] = __builtin_amdgcn_mfma_f32_16x16x32_bf16(Bt[n][k], At[m][k], acc[ai][bj][m][n], 0, 0, 0); __builtin_amdgcn_s_setprio(0); } while (0)
#define PG8_WAIT_V(n) asm volatile("s_waitcnt vmcnt(" #n ")" ::: "memory")
#define PG8_WAIT_L(n) asm volatile("s_waitcnt lgkmcnt(" #n ")" ::: "memory")
#define PG8_BAR __builtin_amdgcn_s_barrier()
#define PG8_SCHED __builtin_amdgcn_sched_barrier(0)
    Unit cur, nxt; int ui = 0;
    if (!S.next(0, cur)) return;
    f32x4 acc[2][2][4][2];
#pragma unroll
    for (int a = 0; a < 2; ++a)
#pragma unroll
        for (int b = 0; b < 2; ++b)
#pragma unroll
            for (int m = 0; m < 4; ++m)
#pragma unroll
                for (int n = 0; n < 2; ++n) acc[a][b][m][n] = (f32x4){0.f, 0.f, 0.f, 0.f};
    bf16x8 At[4][2], B0[2][2], B1[2][2];
    const char* cA = (const char*)g.A + (size_t)cur.pm * tstep; const char* cB = (const char*)g.Bt + (size_t)cur.pn * tstep;
    S.a_ready(cur);
    if constexpr (SP2) {
        PG8_STAGE(PG8_SB(0, 0), cB, voffB); PG8_STAGE(PG8_SB(0, 1), cB + hstep, voffB); PG8_STAGE(PG8_SA(0, 0), cA, voffA); PG8_STAGE(PG8_SA(0, 1), cA + hstep, voffA);
        if (wr == 1) PG8_BAR;
        PG8_WAIT_V(2); PG8_BAR;
        PG8_STAGE(PG8_SB(1, 0), cB + kstep, voffB); PG8_STAGE(PG8_SA(1, 0), cA + kstep, voffA); PG8_STAGE(PG8_SB(1, 1), cB + hstep + kstep, voffB);
        PG8_WAIT_V(6); PG8_BAR;
    } else {
        PG8_STAGE(PG8_SB(0, 0), cB, voffB); PG8_STAGE(PG8_SA(0, 0), cA, voffA); PG8_STAGE(PG8_SB(0, 1), cB + hstep, voffB); PG8_STAGE(PG8_SA(0, 1), cA + hstep, voffA);
        if (wr == 1) PG8_BAR;
        PG8_WAIT_V(4); PG8_BAR;
        PG8_STAGE(PG8_SB(1, 0), cB + kstep, voffB); PG8_STAGE(PG8_SA(1, 0), cA + kstep, voffA); PG8_STAGE(PG8_SB(1, 1), cB + hstep + kstep, voffB);
        PG8_WAIT_V(6); PG8_BAR;
    }
    for (;;) {
        const bool has_next = S.next(ui + 1, nxt);
        const char* nA = has_next ? (const char*)g.A + (size_t)nxt.pm * tstep : cA; const char* nB = has_next ? (const char*)g.Bt + (size_t)nxt.pn * tstep : cB;
        for (int t = 0; t < nt; t += 2) {
            const bool last = (t == nt - 2);
            const char* a1 = cA + (size_t)(t + 1) * kstep;
            const char* a2 = last ? nA : cA + (size_t)(t + 2) * kstep; const char* b2 = last ? nB : cB + (size_t)(t + 2) * kstep;
            const char* a3 = a2 + kstep; const char* b3 = b2 + kstep;
            if (last && has_next) S.a_ready(nxt);
            if constexpr (SP2) {
            PG8_LDB(B0, 0, 0); PG8_LDB(B1, 0, 1); PG8_SCHED; PG8_LDA(At, 0, 0); PG8_STAGE(PG8_SA(1, 1), a1 + hstep, voffA);
            PG8_WAIT_V(8); PG8_WAIT_L(0); PG8_BAR; PG8_MMA(0, 0, At, B0); PG8_MMA(0, 1, At, B1); PG8_BAR; PG8_SCHED;
            PG8_LDA(At, 0, 1); PG8_STAGE(PG8_SB(0, 0), b2, voffB); PG8_STAGE(PG8_SB(0, 1), b2 + hstep, voffB); PG8_STAGE(PG8_SA(0, 0), a2, voffA);
            PG8_WAIT_V(8); PG8_WAIT_L(0); PG8_BAR; PG8_MMA(1, 0, At, B0); PG8_MMA(1, 1, At, B1); PG8_BAR; PG8_SCHED;
            PG8_LDB(B0, 1, 0); PG8_LDB(B1, 1, 1); PG8_SCHED; PG8_LDA(At, 1, 0); PG8_STAGE(PG8_SA(0, 1), a2 + hstep, voffA);
            PG8_WAIT_V(8); PG8_WAIT_L(0); PG8_BAR; PG8_MMA(0, 0, At, B0); PG8_MMA(0, 1, At, B1); PG8_BAR; PG8_SCHED;
            PG8_LDA(At, 1, 1); PG8_STAGE(PG8_SB(1, 0), b3, voffB); PG8_STAGE(PG8_SB(1, 1), b3 + hstep, voffB); PG8_STAGE(PG8_SA(1, 0), a3, voffA);
            PG8_WAIT_V(8); PG8_WAIT_L(0); PG8_BAR; PG8_MMA(1, 0, At, B0); PG8_MMA(1, 1, At, B1); PG8_BAR; PG8_SCHED;
            } else {
            PG8_LDB(B0, 0, 0); PG8_SCHED; PG8_LDA(At, 0, 0); PG8_STAGE(PG8_SA(1, 1), a1 + hstep, voffA);
            PG8_WAIT_L(8); PG8_BAR; PG8_WAIT_L(0); PG8_MMA(0, 0, At, B0); PG8_BAR; PG8_SCHED;
            PG8_LDB(B1, 0, 1); PG8_STAGE(PG8_SB(0, 0), b2, voffB);
            PG8_BAR; PG8_WAIT_L(0); PG8_MMA(0, 1, At, B1); PG8_BAR;
            PG8_LDA(At, 0, 1); PG8_STAGE(PG8_SA(0, 0), a2, voffA);
            PG8_BAR; PG8_WAIT_L(0); PG8_MMA(1, 0, At, B0); PG8_BAR; PG8_SCHED;
            PG8_STAGE(PG8_SB(0, 1), b2 + hstep, voffB);
            PG8_WAIT_V(6); PG8_BAR; PG8_MMA(1, 1, At, B1); PG8_BAR;
            PG8_LDB(B0, 1, 0); PG8_SCHED; PG8_LDA(At, 1, 0); PG8_STAGE(PG8_SA(0, 1), a2 + hstep, voffA);
            PG8_WAIT_L(8); PG8_BAR; PG8_WAIT_L(0); PG8_MMA(0, 0, At, B0); PG8_BAR; PG8_SCHED;
            PG8_LDB(B1, 1, 1); PG8_STAGE(PG8_SB(1, 0), b3, voffB);
            PG8_BAR; PG8_WAIT_L(0); PG8_MMA(0, 1, At, B1); PG8_BAR;
            PG8_LDA(At, 1, 1); PG8_STAGE(PG8_SA(1, 0), a3, voffA);
            PG8_BAR; PG8_WAIT_L(0); PG8_MMA(1, 0, At, B0); PG8_BAR; PG8_SCHED;
            PG8_STAGE(PG8_SB(1, 1), b3 + hstep, voffB);
            PG8_WAIT_V(6); PG8_BAR; PG8_MMA(1, 1, At, B1); PG8_BAR;
            }
        }
        if constexpr (ALIGN_EPI) { if (wr == 0) PG8_BAR; }
        E(acc, cur, wr, wc, fr, fq); S.done(cur);
        if (!has_next) break;
#pragma unroll
        for (int a = 0; a < 2; ++a)
#pragma unroll
            for (int b = 0; b < 2; ++b)
#pragma unroll
                for (int m = 0; m < 4; ++m)
#pragma unroll
                    for (int n = 0; n < 2; ++n) acc[a][b][m][n] = (f32x4){0.f, 0.f, 0.f, 0.f};
        cur = nxt; cA = nA; cB = nB; ++ui;
        if constexpr (ALIGN_EPI) { if (wr == 1) PG8_BAR; }
    }
    PG8_WAIT_V(0);
    if constexpr (!ALIGN_EPI) { if (wr == 0) PG8_BAR; }
    PG8_BAR;
#undef PG8_SA
#undef PG8_SB
#undef PG8_STAGE
#undef PG8_LDA
#undef PG8_LDB
#undef PG8_MMA
#undef PG8_WAIT_V
#undef PG8_WAIT_L
#undef PG8_BAR
#undef PG8_SCHED
}

struct EpiSwiGLU {
    static constexpr bool PERM = false;
    bf16_t* ACT;
    DEVI void operator()(const f32x4 (&acc)[2][2][4][2], const Unit& u, int wr, int wc, int fr, int fq) const {
#pragma unroll
        for (int ai = 0; ai < 2; ++ai)
#pragma unroll
            for (int m = 0; m < 4; ++m) {
                const int row = u.pm * BM + ai * HALF + wr * 64 + m * 16 + fr;
                bf16_t* rp = ACT + (size_t)row * DFF + 16 * (8 * u.pn + wc) + 4 * fq;
#pragma unroll
                for (int bj = 0; bj < 2; ++bj) {
                    const f32x4 a = acc[ai][bj][m][0], b = acc[ai][bj][m][1];
                    u32x2 pk;
                    pk.x = pk2(a[0] * sigmoidf_(a[0]) * b[0], a[1] * sigmoidf_(a[1]) * b[1]);
                    pk.y = pk2(a[2] * sigmoidf_(a[2]) * b[2], a[3] * sigmoidf_(a[3]) * b[3]);
                    *(u32x2*)(rp + 64 * bj) = pk;
                }
            }
    }
};
struct EpiResid {
    static constexpr bool PERM = false;
    float* X; const float* gate_base; float coef;
    DEVI void operator()(const f32x4 (&acc)[2][2][4][2], const Unit& u, int wr, int wc, int fr_, int fq_) const {
        int fr = fr_, fq = fq_; asm volatile("" : "+v"(fr), "+v"(fq));
        const float* gate = gate_base + (size_t)mod_group(u.pm * BM) * 9216;
        const int col0 = u.pn * BM + wc * 32 + 4 * fq;
        f32x4 gv[2][2];
#pragma unroll
        for (int bj = 0; bj < 2; ++bj)
#pragma unroll
            for (int n = 0; n < 2; ++n) gv[bj][n] = *(const f32x4*)(gate + col0 + bj * HALF + 16 * n) * coef;
#pragma unroll
        for (int ah = 0; ah < 4; ++ah) {
            const int ai = ah >> 1, mb = (ah & 1) * 2;
            f32x4 xv[4][2][2];
#pragma unroll
            for (int m = mb; m < mb + 2; ++m)
#pragma unroll
                for (int bj = 0; bj < 2; ++bj)
#pragma unroll
                    for (int n = 0; n < 2; ++n)
                        xv[m][bj][n] = *(const f32x4*)(X + (size_t)(u.pm * BM + ai * HALF + wr * 64 + m * 16 + fr) * D + col0 + bj * HALF + 16 * n);
            __builtin_amdgcn_sched_barrier(0);
#pragma unroll
            for (int m = mb; m < mb + 2; ++m)
#pragma unroll
                for (int bj = 0; bj < 2; ++bj)
#pragma unroll
                    for (int n = 0; n < 2; ++n)
                        *(f32x4*)(X + (size_t)(u.pm * BM + ai * HALF + wr * 64 + m * 16 + fr) * D + col0 + bj * HALF + 16 * n) =
                            xv[m][bj][n] * ALPHA_F + gv[bj][n] * acc[ai][bj][m][n];
            __builtin_amdgcn_sched_barrier(0);
        }
    }
};
struct EpiIn {
    static constexpr bool PERM = true;
    unsigned char* ws; float* out; const float* b_gate; int l;
    static DEVI u32x4 pack8(const f32x4& a, const f32x4& b, float s) {
        u32x4 w; w.x = pk2(a[0] * s, a[1] * s); w.y = pk2(a[2] * s, a[3] * s); w.z = pk2(b[0] * s, b[1] * s); w.w = pk2(b[2] * s, b[3] * s); return w;
    }
    DEVI void operator()(const f32x4 (&acc)[2][2][4][2], const Unit& u, int wr, int wc, int fr_, int fq_) const {
        int fr = fr_, fq = fq_; asm volatile("" : "+v"(fr), "+v"(fq));
        unsigned char* ws = this->ws; float* out = this->out; const float* b_gate = this->b_gate;
        asm volatile("" : "+s"(ws), "+s"(out), "+s"(b_gate));
        const bool ctx = u.pm * BM < NCTX;
#pragma unroll
        for (int bj = 0; bj < 2; ++bj) {
            const int n0 = u.pn * BM + bj * HALF;
            const int c8 = n0 + wc * 32 + 8 * fq;
            f32x4 bg0 = (f32x4){0.f, 0.f, 0.f, 0.f}, bg1 = bg0;
            if (n0 >= 2816) { bg0 = *(const f32x4*)(b_gate + l * 3072 + c8 - 2816); bg1 = *(const f32x4*)(b_gate + l * 3072 + c8 - 2816 + 4); }
#pragma unroll
            for (int ai = 0; ai < 2; ++ai)
#pragma unroll
                for (int m = 0; m < 4; ++m) {
                    const int row = u.pm * BM + ai * HALF + wr * 64 + m * 16 + fr;
                    const f32x4 v0 = acc[ai][bj][m][0], v1 = acc[ai][bj][m][1];
                    if (n0 < 512) {
                        *(u32x4*)((bf16_t*)(ws + WS_UF) + (size_t)row * 512 + c8) = pack8(v0, v1, 1.f);
                    } else if (n0 < 896) {
                        *(u32x4*)((bf16_t*)(ws + WS_UQ) + (size_t)row * 384 + (c8 - 512)) = pack8(v0, v1, 1.f);
                    } else if (n0 < 1152) {
                        float* o = (float*)(ws + WS_UKV) + (size_t)row * 256 + (c8 - 896);
                        *(f32x4*)o = v0; *(f32x4*)(o + 4) = v1;
                    } else if (n0 < 1280) {
                        if (wc == 0) { float* o = (float*)(ws + WS_KRF) + (size_t)row * 32 + 8 * fq; *(f32x4*)o = v0; *(f32x4*)(o + 4) = v1; }
                    } else if (n0 < 1792) {
                        *(u32x4*)((bf16_t*)(ws + WS_NAQ) + (size_t)row * 512 + (c8 - 1280)) = pack8(v0, v1, NA_QS);
                    } else if (n0 < 2304) {
                        const int cc = c8 - 1792;
                        *(u32x4*)((bf16_t*)(ws + WS_NAK) + (size_t)row * 512 + cc) = pack8(v0, v1, 1.f);
                        if (ctx) { float* o = out + OUT_NAK + ((size_t)((row >> 8) * 4 + l) * 256 + (row & 255)) * 512 + cc; *(f32x4*)o = v0; *(f32x4*)(o + 4) = v1; }
                    } else if (n0 < 2816) {
                        const int cc = c8 - 2304, h = cc >> 6, d0 = cc & 63;
                        bf16_t* VT = (bf16_t*)(ws + WS_NAVT);
                        bf16_t* vp;
                        size_t cstride;
                        if (ctx) {
                            const int b = row >> 8, s = row & 255;
                            float* o = out + OUT_NAV + ((size_t)(b * 4 + l) * 256 + s) * 512 + cc; *(f32x4*)o = v0; *(f32x4*)(o + 4) = v1;
                            vp = VT + ((size_t)((b * 8 + h) * 64 + d0)) * 256 + s; cstride = 256;
                        } else {
                            const int rr = row - NCTX, b = rr >> 11, n = rr & 2047;
                            vp = VT + (size_t)4194304 + ((size_t)((b * 8 + h) * 64 + d0)) * 2048 + n; cstride = 2048;
                        }
#pragma unroll
                        for (int e = 0; e < 4; ++e) { vp[(size_t)e * cstride] = f2bf(v0[e]); vp[(size_t)(4 + e) * cstride] = f2bf(v1[e]); }
                    } else {
                        f32x4 g0, g1;
#pragma unroll
                        for (int e = 0; e < 4; ++e) { g0[e] = sigmoidf_(v0[e] + bg0[e]); g1[e] = sigmoidf_(v1[e] + bg1[e]); }
                        *(u32x4*)((bf16_t*)(ws + WS_GATE) + (size_t)row * 3072 + (c8 - 2816)) = pack8(g0, g1, 1.f);
                    }
                    __builtin_amdgcn_sched_barrier(0);
                }
        }
    }
};
struct EpiMerge {
    static constexpr bool PERM = true;
    const bf16_t* GATE; bf16_t* T; bf16_t* MG; int s;
    DEVI void operator()(const f32x4 (&acc)[2][2][4][2], const Unit& u, int wr, int wc, int fr_, int fq_) const {
        int fr = fr_, fq = fq_; asm volatile("" : "+v"(fr), "+v"(fq));
#pragma unroll
        for (int ah = 0; ah < 4; ++ah) {
            const int ai = ah >> 1, mb = (ah & 1) * 2;
            u32x4 gv[4][2], tv[4][2];
#pragma unroll
            for (int m = mb; m < mb + 2; ++m)
#pragma unroll
                for (int bj = 0; bj < 2; ++bj) {
                    const int row = u.pm * BM + ai * HALF + wr * 64 + m * 16 + fr;
                    const int c8 = u.pn * BM + bj * HALF + wc * 32 + 8 * fq;
                    gv[m][bj] = *(const u32x4*)(GATE + (size_t)row * 3072 + s * 1024 + c8);
                    if (s > 0) tv[m][bj] = *(const u32x4*)(T + (size_t)row * D + c8);
                }
            __builtin_amdgcn_sched_barrier(0);
#pragma unroll
            for (int m = mb; m < mb + 2; ++m)
#pragma unroll
                for (int bj = 0; bj < 2; ++bj) {
                    const int row = u.pm * BM + ai * HALF + wr * 64 + m * 16 + fr;
                    const int c8 = u.pn * BM + bj * HALF + wc * 32 + 8 * fq;
                    const u32x4 g = gv[m][bj];
                    f32x4 v0 = acc[ai][bj][m][0], v1 = acc[ai][bj][m][1];
                    v0[0] *= bf2f(g.x & 0xffffu); v0[1] *= bf2f(g.x >> 16); v0[2] *= bf2f(g.y & 0xffffu); v0[3] *= bf2f(g.y >> 16);
                    v1[0] *= bf2f(g.z & 0xffffu); v1[1] *= bf2f(g.z >> 16); v1[2] *= bf2f(g.w & 0xffffu); v1[3] *= bf2f(g.w >> 16);
                    if (s > 0) {
                        const u32x4 t = tv[m][bj];
                        v0[0] += bf2f(t.x & 0xffffu); v0[1] += bf2f(t.x >> 16); v0[2] += bf2f(t.y & 0xffffu); v0[3] += bf2f(t.y >> 16);
                        v1[0] += bf2f(t.z & 0xffffu); v1[1] += bf2f(t.z >> 16); v1[2] += bf2f(t.w & 0xffffu); v1[3] += bf2f(t.w >> 16);
                    }
                    *(u32x4*)((s < 2 ? T : MG) + (size_t)row * D + c8) = EpiIn::pack8(v0, v1, 1.f);
                }
            __builtin_amdgcn_sched_barrier(0);
        }
    }
};
}

DEVI void job_ffn_up(const P& p, unsigned char* ws_b, int l, int which, int t, bf16_t* sm, int tid) {
    const int nN = 44; const int m0 = (t / nN) * 128, n0 = (t % nN) * 128;
    const bf16_t* H = (const bf16_t*)(ws_b + WS_H);
    const bf16_t* W = (const bf16_t*)(ws_b + WS_W) + (size_t)l * LAYER_W + (which ? OFF_W13_2 : OFF_W13_1);
    bf16_t* ACT = (bf16_t*)(ws_b + WS_ACT);
    f32x16 acc[2][2]; zero_acc(acc);
    gemm_core(H + (size_t)m0 * D, D, W + (size_t)n0 * D, D, D, acc, sm, tid);
    EPI_SETUP
    const int oc = (n0 >> 1) + wc * 32 + c32;
#pragma unroll
    for (int i = 0; i < 2; ++i) {
        const int rb = m0 + wr * 64 + i * 32 + 4 * hl;
#pragma unroll
        for (int r = 0; r < 16; ++r) {
            const int row = rb + (r & 3) + 8 * (r >> 2);
            const float a = acc[i][0][r], b = acc[i][1][r];
            const float v = a * sigmoidf_(a) * b;
            ACT[(size_t)row * DFF + oc] = f2bf(v);
        }
    }
}

DEVI void job_resid(const P& p, unsigned char* ws_b, const bf16_t* A, int lda, const bf16_t* Bt, int K, const float* gate_base, float coef, int t, bf16_t* sm, int tid) {
    const int nN = 8; const int m0 = (t / nN) * 128, n0 = (t % nN) * 128;
    float* X = (float*)(ws_b + WS_X);
    f32x16 acc[2][2]; zero_acc(acc);
    gemm_core(A + (size_t)m0 * lda, lda, Bt + (size_t)n0 * K, K, K, acc, sm, tid);
    EPI_SETUP
    const float* gate = gate_base + (size_t)mod_group(m0) * 9216;
#pragma unroll
    for (int j = 0; j < 2; ++j) {
        const int col = n0 + wc * 64 + j * 32 + c32;
        const float gv = coef * gate[col];
#pragma unroll
        for (int i = 0; i < 2; ++i) {
            const int rb = m0 + wr * 64 + i * 32 + 4 * hl;
#pragma unroll
            for (int r = 0; r < 16; ++r) {
                const int row = rb + (r & 3) + 8 * (r >> 2);
                float* xp = X + (size_t)row * D + col;
                *xp = ALPHA_F * (*xp) + gv * acc[i][j][r];
            }
        }
    }
}

DEVI void job_in(const P& p, unsigned char* ws_b, int l, int t, bf16_t* sm, int tid) {
    const int nN = 46; const int m0 = (t / nN) * 128, n0 = (t % nN) * 128;
    const bf16_t* H = (const bf16_t*)(ws_b + WS_H);
    const bf16_t* W = (const bf16_t*)(ws_b + WS_W) + (size_t)l * LAYER_W + OFF_WIN;
    f32x16 acc[2][2]; zero_acc(acc);
    gemm_core(H + (size_t)m0 * D, D, W + (size_t)n0 * D, D, D, acc, sm, tid);
    EPI_SETUP
    const bool ctx = m0 < NCTX;
#pragma unroll
    for (int j = 0; j < 2; ++j) {
        const int col = n0 + wc * 64 + j * 32 + c32;
#pragma unroll
        for (int i = 0; i < 2; ++i) {
            const int rb = m0 + wr * 64 + i * 32 + 4 * hl;
            if (n0 < 512) {
                bf16_t* O = (bf16_t*)(ws_b + WS_UF);
#pragma unroll
                for (int r = 0; r < 16; ++r) O[(size_t)(rb + (r & 3) + 8 * (r >> 2)) * 512 + col] = f2bf(acc[i][j][r]);
            } else if (n0 < 896) {
                bf16_t* O = (bf16_t*)(ws_b + WS_UQ);
#pragma unroll
                for (int r = 0; r < 16; ++r) O[(size_t)(rb + (r & 3) + 8 * (r >> 2)) * 384 + (col - 512)] = f2bf(acc[i][j][r]);
            } else if (n0 < 1152) {
                float* O = (float*)(ws_b + WS_UKV);
#pragma unroll
                for (int r = 0; r < 16; ++r) O[(size_t)(rb + (r & 3) + 8 * (r >> 2)) * 256 + (col - 896)] = acc[i][j][r];
            } else if (n0 < 1280) {
                if (col < 1184) {
                    float* O = (float*)(ws_b + WS_KRF);
#pragma unroll
                    for (int r = 0; r < 16; ++r) O[(size_t)(rb + (r & 3) + 8 * (r >> 2)) * 32 + (col - 1152)] = acc[i][j][r];
                }
            } else if (n0 < 1792) {
                bf16_t* O = (bf16_t*)(ws_b + WS_NAQ);
#pragma unroll
                for (int r = 0; r < 16; ++r) O[(size_t)(rb + (r & 3) + 8 * (r >> 2)) * 512 + (col - 1280)] = f2bf(acc[i][j][r] * NA_QS);
            } else if (n0 < 2304) {
                bf16_t* O = (bf16_t*)(ws_b + WS_NAK);
                const int cc = col - 1792;
#pragma unroll
                for (int r = 0; r < 16; ++r) {
                    const int row = rb + (r & 3) + 8 * (r >> 2);
                    O[(size_t)row * 512 + cc] = f2bf(acc[i][j][r]);
                    if (ctx) p.out[OUT_NAK + ((size_t)((row >> 8) * 4 + l) * 256 + (row & 255)) * 512 + cc] = acc[i][j][r];
                }
            } else if (n0 < 2816) {
                bf16_t* VT = (bf16_t*)(ws_b + WS_NAVT);
                const int cc = col - 2304, h = cc >> 6, d = cc & 63;
#pragma unroll
                for (int qd = 0; qd < 4; ++qd) {
                    const int row = rb + 8 * qd;
                    u32x2 pk; pk.x = pk2(acc[i][j][4 * qd], acc[i][j][4 * qd + 1]); pk.y = pk2(acc[i][j][4 * qd + 2], acc[i][j][4 * qd + 3]);
                    if (ctx) {
                        const int b = row >> 8, s = row & 255;
                        *(u32x2*)(VT + ((size_t)((b * 8 + h) * 64 + d)) * 256 + s) = pk;
#pragma unroll
                        for (int e = 0; e < 4; ++e)
                            p.out[OUT_NAV + ((size_t)(b * 4 + l) * 256 + (s + e)) * 512 + cc] = acc[i][j][4 * qd + e];
                    } else {
                        const int rr = row - NCTX, b = rr >> 11, n = rr & 2047;
                        *(u32x2*)(VT + (size_t)4194304 + ((size_t)((b * 8 + h) * 64 + d)) * 2048 + n) = pk;
                    }
                }
            } else {
                bf16_t* O = (bf16_t*)(ws_b + WS_GATE);
                const int gc = col - 2816;
                const float bg = pin(p, 26)[l * 3072 + gc];
                bf16_t* gp = O + (size_t)gc * M + rb;
#pragma unroll
                for (int qd = 0; qd < 4; ++qd) {
                    u32x2 pk;
                    pk.x = pk2(sigmoidf_(acc[i][j][4 * qd] + bg), sigmoidf_(acc[i][j][4 * qd + 1] + bg));
                    pk.y = pk2(sigmoidf_(acc[i][j][4 * qd + 2] + bg), sigmoidf_(acc[i][j][4 * qd + 3] + bg));
                    *(u32x2*)(gp + 8 * qd) = pk;
                }
            }
        }
    }
}

DEVI void job_uq(const P& p, unsigned char* ws_b, int l, int t, bf16_t* sm, int tid) {
    const int nN = 6; const int m0 = (t / nN) * 128, n0 = (t % nN) * 128;
    const bf16_t* A = (const bf16_t*)(ws_b + WS_UQ);
    const bf16_t* W = (const bf16_t*)(ws_b + WS_W) + (size_t)l * LAYER_W + OFF_WUQ;
    bf16_t* Q = (bf16_t*)(ws_b + WS_Q);
    const float* ropec = (const float*)(ws_b + WS_ROPE);
    const float* ropes = ropec + 512;
    f32x16 acc[2][2]; zero_acc(acc);
    gemm_core(A + (size_t)m0 * 384, 384, W + (size_t)n0 * 384, 384, 384, acc, sm, tid);
    EPI_SETUP
    const bool lat = m0 >= NCTX;
#pragma unroll
    for (int j = 0; j < 2; ++j) {
        const int c0 = n0 + wc * 64 + j * 32;
        const int col = c0 + c32;
        const bool rope = lat && (((c0 >> 5) % 3) == 2);
        const int axis = c32 >> 4, ii = c32 & 15;
#pragma unroll
        for (int i = 0; i < 2; ++i) {
            const int rb = m0 + wr * 64 + i * 32 + 4 * hl;
#pragma unroll
            for (int r = 0; r < 16; ++r) {
                const int row = rb + (r & 3) + 8 * (r >> 2);
                float v = acc[i][j][r];
                const float pr = __shfl_xor(v, 8);
                if (rope) {
                    const int n = (row - NCTX) & 2047;
                    const int pos = axis ? (n & 63) : (n >> 6);
                    const float cs = ropec[pos * 8 + (ii & 7)], sn = ropes[pos * 8 + (ii & 7)];
                    const float rot = (ii < 8) ? -pr : pr;
                    v = v * cs + rot * sn;
                }
                Q[(size_t)row * 768 + col] = f2bf(v * MLA_QS);
            }
        }
    }
}

DEVI void job_ukv(const P& p, unsigned char* ws_b, int l, int t, bf16_t* sm, int tid) {
    const int nN = 8; const int m0 = (t / nN) * 128, h = t % nN, n0 = h * 128;
    const bf16_t* A = (m0 < M) ? (const bf16_t*)(ws_b + WS_CKV) + (size_t)m0 * 256
                               : (const bf16_t*)(ws_b + WS_CCKV) + ((size_t)l * 1024 + (m0 - M)) * 256;
    const bf16_t* W = (const bf16_t*)(ws_b + WS_W) + (size_t)l * LAYER_W + OFF_WUKV;
    bf16_t* KN = (bf16_t*)(ws_b + WS_KN);
    bf16_t* VT = (bf16_t*)(ws_b + WS_VTM);
    f32x16 acc[2][2]; zero_acc(acc);
    gemm_core(A, 256, W + (size_t)n0 * 256, 256, 256, acc, sm, tid);
    EPI_SETUP
#pragma unroll
    for (int j = 0; j < 2; ++j) {
        const int d = j * 32 + c32;
#pragma unroll
        for (int i = 0; i < 2; ++i) {
            const int rb = m0 + wr * 64 + i * 32 + 4 * hl;
            if (wc == 0) {
#pragma unroll
                for (int r = 0; r < 16; ++r) KN[(size_t)(rb + (r & 3) + 8 * (r >> 2)) * 512 + h * 64 + d] = f2bf(acc[i][j][r]);
            } else {
#pragma unroll
                for (int qd = 0; qd < 4; ++qd) {
                    const int row = rb + 8 * qd;
                    u32x2 pk; pk.x = pk2(acc[i][j][4 * qd], acc[i][j][4 * qd + 1]); pk.y = pk2(acc[i][j][4 * qd + 2], acc[i][j][4 * qd + 3]);
                    size_t addr;
                    if (m0 < NCTX) { const int b = row >> 8, s = row & 255; addr = ((size_t)((b * 8 + h) * 64 + d)) * 256 + s; }
                    else if (m0 < M) { const int rr = row - NCTX, b = rr >> 11, n = rr & 2047; addr = (size_t)4194304 + ((size_t)((b * 8 + h) * 64 + d)) * 2560 + n; }
                    else { const int rr = row - M, b = rr >> 9, n = rr & 511; addr = (size_t)4194304 + ((size_t)((b * 8 + h) * 64 + d)) * 2560 + 2048 + n; }
                    *(u32x2*)(VT + addr) = pk;
                }
            }
        }
    }
}

template <int ldo, bool SPLITK = false>
DEVI void job_store(const bf16_t* A, int lda, const bf16_t* Bt, int ldb, int K, bf16_t* Out, bf16_t* sm, int tid, int grp = 0, float* xch = nullptr) {
    f32x16 acc[2][2]; zero_acc(acc);
    if constexpr (SPLITK) { K >>= 1; A += grp * K; Bt += grp * K; }
    gemm_core(A, lda, Bt, ldb, K, acc, sm, tid);
    EPI_SETUP
    if constexpr (SPLITK) {
        if (grp == 1) {
#pragma unroll
            for (int i = 0; i < 2; ++i)
#pragma unroll
                for (int j = 0; j < 2; ++j)
#pragma unroll
                    for (int r = 0; r < 16; ++r) xch[((i * 2 + j) * 16 + r) * 256 + tid] = acc[i][j][r];
        }
        __syncthreads();
        if (grp == 0) {
#pragma unroll
            for (int i = 0; i < 2; ++i)
#pragma unroll
                for (int j = 0; j < 2; ++j)
#pragma unroll
                    for (int r = 0; r < 16; ++r) acc[i][j][r] += xch[((i * 2 + j) * 16 + r) * 256 + tid];
        }
        __syncthreads();
    }
    const bool active = !SPLITK || grp == 0;
    bf16_t* st = sm + (wr * 64 + 4 * hl) * 136 + wc * 64 + c32;
    if (active) {
#pragma unroll
        for (int i = 0; i < 2; ++i)
#pragma unroll
            for (int j = 0; j < 2; ++j)
#pragma unroll
                for (int r = 0; r < 16; ++r) st[(i * 32 + (r & 3) + 8 * (r >> 2)) * 136 + j * 32] = f2bf(acc[i][j][r]);
    }
    __syncthreads();
    if (active) {
        const int orow = tid >> 4, oc = (tid & 15) * 8;
#pragma unroll
        for (int k = 0; k < 8; ++k) {
            const u32x4 v = *(const u32x4*)(sm + (orow + 16 * k) * 136 + oc);
            *(u32x4*)(Out + (size_t)(orow + 16 * k) * ldo + oc) = v;
        }
    }
    __syncthreads();
}

DEVI void job_f1(const P& p, unsigned char* ws_b, int t, bf16_t* sm, int tid) {
    const bf16_t* WCS = (const bf16_t*)(ws_b + WS_WCS);
    const bf16_t* UF = (const bf16_t*)(ws_b + WS_UF);
    bf16_t* F1T = (bf16_t*)(ws_b + WS_F1T);
    if (t < 512) {
        const int bs = t >> 4, g = (t >> 2) & 3, mi = (t >> 1) & 1, ni = t & 1;
        job_store<256>(WCS + mi * 128 * 128, 128, UF + ((size_t)bs * 256 + ni * 128) * 512 + g * 128, 512, 128,
                  F1T + ((size_t)(bs * 4 + g) * 256 + mi * 128) * 256 + ni * 128, sm, tid);
    } else {
        t -= 512;
        const int bs = t >> 7, g = (t >> 5) & 3, mi = (t >> 4) & 1, ni = t & 15;
        job_store<2048>(WCS + mi * 128 * 128, 128, UF + ((size_t)NCTX + bs * 2048 + ni * 128) * 512 + g * 128, 512, 128,
                  F1T + (size_t)8388608 + ((size_t)(bs * 4 + g) * 256 + mi * 128) * 2048 + ni * 128, sm, tid);
    }
}
DEVI void job_f2_lat(const P& p, unsigned char* ws_b, int t, bf16_t* sm, int tid, int grp, float* xch) {
    const int bs = t >> 6, mi = (t >> 2) & 15, ni = t & 3;
    const bf16_t* TAB = (const bf16_t*)(ws_b + WS_TABL);
    const bf16_t* F1T = (const bf16_t*)(ws_b + WS_F1T) + (size_t)8388608;
    bf16_t* YF = (bf16_t*)(ws_b + WS_YF);
    job_store<512, true>(TAB + (size_t)mi * 128 * 4096, 4096, F1T + (size_t)bs * 512 * 4096 + (size_t)ni * 128 * 4096, 4096, 4096,
              YF + ((size_t)NCTX + bs * 2048 + mi * 128) * 512 + ni * 128, sm, tid, grp, xch);
}
DEVI void job_f2_ctx(const P& p, unsigned char* ws_b, int t, bf16_t* sm, int tid) {
    const int bs = t >> 3, mi = (t >> 2) & 1, ni = t & 3;
    const bf16_t* TAB = (const bf16_t*)(ws_b + WS_TABC);
    const bf16_t* F1T = (const bf16_t*)(ws_b + WS_F1T);
    bf16_t* YF = (bf16_t*)(ws_b + WS_YF);
    job_store<512>(TAB + (size_t)mi * 128 * 512, 512, F1T + (size_t)bs * 512 * 512 + (size_t)ni * 128 * 512, 512, 512,
              YF + ((size_t)bs * 256 + mi * 128) * 512 + ni * 128, sm, tid);
}

DEVI void job_merge(const P& p, unsigned char* ws_b, int l, int t, bf16_t* sm, int tid) {
    const int nN = 8; const int m0 = (t / nN) * 128, n0 = (t % nN) * 128;
    const bf16_t* Wl = (const bf16_t*)(ws_b + WS_W) + (size_t)l * LAYER_W;
    const bf16_t* GATE = (const bf16_t*)(ws_b + WS_GATE);
    bf16_t* MG = (bf16_t*)(ws_b + WS_MERGED);
    EPI_SETUP
    f32x16 acc[2][2]; zero_acc(acc);
#pragma unroll 1
    for (int s = 0; s < 3; ++s) {
        const bf16_t* A = (const bf16_t*)(ws_b + (s == 0 ? WS_YF : (s == 1 ? WS_YM : WS_YN)));
        const bf16_t* W = Wl + (s == 0 ? OFF_WBF : (s == 1 ? OFF_WBM : OFF_WBN));
        gemm_core<false>(A + (size_t)m0 * 512, 512, W + (size_t)n0 * 512, 512, 512, acc, sm, tid);
        {
            const int gr = tid >> 4, gc = (tid & 15) * 8;
            const int s1 = s < 2 ? s + 1 : s;
#pragma unroll
            for (int k = 0; k < 8; ++k) {
                const bf16_t* gsrc = GATE + (size_t)(m0 + gr + 16 * k) * 3072 + n0 + gc;
                *(u32x4*)(sm + (gr + 16 * k) * 136 + gc) = *(const u32x4*)(gsrc + s * 1024);
                *(u32x4*)(sm + 128 * 136 + (gr + 16 * k) * 136 + gc) = *(const u32x4*)(gsrc + s1 * 1024);
                if ((k & 1) == 1) __builtin_amdgcn_sched_barrier(0);
            }
        }
        __syncthreads();
#pragma unroll
        for (int j = 0; j < 2; ++j)
#pragma unroll
            for (int i = 0; i < 2; ++i) {
                const bf16_t* gp = sm + (wr * 64 + i * 32 + 4 * hl) * 136 + wc * 64 + j * 32 + c32;
#pragma unroll
                for (int r = 0; r < 16; ++r) {
                    const int o = ((r & 3) + 8 * (r >> 2)) * 136;
                    const float g = bf2f(gp[o]);
                    const float f = (s < 2) ? g * __builtin_amdgcn_rcpf(bf2f(gp[128 * 136 + o])) : g;
                    acc[i][j][r] *= f;
                }
            }
        __syncthreads();
    }
#pragma unroll
    for (int j = 0; j < 2; ++j) {
        const int col = n0 + wc * 64 + j * 32 + c32;
#pragma unroll
        for (int i = 0; i < 2; ++i) {
            const int rb = m0 + wr * 64 + i * 32 + 4 * hl;
#pragma unroll
            for (int r = 0; r < 16; ++r) MG[(size_t)(rb + (r & 3) + 8 * (r >> 2)) * 1024 + col] = f2bf(acc[i][j][r]);
        }
    }
}

struct TileSrc { const bf16_t* k; const bf16_t* k2; const bf16_t* v; const bf16_t* vhi; };
DEVI int pi_row(int r) { return (r & 0x13) | ((r & 4) << 1) | ((r & 8) >> 1); }

template <int NKS>
DEVI void attn_load(const TileSrc& s, bf16x8 (&kf)[NKS], bf16x8 (&vf)[4]) {
#pragma unroll
    for (int ks = 0; ks < NKS; ++ks) kf[ks] = (ks < 4) ? *(const bf16x8*)(s.k + ks * 16) : *(const bf16x8*)(s.k2 + (ks - 4) * 16);
    vf[0] = *(const bf16x8*)(s.v);
    vf[1] = *(const bf16x8*)(s.v + 16);
    vf[2] = *(const bf16x8*)(s.vhi);
    vf[3] = *(const bf16x8*)(s.vhi + 16);
}

template <int NKS, bool SPLIT, class Src, class Mask>
DEVI void attn_wave(const bf16_t* qptr, int t0, int nt, Src src, Mask mask, bf16_t* optr, int lane, float* ex = nullptr, int half = 0) {
    bf16x8 q[NKS];
#pragma unroll
    for (int ks = 0; ks < NKS; ++ks) q[ks] = *(const bf16x8*)(qptr + ks * 16);
    f32x16 o0, o1;
#pragma unroll
    for (int r = 0; r < 16; ++r) { o0[r] = 0.f; o1[r] = 0.f; }
    float m = -1e30f, lsum = 0.f;
    bf16x8 kf[NKS], vf[4];
    nt += t0;
    { TileSrc s0 = src(t0); attn_load<NKS>(s0, kf, vf); }
    for (int t = t0; t < nt; ++t) {
        bf16x8 kn[NKS], vn[4];
        { TileSrc s1 = src(t + 1 < nt ? t + 1 : t); attn_load<NKS>(s1, kn, vn); }
        f32x16 s;
#pragma unroll
        for (int r = 0; r < 16; ++r) s[r] = 0.f;
#pragma unroll
        for (int ks = 0; ks < NKS; ++ks) s = __builtin_amdgcn_mfma_f32_32x32x16_bf16(kf[ks], q[ks], s, 0, 0, 0);
        mask(t, s);
        float mx = s[0];
#pragma unroll
        for (int r = 1; r < 16; ++r) mx = fmaxf(mx, s[r]);
        mx = fmaxf(mx, __shfl_xor(mx, 32));
        const float mn = fmaxf(m, mx);
        const float alpha = fast_exp2(m - mn);
        m = mn;
        float rs = 0.f;
#pragma unroll
        for (int r = 0; r < 16; ++r) { s[r] = fast_exp2(s[r] - mn); rs += s[r]; }
        lsum = lsum * alpha + rs;
#pragma unroll
        for (int r = 0; r < 16; ++r) { o0[r] *= alpha; o1[r] *= alpha; }
        bf16x8 p0, p1;
        {
            u32x4 a, b;
            a.x = pk2(s[0], s[1]); a.y = pk2(s[2], s[3]); a.z = pk2(s[4], s[5]); a.w = pk2(s[6], s[7]);
            b.x = pk2(s[8], s[9]); b.y = pk2(s[10], s[11]); b.z = pk2(s[12], s[13]); b.w = pk2(s[14], s[15]);
            p0 = __builtin_bit_cast(bf16x8, a); p1 = __builtin_bit_cast(bf16x8, b);
        }
        o0 = __builtin_amdgcn_mfma_f32_32x32x16_bf16(vf[0], p0, o0, 0, 0, 0);
        o0 = __builtin_amdgcn_mfma_f32_32x32x16_bf16(vf[1], p1, o0, 0, 0, 0);
        o1 = __builtin_amdgcn_mfma_f32_32x32x16_bf16(vf[2], p0, o1, 0, 0, 0);
        o1 = __builtin_amdgcn_mfma_f32_32x32x16_bf16(vf[3], p1, o1, 0, 0, 0);
#pragma unroll
        for (int ks = 0; ks < NKS; ++ks) kf[ks] = kn[ks];
#pragma unroll
        for (int x = 0; x < 4; ++x) vf[x] = vn[x];
    }
    if constexpr (SPLIT) {
        if (half == 1) {
#pragma unroll
            for (int r = 0; r < 16; ++r) { ex[r * 64 + lane] = o0[r]; ex[(16 + r) * 64 + lane] = o1[r]; }
            ex[32 * 64 + lane] = m; ex[33 * 64 + lane] = lsum;
        }
        __syncthreads();
        if (half == 0) {
            const float m2 = ex[32 * 64 + lane], l2 = ex[33 * 64 + lane];
            const float mn = fmaxf(m, m2), a1 = fast_exp2(m - mn), a2 = fast_exp2(m2 - mn);
            lsum = lsum * a1 + l2 * a2;
#pragma unroll
            for (int r = 0; r < 16; ++r) { o0[r] = o0[r] * a1 + ex[r * 64 + lane] * a2; o1[r] = o1[r] * a1 + ex[(16 + r) * 64 + lane] * a2; }
        }
        __syncthreads();
        if (half == 1) return;
    }
    lsum += __shfl_xor(lsum, 32);
    const float inv = 1.f / lsum;
    const int hl = lane >> 5;
#pragma unroll
    for (int qd = 0; qd < 4; ++qd) {
        u32x2 a, b;
        a.x = pk2(o0[4 * qd] * inv, o0[4 * qd + 1] * inv); a.y = pk2(o0[4 * qd + 2] * inv, o0[4 * qd + 3] * inv);
        b.x = pk2(o1[4 * qd] * inv, o1[4 * qd + 1] * inv); b.y = pk2(o1[4 * qd + 2] * inv, o1[4 * qd + 3] * inv);
        *(u32x2*)(optr + 8 * qd + 4 * hl) = a;
        *(u32x2*)(optr + 32 + 8 * qd + 4 * hl) = b;
    }
}

struct NoMask { DEVI void operator()(int, f32x16&) const {} };

DEVI void attn_mla(const P& p, unsigned char* ws_b, int l, bool lat, int b, int h, int qg, int lane, float* ex = nullptr, int half = 0) {
    const int hl = lane >> 5, c32 = lane & 31, pr = pi_row(c32);
    const bf16_t* Q = (const bf16_t*)(ws_b + WS_Q);
    const bf16_t* KN = (const bf16_t*)(ws_b + WS_KN);
    const bf16_t* KR = (const bf16_t*)(ws_b + WS_KR);
    const bf16_t* CKR = (const bf16_t*)(ws_b + WS_CKR) + (size_t)l * 1024 * 32;
    const bf16_t* VT = (const bf16_t*)(ws_b + WS_VTM);
    bf16_t* YM = (bf16_t*)(ws_b + WS_YM);
    if (!lat) {
        const int row0 = b * 256;
        const int qrow = row0 + qg * 32 + c32;
        const bf16_t* k0 = KN + (size_t)(row0 + pr) * 512 + h * 64 + hl * 8;
        const bf16_t* r0 = KR + (size_t)(row0 + pr) * 32 + hl * 8;
        const bf16_t* v0 = VT + ((size_t)((b * 8 + h) * 64 + c32)) * 256 + hl * 8;
        auto src = [=](int t) { TileSrc s; s.k = k0 + (size_t)t * 32 * 512; s.k2 = r0 + (size_t)t * 32 * 32; s.v = v0 + t * 32; s.vhi = s.v + 32 * 256; return s; };
        attn_wave<6, false>(Q + (size_t)qrow * 768 + h * 96 + hl * 8, 0, 8, src, NoMask(), YM + (size_t)qrow * 512 + h * 64, lane);
    } else {
        const int row0 = NCTX + b * 2048;
        const int qrow = row0 + qg * 32 + c32;
        const bf16_t* k0 = KN + (size_t)(row0 + pr) * 512 + h * 64 + hl * 8;
        const bf16_t* r0 = KR + (size_t)(row0 + pr) * 32 + hl * 8;
        const bf16_t* k1 = KN + (size_t)(M + b * 512 + pr) * 512 + h * 64 + hl * 8;
        const bf16_t* r1 = CKR + (size_t)(b * 512 + pr) * 32 + hl * 8;
        const bf16_t* v0 = VT + (size_t)4194304 + ((size_t)((b * 8 + h) * 64 + c32)) * 2560 + hl * 8;
        auto src = [=](int t) {
            TileSrc s;
            if (t < 64) { s.k = k0 + (size_t)t * 32 * 512; s.k2 = r0 + (size_t)t * 32 * 32; }
            else { s.k = k1 + (size_t)(t - 64) * 32 * 512; s.k2 = r1 + (size_t)(t - 64) * 32 * 32; }
            s.v = v0 + t * 32; s.vhi = s.v + 32 * 2560; return s; };
        attn_wave<6, true>(Q + (size_t)qrow * 768 + h * 96 + hl * 8, half * 40, 40, src, NoMask(), YM + (size_t)qrow * 512 + h * 64, lane, ex, half);
    }
}

template <int NKS, class Mask>
DEVI void attn_step(const bf16x8 (&kf)[NKS], const bf16x8 (&vf)[4], const bf16x8 (&q)[NKS], f32x16& o0, f32x16& o1, float& m, float& lsum, const Mask& mask, int t) {
    f32x16 s;
#pragma unroll
    for (int r = 0; r < 16; ++r) s[r] = 0.f;
#pragma unroll
    for (int ks = 0; ks < NKS; ++ks) s = __builtin_amdgcn_mfma_f32_32x32x16_bf16(kf[ks], q[ks], s, 0, 0, 0);
    mask(t, s);
    float mx = s[0];
#pragma unroll
    for (int r = 1; r < 16; ++r) mx = fmaxf(mx, s[r]);
    mx = fmaxf(mx, __shfl_xor(mx, 32));
    const float mn = fmaxf(m, mx);
    const float alpha = fast_exp2(m - mn);
    m = mn;
    float rs = 0.f;
#pragma unroll
    for (int r = 0; r < 16; ++r) { s[r] = fast_exp2(s[r] - mn); rs += s[r]; }
    lsum = lsum * alpha + rs;
#pragma unroll
    for (int r = 0; r < 16; ++r) { o0[r] *= alpha; o1[r] *= alpha; }
    bf16x8 p0, p1;
    {
        u32x4 a, b;
        a.x = pk2(s[0], s[1]); a.y = pk2(s[2], s[3]); a.z = pk2(s[4], s[5]); a.w = pk2(s[6], s[7]);
        b.x = pk2(s[8], s[9]); b.y = pk2(s[10], s[11]); b.z = pk2(s[12], s[13]); b.w = pk2(s[14], s[15]);
        p0 = __builtin_bit_cast(bf16x8, a); p1 = __builtin_bit_cast(bf16x8, b);
    }
    o0 = __builtin_amdgcn_mfma_f32_32x32x16_bf16(vf[0], p0, o0, 0, 0, 0);
    o0 = __builtin_amdgcn_mfma_f32_32x32x16_bf16(vf[1], p1, o0, 0, 0, 0);
    o1 = __builtin_amdgcn_mfma_f32_32x32x16_bf16(vf[2], p0, o1, 0, 0, 0);
    o1 = __builtin_amdgcn_mfma_f32_32x32x16_bf16(vf[3], p1, o1, 0, 0, 0);
}
struct MlaStage { u32x4 k, v; u32x2 r; };
DEVI void attn_mla_lat_shared(const P& p, unsigned char* ws_b, int l, int b, int h, int qg, int tid, unsigned char* smem, float* ex) {
    const int lane = tid & 63, wave = tid >> 6, half = wave >> 2, htid = tid & 255;
    const int hl = lane >> 5, c32 = lane & 31, pr = pi_row(c32);
    const bf16_t* Q = (const bf16_t*)(ws_b + WS_Q);
    const bf16_t* KN = (const bf16_t*)(ws_b + WS_KN);
    const bf16_t* KR = (const bf16_t*)(ws_b + WS_KR);
    const bf16_t* CKR = (const bf16_t*)(ws_b + WS_CKR) + (size_t)l * 1024 * 32;
    const bf16_t* VT = (const bf16_t*)(ws_b + WS_VTM) + (size_t)4194304 + (size_t)((b * 8 + h) * 64) * 2560;
    bf16_t* YM = (bf16_t*)(ws_b + WS_YM);
    const int row0 = NCTX + b * 2048;
    const int qrow = row0 + qg * 32 + c32;
    bf16_t* ring = (bf16_t*)(smem + 36864 + half * 36864);
    const int kkey = htid >> 3, kch = (htid & 7) * 8, vd = htid >> 2, vch = (htid & 3) * 8;
    const int rch = (htid & 7) * 4;
    const int tb = half * 40, tend = tb + 40;
    bf16x8 q[6];
    {
        const bf16_t* qptr = Q + (size_t)qrow * 768 + h * 96 + hl * 8;
#pragma unroll
        for (int ks = 0; ks < 6; ++ks) q[ks] = *(const bf16x8*)(qptr + ks * 16);
    }
    f32x16 o0, o1;
#pragma unroll
    for (int r = 0; r < 16; ++r) { o0[r] = 0.f; o1[r] = 0.f; }
    float m = -1e30f, lsum = 0.f;
#define MLA_LD(S, T) do { const int t_ = (T) < tend ? (T) : tend - 1; \
        const int krow_ = t_ < 64 ? row0 + t_ * 32 : M + b * 512 + (t_ - 64) * 32; \
        (S).k = *(const u32x4*)(KN + (size_t)(krow_ + kkey) * 512 + h * 64 + kch); \
        (S).v = *(const u32x4*)(VT + (size_t)vd * 2560 + t_ * 32 + vch); \
        (S).r = *(const u32x2*)((t_ < 64 ? KR + (size_t)(krow_ + kkey) * 32 : CKR + (size_t)(b * 512 + (t_ - 64) * 32 + kkey) * 32) + rch); } while (0)
#define MLA_ST(S, SLOT) do { bf16_t* sl_ = ring + (SLOT) * 6144; \
        *(u32x4*)(sl_ + kkey * 72 + kch) = (S).k; *(u32x4*)(sl_ + 3584 + vd * 40 + vch) = (S).v; \
        *(u32x2*)(sl_ + 2304 + kkey * 40 + rch) = (S).r; } while (0)
#define MLA_COMPUTE(SLOT, T) do { const bf16_t* sl_ = ring + (SLOT) * 6144; bf16x8 kf[6], vf[4]; \
        _Pragma("unroll") for (int ks = 0; ks < 4; ++ks) kf[ks] = *(const bf16x8*)(sl_ + pr * 72 + ks * 16 + hl * 8); \
        kf[4] = *(const bf16x8*)(sl_ + 2304 + pr * 40 + hl * 8); kf[5] = *(const bf16x8*)(sl_ + 2304 + pr * 40 + 16 + hl * 8); \
        vf[0] = *(const bf16x8*)(sl_ + 3584 + c32 * 40 + hl * 8); vf[1] = *(const bf16x8*)(sl_ + 3584 + c32 * 40 + 16 + hl * 8); \
        vf[2] = *(const bf16x8*)(sl_ + 3584 + (c32 + 32) * 40 + hl * 8); vf[3] = *(const bf16x8*)(sl_ + 3584 + (c32 + 32) * 40 + 16 + hl * 8); \
        attn_step<6>(kf, vf, q, o0, o1, m, lsum, NoMask(), (T)); } while (0)
    MlaStage s0, s1, s2;
    MLA_LD(s0, tb); MLA_LD(s1, tb + 1); MLA_LD(s2, tb + 2);
    MLA_ST(s0, 0); MLA_LD(s0, tb + 3);
    __syncthreads();
#pragma unroll 1
    for (int i = tb; i < tend; i += 3) {
        MLA_ST(s1, 1); MLA_LD(s1, i + 4); MLA_COMPUTE(0, i); __syncthreads();
        MLA_ST(s2, 2); MLA_LD(s2, i + 5); if (i + 1 < tend) MLA_COMPUTE(1, i + 1); __syncthreads();
        MLA_ST(s0, 0); MLA_LD(s0, i + 6); if (i + 2 < tend) MLA_COMPUTE(2, i + 2); __syncthreads();
    }
#undef MLA_LD
#undef MLA_ST
#undef MLA_COMPUTE
    if (half == 1) {
#pragma unroll
        for (int r = 0; r < 16; ++r) { ex[r * 64 + lane] = o0[r]; ex[(16 + r) * 64 + lane] = o1[r]; }
        ex[32 * 64 + lane] = m; ex[33 * 64 + lane] = lsum;
    }
    __syncthreads();
    if (half == 0) {
        const float m2 = ex[32 * 64 + lane], l2 = ex[33 * 64 + lane];
        const float mn = fmaxf(m, m2), a1 = fast_exp2(m - mn), a2 = fast_exp2(m2 - mn);
        lsum = lsum * a1 + l2 * a2;
#pragma unroll
        for (int r = 0; r < 16; ++r) { o0[r] = o0[r] * a1 + ex[r * 64 + lane] * a2; o1[r] = o1[r] * a1 + ex[(16 + r) * 64 + lane] * a2; }
    }
    __syncthreads();
    if (half == 1) return;
    lsum += __shfl_xor(lsum, 32);
    const float inv = 1.f / lsum;
    bf16_t* optr = YM + (size_t)qrow * 512 + h * 64;
#pragma unroll
    for (int qd = 0; qd < 4; ++qd) {
        u32x2 a, bb;
        a.x = pk2(o0[4 * qd] * inv, o0[4 * qd + 1] * inv); a.y = pk2(o0[4 * qd + 2] * inv, o0[4 * qd + 3] * inv);
        bb.x = pk2(o1[4 * qd] * inv, o1[4 * qd + 1] * inv); bb.y = pk2(o1[4 * qd + 2] * inv, o1[4 * qd + 3] * inv);
        *(u32x2*)(optr + 8 * qd + 4 * hl) = a;
        *(u32x2*)(optr + 32 + 8 * qd + 4 * hl) = bb;
    }
}

template <int NKS>
DEVI void attn_ctx_shared(const bf16_t* Kg, const bf16_t* KRg, const bf16_t* VTg, const bf16_t* qptr, bf16_t* optr, int tid, unsigned char* smem) {
    const int lane = tid & 63, hl = lane >> 5, c32 = lane & 31, pr = pi_row(c32);
    bf16_t* Ks = (bf16_t*)smem;
    bf16_t* Rs = Ks + 256 * 72;
    bf16_t* Vs = Rs + 256 * 40;
    {
        u32x4 kr[4], vr[4], rr[2];
#pragma unroll
        for (int i = 0; i < 4; ++i) { const int c = tid + 512 * i; kr[i] = *(const u32x4*)(Kg + (size_t)(c >> 3) * 512 + (c & 7) * 8); }
#pragma unroll
        for (int i = 0; i < 4; ++i) { const int c = tid + 512 * i; vr[i] = *(const u32x4*)(VTg + (size_t)(c >> 5) * 256 + (c & 31) * 8); }
        if constexpr (NKS == 6) {
#pragma unroll
            for (int i = 0; i < 2; ++i) { const int c = tid + 512 * i; rr[i] = *(const u32x4*)(KRg + (size_t)(c >> 2) * 32 + (c & 3) * 8); }
        }
#pragma unroll
        for (int i = 0; i < 4; ++i) { const int c = tid + 512 * i; *(u32x4*)(Ks + (c >> 3) * 72 + (c & 7) * 8) = kr[i]; }
#pragma unroll
        for (int i = 0; i < 4; ++i) { const int c = tid + 512 * i; *(u32x4*)(Vs + (c >> 5) * 264 + (c & 31) * 8) = vr[i]; }
        if constexpr (NKS == 6) {
#pragma unroll
            for (int i = 0; i < 2; ++i) { const int c = tid + 512 * i; *(u32x4*)(Rs + (c >> 2) * 40 + (c & 3) * 8) = rr[i]; }
        }
    }
    bf16x8 q[NKS];
#pragma unroll
    for (int ks = 0; ks < NKS; ++ks) q[ks] = *(const bf16x8*)(qptr + ks * 16);
    __syncthreads();
    f32x16 o0, o1;
#pragma unroll
    for (int r = 0; r < 16; ++r) { o0[r] = 0.f; o1[r] = 0.f; }
    float m = -1e30f, lsum = 0.f;
#pragma unroll 1
    for (int t = 0; t < 8; ++t) {
        bf16x8 kf[NKS], vf[4];
        const bf16_t* kp = Ks + (t * 32 + pr) * 72 + hl * 8;
#pragma unroll
        for (int ks = 0; ks < 4; ++ks) kf[ks] = *(const bf16x8*)(kp + ks * 16);
        if constexpr (NKS == 6) {
            const bf16_t* rp = Rs + (t * 32 + pr) * 40 + hl * 8;
            kf[4] = *(const bf16x8*)rp; kf[5] = *(const bf16x8*)(rp + 16);
        }
        const bf16_t* vp = Vs + c32 * 264 + t * 32 + hl * 8;
        vf[0] = *(const bf16x8*)vp; vf[1] = *(const bf16x8*)(vp + 16);
        vf[2] = *(const bf16x8*)(vp + 32 * 264); vf[3] = *(const bf16x8*)(vp + 32 * 264 + 16);
        attn_step<NKS>(kf, vf, q, o0, o1, m, lsum, NoMask(), t);
    }
    lsum += __shfl_xor(lsum, 32);
    const float inv = 1.f / lsum;
#pragma unroll
    for (int qd = 0; qd < 4; ++qd) {
        u32x2 a, bb;
        a.x = pk2(o0[4 * qd] * inv, o0[4 * qd + 1] * inv); a.y = pk2(o0[4 * qd + 2] * inv, o0[4 * qd + 3] * inv);
        bb.x = pk2(o1[4 * qd] * inv, o1[4 * qd + 1] * inv); bb.y = pk2(o1[4 * qd + 2] * inv, o1[4 * qd + 3] * inv);
        *(u32x2*)(optr + 8 * qd + 4 * hl) = a;
        *(u32x2*)(optr + 32 + 8 * qd + 4 * hl) = bb;
    }
    __syncthreads();
}

DEVI void attn_na_ctx(const P& p, unsigned char* ws_b, int b, int h, int qg, int lane) {
    const int hl = lane >> 5, c32 = lane & 31, pr = pi_row(c32);
    const bf16_t* Qn = (const bf16_t*)(ws_b + WS_NAQ);
    const bf16_t* Kn = (const bf16_t*)(ws_b + WS_NAK);
    const bf16_t* VT = (const bf16_t*)(ws_b + WS_NAVT);
    bf16_t* YN = (bf16_t*)(ws_b + WS_YN);
    const int row0 = b * 256, qrow = row0 + qg * 32 + c32;
    const bf16_t* k0 = Kn + (size_t)(row0 + pr) * 512 + h * 64 + hl * 8;
    const bf16_t* v0 = VT + ((size_t)((b * 8 + h) * 64 + c32)) * 256 + hl * 8;
    auto src = [=](int t) { TileSrc s; s.k = k0 + (size_t)t * 32 * 512; s.k2 = s.k; s.v = v0 + t * 32; s.vhi = s.v + 32 * 256; return s; };
    attn_wave<4, false>(Qn + (size_t)qrow * 512 + h * 64 + hl * 8, 0, 8, src, NoMask(), YN + (size_t)qrow * 512 + h * 64, lane);
}

struct NaMask {
    const float* rpb;
    int rs, rq, qc, hl;
    DEVI void operator()(int t, f32x16& s) const {
        if (t >= 16) return;
        const int kr = t >> 1, kh = t & 1;
        const int cs = min(max(qc - 8, 0), 48);
        const float* rp = rpb + (rs + kr - rq + 7) * 31;
#pragma unroll
        for (int r = 0; r < 16; ++r) {
            const int kk = (r & 3) + 4 * ((r >> 2) & 1) + 8 * hl + 16 * (r >> 3);
            const int kc = kh * 32 + kk;
            const bool ok = (kc >= cs) && (kc < cs + 16);
            const int dc = min(max(kc - qc + 15, 0), 30);
            const float bias = rp[dc];
            s[r] = ok ? s[r] + bias : -1e30f;
        }
    }
};
DEVI void attn_na_lat(const P& p, unsigned char* ws_b, int l, int b, int h, int rq, int qh, int lane, float* ex, int half, const float* rpb_lds) {
    const int hl = lane >> 5, c32 = lane & 31, pr = pi_row(c32);
    const bf16_t* Qn = (const bf16_t*)(ws_b + WS_NAQ);
    const bf16_t* Kn = (const bf16_t*)(ws_b + WS_NAK);
    const bf16_t* VT = (const bf16_t*)(ws_b + WS_NAVT) + (size_t)4194304;
    const bf16_t* CK = (const bf16_t*)(ws_b + WS_CNAK) + (size_t)l * 1024 * 512;
    const bf16_t* CV = (const bf16_t*)(ws_b + WS_CNAVT) + (size_t)l * 1024 * 512;
    bf16_t* YN = (bf16_t*)(ws_b + WS_YN);
    const int row0 = NCTX + b * 2048;
    const int qrow = row0 + rq * 64 + qh * 32 + c32;
    const int rs = min(max(rq - 4, 0), 24);
    const bf16_t* k0 = Kn + (size_t)(row0 + rs * 64 + pr) * 512 + h * 64 + hl * 8;
    const bf16_t* v0 = VT + ((size_t)((b * 8 + h) * 64 + c32)) * 2048 + rs * 64 + hl * 8;
    const bf16_t* k1 = CK + (size_t)(b * 512 + pr) * 512 + h * 64 + hl * 8;
    const bf16_t* v1 = CV + ((size_t)((b * 8 + h) * 64 + c32)) * 512 + hl * 8;
    auto src = [=](int t) {
        TileSrc s;
        if (t < 16) { s.k = k0 + (size_t)t * 32 * 512; s.v = v0 + t * 32; s.vhi = s.v + 32 * 2048; }
        else { s.k = k1 + (size_t)(t - 16) * 32 * 512; s.v = v1 + (t - 16) * 32; s.vhi = s.v + 32 * 512; }
        s.k2 = s.k; return s; };
    NaMask mk; mk.rpb = rpb_lds; mk.rs = rs; mk.rq = rq; mk.qc = qh * 32 + c32; mk.hl = hl;
    attn_wave<4, true>(Qn + (size_t)qrow * 512 + h * 64 + hl * 8, half * 16, 16, src, mk, YN + (size_t)qrow * 512 + h * 64, lane, ex, half);
}

DEVI void row_load(const float* src, f32x4 (&v)[4], int lane) {
#pragma unroll
    for (int j = 0; j < 4; ++j) v[j] = *(const f32x4*)(src + 4 * lane + 256 * j);
}
DEVI void row_ln_mod(f32x4 (&v)[4], float* xdst, bf16_t* hdst, const float* lng, const float* lnb, const float* shift, const float* scale, int lane) {
    if (lng) {
        float s = 0.f;
#pragma unroll
        for (int j = 0; j < 4; ++j) s += (v[j].x + v[j].y) + (v[j].z + v[j].w);
        const float mu = wave_sum(s) * (1.f / D);
        float q = 0.f;
#pragma unroll
        for (int j = 0; j < 4; ++j) { v[j] = v[j] - mu; q += (v[j].x * v[j].x + v[j].y * v[j].y) + (v[j].z * v[j].z + v[j].w * v[j].w); }
        const float rstd = rsqrtf(wave_sum(q) * (1.f / D) + 1e-5f);
#pragma unroll
        for (int j = 0; j < 4; ++j) {
            const f32x4 g = *(const f32x4*)(lng + 4 * lane + 256 * j), bb = *(const f32x4*)(lnb + 4 * lane + 256 * j);
            v[j] = v[j] * rstd * g + bb;
        }
    }
    if (xdst) {
#pragma unroll
        for (int j = 0; j < 4; ++j) *(f32x4*)(xdst + 4 * lane + 256 * j) = v[j];
    }
    if (hdst) {
        float s = 0.f;
#pragma unroll
        for (int j = 0; j < 4; ++j) s += (v[j].x + v[j].y) + (v[j].z + v[j].w);
        const float mu = wave_sum(s) * (1.f / D);
        float q = 0.f;
#pragma unroll
        for (int j = 0; j < 4; ++j) { v[j] = v[j] - mu; q += (v[j].x * v[j].x + v[j].y * v[j].y) + (v[j].z * v[j].z + v[j].w * v[j].w); }
        const float rstd = rsqrtf(wave_sum(q) * (1.f / D) + 1e-6f);
#pragma unroll
        for (int j = 0; j < 4; ++j) {
            const f32x4 sc = *(const f32x4*)(scale + 4 * lane + 256 * j), sh = *(const f32x4*)(shift + 4 * lane + 256 * j);
            const f32x4 o = v[j] * rstd * (sc + 1.f) + sh;
            u32x2 pk; pk.x = pk2(o.x, o.y); pk.y = pk2(o.z, o.w);
            *(u32x2*)(hdst + 4 * lane + 256 * j) = pk;
        }
    }
}

DEVI const float* phase_rows_src(const P& p, unsigned char* ws_b, int row, int lnidx) {
    return (lnidx < 0) ? (row < NCTX ? pin(p, 0) + (size_t)row * D : pin(p, 1) + (size_t)(row - NCTX) * D) : (const float*)(ws_b + WS_X) + (size_t)row * D;
}
DEVI void phase_rows_one(const P& p, unsigned char* ws_b, f32x4 (&v)[4], int row, int l, int lnidx, int ml, int ms, bool final_, int lane) {
    float* X = (float*)(ws_b + WS_X);
    bf16_t* H = (bf16_t*)(ws_b + WS_H);
    const float* MOD = (const float*)(ws_b + WS_MOD);
    const float* lng = (lnidx < 0) ? nullptr : pin(p, 28) + (size_t)(l * 3 + lnidx) * D;
    const float* lnb = (lnidx < 0) ? nullptr : pin(p, 29) + (size_t)(l * 3 + lnidx) * D;
    if (final_) { row_ln_mod(v, p.out + (size_t)row * D, nullptr, lng, lnb, nullptr, nullptr, lane); return; }
    const float* mb = MOD + ((size_t)ml * 3 + mod_group(row)) * 9216;
    row_ln_mod(v, X + (size_t)row * D, H + (size_t)row * D, lng, lnb, mb + ms * D, mb + (ms + 1) * D, lane);
}
DEVI void phase_rows(const P& p, unsigned char* ws_b, int l, int lnidx, int ml, int ms, bool final_, int gw, int ngw, int lane) {
    int row = gw;
    for (; row + ngw < M; row += 2 * ngw) {
        f32x4 va[4], vb[4];
        row_load(phase_rows_src(p, ws_b, row, lnidx), va, lane);
        row_load(phase_rows_src(p, ws_b, row + ngw, lnidx), vb, lane);
        phase_rows_one(p, ws_b, va, row, l, lnidx, ml, ms, final_, lane);
        phase_rows_one(p, ws_b, vb, row + ngw, l, lnidx, ml, ms, final_, lane);
    }
    if (row < M) { f32x4 va[4]; row_load(phase_rows_src(p, ws_b, row, lnidx), va, lane); phase_rows_one(p, ws_b, va, row, l, lnidx, ml, ms, final_, lane); }
}

DEVI void phase_rowmix(const P& p, unsigned char* ws_b, int l, int gw, int ngw, int lane) {
    bf16_t* UQ = (bf16_t*)(ws_b + WS_UQ);
    const float* UKV = (const float*)(ws_b + WS_UKV);
    const float* KRF = (const float*)(ws_b + WS_KRF);
    bf16_t* CKV = (bf16_t*)(ws_b + WS_CKV);
    bf16_t* KR = (bf16_t*)(ws_b + WS_KR);
    const float* ropec = (const float*)(ws_b + WS_ROPE);
    const float* ropes = ropec + 512;
    const float* gq = pin(p, 17) + l * 384;
    const float* gkv = pin(p, 19) + l * 256;
    for (int row = gw; row < M; row += ngw) {
        {
            unsigned* up = (unsigned*)(UQ + (size_t)row * 384) + lane;
            float x[6]; float ss = 0.f;
#pragma unroll
            for (int j = 0; j < 3; ++j) { const unsigned w = up[64 * j]; x[2 * j] = bf2f(w & 0xffffu); x[2 * j + 1] = bf2f(w >> 16); ss += x[2 * j] * x[2 * j] + x[2 * j + 1] * x[2 * j + 1]; }
            const float rs = rsqrtf(wave_sum(ss) * (1.f / 384.f) + 1e-6f);
#pragma unroll
            for (int j = 0; j < 3; ++j) { const int c = 2 * lane + 128 * j; up[64 * j] = pk2(x[2 * j] * rs * gq[c], x[2 * j + 1] * rs * gq[c + 1]); }
        }
        {
            const f32x4 v = *(const f32x4*)(UKV + (size_t)row * 256 + 4 * lane);
            const float ss = v.x * v.x + v.y * v.y + v.z * v.z + v.w * v.w;
            const float rs = rsqrtf(wave_sum(ss) * (1.f / 256.f) + 1e-6f);
            const f32x4 g = *(const f32x4*)(gkv + 4 * lane);
            const f32x4 o = v * rs * g;
            u32x2 pk; pk.x = pk2(o.x, o.y); pk.y = pk2(o.z, o.w);
            *(u32x2*)(CKV + (size_t)row * 256 + 4 * lane) = pk;
            if (row < NCTX) *(f32x4*)(p.out + OUT_CKV + ((size_t)((row >> 8) * 4 + l) * 256 + (row & 255)) * 256 + 4 * lane) = o;
        }
        {
            const float v = KRF[(size_t)row * 32 + (lane & 31)];
            const float pr = __shfl_xor(v, 8);
            float o = v;
            if (row >= NCTX) {
                const int c = lane & 31, axis = c >> 4, ii = c & 15, n = (row - NCTX) & 2047;
                const int pos = axis ? (n & 63) : (n >> 6);
                const float rot = (ii < 8) ? -pr : pr;
                o = v * ropec[pos * 8 + (ii & 7)] + rot * ropes[pos * 8 + (ii & 7)];
            }
            if (lane < 32) {
                KR[(size_t)row * 32 + lane] = f2bf(o);
                if (row < NCTX) p.out[OUT_KR + ((size_t)((row >> 8) * 4 + l) * 256 + (row & 255)) * 32 + lane] = v;
            }
        }
    }
}

DEVI void transpose_item(const float* __restrict__ src, int N, int c0, int k0, bf16_t* __restrict__ dst, int K, float* scr, int lane) {
#pragma unroll 8
    for (int i = 0; i < 32; ++i) { const int kk = 2 * i + (lane >> 5); scr[kk * 33 + (lane & 31)] = src[(size_t)(k0 + kk) * N + c0 + (lane & 31)]; }
    asm volatile("s_waitcnt lgkmcnt(0)" ::: "memory");
    const int c = lane & 7;
#pragma unroll
    for (int j = 0; j < 4; ++j) {
        const int n = (lane >> 3) + 8 * j; const float* s = scr + (8 * c) * 33 + n;
        u32x4 o; o.x = pk2(s[0], s[33]); o.y = pk2(s[2 * 33], s[3 * 33]); o.z = pk2(s[4 * 33], s[5 * 33]); o.w = pk2(s[6 * 33], s[7 * 33]);
        *(u32x4*)(dst + (size_t)n * K + k0 + 8 * c) = o;
    }
    asm volatile("s_waitcnt lgkmcnt(0)" ::: "memory");
}

DEVI void prep_weight_item(const P& p, unsigned char* ws_b, int item, float* scr, int lane) {
    const int l = item / 12944; int r = item % 12944;
    bf16_t* Wl = (bf16_t*)(ws_b + WS_W) + (size_t)l * LAYER_W;
    if (r < 8448) {
        const int which = r / 4224; r %= 4224;
        if (r < 2816) {
            const int rb = r >> 4, kb = r & 15;
            const float* src = ((lane & 16) ? (which ? pin(p, 14) : pin(p, 11)) : (which ? pin(p, 13) : pin(p, 10))) + (size_t)l * D * DFF;
            transpose_item(src, DFF, rb * 16 - (lane & 16), kb * 64, Wl + (which ? OFF_W13_2 : OFF_W13_1) + (size_t)rb * 32 * D, D, scr, lane);
        } else {
            r -= 2816; const int rb = r / 44, kb = r % 44;
            const float* src = (which ? pin(p, 15) : pin(p, 12)) + (size_t)l * DFF * D;
            transpose_item(src, D, rb * 32, kb * 64, Wl + (which ? OFF_W2_2 : OFF_W2_1) + (size_t)rb * 32 * DFF, DFF, scr, lane);
        }
        return;
    }
    r -= 8448;
    if (r < 2944) {
        const int rb = r >> 4, kb = r & 15, R0 = rb * 32;
        const float* src; int N, c0;
        if (R0 < 1184) { src = pin(p, 16) + (size_t)l * D * 2720; N = 2720; c0 = R0; }
        else if (R0 < 1280) return;
        else if (R0 < 2816) { src = pin(p, 16) + (size_t)l * D * 2720; N = 2720; c0 = R0 - 96; }
        else { src = pin(p, 25) + (size_t)l * D * 3072; N = 3072; c0 = R0 - 2816; }
        transpose_item(src, N, c0, kb * 64, Wl + OFF_WIN + (size_t)R0 * D, D, scr, lane);
        return;
    }
    r -= 2944;
    if (r < 512) { const int rb = r >> 4, kb = r & 15; transpose_item(pin(p, 27) + (size_t)l * D * D, D, rb * 32, kb * 64, Wl + OFF_WOUT + (size_t)rb * 32 * D, D, scr, lane); return; }
    r -= 512;
    if (r < 768) { const int w = r >> 8; r &= 255; const int rb = r >> 3, kb = r & 7;
        transpose_item((w == 0 ? pin(p, 22) : (w == 1 ? pin(p, 23) : pin(p, 24))) + (size_t)l * 512 * D, D, rb * 32, kb * 64, Wl + (w == 0 ? OFF_WBF : (w == 1 ? OFF_WBM : OFF_WBN)) + (size_t)rb * 32 * 512, 512, scr, lane); return; }
    r -= 768;
    if (r < 144) { const int rb = r / 6, kb = r % 6; transpose_item(pin(p, 18) + (size_t)l * 384 * 768, 768, rb * 32, kb * 64, Wl + OFF_WUQ + (size_t)rb * 32 * 384, 384, scr, lane); return; }
    r -= 144;
    { const int rb = r >> 2, kb = r & 3; transpose_item(pin(p, 20) + (size_t)l * 256 * 1024, 1024, rb * 32, kb * 64, Wl + OFF_WUKV + (size_t)rb * 32 * 256, 256, scr, lane); }
}

DEVI void phase_prep(const P& p, unsigned char* ws_b, unsigned char* smem, int tid) {
    const int lane = tid & 63, wave = tid >> 6;
    const int gw = blockIdx.x * NWAVES + wave, ngw = gridDim.x * NWAVES;
    const size_t gt = (size_t)blockIdx.x * NTHREADS + tid, ngt = (size_t)gridDim.x * NTHREADS;
    {
        float* sil = (float*)smem;
        const float* wada = pin(p, 8);
        float* MODP = (float*)(ws_b + WS_MODP);
        for (int item = blockIdx.x; item < 1152; item += gridDim.x) {
            const int l = item / 288, rem = item % 288, kc = rem / 18, cb = rem % 18;
            __syncthreads();
            if (tid < 192) {
                const int g = tid >> 6, k = kc * 64 + (tid & 63);
                const float cv = (g == 0) ? pin(p, 7)[k] : pin(p, 6)[(g - 1) * D + k];
                sil[tid] = cv * sigmoidf_(cv);
            }
            __syncthreads();
            const int col = cb * NTHREADS + tid;
            const float* w = wada + ((size_t)l * D + kc * 64) * 9216 + col;
            float a0 = 0.f, a1 = 0.f, a2 = 0.f;
#pragma unroll 16
            for (int k = 0; k < 64; ++k) { const float wv = w[(size_t)k * 9216]; a0 += sil[k] * wv; a1 += sil[64 + k] * wv; a2 += sil[128 + k] * wv; }
            float* o = MODP + ((size_t)(l * 16 + kc) * 3) * 9216 + col;
            o[0] = a0; o[9216] = a1; o[2 * 9216] = a2;
        }
        __syncthreads();
    }
    {
        float* scr = (float*)smem + wave * (64 * 33);
        for (int item = gw; item < 4 * 12944; item += ngw) prep_weight_item(p, ws_b, item, scr, lane);
    }
    {
        bf16_t* TABL = (bf16_t*)(ws_b + WS_TABL);
        for (size_t e = gt; e < (size_t)2048 * 4096; e += ngt) {
            const int k = (int)(e >> 12), kk = (int)(e & 4095), lidx = kk & 2047;
            const int idx = (k * lidx) & 2047;
            float sn, cs; sincospif((float)idx * (2.f / 2048.f), &sn, &cs);
            TABL[e] = f2bf((kk < 2048 ? cs : -sn) * 0.022097086912079608f);
        }
        bf16_t* TABC = (bf16_t*)(ws_b + WS_TABC);
        for (size_t e = gt; e < (size_t)256 * 512; e += ngt) {
            const int k = (int)(e >> 9), kk = (int)(e & 511), lidx = kk & 255;
            const int idx = (k * lidx) & 255;
            float sn, cs; sincospif((float)idx * (2.f / 256.f), &sn, &cs);
            TABC[e] = f2bf((kk < 256 ? cs : -sn) * 0.0625f);
        }
        bf16_t* WCS = (bf16_t*)(ws_b + WS_WCS);
        for (size_t e = gt; e < (size_t)256 * 128; e += ngt) {
            const int i = (int)(e >> 7), c = (int)(e & 127), m = i >> 1, cs_ = i & 1;
            const int idx = (m * c) & 127;
            float sn, cs; sincospif((float)idx * (2.f / 128.f), &sn, &cs);
            WCS[e] = f2bf((cs_ ? sn : cs) * 0.08838834764831845f);
        }
        float* ROPE = (float*)(ws_b + WS_ROPE);
        for (size_t e = gt; e < 512; e += ngt) {
            const int pos = (int)(e >> 3), i = (int)(e & 7);
            const float inv_freq = powf(10000.f, -(float)i / 8.f);
            const float ang = (float)pos * inv_freq;
            ROPE[e] = cosf(ang); ROPE[512 + e] = sinf(ang);
        }
    }
    {
        bf16_t* CCKV = (bf16_t*)(ws_b + WS_CCKV);
        for (size_t e = gt; e < (size_t)NL * 1024 * 256; e += ngt) {
            const int c = (int)(e & 255), i = (int)((e >> 8) & 511), b = (int)((e >> 17) & 1), l = (int)(e >> 18);
            CCKV[e] = f2bf(pin(p, 2)[((size_t)(b * 4 + l) * 512 + i) * 256 + c]);
        }
        bf16_t* CKR = (bf16_t*)(ws_b + WS_CKR);
        for (size_t e = gt; e < (size_t)NL * 1024 * 32; e += ngt) {
            const int c = (int)(e & 31), i = (int)((e >> 5) & 511), b = (int)((e >> 14) & 1), l = (int)(e >> 15);
            CKR[e] = f2bf(pin(p, 3)[((size_t)(b * 4 + l) * 512 + i) * 32 + c]);
        }
        bf16_t* CNAK = (bf16_t*)(ws_b + WS_CNAK);
        for (size_t e = gt; e < (size_t)NL * 1024 * 512; e += ngt) {
            const int c = (int)(e & 511), i = (int)((e >> 9) & 511), b = (int)((e >> 18) & 1), l = (int)(e >> 19);
            CNAK[e] = f2bf(pin(p, 4)[((size_t)(b * 4 + l) * 512 + i) * 512 + c]);
        }
        bf16_t* CNAVT = (bf16_t*)(ws_b + WS_CNAVT);
        for (size_t e = gt; e < (size_t)NL * 1024 * 512; e += ngt) {
            const int key = (int)(e & 511), hd = (int)((e >> 9) & 511), b = (int)((e >> 18) & 1), l = (int)(e >> 19);
            CNAVT[e] = f2bf(pin(p, 5)[((size_t)(b * 4 + l) * 512 + key) * 512 + hd]);
        }
    }
}

DEVI void phase_modreduce(const P& p, unsigned char* ws_b, int tid) {
    const float* MODP = (const float*)(ws_b + WS_MODP);
    float* MOD = (float*)(ws_b + WS_MOD);
    for (int e = blockIdx.x * NTHREADS + tid; e < NL * 3 * 9216; e += gridDim.x * NTHREADS) {
        const int l = e / (3 * 9216), rem = e % (3 * 9216);
        float a = pin(p, 9)[l * 9216 + (rem % 9216)];
#pragma unroll
        for (int kc = 0; kc < 16; ++kc) a += MODP[((size_t)(l * 16 + kc) * 3) * 9216 + rem];
        MOD[e] = a;
    }
}

#define XB_TMO      128
#define XB_XCNT(j)  (256  + 64 * (j))
#define XB_XSUB(j)  (1280 + 64 * (j))
#define XB_XGEN(j)  (2304 + 64 * (j))
#define XB_TOP      3328
#define XB_TOPGEN   3392
#define XCD_BAR_WORDS 3456
#define XB_SPIN_CAP (1u << 20)
#define LAS __attribute__((address_space(3)))
DEVI unsigned xb_ld(unsigned* p)              { return __hip_atomic_load(p, __ATOMIC_RELAXED, __HIP_MEMORY_SCOPE_AGENT); }
DEVI unsigned xb_add(unsigned* p, unsigned v) { return __hip_atomic_fetch_add(p, v, __ATOMIC_RELAXED, __HIP_MEMORY_SCOPE_AGENT); }
DEVI unsigned xb_xcc_id() { return (unsigned)__builtin_amdgcn_s_getreg((3 << 11) | 20) & 0xFu; }
#define XB_SPIN(cond, bar) do { unsigned _sp = 0; while (cond) { __builtin_amdgcn_s_sleep(1); \
    if ((++_sp & 255u) == 0u) { if (xb_ld(&(bar)[XB_TMO])) break; if (_sp > XB_SPIN_CAP) { atomicAdd(&(bar)[XB_TMO], 1u); break; } } } } while (0)
struct XcdBarrier { unsigned* bar; unsigned x; volatile LAS unsigned* st; };
DEVI XcdBarrier xcd_barrier_post(unsigned* bar, volatile LAS unsigned* st) {
    XcdBarrier b; b.bar = bar; b.x = xb_xcc_id(); b.st = st;
    if (threadIdx.x == 0) (void)xb_add(&bar[XB_XCNT(b.x)], 1u);
    return b;
}
DEVI void xcd_barrier_complete(unsigned* bar, unsigned x, unsigned& nloc, unsigned& nx) {
    const unsigned G = gridDim.x * gridDim.y * gridDim.z;
    unsigned sum, cnt, mine, sp = 0u;
    for (;;) {
        sum = 0u; cnt = 0u; mine = 0u;
#pragma unroll
        for (unsigned j = 0; j < 16; ++j) { const unsigned c = xb_ld(&bar[XB_XCNT(j)]); sum += c; cnt += (c > 0u) ? 1u : 0u; mine = (j == x) ? c : mine; }
        if (sum == G) break;
        __builtin_amdgcn_s_sleep(1);
        if ((++sp & 255u) == 0u) { if (xb_ld(&bar[XB_TMO])) break; if (sp > XB_SPIN_CAP) { atomicAdd(&bar[XB_TMO], 1u); break; } }
    }
    nloc = mine > 0u ? mine : 1u; nx = cnt > 0u ? cnt : 1u;
}
DEVI void xcd_barrier(const XcdBarrier& b) {
    asm volatile("s_waitcnt vmcnt(0)" ::: "memory");
    __syncthreads();
    if (threadIdx.x == 0) {
        unsigned* bar = b.bar;
        __builtin_amdgcn_s_waitcnt(0);
        unsigned nloc = b.st[0], nx = b.st[1];
        if (nloc == 0u) { xcd_barrier_complete(bar, b.x, nloc, nx); b.st[0] = nloc; b.st[1] = nx; }
        const unsigned old = xb_add(&bar[XB_XSUB(b.x)], 1u);
        const unsigned gen = old / nloc;
        if (old + 1u == (gen + 1u) * nloc) {
            __builtin_amdgcn_fence(__ATOMIC_RELEASE, "agent");
            asm volatile("s_waitcnt vmcnt(0)" ::: "memory");
            const unsigned og = xb_add(&bar[XB_TOP], 1u);
            const unsigned tg = og / nx;
            if (og + 1u == (tg + 1u) * nx) xb_add(&bar[XB_TOPGEN], 1u);
            else XB_SPIN(xb_ld(&bar[XB_TOPGEN]) == tg, bar);
            __builtin_amdgcn_fence(__ATOMIC_ACQUIRE, "agent");
            xb_add(&bar[XB_XGEN(b.x)], 1u);
            asm volatile("s_waitcnt vmcnt(0)" ::: "memory");
        } else {
            XB_SPIN(xb_ld(&bar[XB_XGEN(b.x)]) == gen, bar);
            __builtin_amdgcn_fence(__ATOMIC_ACQUIRE, "agent");
            asm volatile("s_waitcnt vmcnt(0)" ::: "memory");
        }
    }
    __syncthreads();
}

DEVI void run_phase(const P& p, unsigned char* ws_b, int ph, unsigned char* smem, int tid) {
    const int lane = tid & 63, wave = tid >> 6;
    const int gw = blockIdx.x * NWAVES + wave, ngw = gridDim.x * NWAVES;
    const int nb = gridDim.x, bid = blockIdx.x;
    const int grp = tid >> 8, ltid = tid & 255;
    bf16_t* sm = (bf16_t*)smem + grp * (SMEM_BYTES / 2);
    if (ph == 0) { phase_prep(p, ws_b, smem, tid); return; }
    if (ph == 1) { phase_modreduce(p, ws_b, tid); return; }
    if (ph == 2) { phase_rows(p, ws_b, 0, -1, 0, 0, false, gw, ngw, lane); return; }
    const int l = (ph - 3) / 13, s = (ph - 3) % 13;
    const bf16_t* Wl = (const bf16_t*)(ws_b + WS_W) + (size_t)l * LAYER_W;
    const float* MODl = (const float*)(ws_b + WS_MOD) + (size_t)l * 3 * 9216;
    switch (s) {
    case 0: case 10:
        {
            pg8::Gemm g{(const bf16_t*)(ws_b + WS_H), Wl + (s == 10 ? OFF_W13_2 : OFF_W13_1), M, 2 * DFF, D};
            pg8::StaticOrder S; S.init(M, 2 * DFF, nb, bid);
            pg8::EpiSwiGLU E{(bf16_t*)(ws_b + WS_ACT)};
            pg8::gemm_phase<pg8::EpiSwiGLU, pg8::StaticOrder, true, true>((PG8_LAS unsigned char*)smem, g, S, E, tid);
        }
        break;
    case 1: case 11:
        {
            pg8::Gemm g{(const bf16_t*)(ws_b + WS_ACT), Wl + (s == 11 ? OFF_W2_2 : OFF_W2_1), M, D, DFF};
            pg8::StaticOrder S; S.init(M, D, nb, bid);
            pg8::EpiResid E{(float*)(ws_b + WS_X), MODl + (s == 11 ? 8 : 2) * D, 0.5f};
            pg8::gemm_phase<pg8::EpiResid, pg8::StaticOrder, false, true>((PG8_LAS unsigned char*)smem, g, S, E, tid);
        }
        break;
    case 2: phase_rows(p, ws_b, l, 0, l, 3, false, gw, ngw, lane); break;
    case 3:
        {
            pg8::Gemm g{(const bf16_t*)(ws_b + WS_H), Wl + OFF_WIN, M, 5888, D};
            pg8::InGateOrder S{nb, bid, 0, nb == 256 ? 1024 : 1104};
            pg8::EpiIn E{ws_b, p.out, pin(p, 26), l};
            pg8::gemm_phase<pg8::EpiIn, pg8::InGateOrder, true, true>((PG8_LAS unsigned char*)smem, g, S, E, tid);
        }
        break;
    case 4: phase_rowmix(p, ws_b, l, gw, ngw, lane); break;
    case 5: {
        float* ex = (float*)smem + (wave & 3) * (34 * 64);
        int u = bid;
        for (; u < 256; u += nb) {
            const int wi = u * 4 + (wave & 3);
            float* rpb_lds = (float*)(smem + 36864);
            {
                const float* rsrc = pin(p, 21) + (size_t)(l * 8 + ((u * 4 >> 6) & 7)) * 465;
                if (tid < 465) rpb_lds[tid] = rsrc[tid] * LOG2E;
                __syncthreads();
            }
            attn_na_lat(p, ws_b, l, wi >> 9, (wi >> 6) & 7, (wi >> 1) & 31, wi & 1, lane, ex, wave >> 2, rpb_lds);
        }
        for (; u < 256 + 416; u += nb) job_ukv(p, ws_b, l, 2 * (u - 256) + grp, sm, ltid);
        for (; u < 256 + 416 + 288; u += nb) job_uq(p, ws_b, l, 2 * (u - 256 - 416) + grp, sm, ltid);
        for (; u < 256 + 416 + 288 + 384; u += nb) job_f1(p, ws_b, 2 * (u - 256 - 416 - 288) + grp, sm, ltid);
        for (; u < 256 + 416 + 288 + 384 + 256; u += nb) {
            const int wi = (u - 256 - 416 - 288 - 384) * 8 + wave;
            const int b = wi >> 6, h = (wi >> 3) & 7, qrow = b * 256 + wave * 32 + (lane & 31);
            attn_ctx_shared<4>((const bf16_t*)(ws_b + WS_NAK) + (size_t)(b * 256) * 512 + h * 64, nullptr,
                               (const bf16_t*)(ws_b + WS_NAVT) + (size_t)((b * 8 + h) * 64) * 256,
                               (const bf16_t*)(ws_b + WS_NAQ) + (size_t)qrow * 512 + h * 64 + (lane >> 5) * 8,
                               (bf16_t*)(ws_b + WS_YN) + (size_t)qrow * 512 + h * 64, tid, smem);
        }
    } break;
    case 6: {
        float* ex = (float*)smem + (wave & 3) * (34 * 64);
        int u = bid;
        for (; u < 256; u += nb) {
            const int wi = u * 4 + (wave & 3);
            attn_mla_lat_shared(p, ws_b, l, wi >> 9, (wi >> 6) & 7, wi & 63, tid, smem, ex);
        }
        for (; u < 256 + 128; u += nb) {
            const int t0 = u - 256, tt = ((t0 & 7) + 8 * ((t0 >> 3) >> 2)) * 4 + ((t0 >> 3) & 3);
            job_f2_lat(p, ws_b, tt, sm, ltid, grp, (float*)(smem + SMEM_BYTES));
        }
        for (; u < 256 + 128 + 128; u += nb) job_f2_ctx(p, ws_b, 2 * (u - 256 - 128) + grp, sm, ltid);
        for (; u < 256 + 128 + 128 + 256; u += nb) {
            const int wi = (u - 256 - 128 - 128) * 8 + wave;
            const int b = wi >> 6, h = (wi >> 3) & 7, qrow = b * 256 + wave * 32 + (lane & 31);
            attn_ctx_shared<6>((const bf16_t*)(ws_b + WS_KN) + (size_t)(b * 256) * 512 + h * 64, (const bf16_t*)(ws_b + WS_KR) + (size_t)(b * 256) * 32,
                               (const bf16_t*)(ws_b + WS_VTM) + (size_t)((b * 8 + h) * 64) * 256,
                               (const bf16_t*)(ws_b + WS_Q) + (size_t)qrow * 768 + h * 96 + (lane >> 5) * 8,
                               (bf16_t*)(ws_b + WS_YM) + (size_t)qrow * 512 + h * 64, tid, smem);
        }
        if (nb == 256 && bid >= 128 && bid < 208) {
            int tid5 = tid; asm volatile("" : "+v"(tid5));
            pg8::Gemm g{(const bf16_t*)(ws_b + WS_H), Wl + OFF_WIN, M, 5888, D};
            pg8::InGateOrder S{1 << 20, bid - 128, 1024, 1104};
            pg8::EpiIn E{ws_b, p.out, pin(p, 26), l};
            pg8::gemm_phase<pg8::EpiIn, pg8::InGateOrder, false, true>((PG8_LAS unsigned char*)smem, g, S, E, tid5);
        }
    } break;
    case 7:

#pragma nounroll
        for (int sg = 0; sg < 3; ++sg) {
            int tid3 = tid; asm volatile("" : "+v"(tid3));
            pg8::Gemm g{(const bf16_t*)(ws_b + (sg == 0 ? WS_YF : (sg == 1 ? WS_YM : WS_YN))), Wl + (sg == 0 ? OFF_WBF : (sg == 1 ? OFF_WBM : OFF_WBN)), M, D, 512};
            pg8::StaticOrder S; S.init(M, D, nb, bid);
            pg8::EpiMerge E{(const bf16_t*)(ws_b + WS_GATE), (bf16_t*)(ws_b + WS_UF)  , (bf16_t*)(ws_b + WS_MERGED), sg};
            pg8::gemm_phase<pg8::EpiMerge, pg8::StaticOrder, false, true>((PG8_LAS unsigned char*)smem, g, S, E, tid3);
        }
        break;
    case 8:
        {
            pg8::Gemm g{(const bf16_t*)(ws_b + WS_MERGED), Wl + OFF_WOUT, M, D, D};
            pg8::StaticOrder S; S.init(M, D, nb, bid);
            pg8::EpiResid E{(float*)(ws_b + WS_X), MODl + 5 * D, 1.0f};
            pg8::gemm_phase<pg8::EpiResid, pg8::StaticOrder, false, true>((PG8_LAS unsigned char*)smem, g, S, E, tid);
        }
        break;
    case 9: phase_rows(p, ws_b, l, 1, l, 6, false, gw, ngw, lane); break;
    case 12:
        if (l == NL - 1) phase_rows(p, ws_b, l, 2, 0, 0, true, gw, ngw, lane);
        else phase_rows(p, ws_b, l, 2, l + 1, 0, false, gw, ngw, lane);
        break;
    default: break;
    }
}

__global__ void __launch_bounds__(NTHREADS, 2) mega_kernel(P p) {
    extern __shared__ __attribute__((aligned(16))) unsigned char smem[];
    __shared__ uint4 xb_words;
    cg::grid_group grid = cg::this_grid();
    const int tid = threadIdx.x;
    unsigned* bar = (unsigned*)(p.ws + WS_BAR);
    if (tid == 0) xb_words = make_uint4(0u, 0u, 0u, 0u);
    if (p.ph_lo == 0 && blockIdx.x == 0) for (int i = tid; i < XCD_BAR_WORDS; i += NTHREADS) bar[i] = 0u;
    __syncthreads();
    XcdBarrier xb; xb.bar = bar; xb.x = 0; xb.st = (volatile LAS unsigned*)&xb_words;
#pragma nounroll
    for (int ph = p.ph_lo; ph < p.ph_hi; ++ph) {
        int tid2 = tid; asm volatile("" : "+v"(tid2));
        unsigned char* ws_b = p.ws; asm volatile("" : "+s"(ws_b));
        run_phase(p, ws_b, ph, smem, tid2);
        if (ph + 1 < p.ph_hi) {
            if (ph == p.ph_lo) { grid.sync(); xb = xcd_barrier_post(bar, (volatile LAS unsigned*)&xb_words); }
            else xcd_barrier(xb);
        }
    }
}

extern "C" void kernel_launch(void* const* d_in, const int* in_sizes, int n_in, void* d_out, int out_size, void* d_ws, size_t ws_size,
                              hipStream_t stream) {
    static int grid_blocks = 0;
    if (grid_blocks == 0) {
        if (n_in != 30 || ws_size < WS_END) { fprintf(stderr, "kernel_launch: n_in %d ws %zu need %zu\n", n_in, ws_size, (size_t)WS_END); grid_blocks = -1; return; }
        int dev = 0, cus = 0, per_cu = 0;
        hipGetDevice(&dev);
        hipDeviceGetAttribute(&cus, hipDeviceAttributeMultiprocessorCount, dev);
        hipFuncSetAttribute((const void*)mega_kernel, hipFuncAttributeMaxDynamicSharedMemorySize, LDS_TOTAL);
        hipOccupancyMaxActiveBlocksPerMultiprocessor(&per_cu, (const void*)mega_kernel, NTHREADS, LDS_TOTAL);
        if (per_cu < 1) per_cu = 1;
        if (per_cu > 1) per_cu = 1;
        grid_blocks = cus * per_cu;
    }
    if (grid_blocks < 0) return;
    P p{};
    for (int i = 0; i < 30; ++i) p.in[i] = (const float*)d_in[i];
    p.out = (float*)d_out; p.ws = (unsigned char*)d_ws; p.ph_lo = 0; p.ph_hi = NPHASE;
#ifndef MULTI_LAUNCH
#define MULTI_LAUNCH 0
#endif
#if MULTI_LAUNCH
    for (int ph = 0; ph < NPHASE; ++ph) {
        p.ph_lo = ph; p.ph_hi = ph + 1;
        hipLaunchKernelGGL(mega_kernel, dim3(grid_blocks), dim3(NTHREADS), LDS_TOTAL, stream, p);
    }
#else
    void* args[] = {&p};
    hipError_t e = hipLaunchCooperativeKernel((const void*)mega_kernel, dim3(grid_blocks), dim3(NTHREADS), args, LDS_TOTAL, stream);
    if (e != hipSuccess) fprintf(stderr, "cooperative launch failed: %s (grid %d)\n", hipGetErrorString(e), grid_blocks);
#endif
}
```

```cpp
#include <hip/hip_runtime.h>
#include <hip/hip_cooperative_groups.h>
#include <cstdint>
#include <cstdio>
namespace cg = cooperative_groups;

typedef unsigned short bf16_t;
typedef short bf16x8 __attribute__((ext_vector_type(8)));
typedef float f32x16 __attribute__((ext_vector_type(16)));
typedef float f32x4 __attribute__((ext_vector_type(4)));
typedef unsigned u32x4 __attribute__((ext_vector_type(4)));
typedef unsigned u32x2 __attribute__((ext_vector_type(2)));
#define DEVI __device__ __forceinline__

constexpr int D = 1024, NCTX = 8192, NLAT = 4096, M = 12288, MX = 13312, DFF = 2816, NL = 4;
constexpr float ALPHA_F = 1.6817928305074290f;
constexpr float LOG2E = 1.4426950408889634f;
constexpr float MLA_QS = 0.10206207261596575f * LOG2E;
constexpr float NA_QS = 0.125f * LOG2E;
constexpr size_t OUT_CKV = 12582912, OUT_KR = 20971520, OUT_NAK = 22020096, OUT_NAV = 38797312;

constexpr size_t al256(size_t x) { return (x + 255) & ~(size_t)255; }
constexpr size_t WS_BAR = 0;
constexpr size_t WS_X = 16384;
constexpr size_t WS_H = WS_X + (size_t)M * D * 4;
constexpr size_t WS_MOD = WS_H + (size_t)M * D * 2;
constexpr size_t WS_MODP = WS_MOD + al256((size_t)NL * 3 * 9216 * 4);
constexpr size_t WS_ROPE = WS_MODP + al256((size_t)NL * 16 * 3 * 9216 * 4);
constexpr size_t WS_TABC = WS_ROPE + 4096;
constexpr size_t WS_TABL = WS_TABC + (size_t)256 * 512 * 2;
constexpr size_t WS_WCS = WS_TABL + (size_t)2048 * 4096 * 2;
constexpr size_t WS_CCKV = WS_WCS + (size_t)256 * 128 * 2;
constexpr size_t WS_CKR = WS_CCKV + (size_t)NL * 1024 * 256 * 2;
constexpr size_t WS_CNAK = WS_CKR + (size_t)NL * 1024 * 32 * 2;
constexpr size_t WS_CNAVT = WS_CNAK + (size_t)NL * 1024 * 512 * 2;
constexpr size_t WS_W = WS_CNAVT + (size_t)NL * 1024 * 512 * 2;
constexpr size_t OFF_W13_1 = 0, OFF_W2_1 = 5767168, OFF_W13_2 = 8650752, OFF_W2_2 = 14417920, OFF_WIN = 17301504,
                 OFF_WOUT = 23330816, OFF_WBF = 24379392, OFF_WBM = 24903680, OFF_WBN = 25427968, OFF_WUQ = 25952256,
                 OFF_WUKV = 26247168, LAYER_W = 26509312;
constexpr size_t WS_R1 = WS_W + (size_t)NL * LAYER_W * 2;
constexpr size_t WS_ACT = WS_R1;
constexpr size_t WS_UF = WS_R1;
constexpr size_t WS_UQ = WS_UF + (size_t)M * 512 * 2;
constexpr size_t WS_UKV = WS_UQ + (size_t)M * 384 * 2;
constexpr size_t WS_KRF = WS_UKV + (size_t)M * 256 * 4;
constexpr size_t WS_CKV = WS_KRF + (size_t)M * 32 * 4;
constexpr size_t WS_KR = WS_CKV + (size_t)M * 256 * 2;
constexpr size_t WS_NAQ = WS_KR + (size_t)M * 32 * 2;
constexpr size_t WS_NAK = WS_NAQ + (size_t)M * 512 * 2;
constexpr size_t WS_NAVT = WS_NAK + (size_t)M * 512 * 2;
constexpr size_t WS_GATE = WS_NAVT + (size_t)M * 512 * 2;
constexpr size_t WS_Q = WS_GATE + (size_t)M * 3072 * 2;
constexpr size_t WS_KN = WS_Q + (size_t)M * 768 * 2;
constexpr size_t WS_VTM = WS_KN + (size_t)MX * 512 * 2;
constexpr size_t WS_F1T = WS_VTM + (size_t)MX * 512 * 2;
constexpr size_t WS_YF = WS_F1T + (size_t)M * 1024 * 2;
constexpr size_t WS_YM = WS_YF + (size_t)M * 512 * 2;
constexpr size_t WS_YN = WS_YM + (size_t)M * 512 * 2;
constexpr size_t WS_MERGED = WS_YN + (size_t)M * 512 * 2;
constexpr size_t WS_END = WS_MERGED + (size_t)M * 1024 * 2;
static_assert(WS_END - WS_R1 >= (size_t)M * DFF * 2, "ACT must fit in R1");
static_assert(WS_NAK - WS_UF >= (size_t)M * D * 4, "merge T32 must fit in the dead UF..NAQ buffers");

constexpr int NPHASE = 3 + 13 * NL;

struct P {
    const float* in[30];
    float* out;
    unsigned char* ws;
    int ph_lo, ph_hi;
};

__device__ __forceinline__ const float* pin(const P& p, int i) { int j = i; asm volatile("" : "+s"(j)); return p.in[j]; }
typedef __bf16 bf16v2 __attribute__((ext_vector_type(2)));
typedef float f32x2 __attribute__((ext_vector_type(2)));
DEVI unsigned pk2(float lo, float hi) { f32x2 v = {lo, hi}; bf16v2 b = __builtin_convertvector(v, bf16v2); return __builtin_bit_cast(unsigned, b); }
DEVI bf16_t f2bf(float x) { return (bf16_t)(pk2(x, 0.f) & 0xffffu); }
DEVI float bf2f(unsigned v) { return __uint_as_float(v << 16); }
DEVI float wave_sum(float v) {
#pragma unroll
    for (int o = 1; o < 64; o <<= 1) v += __shfl_xor(v, o);
    return v;
}
DEVI float fast_exp2(float x) { return __builtin_amdgcn_exp2f(x); }
DEVI float sigmoidf_(float x) { return 1.f / (1.f + __expf(-x)); }

constexpr int LDT = 72;
constexpr int TILE_E = 128 * LDT;
constexpr int SMEM_BYTES = 4 * TILE_E * 2;
constexpr int NTHREADS = 512, NWAVES = 8, LDS_TOTAL = 2 * SMEM_BYTES;

DEVI void gemm_ldg(const bf16_t* ga, const bf16_t* gb, int lda, int ldb, u32x4 (&ra)[4], u32x4 (&rb)[4]) {
#pragma unroll
    for (int i = 0; i < 4; ++i) {
        ra[i] = *(const u32x4*)(ga + (size_t)(32 * i) * lda);
        rb[i] = *(const u32x4*)(gb + (size_t)(32 * i) * ldb);
    }
}
DEVI void gemm_sts(bf16_t* buf, int soff, const u32x4 (&ra)[4], const u32x4 (&rb)[4]) {
#pragma unroll
    for (int i = 0; i < 4; ++i) {
        *(u32x4*)(buf + soff + 32 * i * LDT) = ra[i];
        *(u32x4*)(buf + TILE_E + soff + 32 * i * LDT) = rb[i];
    }
}
DEVI void gemm_mma(const bf16_t* cur, int aoff, int boff, f32x16 (&acc)[2][2]) {
#pragma unroll
    for (int ks = 0; ks < 4; ++ks) {
        bf16x8 a0 = *(const bf16x8*)(cur + aoff + ks * 16);
        bf16x8 a1 = *(const bf16x8*)(cur + aoff + 32 * LDT + ks * 16);
        bf16x8 b0 = *(const bf16x8*)(cur + boff + ks * 16);
        bf16x8 b1 = *(const bf16x8*)(cur + boff + 32 * LDT + ks * 16);
        acc[0][0] = __builtin_amdgcn_mfma_f32_32x32x16_bf16(a0, b0, acc[0][0], 0, 0, 0);
        acc[0][1] = __builtin_amdgcn_mfma_f32_32x32x16_bf16(a0, b1, acc[0][1], 0, 0, 0);
        acc[1][0] = __builtin_amdgcn_mfma_f32_32x32x16_bf16(a1, b0, acc[1][0], 0, 0, 0);
        acc[1][1] = __builtin_amdgcn_mfma_f32_32x32x16_bf16(a1, b1, acc[1][1], 0, 0, 0);
    }
}

template <bool DEEP = true>
DEVI void gemm_core(const bf16_t* __restrict__ A, int lda, const bf16_t* __restrict__ B, int ldb, int K,
                    f32x16 (&acc)[2][2], bf16_t* smem, int tid) {
    const int lane = tid & 63, wave = tid >> 6, wr = wave >> 1, wc = wave & 1;
    const int lr = tid >> 3, lc = (tid & 7) * 8;
    const bf16_t* ga = A + (size_t)lr * lda + lc;
    const bf16_t* gb = B + (size_t)lr * ldb + lc;
    const int soff = lr * LDT + lc;
    const int nk = K >> 6;
    const int aoff = (wr * 64 + (lane & 31)) * LDT + (lane >> 5) * 8;
    const int boff = TILE_E + (wc * 64 + (lane & 31)) * LDT + (lane >> 5) * 8;
    bf16_t* buf0 = smem; bf16_t* buf1 = smem + 2 * TILE_E;
    if constexpr (DEEP) {
        u32x4 ra0[4], rb0[4], ra1[4], rb1[4];
        gemm_ldg(ga, gb, lda, ldb, ra0, rb0);
        gemm_ldg(ga + 64, gb + 64, lda, ldb, ra1, rb1);
        gemm_sts(buf0, soff, ra0, rb0);
        __syncthreads();
        for (int kt = 0; kt < nk; kt += 2) {
            if (kt + 2 < nk) gemm_ldg(ga + (size_t)(kt + 2) * 64, gb + (size_t)(kt + 2) * 64, lda, ldb, ra0, rb0);
            gemm_mma(buf0, aoff, boff, acc);
            gemm_sts(buf1, soff, ra1, rb1);
            __syncthreads();
            if (kt + 3 < nk) gemm_ldg(ga + (size_t)(kt + 3) * 64, gb + (size_t)(kt + 3) * 64, lda, ldb, ra1, rb1);
            gemm_mma(buf1, aoff, boff, acc);
            if (kt + 2 < nk) gemm_sts(buf0, soff, ra0, rb0);
            __syncthreads();
        }
    } else {
        u32x4 ra[4], rb[4];
        gemm_ldg(ga, gb, lda, ldb, ra, rb);
        gemm_sts(buf0, soff, ra, rb);
        __syncthreads();
        for (int kt = 0; kt < nk; ++kt) {
            bf16_t* cur = (kt & 1) ? buf1 : buf0;
            bf16_t* nxt = (kt & 1) ? buf0 : buf1;
            const bool more = (kt + 1 < nk);
            if (more) { ga += 64; gb += 64; gemm_ldg(ga, gb, lda, ldb, ra, rb); }
            gemm_mma(cur, aoff, boff, acc);
            if (more) gemm_sts(nxt, soff, ra, rb);
            __syncthreads();
        }
    }
}

DEVI void zero_acc(f32x16 (&acc)[2][2]) {
#pragma unroll
    for (int i = 0; i < 2; ++i)
#pragma unroll
        for (int j = 0; j < 2; ++j)
#pragma unroll
            for (int r = 0; r < 16; ++r) acc[i][j][r] = 0.f;
}

#define EPI_SETUP const int lane = tid & 63, wave = tid >> 6, wr = wave >> 1, wc = wave & 1, hl = lane >> 5, c32 = lane & 31; (void)wr; (void)wc; (void)hl; (void)c32;

DEVI int mod_group(int row) { return row < NCTX ? 0 : 1 + ((row - NCTX) >> 11); }

namespace pg8 {
#define PG8_LAS __attribute__((address_space(3)))
constexpr int BM = 256, BK = 64, HALF = 128, HTB = HALF * BK * 2, NXCD = 8, WGM = 8;
DEVI int lds_byte(int r, int c) { const int st = (r >> 4) * 2 + (c >> 5), rr = r & 15, cc = c & 31, ob = rr * 64 + cc * 2; return st * 1024 + (ob ^ (((ob >> 9) & 1) << 5)); }
DEVI void stage_rc(int b, int& R, int& C) { const int st = b / 1024, sb = b % 1024, swz = sb ^ (((sb >> 9) & 1) << 5); R = (st >> 1) * 16 + swz / 64; C = (st & 1) * 32 + (swz % 64) / 2; }
DEVI int perm32(int rho) { const int n = rho >> 4, i = rho & 15; return 8 * (i >> 2) + 4 * n + (i & 3); }
struct Unit { int pm, pn; };
struct Gemm { const bf16_t* A; const bf16_t* Bt; int M, N, K; };
struct StaticOrder {
    int nM, nN, nwg, G, c;
    DEVI void init(int M, int N, int G_, int c_) { nM = M / BM; nN = N / BM; nwg = nM * nN; G = G_; c = c_; }
    DEVI bool next(int i, Unit& u) const {
        const long L = (long)i * G + c; if (L >= nwg) return false;
        int wgid = (int)L; { const int q = nwg / NXCD, r = nwg % NXCD, xcd = wgid % NXCD, off = wgid / NXCD; wgid = (xcd < r ? xcd * (q + 1) : r * (q + 1) + (xcd - r) * q) + off; }
        const int nig = WGM * nN, gid = wgid / nig, fm = gid * WGM, gsz = (nM - fm) < WGM ? (nM - fm) : WGM;
        u.pm = fm + ((wgid % nig) % gsz); u.pn = (wgid % nig) / gsz; return true;
    }
    DEVI void a_ready(const Unit&) const {}
    DEVI void done(const Unit&) const {}
};
struct InGateOrder {
    int G, c, lo, hi;
    static DEVI void so_map(int wgid, int nM, int nN, Unit& u) {
        const int nwg = nM * nN;
        { const int q = nwg / NXCD, r = nwg % NXCD, xcd = wgid % NXCD, off = wgid / NXCD; wgid = (xcd < r ? xcd * (q + 1) : r * (q + 1) + (xcd - r) * q) + off; }
        const int nig = WGM * nN, gid = wgid / nig, fm = gid * WGM, gsz = (nM - fm) < WGM ? (nM - fm) : WGM;
        u.pm = fm + ((wgid % nig) % gsz); u.pn = (wgid % nig) / gsz;
    }
    DEVI bool next(int i, Unit& u) const {
        const long L = (long)i * G + c + lo; if (L >= hi) return false;
        if (L < 528) so_map((int)L, 48, 11, u); else { so_map((int)L - 528, 48, 12, u); u.pn += 11; }
        return true;
    }
    DEVI void a_ready(const Unit&) const {}
    DEVI void done(const Unit&) const {}
};
template <class Epi, class Sched, bool ALIGN_EPI = false, bool SP2 = false>
DEVI void gemm_phase(PG8_LAS unsigned char* lds, const Gemm g, const Sched& S, const Epi& E, const int tid) {
    const int wid = __builtin_amdgcn_readfirstlane(tid >> 6), lane = tid & 63, wr = wid >> 2, wc = wid & 3, fr = lane & 15, fq = lane >> 4;
    const int K = g.K, nt = K / BK;
    unsigned voffA[2], voffB[2];
#pragma unroll
    for (int i = 0; i < 2; ++i) { int R, C; stage_rc(tid * 16 + i * 8192, R, C); const int Rb = Epi::PERM ? ((R & ~31) + perm32(R & 31)) : R;
        voffA[i] = (unsigned)(R * K + C) * 2u; voffB[i] = (unsigned)(Rb * K + C) * 2u; }
    const size_t kstep = (size_t)(BK * 2);
    const size_t hstep = (size_t)HALF * K * 2;
    const size_t tstep = 2 * hstep;
    const unsigned ldsw = (unsigned)wid * 1024u;
    const int aoff = lds_byte(wr * 64 + fr, fq * 8), boff = lds_byte(wc * 32 + fr, fq * 8);
#define PG8_SA(b, h) (((b) * 2 + (h)) * HTB)
#define PG8_SB(b, h) ((4 + (b) * 2 + (h)) * HTB)
#define PG8_STAGE(bufoff, gbase, voff) do { _Pragma("unroll") for (int _i = 0; _i < 2; ++_i) \
        __builtin_amdgcn_global_load_lds((const unsigned*)((const char*)(gbase) + (voff)[_i]), (PG8_LAS unsigned*)(lds + (bufoff) + ldsw + _i * 8192), 16, 0, 0); } while (0)
#define PG8_LDA(dst, b, h) do { _Pragma("unroll") for (int m = 0; m < 4; ++m) _Pragma("unroll") for (int k = 0; k < 2; ++k) dst[m][k] = *(const PG8_LAS bf16x8*)(lds + PG8_SA(b, h) + aoff + m * 2048 + k * 1024); } while (0)
#define PG8_LDB(dst, b, h) do { _Pragma("unroll") for (int n = 0; n < 2; ++n) _Pragma("unroll") for (int k = 0; k < 2; ++k) dst[n][k] = *(const PG8_LAS bf16x8*)(lds + PG8_SB(b, h) + boff + n * 2048 + k * 1024); } while (0)
#define PG8_MMA(ai, bj, At, Bt) do { __builtin_amdgcn_s_setprio(1); _Pragma("unroll") for (int m = 0; m < 4; ++m) _Pragma("unroll") for (int n = 0; n < 2; ++n) _Pragma("unroll") for (int k = 0; k < 2; ++k) \
        acc[ai][bj][m][n] = __builtin_amdgcn_mfma_f32_16x16x32_bf16(Bt[n][k], At[m][k], acc[ai][bj][m][n], 0, 0, 0); __builtin_amdgcn_s_setprio(0); } while (0)
#define PG8_WAIT_V(n) asm volatile("s_waitcnt vmcnt(" #n ")" ::: "memory")
#define PG8_WAIT_L(n) asm volatile("s_waitcnt lgkmcnt(" #n ")" ::: "memory")
#define PG8_BAR __builtin_amdgcn_s_barrier()
#define PG8_SCHED __builtin_amdgcn_sched_barrier(0)
    Unit cur, nxt; int ui = 0;
    if (!S.next(0, cur)) return;
    f32x4 acc[2][2][4][2];
#pragma unroll
    for (int a = 0; a < 2; ++a)
#pragma unroll
        for (int b = 0; b < 2; ++b)
#pragma unroll
            for (int m = 0; m < 4; ++m)
#pragma unroll
                for (int n = 0; n < 2; ++n) acc[a][b][m][n] = (f32x4){0.f, 0.f, 0.f, 0.f};
    bf16x8 At[4][2], B0[2][2], B1[2][2];
    const char* cA = (const char*)g.A + (size_t)cur.pm * tstep; const char* cB = (const char*)g.Bt + (size_t)cur.pn * tstep;
    S.a_ready(cur);
    if constexpr (SP2) {
        PG8_STAGE(PG8_SB(0, 0), cB, voffB); PG8_STAGE(PG8_SB(0, 1), cB + hstep, voffB); PG8_STAGE(PG8_SA(0, 0), cA, voffA); PG8_STAGE(PG8_SA(0, 1), cA + hstep, voffA);
        if (wr == 1) PG8_BAR;
        PG8_WAIT_V(2); PG8_BAR;
        PG8_STAGE(PG8_SB(1, 0), cB + kstep, voffB); PG8_STAGE(PG8_SA(1, 0), cA + kstep, voffA); PG8_STAGE(PG8_SB(1, 1), cB + hstep + kstep, voffB);
        PG8_WAIT_V(6); PG8_BAR;
    } else {
        PG8_STAGE(PG8_SB(0, 0), cB, voffB); PG8_STAGE(PG8_SA(0, 0), cA, voffA); PG8_STAGE(PG8_SB(0, 1), cB + hstep, voffB); PG8_STAGE(PG8_SA(0, 1), cA + hstep, voffA);
        if (wr == 1) PG8_BAR;
        PG8_WAIT_V(4); PG8_BAR;
        PG8_STAGE(PG8_SB(1, 0), cB + kstep, voffB); PG8_STAGE(PG8_SA(1, 0), cA + kstep, voffA); PG8_STAGE(PG8_SB(1, 1), cB + hstep + kstep, voffB);
        PG8_WAIT_V(6); PG8_BAR;
    }
    for (;;) {
        const bool has_next = S.next(ui + 1, nxt);
        const char* nA = has_next ? (const char*)g.A + (size_t)nxt.pm * tstep : cA; const char* nB = has_next ? (const char*)g.Bt + (size_t)nxt.pn * tstep : cB;
        for (int t = 0; t < nt; t += 2) {
            const bool last = (t == nt - 2);
            const char* a1 = cA + (size_t)(t + 1) * kstep;
            const char* a2 = last ? nA : cA + (size_t)(t + 2) * kstep; const char* b2 = last ? nB : cB + (size_t)(t + 2) * kstep;
            const char* a3 = a2 + kstep; const char* b3 = b2 + kstep;
            if (last && has_next) S.a_ready(nxt);
            if constexpr (SP2) {
            PG8_LDB(B0, 0, 0); PG8_LDB(B1, 0, 1); PG8_SCHED; PG8_LDA(At, 0, 0); PG8_STAGE(PG8_SA(1, 1), a1 + hstep, voffA);
            PG8_WAIT_V(8); PG8_WAIT_L(0); PG8_BAR; PG8_MMA(0, 0, At, B0); PG8_MMA(0, 1, At, B1); PG8_BAR; PG8_SCHED;
            PG8_LDA(At, 0, 1); PG8_STAGE(PG8_SB(0, 0), b2, voffB); PG8_STAGE(PG8_SB(0, 1), b2 + hstep, voffB); PG8_STAGE(PG8_SA(0, 0), a2, voffA);
            PG8_WAIT_V(8); PG8_WAIT_L(0); PG8_BAR; PG8_MMA(1, 0, At, B0); PG8_MMA(1, 1, At, B1); PG8_BAR; PG8_SCHED;
            PG8_LDB(B0, 1, 0); PG8_LDB(B1, 1, 1); PG8_SCHED; PG8_LDA(At, 1, 0); PG8_STAGE(PG8_SA(0, 1), a2 + hstep, voffA);
            PG8_WAIT_V(8); PG8_WAIT_L(0); PG8_BAR; PG8_MMA(0, 0, At, B0); PG8_MMA(0, 1, At, B1); PG8_BAR; PG8_SCHED;
            PG8_LDA(At, 1, 1); PG8_STAGE(PG8_SB(1, 0), b3, voffB); PG8_STAGE(PG8_SB(1, 1), b3 + hstep, voffB); PG8_STAGE(PG8_SA(1, 0), a3, voffA);
            PG8_WAIT_V(8); PG8_WAIT_L(0); PG8_BAR; PG8_MMA(1, 0, At, B0); PG8_MMA(1, 1, At, B1); PG8_BAR; PG8_SCHED;
            } else {
            PG8_LDB(B0, 0, 0); PG8_SCHED; PG8_LDA(At, 0, 0); PG8_STAGE(PG8_SA(1, 1), a1 + hstep, voffA);
            PG8_WAIT_L(8); PG8_BAR; PG8_WAIT_L(0); PG8_MMA(0, 0, At, B0); PG8_BAR; PG8_SCHED;
            PG8_LDB(B1, 0, 1); PG8_STAGE(PG8_SB(0, 0), b2, voffB);
            PG8_BAR; PG8_WAIT_L(0); PG8_MMA(0, 1, At, B1); PG8_BAR;
            PG8_LDA(At, 0, 1); PG8_STAGE(PG8_SA(0, 0), a2, voffA);
            PG8_BAR; PG8_WAIT_L(0); PG8_MMA(1, 0, At, B0); PG8_BAR; PG8_SCHED;
            PG8_STAGE(PG8_SB(0, 1), b2 + hstep, voffB);
            PG8_WAIT_V(6); PG8_BAR; PG8_MMA(1, 1, At, B1); PG8_BAR;
            PG8_LDB(B0, 1, 0); PG8_SCHED; PG8_LDA(At, 1, 0); PG8_STAGE(PG8_SA(0, 1), a2 + hstep, voffA);
            PG8_WAIT_L(8); PG8_BAR; PG8_WAIT_L(0); PG8_MMA(0, 0, At, B0); PG8_BAR; PG8_SCHED;
            PG8_LDB(B1, 1, 1); PG8_STAGE(PG8_SB(1, 0), b3, voffB);
            PG8_BAR; PG8_WAIT_L(0); PG8_MMA(0, 1, At, B1); PG8_BAR;
            PG8_LDA(At, 1, 1); PG8_STAGE(PG8_SA(1, 0), a3, voffA);
            PG8_BAR; PG8_WAIT_L(0); PG8_MMA(1, 0, At, B0); PG8_BAR; PG8_SCHED;
            PG8_STAGE(PG8_SB(1, 1), b3 + hstep, voffB);
            PG8_WAIT_V(6); PG8_BAR; PG8_MMA(1, 1, At, B1); PG8_BAR;
            }
        }
        if constexpr (ALIGN_EPI) { if (wr == 0) PG8_BAR; }
        E(acc, cur, wr, wc, fr, fq); S.done(cur);
        if (!has_next) break;
#pragma unroll
        for (int a = 0; a < 2; ++a)
#pragma unroll
            for (int b = 0; b < 2; ++b)
#pragma unroll
                for (int m = 0; m < 4; ++m)
#pragma unroll
                    for (int n = 0; n < 2; ++n) acc[a][b][m][n] = (f32x4){0.f, 0.f, 0.f, 0.f};
        cur = nxt; cA = nA; cB = nB; ++ui;
        if constexpr (ALIGN_EPI) { if (wr == 1) PG8_BAR; }
    }
    PG8_WAIT_V(0);
    if constexpr (!ALIGN_EPI) { if (wr == 0) PG8_BAR; }
    PG8_BAR;
#undef PG8_SA
#undef PG8_SB
#undef PG8_STAGE
#undef PG8_LDA
#undef PG8_LDB
#undef PG8_MMA
#undef PG8_WAIT_V
#undef PG8_WAIT_L
#undef PG8_BAR
#undef PG8_SCHED
}

struct EpiSwiGLU {
    static constexpr bool PERM = false;
    bf16_t* ACT;
    DEVI void operator()(const f32x4 (&acc)[2][2][4][2], const Unit& u, int wr, int wc, int fr, int fq) const {
#pragma unroll
        for (int ai = 0; ai < 2; ++ai)
#pragma unroll
            for (int m = 0; m < 4; ++m) {
                const int row = u.pm * BM + ai * HALF + wr * 64 + m * 16 + fr;
                bf16_t* rp = ACT + (size_t)row * DFF + 16 * (8 * u.pn + wc) + 4 * fq;
#pragma unroll
                for (int bj = 0; bj < 2; ++bj) {
                    const f32x4 a = acc[ai][bj][m][0], b = acc[ai][bj][m][1];
                    u32x2 pk;
                    pk.x = pk2(a[0] * sigmoidf_(a[0]) * b[0], a[1] * sigmoidf_(a[1]) * b[1]);
                    pk.y = pk2(a[2] * sigmoidf_(a[2]) * b[2], a[3] * sigmoidf_(a[3]) * b[3]);
                    *(u32x2*)(rp + 64 * bj) = pk;
                }
            }
    }
};
struct EpiResid {
    static constexpr bool PERM = false;
    float* X; const float* gate_base; float coef;
    DEVI void operator()(const f32x4 (&acc)[2][2][4][2], const Unit& u, int wr, int wc, int fr_, int fq_) const {
        int fr = fr_, fq = fq_; asm volatile("" : "+v"(fr), "+v"(fq));
        const float* gate = gate_base + (size_t)mod_group(u.pm * BM) * 9216;
        const int col0 = u.pn * BM + wc * 32 + 4 * fq;
        f32x4 gv[2][2];
#pragma unroll
        for (int bj = 0; bj < 2; ++bj)
#pragma unroll
            for (int n = 0; n < 2; ++n) gv[bj][n] = *(const f32x4*)(gate + col0 + bj * HALF + 16 * n) * coef;
#pragma unroll
        for (int ah = 0; ah < 4; ++ah) {
            const int ai = ah >> 1, mb = (ah & 1) * 2;
            f32x4 xv[4][2][2];
#pragma unroll
            for (int m = mb; m < mb + 2; ++m)
#pragma unroll
                for (int bj = 0; bj < 2; ++bj)
#pragma unroll
                    for (int n = 0; n < 2; ++n)
                        xv[m][bj][n] = *(const f32x4*)(X + (size_t)(u.pm * BM + ai * HALF + wr * 64 + m * 16 + fr) * D + col0 + bj * HALF + 16 * n);
            __builtin_amdgcn_sched_barrier(0);
#pragma unroll
            for (int m = mb; m < mb + 2; ++m)
#pragma unroll
                for (int bj = 0; bj < 2; ++bj)
#pragma unroll
                    for (int n = 0; n < 2; ++n)
                        *(f32x4*)(X + (size_t)(u.pm * BM + ai * HALF + wr * 64 + m * 16 + fr) * D + col0 + bj * HALF + 16 * n) =
                            xv[m][bj][n] * ALPHA_F + gv[bj][n] * acc[ai][bj][m][n];
            __builtin_amdgcn_sched_barrier(0);
        }
    }
};
struct EpiIn {
    static constexpr bool PERM = true;
    unsigned char* ws; float* out; const float* b_gate; int l;
    static DEVI u32x4 pack8(const f32x4& a, const f32x4& b, float s) {
        u32x4 w; w.x = pk2(a[0] * s, a[1] * s); w.y = pk2(a[2] * s, a[3] * s); w.z = pk2(b[0] * s, b[1] * s); w.w = pk2(b[2] * s, b[3] * s); return w;
    }
    DEVI void operator()(const f32x4 (&acc)[2][2][4][2], const Unit& u, int wr, int wc, int fr_, int fq_) const {
        int fr = fr_, fq = fq_; asm volatile("" : "+v"(fr), "+v"(fq));
        unsigned char* ws = this->ws; float* out = this->out; const float* b_gate = this->b_gate;
        asm volatile("" : "+s"(ws), "+s"(out), "+s"(b_gate));
        const bool ctx = u.pm * BM < NCTX;
#pragma unroll
        for (int bj = 0; bj < 2; ++bj) {
            const int n0 = u.pn * BM + bj * HALF;
            const int c8 = n0 + wc * 32 + 8 * fq;
            f32x4 bg0 = (f32x4){0.f, 0.f, 0.f, 0.f}, bg1 = bg0;
            if (n0 >= 2816) { bg0 = *(const f32x4*)(b_gate + l * 3072 + c8 - 2816); bg1 = *(const f32x4*)(b_gate + l * 3072 + c8 - 2816 + 4); }
#pragma unroll
            for (int ai = 0; ai < 2; ++ai)
#pragma unroll
                for (int m = 0; m < 4; ++m) {
                    const int row = u.pm * BM + ai * HALF + wr * 64 + m * 16 + fr;
                    const f32x4 v0 = acc[ai][bj][m][0], v1 = acc[ai][bj][m][1];
                    if (n0 < 512) {
                        *(u32x4*)((bf16_t*)(ws + WS_UF) + (size_t)row * 512 + c8) = pack8(v0, v1, 1.f);
                    } else if (n0 < 896) {
                        *(u32x4*)((bf16_t*)(ws + WS_UQ) + (size_t)row * 384 + (c8 - 512)) = pack8(v0, v1, 1.f);
                    } else if (n0 < 1152) {
                        float* o = (float*)(ws + WS_UKV) + (size_t)row * 256 + (c8 - 896);
                        *(f32x4*)o = v0; *(f32x4*)(o + 4) = v1;
                    } else if (n0 < 1280) {
                        if (wc == 0) { float* o = (float*)(ws + WS_KRF) + (size_t)row * 32 + 8 * fq; *(f32x4*)o = v0; *(f32x4*)(o + 4) = v1; }
                    } else if (n0 < 1792) {
                        *(u32x4*)((bf16_t*)(ws + WS_NAQ) + (size_t)row * 512 + (c8 - 1280)) = pack8(v0, v1, NA_QS);
                    } else if (n0 < 2304) {
                        const int cc = c8 - 1792;
                        *(u32x4*)((bf16_t*)(ws + WS_NAK) + (size_t)row * 512 + cc) = pack8(v0, v1, 1.f);
                        if (ctx) { float* o = out + OUT_NAK + ((size_t)((row >> 8) * 4 + l) * 256 + (row & 255)) * 512 + cc; *(f32x4*)o = v0; *(f32x4*)(o + 4) = v1; }
                    } else if (n0 < 2816) {
                        const int cc = c8 - 2304, h = cc >> 6, d0 = cc & 63;
                        bf16_t* VT = (bf16_t*)(ws + WS_NAVT);
                        bf16_t* vp;
                        size_t cstride;
                        if (ctx) {
                            const int b = row >> 8, s = row & 255;
                            float* o = out + OUT_NAV + ((size_t)(b * 4 + l) * 256 + s) * 512 + cc; *(f32x4*)o = v0; *(f32x4*)(o + 4) = v1;
                            vp = VT + ((size_t)((b * 8 + h) * 64 + d0)) * 256 + s; cstride = 256;
                        } else {
                            const int rr = row - NCTX, b = rr >> 11, n = rr & 2047;
                            vp = VT + (size_t)4194304 + ((size_t)((b * 8 + h) * 64 + d0)) * 2048 + n; cstride = 2048;
                        }
#pragma unroll
                        for (int e = 0; e < 4; ++e) { vp[(size_t)e * cstride] = f2bf(v0[e]); vp[(size_t)(4 + e) * cstride] = f2bf(v1[e]); }
                    } else {
                        f32x4 g0, g1;
#pragma unroll
                        for (int e = 0; e < 4; ++e) { g0[e] = sigmoidf_(v0[e] + bg0[e]); g1[e] = sigmoidf_(v1[e] + bg1[e]); }
                        *(u32x4*)((bf16_t*)(ws + WS_GATE) + (size_t)row * 3072 + (c8 - 2816)) = pack8(g0, g1, 1.f);
                    }
                    __builtin_amdgcn_sched_barrier(0);
                }
        }
    }
};
struct EpiMerge {
    static constexpr bool PERM = true;
    const bf16_t* GATE; bf16_t* T; bf16_t* MG; int s;
    DEVI void operator()(const f32x4 (&acc)[2][2][4][2], const Unit& u, int wr, int wc, int fr_, int fq_) const {
        int fr = fr_, fq = fq_; asm volatile("" : "+v"(fr), "+v"(fq));
#pragma unroll
        for (int ah = 0; ah < 4; ++ah) {
            const int ai = ah >> 1, mb = (ah & 1) * 2;
            u32x4 gv[4][2], tv[4][2];
#pragma unroll
            for (int m = mb; m < mb + 2; ++m)
#pragma unroll
                for (int bj = 0; bj < 2; ++bj) {
                    const int row = u.pm * BM + ai * HALF + wr * 64 + m * 16 + fr;
                    const int c8 = u.pn * BM + bj * HALF + wc * 32 + 8 * fq;
                    gv[m][bj] = *(const u32x4*)(GATE + (size_t)row * 3072 + s * 1024 + c8);
                    if (s > 0) tv[m][bj] = *(const u32x4*)(T + (size_t)row * D + c8);
                }
            __builtin_amdgcn_sched_barrier(0);
#pragma unroll
            for (int m = mb; m < mb + 2; ++m)
#pragma unroll
                for (int bj = 0; bj < 2; ++bj) {
                    const int row = u.pm * BM + ai * HALF + wr * 64 + m * 16 + fr;
                    const int c8 = u.pn * BM + bj * HALF + wc * 32 + 8 * fq;
                    const u32x4 g = gv[m][bj];
                    f32x4 v0 = acc[ai][bj][m][0], v1 = acc[ai][bj][m][1];
                    v0[0] *= bf2f(g.x & 0xffffu); v0[1] *= bf2f(g.x >> 16); v0[2] *= bf2f(g.y & 0xffffu); v0[3] *= bf2f(g.y >> 16);
                    v1[0] *= bf2f(g.z & 0xffffu); v1[1] *= bf2f(g.z >> 16); v1[2] *= bf2f(g.w & 0xffffu); v1[3] *= bf2f(g.w >> 16);
                    if (s > 0) {
                        const u32x4 t = tv[m][bj];
                        v0[0] += bf2f(t.x & 0xffffu); v0[1] += bf2f(t.x >> 16); v0[2] += bf2f(t.y & 0xffffu); v0[3] += bf2f(t.y >> 16);
                        v1[0] += bf2f(t.z & 0xffffu); v1[1] += bf2f(t.z >> 16); v1[2] += bf2f(t.w & 0xffffu); v1[3] += bf2f(t.w >> 16);
                    }
                    *(u32x4*)((s < 2 ? T : MG) + (size_t)row * D + c8) = EpiIn::pack8(v0, v1, 1.f);
                }
            __builtin_amdgcn_sched_barrier(0);
        }
    }
};
}

DEVI void job_ffn_up(const P& p, unsigned char* ws_b, int l, int which, int t, bf16_t* sm, int tid) {
    const int nN = 44; const int m0 = (t / nN) * 128, n0 = (t % nN) * 128;
    const bf16_t* H = (const bf16_t*)(ws_b + WS_H);
    const bf16_t* W = (const bf16_t*)(ws_b + WS_W) + (size_t)l * LAYER_W + (which ? OFF_W13_2 : OFF_W13_1);
    bf16_t* ACT = (bf16_t*)(ws_b + WS_ACT);
    f32x16 acc[2][2]; zero_acc(acc);
    gemm_core(H + (size_t)m0 * D, D, W + (size_t)n0 * D, D, D, acc, sm, tid);
    EPI_SETUP
    const int oc = (n0 >> 1) + wc * 32 + c32;
#pragma unroll
    for (int i = 0; i < 2; ++i) {
        const int rb = m0 + wr * 64 + i * 32 + 4 * hl;
#pragma unroll
        for (int r = 0; r < 16; ++r) {
            const int row = rb + (r & 3) + 8 * (r >> 2);
            const float a = acc[i][0][r], b = acc[i][1][r];
            const float v = a * sigmoidf_(a) * b;
            ACT[(size_t)row * DFF + oc] = f2bf(v);
        }
    }
}

DEVI void job_resid(const P& p, unsigned char* ws_b, const bf16_t* A, int lda, const bf16_t* Bt, int K, const float* gate_base, float coef, int t, bf16_t* sm, int tid) {
    const int nN = 8; const int m0 = (t / nN) * 128, n0 = (t % nN) * 128;
    float* X = (float*)(ws_b + WS_X);
    f32x16 acc[2][2]; zero_acc(acc);
    gemm_core(A + (size_t)m0 * lda, lda, Bt + (size_t)n0 * K, K, K, acc, sm, tid);
    EPI_SETUP
    const float* gate = gate_base + (size_t)mod_group(m0) * 9216;
#pragma unroll
    for (int j = 0; j < 2; ++j) {
        const int col = n0 + wc * 64 + j * 32 + c32;
        const float gv = coef * gate[col];
#pragma unroll
        for (int i = 0; i < 2; ++i) {
            const int rb = m0 + wr * 64 + i * 32 + 4 * hl;
#pragma unroll
            for (int r = 0; r < 16; ++r) {
                const int row = rb + (r & 3) + 8 * (r >> 2);
                float* xp = X + (size_t)row * D + col;
                *xp = ALPHA_F * (*xp) + gv * acc[i][j][r];
            }
        }
    }
}

DEVI void job_in(const P& p, unsigned char* ws_b, int l, int t, bf16_t* sm, int tid) {
    const int nN = 46; const int m0 = (t / nN) * 128, n0 = (t % nN) * 128;
    const bf16_t* H = (const bf16_t*)(ws_b + WS_H);
    const bf16_t* W = (const bf16_t*)(ws_b + WS_W) + (size_t)l * LAYER_W + OFF_WIN;
    f32x16 acc[2][2]; zero_acc(acc);
    gemm_core(H + (size_t)m0 * D, D, W + (size_t)n0 * D, D, D, acc, sm, tid);
    EPI_SETUP
    const bool ctx = m0 < NCTX;
#pragma unroll
    for (int j = 0; j < 2; ++j) {
        const int col = n0 + wc * 64 + j * 32 + c32;
#pragma unroll
        for (int i = 0; i < 2; ++i) {
            const int rb = m0 + wr * 64 + i * 32 + 4 * hl;
            if (n0 < 512) {
                bf16_t* O = (bf16_t*)(ws_b + WS_UF);
#pragma unroll
                for (int r = 0; r < 16; ++r) O[(size_t)(rb + (r & 3) + 8 * (r >> 2)) * 512 + col] = f2bf(acc[i][j][r]);
            } else if (n0 < 896) {
                bf16_t* O = (bf16_t*)(ws_b + WS_UQ);
#pragma unroll
                for (int r = 0; r < 16; ++r) O[(size_t)(rb + (r & 3) + 8 * (r >> 2)) * 384 + (col - 512)] = f2bf(acc[i][j][r]);
            } else if (n0 < 1152) {
                float* O = (float*)(ws_b + WS_UKV);
#pragma unroll
                for (int r = 0; r < 16; ++r) O[(size_t)(rb + (r & 3) + 8 * (r >> 2)) * 256 + (col - 896)] = acc[i][j][r];
            } else if (n0 < 1280) {
                if (col < 1184) {
                    float* O = (float*)(ws_b + WS_KRF);
#pragma unroll
                    for (int r = 0; r < 16; ++r) O[(size_t)(rb + (r & 3) + 8 * (r >> 2)) * 32 + (col - 1152)] = acc[i][j][r];
                }
            } else if (n0 < 1792) {
                bf16_t* O = (bf16_t*)(ws_b + WS_NAQ);
#pragma unroll
                for (int r = 0; r < 16; ++r) O[(size_t)(rb + (r & 3) + 8 * (r >> 2)) * 512 + (col - 1280)] = f2bf(acc[i][j][r] * NA_QS);
            } else if (n0 < 2304) {
                bf16_t* O = (bf16_t*)(ws_b + WS_NAK);
                const int cc = col - 1792;
#pragma unroll
                for (int r = 0; r < 16; ++r) {
                    const int row = rb + (r & 3) + 8 * (r >> 2);
                    O[(size_t)row * 512 + cc] = f2bf(acc[i][j][r]);
                    if (ctx) p.out[OUT_NAK + ((size_t)((row >> 8) * 4 + l) * 256 + (row & 255)) * 512 + cc] = acc[i][j][r];
                }
            } else if (n0 < 2816) {
                bf16_t* VT = (bf16_t*)(ws_b + WS_NAVT);
                const int cc = col - 2304, h = cc >> 6, d = cc & 63;
#pragma unroll
                for (int qd = 0; qd < 4; ++qd) {
                    const int row = rb + 8 * qd;
                    u32x2 pk; pk.x = pk2(acc[i][j][4 * qd], acc[i][j][4 * qd + 1]); pk.y = pk2(acc[i][j][4 * qd + 2], acc[i][j][4 * qd + 3]);
                    if (ctx) {
                        const int b = row >> 8, s = row & 255;
                        *(u32x2*)(VT + ((size_t)((b * 8 + h) * 64 + d)) * 256 + s) = pk;
#pragma unroll
                        for (int e = 0; e < 4; ++e)
                            p.out[OUT_NAV + ((size_t)(b * 4 + l) * 256 + (s + e)) * 512 + cc] = acc[i][j][4 * qd + e];
                    } else {
                        const int rr = row - NCTX, b = rr >> 11, n = rr & 2047;
                        *(u32x2*)(VT + (size_t)4194304 + ((size_t)((b * 8 + h) * 64 + d)) * 2048 + n) = pk;
                    }
                }
            } else {
                bf16_t* O = (bf16_t*)(ws_b + WS_GATE);
                const int gc = col - 2816;
                const float bg = pin(p, 26)[l * 3072 + gc];
                bf16_t* gp = O + (size_t)gc * M + rb;
#pragma unroll
                for (int qd = 0; qd < 4; ++qd) {
                    u32x2 pk;
                    pk.x = pk2(sigmoidf_(acc[i][j][4 * qd] + bg), sigmoidf_(acc[i][j][4 * qd + 1] + bg));
                    pk.y = pk2(sigmoidf_(acc[i][j][4 * qd + 2] + bg), sigmoidf_(acc[i][j][4 * qd + 3] + bg));
                    *(u32x2*)(gp + 8 * qd) = pk;
                }
            }
        }
    }
}

DEVI void job_uq(const P& p, unsigned char* ws_b, int l, int t, bf16_t* sm, int tid) {
    const int nN = 6; const int m0 = (t / nN) * 128, n0 = (t % nN) * 128;
    const bf16_t* A = (const bf16_t*)(ws_b + WS_UQ);
    const bf16_t* W = (const bf16_t*)(ws_b + WS_W) + (size_t)l * LAYER_W + OFF_WUQ;
    bf16_t* Q = (bf16_t*)(ws_b + WS_Q);
    const float* ropec = (const float*)(ws_b + WS_ROPE);
    const float* ropes = ropec + 512;
    f32x16 acc[2][2]; zero_acc(acc);
    gemm_core(A + (size_t)m0 * 384, 384, W + (size_t)n0 * 384, 384, 384, acc, sm, tid);
    EPI_SETUP
    const bool lat = m0 >= NCTX;
#pragma unroll
    for (int j = 0; j < 2; ++j) {
        const int c0 = n0 + wc * 64 + j * 32;
        const int col = c0 + c32;
        const bool rope = lat && (((c0 >> 5) % 3) == 2);
        const int axis = c32 >> 4, ii = c32 & 15;
#pragma unroll
        for (int i = 0; i < 2; ++i) {
            const int rb = m0 + wr * 64 + i * 32 + 4 * hl;
#pragma unroll
            for (int r = 0; r < 16; ++r) {
                const int row = rb + (r & 3) + 8 * (r >> 2);
                float v = acc[i][j][r];
                const float pr = __shfl_xor(v, 8);
                if (rope) {
                    const int n = (row - NCTX) & 2047;
                    const int pos = axis ? (n & 63) : (n >> 6);
                    const float cs = ropec[pos * 8 + (ii & 7)], sn = ropes[pos * 8 + (ii & 7)];
                    const float rot = (ii < 8) ? -pr : pr;
                    v = v * cs + rot * sn;
                }
                Q[(size_t)row * 768 + col] = f2bf(v * MLA_QS);
            }
        }
    }
}

DEVI void job_ukv(const P& p, unsigned char* ws_b, int l, int t, bf16_t* sm, int tid) {
    const int nN = 8; const int m0 = (t / nN) * 128, h = t % nN, n0 = h * 128;
    const bf16_t* A = (m0 < M) ? (const bf16_t*)(ws_b + WS_CKV) + (size_t)m0 * 256
                               : (const bf16_t*)(ws_b + WS_CCKV) + ((size_t)l * 1024 + (m0 - M)) * 256;
    const bf16_t* W = (const bf16_t*)(ws_b + WS_W) + (size_t)l * LAYER_W + OFF_WUKV;
    bf16_t* KN = (bf16_t*)(ws_b + WS_KN);
    bf16_t* VT = (bf16_t*)(ws_b + WS_VTM);
    f32x16 acc[2][2]; zero_acc(acc);
    gemm_core(A, 256, W + (size_t)n0 * 256, 256, 256, acc, sm, tid);
    EPI_SETUP
#pragma unroll
    for (int j = 0; j < 2; ++j) {
        const int d = j * 32 + c32;
#pragma unroll
        for (int i = 0; i < 2; ++i) {
            const int rb = m0 + wr * 64 + i * 32 + 4 * hl;
            if (wc == 0) {
#pragma unroll
                for (int r = 0; r < 16; ++r) KN[(size_t)(rb + (r & 3) + 8 * (r >> 2)) * 512 + h * 64 + d] = f2bf(acc[i][j][r]);
            } else {
#pragma unroll
                for (int qd = 0; qd < 4; ++qd) {
                    const int row = rb + 8 * qd;
                    u32x2 pk; pk.x = pk2(acc[i][j][4 * qd], acc[i][j][4 * qd + 1]); pk.y = pk2(acc[i][j][4 * qd + 2], acc[i][j][4 * qd + 3]);
                    size_t addr;
                    if (m0 < NCTX) { const int b = row >> 8, s = row & 255; addr = ((size_t)((b * 8 + h) * 64 + d)) * 256 + s; }
                    else if (m0 < M) { const int rr = row - NCTX, b = rr >> 11, n = rr & 2047; addr = (size_t)4194304 + ((size_t)((b * 8 + h) * 64 + d)) * 2560 + n; }
                    else { const int rr = row - M, b = rr >> 9, n = rr & 511; addr = (size_t)4194304 + ((size_t)((b * 8 + h) * 64 + d)) * 2560 + 2048 + n; }
                    *(u32x2*)(VT + addr) = pk;
                }
            }
        }
    }
}

template <int ldo, bool SPLITK = false>
DEVI void job_store(const bf16_t* A, int lda, const bf16_t* Bt, int ldb, int K, bf16_t* Out, bf16_t* sm, int tid, int grp = 0, float* xch = nullptr) {
    f32x16 acc[2][2]; zero_acc(acc);
    if constexpr (SPLITK) { K >>= 1; A += grp * K; Bt += grp * K; }
    gemm_core(A, lda, Bt, ldb, K, acc, sm, tid);
    EPI_SETUP
    if constexpr (SPLITK) {
        if (grp == 1) {
#pragma unroll
            for (int i = 0; i < 2; ++i)
#pragma unroll
                for (int j = 0; j < 2; ++j)
#pragma unroll
                    for (int r = 0; r < 16; ++r) xch[((i * 2 + j) * 16 + r) * 256 + tid] = acc[i][j][r];
        }
        __syncthreads();
        if (grp == 0) {
#pragma unroll
            for (int i = 0; i < 2; ++i)
#pragma unroll
                for (int j = 0; j < 2; ++j)
#pragma unroll
                    for (int r = 0; r < 16; ++r) acc[i][j][r] += xch[((i * 2 + j) * 16 + r) * 256 + tid];
        }
        __syncthreads();
    }
    const bool active = !SPLITK || grp == 0;
    bf16_t* st = sm + (wr * 64 + 4 * hl) * 136 + wc * 64 + c32;
    if (active) {
#pragma unroll
        for (int i = 0; i < 2; ++i)
#pragma unroll
            for (int j = 0; j < 2; ++j)
#pragma unroll
                for (int r = 0; r < 16; ++r) st[(i * 32 + (r & 3) + 8 * (r >> 2)) * 136 + j * 32] = f2bf(acc[i][j][r]);
    }
    __syncthreads();
    if (active) {
        const int orow = tid >> 4, oc = (tid & 15) * 8;
#pragma unroll
        for (int k = 0; k < 8; ++k) {
            const u32x4 v = *(const u32x4*)(sm + (orow + 16 * k) * 136 + oc);
            *(u32x4*)(Out + (size_t)(orow + 16 * k) * ldo + oc) = v;
        }
    }
    __syncthreads();
}

DEVI void job_f1(const P& p, unsigned char* ws_b, int t, bf16_t* sm, int tid) {
    const bf16_t* WCS = (const bf16_t*)(ws_b + WS_WCS);
    const bf16_t* UF = (const bf16_t*)(ws_b + WS_UF);
    bf16_t* F1T = (bf16_t*)(ws_b + WS_F1T);
    if (t < 512) {
        const int bs = t >> 4, g = (t >> 2) & 3, mi = (t >> 1) & 1, ni = t & 1;
        job_store<256>(WCS + mi * 128 * 128, 128, UF + ((size_t)bs * 256 + ni * 128) * 512 + g * 128, 512, 128,
                  F1T + ((size_t)(bs * 4 + g) * 256 + mi * 128) * 256 + ni * 128, sm, tid);
    } else {
        t -= 512;
        const int bs = t >> 7, g = (t >> 5) & 3, mi = (t >> 4) & 1, ni = t & 15;
        job_store<2048>(WCS + mi * 128 * 128, 128, UF + ((size_t)NCTX + bs * 2048 + ni * 128) * 512 + g * 128, 512, 128,
                  F1T + (size_t)8388608 + ((size_t)(bs * 4 + g) * 256 + mi * 128) * 2048 + ni * 128, sm, tid);
    }
}
DEVI void job_f2_lat(const P& p, unsigned char* ws_b, int t, bf16_t* sm, int tid, int grp, float* xch) {
    const int bs = t >> 6, mi = (t >> 2) & 15, ni = t & 3;
    const bf16_t* TAB = (const bf16_t*)(ws_b + WS_TABL);
    const bf16_t* F1T = (const bf16_t*)(ws_b + WS_F1T) + (size_t)8388608;
    bf16_t* YF = (bf16_t*)(ws_b + WS_YF);
    job_store<512, true>(TAB + (size_t)mi * 128 * 4096, 4096, F1T + (size_t)bs * 512 * 4096 + (size_t)ni * 128 * 4096, 4096, 4096,
              YF + ((size_t)NCTX + bs * 2048 + mi * 128) * 512 + ni * 128, sm, tid, grp, xch);
}
DEVI void job_f2_ctx(const P& p, unsigned char* ws_b, int t, bf16_t* sm, int tid) {
    const int bs = t >> 3, mi = (t >> 2) & 1, ni = t & 3;
    const bf16_t* TAB = (const bf16_t*)(ws_b + WS_TABC);
    const bf16_t* F1T = (const bf16_t*)(ws_b + WS_F1T);
    bf16_t* YF = (bf16_t*)(ws_b + WS_YF);
    job_store<512>(TAB + (size_t)mi * 128 * 512, 512, F1T + (size_t)bs * 512 * 512 + (size_t)ni * 128 * 512, 512, 512,
              YF + ((size_t)bs * 256 + mi * 128) * 512 + ni * 128, sm, tid);
}

DEVI void job_merge(const P& p, unsigned char* ws_b, int l, int t, bf16_t* sm, int tid) {
    const int nN = 8; const int m0 = (t / nN) * 128, n0 = (t % nN) * 128;
    const bf16_t* Wl = (const bf16_t*)(ws_b + WS_W) + (size_t)l * LAYER_W;
    const bf16_t* GATE = (const bf16_t*)(ws_b + WS_GATE);
    bf16_t* MG = (bf16_t*)(ws_b + WS_MERGED);
    EPI_SETUP
    f32x16 acc[2][2]; zero_acc(acc);
#pragma unroll 1
    for (int s = 0; s < 3; ++s) {
        const bf16_t* A = (const bf16_t*)(ws_b + (s == 0 ? WS_YF : (s == 1 ? WS_YM : WS_YN)));
        const bf16_t* W = Wl + (s == 0 ? OFF_WBF : (s == 1 ? OFF_WBM : OFF_WBN));
        gemm_core<false>(A + (size_t)m0 * 512, 512, W + (size_t)n0 * 512, 512, 512, acc, sm, tid);
        {
            const int gr = tid >> 4, gc = (tid & 15) * 8;
            const int s1 = s < 2 ? s + 1 : s;
#pragma unroll
            for (int k = 0; k < 8; ++k) {
                const bf16_t* gsrc = GATE + (size_t)(m0 + gr + 16 * k) * 3072 + n0 + gc;
                *(u32x4*)(sm + (gr + 16 * k) * 136 + gc) = *(const u32x4*)(gsrc + s * 1024);
                *(u32x4*)(sm + 128 * 136 + (gr + 16 * k) * 136 + gc) = *(const u32x4*)(gsrc + s1 * 1024);
                if ((k & 1) == 1) __builtin_amdgcn_sched_barrier(0);
            }
        }
        __syncthreads();
#pragma unroll
        for (int j = 0; j < 2; ++j)
#pragma unroll
            for (int i = 0; i < 2; ++i) {
                const bf16_t* gp = sm + (wr * 64 + i * 32 + 4 * hl) * 136 + wc * 64 + j * 32 + c32;
#pragma unroll
                for (int r = 0; r < 16; ++r) {
                    const int o = ((r & 3) + 8 * (r >> 2)) * 136;
                    const float g = bf2f(gp[o]);
                    const float f = (s < 2) ? g * __builtin_amdgcn_rcpf(bf2f(gp[128 * 136 + o])) : g;
                    acc[i][j][r] *= f;
                }
            }
        __syncthreads();
    }
#pragma unroll
    for (int j = 0; j < 2; ++j) {
        const int col = n0 + wc * 64 + j * 32 + c32;
#pragma unroll
        for (int i = 0; i < 2; ++i) {
            const int rb = m0 + wr * 64 + i * 32 + 4 * hl;
#pragma unroll
            for (int r = 0; r < 16; ++r) MG[(size_t)(rb + (r & 3) + 8 * (r >> 2)) * 1024 + col] = f2bf(acc[i][j][r]);
        }
    }
}

struct TileSrc { const bf16_t* k; const bf16_t* k2; const bf16_t* v; const bf16_t* vhi; };
DEVI int pi_row(int r) { return (r & 0x13) | ((r & 4) << 1) | ((r & 8) >> 1); }

template <int NKS>
DEVI void attn_load(const TileSrc& s, bf16x8 (&kf)[NKS], bf16x8 (&vf)[4]) {
#pragma unroll
    for (int ks = 0; ks < NKS; ++ks) kf[ks] = (ks < 4) ? *(const bf16x8*)(s.k + ks * 16) : *(const bf16x8*)(s.k2 + (ks - 4) * 16);
    vf[0] = *(const bf16x8*)(s.v);
    vf[1] = *(const bf16x8*)(s.v + 16);
    vf[2] = *(const bf16x8*)(s.vhi);
    vf[3] = *(const bf16x8*)(s.vhi + 16);
}

template <int NKS, bool SPLIT, class Src, class Mask>
DEVI void attn_wave(const bf16_t* qptr, int t0, int nt, Src src, Mask mask, bf16_t* optr, int lane, float* ex = nullptr, int half = 0) {
    bf16x8 q[NKS];
#pragma unroll
    for (int ks = 0; ks < NKS; ++ks) q[ks] = *(const bf16x8*)(qptr + ks * 16);
    f32x16 o0, o1;
#pragma unroll
    for (int r = 0; r < 16; ++r) { o0[r] = 0.f; o1[r] = 0.f; }
    float m = -1e30f, lsum = 0.f;
    bf16x8 kf[NKS], vf[4];
    nt += t0;
    { TileSrc s0 = src(t0); attn_load<NKS>(s0, kf, vf); }
    for (int t = t0; t < nt; ++t) {
        bf16x8 kn[NKS], vn[4];
        { TileSrc s1 = src(t + 1 < nt ? t + 1 : t); attn_load<NKS>(s1, kn, vn); }
        f32x16 s;
#pragma unroll
        for (int r = 0; r < 16; ++r) s[r] = 0.f;
#pragma unroll
        for (int ks = 0; ks < NKS; ++ks) s = __builtin_amdgcn_mfma_f32_32x32x16_bf16(kf[ks], q[ks], s, 0, 0, 0);
        mask(t, s);
        float mx = s[0];
#pragma unroll
        for (int r = 1; r < 16; ++r) mx = fmaxf(mx, s[r]);
        mx = fmaxf(mx, __shfl_xor(mx, 32));
        const float mn = fmaxf(m, mx);
        const float alpha = fast_exp2(m - mn);
        m = mn;
        float rs = 0.f;
#pragma unroll
        for (int r = 0; r < 16; ++r) { s[r] = fast_exp2(s[r] - mn); rs += s[r]; }
        lsum = lsum * alpha + rs;
#pragma unroll
        for (int r = 0; r < 16; ++r) { o0[r] *= alpha; o1[r] *= alpha; }
        bf16x8 p0, p1;
        {
            u32x4 a, b;
            a.x = pk2(s[0], s[1]); a.y = pk2(s[2], s[3]); a.z = pk2(s[4], s[5]); a.w = pk2(s[6], s[7]);
            b.x = pk2(s[8], s[9]); b.y = pk2(s[10], s[11]); b.z = pk2(s[12], s[13]); b.w = pk2(s[14], s[15]);
            p0 = __builtin_bit_cast(bf16x8, a); p1 = __builtin_bit_cast(bf16x8, b);
        }
        o0 = __builtin_amdgcn_mfma_f32_32x32x16_bf16(vf[0], p0, o0, 0, 0, 0);
        o0 = __builtin_amdgcn_mfma_f32_32x32x16_bf16(vf[1], p1, o0, 0, 0, 0);
        o1 = __builtin_amdgcn_mfma_f32_32x32x16_bf16(vf[2], p0, o1, 0, 0, 0);
        o1 = __builtin_amdgcn_mfma_f32_32x32x16_bf16(vf[3], p1, o1, 0, 0, 0);
#pragma unroll
        for (int ks = 0; ks < NKS; ++ks) kf[ks] = kn[ks];
#pragma unroll
        for (int x = 0; x < 4; ++x) vf[x] = vn[x];
    }
    if constexpr (SPLIT) {
        if (half == 1) {
#pragma unroll
            for (int r = 0; r < 16; ++r) { ex[r * 64 + lane] = o0[r]; ex[(16 + r) * 64 + lane] = o1[r]; }
            ex[32 * 64 + lane] = m; ex[33 * 64 + lane] = lsum;
        }
        __syncthreads();
        if (half == 0) {
            const float m2 = ex[32 * 64 + lane], l2 = ex[33 * 64 + lane];
            const float mn = fmaxf(m, m2), a1 = fast_exp2(m - mn), a2 = fast_exp2(m2 - mn);
            lsum = lsum * a1 + l2 * a2;
#pragma unroll
            for (int r = 0; r < 16; ++r) { o0[r] = o0[r] * a1 + ex[r * 64 + lane] * a2; o1[r] = o1[r] * a1 + ex[(16 + r) * 64 + lane] * a2; }
        }
        __syncthreads();
        if (half == 1) return;
    }
    lsum += __shfl_xor(lsum, 32);
    const float inv = 1.f / lsum;
    const int hl = lane >> 5;
#pragma unroll
    for (int qd = 0; qd < 4; ++qd) {
        u32x2 a, b;
        a.x = pk2(o0[4 * qd] * inv, o0[4 * qd + 1] * inv); a.y = pk2(o0[4 * qd + 2] * inv, o0[4 * qd + 3] * inv);
        b.x = pk2(o1[4 * qd] * inv, o1[4 * qd + 1] * inv); b.y = pk2(o1[4 * qd + 2] * inv, o1[4 * qd + 3] * inv);
        *(u32x2*)(optr + 8 * qd + 4 * hl) = a;
        *(u32x2*)(optr + 32 + 8 * qd + 4 * hl) = b;
    }
}

struct NoMask { DEVI void operator()(int, f32x16&) const {} };

DEVI void attn_mla(const P& p, unsigned char* ws_b, int l, bool lat, int b, int h, int qg, int lane, float* ex = nullptr, int half = 0) {
    const int hl = lane >> 5, c32 = lane & 31, pr = pi_row(c32);
    const bf16_t* Q = (const bf16_t*)(ws_b + WS_Q);
    const bf16_t* KN = (const bf16_t*)(ws_b + WS_KN);
    const bf16_t* KR = (const bf16_t*)(ws_b + WS_KR);
    const bf16_t* CKR = (const bf16_t*)(ws_b + WS_CKR) + (size_t)l * 1024 * 32;
    const bf16_t* VT = (const bf16_t*)(ws_b + WS_VTM);
    bf16_t* YM = (bf16_t*)(ws_b + WS_YM);
    if (!lat) {
        const int row0 = b * 256;
        const int qrow = row0 + qg * 32 + c32;
        const bf16_t* k0 = KN + (size_t)(row0 + pr) * 512 + h * 64 + hl * 8;
        const bf16_t* r0 = KR + (size_t)(row0 + pr) * 32 + hl * 8;
        const bf16_t* v0 = VT + ((size_t)((b * 8 + h) * 64 + c32)) * 256 + hl * 8;
        auto src = [=](int t) { TileSrc s; s.k = k0 + (size_t)t * 32 * 512; s.k2 = r0 + (size_t)t * 32 * 32; s.v = v0 + t * 32; s.vhi = s.v + 32 * 256; return s; };
        attn_wave<6, false>(Q + (size_t)qrow * 768 + h * 96 + hl * 8, 0, 8, src, NoMask(), YM + (size_t)qrow * 512 + h * 64, lane);
    } else {
        const int row0 = NCTX + b * 2048;
        const int qrow = row0 + qg * 32 + c32;
        const bf16_t* k0 = KN + (size_t)(row0 + pr) * 512 + h * 64 + hl * 8;
        const bf16_t* r0 = KR + (size_t)(row0 + pr) * 32 + hl * 8;
        const bf16_t* k1 = KN + (size_t)(M + b * 512 + pr) * 512 + h * 64 + hl * 8;
        const bf16_t* r1 = CKR + (size_t)(b * 512 + pr) * 32 + hl * 8;
        const bf16_t* v0 = VT + (size_t)4194304 + ((size_t)((b * 8 + h) * 64 + c32)) * 2560 + hl * 8;
        auto src = [=](int t) {
            TileSrc s;
            if (t < 64) { s.k = k0 + (size_t)t * 32 * 512; s.k2 = r0 + (size_t)t * 32 * 32; }
            else { s.k = k1 + (size_t)(t - 64) * 32 * 512; s.k2 = r1 + (size_t)(t - 64) * 32 * 32; }
            s.v = v0 + t * 32; s.vhi = s.v + 32 * 2560; return s; };
        attn_wave<6, true>(Q + (size_t)qrow * 768 + h * 96 + hl * 8, half * 40, 40, src, NoMask(), YM + (size_t)qrow * 512 + h * 64, lane, ex, half);
    }
}

template <int NKS, class Mask>
DEVI void attn_step(const bf16x8 (&kf)[NKS], const bf16x8 (&vf)[4], const bf16x8 (&q)[NKS], f32x16& o0, f32x16& o1, float& m, float& lsum, const Mask& mask, int t) {
    f32x16 s;
#pragma unroll
    for (int r = 0; r < 16; ++r) s[r] = 0.f;
#pragma unroll
    for (int ks = 0; ks < NKS; ++ks) s = __builtin_amdgcn_mfma_f32_32x32x16_bf16(kf[ks], q[ks], s, 0, 0, 0);
    mask(t, s);
    float mx = s[0];
#pragma unroll
    for (int r = 1; r < 16; ++r) mx = fmaxf(mx, s[r]);
    mx = fmaxf(mx, __shfl_xor(mx, 32));
    const float mn = fmaxf(m, mx);
    const float alpha = fast_exp2(m - mn);
    m = mn;
    float rs = 0.f;
#pragma unroll
    for (int r = 0; r < 16; ++r) { s[r] = fast_exp2(s[r] - mn); rs += s[r]; }
    lsum = lsum * alpha + rs;
#pragma unroll
    for (int r = 0; r < 16; ++r) { o0[r] *= alpha; o1[r] *= alpha; }
    bf16x8 p0, p1;
    {
        u32x4 a, b;
        a.x = pk2(s[0], s[1]); a.y = pk2(s[2], s[3]); a.z = pk2(s[4], s[5]); a.w = pk2(s[6], s[7]);
        b.x = pk2(s[8], s[9]); b.y = pk2(s[10], s[11]); b.z = pk2(s[12], s[13]); b.w = pk2(s[14], s[15]);
        p0 = __builtin_bit_cast(bf16x8, a); p1 = __builtin_bit_cast(bf16x8, b);
    }
    o0 = __builtin_amdgcn_mfma_f32_32x32x16_bf16(vf[0], p0, o0, 0, 0, 0);
    o0 = __builtin_amdgcn_mfma_f32_32x32x16_bf16(vf[1], p1, o0, 0, 0, 0);
    o1 = __builtin_amdgcn_mfma_f32_32x32x16_bf16(vf[2], p0, o1, 0, 0, 0);
    o1 = __builtin_amdgcn_mfma_f32_32x32x16_bf16(vf[3], p1, o1, 0, 0, 0);
}
struct MlaStage { u32x4 k, v; u32x2 r; };
DEVI void attn_mla_lat_shared(const P& p, unsigned char* ws_b, int l, int b, int h, int qg, int tid, unsigned char* smem, float* ex) {
    const int lane = tid & 63, wave = tid >> 6, half = wave >> 2, htid = tid & 255;
    const int hl = lane >> 5, c32 = lane & 31, pr = pi_row(c32);
    const bf16_t* Q = (const bf16_t*)(ws_b + WS_Q);
    const bf16_t* KN = (const bf16_t*)(ws_b + WS_KN);
    const bf16_t* KR = (const bf16_t*)(ws_b + WS_KR);
    const bf16_t* CKR = (const bf16_t*)(ws_b + WS_CKR) + (size_t)l * 1024 * 32;
    const bf16_t* VT = (const bf16_t*)(ws_b + WS_VTM) + (size_t)4194304 + (size_t)((b * 8 + h) * 64) * 2560;
    bf16_t* YM = (bf16_t*)(ws_b + WS_YM);
    const int row0 = NCTX + b * 2048;
    const int qrow = row0 + qg * 32 + c32;
    bf16_t* ring = (bf16_t*)(smem + 36864 + half * 36864);
    const int kkey = htid >> 3, kch = (htid & 7) * 8, vd = htid >> 2, vch = (htid & 3) * 8;
    const int rch = (htid & 7) * 4;
    const int tb = half * 40, tend = tb + 40;
    bf16x8 q[6];
    {
        const bf16_t* qptr = Q + (size_t)qrow * 768 + h * 96 + hl * 8;
#pragma unroll
        for (int ks = 0; ks < 6; ++ks) q[ks] = *(const bf16x8*)(qptr + ks * 16);
    }
    f32x16 o0, o1;
#pragma unroll
    for (int r = 0; r < 16; ++r) { o0[r] = 0.f; o1[r] = 0.f; }
    float m = -1e30f, lsum = 0.f;
#define MLA_LD(S, T) do { const int t_ = (T) < tend ? (T) : tend - 1; \
        const int krow_ = t_ < 64 ? row0 + t_ * 32 : M + b * 512 + (t_ - 64) * 32; \
        (S).k = *(const u32x4*)(KN + (size_t)(krow_ + kkey) * 512 + h * 64 + kch); \
        (S).v = *(const u32x4*)(VT + (size_t)vd * 2560 + t_ * 32 + vch); \
        (S).r = *(const u32x2*)((t_ < 64 ? KR + (size_t)(krow_ + kkey) * 32 : CKR + (size_t)(b * 512 + (t_ - 64) * 32 + kkey) * 32) + rch); } while (0)
#define MLA_ST(S, SLOT) do { bf16_t* sl_ = ring + (SLOT) * 6144; \
        *(u32x4*)(sl_ + kkey * 72 + kch) = (S).k; *(u32x4*)(sl_ + 3584 + vd * 40 + vch) = (S).v; \
        *(u32x2*)(sl_ + 2304 + kkey * 40 + rch) = (S).r; } while (0)
#define MLA_COMPUTE(SLOT, T) do { const bf16_t* sl_ = ring + (SLOT) * 6144; bf16x8 kf[6], vf[4]; \
        _Pragma("unroll") for (int ks = 0; ks < 4; ++ks) kf[ks] = *(const bf16x8*)(sl_ + pr * 72 + ks * 16 + hl * 8); \
        kf[4] = *(const bf16x8*)(sl_ + 2304 + pr * 40 + hl * 8); kf[5] = *(const bf16x8*)(sl_ + 2304 + pr * 40 + 16 + hl * 8); \
        vf[0] = *(const bf16x8*)(sl_ + 3584 + c32 * 40 + hl * 8); vf[1] = *(const bf16x8*)(sl_ + 3584 + c32 * 40 + 16 + hl * 8); \
        vf[2] = *(const bf16x8*)(sl_ + 3584 + (c32 + 32) * 40 + hl * 8); vf[3] = *(const bf16x8*)(sl_ + 3584 + (c32 + 32) * 40 + 16 + hl * 8); \
        attn_step<6>(kf, vf, q, o0, o1, m, lsum, NoMask(), (T)); } while (0)
    MlaStage s0, s1, s2;
    MLA_LD(s0, tb); MLA_LD(s1, tb + 1); MLA_LD(s2, tb + 2);
    MLA_ST(s0, 0); MLA_LD(s0, tb + 3);
    __syncthreads();
#pragma unroll 1
    for (int i = tb; i < tend; i += 3) {
        MLA_ST(s1, 1); MLA_LD(s1, i + 4); MLA_COMPUTE(0, i); __syncthreads();
        MLA_ST(s2, 2); MLA_LD(s2, i + 5); if (i + 1 < tend) MLA_COMPUTE(1, i + 1); __syncthreads();
        MLA_ST(s0, 0); MLA_LD(s0, i + 6); if (i + 2 < tend) MLA_COMPUTE(2, i + 2); __syncthreads();
    }
#undef MLA_LD
#undef MLA_ST
#undef MLA_COMPUTE
    if (half == 1) {
#pragma unroll
        for (int r = 0; r < 16; ++r) { ex[r * 64 + lane] = o0[r]; ex[(16 + r) * 64 + lane] = o1[r]; }
        ex[32 * 64 + lane] = m; ex[33 * 64 + lane] = lsum;
    }
    __syncthreads();
    if (half == 0) {
        const float m2 = ex[32 * 64 + lane], l2 = ex[33 * 64 + lane];
        const float mn = fmaxf(m, m2), a1 = fast_exp2(m - mn), a2 = fast_exp2(m2 - mn);
        lsum = lsum * a1 + l2 * a2;
#pragma unroll
        for (int r = 0; r < 16; ++r) { o0[r] = o0[r] * a1 + ex[r * 64 + lane] * a2; o1[r] = o1[r] * a1 + ex[(16 + r) * 64 + lane] * a2; }
    }
    __syncthreads();
    if (half == 1) return;
    lsum += __shfl_xor(lsum, 32);
    const float inv = 1.f / lsum;
    bf16_t* optr = YM + (size_t)qrow * 512 + h * 64;
#pragma unroll
    for (int qd = 0; qd < 4; ++qd) {
        u32x2 a, bb;
        a.x = pk2(o0[4 * qd] * inv, o0[4 * qd + 1] * inv); a.y = pk2(o0[4 * qd + 2] * inv, o0[4 * qd + 3] * inv);
        bb.x = pk2(o1[4 * qd] * inv, o1[4 * qd + 1] * inv); bb.y = pk2(o1[4 * qd + 2] * inv, o1[4 * qd + 3] * inv);
        *(u32x2*)(optr + 8 * qd + 4 * hl) = a;
        *(u32x2*)(optr + 32 + 8 * qd + 4 * hl) = bb;
    }
}

template <int NKS>
DEVI void attn_ctx_shared(const bf16_t* Kg, const bf16_t* KRg, const bf16_t* VTg, const bf16_t* qptr, bf16_t* optr, int tid, unsigned char* smem) {
    const int lane = tid & 63, hl = lane >> 5, c32 = lane & 31, pr = pi_row(c32);
    bf16_t* Ks = (bf16_t*)smem;
    bf16_t* Rs = Ks + 256 * 72;
    bf16_t* Vs = Rs + 256 * 40;
    {
        u32x4 kr[4], vr[4], rr[2];
#pragma unroll
        for (int i = 0; i < 4; ++i) { const int c = tid + 512 * i; kr[i] = *(const u32x4*)(Kg + (size_t)(c >> 3) * 512 + (c & 7) * 8); }
#pragma unroll
        for (int i = 0; i < 4; ++i) { const int c = tid + 512 * i; vr[i] = *(const u32x4*)(VTg + (size_t)(c >> 5) * 256 + (c & 31) * 8); }
        if constexpr (NKS == 6) {
#pragma unroll
            for (int i = 0; i < 2; ++i) { const int c = tid + 512 * i; rr[i] = *(const u32x4*)(KRg + (size_t)(c >> 2) * 32 + (c & 3) * 8); }
        }
#pragma unroll
        for (int i = 0; i < 4; ++i) { const int c = tid + 512 * i; *(u32x4*)(Ks + (c >> 3) * 72 + (c & 7) * 8) = kr[i]; }
#pragma unroll
        for (int i = 0; i < 4; ++i) { const int c = tid + 512 * i; *(u32x4*)(Vs + (c >> 5) * 264 + (c & 31) * 8) = vr[i]; }
        if constexpr (NKS == 6) {
#pragma unroll
            for (int i = 0; i < 2; ++i) { const int c = tid + 512 * i; *(u32x4*)(Rs + (c >> 2) * 40 + (c & 3) * 8) = rr[i]; }
        }
    }
    bf16x8 q[NKS];
#pragma unroll
    for (int ks = 0; ks < NKS; ++ks) q[ks] = *(const bf16x8*)(qptr + ks * 16);
    __syncthreads();
    f32x16 o0, o1;
#pragma unroll
    for (int r = 0; r < 16; ++r) { o0[r] = 0.f; o1[r] = 0.f; }
    float m = -1e30f, lsum = 0.f;
#pragma unroll 1
    for (int t = 0; t < 8; ++t) {
        bf16x8 kf[NKS], vf[4];
        const bf16_t* kp = Ks + (t * 32 + pr) * 72 + hl * 8;
#pragma unroll
        for (int ks = 0; ks < 4; ++ks) kf[ks] = *(const bf16x8*)(kp + ks * 16);
        if constexpr (NKS == 6) {
            const bf16_t* rp = Rs + (t * 32 + pr) * 40 + hl * 8;
            kf[4] = *(const bf16x8*)rp; kf[5] = *(const bf16x8*)(rp + 16);
        }
        const bf16_t* vp = Vs + c32 * 264 + t * 32 + hl * 8;
        vf[0] = *(const bf16x8*)vp; vf[1] = *(const bf16x8*)(vp + 16);
        vf[2] = *(const bf16x8*)(vp + 32 * 264); vf[3] = *(const bf16x8*)(vp + 32 * 264 + 16);
        attn_step<NKS>(kf, vf, q, o0, o1, m, lsum, NoMask(), t);
    }
    lsum += __shfl_xor(lsum, 32);
    const float inv = 1.f / lsum;
#pragma unroll
    for (int qd = 0; qd < 4; ++qd) {
        u32x2 a, bb;
        a.x = pk2(o0[4 * qd] * inv, o0[4 * qd + 1] * inv); a.y = pk2(o0[4 * qd + 2] * inv, o0[4 * qd + 3] * inv);
        bb.x = pk2(o1[4 * qd] * inv, o1[4 * qd + 1] * inv); bb.y = pk2(o1[4 * qd + 2] * inv, o1[4 * qd + 3] * inv);
        *(u32x2*)(optr + 8 * qd + 4 * hl) = a;
        *(u32x2*)(optr + 32 + 8 * qd + 4 * hl) = bb;
    }
    __syncthreads();
}

DEVI void attn_na_ctx(const P& p, unsigned char* ws_b, int b, int h, int qg, int lane) {
    const int hl = lane >> 5, c32 = lane & 31, pr = pi_row(c32);
    const bf16_t* Qn = (const bf16_t*)(ws_b + WS_NAQ);
    const bf16_t* Kn = (const bf16_t*)(ws_b + WS_NAK);
    const bf16_t* VT = (const bf16_t*)(ws_b + WS_NAVT);
    bf16_t* YN = (bf16_t*)(ws_b + WS_YN);
    const int row0 = b * 256, qrow = row0 + qg * 32 + c32;
    const bf16_t* k0 = Kn + (size_t)(row0 + pr) * 512 + h * 64 + hl * 8;
    const bf16_t* v0 = VT + ((size_t)((b * 8 + h) * 64 + c32)) * 256 + hl * 8;
    auto src = [=](int t) { TileSrc s; s.k = k0 + (size_t)t * 32 * 512; s.k2 = s.k; s.v = v0 + t * 32; s.vhi = s.v + 32 * 256; return s; };
    attn_wave<4, false>(Qn + (size_t)qrow * 512 + h * 64 + hl * 8, 0, 8, src, NoMask(), YN + (size_t)qrow * 512 + h * 64, lane);
}

struct NaMask {
    const float* rpb;
    int rs, rq, qc, hl;
    DEVI void operator()(int t, f32x16& s) const {
        if (t >= 16) return;
        const int kr = t >> 1, kh = t & 1;
        const int cs = min(max(qc - 8, 0), 48);
        const float* rp = rpb + (rs + kr - rq + 7) * 31;
#pragma unroll
        for (int r = 0; r < 16; ++r) {
            const int kk = (r & 3) + 4 * ((r >> 2) & 1) + 8 * hl + 16 * (r >> 3);
            const int kc = kh * 32 + kk;
            const bool ok = (kc >= cs) && (kc < cs + 16);
            const int dc = min(max(kc - qc + 15, 0), 30);
            const float bias = rp[dc];
            s[r] = ok ? s[r] + bias : -1e30f;
        }
    }
};
DEVI void attn_na_lat(const P& p, unsigned char* ws_b, int l, int b, int h, int rq, int qh, int lane, float* ex, int half, const float* rpb_lds) {
    const int hl = lane >> 5, c32 = lane & 31, pr = pi_row(c32);
    const bf16_t* Qn = (const bf16_t*)(ws_b + WS_NAQ);
    const bf16_t* Kn = (const bf16_t*)(ws_b + WS_NAK);
    const bf16_t* VT = (const bf16_t*)(ws_b + WS_NAVT) + (size_t)4194304;
    const bf16_t* CK = (const bf16_t*)(ws_b + WS_CNAK) + (size_t)l * 1024 * 512;
    const bf16_t* CV = (const bf16_t*)(ws_b + WS_CNAVT) + (size_t)l * 1024 * 512;
    bf16_t* YN = (bf16_t*)(ws_b + WS_YN);
    const int row0 = NCTX + b * 2048;
    const int qrow = row0 + rq * 64 + qh * 32 + c32;
    const int rs = min(max(rq - 4, 0), 24);
    const bf16_t* k0 = Kn + (size_t)(row0 + rs * 64 + pr) * 512 + h * 64 + hl * 8;
    const bf16_t* v0 = VT + ((size_t)((b * 8 + h) * 64 + c32)) * 2048 + rs * 64 + hl * 8;
    const bf16_t* k1 = CK + (size_t)(b * 512 + pr) * 512 + h * 64 + hl * 8;
    const bf16_t* v1 = CV + ((size_t)((b * 8 + h) * 64 + c32)) * 512 + hl * 8;
    auto src = [=](int t) {
        TileSrc s;
        if (t < 16) { s.k = k0 + (size_t)t * 32 * 512; s.v = v0 + t * 32; s.vhi = s.v + 32 * 2048; }
        else { s.k = k1 + (size_t)(t - 16) * 32 * 512; s.v = v1 + (t - 16) * 32; s.vhi = s.v + 32 * 512; }
        s.k2 = s.k; return s; };
    NaMask mk; mk.rpb = rpb_lds; mk.rs = rs; mk.rq = rq; mk.qc = qh * 32 + c32; mk.hl = hl;
    attn_wave<4, true>(Qn + (size_t)qrow * 512 + h * 64 + hl * 8, half * 16, 16, src, mk, YN + (size_t)qrow * 512 + h * 64, lane, ex, half);
}

DEVI void row_load(const float* src, f32x4 (&v)[4], int lane) {
#pragma unroll
    for (int j = 0; j < 4; ++j) v[j] = *(const f32x4*)(src + 4 * lane + 256 * j);
}
DEVI void row_ln_mod(f32x4 (&v)[4], float* xdst, bf16_t* hdst, const float* lng, const float* lnb, const float* shift, const float* scale, int lane) {
    if (lng) {
        float s = 0.f;
#pragma unroll
        for (int j = 0; j < 4; ++j) s += (v[j].x + v[j].y) + (v[j].z + v[j].w);
        const float mu = wave_sum(s) * (1.f / D);
        float q = 0.f;
#pragma unroll
        for (int j = 0; j < 4; ++j) { v[j] = v[j] - mu; q += (v[j].x * v[j].x + v[j].y * v[j].y) + (v[j].z * v[j].z + v[j].w * v[j].w); }
        const float rstd = rsqrtf(wave_sum(q) * (1.f / D) + 1e-5f);
#pragma unroll
        for (int j = 0; j < 4; ++j) {
            const f32x4 g = *(const f32x4*)(lng + 4 * lane + 256 * j), bb = *(const f32x4*)(lnb + 4 * lane + 256 * j);
            v[j] = v[j] * rstd * g + bb;
        }
    }
    if (xdst) {
#pragma unroll
        for (int j = 0; j < 4; ++j) *(f32x4*)(xdst + 4 * lane + 256 * j) = v[j];
    }
    if (hdst) {
        float s = 0.f;
#pragma unroll
        for (int j = 0; j < 4; ++j) s += (v[j].x + v[j].y) + (v[j].z + v[j].w);
        const float mu = wave_sum(s) * (1.f / D);
        float q = 0.f;
#pragma unroll
        for (int j = 0; j < 4; ++j) { v[j] = v[j] - mu; q += (v[j].x * v[j].x + v[j].y * v[j].y) + (v[j].z * v[j].z + v[j].w * v[j].w); }
        const float rstd = rsqrtf(wave_sum(q) * (1.f / D) + 1e-6f);
#pragma unroll
        for (int j = 0; j < 4; ++j) {
            const f32x4 sc = *(const f32x4*)(scale + 4 * lane + 256 * j), sh = *(const f32x4*)(shift + 4 * lane + 256 * j);
            const f32x4 o = v[j] * rstd * (sc + 1.f) + sh;
            u32x2 pk; pk.x = pk2(o.x, o.y); pk.y = pk2(o.z, o.w);
            *(u32x2*)(hdst + 4 * lane + 256 * j) = pk;
        }
    }
}

DEVI const float* phase_rows_src(const P& p, unsigned char* ws_b, int row, int lnidx) {
    return (lnidx < 0) ? (row < NCTX ? pin(p, 0) + (size_t)row * D : pin(p, 1) + (size_t)(row - NCTX) * D) : (const float*)(ws_b + WS_X) + (size_t)row * D;
}
DEVI void phase_rows_one(const P& p, unsigned char* ws_b, f32x4 (&v)[4], int row, int l, int lnidx, int ml, int ms, bool final_, int lane) {
    float* X = (float*)(ws_b + WS_X);
    bf16_t* H = (bf16_t*)(ws_b + WS_H);
    const float* MOD = (const float*)(ws_b + WS_MOD);
    const float* lng = (lnidx < 0) ? nullptr : pin(p, 28) + (size_t)(l * 3 + lnidx) * D;
    const float* lnb = (lnidx < 0) ? nullptr : pin(p, 29) + (size_t)(l * 3 + lnidx) * D;
    if (final_) { row_ln_mod(v, p.out + (size_t)row * D, nullptr, lng, lnb, nullptr, nullptr, lane); return; }
    const float* mb = MOD + ((size_t)ml * 3 + mod_group(row)) * 9216;
    row_ln_mod(v, X + (size_t)row * D, H + (size_t)row * D, lng, lnb, mb + ms * D, mb + (ms + 1) * D, lane);
}
DEVI void phase_rows(const P& p, unsigned char* ws_b, int l, int lnidx, int ml, int ms, bool final_, int gw, int ngw, int lane) {
    int row = gw;
    for (; row + ngw < M; row += 2 * ngw) {
        f32x4 va[4], vb[4];
        row_load(phase_rows_src(p, ws_b, row, lnidx), va, lane);
        row_load(phase_rows_src(p, ws_b, row + ngw, lnidx), vb, lane);
        phase_rows_one(p, ws_b, va, row, l, lnidx, ml, ms, final_, lane);
        phase_rows_one(p, ws_b, vb, row + ngw, l, lnidx, ml, ms, final_, lane);
    }
    if (row < M) { f32x4 va[4]; row_load(phase_rows_src(p, ws_b, row, lnidx), va, lane); phase_rows_one(p, ws_b, va, row, l, lnidx, ml, ms, final_, lane); }
}

DEVI void phase_rowmix(const P& p, unsigned char* ws_b, int l, int gw, int ngw, int lane) {
    bf16_t* UQ = (bf16_t*)(ws_b + WS_UQ);
    const float* UKV = (const float*)(ws_b + WS_UKV);
    const float* KRF = (const float*)(ws_b + WS_KRF);
    bf16_t* CKV = (bf16_t*)(ws_b + WS_CKV);
    bf16_t* KR = (bf16_t*)(ws_b + WS_KR);
    const float* ropec = (const float*)(ws_b + WS_ROPE);
    const float* ropes = ropec + 512;
    const float* gq = pin(p, 17) + l * 384;
    const float* gkv = pin(p, 19) + l * 256;
    for (int row = gw; row < M; row += ngw) {
        {
            unsigned* up = (unsigned*)(UQ + (size_t)row * 384) + lane;
            float x[6]; float ss = 0.f;
#pragma unroll
            for (int j = 0; j < 3; ++j) { const unsigned w = up[64 * j]; x[2 * j] = bf2f(w & 0xffffu); x[2 * j + 1] = bf2f(w >> 16); ss += x[2 * j] * x[2 * j] + x[2 * j + 1] * x[2 * j + 1]; }
            const float rs = rsqrtf(wave_sum(ss) * (1.f / 384.f) + 1e-6f);
#pragma unroll
            for (int j = 0; j < 3; ++j) { const int c = 2 * lane + 128 * j; up[64 * j] = pk2(x[2 * j] * rs * gq[c], x[2 * j + 1] * rs * gq[c + 1]); }
        }
        {
            const f32x4 v = *(const f32x4*)(UKV + (size_t)row * 256 + 4 * lane);
            const float ss = v.x * v.x + v.y * v.y + v.z * v.z + v.w * v.w;
            const float rs = rsqrtf(wave_sum(ss) * (1.f / 256.f) + 1e-6f);
            const f32x4 g = *(const f32x4*)(gkv + 4 * lane);
            const f32x4 o = v * rs * g;
            u32x2 pk; pk.x = pk2(o.x, o.y); pk.y = pk2(o.z, o.w);
            *(u32x2*)(CKV + (size_t)row * 256 + 4 * lane) = pk;
            if (row < NCTX) *(f32x4*)(p.out + OUT_CKV + ((size_t)((row >> 8) * 4 + l) * 256 + (row & 255)) * 256 + 4 * lane) = o;
        }
        {
            const float v = KRF[(size_t)row * 32 + (lane & 31)];
            const float pr = __shfl_xor(v, 8);
            float o = v;
            if (row >= NCTX) {
                const int c = lane & 31, axis = c >> 4, ii = c & 15, n = (row - NCTX) & 2047;
                const int pos = axis ? (n & 63) : (n >> 6);
                const float rot = (ii < 8) ? -pr : pr;
                o = v * ropec[pos * 8 + (ii & 7)] + rot * ropes[pos * 8 + (ii & 7)];
            }
            if (lane < 32) {
                KR[(size_t)row * 32 + lane] = f2bf(o);
                if (row < NCTX) p.out[OUT_KR + ((size_t)((row >> 8) * 4 + l) * 256 + (row & 255)) * 32 + lane] = v;
            }
        }
    }
}

DEVI void transpose_item(const float* __restrict__ src, int N, int c0, int k0, bf16_t* __restrict__ dst, int K, float* scr, int lane) {
#pragma unroll 8
    for (int i = 0; i < 32; ++i) { const int kk = 2 * i + (lane >> 5); scr[kk * 33 + (lane & 31)] = src[(size_t)(k0 + kk) * N + c0 + (lane & 31)]; }
    asm volatile("s_waitcnt lgkmcnt(0)" ::: "memory");
    const int c = lane & 7;
#pragma unroll
    for (int j = 0; j < 4; ++j) {
        const int n = (lane >> 3) + 8 * j; const float* s = scr + (8 * c) * 33 + n;
        u32x4 o; o.x = pk2(s[0], s[33]); o.y = pk2(s[2 * 33], s[3 * 33]); o.z = pk2(s[4 * 33], s[5 * 33]); o.w = pk2(s[6 * 33], s[7 * 33]);
        *(u32x4*)(dst + (size_t)n * K + k0 + 8 * c) = o;
    }
    asm volatile("s_waitcnt lgkmcnt(0)" ::: "memory");
}

DEVI void prep_weight_item(const P& p, unsigned char* ws_b, int item, float* scr, int lane) {
    const int l = item / 12944; int r = item % 12944;
    bf16_t* Wl = (bf16_t*)(ws_b + WS_W) + (size_t)l * LAYER_W;
    if (r < 8448) {
        const int which = r / 4224; r %= 4224;
        if (r < 2816) {
            const int rb = r >> 4, kb = r & 15;
            const float* src = ((lane & 16) ? (which ? pin(p, 14) : pin(p, 11)) : (which ? pin(p, 13) : pin(p, 10))) + (size_t)l * D * DFF;
            transpose_item(src, DFF, rb * 16 - (lane & 16), kb * 64, Wl + (which ? OFF_W13_2 : OFF_W13_1) + (size_t)rb * 32 * D, D, scr, lane);
        } else {
            r -= 2816; const int rb = r / 44, kb = r % 44;
            const float* src = (which ? pin(p, 15) : pin(p, 12)) + (size_t)l * DFF * D;
            transpose_item(src, D, rb * 32, kb * 64, Wl + (which ? OFF_W2_2 : OFF_W2_1) + (size_t)rb * 32 * DFF, DFF, scr, lane);
        }
        return;
    }
    r -= 8448;
    if (r < 2944) {
        const int rb = r >> 4, kb = r & 15, R0 = rb * 32;
        const float* src; int N, c0;
        if (R0 < 1184) { src = pin(p, 16) + (size_t)l * D * 2720; N = 2720; c0 = R0; }
        else if (R0 < 1280) return;
        else if (R0 < 2816) { src = pin(p, 16) + (size_t)l * D * 2720; N = 2720; c0 = R0 - 96; }
        else { src = pin(p, 25) + (size_t)l * D * 3072; N = 3072; c0 = R0 - 2816; }
        transpose_item(src, N, c0, kb * 64, Wl + OFF_WIN + (size_t)R0 * D, D, scr, lane);
        return;
    }
    r -= 2944;
    if (r < 512) { const int rb = r >> 4, kb = r & 15; transpose_item(pin(p, 27) + (size_t)l * D * D, D, rb * 32, kb * 64, Wl + OFF_WOUT + (size_t)rb * 32 * D, D, scr, lane); return; }
    r -= 512;
    if (r < 768) { const int w = r >> 8; r &= 255; const int rb = r >> 3, kb = r & 7;
        transpose_item((w == 0 ? pin(p, 22) : (w == 1 ? pin(p, 23) : pin(p, 24))) + (size_t)l * 512 * D, D, rb * 32, kb * 64, Wl + (w == 0 ? OFF_WBF : (w == 1 ? OFF_WBM : OFF_WBN)) + (size_t)rb * 32 * 512, 512, scr, lane); return; }
    r -= 768;
    if (r < 144) { const int rb = r / 6, kb = r % 6; transpose_item(pin(p, 18) + (size_t)l * 384 * 768, 768, rb * 32, kb * 64, Wl + OFF_WUQ + (size_t)rb * 32 * 384, 384, scr, lane); return; }
    r -= 144;
    { const int rb = r >> 2, kb = r & 3; transpose_item(pin(p, 20) + (size_t)l * 256 * 1024, 1024, rb * 32, kb * 64, Wl + OFF_WUKV + (size_t)rb * 32 * 256, 256, scr, lane); }
}

DEVI void phase_prep(const P& p, unsigned char* ws_b, unsigned char* smem, int tid) {
    const int lane = tid & 63, wave = tid >> 6;
    const int gw = blockIdx.x * NWAVES + wave, ngw = gridDim.x * NWAVES;
    const size_t gt = (size_t)blockIdx.x * NTHREADS + tid, ngt = (size_t)gridDim.x * NTHREADS;
    {
        float* sil = (float*)smem;
        const float* wada = pin(p, 8);
        float* MODP = (float*)(ws_b + WS_MODP);
        for (int item = blockIdx.x; item < 1152; item += gridDim.x) {
            const int l = item / 288, rem = item % 288, kc = rem / 18, cb = rem % 18;
            __syncthreads();
            if (tid < 192) {
                const int g = tid >> 6, k = kc * 64 + (tid & 63);
                const float cv = (g == 0) ? pin(p, 7)[k] : pin(p, 6)[(g - 1) * D + k];
                sil[tid] = cv * sigmoidf_(cv);
            }
            __syncthreads();
            const int col = cb * NTHREADS + tid;
            const float* w = wada + ((size_t)l * D + kc * 64) * 9216 + col;
            float a0 = 0.f, a1 = 0.f, a2 = 0.f;
#pragma unroll 16
            for (int k = 0; k < 64; ++k) { const float wv = w[(size_t)k * 9216]; a0 += sil[k] * wv; a1 += sil[64 + k] * wv; a2 += sil[128 + k] * wv; }
            float* o = MODP + ((size_t)(l * 16 + kc) * 3) * 9216 + col;
            o[0] = a0; o[9216] = a1; o[2 * 9216] = a2;
        }
        __syncthreads();
    }
    {
        float* scr = (float*)smem + wave * (64 * 33);
        for (int item = gw; item < 4 * 12944; item += ngw) prep_weight_item(p, ws_b, item, scr, lane);
    }
    {
        bf16_t* TABL = (bf16_t*)(ws_b + WS_TABL);
        for (size_t e = gt; e < (size_t)2048 * 4096; e += ngt) {
            const int k = (int)(e >> 12), kk = (int)(e & 4095), lidx = kk & 2047;
            const int idx = (k * lidx) & 2047;
            float sn, cs; sincospif((float)idx * (2.f / 2048.f), &sn, &cs);
            TABL[e] = f2bf((kk < 2048 ? cs : -sn) * 0.022097086912079608f);
        }
        bf16_t* TABC = (bf16_t*)(ws_b + WS_TABC);
        for (size_t e = gt; e < (size_t)256 * 512; e += ngt) {
            const int k = (int)(e >> 9), kk = (int)(e & 511), lidx = kk & 255;
            const int idx = (k * lidx) & 255;
            float sn, cs; sincospif((float)idx * (2.f / 256.f), &sn, &cs);
            TABC[e] = f2bf((kk < 256 ? cs : -sn) * 0.0625f);
        }
        bf16_t* WCS = (bf16_t*)(ws_b + WS_WCS);
        for (size_t e = gt; e < (size_t)256 * 128; e += ngt) {
            const int i = (int)(e >> 7), c = (int)(e & 127), m = i >> 1, cs_ = i & 1;
            const int idx = (m * c) & 127;
            float sn, cs; sincospif((float)idx * (2.f / 128.f), &sn, &cs);
            WCS[e] = f2bf((cs_ ? sn : cs) * 0.08838834764831845f);
        }
        float* ROPE = (float*)(ws_b + WS_ROPE);
        for (size_t e = gt; e < 512; e += ngt) {
            const int pos = (int)(e >> 3), i = (int)(e & 7);
            const float inv_freq = powf(10000.f, -(float)i / 8.f);
            const float ang = (float)pos * inv_freq;
            ROPE[e] = cosf(ang); ROPE[512 + e] = sinf(ang);
        }
    }
    {
        bf16_t* CCKV = (bf16_t*)(ws_b + WS_CCKV);
        for (size_t e = gt; e < (size_t)NL * 1024 * 256; e += ngt) {
            const int c = (int)(e & 255), i = (int)((e >> 8) & 511), b = (int)((e >> 17) & 1), l = (int)(e >> 18);
            CCKV[e] = f2bf(pin(p, 2)[((size_t)(b * 4 + l) * 512 + i) * 256 + c]);
        }
        bf16_t* CKR = (bf16_t*)(ws_b + WS_CKR);
        for (size_t e = gt; e < (size_t)NL * 1024 * 32; e += ngt) {
            const int c = (int)(e & 31), i = (int)((e >> 5) & 511), b = (int)((e >> 14) & 1), l = (int)(e >> 15);
            CKR[e] = f2bf(pin(p, 3)[((size_t)(b * 4 + l) * 512 + i) * 32 + c]);
        }
        bf16_t* CNAK = (bf16_t*)(ws_b + WS_CNAK);
        for (size_t e = gt; e < (size_t)NL * 1024 * 512; e += ngt) {
            const int c = (int)(e & 511), i = (int)((e >> 9) & 511), b = (int)((e >> 18) & 1), l = (int)(e >> 19);
            CNAK[e] = f2bf(pin(p, 4)[((size_t)(b * 4 + l) * 512 + i) * 512 + c]);
        }
        bf16_t* CNAVT = (bf16_t*)(ws_b + WS_CNAVT);
        for (size_t e = gt; e < (size_t)NL * 1024 * 512; e += ngt) {
            const int key = (int)(e & 511), hd = (int)((e >> 9) & 511), b = (int)((e >> 18) & 1), l = (int)(e >> 19);
            CNAVT[e] = f2bf(pin(p, 5)[((size_t)(b * 4 + l) * 512 + key) * 512 + hd]);
        }
    }
}

DEVI void phase_modreduce(const P& p, unsigned char* ws_b, int tid) {
    const float* MODP = (const float*)(ws_b + WS_MODP);
    float* MOD = (float*)(ws_b + WS_MOD);
    for (int e = blockIdx.x * NTHREADS + tid; e < NL * 3 * 9216; e += gridDim.x * NTHREADS) {
        const int l = e / (3 * 9216), rem = e % (3 * 9216);
        float a = pin(p, 9)[l * 9216 + (rem % 9216)];
#pragma unroll
        for (int kc = 0; kc < 16; ++kc) a += MODP[((size_t)(l * 16 + kc) * 3) * 9216 + rem];
        MOD[e] = a;
    }
}

#define XB_TMO      128
#define XB_XCNT(j)  (256  + 64 * (j))
#define XB_XSUB(j)  (1280 + 64 * (j))
#define XB_XGEN(j)  (2304 + 64 * (j))
#define XB_TOP      3328
#define XB_TOPGEN   3392
#define XCD_BAR_WORDS 3456
#define XB_SPIN_CAP (1u << 20)
#define LAS __attribute__((address_space(3)))
DEVI unsigned xb_ld(unsigned* p)              { return __hip_atomic_load(p, __ATOMIC_RELAXED, __HIP_MEMORY_SCOPE_AGENT); }
DEVI unsigned xb_add(unsigned* p, unsigned v) { return __hip_atomic_fetch_add(p, v, __ATOMIC_RELAXED, __HIP_MEMORY_SCOPE_AGENT); }
DEVI unsigned xb_xcc_id() { return (unsigned)__builtin_amdgcn_s_getreg((3 << 11) | 20) & 0xFu; }
#define XB_SPIN(cond, bar) do { unsigned _sp = 0; while (cond) { __builtin_amdgcn_s_sleep(1); \
    if ((++_sp & 255u) == 0u) { if (xb_ld(&(bar)[XB_TMO])) break; if (_sp > XB_SPIN_CAP) { atomicAdd(&(bar)[XB_TMO], 1u); break; } } } } while (0)
struct XcdBarrier { unsigned* bar; unsigned x; volatile LAS unsigned* st; };
DEVI XcdBarrier xcd_barrier_post(unsigned* bar, volatile LAS unsigned* st) {
    XcdBarrier b; b.bar = bar; b.x = xb_xcc_id(); b.st = st;
    if (threadIdx.x == 0) (void)xb_add(&bar[XB_XCNT(b.x)], 1u);
    return b;
}
DEVI void xcd_barrier_complete(unsigned* bar, unsigned x, unsigned& nloc, unsigned& nx) {
    const unsigned G = gridDim.x * gridDim.y * gridDim.z;
    unsigned sum, cnt, mine, sp = 0u;
    for (;;) {
        sum = 0u; cnt = 0u; mine = 0u;
#pragma unroll
        for (unsigned j = 0; j < 16; ++j) { const unsigned c = xb_ld(&bar[XB_XCNT(j)]); sum += c; cnt += (c > 0u) ? 1u : 0u; mine = (j == x) ? c : mine; }
        if (sum == G) break;
        __builtin_amdgcn_s_sleep(1);
        if ((++sp & 255u) == 0u) { if (xb_ld(&bar[XB_TMO])) break; if (sp > XB_SPIN_CAP) { atomicAdd(&bar[XB_TMO], 1u); break; } }
    }
    nloc = mine > 0u ? mine : 1u; nx = cnt > 0u ? cnt : 1u;
}
DEVI void xcd_barrier(const XcdBarrier& b) {
    asm volatile("s_waitcnt vmcnt(0)" ::: "memory");
    __syncthreads();
    if (threadIdx.x == 0) {
        unsigned* bar = b.bar;
        __builtin_amdgcn_s_waitcnt(0);
        unsigned nloc = b.st[0], nx = b.st[1];
        if (nloc == 0u) { xcd_barrier_complete(bar, b.x, nloc, nx); b.st[0] = nloc; b.st[1] = nx; }
        const unsigned old = xb_add(&bar[XB_XSUB(b.x)], 1u);
        const unsigned gen = old / nloc;
        if (old + 1u == (gen + 1u) * nloc) {
            __builtin_amdgcn_fence(__ATOMIC_RELEASE, "agent");
            asm volatile("s_waitcnt vmcnt(0)" ::: "memory");
            const unsigned og = xb_add(&bar[XB_TOP], 1u);
            const unsigned tg = og / nx;
            if (og + 1u == (tg + 1u) * nx) xb_add(&bar[XB_TOPGEN], 1u);
            else XB_SPIN(xb_ld(&bar[XB_TOPGEN]) == tg, bar);
            __builtin_amdgcn_fence(__ATOMIC_ACQUIRE, "agent");
            xb_add(&bar[XB_XGEN(b.x)], 1u);
            asm volatile("s_waitcnt vmcnt(0)" ::: "memory");
        } else {
            XB_SPIN(xb_ld(&bar[XB_XGEN(b.x)]) == gen, bar);
            __builtin_amdgcn_fence(__ATOMIC_ACQUIRE, "agent");
            asm volatile("s_waitcnt vmcnt(0)" ::: "memory");
        }
    }
    __syncthreads();
}

DEVI void run_phase(const P& p, unsigned char* ws_b, int ph, unsigned char* smem, int tid) {
    const int lane = tid & 63, wave = tid >> 6;
    const int gw = blockIdx.x * NWAVES + wave, ngw = gridDim.x * NWAVES;
    const int nb = gridDim.x, bid = blockIdx.x;
    const int grp = tid >> 8, ltid = tid & 255;
    bf16_t* sm = (bf16_t*)smem + grp * (SMEM_BYTES / 2);
    if (ph == 0) { phase_prep(p, ws_b, smem, tid); return; }
    if (ph == 1) { phase_modreduce(p, ws_b, tid); return; }
    if (ph == 2) { phase_rows(p, ws_b, 0, -1, 0, 0, false, gw, ngw, lane); return; }
    const int l = (ph - 3) / 13, s = (ph - 3) % 13;
    const bf16_t* Wl = (const bf16_t*)(ws_b + WS_W) + (size_t)l * LAYER_W;
    const float* MODl = (const float*)(ws_b + WS_MOD) + (size_t)l * 3 * 9216;
    switch (s) {
    case 0: case 10:
        {
            pg8::Gemm g{(const bf16_t*)(ws_b + WS_H), Wl + (s == 10 ? OFF_W13_2 : OFF_W13_1), M, 2 * DFF, D};
            pg8::StaticOrder S; S.init(M, 2 * DFF, nb, bid);
            pg8::EpiSwiGLU E{(bf16_t*)(ws_b + WS_ACT)};
            pg8::gemm_phase<pg8::EpiSwiGLU, pg8::StaticOrder, true, true>((PG8_LAS unsigned char*)smem, g, S, E, tid);
        }
        break;
    case 1: case 11:
        {
            pg8::Gemm g{(const bf16_t*)(ws_b + WS_ACT), Wl + (s == 11 ? OFF_W2_2 : OFF_W2_1), M, D, DFF};
            pg8::StaticOrder S; S.init(M, D, nb, bid);
            pg8::EpiResid E{(float*)(ws_b + WS_X), MODl + (s == 11 ? 8 : 2) * D, 0.5f};
            pg8::gemm_phase<pg8::EpiResid, pg8::StaticOrder, false, true>((PG8_LAS unsigned char*)smem, g, S, E, tid);
        }
        break;
    case 2: phase_rows(p, ws_b, l, 0, l, 3, false, gw, ngw, lane); break;
    case 3:
        {
            pg8::Gemm g{(const bf16_t*)(ws_b + WS_H), Wl + OFF_WIN, M, 5888, D};
            pg8::InGateOrder S{nb, bid, 0, nb == 256 ? 1024 : 1104};
            pg8::EpiIn E{ws_b, p.out, pin(p, 26), l};
            pg8::gemm_phase<pg8::EpiIn, pg8::InGateOrder, true, true>((PG8_LAS unsigned char*)smem, g, S, E, tid);
        }
        break;
    case 4: phase_rowmix(p, ws_b, l, gw, ngw, lane); break;
    case 5: {
        float* ex = (float*)smem + (wave & 3) * (34 * 64);
        int u = bid;
        for (; u < 256; u += nb) {
            const int wi = u * 4 + (wave & 3);
            float* rpb_lds = (float*)(smem + 36864);
            {
                const float* rsrc = pin(p, 21) + (size_t)(l * 8 + ((u * 4 >> 6) & 7)) * 465;
                if (tid < 465) rpb_lds[tid] = rsrc[tid] * LOG2E;
                __syncthreads();
            }
            attn_na_lat(p, ws_b, l, wi >> 9, (wi >> 6) & 7, (wi >> 1) & 31, wi & 1, lane, ex, wave >> 2, rpb_lds);
        }
        for (; u < 256 + 416; u += nb) job_ukv(p, ws_b, l, 2 * (u - 256) + grp, sm, ltid);
        for (; u < 256 + 416 + 288; u += nb) job_uq(p, ws_b, l, 2 * (u - 256 - 416) + grp, sm, ltid);
        for (; u < 256 + 416 + 288 + 384; u += nb) job_f1(p, ws_b, 2 * (u - 256 - 416 - 288) + grp, sm, ltid);
        for (; u < 256 + 416 + 288 + 384 + 256; u += nb) {
            const int wi = (u - 256 - 416 - 288 - 384) * 8 + wave;
            const int b = wi >> 6, h = (wi >> 3) & 7, qrow = b * 256 + wave * 32 + (lane & 31);
            attn_ctx_shared<4>((const bf16_t*)(ws_b + WS_NAK) + (size_t)(b * 256) * 512 + h * 64, nullptr,
                               (const bf16_t*)(ws_b + WS_NAVT) + (size_t)((b * 8 + h) * 64) * 256,
                               (const bf16_t*)(ws_b + WS_NAQ) + (size_t)qrow * 512 + h * 64 + (lane >> 5) * 8,
                               (bf16_t*)(ws_b + WS_YN) + (size_t)qrow * 512 + h * 64, tid, smem);
        }
    } break;
    case 6: {
        float* ex = (float*)smem + (wave & 3) * (34 * 64);
        int u = bid;
        for (; u < 256; u += nb) {
            const int wi = u * 4 + (wave & 3);
            attn_mla_lat_shared(p, ws_b, l, wi >> 9, (wi >> 6) & 7, wi & 63, tid, smem, ex);
        }
        for (; u < 256 + 128; u += nb) {
            const int t0 = u - 256, tt = ((t0 & 7) + 8 * ((t0 >> 3) >> 2)) * 4 + ((t0 >> 3) & 3);
            job_f2_lat(p, ws_b, tt, sm, ltid, grp, (float*)(smem + SMEM_BYTES));
        }
        for (; u < 256 + 128 + 128; u += nb) job_f2_ctx(p, ws_b, 2 * (u - 256 - 128) + grp, sm, ltid);
        int it = (nb == 256) ? (bid >= 128 ? bid - 128 : 1 << 20) : u - (256 + 128 + 128);
        for (; it < 256; ) {
            const int wi = it * 8 + wave;
            const int b = wi >> 6, h = (wi >> 3) & 7, qrow = b * 256 + wave * 32 + (lane & 31);
            attn_ctx_shared<6>((const bf16_t*)(ws_b + WS_KN) + (size_t)(b * 256) * 512 + h * 64, (const bf16_t*)(ws_b + WS_KR) + (size_t)(b * 256) * 32,
                               (const bf16_t*)(ws_b + WS_VTM) + (size_t)((b * 8 + h) * 64) * 256,
                               (const bf16_t*)(ws_b + WS_Q) + (size_t)qrow * 768 + h * 96 + (lane >> 5) * 8,
                               (bf16_t*)(ws_b + WS_YM) + (size_t)qrow * 512 + h * 64, tid, smem);
            if (nb != 256) it += nb;
            else if (bid < 208) it = 1 << 20;
            else it = (it < 128) ? 128 + (bid - 208) : it + 48;
        }
        if (nb == 256 && bid >= 128 && bid < 208) {
            int tid5 = tid; asm volatile("" : "+v"(tid5));
            pg8::Gemm g{(const bf16_t*)(ws_b + WS_H), Wl + OFF_WIN, M, 5888, D};
            pg8::InGateOrder S{1 << 20, bid - 128, 1024, 1104};
            pg8::EpiIn E{ws_b, p.out, pin(p, 26), l};
            pg8::gemm_phase<pg8::EpiIn, pg8::InGateOrder, false, true>((PG8_LAS unsigned char*)smem, g, S, E, tid5);
        }
    } break;
    case 7:

#pragma nounroll
        for (int sg = 0; sg < 3; ++sg) {
            int tid3 = tid; asm volatile("" : "+v"(tid3));
            pg8::Gemm g{(const bf16_t*)(ws_b + (sg == 0 ? WS_YF : (sg == 1 ? WS_YM : WS_YN))), Wl + (sg == 0 ? OFF_WBF : (sg == 1 ? OFF_WBM : OFF_WBN)), M, D, 512};
            pg8::StaticOrder S; S.init(M, D, nb, bid);
            pg8::EpiMerge E{(const bf16_t*)(ws_b + WS_GATE), (bf16_t*)(ws_b + WS_UF)  , (bf16_t*)(ws_b + WS_MERGED), sg};
            pg8::gemm_phase<pg8::EpiMerge, pg8::StaticOrder, false, true>((PG8_LAS unsigned char*)smem, g, S, E, tid3);
        }
        break;
    case 8:
        {
            pg8::Gemm g{(const bf16_t*)(ws_b + WS_MERGED), Wl + OFF_WOUT, M, D, D};
            pg8::StaticOrder S; S.init(M, D, nb, bid);
            pg8::EpiResid E{(float*)(ws_b + WS_X), MODl + 5 * D, 1.0f};
            pg8::gemm_phase<pg8::EpiResid, pg8::StaticOrder, false, true>((PG8_LAS unsigned char*)smem, g, S, E, tid);
        }
        break;
    case 9: phase_rows(p, ws_b, l, 1, l, 6, false, gw, ngw, lane); break;
    case 12:
        if (l == NL - 1) phase_rows(p, ws_b, l, 2, 0, 0, true, gw, ngw, lane);
        else phase_rows(p, ws_b, l, 2, l + 1, 0, false, gw, ngw, lane);
        break;
    default: break;
    }
}

__global__ void __launch_bounds__(NTHREADS, 2) mega_kernel(P p) {
    extern __shared__ __attribute__((aligned(16))) unsigned char smem[];
    __shared__ uint4 xb_words;
    cg::grid_group grid = cg::this_grid();
    const int tid = threadIdx.x;
    unsigned* bar = (unsigned*)(p.ws + WS_BAR);
    if (tid == 0) xb_words = make_uint4(0u, 0u, 0u, 0u);
    if (p.ph_lo == 0 && blockIdx.x == 0) for (int i = tid; i < XCD_BAR_WORDS; i += NTHREADS) bar[i] = 0u;
    __syncthreads();
    XcdBarrier xb; xb.bar = bar; xb.x = 0; xb.st = (volatile LAS unsigned*)&xb_words;
#pragma nounroll
    for (int ph = p.ph_lo; ph < p.ph_hi; ++ph) {
        int tid2 = tid; asm volatile("" : "+v"(tid2));
        unsigned char* ws_b = p.ws; asm volatile("" : "+s"(ws_b));
        run_phase(p, ws_b, ph, smem, tid2);
        if (ph + 1 < p.ph_hi) {
            if (ph == p.ph_lo) { grid.sync(); xb = xcd_barrier_post(bar, (volatile LAS unsigned*)&xb_words); }
            else xcd_barrier(xb);
        }
    }
}

extern "C" void kernel_launch(void* const* d_in, const int* in_sizes, int n_in, void* d_out, int out_size, void* d_ws, size_t ws_size,
                              hipStream_t stream) {
    static int grid_blocks = 0;
    if (grid_blocks == 0) {
        if (n_in != 30 || ws_size < WS_END) { fprintf(stderr, "kernel_launch: n_in %d ws %zu need %zu\n", n_in, ws_size, (size_t)WS_END); grid_blocks = -1; return; }
        int dev = 0, cus = 0, per_cu = 0;
        hipGetDevice(&dev);
        hipDeviceGetAttribute(&cus, hipDeviceAttributeMultiprocessorCount, dev);
        hipFuncSetAttribute((const void*)mega_kernel, hipFuncAttributeMaxDynamicSharedMemorySize, LDS_TOTAL);
        hipOccupancyMaxActiveBlocksPerMultiprocessor(&per_cu, (const void*)mega_kernel, NTHREADS, LDS_TOTAL);
        if (per_cu < 1) per_cu = 1;
        if (per_cu > 1) per_cu = 1;
        grid_blocks = cus * per_cu;
    }
    if (grid_blocks < 0) return;
    P p{};
    for (int i = 0; i < 30; ++i) p.in[i] = (const float*)d_in[i];
    p.out = (float*)d_out; p.ws = (unsigned char*)d_ws; p.ph_lo = 0; p.ph_hi = NPHASE;
#ifndef MULTI_LAUNCH
#define MULTI_LAUNCH 0
#endif
#if MULTI_LAUNCH
    for (int ph = 0; ph < NPHASE; ++ph) {
        p.ph_lo = ph; p.ph_hi = ph + 1;
        hipLaunchKernelGGL(mega_kernel, dim3(grid_blocks), dim3(NTHREADS), LDS_TOTAL, stream, p);
    }
#else
    void* args[] = {&p};
    hipError_t e = hipLaunchCooperativeKernel((const void*)mega_kernel, dim3(grid_blocks), dim3(NTHREADS), args, LDS_TOTAL, stream);
    if (e != hipSuccess) fprintf(stderr, "cooperative launch failed: %s (grid %d)\n", hipGetErrorString(e), grid_blocks);
#endif
}
```

```cpp
#include <hip/hip_runtime.h>
#include <hip/hip_cooperative_groups.h>
#include <cstdint>
#include <cstdio>
namespace cg = cooperative_groups;

typedef unsigned short bf16_t;
typedef short bf16x8 __attribute__((ext_vector_type(8)));
typedef float f32x16 __attribute__((ext_vector_type(16)));
typedef float f32x4 __attribute__((ext_vector_type(4)));
typedef unsigned u32x4 __attribute__((ext_vector_type(4)));
typedef unsigned u32x2 __attribute__((ext_vector_type(2)));
#define DEVI __device__ __forceinline__

constexpr int D = 1024, NCTX = 8192, NLAT = 4096, M = 12288, MX = 13312, DFF = 2816, NL = 4;
constexpr float ALPHA_F = 1.6817928305074290f;
constexpr float LOG2E = 1.4426950408889634f;
constexpr float MLA_QS = 0.10206207261596575f * LOG2E;
constexpr float NA_QS = 0.125f * LOG2E;
constexpr size_t OUT_CKV = 12582912, OUT_KR = 20971520, OUT_NAK = 22020096, OUT_NAV = 38797312;

constexpr size_t al256(size_t x) { return (x + 255) & ~(size_t)255; }
constexpr size_t WS_BAR = 0;
constexpr size_t WS_X = 16384;
constexpr size_t WS_H = WS_X + (size_t)M * D * 4;
constexpr size_t WS_MOD = WS_H + (size_t)M * D * 2;
constexpr size_t WS_MODP = WS_MOD + al256((size_t)NL * 3 * 9216 * 4);
constexpr size_t WS_ROPE = WS_MODP + al256((size_t)NL * 16 * 3 * 9216 * 4);
constexpr size_t WS_TABC = WS_ROPE + 4096;
constexpr size_t WS_TABL = WS_TABC + (size_t)256 * 512 * 2;
constexpr size_t WS_WCS = WS_TABL + (size_t)2048 * 4096 * 2;
constexpr size_t WS_CCKV = WS_WCS + (size_t)256 * 128 * 2;
constexpr size_t WS_CKR = WS_CCKV + (size_t)NL * 1024 * 256 * 2;
constexpr size_t WS_CNAK = WS_CKR + (size_t)NL * 1024 * 32 * 2;
constexpr size_t WS_CNAVT = WS_CNAK + (size_t)NL * 1024 * 512 * 2;
constexpr size_t WS_W = WS_CNAVT + (size_t)NL * 1024 * 512 * 2;
constexpr size_t OFF_W13_1 = 0, OFF_W2_1 = 5767168, OFF_W13_2 = 8650752, OFF_W2_2 = 14417920, OFF_WIN = 17301504,
                 OFF_WOUT = 23330816, OFF_WBF = 24379392, OFF_WBM = 24903680, OFF_WBN = 25427968, OFF_WUQ = 25952256,
                 OFF_WUKV = 26247168, LAYER_W = 26509312;
constexpr size_t WS_R1 = WS_W + (size_t)NL * LAYER_W * 2;
constexpr size_t WS_ACT = WS_R1;
constexpr size_t WS_UF = WS_R1;
constexpr size_t WS_UQ = WS_UF + (size_t)M * 512 * 2;
constexpr size_t WS_UKV = WS_UQ + (size_t)M * 384 * 2;
constexpr size_t WS_KRF = WS_UKV + (size_t)M * 256 * 4;
constexpr size_t WS_CKV = WS_KRF + (size_t)M * 32 * 4;
constexpr size_t WS_KR = WS_CKV + (size_t)M * 256 * 2;
constexpr size_t WS_NAQ = WS_KR + (size_t)M * 32 * 2;
constexpr size_t WS_NAK = WS_NAQ + (size_t)M * 512 * 2;
constexpr size_t WS_NAVT = WS_NAK + (size_t)M * 512 * 2;
constexpr size_t WS_GATE = WS_NAVT + (size_t)M * 512 * 2;
constexpr size_t WS_Q = WS_GATE + (size_t)M * 3072 * 2;
constexpr size_t WS_KN = WS_Q + (size_t)M * 768 * 2;
constexpr size_t WS_VTM = WS_KN + (size_t)MX * 512 * 2;
constexpr size_t WS_F1T = WS_VTM + (size_t)MX * 512 * 2;
constexpr size_t WS_YF = WS_F1T + (size_t)M * 1024 * 2;
constexpr size_t WS_YM = WS_YF + (size_t)M * 512 * 2;
constexpr size_t WS_YN = WS_YM + (size_t)M * 512 * 2;
constexpr size_t WS_MERGED = WS_YN + (size_t)M * 512 * 2;
constexpr size_t WS_END = WS_MERGED + (size_t)M * 1024 * 2;
static_assert(WS_END - WS_R1 >= (size_t)M * DFF * 2, "ACT must fit in R1");
static_assert(WS_NAK - WS_UF >= (size_t)M * D * 4, "merge T32 must fit in the dead UF..NAQ buffers");

constexpr int NPHASE = 3 + 13 * NL;

struct P {
    const float* in[30];
    float* out;
    unsigned char* ws;
    int ph_lo, ph_hi;
};

__device__ __forceinline__ const float* pin(const P& p, int i) { int j = i; asm volatile("" : "+s"(j)); return p.in[j]; }
typedef __bf16 bf16v2 __attribute__((ext_vector_type(2)));
typedef float f32x2 __attribute__((ext_vector_type(2)));
DEVI unsigned pk2(float lo, float hi) { f32x2 v = {lo, hi}; bf16v2 b = __builtin_convertvector(v, bf16v2); return __builtin_bit_cast(unsigned, b); }
DEVI bf16_t f2bf(float x) { return (bf16_t)(pk2(x, 0.f) & 0xffffu); }
DEVI float bf2f(unsigned v) { return __uint_as_float(v << 16); }
DEVI float wave_sum(float v) {
#pragma unroll
    for (int o = 1; o < 64; o <<= 1) v += __shfl_xor(v, o);
    return v;
}
DEVI float fast_exp2(float x) { return __builtin_amdgcn_exp2f(x); }
DEVI float sigmoidf_(float x) { return __builtin_amdgcn_rcpf(1.f + __expf(-x)); }

constexpr int LDT = 72;
constexpr int TILE_E = 128 * LDT;
constexpr int SMEM_BYTES = 4 * TILE_E * 2;
constexpr int NTHREADS = 512, NWAVES = 8, LDS_TOTAL = 2 * SMEM_BYTES;

DEVI void gemm_ldg(const bf16_t* ga, const bf16_t* gb, int lda, int ldb, u32x4 (&ra)[4], u32x4 (&rb)[4]) {
#pragma unroll
    for (int i = 0; i < 4; ++i) {
        ra[i] = *(const u32x4*)(ga + (size_t)(32 * i) * lda);
        rb[i] = *(const u32x4*)(gb + (size_t)(32 * i) * ldb);
    }
}
DEVI void gemm_sts(bf16_t* buf, int soff, const u32x4 (&ra)[4], const u32x4 (&rb)[4]) {
#pragma unroll
    for (int i = 0; i < 4; ++i) {
        *(u32x4*)(buf + soff + 32 * i * LDT) = ra[i];
        *(u32x4*)(buf + TILE_E + soff + 32 * i * LDT) = rb[i];
    }
}
DEVI void gemm_mma(const bf16_t* cur, int aoff, int boff, f32x16 (&acc)[2][2]) {
#pragma unroll
    for (int ks = 0; ks < 4; ++ks) {
        bf16x8 a0 = *(const bf16x8*)(cur + aoff + ks * 16);
        bf16x8 a1 = *(const bf16x8*)(cur + aoff + 32 * LDT + ks * 16);
        bf16x8 b0 = *(const bf16x8*)(cur + boff + ks * 16);
        bf16x8 b1 = *(const bf16x8*)(cur + boff + 32 * LDT + ks * 16);
        acc[0][0] = __builtin_amdgcn_mfma_f32_32x32x16_bf16(a0, b0, acc[0][0], 0, 0, 0);
        acc[0][1] = __builtin_amdgcn_mfma_f32_32x32x16_bf16(a0, b1, acc[0][1], 0, 0, 0);
        acc[1][0] = __builtin_amdgcn_mfma_f32_32x32x16_bf16(a1, b0, acc[1][0], 0, 0, 0);
        acc[1][1] = __builtin_amdgcn_mfma_f32_32x32x16_bf16(a1, b1, acc[1][1], 0, 0, 0);
    }
}

template <bool DEEP = true>
DEVI void gemm_core(const bf16_t* __restrict__ A, int lda, const bf16_t* __restrict__ B, int ldb, int K,
                    f32x16 (&acc)[2][2], bf16_t* smem, int tid) {
    const int lane = tid & 63, wave = tid >> 6, wr = wave >> 1, wc = wave & 1;
    const int lr = tid >> 3, lc = (tid & 7) * 8;
    const bf16_t* ga = A + (size_t)lr * lda + lc;
    const bf16_t* gb = B + (size_t)lr * ldb + lc;
    const int soff = lr * LDT + lc;
    const int nk = K >> 6;
    const int aoff = (wr * 64 + (lane & 31)) * LDT + (lane >> 5) * 8;
    const int boff = TILE_E + (wc * 64 + (lane & 31)) * LDT + (lane >> 5) * 8;
    bf16_t* buf0 = smem; bf16_t* buf1 = smem + 2 * TILE_E;
    if constexpr (DEEP) {
        u32x4 ra0[4], rb0[4], ra1[4], rb1[4];
        gemm_ldg(ga, gb, lda, ldb, ra0, rb0);
        gemm_ldg(ga + 64, gb + 64, lda, ldb, ra1, rb1);
        gemm_sts(buf0, soff, ra0, rb0);
        __syncthreads();
        for (int kt = 0; kt < nk; kt += 2) {
            if (kt + 2 < nk) gemm_ldg(ga + (size_t)(kt + 2) * 64, gb + (size_t)(kt + 2) * 64, lda, ldb, ra0, rb0);
            gemm_mma(buf0, aoff, boff, acc);
            gemm_sts(buf1, soff, ra1, rb1);
            __syncthreads();
            if (kt + 3 < nk) gemm_ldg(ga + (size_t)(kt + 3) * 64, gb + (size_t)(kt + 3) * 64, lda, ldb, ra1, rb1);
            gemm_mma(buf1, aoff, boff, acc);
            if (kt + 2 < nk) gemm_sts(buf0, soff, ra0, rb0);
            __syncthreads();
        }
    } else {
        u32x4 ra[4], rb[4];
        gemm_ldg(ga, gb, lda, ldb, ra, rb);
        gemm_sts(buf0, soff, ra, rb);
        __syncthreads();
        for (int kt = 0; kt < nk; ++kt) {
            bf16_t* cur = (kt & 1) ? buf1 : buf0;
            bf16_t* nxt = (kt & 1) ? buf0 : buf1;
            const bool more = (kt + 1 < nk);
            if (more) { ga += 64; gb += 64; gemm_ldg(ga, gb, lda, ldb, ra, rb); }
            gemm_mma(cur, aoff, boff, acc);
            if (more) gemm_sts(nxt, soff, ra, rb);
            __syncthreads();
        }
    }
}

DEVI void zero_acc(f32x16 (&acc)[2][2]) {
#pragma unroll
    for (int i = 0; i < 2; ++i)
#pragma unroll
        for (int j = 0; j < 2; ++j)
#pragma unroll
            for (int r = 0; r < 16; ++r) acc[i][j][r] = 0.f;
}

#define EPI_SETUP const int lane = tid & 63, wave = tid >> 6, wr = wave >> 1, wc = wave & 1, hl = lane >> 5, c32 = lane & 31; (void)wr; (void)wc; (void)hl; (void)c32;

DEVI int mod_group(int row) { return row < NCTX ? 0 : 1 + ((row - NCTX) >> 11); }

namespace pg8 {
#define PG8_LAS __attribute__((address_space(3)))
constexpr int BM = 256, BK = 64, HALF = 128, HTB = HALF * BK * 2, NXCD = 8, WGM = 8;
DEVI int lds_byte(int r, int c) { const int st = (r >> 4) * 2 + (c >> 5), rr = r & 15, cc = c & 31, ob = rr * 64 + cc * 2; return st * 1024 + (ob ^ (((ob >> 9) & 1) << 5)); }
DEVI void stage_rc(int b, int& R, int& C) { const int st = b / 1024, sb = b % 1024, swz = sb ^ (((sb >> 9) & 1) << 5); R = (st >> 1) * 16 + swz / 64; C = (st & 1) * 32 + (swz % 64) / 2; }
DEVI int perm32(int rho) { const int n = rho >> 4, i = rho & 15; return 8 * (i >> 2) + 4 * n + (i & 3); }
struct Unit { int pm, pn; };
struct Gemm { const bf16_t* A; const bf16_t* Bt; int M, N, K; };
struct StaticOrder {
    int nM, nN, nwg, G, c;
    DEVI void init(int M, int N, int G_, int c_) { nM = M / BM; nN = N / BM; nwg = nM * nN; G = G_; c = c_; }
    DEVI bool next(int i, Unit& u) const {
        const long L = (long)i * G + c; if (L >= nwg) return false;
        int wgid = (int)L; { const int q = nwg / NXCD, r = nwg % NXCD, xcd = wgid % NXCD, off = wgid / NXCD; wgid = (xcd < r ? xcd * (q + 1) : r * (q + 1) + (xcd - r) * q) + off; }
        const int nig = WGM * nN, gid = wgid / nig, fm = gid * WGM, gsz = (nM - fm) < WGM ? (nM - fm) : WGM;
        u.pm = fm + ((wgid % nig) % gsz); u.pn = (wgid % nig) / gsz; return true;
    }
    DEVI void a_ready(const Unit&) const {}
    DEVI void done(const Unit&) const {}
};
struct InGateOrder {
    int G, c, lo, hi;
    static DEVI void so_map(int wgid, int nM, int nN, Unit& u) {
        const int nwg = nM * nN;
        { const int q = nwg / NXCD, r = nwg % NXCD, xcd = wgid % NXCD, off = wgid / NXCD; wgid = (xcd < r ? xcd * (q + 1) : r * (q + 1) + (xcd - r) * q) + off; }
        const int nig = WGM * nN, gid = wgid / nig, fm = gid * WGM, gsz = (nM - fm) < WGM ? (nM - fm) : WGM;
        u.pm = fm + ((wgid % nig) % gsz); u.pn = (wgid % nig) / gsz;
    }
    DEVI bool next(int i, Unit& u) const {
        const long L = (long)i * G + c + lo; if (L >= hi) return false;
        if (L < 528) so_map((int)L, 48, 11, u); else { so_map((int)L - 528, 48, 12, u); u.pn += 11; }
        return true;
    }
    DEVI void a_ready(const Unit&) const {}
    DEVI void done(const Unit&) const {}
};
template <class Epi, class Sched, bool ALIGN_EPI = false, bool SP2 = false>
DEVI void gemm_phase(PG8_LAS unsigned char* lds, const Gemm g, const Sched& S, const Epi& E, const int tid) {
    const int wid = __builtin_amdgcn_readfirstlane(tid >> 6), lane = tid & 63, wr = wid >> 2, wc = wid & 3, fr = lane & 15, fq = lane >> 4;
    const int K = g.K, nt = K / BK;
    unsigned voffA[2], voffB[2];
#pragma unroll
    for (int i = 0; i < 2; ++i) { int R, C; stage_rc(tid * 16 + i * 8192, R, C); const int Rb = Epi::PERM ? ((R & ~31) + perm32(R & 31)) : R;
        voffA[i] = (unsigned)(R * K + C) * 2u; voffB[i] = (unsigned)(Rb * K + C) * 2u; }
    const size_t kstep = (size_t)(BK * 2);
    const size_t hstep = (size_t)HALF * K * 2;
    const size_t tstep = 2 * hstep;
    const unsigned ldsw = (unsigned)wid * 1024u;
    const int aoff = lds_byte(wr * 64 + fr, fq * 8), boff = lds_byte(wc * 32 + fr, fq * 8);
#define PG8_SA(b, h) (((b) * 2 + (h)) * HTB)
#define PG8_SB(b, h) ((4 + (b) * 2 + (h)) * HTB)
#define PG8_STAGE(bufoff, gbase, voff) do { _Pragma("unroll") for (int _i = 0; _i < 2; ++_i) \
        __builtin_amdgcn_global_load_lds((const unsigned*)((const char*)(gbase) + (voff)[_i]), (PG8_LAS unsigned*)(lds + (bufoff) + ldsw + _i * 8192), 16, 0, 0); } while (0)
#define PG8_LDA(dst, b, h) do { _Pragma("unroll") for (int m = 0; m < 4; ++m) _Pragma("unroll") for (int k = 0; k < 2; ++k) dst[m][k] = *(const PG8_LAS bf16x8*)(lds + PG8_SA(b, h) + aoff + m * 2048 + k * 1024); } while (0)
#define PG8_LDB(dst, b, h) do { _Pragma("unroll") for (int n = 0; n < 2; ++n) _Pragma("unroll") for (int k = 0; k < 2; ++k) dst[n][k] = *(const PG8_LAS bf16x8*)(lds + PG8_SB(b, h) + boff + n * 2048 + k * 1024); } while (0)
#define PG8_MMA(ai, bj, At, Bt) do { __builtin_amdgcn_s_setprio(1); _Pragma("unroll") for (int m = 0; m < 4; ++m) _Pragma("unroll") for (int n = 0; n < 2; ++n) _Pragma("unroll") for (int k = 0; k < 2; ++k) \
        acc[ai][bj][m][n] = __builtin_amdgcn_mfma_f32_16x16x32_bf16(Bt[n][k], At[m][k], acc[ai][bj][m][n], 0, 0, 0); __builtin_amdgcn_s_setprio(0); } while (0)
#define PG8_WAIT_V(n) asm volatile("s_waitcnt vmcnt(" #n ")" ::: "memory")
#define PG8_WAIT_L(n) asm volatile("s_waitcnt lgkmcnt(" #n ")" ::: "memory")
#define PG8_BAR __builtin_amdgcn_s_barrier()
#define PG8_SCHED __builtin_amdgcn_sched_barrier(0)
    Unit cur, nxt; int ui = 0;
    if (!S.next(0, cur)) return;
    f32x4 acc[2][2][4][2];
#pragma unroll
    for (int a = 0; a < 2; ++a)
#pragma unroll
        for (int b = 0; b < 2; ++b)
#pragma unroll
            for (int m = 0; m < 4; ++m)
#pragma unroll
                for (int n = 0; n < 2; ++n) acc[a][b][m][n] = (f32x4){0.f, 0.f, 0.f, 0.f};
    bf16x8 At[4][2], B0[2][2], B1[2][2];
    const char* cA = (const char*)g.A + (size_t)cur.pm * tstep; const char* cB = (const char*)g.Bt + (size_t)cur.pn * tstep;
    S.a_ready(cur);
    if constexpr (SP2) {
        PG8_STAGE(PG8_SB(0, 0), cB, voffB); PG8_STAGE(PG8_SB(0, 1), cB + hstep, voffB); PG8_STAGE(PG8_SA(0, 0), cA, voffA); PG8_STAGE(PG8_SA(0, 1), cA + hstep, voffA);
        if (wr == 1) PG8_BAR;
        PG8_WAIT_V(2); PG8_BAR;
        PG8_STAGE(PG8_SB(1, 0), cB + kstep, voffB); PG8_STAGE(PG8_SA(1, 0), cA + kstep, voffA); PG8_STAGE(PG8_SB(1, 1), cB + hstep + kstep, voffB);
        PG8_WAIT_V(6); PG8_BAR;
    } else {
        PG8_STAGE(PG8_SB(0, 0), cB, voffB); PG8_STAGE(PG8_SA(0, 0), cA, voffA); PG8_STAGE(PG8_SB(0, 1), cB + hstep, voffB); PG8_STAGE(PG8_SA(0, 1), cA + hstep, voffA);
        if (wr == 1) PG8_BAR;
        PG8_WAIT_V(4); PG8_BAR;
        PG8_STAGE(PG8_SB(1, 0), cB + kstep, voffB); PG8_STAGE(PG8_SA(1, 0), cA + kstep, voffA); PG8_STAGE(PG8_SB(1, 1), cB + hstep + kstep, voffB);
        PG8_WAIT_V(6); PG8_BAR;
    }
    for (;;) {
        const bool has_next = S.next(ui + 1, nxt);
        const char* nA = has_next ? (const char*)g.A + (size_t)nxt.pm * tstep : cA; const char* nB = has_next ? (const char*)g.Bt + (size_t)nxt.pn * tstep : cB;
        for (int t = 0; t < nt; t += 2) {
            const bool last = (t == nt - 2);
            const char* a1 = cA + (size_t)(t + 1) * kstep;
            const char* a2 = last ? nA : cA + (size_t)(t + 2) * kstep; const char* b2 = last ? nB : cB + (size_t)(t + 2) * kstep;
            const char* a3 = a2 + kstep; const char* b3 = b2 + kstep;
            if (last && has_next) S.a_ready(nxt);
            if constexpr (SP2) {
            PG8_LDB(B0, 0, 0); PG8_LDB(B1, 0, 1); PG8_SCHED; PG8_LDA(At, 0, 0); PG8_STAGE(PG8_SA(1, 1), a1 + hstep, voffA);
            PG8_WAIT_V(8); PG8_WAIT_L(0); PG8_BAR; PG8_MMA(0, 0, At, B0); PG8_MMA(0, 1, At, B1); PG8_BAR; PG8_SCHED;
            PG8_LDA(At, 0, 1); PG8_STAGE(PG8_SB(0, 0), b2, voffB); PG8_STAGE(PG8_SB(0, 1), b2 + hstep, voffB); PG8_STAGE(PG8_SA(0, 0), a2, voffA);
            PG8_WAIT_V(8); PG8_WAIT_L(0); PG8_BAR; PG8_MMA(1, 0, At, B0); PG8_MMA(1, 1, At, B1); PG8_BAR; PG8_SCHED;
            PG8_LDB(B0, 1, 0); PG8_LDB(B1, 1, 1); PG8_SCHED; PG8_LDA(At, 1, 0); PG8_STAGE(PG8_SA(0, 1), a2 + hstep, voffA);
            PG8_WAIT_V(8); PG8_WAIT_L(0); PG8_BAR; PG8_MMA(0, 0, At, B0); PG8_MMA(0, 1, At, B1); PG8_BAR; PG8_SCHED;
            PG8_LDA(At, 1, 1); PG8_STAGE(PG8_SB(1, 0), b3, voffB); PG8_STAGE(PG8_SB(1, 1), b3 + hstep, voffB); PG8_STAGE(PG8_SA(1, 0), a3, voffA);
            PG8_WAIT_V(8); PG8_WAIT_L(0); PG8_BAR; PG8_MMA(1, 0, At, B0); PG8_MMA(1, 1, At, B1); PG8_BAR; PG8_SCHED;
            } else {
            PG8_LDB(B0, 0, 0); PG8_SCHED; PG8_LDA(At, 0, 0); PG8_STAGE(PG8_SA(1, 1), a1 + hstep, voffA);
            PG8_WAIT_L(8); PG8_BAR; PG8_WAIT_L(0); PG8_MMA(0, 0, At, B0); PG8_BAR; PG8_SCHED;
            PG8_LDB(B1, 0, 1); PG8_STAGE(PG8_SB(0, 0), b2, voffB);
            PG8_BAR; PG8_WAIT_L(0); PG8_MMA(0, 1, At, B1); PG8_BAR;
            PG8_LDA(At, 0, 1); PG8_STAGE(PG8_SA(0, 0), a2, voffA);
            PG8_BAR; PG8_WAIT_L(0); PG8_MMA(1, 0, At, B0); PG8_BAR; PG8_SCHED;
            PG8_STAGE(PG8_SB(0, 1), b2 + hstep, voffB);
            PG8_WAIT_V(6); PG8_BAR; PG8_MMA(1, 1, At, B1); PG8_BAR;
            PG8_LDB(B0, 1, 0); PG8_SCHED; PG8_LDA(At, 1, 0); PG8_STAGE(PG8_SA(0, 1), a2 + hstep, voffA);
            PG8_WAIT_L(8); PG8_BAR; PG8_WAIT_L(0); PG8_MMA(0, 0, At, B0); PG8_BAR; PG8_SCHED;
            PG8_LDB(B1, 1, 1); PG8_STAGE(PG8_SB(1, 0), b3, voffB);
            PG8_BAR; PG8_WAIT_L(0); PG8_MMA(0, 1, At, B1); PG8_BAR;
            PG8_LDA(At, 1, 1); PG8_STAGE(PG8_SA(1, 0), a3, voffA);
            PG8_BAR; PG8_WAIT_L(0); PG8_MMA(1, 0, At, B0); PG8_BAR; PG8_SCHED;
            PG8_STAGE(PG8_SB(1, 1), b3 + hstep, voffB);
            PG8_WAIT_V(6); PG8_BAR; PG8_MMA(1, 1, At, B1); PG8_BAR;
            }
        }
        if constexpr (ALIGN_EPI) { if (wr == 0) PG8_BAR; }
        E(acc, cur, wr, wc, fr, fq); S.done(cur);
        if (!has_next) break;
#pragma unroll
        for (int a = 0; a < 2; ++a)
#pragma unroll
            for (int b = 0; b < 2; ++b)
#pragma unroll
                for (int m = 0; m < 4; ++m)
#pragma unroll
                    for (int n = 0; n < 2; ++n) acc[a][b][m][n] = (f32x4){0.f, 0.f, 0.f, 0.f};
        cur = nxt; cA = nA; cB = nB; ++ui;
        if constexpr (ALIGN_EPI) { if (wr == 1) PG8_BAR; }
    }
    PG8_WAIT_V(0);
    if constexpr (!ALIGN_EPI) { if (wr == 0) PG8_BAR; }
    PG8_BAR;
#undef PG8_SA
#undef PG8_SB
#undef PG8_STAGE
#undef PG8_LDA
#undef PG8_LDB
#undef PG8_MMA
#undef PG8_WAIT_V
#undef PG8_WAIT_L
#undef PG8_BAR
#undef PG8_SCHED
}

struct EpiSwiGLU {
    static constexpr bool PERM = false;
    bf16_t* ACT;
    DEVI void operator()(const f32x4 (&acc)[2][2][4][2], const Unit& u, int wr, int wc, int fr, int fq) const {
#pragma unroll
        for (int ai = 0; ai < 2; ++ai)
#pragma unroll
            for (int m = 0; m < 4; ++m) {
                const int row = u.pm * BM + ai * HALF + wr * 64 + m * 16 + fr;
                bf16_t* rp = ACT + (size_t)row * DFF + 16 * (8 * u.pn + wc) + 4 * fq;
#pragma unroll
                for (int bj = 0; bj < 2; ++bj) {
                    const f32x4 a = acc[ai][bj][m][0], b = acc[ai][bj][m][1];
                    u32x2 pk;
                    pk.x = pk2(a[0] * sigmoidf_(a[0]) * b[0], a[1] * sigmoidf_(a[1]) * b[1]);
                    pk.y = pk2(a[2] * sigmoidf_(a[2]) * b[2], a[3] * sigmoidf_(a[3]) * b[3]);
                    *(u32x2*)(rp + 64 * bj) = pk;
                }
            }
    }
};
struct EpiResid {
    static constexpr bool PERM = false;
    float* X; const float* gate_base; float coef;
    DEVI void operator()(const f32x4 (&acc)[2][2][4][2], const Unit& u, int wr, int wc, int fr_, int fq_) const {
        int fr = fr_, fq = fq_; asm volatile("" : "+v"(fr), "+v"(fq));
        const float* gate = gate_base + (size_t)mod_group(u.pm * BM) * 9216;
        const int col0 = u.pn * BM + wc * 32 + 4 * fq;
        f32x4 gv[2][2];
#pragma unroll
        for (int bj = 0; bj < 2; ++bj)
#pragma unroll
            for (int n = 0; n < 2; ++n) gv[bj][n] = *(const f32x4*)(gate + col0 + bj * HALF + 16 * n) * coef;
#pragma unroll
        for (int ah = 0; ah < 4; ++ah) {
            const int ai = ah >> 1, mb = (ah & 1) * 2;
            f32x4 xv[4][2][2];
#pragma unroll
            for (int m = mb; m < mb + 2; ++m)
#pragma unroll
                for (int bj = 0; bj < 2; ++bj)
#pragma unroll
                    for (int n = 0; n < 2; ++n)
                        xv[m][bj][n] = *(const f32x4*)(X + (size_t)(u.pm * BM + ai * HALF + wr * 64 + m * 16 + fr) * D + col0 + bj * HALF + 16 * n);
            __builtin_amdgcn_sched_barrier(0);
#pragma unroll
            for (int m = mb; m < mb + 2; ++m)
#pragma unroll
                for (int bj = 0; bj < 2; ++bj)
#pragma unroll
                    for (int n = 0; n < 2; ++n)
                        *(f32x4*)(X + (size_t)(u.pm * BM + ai * HALF + wr * 64 + m * 16 + fr) * D + col0 + bj * HALF + 16 * n) =
                            xv[m][bj][n] * ALPHA_F + gv[bj][n] * acc[ai][bj][m][n];
            __builtin_amdgcn_sched_barrier(0);
        }
    }
};
struct EpiIn {
    static constexpr bool PERM = true;
    unsigned char* ws; float* out; const float* b_gate; int l;
    static DEVI u32x4 pack8(const f32x4& a, const f32x4& b, float s) {
        u32x4 w; w.x = pk2(a[0] * s, a[1] * s); w.y = pk2(a[2] * s, a[3] * s); w.z = pk2(b[0] * s, b[1] * s); w.w = pk2(b[2] * s, b[3] * s); return w;
    }
    DEVI void operator()(const f32x4 (&acc)[2][2][4][2], const Unit& u, int wr, int wc, int fr_, int fq_) const {
        int fr = fr_, fq = fq_; asm volatile("" : "+v"(fr), "+v"(fq));
        unsigned char* ws = this->ws; float* out = this->out; const float* b_gate = this->b_gate;
        asm volatile("" : "+s"(ws), "+s"(out), "+s"(b_gate));
        const bool ctx = u.pm * BM < NCTX;
#pragma unroll
        for (int bj = 0; bj < 2; ++bj) {
            const int n0 = u.pn * BM + bj * HALF;
            const int c8 = n0 + wc * 32 + 8 * fq;
            f32x4 bg0 = (f32x4){0.f, 0.f, 0.f, 0.f}, bg1 = bg0;
            if (n0 >= 2816) { bg0 = *(const f32x4*)(b_gate + l * 3072 + c8 - 2816); bg1 = *(const f32x4*)(b_gate + l * 3072 + c8 - 2816 + 4); }
#pragma unroll
            for (int ai = 0; ai < 2; ++ai)
#pragma unroll
                for (int m = 0; m < 4; ++m) {
                    const int row = u.pm * BM + ai * HALF + wr * 64 + m * 16 + fr;
                    const f32x4 v0 = acc[ai][bj][m][0], v1 = acc[ai][bj][m][1];
                    if (n0 < 512) {
                        *(u32x4*)((bf16_t*)(ws + WS_UF) + (size_t)row * 512 + c8) = pack8(v0, v1, 1.f);
                    } else if (n0 < 896) {
                        *(u32x4*)((bf16_t*)(ws + WS_UQ) + (size_t)row * 384 + (c8 - 512)) = pack8(v0, v1, 1.f);
                    } else if (n0 < 1152) {
                        float* o = (float*)(ws + WS_UKV) + (size_t)row * 256 + (c8 - 896);
                        *(f32x4*)o = v0; *(f32x4*)(o + 4) = v1;
                    } else if (n0 < 1280) {
                        if (wc == 0) { float* o = (float*)(ws + WS_KRF) + (size_t)row * 32 + 8 * fq; *(f32x4*)o = v0; *(f32x4*)(o + 4) = v1; }
                    } else if (n0 < 1792) {
                        *(u32x4*)((bf16_t*)(ws + WS_NAQ) + (size_t)row * 512 + (c8 - 1280)) = pack8(v0, v1, NA_QS);
                    } else if (n0 < 2304) {
                        const int cc = c8 - 1792;
                        *(u32x4*)((bf16_t*)(ws + WS_NAK) + (size_t)row * 512 + cc) = pack8(v0, v1, 1.f);
                        if (ctx) { float* o = out + OUT_NAK + ((size_t)((row >> 8) * 4 + l) * 256 + (row & 255)) * 512 + cc; *(f32x4*)o = v0; *(f32x4*)(o + 4) = v1; }
                    } else if (n0 < 2816) {
                        const int cc = c8 - 2304, h = cc >> 6, d0 = cc & 63;
                        bf16_t* VT = (bf16_t*)(ws + WS_NAVT);
                        bf16_t* vp;
                        size_t cstride;
                        if (ctx) {
                            const int b = row >> 8, s = row & 255;
                            float* o = out + OUT_NAV + ((size_t)(b * 4 + l) * 256 + s) * 512 + cc; *(f32x4*)o = v0; *(f32x4*)(o + 4) = v1;
                            vp = VT + ((size_t)((b * 8 + h) * 64 + d0)) * 256 + s; cstride = 256;
                        } else {
                            const int rr = row - NCTX, b = rr >> 11, n = rr & 2047;
                            vp = VT + (size_t)4194304 + ((size_t)((b * 8 + h) * 64 + d0)) * 2048 + n; cstride = 2048;
                        }
#pragma unroll
                        for (int e = 0; e < 4; ++e) { vp[(size_t)e * cstride] = f2bf(v0[e]); vp[(size_t)(4 + e) * cstride] = f2bf(v1[e]); }
                    } else {
                        f32x4 g0, g1;
#pragma unroll
                        for (int e = 0; e < 4; ++e) { g0[e] = sigmoidf_(v0[e] + bg0[e]); g1[e] = sigmoidf_(v1[e] + bg1[e]); }
                        *(u32x4*)((bf16_t*)(ws + WS_GATE) + (size_t)row * 3072 + (c8 - 2816)) = pack8(g0, g1, 1.f);
                    }
                    __builtin_amdgcn_sched_barrier(0);
                }
        }
    }
};
struct EpiMerge {
    static constexpr bool PERM = true;
    const bf16_t* GATE; bf16_t* T; bf16_t* MG; int s;
    DEVI void operator()(const f32x4 (&acc)[2][2][4][2], const Unit& u, int wr, int wc, int fr_, int fq_) const {
        int fr = fr_, fq = fq_; asm volatile("" : "+v"(fr), "+v"(fq));
#pragma unroll
        for (int ah = 0; ah < 4; ++ah) {
            const int ai = ah >> 1, mb = (ah & 1) * 2;
            u32x4 gv[4][2], tv[4][2];
#pragma unroll
            for (int m = mb; m < mb + 2; ++m)
#pragma unroll
                for (int bj = 0; bj < 2; ++bj) {
                    const int row = u.pm * BM + ai * HALF + wr * 64 + m * 16 + fr;
                    const int c8 = u.pn * BM + bj * HALF + wc * 32 + 8 * fq;
                    gv[m][bj] = *(const u32x4*)(GATE + (size_t)row * 3072 + s * 1024 + c8);
                    if (s > 0) tv[m][bj] = *(const u32x4*)(T + (size_t)row * D + c8);
                }
            __builtin_amdgcn_sched_barrier(0);
#pragma unroll
            for (int m = mb; m < mb + 2; ++m)
#pragma unroll
                for (int bj = 0; bj < 2; ++bj) {
                    const int row = u.pm * BM + ai * HALF + wr * 64 + m * 16 + fr;
                    const int c8 = u.pn * BM + bj * HALF + wc * 32 + 8 * fq;
                    const u32x4 g = gv[m][bj];
                    f32x4 v0 = acc[ai][bj][m][0], v1 = acc[ai][bj][m][1];
                    v0[0] *= bf2f(g.x & 0xffffu); v0[1] *= bf2f(g.x >> 16); v0[2] *= bf2f(g.y & 0xffffu); v0[3] *= bf2f(g.y >> 16);
                    v1[0] *= bf2f(g.z & 0xffffu); v1[1] *= bf2f(g.z >> 16); v1[2] *= bf2f(g.w & 0xffffu); v1[3] *= bf2f(g.w >> 16);
                    if (s > 0) {
                        const u32x4 t = tv[m][bj];
                        v0[0] += bf2f(t.x & 0xffffu); v0[1] += bf2f(t.x >> 16); v0[2] += bf2f(t.y & 0xffffu); v0[3] += bf2f(t.y >> 16);
                        v1[0] += bf2f(t.z & 0xffffu); v1[1] += bf2f(t.z >> 16); v1[2] += bf2f(t.w & 0xffffu); v1[3] += bf2f(t.w >> 16);
                    }
                    *(u32x4*)((s < 2 ? T : MG) + (size_t)row * D + c8) = EpiIn::pack8(v0, v1, 1.f);
                }
            __builtin_amdgcn_sched_barrier(0);
        }
    }
};
}

DEVI void job_ffn_up(const P& p, unsigned char* ws_b, int l, int which, int t, bf16_t* sm, int tid) {
    const int nN = 44; const int m0 = (t / nN) * 128, n0 = (t % nN) * 128;
    const bf16_t* H = (const bf16_t*)(ws_b + WS_H);
    const bf16_t* W = (const bf16_t*)(ws_b + WS_W) + (size_t)l * LAYER_W + (which ? OFF_W13_2 : OFF_W13_1);
    bf16_t* ACT = (bf16_t*)(ws_b + WS_ACT);
    f32x16 acc[2][2]; zero_acc(acc);
    gemm_core(H + (size_t)m0 * D, D, W + (size_t)n0 * D, D, D, acc, sm, tid);
    EPI_SETUP
    const int oc = (n0 >> 1) + wc * 32 + c32;
#pragma unroll
    for (int i = 0; i < 2; ++i) {
        const int rb = m0 + wr * 64 + i * 32 + 4 * hl;
#pragma unroll
        for (int r = 0; r < 16; ++r) {
            const int row = rb + (r & 3) + 8 * (r >> 2);
            const float a = acc[i][0][r], b = acc[i][1][r];
            const float v = a * sigmoidf_(a) * b;
            ACT[(size_t)row * DFF + oc] = f2bf(v);
        }
    }
}

DEVI void job_resid(const P& p, unsigned char* ws_b, const bf16_t* A, int lda, const bf16_t* Bt, int K, const float* gate_base, float coef, int t, bf16_t* sm, int tid) {
    const int nN = 8; const int m0 = (t / nN) * 128, n0 = (t % nN) * 128;
    float* X = (float*)(ws_b + WS_X);
    f32x16 acc[2][2]; zero_acc(acc);
    gemm_core(A + (size_t)m0 * lda, lda, Bt + (size_t)n0 * K, K, K, acc, sm, tid);
    EPI_SETUP
    const float* gate = gate_base + (size_t)mod_group(m0) * 9216;
#pragma unroll
    for (int j = 0; j < 2; ++j) {
        const int col = n0 + wc * 64 + j * 32 + c32;
        const float gv = coef * gate[col];
#pragma unroll
        for (int i = 0; i < 2; ++i) {
            const int rb = m0 + wr * 64 + i * 32 + 4 * hl;
#pragma unroll
            for (int r = 0; r < 16; ++r) {
                const int row = rb + (r & 3) + 8 * (r >> 2);
                float* xp = X + (size_t)row * D + col;
                *xp = ALPHA_F * (*xp) + gv * acc[i][j][r];
            }
        }
    }
}

DEVI void job_in(const P& p, unsigned char* ws_b, int l, int t, bf16_t* sm, int tid) {
    const int nN = 46; const int m0 = (t / nN) * 128, n0 = (t % nN) * 128;
    const bf16_t* H = (const bf16_t*)(ws_b + WS_H);
    const bf16_t* W = (const bf16_t*)(ws_b + WS_W) + (size_t)l * LAYER_W + OFF_WIN;
    f32x16 acc[2][2]; zero_acc(acc);
    gemm_core(H + (size_t)m0 * D, D, W + (size_t)n0 * D, D, D, acc, sm, tid);
    EPI_SETUP
    const bool ctx = m0 < NCTX;
#pragma unroll
    for (int j = 0; j < 2; ++j) {
        const int col = n0 + wc * 64 + j * 32 + c32;
#pragma unroll
        for (int i = 0; i < 2; ++i) {
            const int rb = m0 + wr * 64 + i * 32 + 4 * hl;
            if (n0 < 512) {
                bf16_t* O = (bf16_t*)(ws_b + WS_UF);
#pragma unroll
                for (int r = 0; r < 16; ++r) O[(size_t)(rb + (r & 3) + 8 * (r >> 2)) * 512 + col] = f2bf(acc[i][j][r]);
            } else if (n0 < 896) {
                bf16_t* O = (bf16_t*)(ws_b + WS_UQ);
#pragma unroll
                for (int r = 0; r < 16; ++r) O[(size_t)(rb + (r & 3) + 8 * (r >> 2)) * 384 + (col - 512)] = f2bf(acc[i][j][r]);
            } else if (n0 < 1152) {
                float* O = (float*)(ws_b + WS_UKV);
#pragma unroll
                for (int r = 0; r < 16; ++r) O[(size_t)(rb + (r & 3) + 8 * (r >> 2)) * 256 + (col - 896)] = acc[i][j][r];
            } else if (n0 < 1280) {
                if (col < 1184) {
                    float* O = (float*)(ws_b + WS_KRF);
#pragma unroll
                    for (int r = 0; r < 16; ++r) O[(size_t)(rb + (r & 3) + 8 * (r >> 2)) * 32 + (col - 1152)] = acc[i][j][r];
                }
            } else if (n0 < 1792) {
                bf16_t* O = (bf16_t*)(ws_b + WS_NAQ);
#pragma unroll
                for (int r = 0; r < 16; ++r) O[(size_t)(rb + (r & 3) + 8 * (r >> 2)) * 512 + (col - 1280)] = f2bf(acc[i][j][r] * NA_QS);
            } else if (n0 < 2304) {
                bf16_t* O = (bf16_t*)(ws_b + WS_NAK);
                const int cc = col - 1792;
#pragma unroll
                for (int r = 0; r < 16; ++r) {
                    const int row = rb + (r & 3) + 8 * (r >> 2);
                    O[(size_t)row * 512 + cc] = f2bf(acc[i][j][r]);
                    if (ctx) p.out[OUT_NAK + ((size_t)((row >> 8) * 4 + l) * 256 + (row & 255)) * 512 + cc] = acc[i][j][r];
                }
            } else if (n0 < 2816) {
                bf16_t* VT = (bf16_t*)(ws_b + WS_NAVT);
                const int cc = col - 2304, h = cc >> 6, d = cc & 63;
#pragma unroll
                for (int qd = 0; qd < 4; ++qd) {
                    const int row = rb + 8 * qd;
                    u32x2 pk; pk.x = pk2(acc[i][j][4 * qd], acc[i][j][4 * qd + 1]); pk.y = pk2(acc[i][j][4 * qd + 2], acc[i][j][4 * qd + 3]);
                    if (ctx) {
                        const int b = row >> 8, s = row & 255;
                        *(u32x2*)(VT + ((size_t)((b * 8 + h) * 64 + d)) * 256 + s) = pk;
#pragma unroll
                        for (int e = 0; e < 4; ++e)
                            p.out[OUT_NAV + ((size_t)(b * 4 + l) * 256 + (s + e)) * 512 + cc] = acc[i][j][4 * qd + e];
                    } else {
                        const int rr = row - NCTX, b = rr >> 11, n = rr & 2047;
                        *(u32x2*)(VT + (size_t)4194304 + ((size_t)((b * 8 + h) * 64 + d)) * 2048 + n) = pk;
                    }
                }
            } else {
                bf16_t* O = (bf16_t*)(ws_b + WS_GATE);
                const int gc = col - 2816;
                const float bg = pin(p, 26)[l * 3072 + gc];
                bf16_t* gp = O + (size_t)gc * M + rb;
#pragma unroll
                for (int qd = 0; qd < 4; ++qd) {
                    u32x2 pk;
                    pk.x = pk2(sigmoidf_(acc[i][j][4 * qd] + bg), sigmoidf_(acc[i][j][4 * qd + 1] + bg));
                    pk.y = pk2(sigmoidf_(acc[i][j][4 * qd + 2] + bg), sigmoidf_(acc[i][j][4 * qd + 3] + bg));
                    *(u32x2*)(gp + 8 * qd) = pk;
                }
            }
        }
    }
}

DEVI void job_uq(const P& p, unsigned char* ws_b, int l, int t, bf16_t* sm, int tid) {
    const int nN = 6; const int m0 = (t / nN) * 128, n0 = (t % nN) * 128;
    const bf16_t* A = (const bf16_t*)(ws_b + WS_UQ);
    const bf16_t* W = (const bf16_t*)(ws_b + WS_W) + (size_t)l * LAYER_W + OFF_WUQ;
    bf16_t* Q = (bf16_t*)(ws_b + WS_Q);
    const float* ropec = (const float*)(ws_b + WS_ROPE);
    const float* ropes = ropec + 512;
    f32x16 acc[2][2]; zero_acc(acc);
    gemm_core(A + (size_t)m0 * 384, 384, W + (size_t)n0 * 384, 384, 384, acc, sm, tid);
    EPI_SETUP
    const bool lat = m0 >= NCTX;
#pragma unroll
    for (int j = 0; j < 2; ++j) {
        const int c0 = n0 + wc * 64 + j * 32;
        const int col = c0 + c32;
        const bool rope = lat && (((c0 >> 5) % 3) == 2);
        const int axis = c32 >> 4, ii = c32 & 15;
#pragma unroll
        for (int i = 0; i < 2; ++i) {
            const int rb = m0 + wr * 64 + i * 32 + 4 * hl;
#pragma unroll
            for (int r = 0; r < 16; ++r) {
                const int row = rb + (r & 3) + 8 * (r >> 2);
                float v = acc[i][j][r];
                const float pr = __shfl_xor(v, 8);
                if (rope) {
                    const int n = (row - NCTX) & 2047;
                    const int pos = axis ? (n & 63) : (n >> 6);
                    const float cs = ropec[pos * 8 + (ii & 7)], sn = ropes[pos * 8 + (ii & 7)];
                    const float rot = (ii < 8) ? -pr : pr;
                    v = v * cs + rot * sn;
                }
                Q[(size_t)row * 768 + col] = f2bf(v * MLA_QS);
            }
        }
    }
}

DEVI void job_ukv(const P& p, unsigned char* ws_b, int l, int t, bf16_t* sm, int tid) {
    const int nN = 8; const int m0 = (t / nN) * 128, h = t % nN, n0 = h * 128;
    const bf16_t* A = (m0 < M) ? (const bf16_t*)(ws_b + WS_CKV) + (size_t)m0 * 256
                               : (const bf16_t*)(ws_b + WS_CCKV) + ((size_t)l * 1024 + (m0 - M)) * 256;
    const bf16_t* W = (const bf16_t*)(ws_b + WS_W) + (size_t)l * LAYER_W + OFF_WUKV;
    bf16_t* KN = (bf16_t*)(ws_b + WS_KN);
    bf16_t* VT = (bf16_t*)(ws_b + WS_VTM);
    f32x16 acc[2][2]; zero_acc(acc);
    gemm_core(A, 256, W + (size_t)n0 * 256, 256, 256, acc, sm, tid);
    EPI_SETUP
#pragma unroll
    for (int j = 0; j < 2; ++j) {
        const int d = j * 32 + c32;
#pragma unroll
        for (int i = 0; i < 2; ++i) {
            const int rb = m0 + wr * 64 + i * 32 + 4 * hl;
            if (wc == 0) {
#pragma unroll
                for (int r = 0; r < 16; ++r) KN[(size_t)(rb + (r & 3) + 8 * (r >> 2)) * 512 + h * 64 + d] = f2bf(acc[i][j][r]);
            } else {
#pragma unroll
                for (int qd = 0; qd < 4; ++qd) {
                    const int row = rb + 8 * qd;
                    u32x2 pk; pk.x = pk2(acc[i][j][4 * qd], acc[i][j][4 * qd + 1]); pk.y = pk2(acc[i][j][4 * qd + 2], acc[i][j][4 * qd + 3]);
                    size_t addr;
                    if (m0 < NCTX) { const int b = row >> 8, s = row & 255; addr = ((size_t)((b * 8 + h) * 64 + d)) * 256 + s; }
                    else if (m0 < M) { const int rr = row - NCTX, b = rr >> 11, n = rr & 2047; addr = (size_t)4194304 + ((size_t)((b * 8 + h) * 64 + d)) * 2560 + n; }
                    else { const int rr = row - M, b = rr >> 9, n = rr & 511; addr = (size_t)4194304 + ((size_t)((b * 8 + h) * 64 + d)) * 2560 + 2048 + n; }
                    *(u32x2*)(VT + addr) = pk;
                }
            }
        }
    }
}

template <int ldo, bool SPLITK = false>
DEVI void job_store(const bf16_t* A, int lda, const bf16_t* Bt, int ldb, int K, bf16_t* Out, bf16_t* sm, int tid, int grp = 0, float* xch = nullptr) {
    f32x16 acc[2][2]; zero_acc(acc);
    if constexpr (SPLITK) { K >>= 1; A += grp * K; Bt += grp * K; }
    gemm_core(A, lda, Bt, ldb, K, acc, sm, tid);
    EPI_SETUP
    if constexpr (SPLITK) {
        if (grp == 1) {
#pragma unroll
            for (int i = 0; i < 2; ++i)
#pragma unroll
                for (int j = 0; j < 2; ++j)
#pragma unroll
                    for (int r = 0; r < 16; ++r) xch[((i * 2 + j) * 16 + r) * 256 + tid] = acc[i][j][r];
        }
        __syncthreads();
        if (grp == 0) {
#pragma unroll
            for (int i = 0; i < 2; ++i)
#pragma unroll
                for (int j = 0; j < 2; ++j)
#pragma unroll
                    for (int r = 0; r < 16; ++r) acc[i][j][r] += xch[((i * 2 + j) * 16 + r) * 256 + tid];
        }
        __syncthreads();
    }
    const bool active = !SPLITK || grp == 0;
    bf16_t* st = sm + (wr * 64 + 4 * hl) * 136 + wc * 64 + c32;
    if (active) {
#pragma unroll
        for (int i = 0; i < 2; ++i)
#pragma unroll
            for (int j = 0; j < 2; ++j)
#pragma unroll
                for (int r = 0; r < 16; ++r) st[(i * 32 + (r & 3) + 8 * (r >> 2)) * 136 + j * 32] = f2bf(acc[i][j][r]);
    }
    __syncthreads();
    if (active) {
        const int orow = tid >> 4, oc = (tid & 15) * 8;
#pragma unroll
        for (int k = 0; k < 8; ++k) {
            const u32x4 v = *(const u32x4*)(sm + (orow + 16 * k) * 136 + oc);
            *(u32x4*)(Out + (size_t)(orow + 16 * k) * ldo + oc) = v;
        }
    }
    __syncthreads();
}

DEVI void job_f1(const P& p, unsigned char* ws_b, int t, bf16_t* sm, int tid) {
    const bf16_t* WCS = (const bf16_t*)(ws_b + WS_WCS);
    const bf16_t* UF = (const bf16_t*)(ws_b + WS_UF);
    bf16_t* F1T = (bf16_t*)(ws_b + WS_F1T);
    if (t < 512) {
        const int bs = t >> 4, g = (t >> 2) & 3, mi = (t >> 1) & 1, ni = t & 1;
        job_store<256>(WCS + mi * 128 * 128, 128, UF + ((size_t)bs * 256 + ni * 128) * 512 + g * 128, 512, 128,
                  F1T + ((size_t)(bs * 4 + g) * 256 + mi * 128) * 256 + ni * 128, sm, tid);
    } else {
        t -= 512;
        const int bs = t >> 7, g = (t >> 5) & 3, mi = (t >> 4) & 1, ni = t & 15;
        job_store<2048>(WCS + mi * 128 * 128, 128, UF + ((size_t)NCTX + bs * 2048 + ni * 128) * 512 + g * 128, 512, 128,
                  F1T + (size_t)8388608 + ((size_t)(bs * 4 + g) * 256 + mi * 128) * 2048 + ni * 128, sm, tid);
    }
}
DEVI void job_f2_lat(const P& p, unsigned char* ws_b, int t, bf16_t* sm, int tid, int grp, float* xch) {
    const int bs = t >> 6, mi = (t >> 2) & 15, ni = t & 3;
    const bf16_t* TAB = (const bf16_t*)(ws_b + WS_TABL);
    const bf16_t* F1T = (const bf16_t*)(ws_b + WS_F1T) + (size_t)8388608;
    bf16_t* YF = (bf16_t*)(ws_b + WS_YF);
    job_store<512, true>(TAB + (size_t)mi * 128 * 4096, 4096, F1T + (size_t)bs * 512 * 4096 + (size_t)ni * 128 * 4096, 4096, 4096,
              YF + ((size_t)NCTX + bs * 2048 + mi * 128) * 512 + ni * 128, sm, tid, grp, xch);
}
DEVI void job_f2_ctx(const P& p, unsigned char* ws_b, int t, bf16_t* sm, int tid) {
    const int bs = t >> 3, mi = (t >> 2) & 1, ni = t & 3;
    const bf16_t* TAB = (const bf16_t*)(ws_b + WS_TABC);
    const bf16_t* F1T = (const bf16_t*)(ws_b + WS_F1T);
    bf16_t* YF = (bf16_t*)(ws_b + WS_YF);
    job_store<512>(TAB + (size_t)mi * 128 * 512, 512, F1T + (size_t)bs * 512 * 512 + (size_t)ni * 128 * 512, 512, 512,
              YF + ((size_t)bs * 256 + mi * 128) * 512 + ni * 128, sm, tid);
}

DEVI void job_merge(const P& p, unsigned char* ws_b, int l, int t, bf16_t* sm, int tid) {
    const int nN = 8; const int m0 = (t / nN) * 128, n0 = (t % nN) * 128;
    const bf16_t* Wl = (const bf16_t*)(ws_b + WS_W) + (size_t)l * LAYER_W;
    const bf16_t* GATE = (const bf16_t*)(ws_b + WS_GATE);
    bf16_t* MG = (bf16_t*)(ws_b + WS_MERGED);
    EPI_SETUP
    f32x16 acc[2][2]; zero_acc(acc);
#pragma unroll 1
    for (int s = 0; s < 3; ++s) {
        const bf16_t* A = (const bf16_t*)(ws_b + (s == 0 ? WS_YF : (s == 1 ? WS_YM : WS_YN)));
        const bf16_t* W = Wl + (s == 0 ? OFF_WBF : (s == 1 ? OFF_WBM : OFF_WBN));
        gemm_core<false>(A + (size_t)m0 * 512, 512, W + (size_t)n0 * 512, 512, 512, acc, sm, tid);
        {
            const int gr = tid >> 4, gc = (tid & 15) * 8;
            const int s1 = s < 2 ? s + 1 : s;
#pragma unroll
            for (int k = 0; k < 8; ++k) {
                const bf16_t* gsrc = GATE + (size_t)(m0 + gr + 16 * k) * 3072 + n0 + gc;
                *(u32x4*)(sm + (gr + 16 * k) * 136 + gc) = *(const u32x4*)(gsrc + s * 1024);
                *(u32x4*)(sm + 128 * 136 + (gr + 16 * k) * 136 + gc) = *(const u32x4*)(gsrc + s1 * 1024);
                if ((k & 1) == 1) __builtin_amdgcn_sched_barrier(0);
            }
        }
        __syncthreads();
#pragma unroll
        for (int j = 0; j < 2; ++j)
#pragma unroll
            for (int i = 0; i < 2; ++i) {
                const bf16_t* gp = sm + (wr * 64 + i * 32 + 4 * hl) * 136 + wc * 64 + j * 32 + c32;
#pragma unroll
                for (int r = 0; r < 16; ++r) {
                    const int o = ((r & 3) + 8 * (r >> 2)) * 136;
                    const float g = bf2f(gp[o]);
                    const float f = (s < 2) ? g * __builtin_amdgcn_rcpf(bf2f(gp[128 * 136 + o])) : g;
                    acc[i][j][r] *= f;
                }
            }
        __syncthreads();
    }
#pragma unroll
    for (int j = 0; j < 2; ++j) {
        const int col = n0 + wc * 64 + j * 32 + c32;
#pragma unroll
        for (int i = 0; i < 2; ++i) {
            const int rb = m0 + wr * 64 + i * 32 + 4 * hl;
#pragma unroll
            for (int r = 0; r < 16; ++r) MG[(size_t)(rb + (r & 3) + 8 * (r >> 2)) * 1024 + col] = f2bf(acc[i][j][r]);
        }
    }
}

struct TileSrc { const bf16_t* k; const bf16_t* k2; const bf16_t* v; const bf16_t* vhi; };
DEVI int pi_row(int r) { return (r & 0x13) | ((r & 4) << 1) | ((r & 8) >> 1); }

template <int NKS>
DEVI void attn_load(const TileSrc& s, bf16x8 (&kf)[NKS], bf16x8 (&vf)[4]) {
#pragma unroll
    for (int ks = 0; ks < NKS; ++ks) kf[ks] = (ks < 4) ? *(const bf16x8*)(s.k + ks * 16) : *(const bf16x8*)(s.k2 + (ks - 4) * 16);
    vf[0] = *(const bf16x8*)(s.v);
    vf[1] = *(const bf16x8*)(s.v + 16);
    vf[2] = *(const bf16x8*)(s.vhi);
    vf[3] = *(const bf16x8*)(s.vhi + 16);
}

template <int NKS, bool SPLIT, class Src, class Mask>
DEVI void attn_wave(const bf16_t* qptr, int t0, int nt, Src src, Mask mask, bf16_t* optr, int lane, float* ex = nullptr, int half = 0) {
    bf16x8 q[NKS];
#pragma unroll
    for (int ks = 0; ks < NKS; ++ks) q[ks] = *(const bf16x8*)(qptr + ks * 16);
    f32x16 o0, o1;
#pragma unroll
    for (int r = 0; r < 16; ++r) { o0[r] = 0.f; o1[r] = 0.f; }
    float m = -1e30f, lsum = 0.f;
    bf16x8 kf[NKS], vf[4];
    nt += t0;
    { TileSrc s0 = src(t0); attn_load<NKS>(s0, kf, vf); }
    for (int t = t0; t < nt; ++t) {
        bf16x8 kn[NKS], vn[4];
        { TileSrc s1 = src(t + 1 < nt ? t + 1 : t); attn_load<NKS>(s1, kn, vn); }
        f32x16 s;
#pragma unroll
        for (int r = 0; r < 16; ++r) s[r] = 0.f;
#pragma unroll
        for (int ks = 0; ks < NKS; ++ks) s = __builtin_amdgcn_mfma_f32_32x32x16_bf16(kf[ks], q[ks], s, 0, 0, 0);
        mask(t, s);
        float mx = s[0];
#pragma unroll
        for (int r = 1; r < 16; ++r) mx = fmaxf(mx, s[r]);
        mx = fmaxf(mx, __shfl_xor(mx, 32));
        const float mn = fmaxf(m, mx);
        const float alpha = fast_exp2(m - mn);
        m = mn;
        float rs = 0.f;
#pragma unroll
        for (int r = 0; r < 16; ++r) { s[r] = fast_exp2(s[r] - mn); rs += s[r]; }
        lsum = lsum * alpha + rs;
#pragma unroll
        for (int r = 0; r < 16; ++r) { o0[r] *= alpha; o1[r] *= alpha; }
        bf16x8 p0, p1;
        {
            u32x4 a, b;
            a.x = pk2(s[0], s[1]); a.y = pk2(s[2], s[3]); a.z = pk2(s[4], s[5]); a.w = pk2(s[6], s[7]);
            b.x = pk2(s[8], s[9]); b.y = pk2(s[10], s[11]); b.z = pk2(s[12], s[13]); b.w = pk2(s[14], s[15]);
            p0 = __builtin_bit_cast(bf16x8, a); p1 = __builtin_bit_cast(bf16x8, b);
        }
        o0 = __builtin_amdgcn_mfma_f32_32x32x16_bf16(vf[0], p0, o0, 0, 0, 0);
        o0 = __builtin_amdgcn_mfma_f32_32x32x16_bf16(vf[1], p1, o0, 0, 0, 0);
        o1 = __builtin_amdgcn_mfma_f32_32x32x16_bf16(vf[2], p0, o1, 0, 0, 0);
        o1 = __builtin_amdgcn_mfma_f32_32x32x16_bf16(vf[3], p1, o1, 0, 0, 0);
#pragma unroll
        for (int ks = 0; ks < NKS; ++ks) kf[ks] = kn[ks];
#pragma unroll
        for (int x = 0; x < 4; ++x) vf[x] = vn[x];
    }
    if constexpr (SPLIT) {
        if (half == 1) {
#pragma unroll
            for (int r = 0; r < 16; ++r) { ex[r * 64 + lane] = o0[r]; ex[(16 + r) * 64 + lane] = o1[r]; }
            ex[32 * 64 + lane] = m; ex[33 * 64 + lane] = lsum;
        }
        __syncthreads();
        if (half == 0) {
            const float m2 = ex[32 * 64 + lane], l2 = ex[33 * 64 + lane];
            const float mn = fmaxf(m, m2), a1 = fast_exp2(m - mn), a2 = fast_exp2(m2 - mn);
            lsum = lsum * a1 + l2 * a2;
#pragma unroll
            for (int r = 0; r < 16; ++r) { o0[r] = o0[r] * a1 + ex[r * 64 + lane] * a2; o1[r] = o1[r] * a1 + ex[(16 + r) * 64 + lane] * a2; }
        }
        __syncthreads();
        if (half == 1) return;
    }
    lsum += __shfl_xor(lsum, 32);
    const float inv = 1.f / lsum;
    const int hl = lane >> 5;
#pragma unroll
    for (int qd = 0; qd < 4; ++qd) {
        u32x2 a, b;
        a.x = pk2(o0[4 * qd] * inv, o0[4 * qd + 1] * inv); a.y = pk2(o0[4 * qd + 2] * inv, o0[4 * qd + 3] * inv);
        b.x = pk2(o1[4 * qd] * inv, o1[4 * qd + 1] * inv); b.y = pk2(o1[4 * qd + 2] * inv, o1[4 * qd + 3] * inv);
        *(u32x2*)(optr + 8 * qd + 4 * hl) = a;
        *(u32x2*)(optr + 32 + 8 * qd + 4 * hl) = b;
    }
}

struct NoMask { DEVI void operator()(int, f32x16&) const {} };

DEVI void attn_mla(const P& p, unsigned char* ws_b, int l, bool lat, int b, int h, int qg, int lane, float* ex = nullptr, int half = 0) {
    const int hl = lane >> 5, c32 = lane & 31, pr = pi_row(c32);
    const bf16_t* Q = (const bf16_t*)(ws_b + WS_Q);
    const bf16_t* KN = (const bf16_t*)(ws_b + WS_KN);
    const bf16_t* KR = (const bf16_t*)(ws_b + WS_KR);
    const bf16_t* CKR = (const bf16_t*)(ws_b + WS_CKR) + (size_t)l * 1024 * 32;
    const bf16_t* VT = (const bf16_t*)(ws_b + WS_VTM);
    bf16_t* YM = (bf16_t*)(ws_b + WS_YM);
    if (!lat) {
        const int row0 = b * 256;
        const int qrow = row0 + qg * 32 + c32;
        const bf16_t* k0 = KN + (size_t)(row0 + pr) * 512 + h * 64 + hl * 8;
        const bf16_t* r0 = KR + (size_t)(row0 + pr) * 32 + hl * 8;
        const bf16_t* v0 = VT + ((size_t)((b * 8 + h) * 64 + c32)) * 256 + hl * 8;
        auto src = [=](int t) { TileSrc s; s.k = k0 + (size_t)t * 32 * 512; s.k2 = r0 + (size_t)t * 32 * 32; s.v = v0 + t * 32; s.vhi = s.v + 32 * 256; return s; };
        attn_wave<6, false>(Q + (size_t)qrow * 768 + h * 96 + hl * 8, 0, 8, src, NoMask(), YM + (size_t)qrow * 512 + h * 64, lane);
    } else {
        const int row0 = NCTX + b * 2048;
        const int qrow = row0 + qg * 32 + c32;
        const bf16_t* k0 = KN + (size_t)(row0 + pr) * 512 + h * 64 + hl * 8;
        const bf16_t* r0 = KR + (size_t)(row0 + pr) * 32 + hl * 8;
        const bf16_t* k1 = KN + (size_t)(M + b * 512 + pr) * 512 + h * 64 + hl * 8;
        const bf16_t* r1 = CKR + (size_t)(b * 512 + pr) * 32 + hl * 8;
        const bf16_t* v0 = VT + (size_t)4194304 + ((size_t)((b * 8 + h) * 64 + c32)) * 2560 + hl * 8;
        auto src = [=](int t) {
            TileSrc s;
            if (t < 64) { s.k = k0 + (size_t)t * 32 * 512; s.k2 = r0 + (size_t)t * 32 * 32; }
            else { s.k = k1 + (size_t)(t - 64) * 32 * 512; s.k2 = r1 + (size_t)(t - 64) * 32 * 32; }
            s.v = v0 + t * 32; s.vhi = s.v + 32 * 2560; return s; };
        attn_wave<6, true>(Q + (size_t)qrow * 768 + h * 96 + hl * 8, half * 40, 40, src, NoMask(), YM + (size_t)qrow * 512 + h * 64, lane, ex, half);
    }
}

template <int NKS, class Mask>
DEVI void attn_step(const bf16x8 (&kf)[NKS], const bf16x8 (&vf)[4], const bf16x8 (&q)[NKS], f32x16& o0, f32x16& o1, float& m, float& lsum, const Mask& mask, int t) {
    f32x16 s;
#pragma unroll
    for (int r = 0; r < 16; ++r) s[r] = 0.f;
#pragma unroll
    for (int ks = 0; ks < NKS; ++ks) s = __builtin_amdgcn_mfma_f32_32x32x16_bf16(kf[ks], q[ks], s, 0, 0, 0);
    mask(t, s);
    float mx = s[0];
#pragma unroll
    for (int r = 1; r < 16; ++r) mx = fmaxf(mx, s[r]);
    mx = fmaxf(mx, __shfl_xor(mx, 32));
    const float mn = fmaxf(m, mx);
    const float alpha = fast_exp2(m - mn);
    m = mn;
    float rs = 0.f;
#pragma unroll
    for (int r = 0; r < 16; ++r) { s[r] = fast_exp2(s[r] - mn); rs += s[r]; }
    lsum = lsum * alpha + rs;
#pragma unroll
    for (int r = 0; r < 16; ++r) { o0[r] *= alpha; o1[r] *= alpha; }
    bf16x8 p0, p1;
    {
        u32x4 a, b;
        a.x = pk2(s[0], s[1]); a.y = pk2(s[2], s[3]); a.z = pk2(s[4], s[5]); a.w = pk2(s[6], s[7]);
        b.x = pk2(s[8], s[9]); b.y = pk2(s[10], s[11]); b.z = pk2(s[12], s[13]); b.w = pk2(s[14], s[15]);
        p0 = __builtin_bit_cast(bf16x8, a); p1 = __builtin_bit_cast(bf16x8, b);
    }
    o0 = __builtin_amdgcn_mfma_f32_32x32x16_bf16(vf[0], p0, o0, 0, 0, 0);
    o0 = __builtin_amdgcn_mfma_f32_32x32x16_bf16(vf[1], p1, o0, 0, 0, 0);
    o1 = __builtin_amdgcn_mfma_f32_32x32x16_bf16(vf[2], p0, o1, 0, 0, 0);
    o1 = __builtin_amdgcn_mfma_f32_32x32x16_bf16(vf[3], p1, o1, 0, 0, 0);
}
struct MlaStage { u32x4 k, v; u32x2 r; };
DEVI void attn_mla_lat_shared(const P& p, unsigned char* ws_b, int l, int b, int h, int qg, int tid, unsigned char* smem, float* ex) {
    const int lane = tid & 63, wave = tid >> 6, half = wave >> 2, htid = tid & 255;
    const int hl = lane >> 5, c32 = lane & 31, pr = pi_row(c32);
    const bf16_t* Q = (const bf16_t*)(ws_b + WS_Q);
    const bf16_t* KN = (const bf16_t*)(ws_b + WS_KN);
    const bf16_t* KR = (const bf16_t*)(ws_b + WS_KR);
    const bf16_t* CKR = (const bf16_t*)(ws_b + WS_CKR) + (size_t)l * 1024 * 32;
    const bf16_t* VT = (const bf16_t*)(ws_b + WS_VTM) + (size_t)4194304 + (size_t)((b * 8 + h) * 64) * 2560;
    bf16_t* YM = (bf16_t*)(ws_b + WS_YM);
    const int row0 = NCTX + b * 2048;
    const int qrow = row0 + qg * 32 + c32;
    bf16_t* ring = (bf16_t*)(smem + 36864 + half * 36864);
    const int kkey = htid >> 3, kch = (htid & 7) * 8, vd = htid >> 2, vch = (htid & 3) * 8;
    const int rch = (htid & 7) * 4;
    const int tb = half * 40, tend = tb + 40;
    bf16x8 q[6];
    {
        const bf16_t* qptr = Q + (size_t)qrow * 768 + h * 96 + hl * 8;
#pragma unroll
        for (int ks = 0; ks < 6; ++ks) q[ks] = *(const bf16x8*)(qptr + ks * 16);
    }
    f32x16 o0, o1;
#pragma unroll
    for (int r = 0; r < 16; ++r) { o0[r] = 0.f; o1[r] = 0.f; }
    float m = -1e30f, lsum = 0.f;
#define MLA_LD(S, T) do { const int t_ = (T) < tend ? (T) : tend - 1; \
        const int krow_ = t_ < 64 ? row0 + t_ * 32 : M + b * 512 + (t_ - 64) * 32; \
        (S).k = *(const u32x4*)(KN + (size_t)(krow_ + kkey) * 512 + h * 64 + kch); \
        (S).v = *(const u32x4*)(VT + (size_t)vd * 2560 + t_ * 32 + vch); \
        (S).r = *(const u32x2*)((t_ < 64 ? KR + (size_t)(krow_ + kkey) * 32 : CKR + (size_t)(b * 512 + (t_ - 64) * 32 + kkey) * 32) + rch); } while (0)
#define MLA_ST(S, SLOT) do { bf16_t* sl_ = ring + (SLOT) * 6144; \
        *(u32x4*)(sl_ + kkey * 72 + kch) = (S).k; *(u32x4*)(sl_ + 3584 + vd * 40 + vch) = (S).v; \
        *(u32x2*)(sl_ + 2304 + kkey * 40 + rch) = (S).r; } while (0)
#define MLA_COMPUTE(SLOT, T) do { const bf16_t* sl_ = ring + (SLOT) * 6144; bf16x8 kf[6], vf[4]; \
        _Pragma("unroll") for (int ks = 0; ks < 4; ++ks) kf[ks] = *(const bf16x8*)(sl_ + pr * 72 + ks * 16 + hl * 8); \
        kf[4] = *(const bf16x8*)(sl_ + 2304 + pr * 40 + hl * 8); kf[5] = *(const bf16x8*)(sl_ + 2304 + pr * 40 + 16 + hl * 8); \
        vf[0] = *(const bf16x8*)(sl_ + 3584 + c32 * 40 + hl * 8); vf[1] = *(const bf16x8*)(sl_ + 3584 + c32 * 40 + 16 + hl * 8); \
        vf[2] = *(const bf16x8*)(sl_ + 3584 + (c32 + 32) * 40 + hl * 8); vf[3] = *(const bf16x8*)(sl_ + 3584 + (c32 + 32) * 40 + 16 + hl * 8); \
        attn_step<6>(kf, vf, q, o0, o1, m, lsum, NoMask(), (T)); } while (0)
    MlaStage s0, s1, s2;
    MLA_LD(s0, tb); MLA_LD(s1, tb + 1); MLA_LD(s2, tb + 2);
    MLA_ST(s0, 0); MLA_LD(s0, tb + 3);
    __syncthreads();
#pragma unroll 1
    for (int i = tb; i < tend; i += 3) {
        MLA_ST(s1, 1); MLA_LD(s1, i + 4); MLA_COMPUTE(0, i); __syncthreads();
        MLA_ST(s2, 2); MLA_LD(s2, i + 5); if (i + 1 < tend) MLA_COMPUTE(1, i + 1); __syncthreads();
        MLA_ST(s0, 0); MLA_LD(s0, i + 6); if (i + 2 < tend) MLA_COMPUTE(2, i + 2); __syncthreads();
    }
#undef MLA_LD
#undef MLA_ST
#undef MLA_COMPUTE
    if (half == 1) {
#pragma unroll
        for (int r = 0; r < 16; ++r) { ex[r * 64 + lane] = o0[r]; ex[(16 + r) * 64 + lane] = o1[r]; }
        ex[32 * 64 + lane] = m; ex[33 * 64 + lane] = lsum;
    }
    __syncthreads();
    if (half == 0) {
        const float m2 = ex[32 * 64 + lane], l2 = ex[33 * 64 + lane];
        const float mn = fmaxf(m, m2), a1 = fast_exp2(m - mn), a2 = fast_exp2(m2 - mn);
        lsum = lsum * a1 + l2 * a2;
#pragma unroll
        for (int r = 0; r < 16; ++r) { o0[r] = o0[r] * a1 + ex[r * 64 + lane] * a2; o1[r] = o1[r] * a1 + ex[(16 + r) * 64 + lane] * a2; }
    }
    __syncthreads();
    if (half == 1) return;
    lsum += __shfl_xor(lsum, 32);
    const float inv = 1.f / lsum;
    bf16_t* optr = YM + (size_t)qrow * 512 + h * 64;
#pragma unroll
    for (int qd = 0; qd < 4; ++qd) {
        u32x2 a, bb;
        a.x = pk2(o0[4 * qd] * inv, o0[4 * qd + 1] * inv); a.y = pk2(o0[4 * qd + 2] * inv, o0[4 * qd + 3] * inv);
        bb.x = pk2(o1[4 * qd] * inv, o1[4 * qd + 1] * inv); bb.y = pk2(o1[4 * qd + 2] * inv, o1[4 * qd + 3] * inv);
        *(u32x2*)(optr + 8 * qd + 4 * hl) = a;
        *(u32x2*)(optr + 32 + 8 * qd + 4 * hl) = bb;
    }
}

template <int NKS>
DEVI void attn_ctx_shared(const bf16_t* Kg, const bf16_t* KRg, const bf16_t* VTg, const bf16_t* qptr, bf16_t* optr, int tid, unsigned char* smem) {
    const int lane = tid & 63, hl = lane >> 5, c32 = lane & 31, pr = pi_row(c32);
    bf16_t* Ks = (bf16_t*)smem;
    bf16_t* Rs = Ks + 256 * 72;
    bf16_t* Vs = Rs + 256 * 40;
    {
        u32x4 kr[4], vr[4], rr[2];
#pragma unroll
        for (int i = 0; i < 4; ++i) { const int c = tid + 512 * i; kr[i] = *(const u32x4*)(Kg + (size_t)(c >> 3) * 512 + (c & 7) * 8); }
#pragma unroll
        for (int i = 0; i < 4; ++i) { const int c = tid + 512 * i; vr[i] = *(const u32x4*)(VTg + (size_t)(c >> 5) * 256 + (c & 31) * 8); }
        if constexpr (NKS == 6) {
#pragma unroll
            for (int i = 0; i < 2; ++i) { const int c = tid + 512 * i; rr[i] = *(const u32x4*)(KRg + (size_t)(c >> 2) * 32 + (c & 3) * 8); }
        }
#pragma unroll
        for (int i = 0; i < 4; ++i) { const int c = tid + 512 * i; *(u32x4*)(Ks + (c >> 3) * 72 + (c & 7) * 8) = kr[i]; }
#pragma unroll
        for (int i = 0; i < 4; ++i) { const int c = tid + 512 * i; *(u32x4*)(Vs + (c >> 5) * 264 + (c & 31) * 8) = vr[i]; }
        if constexpr (NKS == 6) {
#pragma unroll
            for (int i = 0; i < 2; ++i) { const int c = tid + 512 * i; *(u32x4*)(Rs + (c >> 2) * 40 + (c & 3) * 8) = rr[i]; }
        }
    }
    bf16x8 q[NKS];
#pragma unroll
    for (int ks = 0; ks < NKS; ++ks) q[ks] = *(const bf16x8*)(qptr + ks * 16);
    __syncthreads();
    f32x16 o0, o1;
#pragma unroll
    for (int r = 0; r < 16; ++r) { o0[r] = 0.f; o1[r] = 0.f; }
    float m = -1e30f, lsum = 0.f;
#pragma unroll 1
    for (int t = 0; t < 8; ++t) {
        bf16x8 kf[NKS], vf[4];
        const bf16_t* kp = Ks + (t * 32 + pr) * 72 + hl * 8;
#pragma unroll
        for (int ks = 0; ks < 4; ++ks) kf[ks] = *(const bf16x8*)(kp + ks * 16);
        if constexpr (NKS == 6) {
            const bf16_t* rp = Rs + (t * 32 + pr) * 40 + hl * 8;
            kf[4] = *(const bf16x8*)rp; kf[5] = *(const bf16x8*)(rp + 16);
        }
        const bf16_t* vp = Vs + c32 * 264 + t * 32 + hl * 8;
        vf[0] = *(const bf16x8*)vp; vf[1] = *(const bf16x8*)(vp + 16);
        vf[2] = *(const bf16x8*)(vp + 32 * 264); vf[3] = *(const bf16x8*)(vp + 32 * 264 + 16);
        attn_step<NKS>(kf, vf, q, o0, o1, m, lsum, NoMask(), t);
    }
    lsum += __shfl_xor(lsum, 32);
    const float inv = 1.f / lsum;
#pragma unroll
    for (int qd = 0; qd < 4; ++qd) {
        u32x2 a, bb;
        a.x = pk2(o0[4 * qd] * inv, o0[4 * qd + 1] * inv); a.y = pk2(o0[4 * qd + 2] * inv, o0[4 * qd + 3] * inv);
        bb.x = pk2(o1[4 * qd] * inv, o1[4 * qd + 1] * inv); bb.y = pk2(o1[4 * qd + 2] * inv, o1[4 * qd + 3] * inv);
        *(u32x2*)(optr + 8 * qd + 4 * hl) = a;
        *(u32x2*)(optr + 32 + 8 * qd + 4 * hl) = bb;
    }
    __syncthreads();
}

DEVI void attn_na_ctx(const P& p, unsigned char* ws_b, int b, int h, int qg, int lane) {
    const int hl = lane >> 5, c32 = lane & 31, pr = pi_row(c32);
    const bf16_t* Qn = (const bf16_t*)(ws_b + WS_NAQ);
    const bf16_t* Kn = (const bf16_t*)(ws_b + WS_NAK);
    const bf16_t* VT = (const bf16_t*)(ws_b + WS_NAVT);
    bf16_t* YN = (bf16_t*)(ws_b + WS_YN);
    const int row0 = b * 256, qrow = row0 + qg * 32 + c32;
    const bf16_t* k0 = Kn + (size_t)(row0 + pr) * 512 + h * 64 + hl * 8;
    const bf16_t* v0 = VT + ((size_t)((b * 8 + h) * 64 + c32)) * 256 + hl * 8;
    auto src = [=](int t) { TileSrc s; s.k = k0 + (size_t)t * 32 * 512; s.k2 = s.k; s.v = v0 + t * 32; s.vhi = s.v + 32 * 256; return s; };
    attn_wave<4, false>(Qn + (size_t)qrow * 512 + h * 64 + hl * 8, 0, 8, src, NoMask(), YN + (size_t)qrow * 512 + h * 64, lane);
}

struct NaMask {
    const float* rpb;
    int rs, rq, qc, hl;
    DEVI void operator()(int t, f32x16& s) const {
        if (t >= 16) return;
        const int kr = t >> 1, kh = t & 1;
        const int cs = min(max(qc - 8, 0), 48);
        const float* rp = rpb + (rs + kr - rq + 7) * 31;
#pragma unroll
        for (int r = 0; r < 16; ++r) {
            const int kk = (r & 3) + 4 * ((r >> 2) & 1) + 8 * hl + 16 * (r >> 3);
            const int kc = kh * 32 + kk;
            const bool ok = (kc >= cs) && (kc < cs + 16);
            const int dc = min(max(kc - qc + 15, 0), 30);
            const float bias = rp[dc];
            s[r] = ok ? s[r] + bias : -1e30f;
        }
    }
};
DEVI void attn_na_lat(const P& p, unsigned char* ws_b, int l, int b, int h, int rq, int qh, int lane, float* ex, int half, const float* rpb_lds) {
    const int hl = lane >> 5, c32 = lane & 31, pr = pi_row(c32);
    const bf16_t* Qn = (const bf16_t*)(ws_b + WS_NAQ);
    const bf16_t* Kn = (const bf16_t*)(ws_b + WS_NAK);
    const bf16_t* VT = (const bf16_t*)(ws_b + WS_NAVT) + (size_t)4194304;
    const bf16_t* CK = (const bf16_t*)(ws_b + WS_CNAK) + (size_t)l * 1024 * 512;
    const bf16_t* CV = (const bf16_t*)(ws_b + WS_CNAVT) + (size_t)l * 1024 * 512;
    bf16_t* YN = (bf16_t*)(ws_b + WS_YN);
    const int row0 = NCTX + b * 2048;
    const int qrow = row0 + rq * 64 + qh * 32 + c32;
    const int rs = min(max(rq - 4, 0), 24);
    const bf16_t* k0 = Kn + (size_t)(row0 + rs * 64 + pr) * 512 + h * 64 + hl * 8;
    const bf16_t* v0 = VT + ((size_t)((b * 8 + h) * 64 + c32)) * 2048 + rs * 64 + hl * 8;
    const bf16_t* k1 = CK + (size_t)(b * 512 + pr) * 512 + h * 64 + hl * 8;
    const bf16_t* v1 = CV + ((size_t)((b * 8 + h) * 64 + c32)) * 512 + hl * 8;
    auto src = [=](int t) {
        TileSrc s;
        if (t < 16) { s.k = k0 + (size_t)t * 32 * 512; s.v = v0 + t * 32; s.vhi = s.v + 32 * 2048; }
        else { s.k = k1 + (size_t)(t - 16) * 32 * 512; s.v = v1 + (t - 16) * 32; s.vhi = s.v + 32 * 512; }
        s.k2 = s.k; return s; };
    NaMask mk; mk.rpb = rpb_lds; mk.rs = rs; mk.rq = rq; mk.qc = qh * 32 + c32; mk.hl = hl;
    attn_wave<4, true>(Qn + (size_t)qrow * 512 + h * 64 + hl * 8, half * 16, 16, src, mk, YN + (size_t)qrow * 512 + h * 64, lane, ex, half);
}

DEVI void row_load(const float* src, f32x4 (&v)[4], int lane) {
#pragma unroll
    for (int j = 0; j < 4; ++j) v[j] = *(const f32x4*)(src + 4 * lane + 256 * j);
}
DEVI void row_ln_mod(f32x4 (&v)[4], float* xdst, bf16_t* hdst, const float* lng, const float* lnb, const float* shift, const float* scale, int lane) {
    if (lng) {
        float s = 0.f;
#pragma unroll
        for (int j = 0; j < 4; ++j) s += (v[j].x + v[j].y) + (v[j].z + v[j].w);
        const float mu = wave_sum(s) * (1.f / D);
        float q = 0.f;
#pragma unroll
        for (int j = 0; j < 4; ++j) { v[j] = v[j] - mu; q += (v[j].x * v[j].x + v[j].y * v[j].y) + (v[j].z * v[j].z + v[j].w * v[j].w); }
        const float rstd = rsqrtf(wave_sum(q) * (1.f / D) + 1e-5f);
#pragma unroll
        for (int j = 0; j < 4; ++j) {
            const f32x4 g = *(const f32x4*)(lng + 4 * lane + 256 * j), bb = *(const f32x4*)(lnb + 4 * lane + 256 * j);
            v[j] = v[j] * rstd * g + bb;
        }
    }
    if (xdst) {
#pragma unroll
        for (int j = 0; j < 4; ++j) *(f32x4*)(xdst + 4 * lane + 256 * j) = v[j];
    }
    if (hdst) {
        float s = 0.f;
#pragma unroll
        for (int j = 0; j < 4; ++j) s += (v[j].x + v[j].y) + (v[j].z + v[j].w);
        const float mu = wave_sum(s) * (1.f / D);
        float q = 0.f;
#pragma unroll
        for (int j = 0; j < 4; ++j) { v[j] = v[j] - mu; q += (v[j].x * v[j].x + v[j].y * v[j].y) + (v[j].z * v[j].z + v[j].w * v[j].w); }
        const float rstd = rsqrtf(wave_sum(q) * (1.f / D) + 1e-6f);
#pragma unroll
        for (int j = 0; j < 4; ++j) {
            const f32x4 sc = *(const f32x4*)(scale + 4 * lane + 256 * j), sh = *(const f32x4*)(shift + 4 * lane + 256 * j);
            const f32x4 o = v[j] * rstd * (sc + 1.f) + sh;
            u32x2 pk; pk.x = pk2(o.x, o.y); pk.y = pk2(o.z, o.w);
            *(u32x2*)(hdst + 4 * lane + 256 * j) = pk;
        }
    }
}

DEVI const float* phase_rows_src(const P& p, unsigned char* ws_b, int row, int lnidx) {
    return (lnidx < 0) ? (row < NCTX ? pin(p, 0) + (size_t)row * D : pin(p, 1) + (size_t)(row - NCTX) * D) : (const float*)(ws_b + WS_X) + (size_t)row * D;
}
DEVI void phase_rows_one(const P& p, unsigned char* ws_b, f32x4 (&v)[4], int row, int l, int lnidx, int ml, int ms, bool final_, int lane) {
    float* X = (float*)(ws_b + WS_X);
    bf16_t* H = (bf16_t*)(ws_b + WS_H);
    const float* MOD = (const float*)(ws_b + WS_MOD);
    const float* lng = (lnidx < 0) ? nullptr : pin(p, 28) + (size_t)(l * 3 + lnidx) * D;
    const float* lnb = (lnidx < 0) ? nullptr : pin(p, 29) + (size_t)(l * 3 + lnidx) * D;
    if (final_) { row_ln_mod(v, p.out + (size_t)row * D, nullptr, lng, lnb, nullptr, nullptr, lane); return; }
    const float* mb = MOD + ((size_t)ml * 3 + mod_group(row)) * 9216;
    row_ln_mod(v, X + (size_t)row * D, H + (size_t)row * D, lng, lnb, mb + ms * D, mb + (ms + 1) * D, lane);
}
DEVI void phase_rows(const P& p, unsigned char* ws_b, int l, int lnidx, int ml, int ms, bool final_, int gw, int ngw, int lane) {
    int row = gw;
    for (; row + ngw < M; row += 2 * ngw) {
        f32x4 va[4], vb[4];
        row_load(phase_rows_src(p, ws_b, row, lnidx), va, lane);
        row_load(phase_rows_src(p, ws_b, row + ngw, lnidx), vb, lane);
        phase_rows_one(p, ws_b, va, row, l, lnidx, ml, ms, final_, lane);
        phase_rows_one(p, ws_b, vb, row + ngw, l, lnidx, ml, ms, final_, lane);
    }
    if (row < M) { f32x4 va[4]; row_load(phase_rows_src(p, ws_b, row, lnidx), va, lane); phase_rows_one(p, ws_b, va, row, l, lnidx, ml, ms, final_, lane); }
}

DEVI void phase_rowmix(const P& p, unsigned char* ws_b, int l, int gw, int ngw, int lane) {
    bf16_t* UQ = (bf16_t*)(ws_b + WS_UQ);
    const float* UKV = (const float*)(ws_b + WS_UKV);
    const float* KRF = (const float*)(ws_b + WS_KRF);
    bf16_t* CKV = (bf16_t*)(ws_b + WS_CKV);
    bf16_t* KR = (bf16_t*)(ws_b + WS_KR);
    const float* ropec = (const float*)(ws_b + WS_ROPE);
    const float* ropes = ropec + 512;
    const float* gq = pin(p, 17) + l * 384;
    const float* gkv = pin(p, 19) + l * 256;
    for (int row = gw; row < M; row += ngw) {
        {
            unsigned* up = (unsigned*)(UQ + (size_t)row * 384) + lane;
            float x[6]; float ss = 0.f;
#pragma unroll
            for (int j = 0; j < 3; ++j) { const unsigned w = up[64 * j]; x[2 * j] = bf2f(w & 0xffffu); x[2 * j + 1] = bf2f(w >> 16); ss += x[2 * j] * x[2 * j] + x[2 * j + 1] * x[2 * j + 1]; }
            const float rs = rsqrtf(wave_sum(ss) * (1.f / 384.f) + 1e-6f);
#pragma unroll
            for (int j = 0; j < 3; ++j) { const int c = 2 * lane + 128 * j; up[64 * j] = pk2(x[2 * j] * rs * gq[c], x[2 * j + 1] * rs * gq[c + 1]); }
        }
        {
            const f32x4 v = *(const f32x4*)(UKV + (size_t)row * 256 + 4 * lane);
            const float ss = v.x * v.x + v.y * v.y + v.z * v.z + v.w * v.w;
            const float rs = rsqrtf(wave_sum(ss) * (1.f / 256.f) + 1e-6f);
            const f32x4 g = *(const f32x4*)(gkv + 4 * lane);
            const f32x4 o = v * rs * g;
            u32x2 pk; pk.x = pk2(o.x, o.y); pk.y = pk2(o.z, o.w);
            *(u32x2*)(CKV + (size_t)row * 256 + 4 * lane) = pk;
            if (row < NCTX) *(f32x4*)(p.out + OUT_CKV + ((size_t)((row >> 8) * 4 + l) * 256 + (row & 255)) * 256 + 4 * lane) = o;
        }
        {
            const float v = KRF[(size_t)row * 32 + (lane & 31)];
            const float pr = __shfl_xor(v, 8);
            float o = v;
            if (row >= NCTX) {
                const int c = lane & 31, axis = c >> 4, ii = c & 15, n = (row - NCTX) & 2047;
                const int pos = axis ? (n & 63) : (n >> 6);
                const float rot = (ii < 8) ? -pr : pr;
                o = v * ropec[pos * 8 + (ii & 7)] + rot * ropes[pos * 8 + (ii & 7)];
            }
            if (lane < 32) {
                KR[(size_t)row * 32 + lane] = f2bf(o);
                if (row < NCTX) p.out[OUT_KR + ((size_t)((row >> 8) * 4 + l) * 256 + (row & 255)) * 32 + lane] = v;
            }
        }
    }
}

DEVI void transpose_item(const float* __restrict__ src, int N, int c0, int k0, bf16_t* __restrict__ dst, int K, float* scr, int lane) {
#pragma unroll 8
    for (int i = 0; i < 32; ++i) { const int kk = 2 * i + (lane >> 5); scr[kk * 33 + (lane & 31)] = src[(size_t)(k0 + kk) * N + c0 + (lane & 31)]; }
    asm volatile("s_waitcnt lgkmcnt(0)" ::: "memory");
    const int c = lane & 7;
#pragma unroll
    for (int j = 0; j < 4; ++j) {
        const int n = (lane >> 3) + 8 * j; const float* s = scr + (8 * c) * 33 + n;
        u32x4 o; o.x = pk2(s[0], s[33]); o.y = pk2(s[2 * 33], s[3 * 33]); o.z = pk2(s[4 * 33], s[5 * 33]); o.w = pk2(s[6 * 33], s[7 * 33]);
        *(u32x4*)(dst + (size_t)n * K + k0 + 8 * c) = o;
    }
    asm volatile("s_waitcnt lgkmcnt(0)" ::: "memory");
}

DEVI void prep_weight_item(const P& p, unsigned char* ws_b, int item, float* scr, int lane) {
    const int l = item / 12944; int r = item % 12944;
    bf16_t* Wl = (bf16_t*)(ws_b + WS_W) + (size_t)l * LAYER_W;
    if (r < 8448) {
        const int which = r / 4224; r %= 4224;
        if (r < 2816) {
            const int rb = r >> 4, kb = r & 15;
            const float* src = ((lane & 16) ? (which ? pin(p, 14) : pin(p, 11)) : (which ? pin(p, 13) : pin(p, 10))) + (size_t)l * D * DFF;
            transpose_item(src, DFF, rb * 16 - (lane & 16), kb * 64, Wl + (which ? OFF_W13_2 : OFF_W13_1) + (size_t)rb * 32 * D, D, scr, lane);
        } else {
            r -= 2816; const int rb = r / 44, kb = r % 44;
            const float* src = (which ? pin(p, 15) : pin(p, 12)) + (size_t)l * DFF * D;
            transpose_item(src, D, rb * 32, kb * 64, Wl + (which ? OFF_W2_2 : OFF_W2_1) + (size_t)rb * 32 * DFF, DFF, scr, lane);
        }
        return;
    }
    r -= 8448;
    if (r < 2944) {
        const int rb = r >> 4, kb = r & 15, R0 = rb * 32;
        const float* src; int N, c0;
        if (R0 < 1184) { src = pin(p, 16) + (size_t)l * D * 2720; N = 2720; c0 = R0; }
        else if (R0 < 1280) return;
        else if (R0 < 2816) { src = pin(p, 16) + (size_t)l * D * 2720; N = 2720; c0 = R0 - 96; }
        else { src = pin(p, 25) + (size_t)l * D * 3072; N = 3072; c0 = R0 - 2816; }
        transpose_item(src, N, c0, kb * 64, Wl + OFF_WIN + (size_t)R0 * D, D, scr, lane);
        return;
    }
    r -= 2944;
    if (r < 512) { const int rb = r >> 4, kb = r & 15; transpose_item(pin(p, 27) + (size_t)l * D * D, D, rb * 32, kb * 64, Wl + OFF_WOUT + (size_t)rb * 32 * D, D, scr, lane); return; }
    r -= 512;
    if (r < 768) { const int w = r >> 8; r &= 255; const int rb = r >> 3, kb = r & 7;
        transpose_item((w == 0 ? pin(p, 22) : (w == 1 ? pin(p, 23) : pin(p, 24))) + (size_t)l * 512 * D, D, rb * 32, kb * 64, Wl + (w == 0 ? OFF_WBF : (w == 1 ? OFF_WBM : OFF_WBN)) + (size_t)rb * 32 * 512, 512, scr, lane); return; }
    r -= 768;
    if (r < 144) { const int rb = r / 6, kb = r % 6; transpose_item(pin(p, 18) + (size_t)l * 384 * 768, 768, rb * 32, kb * 64, Wl + OFF_WUQ + (size_t)rb * 32 * 384, 384, scr, lane); return; }
    r -= 144;
    { const int rb = r >> 2, kb = r & 3; transpose_item(pin(p, 20) + (size_t)l * 256 * 1024, 1024, rb * 32, kb * 64, Wl + OFF_WUKV + (size_t)rb * 32 * 256, 256, scr, lane); }
}

DEVI void phase_prep(const P& p, unsigned char* ws_b, unsigned char* smem, int tid) {
    const int lane = tid & 63, wave = tid >> 6;
    const int gw = blockIdx.x * NWAVES + wave, ngw = gridDim.x * NWAVES;
    const size_t gt = (size_t)blockIdx.x * NTHREADS + tid, ngt = (size_t)gridDim.x * NTHREADS;
    {
        float* sil = (float*)smem;
        const float* wada = pin(p, 8);
        float* MODP = (float*)(ws_b + WS_MODP);
        for (int item = blockIdx.x; item < 1152; item += gridDim.x) {
            const int l = item / 288, rem = item % 288, kc = rem / 18, cb = rem % 18;
            __syncthreads();
            if (tid < 192) {
                const int g = tid >> 6, k = kc * 64 + (tid & 63);
                const float cv = (g == 0) ? pin(p, 7)[k] : pin(p, 6)[(g - 1) * D + k];
                sil[tid] = cv * sigmoidf_(cv);
            }
            __syncthreads();
            const int col = cb * NTHREADS + tid;
            const float* w = wada + ((size_t)l * D + kc * 64) * 9216 + col;
            float a0 = 0.f, a1 = 0.f, a2 = 0.f;
#pragma unroll 16
            for (int k = 0; k < 64; ++k) { const float wv = w[(size_t)k * 9216]; a0 += sil[k] * wv; a1 += sil[64 + k] * wv; a2 += sil[128 + k] * wv; }
            float* o = MODP + ((size_t)(l * 16 + kc) * 3) * 9216 + col;
            o[0] = a0; o[9216] = a1; o[2 * 9216] = a2;
        }
        __syncthreads();
    }
    {
        float* scr = (float*)smem + wave * (64 * 33);
        for (int item = gw; item < 4 * 12944; item += ngw) prep_weight_item(p, ws_b, item, scr, lane);
    }
    {
        bf16_t* TABL = (bf16_t*)(ws_b + WS_TABL);
        for (size_t e = gt; e < (size_t)2048 * 4096; e += ngt) {
            const int k = (int)(e >> 12), kk = (int)(e & 4095), lidx = kk & 2047;
            const int idx = (k * lidx) & 2047;
            float sn, cs; sincospif((float)idx * (2.f / 2048.f), &sn, &cs);
            TABL[e] = f2bf((kk < 2048 ? cs : -sn) * 0.022097086912079608f);
        }
        bf16_t* TABC = (bf16_t*)(ws_b + WS_TABC);
        for (size_t e = gt; e < (size_t)256 * 512; e += ngt) {
            const int k = (int)(e >> 9), kk = (int)(e & 511), lidx = kk & 255;
            const int idx = (k * lidx) & 255;
            float sn, cs; sincospif((float)idx * (2.f / 256.f), &sn, &cs);
            TABC[e] = f2bf((kk < 256 ? cs : -sn) * 0.0625f);
        }
        bf16_t* WCS = (bf16_t*)(ws_b + WS_WCS);
        for (size_t e = gt; e < (size_t)256 * 128; e += ngt) {
            const int i = (int)(e >> 7), c = (int)(e & 127), m = i >> 1, cs_ = i & 1;
            const int idx = (m * c) & 127;
            float sn, cs; sincospif((float)idx * (2.f / 128.f), &sn, &cs);
            WCS[e] = f2bf((cs_ ? sn : cs) * 0.08838834764831845f);
        }
        float* ROPE = (float*)(ws_b + WS_ROPE);
        for (size_t e = gt; e < 512; e += ngt) {
            const int pos = (int)(e >> 3), i = (int)(e & 7);
            const float inv_freq = powf(10000.f, -(float)i / 8.f);
            const float ang = (float)pos * inv_freq;
            ROPE[e] = cosf(ang); ROPE[512 + e] = sinf(ang);
        }
    }
    {
        bf16_t* CCKV = (bf16_t*)(ws_b + WS_CCKV);
        for (size_t e = gt; e < (size_t)NL * 1024 * 256; e += ngt) {
            const int c = (int)(e & 255), i = (int)((e >> 8) & 511), b = (int)((e >> 17) & 1), l = (int)(e >> 18);
            CCKV[e] = f2bf(pin(p, 2)[((size_t)(b * 4 + l) * 512 + i) * 256 + c]);
        }
        bf16_t* CKR = (bf16_t*)(ws_b + WS_CKR);
        for (size_t e = gt; e < (size_t)NL * 1024 * 32; e += ngt) {
            const int c = (int)(e & 31), i = (int)((e >> 5) & 511), b = (int)((e >> 14) & 1), l = (int)(e >> 15);
            CKR[e] = f2bf(pin(p, 3)[((size_t)(b * 4 + l) * 512 + i) * 32 + c]);
        }
        bf16_t* CNAK = (bf16_t*)(ws_b + WS_CNAK);
        for (size_t e = gt; e < (size_t)NL * 1024 * 512; e += ngt) {
            const int c = (int)(e & 511), i = (int)((e >> 9) & 511), b = (int)((e >> 18) & 1), l = (int)(e >> 19);
            CNAK[e] = f2bf(pin(p, 4)[((size_t)(b * 4 + l) * 512 + i) * 512 + c]);
        }
        bf16_t* CNAVT = (bf16_t*)(ws_b + WS_CNAVT);
        for (size_t e = gt; e < (size_t)NL * 1024 * 512; e += ngt) {
            const int key = (int)(e & 511), hd = (int)((e >> 9) & 511), b = (int)((e >> 18) & 1), l = (int)(e >> 19);
            CNAVT[e] = f2bf(pin(p, 5)[((size_t)(b * 4 + l) * 512 + key) * 512 + hd]);
        }
    }
}

DEVI void phase_modreduce(const P& p, unsigned char* ws_b, int tid) {
    const float* MODP = (const float*)(ws_b + WS_MODP);
    float* MOD = (float*)(ws_b + WS_MOD);
    for (int e = blockIdx.x * NTHREADS + tid; e < NL * 3 * 9216; e += gridDim.x * NTHREADS) {
        const int l = e / (3 * 9216), rem = e % (3 * 9216);
        float a = pin(p, 9)[l * 9216 + (rem % 9216)];
#pragma unroll
        for (int kc = 0; kc < 16; ++kc) a += MODP[((size_t)(l * 16 + kc) * 3) * 9216 + rem];
        MOD[e] = a;
    }
}

#define XB_TMO      128
#define XB_XCNT(j)  (256  + 64 * (j))
#define XB_XSUB(j)  (1280 + 64 * (j))
#define XB_XGEN(j)  (2304 + 64 * (j))
#define XB_TOP      3328
#define XB_TOPGEN   3392
#define XCD_BAR_WORDS 3456
#define XB_SPIN_CAP (1u << 20)
#define LAS __attribute__((address_space(3)))
DEVI unsigned xb_ld(unsigned* p)              { return __hip_atomic_load(p, __ATOMIC_RELAXED, __HIP_MEMORY_SCOPE_AGENT); }
DEVI unsigned xb_add(unsigned* p, unsigned v) { return __hip_atomic_fetch_add(p, v, __ATOMIC_RELAXED, __HIP_MEMORY_SCOPE_AGENT); }
DEVI unsigned xb_xcc_id() { return (unsigned)__builtin_amdgcn_s_getreg((3 << 11) | 20) & 0xFu; }
#define XB_SPIN(cond, bar) do { unsigned _sp = 0; while (cond) { __builtin_amdgcn_s_sleep(1); \
    if ((++_sp & 255u) == 0u) { if (xb_ld(&(bar)[XB_TMO])) break; if (_sp > XB_SPIN_CAP) { atomicAdd(&(bar)[XB_TMO], 1u); break; } } } } while (0)
struct XcdBarrier { unsigned* bar; unsigned x; volatile LAS unsigned* st; };
DEVI XcdBarrier xcd_barrier_post(unsigned* bar, volatile LAS unsigned* st) {
    XcdBarrier b; b.bar = bar; b.x = xb_xcc_id(); b.st = st;
    if (threadIdx.x == 0) (void)xb_add(&bar[XB_XCNT(b.x)], 1u);
    return b;
}
DEVI void xcd_barrier_complete(unsigned* bar, unsigned x, unsigned& nloc, unsigned& nx) {
    const unsigned G = gridDim.x * gridDim.y * gridDim.z;
    unsigned sum, cnt, mine, sp = 0u;
    for (;;) {
        sum = 0u; cnt = 0u; mine = 0u;
#pragma unroll
        for (unsigned j = 0; j < 16; ++j) { const unsigned c = xb_ld(&bar[XB_XCNT(j)]); sum += c; cnt += (c > 0u) ? 1u : 0u; mine = (j == x) ? c : mine; }
        if (sum == G) break;
        __builtin_amdgcn_s_sleep(1);
        if ((++sp & 255u) == 0u) { if (xb_ld(&bar[XB_TMO])) break; if (sp > XB_SPIN_CAP) { atomicAdd(&bar[XB_TMO], 1u); break; } }
    }
    nloc = mine > 0u ? mine : 1u; nx = cnt > 0u ? cnt : 1u;
}
DEVI void xcd_barrier(const XcdBarrier& b) {
    asm volatile("s_waitcnt vmcnt(0)" ::: "memory");
    __syncthreads();
    if (threadIdx.x == 0) {
        unsigned* bar = b.bar;
        __builtin_amdgcn_s_waitcnt(0);
        unsigned nloc = b.st[0], nx = b.st[1];
        if (nloc == 0u) { xcd_barrier_complete(bar, b.x, nloc, nx); b.st[0] = nloc; b.st[1] = nx; }
        const unsigned old = xb_add(&bar[XB_XSUB(b.x)], 1u);
        const unsigned gen = old / nloc;
        if (old + 1u == (gen + 1u) * nloc) {
            __builtin_amdgcn_fence(__ATOMIC_RELEASE, "agent");
            asm volatile("s_waitcnt vmcnt(0)" ::: "memory");
            const unsigned og = xb_add(&bar[XB_TOP], 1u);
            const unsigned tg = og / nx;
            if (og + 1u == (tg + 1u) * nx) xb_add(&bar[XB_TOPGEN], 1u);
            else XB_SPIN(xb_ld(&bar[XB_TOPGEN]) == tg, bar);
            __builtin_amdgcn_fence(__ATOMIC_ACQUIRE, "agent");
            xb_add(&bar[XB_XGEN(b.x)], 1u);
            asm volatile("s_waitcnt vmcnt(0)" ::: "memory");
        } else {
            XB_SPIN(xb_ld(&bar[XB_XGEN(b.x)]) == gen, bar);
            __builtin_amdgcn_fence(__ATOMIC_ACQUIRE, "agent");
            asm volatile("s_waitcnt vmcnt(0)" ::: "memory");
        }
    }
    __syncthreads();
}

DEVI void run_phase(const P& p, unsigned char* ws_b, int ph, unsigned char* smem, int tid) {
    const int lane = tid & 63, wave = tid >> 6;
    const int gw = blockIdx.x * NWAVES + wave, ngw = gridDim.x * NWAVES;
    const int nb = gridDim.x, bid = blockIdx.x;
    const int grp = tid >> 8, ltid = tid & 255;
    bf16_t* sm = (bf16_t*)smem + grp * (SMEM_BYTES / 2);
    if (ph == 0) { phase_prep(p, ws_b, smem, tid); return; }
    if (ph == 1) { phase_modreduce(p, ws_b, tid); return; }
    if (ph == 2) { phase_rows(p, ws_b, 0, -1, 0, 0, false, gw, ngw, lane); return; }
    const int l = (ph - 3) / 13, s = (ph - 3) % 13;
    const bf16_t* Wl = (const bf16_t*)(ws_b + WS_W) + (size_t)l * LAYER_W;
    const float* MODl = (const float*)(ws_b + WS_MOD) + (size_t)l * 3 * 9216;
    switch (s) {
    case 0: case 10:
        {
            pg8::Gemm g{(const bf16_t*)(ws_b + WS_H), Wl + (s == 10 ? OFF_W13_2 : OFF_W13_1), M, 2 * DFF, D};
            pg8::StaticOrder S; S.init(M, 2 * DFF, nb, bid);
            pg8::EpiSwiGLU E{(bf16_t*)(ws_b + WS_ACT)};
            pg8::gemm_phase<pg8::EpiSwiGLU, pg8::StaticOrder, true, true>((PG8_LAS unsigned char*)smem, g, S, E, tid);
        }
        break;
    case 1: case 11:
        {
            pg8::Gemm g{(const bf16_t*)(ws_b + WS_ACT), Wl + (s == 11 ? OFF_W2_2 : OFF_W2_1), M, D, DFF};
            pg8::StaticOrder S; S.init(M, D, nb, bid);
            pg8::EpiResid E{(float*)(ws_b + WS_X), MODl + (s == 11 ? 8 : 2) * D, 0.5f};
            pg8::gemm_phase<pg8::EpiResid, pg8::StaticOrder, false, true>((PG8_LAS unsigned char*)smem, g, S, E, tid);
        }
        break;
    case 2: phase_rows(p, ws_b, l, 0, l, 3, false, gw, ngw, lane); break;
    case 3:
        {
            pg8::Gemm g{(const bf16_t*)(ws_b + WS_H), Wl + OFF_WIN, M, 5888, D};
            pg8::InGateOrder S{nb, bid, 0, nb == 256 ? 1024 : 1104};
            pg8::EpiIn E{ws_b, p.out, pin(p, 26), l};
            pg8::gemm_phase<pg8::EpiIn, pg8::InGateOrder, true, true>((PG8_LAS unsigned char*)smem, g, S, E, tid);
        }
        break;
    case 4: phase_rowmix(p, ws_b, l, gw, ngw, lane); break;
    case 5: {
        float* ex = (float*)smem + (wave & 3) * (34 * 64);
        int u = bid;
        for (; u < 256; u += nb) {
            const int wi = u * 4 + (wave & 3);
            float* rpb_lds = (float*)(smem + 36864);
            {
                const float* rsrc = pin(p, 21) + (size_t)(l * 8 + ((u * 4 >> 6) & 7)) * 465;
                if (tid < 465) rpb_lds[tid] = rsrc[tid] * LOG2E;
                __syncthreads();
            }
            attn_na_lat(p, ws_b, l, wi >> 9, (wi >> 6) & 7, (wi >> 1) & 31, wi & 1, lane, ex, wave >> 2, rpb_lds);
        }
        for (; u < 256 + 416; u += nb) job_ukv(p, ws_b, l, 2 * (u - 256) + grp, sm, ltid);
        for (; u < 256 + 416 + 288; u += nb) job_uq(p, ws_b, l, 2 * (u - 256 - 416) + grp, sm, ltid);
        for (; u < 256 + 416 + 288 + 384; u += nb) job_f1(p, ws_b, 2 * (u - 256 - 416 - 288) + grp, sm, ltid);
        for (; u < 256 + 416 + 288 + 384 + 256; u += nb) {
            const int wi = (u - 256 - 416 - 288 - 384) * 8 + wave;
            const int b = wi >> 6, h = (wi >> 3) & 7, qrow = b * 256 + wave * 32 + (lane & 31);
            attn_ctx_shared<4>((const bf16_t*)(ws_b + WS_NAK) + (size_t)(b * 256) * 512 + h * 64, nullptr,
                               (const bf16_t*)(ws_b + WS_NAVT) + (size_t)((b * 8 + h) * 64) * 256,
                               (const bf16_t*)(ws_b + WS_NAQ) + (size_t)qrow * 512 + h * 64 + (lane >> 5) * 8,
                               (bf16_t*)(ws_b + WS_YN) + (size_t)qrow * 512 + h * 64, tid, smem);
        }
    } break;
    case 6: {
        float* ex = (float*)smem + (wave & 3) * (34 * 64);
        int u = bid;
        for (; u < 256; u += nb) {
            const int wi = u * 4 + (wave & 3);
            attn_mla_lat_shared(p, ws_b, l, wi >> 9, (wi >> 6) & 7, wi & 63, tid, smem, ex);
        }
        for (; u < 256 + 128; u += nb) {
            const int t0 = u - 256, tt = ((t0 & 7) + 8 * ((t0 >> 3) >> 2)) * 4 + ((t0 >> 3) & 3);
            job_f2_lat(p, ws_b, tt, sm, ltid, grp, (float*)(smem + SMEM_BYTES));
        }
        for (; u < 256 + 128 + 128; u += nb) job_f2_ctx(p, ws_b, 2 * (u - 256 - 128) + grp, sm, ltid);
        int it = (nb == 256) ? (bid >= 128 ? bid - 128 : 1 << 20) : u - (256 + 128 + 128);
        for (; it < 256; ) {
            const int wi = it * 8 + wave;
            const int b = wi >> 6, h = (wi >> 3) & 7, qrow = b * 256 + wave * 32 + (lane & 31);
            attn_ctx_shared<6>((const bf16_t*)(ws_b + WS_KN) + (size_t)(b * 256) * 512 + h * 64, (const bf16_t*)(ws_b + WS_KR) + (size_t)(b * 256) * 32,
                               (const bf16_t*)(ws_b + WS_VTM) + (size_t)((b * 8 + h) * 64) * 256,
                               (const bf16_t*)(ws_b + WS_Q) + (size_t)qrow * 768 + h * 96 + (lane >> 5) * 8,
                               (bf16_t*)(ws_b + WS_YM) + (size_t)qrow * 512 + h * 64, tid, smem);
            if (nb != 256) it += nb;
            else if (bid < 208) it = 1 << 20;
            else it = (it < 128) ? 128 + (bid - 208) : it + 48;
        }
        if (nb == 256 && bid >= 128 && bid < 208) {
            int tid5 = tid; asm volatile("" : "+v"(tid5));
            pg8::Gemm g{(const bf16_t*)(ws_b + WS_H), Wl + OFF_WIN, M, 5888, D};
            pg8::InGateOrder S{1 << 20, bid - 128, 1024, 1104};
            pg8::EpiIn E{ws_b, p.out, pin(p, 26), l};
            pg8::gemm_phase<pg8::EpiIn, pg8::InGateOrder, false, true>((PG8_LAS unsigned char*)smem, g, S, E, tid5);
        }
    } break;
    case 7:

#pragma nounroll
        for (int sg = 0; sg < 3; ++sg) {
            int tid3 = tid; asm volatile("" : "+v"(tid3));
            pg8::Gemm g{(const bf16_t*)(ws_b + (sg == 0 ? WS_YF : (sg == 1 ? WS_YM : WS_YN))), Wl + (sg == 0 ? OFF_WBF : (sg == 1 ? OFF_WBM : OFF_WBN)), M, D, 512};
            pg8::StaticOrder S; S.init(M, D, nb, bid);
            pg8::EpiMerge E{(const bf16_t*)(ws_b + WS_GATE), (bf16_t*)(ws_b + WS_UF)  , (bf16_t*)(ws_b + WS_MERGED), sg};
            pg8::gemm_phase<pg8::EpiMerge, pg8::StaticOrder, false, true>((PG8_LAS unsigned char*)smem, g, S, E, tid3);
        }
        break;
    case 8:
        {
            pg8::Gemm g{(const bf16_t*)(ws_b + WS_MERGED), Wl + OFF_WOUT, M, D, D};
            pg8::StaticOrder S; S.init(M, D, nb, bid);
            pg8::EpiResid E{(float*)(ws_b + WS_X), MODl + 5 * D, 1.0f};
            pg8::gemm_phase<pg8::EpiResid, pg8::StaticOrder, false, true>((PG8_LAS unsigned char*)smem, g, S, E, tid);
        }
        break;
    case 9: phase_rows(p, ws_b, l, 1, l, 6, false, gw, ngw, lane); break;
    case 12:
        if (l == NL - 1) phase_rows(p, ws_b, l, 2, 0, 0, true, gw, ngw, lane);
        else phase_rows(p, ws_b, l, 2, l + 1, 0, false, gw, ngw, lane);
        break;
    default: break;
    }
}

__global__ void __launch_bounds__(NTHREADS, 2) mega_kernel(P p) {
    extern __shared__ __attribute__((aligned(16))) unsigned char smem[];
    __shared__ uint4 xb_words;
    cg::grid_group grid = cg::this_grid();
    const int tid = threadIdx.x;
    unsigned* bar = (unsigned*)(p.ws + WS_BAR);
    if (tid == 0) xb_words = make_uint4(0u, 0u, 0u, 0u);
    if (p.ph_lo == 0 && blockIdx.x == 0) for (int i = tid; i < XCD_BAR_WORDS; i += NTHREADS) bar[i] = 0u;
    __syncthreads();
    XcdBarrier xb; xb.bar = bar; xb.x = 0; xb.st = (volatile LAS unsigned*)&xb_words;
#pragma nounroll
    for (int ph = p.ph_lo; ph < p.ph_hi; ++ph) {
        int tid2 = tid; asm volatile("" : "+v"(tid2));
        unsigned char* ws_b = p.ws; asm volatile("" : "+s"(ws_b));
        run_phase(p, ws_b, ph, smem, tid2);
        if (ph + 1 < p.ph_hi) {
            if (ph == p.ph_lo) { grid.sync(); xb = xcd_barrier_post(bar, (volatile LAS unsigned*)&xb_words); }
            else xcd_barrier(xb);
        }
    }
}

extern "C" void kernel_launch(void* const* d_in, const int* in_sizes, int n_in, void* d_out, int out_size, void* d_ws, size_t ws_size,
                              hipStream_t stream) {
    static int grid_blocks = 0;
    if (grid_blocks == 0) {
        if (n_in != 30 || ws_size < WS_END) { fprintf(stderr, "kernel_launch: n_in %d ws %zu need %zu\n", n_in, ws_size, (size_t)WS_END); grid_blocks = -1; return; }
        int dev = 0, cus = 0, per_cu = 0;
        hipGetDevice(&dev);
        hipDeviceGetAttribute(&cus, hipDeviceAttributeMultiprocessorCount, dev);
        hipFuncSetAttribute((const void*)mega_kernel, hipFuncAttributeMaxDynamicSharedMemorySize, LDS_TOTAL);
        hipOccupancyMaxActiveBlocksPerMultiprocessor(&per_cu, (const void*)mega_kernel, NTHREADS, LDS_TOTAL);
        if (per_cu < 1) per_cu = 1;
        if (per_cu > 1) per_cu = 1;
        grid_blocks = cus * per_cu;
    }
    if (grid_blocks < 0) return;
    P p{};
    for (int i = 0; i < 30; ++i) p.in[i] = (const float*)d_in[i];
    p.out = (float*)d_out; p.ws = (unsigned char*)d_ws; p.ph_lo = 0; p.ph_hi = NPHASE;
#ifndef MULTI_LAUNCH
#define MULTI_LAUNCH 0
#endif
#if MULTI_LAUNCH
    for (int ph = 0; ph < NPHASE; ++ph) {
        p.ph_lo = ph; p.ph_hi = ph + 1;
        hipLaunchKernelGGL(mega_kernel, dim3(grid_blocks), dim3(NTHREADS), LDS_TOTAL, stream, p);
    }
#else
    void* args[] = {&p};
    hipError_t e = hipLaunchCooperativeKernel((const void*)mega_kernel, dim3(grid_blocks), dim3(NTHREADS), args, LDS_TOTAL, stream);
    if (e != hipSuccess) fprintf(stderr, "cooperative launch failed: %s (grid %d)\n", hipGetErrorString(e), grid_blocks);
#endif
}
```

```cpp
#include <hip/hip_runtime.h>
#include <hip/hip_cooperative_groups.h>
#include <cstdint>
#include <cstdio>
namespace cg = cooperative_groups;

typedef unsigned short bf16_t;
typedef short bf16x8 __attribute__((ext_vector_type(8)));
typedef float f32x16 __attribute__((ext_vector_type(16)));
typedef float f32x4 __attribute__((ext_vector_type(4)));
typedef unsigned u32x4 __attribute__((ext_vector_type(4)));
typedef unsigned u32x2 __attribute__((ext_vector_type(2)));
#define DEVI __device__ __forceinline__

constexpr int D = 1024, NCTX = 8192, NLAT = 4096, M = 12288, MX = 13312, DFF = 2816, NL = 4;
constexpr float ALPHA_F = 1.6817928305074290f;
constexpr float LOG2E = 1.4426950408889634f;
constexpr float MLA_QS = 0.10206207261596575f * LOG2E;
constexpr float NA_QS = 0.125f * LOG2E;
constexpr size_t OUT_CKV = 12582912, OUT_KR = 20971520, OUT_NAK = 22020096, OUT_NAV = 38797312;

constexpr size_t al256(size_t x) { return (x + 255) & ~(size_t)255; }
constexpr size_t WS_BAR = 0;
constexpr size_t WS_X = 16384;
constexpr size_t WS_H = WS_X + (size_t)M * D * 4;
constexpr size_t WS_MOD = WS_H + (size_t)M * D * 2;
constexpr size_t WS_MODP = WS_MOD + al256((size_t)NL * 3 * 9216 * 4);
constexpr size_t WS_ROPE = WS_MODP + al256((size_t)NL * 16 * 3 * 9216 * 4);
constexpr size_t WS_TABC = WS_ROPE + 4096;
constexpr size_t WS_TABL = WS_TABC + (size_t)256 * 512 * 2;
constexpr size_t WS_WCS = WS_TABL + (size_t)2048 * 4096 * 2;
constexpr size_t WS_CCKV = WS_WCS + (size_t)256 * 128 * 2;
constexpr size_t WS_CKR = WS_CCKV + (size_t)NL * 1024 * 256 * 2;
constexpr size_t WS_CNAK = WS_CKR + (size_t)NL * 1024 * 32 * 2;
constexpr size_t WS_CNAVT = WS_CNAK + (size_t)NL * 1024 * 512 * 2;
constexpr size_t WS_W = WS_CNAVT + (size_t)NL * 1024 * 512 * 2;
constexpr size_t OFF_W13_1 = 0, OFF_W2_1 = 5767168, OFF_W13_2 = 8650752, OFF_W2_2 = 14417920, OFF_WIN = 17301504,
                 OFF_WOUT = 23330816, OFF_WBF = 24379392, OFF_WBM = 24903680, OFF_WBN = 25427968, OFF_WUQ = 25952256,
                 OFF_WUKV = 26247168, LAYER_W = 26509312;
constexpr size_t WS_R1 = WS_W + (size_t)NL * LAYER_W * 2;
constexpr size_t WS_ACT = WS_R1;
constexpr size_t WS_UF = WS_R1;
constexpr size_t WS_UQ = WS_UF + (size_t)M * 512 * 2;
constexpr size_t WS_UKV = WS_UQ + (size_t)M * 384 * 2;
constexpr size_t WS_KRF = WS_UKV + (size_t)M * 256 * 4;
constexpr size_t WS_CKV = WS_KRF + (size_t)M * 32 * 4;
constexpr size_t WS_KR = WS_CKV + (size_t)M * 256 * 2;
constexpr size_t WS_NAQ = WS_KR + (size_t)M * 32 * 2;
constexpr size_t WS_NAK = WS_NAQ + (size_t)M * 512 * 2;
constexpr size_t WS_NAVT = WS_NAK + (size_t)M * 512 * 2;
constexpr size_t WS_GATE = WS_NAVT + (size_t)M * 512 * 2;
constexpr size_t WS_Q = WS_GATE + (size_t)M * 3072 * 2;
constexpr size_t WS_KN = WS_Q + (size_t)M * 768 * 2;
constexpr size_t WS_VTM = WS_KN + (size_t)MX * 512 * 2;
constexpr size_t WS_F1T = WS_VTM + (size_t)MX * 512 * 2;
constexpr size_t WS_YF = WS_F1T + (size_t)M * 1024 * 2;
constexpr size_t WS_YM = WS_YF + (size_t)M * 512 * 2;
constexpr size_t WS_YN = WS_YM + (size_t)M * 512 * 2;
constexpr size_t WS_MERGED = WS_YN + (size_t)M * 512 * 2;
constexpr size_t WS_END = WS_MERGED + (size_t)M * 1024 * 2;
static_assert(WS_END - WS_R1 >= (size_t)M * DFF * 2, "ACT must fit in R1");
static_assert(WS_NAK - WS_UF >= (size_t)M * D * 4, "merge T32 must fit in the dead UF..NAQ buffers");

constexpr int NPHASE = 3 + 13 * NL;

struct P {
    const float* in[30];
    float* out;
    unsigned char* ws;
    int ph_lo, ph_hi;
};

__device__ __forceinline__ const float* pin(const P& p, int i) { int j = i; asm volatile("" : "+s"(j)); return p.in[j]; }
typedef __bf16 bf16v2 __attribute__((ext_vector_type(2)));
typedef float f32x2 __attribute__((ext_vector_type(2)));
DEVI unsigned pk2(float lo, float hi) { f32x2 v = {lo, hi}; bf16v2 b = __builtin_convertvector(v, bf16v2); return __builtin_bit_cast(unsigned, b); }
DEVI bf16_t f2bf(float x) { return (bf16_t)(pk2(x, 0.f) & 0xffffu); }
DEVI float bf2f(unsigned v) { return __uint_as_float(v << 16); }
DEVI float wave_sum(float v) {
#pragma unroll
    for (int o = 1; o < 64; o <<= 1) v += __shfl_xor(v, o);
    return v;
}
DEVI float fast_exp2(float x) { return __builtin_amdgcn_exp2f(x); }
DEVI float sigmoidf_(float x) { return __builtin_amdgcn_rcpf(1.f + __expf(-x)); }

constexpr int LDT = 72;
constexpr int TILE_E = 128 * LDT;
constexpr int SMEM_BYTES = 4 * TILE_E * 2;
constexpr int NTHREADS = 512, NWAVES = 8, LDS_TOTAL = 2 * SMEM_BYTES;

DEVI void gemm_ldg(const bf16_t* ga, const bf16_t* gb, int lda, int ldb, u32x4 (&ra)[4], u32x4 (&rb)[4]) {
#pragma unroll
    for (int i = 0; i < 4; ++i) {
        ra[i] = *(const u32x4*)(ga + (size_t)(32 * i) * lda);
        rb[i] = *(const u32x4*)(gb + (size_t)(32 * i) * ldb);
    }
}
DEVI void gemm_sts(bf16_t* buf, int soff, const u32x4 (&ra)[4], const u32x4 (&rb)[4]) {
#pragma unroll
    for (int i = 0; i < 4; ++i) {
        *(u32x4*)(buf + soff + 32 * i * LDT) = ra[i];
        *(u32x4*)(buf + TILE_E + soff + 32 * i * LDT) = rb[i];
    }
}
DEVI void gemm_mma(const bf16_t* cur, int aoff, int boff, f32x16 (&acc)[2][2]) {
#pragma unroll
    for (int ks = 0; ks < 4; ++ks) {
        bf16x8 a0 = *(const bf16x8*)(cur + aoff + ks * 16);
        bf16x8 a1 = *(const bf16x8*)(cur + aoff + 32 * LDT + ks * 16);
        bf16x8 b0 = *(const bf16x8*)(cur + boff + ks * 16);
        bf16x8 b1 = *(const bf16x8*)(cur + boff + 32 * LDT + ks * 16);
        acc[0][0] = __builtin_amdgcn_mfma_f32_32x32x16_bf16(a0, b0, acc[0][0], 0, 0, 0);
        acc[0][1] = __builtin_amdgcn_mfma_f32_32x32x16_bf16(a0, b1, acc[0][1], 0, 0, 0);
        acc[1][0] = __builtin_amdgcn_mfma_f32_32x32x16_bf16(a1, b0, acc[1][0], 0, 0, 0);
        acc[1][1] = __builtin_amdgcn_mfma_f32_32x32x16_bf16(a1, b1, acc[1][1], 0, 0, 0);
    }
}

template <bool DEEP = true>
DEVI void gemm_core(const bf16_t* __restrict__ A, int lda, const bf16_t* __restrict__ B, int ldb, int K,
                    f32x16 (&acc)[2][2], bf16_t* smem, int tid) {
    const int lane = tid & 63, wave = tid >> 6, wr = wave >> 1, wc = wave & 1;
    const int lr = tid >> 3, lc = (tid & 7) * 8;
    const bf16_t* ga = A + (size_t)lr * lda + lc;
    const bf16_t* gb = B + (size_t)lr * ldb + lc;
    const int soff = lr * LDT + lc;
    const int nk = K >> 6;
    const int aoff = (wr * 64 + (lane & 31)) * LDT + (lane >> 5) * 8;
    const int boff = TILE_E + (wc * 64 + (lane & 31)) * LDT + (lane >> 5) * 8;
    bf16_t* buf0 = smem; bf16_t* buf1 = smem + 2 * TILE_E;
    if constexpr (DEEP) {
        u32x4 ra0[4], rb0[4], ra1[4], rb1[4];
        gemm_ldg(ga, gb, lda, ldb, ra0, rb0);
        gemm_ldg(ga + 64, gb + 64, lda, ldb, ra1, rb1);
        gemm_sts(buf0, soff, ra0, rb0);
        __syncthreads();
        for (int kt = 0; kt < nk; kt += 2) {
            if (kt + 2 < nk) gemm_ldg(ga + (size_t)(kt + 2) * 64, gb + (size_t)(kt + 2) * 64, lda, ldb, ra0, rb0);
            gemm_mma(buf0, aoff, boff, acc);
            gemm_sts(buf1, soff, ra1, rb1);
            __syncthreads();
            if (kt + 3 < nk) gemm_ldg(ga + (size_t)(kt + 3) * 64, gb + (size_t)(kt + 3) * 64, lda, ldb, ra1, rb1);
            gemm_mma(buf1, aoff, boff, acc);
            if (kt + 2 < nk) gemm_sts(buf0, soff, ra0, rb0);
            __syncthreads();
        }
    } else {
        u32x4 ra[4], rb[4];
        gemm_ldg(ga, gb, lda, ldb, ra, rb);
        gemm_sts(buf0, soff, ra, rb);
        __syncthreads();
        for (int kt = 0; kt < nk; ++kt) {
            bf16_t* cur = (kt & 1) ? buf1 : buf0;
            bf16_t* nxt = (kt & 1) ? buf0 : buf1;
            const bool more = (kt + 1 < nk);
            if (more) { ga += 64; gb += 64; gemm_ldg(ga, gb, lda, ldb, ra, rb); }
            gemm_mma(cur, aoff, boff, acc);
            if (more) gemm_sts(nxt, soff, ra, rb);
            __syncthreads();
        }
    }
}

DEVI void zero_acc(f32x16 (&acc)[2][2]) {
#pragma unroll
    for (int i = 0; i < 2; ++i)
#pragma unroll
        for (int j = 0; j < 2; ++j)
#pragma unroll
            for (int r = 0; r < 16; ++r) acc[i][j][r] = 0.f;
}

#define EPI_SETUP const int lane = tid & 63, wave = tid >> 6, wr = wave >> 1, wc = wave & 1, hl = lane >> 5, c32 = lane & 31; (void)wr; (void)wc; (void)hl; (void)c32;

DEVI int mod_group(int row) { return row < NCTX ? 0 : 1 + ((row - NCTX) >> 11); }

namespace pg8 {
#define PG8_LAS __attribute__((address_space(3)))
constexpr int BM = 256, BK = 64, HALF = 128, HTB = HALF * BK * 2, NXCD = 8, WGM = 8;
DEVI int lds_byte(int r, int c) { const int st = (r >> 4) * 2 + (c >> 5), rr = r & 15, cc = c & 31, ob = rr * 64 + cc * 2; return st * 1024 + (ob ^ (((ob >> 9) & 1) << 5)); }
DEVI void stage_rc(int b, int& R, int& C) { const int st = b / 1024, sb = b % 1024, swz = sb ^ (((sb >> 9) & 1) << 5); R = (st >> 1) * 16 + swz / 64; C = (st & 1) * 32 + (swz % 64) / 2; }
DEVI int perm32(int rho) { const int n = rho >> 4, i = rho & 15; return 8 * (i >> 2) + 4 * n + (i & 3); }
struct Unit { int pm, pn; };
struct Gemm { const bf16_t* A; const bf16_t* Bt; int M, N, K; };
struct StaticOrder {
    int nM, nN, nwg, G, c;
    DEVI void init(int M, int N, int G_, int c_) { nM = M / BM; nN = N / BM; nwg = nM * nN; G = G_; c = c_; }
    DEVI bool next(int i, Unit& u) const {
        const long L = (long)i * G + c; if (L >= nwg) return false;
        int wgid = (int)L; { const int q = nwg / NXCD, r = nwg % NXCD, xcd = wgid % NXCD, off = wgid / NXCD; wgid = (xcd < r ? xcd * (q + 1) : r * (q + 1) + (xcd - r) * q) + off; }
        const int nig = WGM * nN, gid = wgid / nig, fm = gid * WGM, gsz = (nM - fm) < WGM ? (nM - fm) : WGM;
        u.pm = fm + ((wgid % nig) % gsz); u.pn = (wgid % nig) / gsz; return true;
    }
    DEVI void a_ready(const Unit&) const {}
    DEVI void done(const Unit&) const {}
};
struct InGateOrder {
    int G, c, lo, hi;
    static DEVI void so_map(int wgid, int nM, int nN, Unit& u) {
        const int nwg = nM * nN;
        { const int q = nwg / NXCD, r = nwg % NXCD, xcd = wgid % NXCD, off = wgid / NXCD; wgid = (xcd < r ? xcd * (q + 1) : r * (q + 1) + (xcd - r) * q) + off; }
        const int nig = WGM * nN, gid = wgid / nig, fm = gid * WGM, gsz = (nM - fm) < WGM ? (nM - fm) : WGM;
        u.pm = fm + ((wgid % nig) % gsz); u.pn = (wgid % nig) / gsz;
    }
    DEVI bool next(int i, Unit& u) const {
        const long L = (long)i * G + c + lo; if (L >= hi) return false;
        if (L < 528) so_map((int)L, 48, 11, u); else { so_map((int)L - 528, 48, 12, u); u.pn += 11; }
        return true;
    }
    DEVI void a_ready(const Unit&) const {}
    DEVI void done(const Unit&) const {}
};
template <class Epi, class Sched, bool ALIGN_EPI = false, bool SP2 = false>
DEVI void gemm_phase(PG8_LAS unsigned char* lds, const Gemm g, const Sched& S, const Epi& E, const int tid) {
    const int wid = __builtin_amdgcn_readfirstlane(tid >> 6), lane = tid & 63, wr = wid >> 2, wc = wid & 3, fr = lane & 15, fq = lane >> 4;
    const int K = g.K, nt = K / BK;
    unsigned voffA[2], voffB[2];
#pragma unroll
    for (int i = 0; i < 2; ++i) { int R, C; stage_rc(tid * 16 + i * 8192, R, C); const int Rb = Epi::PERM ? ((R & ~31) + perm32(R & 31)) : R;
        voffA[i] = (unsigned)(R * K + C) * 2u; voffB[i] = (unsigned)(Rb * K + C) * 2u; }
    const size_t kstep = (size_t)(BK * 2);
    const size_t hstep = (size_t)HALF * K * 2;
    const size_t tstep = 2 * hstep;
    const unsigned ldsw = (unsigned)wid * 1024u;
    const int aoff = lds_byte(wr * 64 + fr, fq * 8), boff = lds_byte(wc * 32 + fr, fq * 8);
#define PG8_SA(b, h) (((b) * 2 + (h)) * HTB)
#define PG8_SB(b, h) ((4 + (b) * 2 + (h)) * HTB)
#define PG8_STAGE(bufoff, gbase, voff) do { _Pragma("unroll") for (int _i = 0; _i < 2; ++_i) \
        __builtin_amdgcn_global_load_lds((const unsigned*)((const char*)(gbase) + (voff)[_i]), (PG8_LAS unsigned*)(lds + (bufoff) + ldsw + _i * 8192), 16, 0, 0); } while (0)
#define PG8_LDA(dst, b, h) do { _Pragma("unroll") for (int m = 0; m < 4; ++m) _Pragma("unroll") for (int k = 0; k < 2; ++k) dst[m][k] = *(const PG8_LAS bf16x8*)(lds + PG8_SA(b, h) + aoff + m * 2048 + k * 1024); } while (0)
#define PG8_LDB(dst, b, h) do { _Pragma("unroll") for (int n = 0; n < 2; ++n) _Pragma("unroll") for (int k = 0; k < 2; ++k) dst[n][k] = *(const PG8_LAS bf16x8*)(lds + PG8_SB(b, h) + boff + n * 2048 + k * 1024); } while (0)
#define PG8_MMA(ai, bj, At, Bt) do { __builtin_amdgcn_s_setprio(1); _Pragma("unroll") for (int m = 0; m < 4; ++m) _Pragma("unroll") for (int n = 0; n < 2; ++n) _Pragma("unroll") for (int k = 0; k < 2; ++k) \
        acc[ai][bj][m][n] = __builtin_amdgcn_mfma_f32_16x16x32_bf16(Bt[n][k], At[m][k], acc[ai][bj][m][n], 0, 0, 0); __builtin_amdgcn_s_setprio(0); } while (0)
#define PG8_WAIT_V(n) asm volatile("s_waitcnt vmcnt(" #n ")" ::: "memory")
#define PG8_WAIT_L(n) asm volatile("s_waitcnt lgkmcnt(" #n ")" ::: "memory")
#define PG8_BAR __builtin_amdgcn_s_barrier()
#define PG8_SCHED __builtin_amdgcn_sched_barrier(0)
    Unit cur, nxt; int ui = 0;
    if (!S.next(0, cur)) return;
    f32x4 acc[2][2][4][2];
#pragma unroll
    for (int a = 0; a < 2; ++a)
#pragma unroll
        for (int b = 0; b < 2; ++b)
#pragma unroll
            for (int m = 0; m < 4; ++m)
#pragma unroll
                for (int n = 0; n < 2; ++n) acc[a][b][m][n] = (f32x4){0.f, 0.f, 0.f, 0.f};
    bf16x8 At[4][2], B0[2][2], B1[2][2];
    const char* cA = (const char*)g.A + (size_t)cur.pm * tstep; const char* cB = (const char*)g.Bt + (size_t)cur.pn * tstep;
    S.a_ready(cur);
    if constexpr (SP2) {
        PG8_STAGE(PG8_SB(0, 0), cB, voffB); PG8_STAGE(PG8_SB(0, 1), cB + hstep, voffB); PG8_STAGE(PG8_SA(0, 0), cA, voffA); PG8_STAGE(PG8_SA(0, 1), cA + hstep, voffA);
        if (wr == 1) PG8_BAR;
        PG8_WAIT_V(2); PG8_BAR;
        PG8_STAGE(PG8_SB(1, 0), cB + kstep, voffB); PG8_STAGE(PG8_SA(1, 0), cA + kstep, voffA); PG8_STAGE(PG8_SB(1, 1), cB + hstep + kstep, voffB);
        PG8_WAIT_V(6); PG8_BAR;
    } else {
        PG8_STAGE(PG8_SB(0, 0), cB, voffB); PG8_STAGE(PG8_SA(0, 0), cA, voffA); PG8_STAGE(PG8_SB(0, 1), cB + hstep, voffB); PG8_STAGE(PG8_SA(0, 1), cA + hstep, voffA);
        if (wr == 1) PG8_BAR;
        PG8_WAIT_V(4); PG8_BAR;
        PG8_STAGE(PG8_SB(1, 0), cB + kstep, voffB); PG8_STAGE(PG8_SA(1, 0), cA + kstep, voffA); PG8_STAGE(PG8_SB(1, 1), cB + hstep + kstep, voffB);
        PG8_WAIT_V(6); PG8_BAR;
    }
    for (;;) {
        const bool has_next = S.next(ui + 1, nxt);
        const char* nA = has_next ? (const char*)g.A + (size_t)nxt.pm * tstep : cA; const char* nB = has_next ? (const char*)g.Bt + (size_t)nxt.pn * tstep : cB;
        for (int t = 0; t < nt; t += 2) {
            const bool last = (t == nt - 2);
            const char* a1 = cA + (size_t)(t + 1) * kstep;
            const char* a2 = last ? nA : cA + (size_t)(t + 2) * kstep; const char* b2 = last ? nB : cB + (size_t)(t + 2) * kstep;
            const char* a3 = a2 + kstep; const char* b3 = b2 + kstep;
            if (last && has_next) S.a_ready(nxt);
            if constexpr (SP2) {
            PG8_LDB(B0, 0, 0); PG8_LDB(B1, 0, 1); PG8_SCHED; PG8_LDA(At, 0, 0); PG8_STAGE(PG8_SA(1, 1), a1 + hstep, voffA);
            PG8_WAIT_V(8); PG8_WAIT_L(0); PG8_BAR; PG8_MMA(0, 0, At, B0); PG8_MMA(0, 1, At, B1); PG8_BAR; PG8_SCHED;
            PG8_LDA(At, 0, 1); PG8_STAGE(PG8_SB(0, 0), b2, voffB); PG8_STAGE(PG8_SB(0, 1), b2 + hstep, voffB); PG8_STAGE(PG8_SA(0, 0), a2, voffA);
            PG8_WAIT_V(8); PG8_WAIT_L(0); PG8_BAR; PG8_MMA(1, 0, At, B0); PG8_MMA(1, 1, At, B1); PG8_BAR; PG8_SCHED;
            PG8_LDB(B0, 1, 0); PG8_LDB(B1, 1, 1); PG8_SCHED; PG8_LDA(At, 1, 0); PG8_STAGE(PG8_SA(0, 1), a2 + hstep, voffA);
            PG8_WAIT_V(8); PG8_WAIT_L(0); PG8_BAR; PG8_MMA(0, 0, At, B0); PG8_MMA(0, 1, At, B1); PG8_BAR; PG8_SCHED;
            PG8_LDA(At, 1, 1); PG8_STAGE(PG8_SB(1, 0), b3, voffB); PG8_STAGE(PG8_SB(1, 1), b3 + hstep, voffB); PG8_STAGE(PG8_SA(1, 0), a3, voffA);
            PG8_WAIT_V(8); PG8_WAIT_L(0); PG8_BAR; PG8_MMA(1, 0, At, B0); PG8_MMA(1, 1, At, B1); PG8_BAR; PG8_SCHED;
            } else {
            PG8_LDB(B0, 0, 0); PG8_SCHED; PG8_LDA(At, 0, 0); PG8_STAGE(PG8_SA(1, 1), a1 + hstep, voffA);
            PG8_WAIT_L(8); PG8_BAR; PG8_WAIT_L(0); PG8_MMA(0, 0, At, B0); PG8_BAR; PG8_SCHED;
            PG8_LDB(B1, 0, 1); PG8_STAGE(PG8_SB(0, 0), b2, voffB);
            PG8_BAR; PG8_WAIT_L(0); PG8_MMA(0, 1, At, B1); PG8_BAR;
            PG8_LDA(At, 0, 1); PG8_STAGE(PG8_SA(0, 0), a2, voffA);
            PG8_BAR; PG8_WAIT_L(0); PG8_MMA(1, 0, At, B0); PG8_BAR; PG8_SCHED;
            PG8_STAGE(PG8_SB(0, 1), b2 + hstep, voffB);
            PG8_WAIT_V(6); PG8_BAR; PG8_MMA(1, 1, At, B1); PG8_BAR;
            PG8_LDB(B0, 1, 0); PG8_SCHED; PG8_LDA(At, 1, 0); PG8_STAGE(PG8_SA(0, 1), a2 + hstep, voffA);
            PG8_WAIT_L(8); PG8_BAR; PG8_WAIT_L(0); PG8_MMA(0, 0, At, B0); PG8_BAR; PG8_SCHED;
            PG8_LDB(B1, 1, 1); PG8_STAGE(PG8_SB(1, 0), b3, voffB);
            PG8_BAR; PG8_WAIT_L(0); PG8_MMA(0, 1, At, B1); PG8_BAR;
            PG8_LDA(At, 1, 1); PG8_STAGE(PG8_SA(1, 0), a3, voffA);
            PG8_BAR; PG8_WAIT_L(0); PG8_MMA(1, 0, At, B0); PG8_BAR; PG8_SCHED;
            PG8_STAGE(PG8_SB(1, 1), b3 + hstep, voffB);
            PG8_WAIT_V(6); PG8_BAR; PG8_MMA(1, 1, At, B1); PG8_BAR;
            }
        }
        if constexpr (ALIGN_EPI) { if (wr == 0) PG8_BAR; }
        E(acc, cur, wr, wc, fr, fq); S.done(cur);
        if (!has_next) break;
#pragma unroll
        for (int a = 0; a < 2; ++a)
#pragma unroll
            for (int b = 0; b < 2; ++b)
#pragma unroll
                for (int m = 0; m < 4; ++m)
#pragma unroll
                    for (int n = 0; n < 2; ++n) acc[a][b][m][n] = (f32x4){0.f, 0.f, 0.f, 0.f};
        cur = nxt; cA = nA; cB = nB; ++ui;
        if constexpr (ALIGN_EPI) { if (wr == 1) PG8_BAR; }
    }
    PG8_WAIT_V(0);
    if constexpr (!ALIGN_EPI) { if (wr == 0) PG8_BAR; }
    PG8_BAR;
#undef PG8_SA
#undef PG8_SB
#undef PG8_STAGE
#undef PG8_LDA
#undef PG8_LDB
#undef PG8_MMA
#undef PG8_WAIT_V
#undef PG8_WAIT_L
#undef PG8_BAR
#undef PG8_SCHED
}

struct EpiSwiGLU {
    static constexpr bool PERM = true;
    bf16_t* ACT;
    DEVI void operator()(const f32x4 (&acc)[2][2][4][2], const Unit& u, int wr, int wc, int fr, int fq) const {
#pragma unroll
        for (int ai = 0; ai < 2; ++ai)
#pragma unroll
            for (int m = 0; m < 4; ++m) {
                const int row = u.pm * BM + ai * HALF + wr * 64 + m * 16 + fr;
                u32x4 pk;
#pragma unroll
                for (int n = 0; n < 2; ++n) {
                    const f32x4 a = acc[ai][0][m][n], b = acc[ai][1][m][n];
                    const unsigned lo = pk2(a[0] * sigmoidf_(a[0]) * b[0], a[1] * sigmoidf_(a[1]) * b[1]);
                    const unsigned hi = pk2(a[2] * sigmoidf_(a[2]) * b[2], a[3] * sigmoidf_(a[3]) * b[3]);
                    if (n == 0) { pk.x = lo; pk.y = hi; } else { pk.z = lo; pk.w = hi; }
                }
                *(u32x4*)(ACT + (size_t)row * DFF + u.pn * 128 + wc * 32 + 8 * fq) = pk;
            }
    }
};
struct EpiResid {
    static constexpr bool PERM = false;
    float* X; const float* gate_base; float coef;
    DEVI void operator()(const f32x4 (&acc)[2][2][4][2], const Unit& u, int wr, int wc, int fr_, int fq_) const {
        int fr = fr_, fq = fq_; asm volatile("" : "+v"(fr), "+v"(fq));
        const float* gate = gate_base + (size_t)mod_group(u.pm * BM) * 9216;
        const int col0 = u.pn * BM + wc * 32 + 4 * fq;
        f32x4 gv[2][2];
#pragma unroll
        for (int bj = 0; bj < 2; ++bj)
#pragma unroll
            for (int n = 0; n < 2; ++n) gv[bj][n] = *(const f32x4*)(gate + col0 + bj * HALF + 16 * n) * coef;
#pragma unroll
        for (int ah = 0; ah < 4; ++ah) {
            const int ai = ah >> 1, mb = (ah & 1) * 2;
            f32x4 xv[4][2][2];
#pragma unroll
            for (int m = mb; m < mb + 2; ++m)
#pragma unroll
                for (int bj = 0; bj < 2; ++bj)
#pragma unroll
                    for (int n = 0; n < 2; ++n)
                        xv[m][bj][n] = *(const f32x4*)(X + (size_t)(u.pm * BM + ai * HALF + wr * 64 + m * 16 + fr) * D + col0 + bj * HALF + 16 * n);
            __builtin_amdgcn_sched_barrier(0);
#pragma unroll
            for (int m = mb; m < mb + 2; ++m)
#pragma unroll
                for (int bj = 0; bj < 2; ++bj)
#pragma unroll
                    for (int n = 0; n < 2; ++n)
                        *(f32x4*)(X + (size_t)(u.pm * BM + ai * HALF + wr * 64 + m * 16 + fr) * D + col0 + bj * HALF + 16 * n) =
                            xv[m][bj][n] * ALPHA_F + gv[bj][n] * acc[ai][bj][m][n];
            __builtin_amdgcn_sched_barrier(0);
        }
    }
};
struct EpiIn {
    static constexpr bool PERM = true;
    unsigned char* ws; float* out; const float* b_gate; int l;
    static DEVI u32x4 pack8(const f32x4& a, const f32x4& b, float s) {
        u32x4 w; w.x = pk2(a[0] * s, a[1] * s); w.y = pk2(a[2] * s, a[3] * s); w.z = pk2(b[0] * s, b[1] * s); w.w = pk2(b[2] * s, b[3] * s); return w;
    }
    DEVI void operator()(const f32x4 (&acc)[2][2][4][2], const Unit& u, int wr, int wc, int fr_, int fq_) const {
        int fr = fr_, fq = fq_; asm volatile("" : "+v"(fr), "+v"(fq));
        unsigned char* ws = this->ws; float* out = this->out; const float* b_gate = this->b_gate;
        asm volatile("" : "+s"(ws), "+s"(out), "+s"(b_gate));
        const bool ctx = u.pm * BM < NCTX;
#pragma unroll
        for (int bj = 0; bj < 2; ++bj) {
            const int n0 = u.pn * BM + bj * HALF;
            const int c8 = n0 + wc * 32 + 8 * fq;
            f32x4 bg0 = (f32x4){0.f, 0.f, 0.f, 0.f}, bg1 = bg0;
            if (n0 >= 2816) { bg0 = *(const f32x4*)(b_gate + l * 3072 + c8 - 2816); bg1 = *(const f32x4*)(b_gate + l * 3072 + c8 - 2816 + 4); }
#pragma unroll
            for (int ai = 0; ai < 2; ++ai)
#pragma unroll
                for (int m = 0; m < 4; ++m) {
                    const int row = u.pm * BM + ai * HALF + wr * 64 + m * 16 + fr;
                    const f32x4 v0 = acc[ai][bj][m][0], v1 = acc[ai][bj][m][1];
                    if (n0 < 512) {
                        *(u32x4*)((bf16_t*)(ws + WS_UF) + (size_t)row * 512 + c8) = pack8(v0, v1, 1.f);
                    } else if (n0 < 896) {
                        *(u32x4*)((bf16_t*)(ws + WS_UQ) + (size_t)row * 384 + (c8 - 512)) = pack8(v0, v1, 1.f);
                    } else if (n0 < 1152) {
                        float* o = (float*)(ws + WS_UKV) + (size_t)row * 256 + (c8 - 896);
                        *(f32x4*)o = v0; *(f32x4*)(o + 4) = v1;
                    } else if (n0 < 1280) {
                        if (wc == 0) { float* o = (float*)(ws + WS_KRF) + (size_t)row * 32 + 8 * fq; *(f32x4*)o = v0; *(f32x4*)(o + 4) = v1; }
                    } else if (n0 < 1792) {
                        *(u32x4*)((bf16_t*)(ws + WS_NAQ) + (size_t)row * 512 + (c8 - 1280)) = pack8(v0, v1, NA_QS);
                    } else if (n0 < 2304) {
                        const int cc = c8 - 1792;
                        *(u32x4*)((bf16_t*)(ws + WS_NAK) + (size_t)row * 512 + cc) = pack8(v0, v1, 1.f);
                        if (ctx) { float* o = out + OUT_NAK + ((size_t)((row >> 8) * 4 + l) * 256 + (row & 255)) * 512 + cc; *(f32x4*)o = v0; *(f32x4*)(o + 4) = v1; }
                    } else if (n0 < 2816) {
                        const int cc = c8 - 2304, h = cc >> 6, d0 = cc & 63;
                        bf16_t* VT = (bf16_t*)(ws + WS_NAVT);
                        bf16_t* vp;
                        size_t cstride;
                        if (ctx) {
                            const int b = row >> 8, s = row & 255;
                            float* o = out + OUT_NAV + ((size_t)(b * 4 + l) * 256 + s) * 512 + cc; *(f32x4*)o = v0; *(f32x4*)(o + 4) = v1;
                            vp = VT + ((size_t)((b * 8 + h) * 64 + d0)) * 256 + s; cstride = 256;
                        } else {
                            const int rr = row - NCTX, b = rr >> 11, n = rr & 2047;
                            vp = VT + (size_t)4194304 + ((size_t)((b * 8 + h) * 64 + d0)) * 2048 + n; cstride = 2048;
                        }
#pragma unroll
                        for (int e = 0; e < 4; ++e) { vp[(size_t)e * cstride] = f2bf(v0[e]); vp[(size_t)(4 + e) * cstride] = f2bf(v1[e]); }
                    } else {
                        f32x4 g0, g1;
#pragma unroll
                        for (int e = 0; e < 4; ++e) { g0[e] = sigmoidf_(v0[e] + bg0[e]); g1[e] = sigmoidf_(v1[e] + bg1[e]); }
                        *(u32x4*)((bf16_t*)(ws + WS_GATE) + (size_t)row * 3072 + (c8 - 2816)) = pack8(g0, g1, 1.f);
                    }
                    __builtin_amdgcn_sched_barrier(0);
                }
        }
    }
};
struct EpiMerge {
    static constexpr bool PERM = true;
    const bf16_t* GATE; bf16_t* T; bf16_t* MG; int s;
    DEVI void operator()(const f32x4 (&acc)[2][2][4][2], const Unit& u, int wr, int wc, int fr_, int fq_) const {
        int fr = fr_, fq = fq_; asm volatile("" : "+v"(fr), "+v"(fq));
#pragma unroll
        for (int ah = 0; ah < 4; ++ah) {
            const int ai = ah >> 1, mb = (ah & 1) * 2;
            u32x4 gv[4][2], tv[4][2];
#pragma unroll
            for (int m = mb; m < mb + 2; ++m)
#pragma unroll
                for (int bj = 0; bj < 2; ++bj) {
                    const int row = u.pm * BM + ai * HALF + wr * 64 + m * 16 + fr;
                    const int c8 = u.pn * BM + bj * HALF + wc * 32 + 8 * fq;
                    gv[m][bj] = *(const u32x4*)(GATE + (size_t)row * 3072 + s * 1024 + c8);
                    if (s > 0) tv[m][bj] = *(const u32x4*)(T + (size_t)row * D + c8);
                }
            __builtin_amdgcn_sched_barrier(0);
#pragma unroll
            for (int m = mb; m < mb + 2; ++m)
#pragma unroll
                for (int bj = 0; bj < 2; ++bj) {
                    const int row = u.pm * BM + ai * HALF + wr * 64 + m * 16 + fr;
                    const int c8 = u.pn * BM + bj * HALF + wc * 32 + 8 * fq;
                    const u32x4 g = gv[m][bj];
                    f32x4 v0 = acc[ai][bj][m][0], v1 = acc[ai][bj][m][1];
                    v0[0] *= bf2f(g.x & 0xffffu); v0[1] *= bf2f(g.x >> 16); v0[2] *= bf2f(g.y & 0xffffu); v0[3] *= bf2f(g.y >> 16);
                    v1[0] *= bf2f(g.z & 0xffffu); v1[1] *= bf2f(g.z >> 16); v1[2] *= bf2f(g.w & 0xffffu); v1[3] *= bf2f(g.w >> 16);
                    if (s > 0) {
                        const u32x4 t = tv[m][bj];
                        v0[0] += bf2f(t.x & 0xffffu); v0[1] += bf2f(t.x >> 16); v0[2] += bf2f(t.y & 0xffffu); v0[3] += bf2f(t.y >> 16);
                        v1[0] += bf2f(t.z & 0xffffu); v1[1] += bf2f(t.z >> 16); v1[2] += bf2f(t.w & 0xffffu); v1[3] += bf2f(t.w >> 16);
                    }
                    *(u32x4*)((s < 2 ? T : MG) + (size_t)row * D + c8) = EpiIn::pack8(v0, v1, 1.f);
                }
            __builtin_amdgcn_sched_barrier(0);
        }
    }
};
}

DEVI void job_ffn_up(const P& p, unsigned char* ws_b, int l, int which, int t, bf16_t* sm, int tid) {
    const int nN = 44; const int m0 = (t / nN) * 128, n0 = (t % nN) * 128;
    const bf16_t* H = (const bf16_t*)(ws_b + WS_H);
    const bf16_t* W = (const bf16_t*)(ws_b + WS_W) + (size_t)l * LAYER_W + (which ? OFF_W13_2 : OFF_W13_1);
    bf16_t* ACT = (bf16_t*)(ws_b + WS_ACT);
    f32x16 acc[2][2]; zero_acc(acc);
    gemm_core(H + (size_t)m0 * D, D, W + (size_t)n0 * D, D, D, acc, sm, tid);
    EPI_SETUP
    const int oc = (n0 >> 1) + wc * 32 + c32;
#pragma unroll
    for (int i = 0; i < 2; ++i) {
        const int rb = m0 + wr * 64 + i * 32 + 4 * hl;
#pragma unroll
        for (int r = 0; r < 16; ++r) {
            const int row = rb + (r & 3) + 8 * (r >> 2);
            const float a = acc[i][0][r], b = acc[i][1][r];
            const float v = a * sigmoidf_(a) * b;
            ACT[(size_t)row * DFF + oc] = f2bf(v);
        }
    }
}

DEVI void job_resid(const P& p, unsigned char* ws_b, const bf16_t* A, int lda, const bf16_t* Bt, int K, const float* gate_base, float coef, int t, bf16_t* sm, int tid) {
    const int nN = 8; const int m0 = (t / nN) * 128, n0 = (t % nN) * 128;
    float* X = (float*)(ws_b + WS_X);
    f32x16 acc[2][2]; zero_acc(acc);
    gemm_core(A + (size_t)m0 * lda, lda, Bt + (size_t)n0 * K, K, K, acc, sm, tid);
    EPI_SETUP
    const float* gate = gate_base + (size_t)mod_group(m0) * 9216;
#pragma unroll
    for (int j = 0; j < 2; ++j) {
        const int col = n0 + wc * 64 + j * 32 + c32;
        const float gv = coef * gate[col];
#pragma unroll
        for (int i = 0; i < 2; ++i) {
            const int rb = m0 + wr * 64 + i * 32 + 4 * hl;
#pragma unroll
            for (int r = 0; r < 16; ++r) {
                const int row = rb + (r & 3) + 8 * (r >> 2);
                float* xp = X + (size_t)row * D + col;
                *xp = ALPHA_F * (*xp) + gv * acc[i][j][r];
            }
        }
    }
}

DEVI void job_in(const P& p, unsigned char* ws_b, int l, int t, bf16_t* sm, int tid) {
    const int nN = 46; const int m0 = (t / nN) * 128, n0 = (t % nN) * 128;
    const bf16_t* H = (const bf16_t*)(ws_b + WS_H);
    const bf16_t* W = (const bf16_t*)(ws_b + WS_W) + (size_t)l * LAYER_W + OFF_WIN;
    f32x16 acc[2][2]; zero_acc(acc);
    gemm_core(H + (size_t)m0 * D, D, W + (size_t)n0 * D, D, D, acc, sm, tid);
    EPI_SETUP
    const bool ctx = m0 < NCTX;
#pragma unroll
    for (int j = 0; j < 2; ++j) {
        const int col = n0 + wc * 64 + j * 32 + c32;
#pragma unroll
        for (int i = 0; i < 2; ++i) {
            const int rb = m0 + wr * 64 + i * 32 + 4 * hl;
            if (n0 < 512) {
                bf16_t* O = (bf16_t*)(ws_b + WS_UF);
#pragma unroll
                for (int r = 0; r < 16; ++r) O[(size_t)(rb + (r & 3) + 8 * (r >> 2)) * 512 + col] = f2bf(acc[i][j][r]);
            } else if (n0 < 896) {
                bf16_t* O = (bf16_t*)(ws_b + WS_UQ);
#pragma unroll
                for (int r = 0; r < 16; ++r) O[(size_t)(rb + (r & 3) + 8 * (r >> 2)) * 384 + (col - 512)] = f2bf(acc[i][j][r]);
            } else if (n0 < 1152) {
                float* O = (float*)(ws_b + WS_UKV);
#pragma unroll
                for (int r = 0; r < 16; ++r) O[(size_t)(rb + (r & 3) + 8 * (r >> 2)) * 256 + (col - 896)] = acc[i][j][r];
            } else if (n0 < 1280) {
                if (col < 1184) {
                    float* O = (float*)(ws_b + WS_KRF);
#pragma unroll
                    for (int r = 0; r < 16; ++r) O[(size_t)(rb + (r & 3) + 8 * (r >> 2)) * 32 + (col - 1152)] = acc[i][j][r];
                }
            } else if (n0 < 1792) {
                bf16_t* O = (bf16_t*)(ws_b + WS_NAQ);
#pragma unroll
                for (int r = 0; r < 16; ++r) O[(size_t)(rb + (r & 3) + 8 * (r >> 2)) * 512 + (col - 1280)] = f2bf(acc[i][j][r] * NA_QS);
            } else if (n0 < 2304) {
                bf16_t* O = (bf16_t*)(ws_b + WS_NAK);
                const int cc = col - 1792;
#pragma unroll
                for (int r = 0; r < 16; ++r) {
                    const int row = rb + (r & 3) + 8 * (r >> 2);
                    O[(size_t)row * 512 + cc] = f2bf(acc[i][j][r]);
                    if (ctx) p.out[OUT_NAK + ((size_t)((row >> 8) * 4 + l) * 256 + (row & 255)) * 512 + cc] = acc[i][j][r];
                }
            } else if (n0 < 2816) {
                bf16_t* VT = (bf16_t*)(ws_b + WS_NAVT);
                const int cc = col - 2304, h = cc >> 6, d = cc & 63;
#pragma unroll
                for (int qd = 0; qd < 4; ++qd) {
                    const int row = rb + 8 * qd;
                    u32x2 pk; pk.x = pk2(acc[i][j][4 * qd], acc[i][j][4 * qd + 1]); pk.y = pk2(acc[i][j][4 * qd + 2], acc[i][j][4 * qd + 3]);
                    if (ctx) {
                        const int b = row >> 8, s = row & 255;
                        *(u32x2*)(VT + ((size_t)((b * 8 + h) * 64 + d)) * 256 + s) = pk;
#pragma unroll
                        for (int e = 0; e < 4; ++e)
                            p.out[OUT_NAV + ((size_t)(b * 4 + l) * 256 + (s + e)) * 512 + cc] = acc[i][j][4 * qd + e];
                    } else {
                        const int rr = row - NCTX, b = rr >> 11, n = rr & 2047;
                        *(u32x2*)(VT + (size_t)4194304 + ((size_t)((b * 8 + h) * 64 + d)) * 2048 + n) = pk;
                    }
                }
            } else {
                bf16_t* O = (bf16_t*)(ws_b + WS_GATE);
                const int gc = col - 2816;
                const float bg = pin(p, 26)[l * 3072 + gc];
                bf16_t* gp = O + (size_t)gc * M + rb;
#pragma unroll
                for (int qd = 0; qd < 4; ++qd) {
                    u32x2 pk;
                    pk.x = pk2(sigmoidf_(acc[i][j][4 * qd] + bg), sigmoidf_(acc[i][j][4 * qd + 1] + bg));
                    pk.y = pk2(sigmoidf_(acc[i][j][4 * qd + 2] + bg), sigmoidf_(acc[i][j][4 * qd + 3] + bg));
                    *(u32x2*)(gp + 8 * qd) = pk;
                }
            }
        }
    }
}

DEVI void job_uq(const P& p, unsigned char* ws_b, int l, int t, bf16_t* sm, int tid) {
    const int nN = 6; const int m0 = (t / nN) * 128, n0 = (t % nN) * 128;
    const bf16_t* A = (const bf16_t*)(ws_b + WS_UQ);
    const bf16_t* W = (const bf16_t*)(ws_b + WS_W) + (size_t)l * LAYER_W + OFF_WUQ;
    bf16_t* Q = (bf16_t*)(ws_b + WS_Q);
    const float* ropec = (const float*)(ws_b + WS_ROPE);
    const float* ropes = ropec + 512;
    f32x16 acc[2][2]; zero_acc(acc);
    gemm_core(A + (size_t)m0 * 384, 384, W + (size_t)n0 * 384, 384, 384, acc, sm, tid);
    EPI_SETUP
    const bool lat = m0 >= NCTX;
#pragma unroll
    for (int j = 0; j < 2; ++j) {
        const int c0 = n0 + wc * 64 + j * 32;
        const int col = c0 + c32;
        const bool rope = lat && (((c0 >> 5) % 3) == 2);
        const int axis = c32 >> 4, ii = c32 & 15;
#pragma unroll
        for (int i = 0; i < 2; ++i) {
            const int rb = m0 + wr * 64 + i * 32 + 4 * hl;
#pragma unroll
            for (int r = 0; r < 16; ++r) {
                const int row = rb + (r & 3) + 8 * (r >> 2);
                float v = acc[i][j][r];
                const float pr = __shfl_xor(v, 8);
                if (rope) {
                    const int n = (row - NCTX) & 2047;
                    const int pos = axis ? (n & 63) : (n >> 6);
                    const float cs = ropec[pos * 8 + (ii & 7)], sn = ropes[pos * 8 + (ii & 7)];
                    const float rot = (ii < 8) ? -pr : pr;
                    v = v * cs + rot * sn;
                }
                Q[(size_t)row * 768 + col] = f2bf(v * MLA_QS);
            }
        }
    }
}

DEVI void job_ukv(const P& p, unsigned char* ws_b, int l, int t, bf16_t* sm, int tid) {
    const int nN = 8; const int m0 = (t / nN) * 128, h = t % nN, n0 = h * 128;
    const bf16_t* A = (m0 < M) ? (const bf16_t*)(ws_b + WS_CKV) + (size_t)m0 * 256
                               : (const bf16_t*)(ws_b + WS_CCKV) + ((size_t)l * 1024 + (m0 - M)) * 256;
    const bf16_t* W = (const bf16_t*)(ws_b + WS_W) + (size_t)l * LAYER_W + OFF_WUKV;
    bf16_t* KN = (bf16_t*)(ws_b + WS_KN);
    bf16_t* VT = (bf16_t*)(ws_b + WS_VTM);
    f32x16 acc[2][2]; zero_acc(acc);
    gemm_core(A, 256, W + (size_t)n0 * 256, 256, 256, acc, sm, tid);
    EPI_SETUP
#pragma unroll
    for (int j = 0; j < 2; ++j) {
        const int d = j * 32 + c32;
#pragma unroll
        for (int i = 0; i < 2; ++i) {
            const int rb = m0 + wr * 64 + i * 32 + 4 * hl;
            if (wc == 0) {
#pragma unroll
                for (int r = 0; r < 16; ++r) KN[(size_t)(rb + (r & 3) + 8 * (r >> 2)) * 512 + h * 64 + d] = f2bf(acc[i][j][r]);
            } else {
#pragma unroll
                for (int qd = 0; qd < 4; ++qd) {
                    const int row = rb + 8 * qd;
                    u32x2 pk; pk.x = pk2(acc[i][j][4 * qd], acc[i][j][4 * qd + 1]); pk.y = pk2(acc[i][j][4 * qd + 2], acc[i][j][4 * qd + 3]);
                    size_t addr;
                    if (m0 < NCTX) { const int b = row >> 8, s = row & 255; addr = ((size_t)((b * 8 + h) * 64 + d)) * 256 + s; }
                    else if (m0 < M) { const int rr = row - NCTX, b = rr >> 11, n = rr & 2047; addr = (size_t)4194304 + ((size_t)((b * 8 + h) * 64 + d)) * 2560 + n; }
                    else { const int rr = row - M, b = rr >> 9, n = rr & 511; addr = (size_t)4194304 + ((size_t)((b * 8 + h) * 64 + d)) * 2560 + 2048 + n; }
                    *(u32x2*)(VT + addr) = pk;
                }
            }
        }
    }
}

template <int ldo, bool SPLITK = false>
DEVI void job_store(const bf16_t* A, int lda, const bf16_t* Bt, int ldb, int K, bf16_t* Out, bf16_t* sm, int tid, int grp = 0, float* xch = nullptr) {
    f32x16 acc[2][2]; zero_acc(acc);
    if constexpr (SPLITK) { K >>= 1; A += grp * K; Bt += grp * K; }
    gemm_core(A, lda, Bt, ldb, K, acc, sm, tid);
    EPI_SETUP
    if constexpr (SPLITK) {
        if (grp == 1) {
#pragma unroll
            for (int i = 0; i < 2; ++i)
#pragma unroll
                for (int j = 0; j < 2; ++j)
#pragma unroll
                    for (int r = 0; r < 16; ++r) xch[((i * 2 + j) * 16 + r) * 256 + tid] = acc[i][j][r];
        }
        __syncthreads();
        if (grp == 0) {
#pragma unroll
            for (int i = 0; i < 2; ++i)
#pragma unroll
                for (int j = 0; j < 2; ++j)
#pragma unroll
                    for (int r = 0; r < 16; ++r) acc[i][j][r] += xch[((i * 2 + j) * 16 + r) * 256 + tid];
        }
        __syncthreads();
    }
    const bool active = !SPLITK || grp == 0;
    bf16_t* st = sm + (wr * 64 + 4 * hl) * 136 + wc * 64 + c32;
    if (active) {
#pragma unroll
        for (int i = 0; i < 2; ++i)
#pragma unroll
            for (int j = 0; j < 2; ++j)
#pragma unroll
                for (int r = 0; r < 16; ++r) st[(i * 32 + (r & 3) + 8 * (r >> 2)) * 136 + j * 32] = f2bf(acc[i][j][r]);
    }
    __syncthreads();
    if (active) {
        const int orow = tid >> 4, oc = (tid & 15) * 8;
#pragma unroll
        for (int k = 0; k < 8; ++k) {
            const u32x4 v = *(const u32x4*)(sm + (orow + 16 * k) * 136 + oc);
            *(u32x4*)(Out + (size_t)(orow + 16 * k) * ldo + oc) = v;
        }
    }
    __syncthreads();
}

DEVI void job_f1(const P& p, unsigned char* ws_b, int t, bf16_t* sm, int tid) {
    const bf16_t* WCS = (const bf16_t*)(ws_b + WS_WCS);
    const bf16_t* UF = (const bf16_t*)(ws_b + WS_UF);
    bf16_t* F1T = (bf16_t*)(ws_b + WS_F1T);
    if (t < 512) {
        const int bs = t >> 4, g = (t >> 2) & 3, mi = (t >> 1) & 1, ni = t & 1;
        job_store<256>(WCS + mi * 128 * 128, 128, UF + ((size_t)bs * 256 + ni * 128) * 512 + g * 128, 512, 128,
                  F1T + ((size_t)(bs * 4 + g) * 256 + mi * 128) * 256 + ni * 128, sm, tid);
    } else {
        t -= 512;
        const int bs = t >> 7, g = (t >> 5) & 3, mi = (t >> 4) & 1, ni = t & 15;
        job_store<2048>(WCS + mi * 128 * 128, 128, UF + ((size_t)NCTX + bs * 2048 + ni * 128) * 512 + g * 128, 512, 128,
                  F1T + (size_t)8388608 + ((size_t)(bs * 4 + g) * 256 + mi * 128) * 2048 + ni * 128, sm, tid);
    }
}
DEVI void job_f2_lat(const P& p, unsigned char* ws_b, int t, bf16_t* sm, int tid, int grp, float* xch) {
    const int bs = t >> 6, mi = (t >> 2) & 15, ni = t & 3;
    const bf16_t* TAB = (const bf16_t*)(ws_b + WS_TABL);
    const bf16_t* F1T = (const bf16_t*)(ws_b + WS_F1T) + (size_t)8388608;
    bf16_t* YF = (bf16_t*)(ws_b + WS_YF);
    job_store<512, true>(TAB + (size_t)mi * 128 * 4096, 4096, F1T + (size_t)bs * 512 * 4096 + (size_t)ni * 128 * 4096, 4096, 4096,
              YF + ((size_t)NCTX + bs * 2048 + mi * 128) * 512 + ni * 128, sm, tid, grp, xch);
}
DEVI void job_f2_ctx(const P& p, unsigned char* ws_b, int t, bf16_t* sm, int tid) {
    const int bs = t >> 3, mi = (t >> 2) & 1, ni = t & 3;
    const bf16_t* TAB = (const bf16_t*)(ws_b + WS_TABC);
    const bf16_t* F1T = (const bf16_t*)(ws_b + WS_F1T);
    bf16_t* YF = (bf16_t*)(ws_b + WS_YF);
    job_store<512>(TAB + (size_t)mi * 128 * 512, 512, F1T + (size_t)bs * 512 * 512 + (size_t)ni * 128 * 512, 512, 512,
              YF + ((size_t)bs * 256 + mi * 128) * 512 + ni * 128, sm, tid);
}

DEVI void job_merge(const P& p, unsigned char* ws_b, int l, int t, bf16_t* sm, int tid) {
    const int nN = 8; const int m0 = (t / nN) * 128, n0 = (t % nN) * 128;
    const bf16_t* Wl = (const bf16_t*)(ws_b + WS_W) + (size_t)l * LAYER_W;
    const bf16_t* GATE = (const bf16_t*)(ws_b + WS_GATE);
    bf16_t* MG = (bf16_t*)(ws_b + WS_MERGED);
    EPI_SETUP
    f32x16 acc[2][2]; zero_acc(acc);
#pragma unroll 1
    for (int s = 0; s < 3; ++s) {
        const bf16_t* A = (const bf16_t*)(ws_b + (s == 0 ? WS_YF : (s == 1 ? WS_YM : WS_YN)));
        const bf16_t* W = Wl + (s == 0 ? OFF_WBF : (s == 1 ? OFF_WBM : OFF_WBN));
        gemm_core<false>(A + (size_t)m0 * 512, 512, W + (size_t)n0 * 512, 512, 512, acc, sm, tid);
        {
            const int gr = tid >> 4, gc = (tid & 15) * 8;
            const int s1 = s < 2 ? s + 1 : s;
#pragma unroll
            for (int k = 0; k < 8; ++k) {
                const bf16_t* gsrc = GATE + (size_t)(m0 + gr + 16 * k) * 3072 + n0 + gc;
                *(u32x4*)(sm + (gr + 16 * k) * 136 + gc) = *(const u32x4*)(gsrc + s * 1024);
                *(u32x4*)(sm + 128 * 136 + (gr + 16 * k) * 136 + gc) = *(const u32x4*)(gsrc + s1 * 1024);
                if ((k & 1) == 1) __builtin_amdgcn_sched_barrier(0);
            }
        }
        __syncthreads();
#pragma unroll
        for (int j = 0; j < 2; ++j)
#pragma unroll
            for (int i = 0; i < 2; ++i) {
                const bf16_t* gp = sm + (wr * 64 + i * 32 + 4 * hl) * 136 + wc * 64 + j * 32 + c32;
#pragma unroll
                for (int r = 0; r < 16; ++r) {
                    const int o = ((r & 3) + 8 * (r >> 2)) * 136;
                    const float g = bf2f(gp[o]);
                    const float f = (s < 2) ? g * __builtin_amdgcn_rcpf(bf2f(gp[128 * 136 + o])) : g;
                    acc[i][j][r] *= f;
                }
            }
        __syncthreads();
    }
#pragma unroll
    for (int j = 0; j < 2; ++j) {
        const int col = n0 + wc * 64 + j * 32 + c32;
#pragma unroll
        for (int i = 0; i < 2; ++i) {
            const int rb = m0 + wr * 64 + i * 32 + 4 * hl;
#pragma unroll
            for (int r = 0; r < 16; ++r) MG[(size_t)(rb + (r & 3) + 8 * (r >> 2)) * 1024 + col] = f2bf(acc[i][j][r]);
        }
    }
}

struct TileSrc { const bf16_t* k; const bf16_t* k2; const bf16_t* v; const bf16_t* vhi; };
DEVI int pi_row(int r) { return (r & 0x13) | ((r & 4) << 1) | ((r & 8) >> 1); }

template <int NKS>
DEVI void attn_load(const TileSrc& s, bf16x8 (&kf)[NKS], bf16x8 (&vf)[4]) {
#pragma unroll
    for (int ks = 0; ks < NKS; ++ks) kf[ks] = (ks < 4) ? *(const bf16x8*)(s.k + ks * 16) : *(const bf16x8*)(s.k2 + (ks - 4) * 16);
    vf[0] = *(const bf16x8*)(s.v);
    vf[1] = *(const bf16x8*)(s.v + 16);
    vf[2] = *(const bf16x8*)(s.vhi);
    vf[3] = *(const bf16x8*)(s.vhi + 16);
}

template <int NKS, bool SPLIT, class Src, class Mask>
DEVI void attn_wave(const bf16_t* qptr, int t0, int nt, Src src, Mask mask, bf16_t* optr, int lane, float* ex = nullptr, int half = 0) {
    bf16x8 q[NKS];
#pragma unroll
    for (int ks = 0; ks < NKS; ++ks) q[ks] = *(const bf16x8*)(qptr + ks * 16);
    f32x16 o0, o1;
#pragma unroll
    for (int r = 0; r < 16; ++r) { o0[r] = 0.f; o1[r] = 0.f; }
    float m = -1e30f, lsum = 0.f;
    bf16x8 kf[NKS], vf[4];
    nt += t0;
    { TileSrc s0 = src(t0); attn_load<NKS>(s0, kf, vf); }
    for (int t = t0; t < nt; ++t) {
        bf16x8 kn[NKS], vn[4];
        { TileSrc s1 = src(t + 1 < nt ? t + 1 : t); attn_load<NKS>(s1, kn, vn); }
        f32x16 s;
#pragma unroll
        for (int r = 0; r < 16; ++r) s[r] = 0.f;
#pragma unroll
        for (int ks = 0; ks < NKS; ++ks) s = __builtin_amdgcn_mfma_f32_32x32x16_bf16(kf[ks], q[ks], s, 0, 0, 0);
        mask(t, s);
        float mx = s[0];
#pragma unroll
        for (int r = 1; r < 16; ++r) mx = fmaxf(mx, s[r]);
        mx = fmaxf(mx, __shfl_xor(mx, 32));
        const float mn = fmaxf(m, mx);
        const float alpha = fast_exp2(m - mn);
        m = mn;
        float rs = 0.f;
#pragma unroll
        for (int r = 0; r < 16; ++r) { s[r] = fast_exp2(s[r] - mn); rs += s[r]; }
        lsum = lsum * alpha + rs;
#pragma unroll
        for (int r = 0; r < 16; ++r) { o0[r] *= alpha; o1[r] *= alpha; }
        bf16x8 p0, p1;
        {
            u32x4 a, b;
            a.x = pk2(s[0], s[1]); a.y = pk2(s[2], s[3]); a.z = pk2(s[4], s[5]); a.w = pk2(s[6], s[7]);
            b.x = pk2(s[8], s[9]); b.y = pk2(s[10], s[11]); b.z = pk2(s[12], s[13]); b.w = pk2(s[14], s[15]);
            p0 = __builtin_bit_cast(bf16x8, a); p1 = __builtin_bit_cast(bf16x8, b);
        }
        o0 = __builtin_amdgcn_mfma_f32_32x32x16_bf16(vf[0], p0, o0, 0, 0, 0);
        o0 = __builtin_amdgcn_mfma_f32_32x32x16_bf16(vf[1], p1, o0, 0, 0, 0);
        o1 = __builtin_amdgcn_mfma_f32_32x32x16_bf16(vf[2], p0, o1, 0, 0, 0);
        o1 = __builtin_amdgcn_mfma_f32_32x32x16_bf16(vf[3], p1, o1, 0, 0, 0);
#pragma unroll
        for (int ks = 0; ks < NKS; ++ks) kf[ks] = kn[ks];
#pragma unroll
        for (int x = 0; x < 4; ++x) vf[x] = vn[x];
    }
    if constexpr (SPLIT) {
        if (half == 1) {
#pragma unroll
            for (int r = 0; r < 16; ++r) { ex[r * 64 + lane] = o0[r]; ex[(16 + r) * 64 + lane] = o1[r]; }
            ex[32 * 64 + lane] = m; ex[33 * 64 + lane] = lsum;
        }
        __syncthreads();
        if (half == 0) {
            const float m2 = ex[32 * 64 + lane], l2 = ex[33 * 64 + lane];
            const float mn = fmaxf(m, m2), a1 = fast_exp2(m - mn), a2 = fast_exp2(m2 - mn);
            lsum = lsum * a1 + l2 * a2;
#pragma unroll
            for (int r = 0; r < 16; ++r) { o0[r] = o0[r] * a1 + ex[r * 64 + lane] * a2; o1[r] = o1[r] * a1 + ex[(16 + r) * 64 + lane] * a2; }
        }
        __syncthreads();
        if (half == 1) return;
    }
    lsum += __shfl_xor(lsum, 32);
    const float inv = 1.f / lsum;
    const int hl = lane >> 5;
#pragma unroll
    for (int qd = 0; qd < 4; ++qd) {
        u32x2 a, b;
        a.x = pk2(o0[4 * qd] * inv, o0[4 * qd + 1] * inv); a.y = pk2(o0[4 * qd + 2] * inv, o0[4 * qd + 3] * inv);
        b.x = pk2(o1[4 * qd] * inv, o1[4 * qd + 1] * inv); b.y = pk2(o1[4 * qd + 2] * inv, o1[4 * qd + 3] * inv);
        *(u32x2*)(optr + 8 * qd + 4 * hl) = a;
        *(u32x2*)(optr + 32 + 8 * qd + 4 * hl) = b;
    }
}

struct NoMask { DEVI void operator()(int, f32x16&) const {} };

DEVI void attn_mla(const P& p, unsigned char* ws_b, int l, bool lat, int b, int h, int qg, int lane, float* ex = nullptr, int half = 0) {
    const int hl = lane >> 5, c32 = lane & 31, pr = pi_row(c32);
    const bf16_t* Q = (const bf16_t*)(ws_b + WS_Q);
    const bf16_t* KN = (const bf16_t*)(ws_b + WS_KN);
    const bf16_t* KR = (const bf16_t*)(ws_b + WS_KR);
    const bf16_t* CKR = (const bf16_t*)(ws_b + WS_CKR) + (size_t)l * 1024 * 32;
    const bf16_t* VT = (const bf16_t*)(ws_b + WS_VTM);
    bf16_t* YM = (bf16_t*)(ws_b + WS_YM);
    if (!lat) {
        const int row0 = b * 256;
        const int qrow = row0 + qg * 32 + c32;
        const bf16_t* k0 = KN + (size_t)(row0 + pr) * 512 + h * 64 + hl * 8;
        const bf16_t* r0 = KR + (size_t)(row0 + pr) * 32 + hl * 8;
        const bf16_t* v0 = VT + ((size_t)((b * 8 + h) * 64 + c32)) * 256 + hl * 8;
        auto src = [=](int t) { TileSrc s; s.k = k0 + (size_t)t * 32 * 512; s.k2 = r0 + (size_t)t * 32 * 32; s.v = v0 + t * 32; s.vhi = s.v + 32 * 256; return s; };
        attn_wave<6, false>(Q + (size_t)qrow * 768 + h * 96 + hl * 8, 0, 8, src, NoMask(), YM + (size_t)qrow * 512 + h * 64, lane);
    } else {
        const int row0 = NCTX + b * 2048;
        const int qrow = row0 + qg * 32 + c32;
        const bf16_t* k0 = KN + (size_t)(row0 + pr) * 512 + h * 64 + hl * 8;
        const bf16_t* r0 = KR + (size_t)(row0 + pr) * 32 + hl * 8;
        const bf16_t* k1 = KN + (size_t)(M + b * 512 + pr) * 512 + h * 64 + hl * 8;
        const bf16_t* r1 = CKR + (size_t)(b * 512 + pr) * 32 + hl * 8;
        const bf16_t* v0 = VT + (size_t)4194304 + ((size_t)((b * 8 + h) * 64 + c32)) * 2560 + hl * 8;
        auto src = [=](int t) {
            TileSrc s;
            if (t < 64) { s.k = k0 + (size_t)t * 32 * 512; s.k2 = r0 + (size_t)t * 32 * 32; }
            else { s.k = k1 + (size_t)(t - 64) * 32 * 512; s.k2 = r1 + (size_t)(t - 64) * 32 * 32; }
            s.v = v0 + t * 32; s.vhi = s.v + 32 * 2560; return s; };
        attn_wave<6, true>(Q + (size_t)qrow * 768 + h * 96 + hl * 8, half * 40, 40, src, NoMask(), YM + (size_t)qrow * 512 + h * 64, lane, ex, half);
    }
}

template <int NKS, class Mask>
DEVI void attn_step(const bf16x8 (&kf)[NKS], const bf16x8 (&vf)[4], const bf16x8 (&q)[NKS], f32x16& o0, f32x16& o1, float& m, float& lsum, const Mask& mask, int t) {
    f32x16 s;
#pragma unroll
    for (int r = 0; r < 16; ++r) s[r] = 0.f;
#pragma unroll
    for (int ks = 0; ks < NKS; ++ks) s = __builtin_amdgcn_mfma_f32_32x32x16_bf16(kf[ks], q[ks], s, 0, 0, 0);
    mask(t, s);
    float mx = s[0];
#pragma unroll
    for (int r = 1; r < 16; ++r) mx = fmaxf(mx, s[r]);
    mx = fmaxf(mx, __shfl_xor(mx, 32));
    const float mn = fmaxf(m, mx);
    const float alpha = fast_exp2(m - mn);
    m = mn;
    float rs = 0.f;
#pragma unroll
    for (int r = 0; r < 16; ++r) { s[r] = fast_exp2(s[r] - mn); rs += s[r]; }
    lsum = lsum * alpha + rs;
#pragma unroll
    for (int r = 0; r < 16; ++r) { o0[r] *= alpha; o1[r] *= alpha; }
    bf16x8 p0, p1;
    {
        u32x4 a, b;
        a.x = pk2(s[0], s[1]); a.y = pk2(s[2], s[3]); a.z = pk2(s[4], s[5]); a.w = pk2(s[6], s[7]);
        b.x = pk2(s[8], s[9]); b.y = pk2(s[10], s[11]); b.z = pk2(s[12], s[13]); b.w = pk2(s[14], s[15]);
        p0 = __builtin_bit_cast(bf16x8, a); p1 = __builtin_bit_cast(bf16x8, b);
    }
    o0 = __builtin_amdgcn_mfma_f32_32x32x16_bf16(vf[0], p0, o0, 0, 0, 0);
    o0 = __builtin_amdgcn_mfma_f32_32x32x16_bf16(vf[1], p1, o0, 0, 0, 0);
    o1 = __builtin_amdgcn_mfma_f32_32x32x16_bf16(vf[2], p0, o1, 0, 0, 0);
    o1 = __builtin_amdgcn_mfma_f32_32x32x16_bf16(vf[3], p1, o1, 0, 0, 0);
}
struct MlaStage { u32x4 k, v; u32x2 r; };
DEVI void attn_mla_lat_shared(const P& p, unsigned char* ws_b, int l, int b, int h, int qg, int tid, unsigned char* smem, float* ex) {
    const int lane = tid & 63, wave = tid >> 6, half = wave >> 2, htid = tid & 255;
    const int hl = lane >> 5, c32 = lane & 31, pr = pi_row(c32);
    const bf16_t* Q = (const bf16_t*)(ws_b + WS_Q);
    const bf16_t* KN = (const bf16_t*)(ws_b + WS_KN);
    const bf16_t* KR = (const bf16_t*)(ws_b + WS_KR);
    const bf16_t* CKR = (const bf16_t*)(ws_b + WS_CKR) + (size_t)l * 1024 * 32;
    const bf16_t* VT = (const bf16_t*)(ws_b + WS_VTM) + (size_t)4194304 + (size_t)((b * 8 + h) * 64) * 2560;
    bf16_t* YM = (bf16_t*)(ws_b + WS_YM);
    const int row0 = NCTX + b * 2048;
    const int qrow = row0 + qg * 32 + c32;
    bf16_t* ring = (bf16_t*)(smem + 36864 + half * 36864);
    const int kkey = htid >> 3, kch = (htid & 7) * 8, vd = htid >> 2, vch = (htid & 3) * 8;
    const int rch = (htid & 7) * 4;
    const int tb = half * 40, tend = tb + 40;
    bf16x8 q[6];
    {
        const bf16_t* qptr = Q + (size_t)qrow * 768 + h * 96 + hl * 8;
#pragma unroll
        for (int ks = 0; ks < 6; ++ks) q[ks] = *(const bf16x8*)(qptr + ks * 16);
    }
    f32x16 o0, o1;
#pragma unroll
    for (int r = 0; r < 16; ++r) { o0[r] = 0.f; o1[r] = 0.f; }
    float m = -1e30f, lsum = 0.f;
#define MLA_LD(S, T) do { const int t_ = (T) < tend ? (T) : tend - 1; \
        const int krow_ = t_ < 64 ? row0 + t_ * 32 : M + b * 512 + (t_ - 64) * 32; \
        (S).k = *(const u32x4*)(KN + (size_t)(krow_ + kkey) * 512 + h * 64 + kch); \
        (S).v = *(const u32x4*)(VT + (size_t)vd * 2560 + t_ * 32 + vch); \
        (S).r = *(const u32x2*)((t_ < 64 ? KR + (size_t)(krow_ + kkey) * 32 : CKR + (size_t)(b * 512 + (t_ - 64) * 32 + kkey) * 32) + rch); } while (0)
#define MLA_ST(S, SLOT) do { bf16_t* sl_ = ring + (SLOT) * 6144; \
        *(u32x4*)(sl_ + kkey * 72 + kch) = (S).k; *(u32x4*)(sl_ + 3584 + vd * 40 + vch) = (S).v; \
        *(u32x2*)(sl_ + 2304 + kkey * 40 + rch) = (S).r; } while (0)
#define MLA_COMPUTE(SLOT, T) do { const bf16_t* sl_ = ring + (SLOT) * 6144; bf16x8 kf[6], vf[4]; \
        _Pragma("unroll") for (int ks = 0; ks < 4; ++ks) kf[ks] = *(const bf16x8*)(sl_ + pr * 72 + ks * 16 + hl * 8); \
        kf[4] = *(const bf16x8*)(sl_ + 2304 + pr * 40 + hl * 8); kf[5] = *(const bf16x8*)(sl_ + 2304 + pr * 40 + 16 + hl * 8); \
        vf[0] = *(const bf16x8*)(sl_ + 3584 + c32 * 40 + hl * 8); vf[1] = *(const bf16x8*)(sl_ + 3584 + c32 * 40 + 16 + hl * 8); \
        vf[2] = *(const bf16x8*)(sl_ + 3584 + (c32 + 32) * 40 + hl * 8); vf[3] = *(const bf16x8*)(sl_ + 3584 + (c32 + 32) * 40 + 16 + hl * 8); \
        attn_step<6>(kf, vf, q, o0, o1, m, lsum, NoMask(), (T)); } while (0)
    MlaStage s0, s1, s2;
    MLA_LD(s0, tb); MLA_LD(s1, tb + 1); MLA_LD(s2, tb + 2);
    MLA_ST(s0, 0); MLA_LD(s0, tb + 3);
    __syncthreads();
#pragma unroll 1
    for (int i = tb; i < tend; i += 3) {
        MLA_ST(s1, 1); MLA_LD(s1, i + 4); MLA_COMPUTE(0, i); __syncthreads();
        MLA_ST(s2, 2); MLA_LD(s2, i + 5); if (i + 1 < tend) MLA_COMPUTE(1, i + 1); __syncthreads();
        MLA_ST(s0, 0); MLA_LD(s0, i + 6); if (i + 2 < tend) MLA_COMPUTE(2, i + 2); __syncthreads();
    }
#undef MLA_LD
#undef MLA_ST
#undef MLA_COMPUTE
    if (half == 1) {
#pragma unroll
        for (int r = 0; r < 16; ++r) { ex[r * 64 + lane] = o0[r]; ex[(16 + r) * 64 + lane] = o1[r]; }
        ex[32 * 64 + lane] = m; ex[33 * 64 + lane] = lsum;
    }
    __syncthreads();
    if (half == 0) {
        const float m2 = ex[32 * 64 + lane], l2 = ex[33 * 64 + lane];
        const float mn = fmaxf(m, m2), a1 = fast_exp2(m - mn), a2 = fast_exp2(m2 - mn);
        lsum = lsum * a1 + l2 * a2;
#pragma unroll
        for (int r = 0; r < 16; ++r) { o0[r] = o0[r] * a1 + ex[r * 64 + lane] * a2; o1[r] = o1[r] * a1 + ex[(16 + r) * 64 + lane] * a2; }
    }
    __syncthreads();
    if (half == 1) return;
    lsum += __shfl_xor(lsum, 32);
    const float inv = 1.f / lsum;
    bf16_t* optr = YM + (size_t)qrow * 512 + h * 64;
#pragma unroll
    for (int qd = 0; qd < 4; ++qd) {
        u32x2 a, bb;
        a.x = pk2(o0[4 * qd] * inv, o0[4 * qd + 1] * inv); a.y = pk2(o0[4 * qd + 2] * inv, o0[4 * qd + 3] * inv);
        bb.x = pk2(o1[4 * qd] * inv, o1[4 * qd + 1] * inv); bb.y = pk2(o1[4 * qd + 2] * inv, o1[4 * qd + 3] * inv);
        *(u32x2*)(optr + 8 * qd + 4 * hl) = a;
        *(u32x2*)(optr + 32 + 8 * qd + 4 * hl) = bb;
    }
}

template <int NKS>
DEVI void attn_ctx_shared(const bf16_t* Kg, const bf16_t* KRg, const bf16_t* VTg, const bf16_t* qptr, bf16_t* optr, int tid, unsigned char* smem) {
    const int lane = tid & 63, hl = lane >> 5, c32 = lane & 31, pr = pi_row(c32);
    bf16_t* Ks = (bf16_t*)smem;
    bf16_t* Rs = Ks + 256 * 72;
    bf16_t* Vs = Rs + 256 * 40;
    {
        u32x4 kr[4], vr[4], rr[2];
#pragma unroll
        for (int i = 0; i < 4; ++i) { const int c = tid + 512 * i; kr[i] = *(const u32x4*)(Kg + (size_t)(c >> 3) * 512 + (c & 7) * 8); }
#pragma unroll
        for (int i = 0; i < 4; ++i) { const int c = tid + 512 * i; vr[i] = *(const u32x4*)(VTg + (size_t)(c >> 5) * 256 + (c & 31) * 8); }
        if constexpr (NKS == 6) {
#pragma unroll
            for (int i = 0; i < 2; ++i) { const int c = tid + 512 * i; rr[i] = *(const u32x4*)(KRg + (size_t)(c >> 2) * 32 + (c & 3) * 8); }
        }
#pragma unroll
        for (int i = 0; i < 4; ++i) { const int c = tid + 512 * i; *(u32x4*)(Ks + (c >> 3) * 72 + (c & 7) * 8) = kr[i]; }
#pragma unroll
        for (int i = 0; i < 4; ++i) { const int c = tid + 512 * i; *(u32x4*)(Vs + (c >> 5) * 264 + (c & 31) * 8) = vr[i]; }
        if constexpr (NKS == 6) {
#pragma unroll
            for (int i = 0; i < 2; ++i) { const int c = tid + 512 * i; *(u32x4*)(Rs + (c >> 2) * 40 + (c & 3) * 8) = rr[i]; }
        }
    }
    bf16x8 q[NKS];
#pragma unroll
    for (int ks = 0; ks < NKS; ++ks) q[ks] = *(const bf16x8*)(qptr + ks * 16);
    __syncthreads();
    f32x16 o0, o1;
#pragma unroll
    for (int r = 0; r < 16; ++r) { o0[r] = 0.f; o1[r] = 0.f; }
    float m = -1e30f, lsum = 0.f;
#pragma unroll 1
    for (int t = 0; t < 8; ++t) {
        bf16x8 kf[NKS], vf[4];
        const bf16_t* kp = Ks + (t * 32 + pr) * 72 + hl * 8;
#pragma unroll
        for (int ks = 0; ks < 4; ++ks) kf[ks] = *(const bf16x8*)(kp + ks * 16);
        if constexpr (NKS == 6) {
            const bf16_t* rp = Rs + (t * 32 + pr) * 40 + hl * 8;
            kf[4] = *(const bf16x8*)rp; kf[5] = *(const bf16x8*)(rp + 16);
        }
        const bf16_t* vp = Vs + c32 * 264 + t * 32 + hl * 8;
        vf[0] = *(const bf16x8*)vp; vf[1] = *(const bf16x8*)(vp + 16);
        vf[2] = *(const bf16x8*)(vp + 32 * 264); vf[3] = *(const bf16x8*)(vp + 32 * 264 + 16);
        attn_step<NKS>(kf, vf, q, o0, o1, m, lsum, NoMask(), t);
    }
    lsum += __shfl_xor(lsum, 32);
    const float inv = 1.f / lsum;
#pragma unroll
    for (int qd = 0; qd < 4; ++qd) {
        u32x2 a, bb;
        a.x = pk2(o0[4 * qd] * inv, o0[4 * qd + 1] * inv); a.y = pk2(o0[4 * qd + 2] * inv, o0[4 * qd + 3] * inv);
        bb.x = pk2(o1[4 * qd] * inv, o1[4 * qd + 1] * inv); bb.y = pk2(o1[4 * qd + 2] * inv, o1[4 * qd + 3] * inv);
        *(u32x2*)(optr + 8 * qd + 4 * hl) = a;
        *(u32x2*)(optr + 32 + 8 * qd + 4 * hl) = bb;
    }
    __syncthreads();
}

DEVI void attn_na_ctx(const P& p, unsigned char* ws_b, int b, int h, int qg, int lane) {
    const int hl = lane >> 5, c32 = lane & 31, pr = pi_row(c32);
    const bf16_t* Qn = (const bf16_t*)(ws_b + WS_NAQ);
    const bf16_t* Kn = (const bf16_t*)(ws_b + WS_NAK);
    const bf16_t* VT = (const bf16_t*)(ws_b + WS_NAVT);
    bf16_t* YN = (bf16_t*)(ws_b + WS_YN);
    const int row0 = b * 256, qrow = row0 + qg * 32 + c32;
    const bf16_t* k0 = Kn + (size_t)(row0 + pr) * 512 + h * 64 + hl * 8;
    const bf16_t* v0 = VT + ((size_t)((b * 8 + h) * 64 + c32)) * 256 + hl * 8;
    auto src = [=](int t) { TileSrc s; s.k = k0 + (size_t)t * 32 * 512; s.k2 = s.k; s.v = v0 + t * 32; s.vhi = s.v + 32 * 256; return s; };
    attn_wave<4, false>(Qn + (size_t)qrow * 512 + h * 64 + hl * 8, 0, 8, src, NoMask(), YN + (size_t)qrow * 512 + h * 64, lane);
}

struct NaMask {
    const float* rpb;
    int rs, rq, qc, hl;
    DEVI void operator()(int t, f32x16& s) const {
        if (t >= 16) return;
        const int kr = t >> 1, kh = t & 1;
        const int cs = min(max(qc - 8, 0), 48);
        const float* rp = rpb + (rs + kr - rq + 7) * 31;
#pragma unroll
        for (int r = 0; r < 16; ++r) {
            const int kk = (r & 3) + 4 * ((r >> 2) & 1) + 8 * hl + 16 * (r >> 3);
            const int kc = kh * 32 + kk;
            const bool ok = (kc >= cs) && (kc < cs + 16);
            const int dc = min(max(kc - qc + 15, 0), 30);
            const float bias = rp[dc];
            s[r] = ok ? s[r] + bias : -1e30f;
        }
    }
};
DEVI void attn_na_lat(const P& p, unsigned char* ws_b, int l, int b, int h, int rq, int qh, int lane, float* ex, int half, const float* rpb_lds) {
    const int hl = lane >> 5, c32 = lane & 31, pr = pi_row(c32);
    const bf16_t* Qn = (const bf16_t*)(ws_b + WS_NAQ);
    const bf16_t* Kn = (const bf16_t*)(ws_b + WS_NAK);
    const bf16_t* VT = (const bf16_t*)(ws_b + WS_NAVT) + (size_t)4194304;
    const bf16_t* CK = (const bf16_t*)(ws_b + WS_CNAK) + (size_t)l * 1024 * 512;
    const bf16_t* CV = (const bf16_t*)(ws_b + WS_CNAVT) + (size_t)l * 1024 * 512;
    bf16_t* YN = (bf16_t*)(ws_b + WS_YN);
    const int row0 = NCTX + b * 2048;
    const int qrow = row0 + rq * 64 + qh * 32 + c32;
    const int rs = min(max(rq - 4, 0), 24);
    const bf16_t* k0 = Kn + (size_t)(row0 + rs * 64 + pr) * 512 + h * 64 + hl * 8;
    const bf16_t* v0 = VT + ((size_t)((b * 8 + h) * 64 + c32)) * 2048 + rs * 64 + hl * 8;
    const bf16_t* k1 = CK + (size_t)(b * 512 + pr) * 512 + h * 64 + hl * 8;
    const bf16_t* v1 = CV + ((size_t)((b * 8 + h) * 64 + c32)) * 512 + hl * 8;
    auto src = [=](int t) {
        TileSrc s;
        if (t < 16) { s.k = k0 + (size_t)t * 32 * 512; s.v = v0 + t * 32; s.vhi = s.v + 32 * 2048; }
        else { s.k = k1 + (size_t)(t - 16) * 32 * 512; s.v = v1 + (t - 16) * 32; s.vhi = s.v + 32 * 512; }
        s.k2 = s.k; return s; };
    NaMask mk; mk.rpb = rpb_lds; mk.rs = rs; mk.rq = rq; mk.qc = qh * 32 + c32; mk.hl = hl;
    attn_wave<4, true>(Qn + (size_t)qrow * 512 + h * 64 + hl * 8, half * 16, 16, src, mk, YN + (size_t)qrow * 512 + h * 64, lane, ex, half);
}

DEVI void row_load(const float* src, f32x4 (&v)[4], int lane) {
#pragma unroll
    for (int j = 0; j < 4; ++j) v[j] = *(const f32x4*)(src + 4 * lane + 256 * j);
}
DEVI void row_ln_mod(f32x4 (&v)[4], float* xdst, bf16_t* hdst, const float* lng, const float* lnb, const float* shift, const float* scale, int lane) {
    if (lng) {
        float s = 0.f;
#pragma unroll
        for (int j = 0; j < 4; ++j) s += (v[j].x + v[j].y) + (v[j].z + v[j].w);
        const float mu = wave_sum(s) * (1.f / D);
        float q = 0.f;
#pragma unroll
        for (int j = 0; j < 4; ++j) { v[j] = v[j] - mu; q += (v[j].x * v[j].x + v[j].y * v[j].y) + (v[j].z * v[j].z + v[j].w * v[j].w); }
        const float rstd = rsqrtf(wave_sum(q) * (1.f / D) + 1e-5f);
#pragma unroll
        for (int j = 0; j < 4; ++j) {
            const f32x4 g = *(const f32x4*)(lng + 4 * lane + 256 * j), bb = *(const f32x4*)(lnb + 4 * lane + 256 * j);
            v[j] = v[j] * rstd * g + bb;
        }
    }
    if (xdst) {
#pragma unroll
        for (int j = 0; j < 4; ++j) *(f32x4*)(xdst + 4 * lane + 256 * j) = v[j];
    }
    if (hdst) {
        float s = 0.f;
#pragma unroll
        for (int j = 0; j < 4; ++j) s += (v[j].x + v[j].y) + (v[j].z + v[j].w);
        const float mu = wave_sum(s) * (1.f / D);
        float q = 0.f;
#pragma unroll
        for (int j = 0; j < 4; ++j) { v[j] = v[j] - mu; q += (v[j].x * v[j].x + v[j].y * v[j].y) + (v[j].z * v[j].z + v[j].w * v[j].w); }
        const float rstd = rsqrtf(wave_sum(q) * (1.f / D) + 1e-6f);
#pragma unroll
        for (int j = 0; j < 4; ++j) {
            const f32x4 sc = *(const f32x4*)(scale + 4 * lane + 256 * j), sh = *(const f32x4*)(shift + 4 * lane + 256 * j);
            const f32x4 o = v[j] * rstd * (sc + 1.f) + sh;
            u32x2 pk; pk.x = pk2(o.x, o.y); pk.y = pk2(o.z, o.w);
            *(u32x2*)(hdst + 4 * lane + 256 * j) = pk;
        }
    }
}

DEVI const float* phase_rows_src(const P& p, unsigned char* ws_b, int row, int lnidx) {
    return (lnidx < 0) ? (row < NCTX ? pin(p, 0) + (size_t)row * D : pin(p, 1) + (size_t)(row - NCTX) * D) : (const float*)(ws_b + WS_X) + (size_t)row * D;
}
DEVI void phase_rows_one(const P& p, unsigned char* ws_b, f32x4 (&v)[4], int row, int l, int lnidx, int ml, int ms, bool final_, int lane) {
    float* X = (float*)(ws_b + WS_X);
    bf16_t* H = (bf16_t*)(ws_b + WS_H);
    const float* MOD = (const float*)(ws_b + WS_MOD);
    const float* lng = (lnidx < 0) ? nullptr : pin(p, 28) + (size_t)(l * 3 + lnidx) * D;
    const float* lnb = (lnidx < 0) ? nullptr : pin(p, 29) + (size_t)(l * 3 + lnidx) * D;
    if (final_) { row_ln_mod(v, p.out + (size_t)row * D, nullptr, lng, lnb, nullptr, nullptr, lane); return; }
    const float* mb = MOD + ((size_t)ml * 3 + mod_group(row)) * 9216;
    row_ln_mod(v, X + (size_t)row * D, H + (size_t)row * D, lng, lnb, mb + ms * D, mb + (ms + 1) * D, lane);
}
DEVI void phase_rows(const P& p, unsigned char* ws_b, int l, int lnidx, int ml, int ms, bool final_, int gw, int ngw, int lane) {
    int row = gw;
    for (; row + ngw < M; row += 2 * ngw) {
        f32x4 va[4], vb[4];
        row_load(phase_rows_src(p, ws_b, row, lnidx), va, lane);
        row_load(phase_rows_src(p, ws_b, row + ngw, lnidx), vb, lane);
        phase_rows_one(p, ws_b, va, row, l, lnidx, ml, ms, final_, lane);
        phase_rows_one(p, ws_b, vb, row + ngw, l, lnidx, ml, ms, final_, lane);
    }
    if (row < M) { f32x4 va[4]; row_load(phase_rows_src(p, ws_b, row, lnidx), va, lane); phase_rows_one(p, ws_b, va, row, l, lnidx, ml, ms, final_, lane); }
}

DEVI void phase_rowmix(const P& p, unsigned char* ws_b, int l, int gw, int ngw, int lane) {
    bf16_t* UQ = (bf16_t*)(ws_b + WS_UQ);
    const float* UKV = (const float*)(ws_b + WS_UKV);
    const float* KRF = (const float*)(ws_b + WS_KRF);
    bf16_t* CKV = (bf16_t*)(ws_b + WS_CKV);
    bf16_t* KR = (bf16_t*)(ws_b + WS_KR);
    const float* ropec = (const float*)(ws_b + WS_ROPE);
    const float* ropes = ropec + 512;
    const float* gq = pin(p, 17) + l * 384;
    const float* gkv = pin(p, 19) + l * 256;
    for (int row = gw; row < M; row += ngw) {
        {
            unsigned* up = (unsigned*)(UQ + (size_t)row * 384) + lane;
            float x[6]; float ss = 0.f;
#pragma unroll
            for (int j = 0; j < 3; ++j) { const unsigned w = up[64 * j]; x[2 * j] = bf2f(w & 0xffffu); x[2 * j + 1] = bf2f(w >> 16); ss += x[2 * j] * x[2 * j] + x[2 * j + 1] * x[2 * j + 1]; }
            const float rs = rsqrtf(wave_sum(ss) * (1.f / 384.f) + 1e-6f);
#pragma unroll
            for (int j = 0; j < 3; ++j) { const int c = 2 * lane + 128 * j; up[64 * j] = pk2(x[2 * j] * rs * gq[c], x[2 * j + 1] * rs * gq[c + 1]); }
        }
        {
            const f32x4 v = *(const f32x4*)(UKV + (size_t)row * 256 + 4 * lane);
            const float ss = v.x * v.x + v.y * v.y + v.z * v.z + v.w * v.w;
            const float rs = rsqrtf(wave_sum(ss) * (1.f / 256.f) + 1e-6f);
            const f32x4 g = *(const f32x4*)(gkv + 4 * lane);
            const f32x4 o = v * rs * g;
            u32x2 pk; pk.x = pk2(o.x, o.y); pk.y = pk2(o.z, o.w);
            *(u32x2*)(CKV + (size_t)row * 256 + 4 * lane) = pk;
            if (row < NCTX) *(f32x4*)(p.out + OUT_CKV + ((size_t)((row >> 8) * 4 + l) * 256 + (row & 255)) * 256 + 4 * lane) = o;
        }
        {
            const float v = KRF[(size_t)row * 32 + (lane & 31)];
            const float pr = __shfl_xor(v, 8);
            float o = v;
            if (row >= NCTX) {
                const int c = lane & 31, axis = c >> 4, ii = c & 15, n = (row - NCTX) & 2047;
                const int pos = axis ? (n & 63) : (n >> 6);
                const float rot = (ii < 8) ? -pr : pr;
                o = v * ropec[pos * 8 + (ii & 7)] + rot * ropes[pos * 8 + (ii & 7)];
            }
            if (lane < 32) {
                KR[(size_t)row * 32 + lane] = f2bf(o);
                if (row < NCTX) p.out[OUT_KR + ((size_t)((row >> 8) * 4 + l) * 256 + (row & 255)) * 32 + lane] = v;
            }
        }
    }
}

DEVI void transpose_item(const float* __restrict__ src, int N, int c0, int k0, bf16_t* __restrict__ dst, int K, float* scr, int lane) {
#pragma unroll 8
    for (int i = 0; i < 32; ++i) { const int kk = 2 * i + (lane >> 5); scr[kk * 33 + (lane & 31)] = src[(size_t)(k0 + kk) * N + c0 + (lane & 31)]; }
    asm volatile("s_waitcnt lgkmcnt(0)" ::: "memory");
    const int c = lane & 7;
#pragma unroll
    for (int j = 0; j < 4; ++j) {
        const int n = (lane >> 3) + 8 * j; const float* s = scr + (8 * c) * 33 + n;
        u32x4 o; o.x = pk2(s[0], s[33]); o.y = pk2(s[2 * 33], s[3 * 33]); o.z = pk2(s[4 * 33], s[5 * 33]); o.w = pk2(s[6 * 33], s[7 * 33]);
        *(u32x4*)(dst + (size_t)n * K + k0 + 8 * c) = o;
    }
    asm volatile("s_waitcnt lgkmcnt(0)" ::: "memory");
}

DEVI void prep_weight_item(const P& p, unsigned char* ws_b, int item, float* scr, int lane) {
    const int l = item / 12944; int r = item % 12944;
    bf16_t* Wl = (bf16_t*)(ws_b + WS_W) + (size_t)l * LAYER_W;
    if (r < 8448) {
        const int which = r / 4224; r %= 4224;
        if (r < 2816) {
            const int rb = r >> 4, kb = r & 15;
            const int unit = rb >> 3, sub = rb & 7;
            const float* src = (sub < 4 ? (which ? pin(p, 13) : pin(p, 10)) : (which ? pin(p, 14) : pin(p, 11))) + (size_t)l * D * DFF;
            transpose_item(src, DFF, unit * 128 + (sub & 3) * 32, kb * 64, Wl + (which ? OFF_W13_2 : OFF_W13_1) + (size_t)rb * 32 * D, D, scr, lane);
        } else {
            r -= 2816; const int rb = r / 44, kb = r % 44;
            const float* src = (which ? pin(p, 15) : pin(p, 12)) + (size_t)l * DFF * D;
            transpose_item(src, D, rb * 32, kb * 64, Wl + (which ? OFF_W2_2 : OFF_W2_1) + (size_t)rb * 32 * DFF, DFF, scr, lane);
        }
        return;
    }
    r -= 8448;
    if (r < 2944) {
        const int rb = r >> 4, kb = r & 15, R0 = rb * 32;
        const float* src; int N, c0;
        if (R0 < 1184) { src = pin(p, 16) + (size_t)l * D * 2720; N = 2720; c0 = R0; }
        else if (R0 < 1280) return;
        else if (R0 < 2816) { src = pin(p, 16) + (size_t)l * D * 2720; N = 2720; c0 = R0 - 96; }
        else { src = pin(p, 25) + (size_t)l * D * 3072; N = 3072; c0 = R0 - 2816; }
        transpose_item(src, N, c0, kb * 64, Wl + OFF_WIN + (size_t)R0 * D, D, scr, lane);
        return;
    }
    r -= 2944;
    if (r < 512) { const int rb = r >> 4, kb = r & 15; transpose_item(pin(p, 27) + (size_t)l * D * D, D, rb * 32, kb * 64, Wl + OFF_WOUT + (size_t)rb * 32 * D, D, scr, lane); return; }
    r -= 512;
    if (r < 768) { const int w = r >> 8; r &= 255; const int rb = r >> 3, kb = r & 7;
        transpose_item((w == 0 ? pin(p, 22) : (w == 1 ? pin(p, 23) : pin(p, 24))) + (size_t)l * 512 * D, D, rb * 32, kb * 64, Wl + (w == 0 ? OFF_WBF : (w == 1 ? OFF_WBM : OFF_WBN)) + (size_t)rb * 32 * 512, 512, scr, lane); return; }
    r -= 768;
    if (r < 144) { const int rb = r / 6, kb = r % 6; transpose_item(pin(p, 18) + (size_t)l * 384 * 768, 768, rb * 32, kb * 64, Wl + OFF_WUQ + (size_t)rb * 32 * 384, 384, scr, lane); return; }
    r -= 144;
    { const int rb = r >> 2, kb = r & 3; transpose_item(pin(p, 20) + (size_t)l * 256 * 1024, 1024, rb * 32, kb * 64, Wl + OFF_WUKV + (size_t)rb * 32 * 256, 256, scr, lane); }
}

DEVI void phase_prep(const P& p, unsigned char* ws_b, unsigned char* smem, int tid) {
    const int lane = tid & 63, wave = tid >> 6;
    const int gw = blockIdx.x * NWAVES + wave, ngw = gridDim.x * NWAVES;
    const size_t gt = (size_t)blockIdx.x * NTHREADS + tid, ngt = (size_t)gridDim.x * NTHREADS;
    {
        float* sil = (float*)smem;
        const float* wada = pin(p, 8);
        float* MODP = (float*)(ws_b + WS_MODP);
        for (int item = blockIdx.x; item < 1152; item += gridDim.x) {
            const int l = item / 288, rem = item % 288, kc = rem / 18, cb = rem % 18;
            __syncthreads();
            if (tid < 192) {
                const int g = tid >> 6, k = kc * 64 + (tid & 63);
                const float cv = (g == 0) ? pin(p, 7)[k] : pin(p, 6)[(g - 1) * D + k];
                sil[tid] = cv * sigmoidf_(cv);
            }
            __syncthreads();
            const int col = cb * NTHREADS + tid;
            const float* w = wada + ((size_t)l * D + kc * 64) * 9216 + col;
            float a0 = 0.f, a1 = 0.f, a2 = 0.f;
#pragma unroll 16
            for (int k = 0; k < 64; ++k) { const float wv = w[(size_t)k * 9216]; a0 += sil[k] * wv; a1 += sil[64 + k] * wv; a2 += sil[128 + k] * wv; }
            float* o = MODP + ((size_t)(l * 16 + kc) * 3) * 9216 + col;
            o[0] = a0; o[9216] = a1; o[2 * 9216] = a2;
        }
        __syncthreads();
    }
    {
        float* scr = (float*)smem + wave * (64 * 33);
        for (int item = gw; item < 4 * 12944; item += ngw) prep_weight_item(p, ws_b, item, scr, lane);
    }
    {
        bf16_t* TABL = (bf16_t*)(ws_b + WS_TABL);
        for (size_t e = gt; e < (size_t)2048 * 4096; e += ngt) {
            const int k = (int)(e >> 12), kk = (int)(e & 4095), lidx = kk & 2047;
            const int idx = (k * lidx) & 2047;
            float sn, cs; sincospif((float)idx * (2.f / 2048.f), &sn, &cs);
            TABL[e] = f2bf((kk < 2048 ? cs : -sn) * 0.022097086912079608f);
        }
        bf16_t* TABC = (bf16_t*)(ws_b + WS_TABC);
        for (size_t e = gt; e < (size_t)256 * 512; e += ngt) {
            const int k = (int)(e >> 9), kk = (int)(e & 511), lidx = kk & 255;
            const int idx = (k * lidx) & 255;
            float sn, cs; sincospif((float)idx * (2.f / 256.f), &sn, &cs);
            TABC[e] = f2bf((kk < 256 ? cs : -sn) * 0.0625f);
        }
        bf16_t* WCS = (bf16_t*)(ws_b + WS_WCS);
        for (size_t e = gt; e < (size_t)256 * 128; e += ngt) {
            const int i = (int)(e >> 7), c = (int)(e & 127), m = i >> 1, cs_ = i & 1;
            const int idx = (m * c) & 127;
            float sn, cs; sincospif((float)idx * (2.f / 128.f), &sn, &cs);
            WCS[e] = f2bf((cs_ ? sn : cs) * 0.08838834764831845f);
        }
        float* ROPE = (float*)(ws_b + WS_ROPE);
        for (size_t e = gt; e < 512; e += ngt) {
            const int pos = (int)(e >> 3), i = (int)(e & 7);
            const float inv_freq = powf(10000.f, -(float)i / 8.f);
            const float ang = (float)pos * inv_freq;
            ROPE[e] = cosf(ang); ROPE[512 + e] = sinf(ang);
        }
    }
    {
        bf16_t* CCKV = (bf16_t*)(ws_b + WS_CCKV);
        for (size_t e = gt; e < (size_t)NL * 1024 * 256; e += ngt) {
            const int c = (int)(e & 255), i = (int)((e >> 8) & 511), b = (int)((e >> 17) & 1), l = (int)(e >> 18);
            CCKV[e] = f2bf(pin(p, 2)[((size_t)(b * 4 + l) * 512 + i) * 256 + c]);
        }
        bf16_t* CKR = (bf16_t*)(ws_b + WS_CKR);
        for (size_t e = gt; e < (size_t)NL * 1024 * 32; e += ngt) {
            const int c = (int)(e & 31), i = (int)((e >> 5) & 511), b = (int)((e >> 14) & 1), l = (int)(e >> 15);
            CKR[e] = f2bf(pin(p, 3)[((size_t)(b * 4 + l) * 512 + i) * 32 + c]);
        }
        bf16_t* CNAK = (bf16_t*)(ws_b + WS_CNAK);
        for (size_t e = gt; e < (size_t)NL * 1024 * 512; e += ngt) {
            const int c = (int)(e & 511), i = (int)((e >> 9) & 511), b = (int)((e >> 18) & 1), l = (int)(e >> 19);
            CNAK[e] = f2bf(pin(p, 4)[((size_t)(b * 4 + l) * 512 + i) * 512 + c]);
        }
        bf16_t* CNAVT = (bf16_t*)(ws_b + WS_CNAVT);
        for (size_t e = gt; e < (size_t)NL * 1024 * 512; e += ngt) {
            const int key = (int)(e & 511), hd = (int)((e >> 9) & 511), b = (int)((e >> 18) & 1), l = (int)(e >> 19);
            CNAVT[e] = f2bf(pin(p, 5)[((size_t)(b * 4 + l) * 512 + key) * 512 + hd]);
        }
    }
}

DEVI void phase_modreduce(const P& p, unsigned char* ws_b, int tid) {
    const float* MODP = (const float*)(ws_b + WS_MODP);
    float* MOD = (float*)(ws_b + WS_MOD);
    for (int e = blockIdx.x * NTHREADS + tid; e < NL * 3 * 9216; e += gridDim.x * NTHREADS) {
        const int l = e / (3 * 9216), rem = e % (3 * 9216);
        float a = pin(p, 9)[l * 9216 + (rem % 9216)];
#pragma unroll
        for (int kc = 0; kc < 16; ++kc) a += MODP[((size_t)(l * 16 + kc) * 3) * 9216 + rem];
        MOD[e] = a;
    }
}

#define XB_TMO      128
#define XB_XCNT(j)  (256  + 64 * (j))
#define XB_XSUB(j)  (1280 + 64 * (j))
#define XB_XGEN(j)  (2304 + 64 * (j))
#define XB_TOP      3328
#define XB_TOPGEN   3392
#define XCD_BAR_WORDS 3456
#define XB_SPIN_CAP (1u << 20)
#define LAS __attribute__((address_space(3)))
DEVI unsigned xb_ld(unsigned* p)              { return __hip_atomic_load(p, __ATOMIC_RELAXED, __HIP_MEMORY_SCOPE_AGENT); }
DEVI unsigned xb_add(unsigned* p, unsigned v) { return __hip_atomic_fetch_add(p, v, __ATOMIC_RELAXED, __HIP_MEMORY_SCOPE_AGENT); }
DEVI unsigned xb_xcc_id() { return (unsigned)__builtin_amdgcn_s_getreg((3 << 11) | 20) & 0xFu; }
#define XB_SPIN(cond, bar) do { unsigned _sp = 0; while (cond) { __builtin_amdgcn_s_sleep(1); \
    if ((++_sp & 255u) == 0u) { if (xb_ld(&(bar)[XB_TMO])) break; if (_sp > XB_SPIN_CAP) { atomicAdd(&(bar)[XB_TMO], 1u); break; } } } } while (0)
struct XcdBarrier { unsigned* bar; unsigned x; volatile LAS unsigned* st; };
DEVI XcdBarrier xcd_barrier_post(unsigned* bar, volatile LAS unsigned* st) {
    XcdBarrier b; b.bar = bar; b.x = xb_xcc_id(); b.st = st;
    if (threadIdx.x == 0) (void)xb_add(&bar[XB_XCNT(b.x)], 1u);
    return b;
}
DEVI void xcd_barrier_complete(unsigned* bar, unsigned x, unsigned& nloc, unsigned& nx) {
    const unsigned G = gridDim.x * gridDim.y * gridDim.z;
    unsigned sum, cnt, mine, sp = 0u;
    for (;;) {
        sum = 0u; cnt = 0u; mine = 0u;
#pragma unroll
        for (unsigned j = 0; j < 16; ++j) { const unsigned c = xb_ld(&bar[XB_XCNT(j)]); sum += c; cnt += (c > 0u) ? 1u : 0u; mine = (j == x) ? c : mine; }
        if (sum == G) break;
        __builtin_amdgcn_s_sleep(1);
        if ((++sp & 255u) == 0u) { if (xb_ld(&bar[XB_TMO])) break; if (sp > XB_SPIN_CAP) { atomicAdd(&bar[XB_TMO], 1u); break; } }
    }
    nloc = mine > 0u ? mine : 1u; nx = cnt > 0u ? cnt : 1u;
}
DEVI void xcd_barrier(const XcdBarrier& b) {
    asm volatile("s_waitcnt vmcnt(0)" ::: "memory");
    __syncthreads();
    if (threadIdx.x == 0) {
        unsigned* bar = b.bar;
        __builtin_amdgcn_s_waitcnt(0);
        unsigned nloc = b.st[0], nx = b.st[1];
        if (nloc == 0u) { xcd_barrier_complete(bar, b.x, nloc, nx); b.st[0] = nloc; b.st[1] = nx; }
        const unsigned old = xb_add(&bar[XB_XSUB(b.x)], 1u);
        const unsigned gen = old / nloc;
        if (old + 1u == (gen + 1u) * nloc) {
            __builtin_amdgcn_fence(__ATOMIC_RELEASE, "agent");
            asm volatile("s_waitcnt vmcnt(0)" ::: "memory");
            const unsigned og = xb_add(&bar[XB_TOP], 1u);
            const unsigned tg = og / nx;
            if (og + 1u == (tg + 1u) * nx) xb_add(&bar[XB_TOPGEN], 1u);
            else XB_SPIN(xb_ld(&bar[XB_TOPGEN]) == tg, bar);
            __builtin_amdgcn_fence(__ATOMIC_ACQUIRE, "agent");
            xb_add(&bar[XB_XGEN(b.x)], 1u);
            asm volatile("s_waitcnt vmcnt(0)" ::: "memory");
        } else {
            XB_SPIN(xb_ld(&bar[XB_XGEN(b.x)]) == gen, bar);
            __builtin_amdgcn_fence(__ATOMIC_ACQUIRE, "agent");
            asm volatile("s_waitcnt vmcnt(0)" ::: "memory");
        }
    }
    __syncthreads();
}

DEVI void run_phase(const P& p, unsigned char* ws_b, int ph, unsigned char* smem, int tid) {
    const int lane = tid & 63, wave = tid >> 6;
    const int gw = blockIdx.x * NWAVES + wave, ngw = gridDim.x * NWAVES;
    const int nb = gridDim.x, bid = blockIdx.x;
    const int grp = tid >> 8, ltid = tid & 255;
    bf16_t* sm = (bf16_t*)smem + grp * (SMEM_BYTES / 2);
    if (ph == 0) { phase_prep(p, ws_b, smem, tid); return; }
    if (ph == 1) { phase_modreduce(p, ws_b, tid); return; }
    if (ph == 2) { phase_rows(p, ws_b, 0, -1, 0, 0, false, gw, ngw, lane); return; }
    const int l = (ph - 3) / 13, s = (ph - 3) % 13;
    const bf16_t* Wl = (const bf16_t*)(ws_b + WS_W) + (size_t)l * LAYER_W;
    const float* MODl = (const float*)(ws_b + WS_MOD) + (size_t)l * 3 * 9216;
    switch (s) {
    case 0: case 10:
        {
            pg8::Gemm g{(const bf16_t*)(ws_b + WS_H), Wl + (s == 10 ? OFF_W13_2 : OFF_W13_1), M, 2 * DFF, D};
            pg8::StaticOrder S; S.init(M, 2 * DFF, nb, bid);
            pg8::EpiSwiGLU E{(bf16_t*)(ws_b + WS_ACT)};
            pg8::gemm_phase<pg8::EpiSwiGLU, pg8::StaticOrder, true, true>((PG8_LAS unsigned char*)smem, g, S, E, tid);
        }
        break;
    case 1: case 11:
        {
            pg8::Gemm g{(const bf16_t*)(ws_b + WS_ACT), Wl + (s == 11 ? OFF_W2_2 : OFF_W2_1), M, D, DFF};
            pg8::StaticOrder S; S.init(M, D, nb, bid);
            pg8::EpiResid E{(float*)(ws_b + WS_X), MODl + (s == 11 ? 8 : 2) * D, 0.5f};
            pg8::gemm_phase<pg8::EpiResid, pg8::StaticOrder, false, true>((PG8_LAS unsigned char*)smem, g, S, E, tid);
        }
        break;
    case 2: phase_rows(p, ws_b, l, 0, l, 3, false, gw, ngw, lane); break;
    case 3:
        {
            pg8::Gemm g{(const bf16_t*)(ws_b + WS_H), Wl + OFF_WIN, M, 5888, D};
            pg8::InGateOrder S{nb, bid, 0, nb == 256 ? 1024 : 1104};
            pg8::EpiIn E{ws_b, p.out, pin(p, 26), l};
            pg8::gemm_phase<pg8::EpiIn, pg8::InGateOrder, true, true>((PG8_LAS unsigned char*)smem, g, S, E, tid);
        }
        break;
    case 4: phase_rowmix(p, ws_b, l, gw, ngw, lane); break;
    case 5: {
        float* ex = (float*)smem + (wave & 3) * (34 * 64);
        int u = bid;
        for (; u < 256; u += nb) {
            const int wi = u * 4 + (wave & 3);
            float* rpb_lds = (float*)(smem + 36864);
            {
                const float* rsrc = pin(p, 21) + (size_t)(l * 8 + ((u * 4 >> 6) & 7)) * 465;
                if (tid < 465) rpb_lds[tid] = rsrc[tid] * LOG2E;
                __syncthreads();
            }
            attn_na_lat(p, ws_b, l, wi >> 9, (wi >> 6) & 7, (wi >> 1) & 31, wi & 1, lane, ex, wave >> 2, rpb_lds);
        }
        for (; u < 256 + 416; u += nb) job_ukv(p, ws_b, l, 2 * (u - 256) + grp, sm, ltid);
        for (; u < 256 + 416 + 288; u += nb) job_uq(p, ws_b, l, 2 * (u - 256 - 416) + grp, sm, ltid);
        for (; u < 256 + 416 + 288 + 384; u += nb) job_f1(p, ws_b, 2 * (u - 256 - 416 - 288) + grp, sm, ltid);
        for (; u < 256 + 416 + 288 + 384 + 256; u += nb) {
            const int wi = (u - 256 - 416 - 288 - 384) * 8 + wave;
            const int b = wi >> 6, h = (wi >> 3) & 7, qrow = b * 256 + wave * 32 + (lane & 31);
            attn_ctx_shared<4>((const bf16_t*)(ws_b + WS_NAK) + (size_t)(b * 256) * 512 + h * 64, nullptr,
                               (const bf16_t*)(ws_b + WS_NAVT) + (size_t)((b * 8 + h) * 64) * 256,
                               (const bf16_t*)(ws_b + WS_NAQ) + (size_t)qrow * 512 + h * 64 + (lane >> 5) * 8,
                               (bf16_t*)(ws_b + WS_YN) + (size_t)qrow * 512 + h * 64, tid, smem);
        }
    } break;
    case 6: {
        float* ex = (float*)smem + (wave & 3) * (34 * 64);
        int u = bid;
        for (; u < 256; u += nb) {
            const int wi = u * 4 + (wave & 3);
            attn_mla_lat_shared(p, ws_b, l, wi >> 9, (wi >> 6) & 7, wi & 63, tid, smem, ex);
        }
        for (; u < 256 + 128; u += nb) {
            const int t0 = u - 256, tt = ((t0 & 7) + 8 * ((t0 >> 3) >> 2)) * 4 + ((t0 >> 3) & 3);
            job_f2_lat(p, ws_b, tt, sm, ltid, grp, (float*)(smem + SMEM_BYTES));
        }
        for (; u < 256 + 128 + 128; u += nb) job_f2_ctx(p, ws_b, 2 * (u - 256 - 128) + grp, sm, ltid);
        int it = (nb == 256) ? (bid >= 128 ? bid - 128 : 1 << 20) : u - (256 + 128 + 128);
        for (; it < 256; ) {
            const int wi = it * 8 + wave;
            const int b = wi >> 6, h = (wi >> 3) & 7, qrow = b * 256 + wave * 32 + (lane & 31);
            attn_ctx_shared<6>((const bf16_t*)(ws_b + WS_KN) + (size_t)(b * 256) * 512 + h * 64, (const bf16_t*)(ws_b + WS_KR) + (size_t)(b * 256) * 32,
                               (const bf16_t*)(ws_b + WS_VTM) + (size_t)((b * 8 + h) * 64) * 256,
                               (const bf16_t*)(ws_b + WS_Q) + (size_t)qrow * 768 + h * 96 + (lane >> 5) * 8,
                               (bf16_t*)(ws_b + WS_YM) + (size_t)qrow * 512 + h * 64, tid, smem);
            if (nb != 256) it += nb;
            else if (bid < 208) it = 1 << 20;
            else it = (it < 128) ? 128 + (bid - 208) : it + 48;
        }
        if (nb == 256 && bid >= 128 && bid < 208) {
            int tid5 = tid; asm volatile("" : "+v"(tid5));
            pg8::Gemm g{(const bf16_t*)(ws_b + WS_H), Wl + OFF_WIN, M, 5888, D};
            pg8::InGateOrder S{1 << 20, bid - 128, 1024, 1104};
            pg8::EpiIn E{ws_b, p.out, pin(p, 26), l};
            pg8::gemm_phase<pg8::EpiIn, pg8::InGateOrder, false, true>((PG8_LAS unsigned char*)smem, g, S, E, tid5);
        }
    } break;
    case 7:

#pragma nounroll
        for (int sg = 0; sg < 3; ++sg) {
            int tid3 = tid; asm volatile("" : "+v"(tid3));
            pg8::Gemm g{(const bf16_t*)(ws_b + (sg == 0 ? WS_YF : (sg == 1 ? WS_YM : WS_YN))), Wl + (sg == 0 ? OFF_WBF : (sg == 1 ? OFF_WBM : OFF_WBN)), M, D, 512};
            pg8::StaticOrder S; S.init(M, D, nb, bid);
            pg8::EpiMerge E{(const bf16_t*)(ws_b + WS_GATE), (bf16_t*)(ws_b + WS_UF)  , (bf16_t*)(ws_b + WS_MERGED), sg};
            pg8::gemm_phase<pg8::EpiMerge, pg8::StaticOrder, false, true>((PG8_LAS unsigned char*)smem, g, S, E, tid3);
        }
        break;
    case 8:
        {
            pg8::Gemm g{(const bf16_t*)(ws_b + WS_MERGED), Wl + OFF_WOUT, M, D, D};
            pg8::StaticOrder S; S.init(M, D, nb, bid);
            pg8::EpiResid E{(float*)(ws_b + WS_X), MODl + 5 * D, 1.0f};
            pg8::gemm_phase<pg8::EpiResid, pg8::StaticOrder, false, true>((PG8_LAS unsigned char*)smem, g, S, E, tid);
        }
        break;
    case 9: phase_rows(p, ws_b, l, 1, l, 6, false, gw, ngw, lane); break;
    case 12:
        if (l == NL - 1) phase_rows(p, ws_b, l, 2, 0, 0, true, gw, ngw, lane);
        else phase_rows(p, ws_b, l, 2, l + 1, 0, false, gw, ngw, lane);
        break;
    default: break;
    }
}

__global__ void __launch_bounds__(NTHREADS, 2) mega_kernel(P p) {
    extern __shared__ __attribute__((aligned(16))) unsigned char smem[];
    __shared__ uint4 xb_words;
    cg::grid_group grid = cg::this_grid();
    const int tid = threadIdx.x;
    unsigned* bar = (unsigned*)(p.ws + WS_BAR);
    if (tid == 0) xb_words = make_uint4(0u, 0u, 0u, 0u);
    if (p.ph_lo == 0 && blockIdx.x == 0) for (int i = tid; i < XCD_BAR_WORDS; i += NTHREADS) bar[i] = 0u;
    __syncthreads();
    XcdBarrier xb; xb.bar = bar; xb.x = 0; xb.st = (volatile LAS unsigned*)&xb_words;
#pragma nounroll
    for (int ph = p.ph_lo; ph < p.ph_hi; ++ph) {
        int tid2 = tid; asm volatile("" : "+v"(tid2));
        unsigned char* ws_b = p.ws; asm volatile("" : "+s"(ws_b));
        run_phase(p, ws_b, ph, smem, tid2);
        if (ph + 1 < p.ph_hi) {
            if (ph == p.ph_lo) { grid.sync(); xb = xcd_barrier_post(bar, (volatile LAS unsigned*)&xb_words); }
            else xcd_barrier(xb);
        }
    }
}

extern "C" void kernel_launch(void* const* d_in, const int* in_sizes, int n_in, void* d_out, int out_size, void* d_ws, size_t ws_size,
                              hipStream_t stream) {
    static int grid_blocks = 0;
    if (grid_blocks == 0) {
        if (n_in != 30 || ws_size < WS_END) { fprintf(stderr, "kernel_launch: n_in %d ws %zu need %zu\n", n_in, ws_size, (size_t)WS_END); grid_blocks = -1; return; }
        int dev = 0, cus = 0, per_cu = 0;
        hipGetDevice(&dev);
        hipDeviceGetAttribute(&cus, hipDeviceAttributeMultiprocessorCount, dev);
        hipFuncSetAttribute((const void*)mega_kernel, hipFuncAttributeMaxDynamicSharedMemorySize, LDS_TOTAL);
        hipOccupancyMaxActiveBlocksPerMultiprocessor(&per_cu, (const void*)mega_kernel, NTHREADS, LDS_TOTAL);
        if (per_cu < 1) per_cu = 1;
        if (per_cu > 1) per_cu = 1;
        grid_blocks = cus * per_cu;
    }
    if (grid_blocks < 0) return;
    P p{};
    for (int i = 0; i < 30; ++i) p.in[i] = (const float*)d_in[i];
    p.out = (float*)d_out; p.ws = (unsigned char*)d_ws; p.ph_lo = 0; p.ph_hi = NPHASE;
#ifndef MULTI_LAUNCH
#define MULTI_LAUNCH 0
#endif
#if MULTI_LAUNCH
    for (int ph = 0; ph < NPHASE; ++ph) {
        p.ph_lo = ph; p.ph_hi = ph + 1;
        hipLaunchKernelGGL(mega_kernel, dim3(grid_blocks), dim3(NTHREADS), LDS_TOTAL, stream, p);
    }
#else
    void* args[] = {&p};
    hipError_t e = hipLaunchCooperativeKernel((const void*)mega_kernel, dim3(grid_blocks), dim3(NTHREADS), args, LDS_TOTAL, stream);
    if (e != hipSuccess) fprintf(stderr, "cooperative launch failed: %s (grid %d)\n", hipGetErrorString(e), grid_blocks);
#endif
}
```

```cpp
#include <hip/hip_runtime.h>
#include <hip/hip_cooperative_groups.h>
#include <cstdint>
#include <cstdio>
namespace cg = cooperative_groups;

typedef unsigned short bf16_t;
typedef short bf16x8 __attribute__((ext_vector_type(8)));
typedef float f32x16 __attribute__((ext_vector_type(16)));
typedef float f32x4 __attribute__((ext_vector_type(4)));
typedef unsigned u32x4 __attribute__((ext_vector_type(4)));
typedef unsigned u32x2 __attribute__((ext_vector_type(2)));
#define DEVI __device__ __forceinline__

constexpr int D = 1024, NCTX = 8192, NLAT = 4096, M = 12288, MX = 13312, DFF = 2816, NL = 4;
constexpr float ALPHA_F = 1.6817928305074290f;
constexpr float LOG2E = 1.4426950408889634f;
constexpr float MLA_QS = 0.10206207261596575f * LOG2E;
constexpr float NA_QS = 0.125f * LOG2E;
constexpr size_t OUT_CKV = 12582912, OUT_KR = 20971520, OUT_NAK = 22020096, OUT_NAV = 38797312;

constexpr size_t al256(size_t x) { return (x + 255) & ~(size_t)255; }
constexpr size_t WS_BAR = 0;
constexpr size_t WS_X = 16384;
constexpr size_t WS_H = WS_X + (size_t)M * D * 4;
constexpr size_t WS_MOD = WS_H + (size_t)M * D * 2;
constexpr size_t WS_MODP = WS_MOD + al256((size_t)NL * 3 * 9216 * 4);
constexpr size_t WS_ROPE = WS_MODP + al256((size_t)NL * 16 * 3 * 9216 * 4);
constexpr size_t WS_TABC = WS_ROPE + 4096;
constexpr size_t WS_TABL = WS_TABC + (size_t)256 * 512 * 2;
constexpr size_t WS_WCS = WS_TABL + (size_t)2048 * 4096 * 2;
constexpr size_t WS_CCKV = WS_WCS + (size_t)256 * 128 * 2;
constexpr size_t WS_CKR = WS_CCKV + (size_t)NL * 1024 * 256 * 2;
constexpr size_t WS_CNAK = WS_CKR + (size_t)NL * 1024 * 32 * 2;
constexpr size_t WS_CNAVT = WS_CNAK + (size_t)NL * 1024 * 512 * 2;
constexpr size_t WS_W = WS_CNAVT + (size_t)NL * 1024 * 512 * 2;
constexpr size_t OFF_W13_1 = 0, OFF_W2_1 = 5767168, OFF_W13_2 = 8650752, OFF_W2_2 = 14417920, OFF_WIN = 17301504,
                 OFF_WOUT = 23330816, OFF_WBF = 24379392, OFF_WBM = 24903680, OFF_WBN = 25427968, OFF_WUQ = 25952256,
                 OFF_WUKV = 26247168, LAYER_W = 26509312;
constexpr size_t WS_R1 = WS_W + (size_t)NL * LAYER_W * 2;
constexpr size_t WS_ACT = WS_R1;
constexpr size_t WS_UF = WS_R1;
constexpr size_t WS_UQ = WS_UF + (size_t)M * 512 * 2;
constexpr size_t WS_UKV = WS_UQ + (size_t)M * 384 * 2;
constexpr size_t WS_KRF = WS_UKV + (size_t)M * 256 * 4;
constexpr size_t WS_CKV = WS_KRF + (size_t)M * 32 * 4;
constexpr size_t WS_KR = WS_CKV + (size_t)M * 256 * 2;
constexpr size_t WS_NAQ = WS_KR + (size_t)M * 32 * 2;
constexpr size_t WS_NAK = WS_NAQ + (size_t)M * 512 * 2;
constexpr size_t WS_NAVT = WS_NAK + (size_t)M * 512 * 2;
constexpr size_t WS_GATE = WS_NAVT + (size_t)M * 512 * 2;
constexpr size_t WS_Q = WS_GATE + (size_t)M * 3072 * 2;
constexpr size_t WS_KN = WS_Q + (size_t)M * 768 * 2;
constexpr size_t WS_VTM = WS_KN + (size_t)MX * 512 * 2;
constexpr size_t WS_F1T = WS_VTM + (size_t)MX * 512 * 2;
constexpr size_t WS_YF = WS_F1T + (size_t)M * 1024 * 2;
constexpr size_t WS_YM = WS_YF + (size_t)M * 512 * 2;
constexpr size_t WS_YN = WS_YM + (size_t)M * 512 * 2;
constexpr size_t WS_MERGED = WS_YN + (size_t)M * 512 * 2;
constexpr size_t WS_END = WS_MERGED + (size_t)M * 1024 * 2;
static_assert(WS_END - WS_R1 >= (size_t)M * DFF * 2, "ACT must fit in R1");
static_assert(WS_NAK - WS_UF >= (size_t)M * D * 4, "merge T32 must fit in the dead UF..NAQ buffers");

constexpr int NPHASE = 3 + 13 * NL;

struct P {
    const float* in[30];
    float* out;
    unsigned char* ws;
    int ph_lo, ph_hi;
};

__device__ __forceinline__ const float* pin(const P& p, int i) { int j = i; asm volatile("" : "+s"(j)); return p.in[j]; }
typedef __bf16 bf16v2 __attribute__((ext_vector_type(2)));
typedef float f32x2 __attribute__((ext_vector_type(2)));
DEVI unsigned pk2(float lo, float hi) { f32x2 v = {lo, hi}; bf16v2 b = __builtin_convertvector(v, bf16v2); return __builtin_bit_cast(unsigned, b); }
DEVI bf16_t f2bf(float x) { return (bf16_t)(pk2(x, 0.f) & 0xffffu); }
DEVI float bf2f(unsigned v) { return __uint_as_float(v << 16); }
DEVI float wave_sum(float v) {
#pragma unroll
    for (int o = 1; o < 64; o <<= 1) v += __shfl_xor(v, o);
    return v;
}
DEVI float fast_exp2(float x) { return __builtin_amdgcn_exp2f(x); }
DEVI float sigmoidf_(float x) { return __builtin_amdgcn_rcpf(1.f + __expf(-x)); }

constexpr int LDT = 72;
constexpr int TILE_E = 128 * LDT;
constexpr int SMEM_BYTES = 4 * TILE_E * 2;
constexpr int NTHREADS = 512, NWAVES = 8, LDS_TOTAL = 2 * SMEM_BYTES;

DEVI void gemm_ldg(const bf16_t* ga, const bf16_t* gb, int lda, int ldb, u32x4 (&ra)[4], u32x4 (&rb)[4]) {
#pragma unroll
    for (int i = 0; i < 4; ++i) {
        ra[i] = *(const u32x4*)(ga + (size_t)(32 * i) * lda);
        rb[i] = *(const u32x4*)(gb + (size_t)(32 * i) * ldb);
    }
}
DEVI void gemm_sts(bf16_t* buf, int soff, const u32x4 (&ra)[4], const u32x4 (&rb)[4]) {
#pragma unroll
    for (int i = 0; i < 4; ++i) {
        *(u32x4*)(buf + soff + 32 * i * LDT) = ra[i];
        *(u32x4*)(buf + TILE_E + soff + 32 * i * LDT) = rb[i];
    }
}
DEVI void gemm_mma(const bf16_t* cur, int aoff, int boff, f32x16 (&acc)[2][2]) {
#pragma unroll
    for (int ks = 0; ks < 4; ++ks) {
        bf16x8 a0 = *(const bf16x8*)(cur + aoff + ks * 16);
        bf16x8 a1 = *(const bf16x8*)(cur + aoff + 32 * LDT + ks * 16);
        bf16x8 b0 = *(const bf16x8*)(cur + boff + ks * 16);
        bf16x8 b1 = *(const bf16x8*)(cur + boff + 32 * LDT + ks * 16);
        acc[0][0] = __builtin_amdgcn_mfma_f32_32x32x16_bf16(a0, b0, acc[0][0], 0, 0, 0);
        acc[0][1] = __builtin_amdgcn_mfma_f32_32x32x16_bf16(a0, b1, acc[0][1], 0, 0, 0);
        acc[1][0] = __builtin_amdgcn_mfma_f32_32x32x16_bf16(a1, b0, acc[1][0], 0, 0, 0);
        acc[1][1] = __builtin_amdgcn_mfma_f32_32x32x16_bf16(a1, b1, acc[1][1], 0, 0, 0);
    }
}

template <bool DEEP = true>
DEVI void gemm_core(const bf16_t* __restrict__ A, int lda, const bf16_t* __restrict__ B, int ldb, int K,
                    f32x16 (&acc)[2][2], bf16_t* smem, int tid) {
    const int lane = tid & 63, wave = tid >> 6, wr = wave >> 1, wc = wave & 1;
    const int lr = tid >> 3, lc = (tid & 7) * 8;
    const bf16_t* ga = A + (size_t)lr * lda + lc;
    const bf16_t* gb = B + (size_t)lr * ldb + lc;
    const int soff = lr * LDT + lc;
    const int nk = K >> 6;
    const int aoff = (wr * 64 + (lane & 31)) * LDT + (lane >> 5) * 8;
    const int boff = TILE_E + (wc * 64 + (lane & 31)) * LDT + (lane >> 5) * 8;
    bf16_t* buf0 = smem; bf16_t* buf1 = smem + 2 * TILE_E;
    if constexpr (DEEP) {
        u32x4 ra0[4], rb0[4], ra1[4], rb1[4];
        gemm_ldg(ga, gb, lda, ldb, ra0, rb0);
        gemm_ldg(ga + 64, gb + 64, lda, ldb, ra1, rb1);
        gemm_sts(buf0, soff, ra0, rb0);
        __syncthreads();
        for (int kt = 0; kt < nk; kt += 2) {
            if (kt + 2 < nk) gemm_ldg(ga + (size_t)(kt + 2) * 64, gb + (size_t)(kt + 2) * 64, lda, ldb, ra0, rb0);
            gemm_mma(buf0, aoff, boff, acc);
            gemm_sts(buf1, soff, ra1, rb1);
            __syncthreads();
            if (kt + 3 < nk) gemm_ldg(ga + (size_t)(kt + 3) * 64, gb + (size_t)(kt + 3) * 64, lda, ldb, ra1, rb1);
            gemm_mma(buf1, aoff, boff, acc);
            if (kt + 2 < nk) gemm_sts(buf0, soff, ra0, rb0);
            __syncthreads();
        }
    } else {
        u32x4 ra[4], rb[4];
        gemm_ldg(ga, gb, lda, ldb, ra, rb);
        gemm_sts(buf0, soff, ra, rb);
        __syncthreads();
        for (int kt = 0; kt < nk; ++kt) {
            bf16_t* cur = (kt & 1) ? buf1 : buf0;
            bf16_t* nxt = (kt & 1) ? buf0 : buf1;
            const bool more = (kt + 1 < nk);
            if (more) { ga += 64; gb += 64; gemm_ldg(ga, gb, lda, ldb, ra, rb); }
            gemm_mma(cur, aoff, boff, acc);
            if (more) gemm_sts(nxt, soff, ra, rb);
            __syncthreads();
        }
    }
}

DEVI void zero_acc(f32x16 (&acc)[2][2]) {
#pragma unroll
    for (int i = 0; i < 2; ++i)
#pragma unroll
        for (int j = 0; j < 2; ++j)
#pragma unroll
            for (int r = 0; r < 16; ++r) acc[i][j][r] = 0.f;
}

#define EPI_SETUP const int lane = tid & 63, wave = tid >> 6, wr = wave >> 1, wc = wave & 1, hl = lane >> 5, c32 = lane & 31; (void)wr; (void)wc; (void)hl; (void)c32;

DEVI int mod_group(int row) { return row < NCTX ? 0 : 1 + ((row - NCTX) >> 11); }

namespace pg8 {
#define PG8_LAS __attribute__((address_space(3)))
constexpr int BM = 256, BK = 64, HALF = 128, HTB = HALF * BK * 2, NXCD = 8, WGM = 8;
DEVI int lds_byte(int r, int c) { const int st = (r >> 4) * 2 + (c >> 5), rr = r & 15, cc = c & 31, ob = rr * 64 + cc * 2; return st * 1024 + (ob ^ (((ob >> 9) & 1) << 5)); }
DEVI void stage_rc(int b, int& R, int& C) { const int st = b / 1024, sb = b % 1024, swz = sb ^ (((sb >> 9) & 1) << 5); R = (st >> 1) * 16 + swz / 64; C = (st & 1) * 32 + (swz % 64) / 2; }
DEVI int perm32(int rho) { const int n = rho >> 4, i = rho & 15; return 8 * (i >> 2) + 4 * n + (i & 3); }
struct Unit { int pm, pn; };
struct Gemm { const bf16_t* A; const bf16_t* Bt; int M, N, K; };
struct StaticOrder {
    int nM, nN, nwg, G, c;
    DEVI void init(int M, int N, int G_, int c_) { nM = M / BM; nN = N / BM; nwg = nM * nN; G = G_; c = c_; }
    DEVI bool next(int i, Unit& u) const {
        const long L = (long)i * G + c; if (L >= nwg) return false;
        int wgid = (int)L; { const int q = nwg / NXCD, r = nwg % NXCD, xcd = wgid % NXCD, off = wgid / NXCD; wgid = (xcd < r ? xcd * (q + 1) : r * (q + 1) + (xcd - r) * q) + off; }
        const int nig = WGM * nN, gid = wgid / nig, fm = gid * WGM, gsz = (nM - fm) < WGM ? (nM - fm) : WGM;
        u.pm = fm + ((wgid % nig) % gsz); u.pn = (wgid % nig) / gsz; return true;
    }
    DEVI void a_ready(const Unit&) const {}
    DEVI void done(const Unit&) const {}
};
struct InGateOrder {
    int G, c, lo, hi;
    static DEVI void so_map(int wgid, int nM, int nN, Unit& u) {
        const int nwg = nM * nN;
        { const int q = nwg / NXCD, r = nwg % NXCD, xcd = wgid % NXCD, off = wgid / NXCD; wgid = (xcd < r ? xcd * (q + 1) : r * (q + 1) + (xcd - r) * q) + off; }
        const int nig = WGM * nN, gid = wgid / nig, fm = gid * WGM, gsz = (nM - fm) < WGM ? (nM - fm) : WGM;
        u.pm = fm + ((wgid % nig) % gsz); u.pn = (wgid % nig) / gsz;
    }
    DEVI bool next(int i, Unit& u) const {
        const long L = (long)i * G + c + lo; if (L >= hi) return false;
        if (L < 528) so_map((int)L, 48, 11, u); else { so_map((int)L - 528, 48, 12, u); u.pn += 11; }
        return true;
    }
    DEVI void a_ready(const Unit&) const {}
    DEVI void done(const Unit&) const {}
};
template <class Epi, class Sched, bool ALIGN_EPI = false, bool SP2 = false>
DEVI void gemm_phase(PG8_LAS unsigned char* lds, const Gemm g, const Sched& S, const Epi& E, const int tid) {
    const int wid = __builtin_amdgcn_readfirstlane(tid >> 6), lane = tid & 63, wr = wid >> 2, wc = wid & 3, fr = lane & 15, fq = lane >> 4;
    const int K = g.K, nt = K / BK;
    unsigned voffA[2], voffB[2];
#pragma unroll
    for (int i = 0; i < 2; ++i) { int R, C; stage_rc(tid * 16 + i * 8192, R, C); const int Rb = Epi::PERM ? ((R & ~31) + perm32(R & 31)) : R;
        voffA[i] = (unsigned)(R * K + C) * 2u; voffB[i] = (unsigned)(Rb * K + C) * 2u; }
    const size_t kstep = (size_t)(BK * 2);
    const size_t hstep = (size_t)HALF * K * 2;
    const size_t tstep = 2 * hstep;
    const unsigned ldsw = (unsigned)wid * 1024u;
    const int aoff = lds_byte(wr * 64 + fr, fq * 8), boff = lds_byte(wc * 32 + fr, fq * 8);
#define PG8_SA(b, h) (((b) * 2 + (h)) * HTB)
#define PG8_SB(b, h) ((4 + (b) * 2 + (h)) * HTB)
#define PG8_STAGE(bufoff, gbase, voff) do { _Pragma("unroll") for (int _i = 0; _i < 2; ++_i) \
        __builtin_amdgcn_global_load_lds((const unsigned*)((const char*)(gbase) + (voff)[_i]), (PG8_LAS unsigned*)(lds + (bufoff) + ldsw + _i * 8192), 16, 0, 0); } while (0)
#define PG8_LDA(dst, b, h) do { _Pragma("unroll") for (int m = 0; m < 4; ++m) _Pragma("unroll") for (int k = 0; k < 2; ++k) dst[m][k] = *(const PG8_LAS bf16x8*)(lds + PG8_SA(b, h) + aoff + m * 2048 + k * 1024); } while (0)
#define PG8_LDB(dst, b, h) do { _Pragma("unroll") for (int n = 0; n < 2; ++n) _Pragma("unroll") for (int k = 0; k < 2; ++k) dst[n][k] = *(const PG8_LAS bf16x8*)(lds + PG8_SB(b, h) + boff + n * 2048 + k * 1024); } while (0)
#define PG8_MMA(ai, bj, At, Bt) do { __builtin_amdgcn_s_setprio(1); _Pragma("unroll") for (int m = 0; m < 4; ++m) _Pragma("unroll") for (int n = 0; n < 2; ++n) _Pragma("unroll") for (int k = 0; k < 2; ++k) \
        acc[ai][bj][m][n] = __builtin_amdgcn_mfma_f32_16x16x32_bf16(Bt[n][k], At[m][k], acc[ai][bj][m][n], 0, 0, 0); __builtin_amdgcn_s_setprio(0); } while (0)
#define PG8_WAIT_V(n) asm volatile("s_waitcnt vmcnt(" #n ")" ::: "memory")
#define PG8_WAIT_L(n) asm volatile("s_waitcnt lgkmcnt(" #n ")" ::: "memory")
#define PG8_BAR __builtin_amdgcn_s_barrier()
#define PG8_SCHED __builtin_amdgcn_sched_barrier(0)
    Unit cur, nxt; int ui = 0;
    if (!S.next(0, cur)) return;
    f32x4 acc[2][2][4][2];
#pragma unroll
    for (int a = 0; a < 2; ++a)
#pragma unroll
        for (int b = 0; b < 2; ++b)
#pragma unroll
            for (int m = 0; m < 4; ++m)
#pragma unroll
                for (int n = 0; n < 2; ++n) acc[a][b][m][n] = (f32x4){0.f, 0.f, 0.f, 0.f};
    bf16x8 At[4][2], B0[2][2], B1[2][2];
    const char* cA = (const char*)g.A + (size_t)cur.pm * tstep; const char* cB = (const char*)g.Bt + (size_t)cur.pn * tstep;
    S.a_ready(cur);
    if constexpr (SP2) {
        PG8_STAGE(PG8_SB(0, 0), cB, voffB); PG8_STAGE(PG8_SB(0, 1), cB + hstep, voffB); PG8_STAGE(PG8_SA(0, 0), cA, voffA); PG8_STAGE(PG8_SA(0, 1), cA + hstep, voffA);
        if (wr == 1) PG8_BAR;
        PG8_WAIT_V(2); PG8_BAR;
        PG8_STAGE(PG8_SB(1, 0), cB + kstep, voffB); PG8_STAGE(PG8_SA(1, 0), cA + kstep, voffA); PG8_STAGE(PG8_SB(1, 1), cB + hstep + kstep, voffB);
        PG8_WAIT_V(6); PG8_BAR;
    } else {
        PG8_STAGE(PG8_SB(0, 0), cB, voffB); PG8_STAGE(PG8_SA(0, 0), cA, voffA); PG8_STAGE(PG8_SB(0, 1), cB + hstep, voffB); PG8_STAGE(PG8_SA(0, 1), cA + hstep, voffA);
        if (wr == 1) PG8_BAR;
        PG8_WAIT_V(4); PG8_BAR;
        PG8_STAGE(PG8_SB(1, 0), cB + kstep, voffB); PG8_STAGE(PG8_SA(1, 0), cA + kstep, voffA); PG8_STAGE(PG8_SB(1, 1), cB + hstep + kstep, voffB);
        PG8_WAIT_V(6); PG8_BAR;
    }
    for (;;) {
        const bool has_next = S.next(ui + 1, nxt);
        const char* nA = has_next ? (const char*)g.A + (size_t)nxt.pm * tstep : cA; const char* nB = has_next ? (const char*)g.Bt + (size_t)nxt.pn * tstep : cB;
        for (int t = 0; t < nt; t += 2) {
            const bool last = (t == nt - 2);
            const char* a1 = cA + (size_t)(t + 1) * kstep;
            const char* a2 = last ? nA : cA + (size_t)(t + 2) * kstep; const char* b2 = last ? nB : cB + (size_t)(t + 2) * kstep;
            const char* a3 = a2 + kstep; const char* b3 = b2 + kstep;
            if (last && has_next) S.a_ready(nxt);
            if constexpr (SP2) {
            PG8_LDB(B0, 0, 0); PG8_LDB(B1, 0, 1); PG8_SCHED; PG8_LDA(At, 0, 0); PG8_STAGE(PG8_SA(1, 1), a1 + hstep, voffA);
            PG8_WAIT_V(8); PG8_WAIT_L(0); PG8_BAR; PG8_MMA(0, 0, At, B0); PG8_MMA(0, 1, At, B1); PG8_BAR; PG8_SCHED;
            PG8_LDA(At, 0, 1); PG8_STAGE(PG8_SB(0, 0), b2, voffB); PG8_STAGE(PG8_SB(0, 1), b2 + hstep, voffB); PG8_STAGE(PG8_SA(0, 0), a2, voffA);
            PG8_WAIT_V(8); PG8_WAIT_L(0); PG8_BAR; PG8_MMA(1, 0, At, B0); PG8_MMA(1, 1, At, B1); PG8_BAR; PG8_SCHED;
            PG8_LDB(B0, 1, 0); PG8_LDB(B1, 1, 1); PG8_SCHED; PG8_LDA(At, 1, 0); PG8_STAGE(PG8_SA(0, 1), a2 + hstep, voffA);
            PG8_WAIT_V(8); PG8_WAIT_L(0); PG8_BAR; PG8_MMA(0, 0, At, B0); PG8_MMA(0, 1, At, B1); PG8_BAR; PG8_SCHED;
            PG8_LDA(At, 1, 1); PG8_STAGE(PG8_SB(1, 0), b3, voffB); PG8_STAGE(PG8_SB(1, 1), b3 + hstep, voffB); PG8_STAGE(PG8_SA(1, 0), a3, voffA);
            PG8_WAIT_V(8); PG8_WAIT_L(0); PG8_BAR; PG8_MMA(1, 0, At, B0); PG8_MMA(1, 1, At, B1); PG8_BAR; PG8_SCHED;
            } else {
            PG8_LDB(B0, 0, 0); PG8_SCHED; PG8_LDA(At, 0, 0); PG8_STAGE(PG8_SA(1, 1), a1 + hstep, voffA);
            PG8_WAIT_L(8); PG8_BAR; PG8_WAIT_L(0); PG8_MMA(0, 0, At, B0); PG8_BAR; PG8_SCHED;
            PG8_LDB(B1, 0, 1); PG8_STAGE(PG8_SB(0, 0), b2, voffB);
            PG8_BAR; PG8_WAIT_L(0); PG8_MMA(0, 1, At, B1); PG8_BAR;
            PG8_LDA(At, 0, 1); PG8_STAGE(PG8_SA(0, 0), a2, voffA);
            PG8_BAR; PG8_WAIT_L(0); PG8_MMA(1, 0, At, B0); PG8_BAR; PG8_SCHED;
            PG8_STAGE(PG8_SB(0, 1), b2 + hstep, voffB);
            PG8_WAIT_V(6); PG8_BAR; PG8_MMA(1, 1, At, B1); PG8_BAR;
            PG8_LDB(B0, 1, 0); PG8_SCHED; PG8_LDA(At, 1, 0); PG8_STAGE(PG8_SA(0, 1), a2 + hstep, voffA);
            PG8_WAIT_L(8); PG8_BAR; PG8_WAIT_L(0); PG8_MMA(0, 0, At, B0); PG8_BAR; PG8_SCHED;
            PG8_LDB(B1, 1, 1); PG8_STAGE(PG8_SB(1, 0), b3, voffB);
            PG8_BAR; PG8_WAIT_L(0); PG8_MMA(0, 1, At, B1); PG8_BAR;
            PG8_LDA(At, 1, 1); PG8_STAGE(PG8_SA(1, 0), a3, voffA);
            PG8_BAR; PG8_WAIT_L(0); PG8_MMA(1, 0, At, B0); PG8_BAR; PG8_SCHED;
            PG8_STAGE(PG8_SB(1, 1), b3 + hstep, voffB);
            PG8_WAIT_V(6); PG8_BAR; PG8_MMA(1, 1, At, B1); PG8_BAR;
            }
        }
        if constexpr (ALIGN_EPI) { if (wr == 0) PG8_BAR; }
        E(acc, cur, wr, wc, fr, fq); S.done(cur);
        if (!has_next) break;
#pragma unroll
        for (int a = 0; a < 2; ++a)
#pragma unroll
            for (int b = 0; b < 2; ++b)
#pragma unroll
                for (int m = 0; m < 4; ++m)
#pragma unroll
                    for (int n = 0; n < 2; ++n) acc[a][b][m][n] = (f32x4){0.f, 0.f, 0.f, 0.f};
        cur = nxt; cA = nA; cB = nB; ++ui;
        if constexpr (ALIGN_EPI) { if (wr == 1) PG8_BAR; }
    }
    PG8_WAIT_V(0);
    if constexpr (!ALIGN_EPI) { if (wr == 0) PG8_BAR; }
    PG8_BAR;
#undef PG8_SA
#undef PG8_SB
#undef PG8_STAGE
#undef PG8_LDA
#undef PG8_LDB
#undef PG8_MMA
#undef PG8_WAIT_V
#undef PG8_WAIT_L
#undef PG8_BAR
#undef PG8_SCHED
}

struct EpiSwiGLU {
    static constexpr bool PERM = true;
    bf16_t* ACT;
    DEVI void operator()(const f32x4 (&acc)[2][2][4][2], const Unit& u, int wr, int wc, int fr, int fq) const {
#pragma unroll
        for (int ai = 0; ai < 2; ++ai)
#pragma unroll
            for (int m = 0; m < 4; ++m) {
                const int row = u.pm * BM + ai * HALF + wr * 64 + m * 16 + fr;
                u32x4 pk;
#pragma unroll
                for (int n = 0; n < 2; ++n) {
                    const f32x4 a = acc[ai][0][m][n], b = acc[ai][1][m][n];
                    const unsigned lo = pk2(a[0] * sigmoidf_(a[0]) * b[0], a[1] * sigmoidf_(a[1]) * b[1]);
                    const unsigned hi = pk2(a[2] * sigmoidf_(a[2]) * b[2], a[3] * sigmoidf_(a[3]) * b[3]);
                    if (n == 0) { pk.x = lo; pk.y = hi; } else { pk.z = lo; pk.w = hi; }
                }
                *(u32x4*)(ACT + (size_t)row * DFF + u.pn * 128 + wc * 32 + 8 * fq) = pk;
            }
    }
};
struct EpiResid {
    static constexpr bool PERM = true;
    float* X; const float* gate_base; float coef;
    DEVI void operator()(const f32x4 (&acc)[2][2][4][2], const Unit& u, int wr, int wc, int fr_, int fq_) const {
        int fr = fr_, fq = fq_; asm volatile("" : "+v"(fr), "+v"(fq));
        const float* gate = gate_base + (size_t)mod_group(u.pm * BM) * 9216;
        const int col0 = u.pn * BM + wc * 32 + 8 * fq;
        f32x4 gv[2][2];
#pragma unroll
        for (int bj = 0; bj < 2; ++bj)
#pragma unroll
            for (int n = 0; n < 2; ++n) gv[bj][n] = *(const f32x4*)(gate + col0 + bj * HALF + 4 * n) * coef;
#pragma unroll
        for (int ah = 0; ah < 4; ++ah) {
            const int ai = ah >> 1, mb = (ah & 1) * 2;
            f32x4 xv[4][2][2];
#pragma unroll
            for (int m = mb; m < mb + 2; ++m)
#pragma unroll
                for (int bj = 0; bj < 2; ++bj)
#pragma unroll
                    for (int n = 0; n < 2; ++n)
                        xv[m][bj][n] = *(const f32x4*)(X + (size_t)(u.pm * BM + ai * HALF + wr * 64 + m * 16 + fr) * D + col0 + bj * HALF + 4 * n);
            __builtin_amdgcn_sched_barrier(0);
#pragma unroll
            for (int m = mb; m < mb + 2; ++m)
#pragma unroll
                for (int bj = 0; bj < 2; ++bj)
#pragma unroll
                    for (int n = 0; n < 2; ++n)
                        *(f32x4*)(X + (size_t)(u.pm * BM + ai * HALF + wr * 64 + m * 16 + fr) * D + col0 + bj * HALF + 4 * n) =
                            xv[m][bj][n] * ALPHA_F + gv[bj][n] * acc[ai][bj][m][n];
            __builtin_amdgcn_sched_barrier(0);
        }
    }
};
struct EpiIn {
    static constexpr bool PERM = true;
    unsigned char* ws; float* out; const float* b_gate; int l;
    static DEVI u32x4 pack8(const f32x4& a, const f32x4& b, float s) {
        u32x4 w; w.x = pk2(a[0] * s, a[1] * s); w.y = pk2(a[2] * s, a[3] * s); w.z = pk2(b[0] * s, b[1] * s); w.w = pk2(b[2] * s, b[3] * s); return w;
    }
    DEVI void operator()(const f32x4 (&acc)[2][2][4][2], const Unit& u, int wr, int wc, int fr_, int fq_) const {
        int fr = fr_, fq = fq_; asm volatile("" : "+v"(fr), "+v"(fq));
        unsigned char* ws = this->ws; float* out = this->out; const float* b_gate = this->b_gate;
        asm volatile("" : "+s"(ws), "+s"(out), "+s"(b_gate));
        const bool ctx = u.pm * BM < NCTX;
#pragma unroll
        for (int bj = 0; bj < 2; ++bj) {
            const int n0 = u.pn * BM + bj * HALF;
            const int c8 = n0 + wc * 32 + 8 * fq;
            f32x4 bg0 = (f32x4){0.f, 0.f, 0.f, 0.f}, bg1 = bg0;
            if (n0 >= 2816) { bg0 = *(const f32x4*)(b_gate + l * 3072 + c8 - 2816); bg1 = *(const f32x4*)(b_gate + l * 3072 + c8 - 2816 + 4); }
#pragma unroll
            for (int ai = 0; ai < 2; ++ai)
#pragma unroll
                for (int m = 0; m < 4; ++m) {
                    const int row = u.pm * BM + ai * HALF + wr * 64 + m * 16 + fr;
                    const f32x4 v0 = acc[ai][bj][m][0], v1 = acc[ai][bj][m][1];
                    if (n0 < 512) {
                        *(u32x4*)((bf16_t*)(ws + WS_UF) + (size_t)row * 512 + c8) = pack8(v0, v1, 1.f);
                    } else if (n0 < 896) {
                        *(u32x4*)((bf16_t*)(ws + WS_UQ) + (size_t)row * 384 + (c8 - 512)) = pack8(v0, v1, 1.f);
                    } else if (n0 < 1152) {
                        float* o = (float*)(ws + WS_UKV) + (size_t)row * 256 + (c8 - 896);
                        *(f32x4*)o = v0; *(f32x4*)(o + 4) = v1;
                    } else if (n0 < 1280) {
                        if (wc == 0) { float* o = (float*)(ws + WS_KRF) + (size_t)row * 32 + 8 * fq; *(f32x4*)o = v0; *(f32x4*)(o + 4) = v1; }
                    } else if (n0 < 1792) {
                        *(u32x4*)((bf16_t*)(ws + WS_NAQ) + (size_t)row * 512 + (c8 - 1280)) = pack8(v0, v1, NA_QS);
                    } else if (n0 < 2304) {
                        const int cc = c8 - 1792;
                        *(u32x4*)((bf16_t*)(ws + WS_NAK) + (size_t)row * 512 + cc) = pack8(v0, v1, 1.f);
                        if (ctx) { float* o = out + OUT_NAK + ((size_t)((row >> 8) * 4 + l) * 256 + (row & 255)) * 512 + cc; *(f32x4*)o = v0; *(f32x4*)(o + 4) = v1; }
                    } else if (n0 < 2816) {
                        const int cc = c8 - 2304, h = cc >> 6, d0 = cc & 63;
                        bf16_t* VT = (bf16_t*)(ws + WS_NAVT);
                        bf16_t* vp;
                        size_t cstride;
                        if (ctx) {
                            const int b = row >> 8, s = row & 255;
                            float* o = out + OUT_NAV + ((size_t)(b * 4 + l) * 256 + s) * 512 + cc; *(f32x4*)o = v0; *(f32x4*)(o + 4) = v1;
                            vp = VT + ((size_t)((b * 8 + h) * 64 + d0)) * 256 + s; cstride = 256;
                        } else {
                            const int rr = row - NCTX, b = rr >> 11, n = rr & 2047;
                            vp = VT + (size_t)4194304 + ((size_t)((b * 8 + h) * 64 + d0)) * 2048 + n; cstride = 2048;
                        }
#pragma unroll
                        for (int e = 0; e < 4; ++e) { vp[(size_t)e * cstride] = f2bf(v0[e]); vp[(size_t)(4 + e) * cstride] = f2bf(v1[e]); }
                    } else {
                        f32x4 g0, g1;
#pragma unroll
                        for (int e = 0; e < 4; ++e) { g0[e] = sigmoidf_(v0[e] + bg0[e]); g1[e] = sigmoidf_(v1[e] + bg1[e]); }
                        *(u32x4*)((bf16_t*)(ws + WS_GATE) + (size_t)row * 3072 + (c8 - 2816)) = pack8(g0, g1, 1.f);
                    }
                    __builtin_amdgcn_sched_barrier(0);
                }
        }
    }
};
struct EpiMerge {
    static constexpr bool PERM = true;
    const bf16_t* GATE; bf16_t* T; bf16_t* MG; int s;
    DEVI void operator()(const f32x4 (&acc)[2][2][4][2], const Unit& u, int wr, int wc, int fr_, int fq_) const {
        int fr = fr_, fq = fq_; asm volatile("" : "+v"(fr), "+v"(fq));
#pragma unroll
        for (int ah = 0; ah < 4; ++ah) {
            const int ai = ah >> 1, mb = (ah & 1) * 2;
            u32x4 gv[4][2], tv[4][2];
#pragma unroll
            for (int m = mb; m < mb + 2; ++m)
#pragma unroll
                for (int bj = 0; bj < 2; ++bj) {
                    const int row = u.pm * BM + ai * HALF + wr * 64 + m * 16 + fr;
                    const int c8 = u.pn * BM + bj * HALF + wc * 32 + 8 * fq;
                    gv[m][bj] = *(const u32x4*)(GATE + (size_t)row * 3072 + s * 1024 + c8);
                    if (s > 0) tv[m][bj] = *(const u32x4*)(T + (size_t)row * D + c8);
                }
            __builtin_amdgcn_sched_barrier(0);
#pragma unroll
            for (int m = mb; m < mb + 2; ++m)
#pragma unroll
                for (int bj = 0; bj < 2; ++bj) {
                    const int row = u.pm * BM + ai * HALF + wr * 64 + m * 16 + fr;
                    const int c8 = u.pn * BM + bj * HALF + wc * 32 + 8 * fq;
                    const u32x4 g = gv[m][bj];
                    f32x4 v0 = acc[ai][bj][m][0], v1 = acc[ai][bj][m][1];
                    v0[0] *= bf2f(g.x & 0xffffu); v0[1] *= bf2f(g.x >> 16); v0[2] *= bf2f(g.y & 0xffffu); v0[3] *= bf2f(g.y >> 16);
                    v1[0] *= bf2f(g.z & 0xffffu); v1[1] *= bf2f(g.z >> 16); v1[2] *= bf2f(g.w & 0xffffu); v1[3] *= bf2f(g.w >> 16);
                    if (s > 0) {
                        const u32x4 t = tv[m][bj];
                        v0[0] += bf2f(t.x & 0xffffu); v0[1] += bf2f(t.x >> 16); v0[2] += bf2f(t.y & 0xffffu); v0[3] += bf2f(t.y >> 16);
                        v1[0] += bf2f(t.z & 0xffffu); v1[1] += bf2f(t.z >> 16); v1[2] += bf2f(t.w & 0xffffu); v1[3] += bf2f(t.w >> 16);
                    }
                    *(u32x4*)((s < 2 ? T : MG) + (size_t)row * D + c8) = EpiIn::pack8(v0, v1, 1.f);
                }
            __builtin_amdgcn_sched_barrier(0);
        }
    }
};
}

DEVI void job_ffn_up(const P& p, unsigned char* ws_b, int l, int which, int t, bf16_t* sm, int tid) {
    const int nN = 44; const int m0 = (t / nN) * 128, n0 = (t % nN) * 128;
    const bf16_t* H = (const bf16_t*)(ws_b + WS_H);
    const bf16_t* W = (const bf16_t*)(ws_b + WS_W) + (size_t)l * LAYER_W + (which ? OFF_W13_2 : OFF_W13_1);
    bf16_t* ACT = (bf16_t*)(ws_b + WS_ACT);
    f32x16 acc[2][2]; zero_acc(acc);
    gemm_core(H + (size_t)m0 * D, D, W + (size_t)n0 * D, D, D, acc, sm, tid);
    EPI_SETUP
    const int oc = (n0 >> 1) + wc * 32 + c32;
#pragma unroll
    for (int i = 0; i < 2; ++i) {
        const int rb = m0 + wr * 64 + i * 32 + 4 * hl;
#pragma unroll
        for (int r = 0; r < 16; ++r) {
            const int row = rb + (r & 3) + 8 * (r >> 2);
            const float a = acc[i][0][r], b = acc[i][1][r];
            const float v = a * sigmoidf_(a) * b;
            ACT[(size_t)row * DFF + oc] = f2bf(v);
        }
    }
}

DEVI void job_resid(const P& p, unsigned char* ws_b, const bf16_t* A, int lda, const bf16_t* Bt, int K, const float* gate_base, float coef, int t, bf16_t* sm, int tid) {
    const int nN = 8; const int m0 = (t / nN) * 128, n0 = (t % nN) * 128;
    float* X = (float*)(ws_b + WS_X);
    f32x16 acc[2][2]; zero_acc(acc);
    gemm_core(A + (size_t)m0 * lda, lda, Bt + (size_t)n0 * K, K, K, acc, sm, tid);
    EPI_SETUP
    const float* gate = gate_base + (size_t)mod_group(m0) * 9216;
#pragma unroll
    for (int j = 0; j < 2; ++j) {
        const int col = n0 + wc * 64 + j * 32 + c32;
        const float gv = coef * gate[col];
#pragma unroll
        for (int i = 0; i < 2; ++i) {
            const int rb = m0 + wr * 64 + i * 32 + 4 * hl;
#pragma unroll
            for (int r = 0; r < 16; ++r) {
                const int row = rb + (r & 3) + 8 * (r >> 2);
                float* xp = X + (size_t)row * D + col;
                *xp = ALPHA_F * (*xp) + gv * acc[i][j][r];
            }
        }
    }
}

DEVI void job_in(const P& p, unsigned char* ws_b, int l, int t, bf16_t* sm, int tid) {
    const int nN = 46; const int m0 = (t / nN) * 128, n0 = (t % nN) * 128;
    const bf16_t* H = (const bf16_t*)(ws_b + WS_H);
    const bf16_t* W = (const bf16_t*)(ws_b + WS_W) + (size_t)l * LAYER_W + OFF_WIN;
    f32x16 acc[2][2]; zero_acc(acc);
    gemm_core(H + (size_t)m0 * D, D, W + (size_t)n0 * D, D, D, acc, sm, tid);
    EPI_SETUP
    const bool ctx = m0 < NCTX;
#pragma unroll
    for (int j = 0; j < 2; ++j) {
        const int col = n0 + wc * 64 + j * 32 + c32;
#pragma unroll
        for (int i = 0; i < 2; ++i) {
            const int rb = m0 + wr * 64 + i * 32 + 4 * hl;
            if (n0 < 512) {
                bf16_t* O = (bf16_t*)(ws_b + WS_UF);
#pragma unroll
                for (int r = 0; r < 16; ++r) O[(size_t)(rb + (r & 3) + 8 * (r >> 2)) * 512 + col] = f2bf(acc[i][j][r]);
            } else if (n0 < 896) {
                bf16_t* O = (bf16_t*)(ws_b + WS_UQ);
#pragma unroll
                for (int r = 0; r < 16; ++r) O[(size_t)(rb + (r & 3) + 8 * (r >> 2)) * 384 + (col - 512)] = f2bf(acc[i][j][r]);
            } else if (n0 < 1152) {
                float* O = (float*)(ws_b + WS_UKV);
#pragma unroll
                for (int r = 0; r < 16; ++r) O[(size_t)(rb + (r & 3) + 8 * (r >> 2)) * 256 + (col - 896)] = acc[i][j][r];
            } else if (n0 < 1280) {
                if (col < 1184) {
                    float* O = (float*)(ws_b + WS_KRF);
#pragma unroll
                    for (int r = 0; r < 16; ++r) O[(size_t)(rb + (r & 3) + 8 * (r >> 2)) * 32 + (col - 1152)] = acc[i][j][r];
                }
            } else if (n0 < 1792) {
                bf16_t* O = (bf16_t*)(ws_b + WS_NAQ);
#pragma unroll
                for (int r = 0; r < 16; ++r) O[(size_t)(rb + (r & 3) + 8 * (r >> 2)) * 512 + (col - 1280)] = f2bf(acc[i][j][r] * NA_QS);
            } else if (n0 < 2304) {
                bf16_t* O = (bf16_t*)(ws_b + WS_NAK);
                const int cc = col - 1792;
#pragma unroll
                for (int r = 0; r < 16; ++r) {
                    const int row = rb + (r & 3) + 8 * (r >> 2);
                    O[(size_t)row * 512 + cc] = f2bf(acc[i][j][r]);
                    if (ctx) p.out[OUT_NAK + ((size_t)((row >> 8) * 4 + l) * 256 + (row & 255)) * 512 + cc] = acc[i][j][r];
                }
            } else if (n0 < 2816) {
                bf16_t* VT = (bf16_t*)(ws_b + WS_NAVT);
                const int cc = col - 2304, h = cc >> 6, d = cc & 63;
#pragma unroll
                for (int qd = 0; qd < 4; ++qd) {
                    const int row = rb + 8 * qd;
                    u32x2 pk; pk.x = pk2(acc[i][j][4 * qd], acc[i][j][4 * qd + 1]); pk.y = pk2(acc[i][j][4 * qd + 2], acc[i][j][4 * qd + 3]);
                    if (ctx) {
                        const int b = row >> 8, s = row & 255;
                        *(u32x2*)(VT + ((size_t)((b * 8 + h) * 64 + d)) * 256 + s) = pk;
#pragma unroll
                        for (int e = 0; e < 4; ++e)
                            p.out[OUT_NAV + ((size_t)(b * 4 + l) * 256 + (s + e)) * 512 + cc] = acc[i][j][4 * qd + e];
                    } else {
                        const int rr = row - NCTX, b = rr >> 11, n = rr & 2047;
                        *(u32x2*)(VT + (size_t)4194304 + ((size_t)((b * 8 + h) * 64 + d)) * 2048 + n) = pk;
                    }
                }
            } else {
                bf16_t* O = (bf16_t*)(ws_b + WS_GATE);
                const int gc = col - 2816;
                const float bg = pin(p, 26)[l * 3072 + gc];
                bf16_t* gp = O + (size_t)gc * M + rb;
#pragma unroll
                for (int qd = 0; qd < 4; ++qd) {
                    u32x2 pk;
                    pk.x = pk2(sigmoidf_(acc[i][j][4 * qd] + bg), sigmoidf_(acc[i][j][4 * qd + 1] + bg));
                    pk.y = pk2(sigmoidf_(acc[i][j][4 * qd + 2] + bg), sigmoidf_(acc[i][j][4 * qd + 3] + bg));
                    *(u32x2*)(gp + 8 * qd) = pk;
                }
            }
        }
    }
}

DEVI void job_uq(const P& p, unsigned char* ws_b, int l, int t, bf16_t* sm, int tid) {
    const int nN = 6; const int m0 = (t / nN) * 128, n0 = (t % nN) * 128;
    const bf16_t* A = (const bf16_t*)(ws_b + WS_UQ);
    const bf16_t* W = (const bf16_t*)(ws_b + WS_W) + (size_t)l * LAYER_W + OFF_WUQ;
    bf16_t* Q = (bf16_t*)(ws_b + WS_Q);
    const float* ropec = (const float*)(ws_b + WS_ROPE);
    const float* ropes = ropec + 512;
    f32x16 acc[2][2]; zero_acc(acc);
    gemm_core(A + (size_t)m0 * 384, 384, W + (size_t)n0 * 384, 384, 384, acc, sm, tid);
    EPI_SETUP
    const bool lat = m0 >= NCTX;
#pragma unroll
    for (int j = 0; j < 2; ++j) {
        const int c0 = n0 + wc * 64 + j * 32;
        const int col = c0 + c32;
        const bool rope = lat && (((c0 >> 5) % 3) == 2);
        const int axis = c32 >> 4, ii = c32 & 15;
#pragma unroll
        for (int i = 0; i < 2; ++i) {
            const int rb = m0 + wr * 64 + i * 32 + 4 * hl;
#pragma unroll
            for (int r = 0; r < 16; ++r) {
                const int row = rb + (r & 3) + 8 * (r >> 2);
                float v = acc[i][j][r];
                const float pr = __shfl_xor(v, 8);
                if (rope) {
                    const int n = (row - NCTX) & 2047;
                    const int pos = axis ? (n & 63) : (n >> 6);
                    const float cs = ropec[pos * 8 + (ii & 7)], sn = ropes[pos * 8 + (ii & 7)];
                    const float rot = (ii < 8) ? -pr : pr;
                    v = v * cs + rot * sn;
                }
                Q[(size_t)row * 768 + col] = f2bf(v * MLA_QS);
            }
        }
    }
}

DEVI void job_ukv(const P& p, unsigned char* ws_b, int l, int t, bf16_t* sm, int tid) {
    const int nN = 8; const int m0 = (t / nN) * 128, h = t % nN, n0 = h * 128;
    const bf16_t* A = (m0 < M) ? (const bf16_t*)(ws_b + WS_CKV) + (size_t)m0 * 256
                               : (const bf16_t*)(ws_b + WS_CCKV) + ((size_t)l * 1024 + (m0 - M)) * 256;
    const bf16_t* W = (const bf16_t*)(ws_b + WS_W) + (size_t)l * LAYER_W + OFF_WUKV;
    bf16_t* KN = (bf16_t*)(ws_b + WS_KN);
    bf16_t* VT = (bf16_t*)(ws_b + WS_VTM);
    f32x16 acc[2][2]; zero_acc(acc);
    gemm_core(A, 256, W + (size_t)n0 * 256, 256, 256, acc, sm, tid);
    EPI_SETUP
#pragma unroll
    for (int j = 0; j < 2; ++j) {
        const int d = j * 32 + c32;
#pragma unroll
        for (int i = 0; i < 2; ++i) {
            const int rb = m0 + wr * 64 + i * 32 + 4 * hl;
            if (wc == 0) {
#pragma unroll
                for (int r = 0; r < 16; ++r) KN[(size_t)(rb + (r & 3) + 8 * (r >> 2)) * 512 + h * 64 + d] = f2bf(acc[i][j][r]);
            } else {
#pragma unroll
                for (int qd = 0; qd < 4; ++qd) {
                    const int row = rb + 8 * qd;
                    u32x2 pk; pk.x = pk2(acc[i][j][4 * qd], acc[i][j][4 * qd + 1]); pk.y = pk2(acc[i][j][4 * qd + 2], acc[i][j][4 * qd + 3]);
                    size_t addr;
                    if (m0 < NCTX) { const int b = row >> 8, s = row & 255; addr = ((size_t)((b * 8 + h) * 64 + d)) * 256 + s; }
                    else if (m0 < M) { const int rr = row - NCTX, b = rr >> 11, n = rr & 2047; addr = (size_t)4194304 + ((size_t)((b * 8 + h) * 64 + d)) * 2560 + n; }
                    else { const int rr = row - M, b = rr >> 9, n = rr & 511; addr = (size_t)4194304 + ((size_t)((b * 8 + h) * 64 + d)) * 2560 + 2048 + n; }
                    *(u32x2*)(VT + addr) = pk;
                }
            }
        }
    }
}

template <int ldo, bool SPLITK = false>
DEVI void job_store(const bf16_t* A, int lda, const bf16_t* Bt, int ldb, int K, bf16_t* Out, bf16_t* sm, int tid, int grp = 0, float* xch = nullptr) {
    f32x16 acc[2][2]; zero_acc(acc);
    if constexpr (SPLITK) { K >>= 1; A += grp * K; Bt += grp * K; }
    gemm_core(A, lda, Bt, ldb, K, acc, sm, tid);
    EPI_SETUP
    if constexpr (SPLITK) {
        if (grp == 1) {
#pragma unroll
            for (int i = 0; i < 2; ++i)
#pragma unroll
                for (int j = 0; j < 2; ++j)
#pragma unroll
                    for (int r = 0; r < 16; ++r) xch[((i * 2 + j) * 16 + r) * 256 + tid] = acc[i][j][r];
        }
        __syncthreads();
        if (grp == 0) {
#pragma unroll
            for (int i = 0; i < 2; ++i)
#pragma unroll
                for (int j = 0; j < 2; ++j)
#pragma unroll
                    for (int r = 0; r < 16; ++r) acc[i][j][r] += xch[((i * 2 + j) * 16 + r) * 256 + tid];
        }
        __syncthreads();
    }
    const bool active = !SPLITK || grp == 0;
    bf16_t* st = sm + (wr * 64 + 4 * hl) * 136 + wc * 64 + c32;
    if (active) {
#pragma unroll
        for (int i = 0; i < 2; ++i)
#pragma unroll
            for (int j = 0; j < 2; ++j)
#pragma unroll
                for (int r = 0; r < 16; ++r) st[(i * 32 + (r & 3) + 8 * (r >> 2)) * 136 + j * 32] = f2bf(acc[i][j][r]);
    }
    __syncthreads();
    if (active) {
        const int orow = tid >> 4, oc = (tid & 15) * 8;
#pragma unroll
        for (int k = 0; k < 8; ++k) {
            const u32x4 v = *(const u32x4*)(sm + (orow + 16 * k) * 136 + oc);
            *(u32x4*)(Out + (size_t)(orow + 16 * k) * ldo + oc) = v;
        }
    }
    __syncthreads();
}

DEVI void job_f1(const P& p, unsigned char* ws_b, int t, bf16_t* sm, int tid) {
    const bf16_t* WCS = (const bf16_t*)(ws_b + WS_WCS);
    const bf16_t* UF = (const bf16_t*)(ws_b + WS_UF);
    bf16_t* F1T = (bf16_t*)(ws_b + WS_F1T);
    if (t < 512) {
        const int bs = t >> 4, g = (t >> 2) & 3, mi = (t >> 1) & 1, ni = t & 1;
        job_store<256>(WCS + mi * 128 * 128, 128, UF + ((size_t)bs * 256 + ni * 128) * 512 + g * 128, 512, 128,
                  F1T + ((size_t)(bs * 4 + g) * 256 + mi * 128) * 256 + ni * 128, sm, tid);
    } else {
        t -= 512;
        const int bs = t >> 7, g = (t >> 5) & 3, mi = (t >> 4) & 1, ni = t & 15;
        job_store<2048>(WCS + mi * 128 * 128, 128, UF + ((size_t)NCTX + bs * 2048 + ni * 128) * 512 + g * 128, 512, 128,
                  F1T + (size_t)8388608 + ((size_t)(bs * 4 + g) * 256 + mi * 128) * 2048 + ni * 128, sm, tid);
    }
}
DEVI void job_f2_lat(const P& p, unsigned char* ws_b, int t, bf16_t* sm, int tid, int grp, float* xch) {
    const int bs = t >> 6, mi = (t >> 2) & 15, ni = t & 3;
    const bf16_t* TAB = (const bf16_t*)(ws_b + WS_TABL);
    const bf16_t* F1T = (const bf16_t*)(ws_b + WS_F1T) + (size_t)8388608;
    bf16_t* YF = (bf16_t*)(ws_b + WS_YF);
    job_store<512, true>(TAB + (size_t)mi * 128 * 4096, 4096, F1T + (size_t)bs * 512 * 4096 + (size_t)ni * 128 * 4096, 4096, 4096,
              YF + ((size_t)NCTX + bs * 2048 + mi * 128) * 512 + ni * 128, sm, tid, grp, xch);
}
DEVI void job_f2_ctx(const P& p, unsigned char* ws_b, int t, bf16_t* sm, int tid) {
    const int bs = t >> 3, mi = (t >> 2) & 1, ni = t & 3;
    const bf16_t* TAB = (const bf16_t*)(ws_b + WS_TABC);
    const bf16_t* F1T = (const bf16_t*)(ws_b + WS_F1T);
    bf16_t* YF = (bf16_t*)(ws_b + WS_YF);
    job_store<512>(TAB + (size_t)mi * 128 * 512, 512, F1T + (size_t)bs * 512 * 512 + (size_t)ni * 128 * 512, 512, 512,
              YF + ((size_t)bs * 256 + mi * 128) * 512 + ni * 128, sm, tid);
}

DEVI void job_merge(const P& p, unsigned char* ws_b, int l, int t, bf16_t* sm, int tid) {
    const int nN = 8; const int m0 = (t / nN) * 128, n0 = (t % nN) * 128;
    const bf16_t* Wl = (const bf16_t*)(ws_b + WS_W) + (size_t)l * LAYER_W;
    const bf16_t* GATE = (const bf16_t*)(ws_b + WS_GATE);
    bf16_t* MG = (bf16_t*)(ws_b + WS_MERGED);
    EPI_SETUP
    f32x16 acc[2][2]; zero_acc(acc);
#pragma unroll 1
    for (int s = 0; s < 3; ++s) {
        const bf16_t* A = (const bf16_t*)(ws_b + (s == 0 ? WS_YF : (s == 1 ? WS_YM : WS_YN)));
        const bf16_t* W = Wl + (s == 0 ? OFF_WBF : (s == 1 ? OFF_WBM : OFF_WBN));
        gemm_core<false>(A + (size_t)m0 * 512, 512, W + (size_t)n0 * 512, 512, 512, acc, sm, tid);
        {
            const int gr = tid >> 4, gc = (tid & 15) * 8;
            const int s1 = s < 2 ? s + 1 : s;
#pragma unroll
            for (int k = 0; k < 8; ++k) {
                const bf16_t* gsrc = GATE + (size_t)(m0 + gr + 16 * k) * 3072 + n0 + gc;
                *(u32x4*)(sm + (gr + 16 * k) * 136 + gc) = *(const u32x4*)(gsrc + s * 1024);
                *(u32x4*)(sm + 128 * 136 + (gr + 16 * k) * 136 + gc) = *(const u32x4*)(gsrc + s1 * 1024);
                if ((k & 1) == 1) __builtin_amdgcn_sched_barrier(0);
            }
        }
        __syncthreads();
#pragma unroll
        for (int j = 0; j < 2; ++j)
#pragma unroll
            for (int i = 0; i < 2; ++i) {
                const bf16_t* gp = sm + (wr * 64 + i * 32 + 4 * hl) * 136 + wc * 64 + j * 32 + c32;
#pragma unroll
                for (int r = 0; r < 16; ++r) {
                    const int o = ((r & 3) + 8 * (r >> 2)) * 136;
                    const float g = bf2f(gp[o]);
                    const float f = (s < 2) ? g * __builtin_amdgcn_rcpf(bf2f(gp[128 * 136 + o])) : g;
                    acc[i][j][r] *= f;
                }
            }
        __syncthreads();
    }
#pragma unroll
    for (int j = 0; j < 2; ++j) {
        const int col = n0 + wc * 64 + j * 32 + c32;
#pragma unroll
        for (int i = 0; i < 2; ++i) {
            const int rb = m0 + wr * 64 + i * 32 + 4 * hl;
#pragma unroll
            for (int r = 0; r < 16; ++r) MG[(size_t)(rb + (r & 3) + 8 * (r >> 2)) * 1024 + col] = f2bf(acc[i][j][r]);
        }
    }
}

struct TileSrc { const bf16_t* k; const bf16_t* k2; const bf16_t* v; const bf16_t* vhi; };
DEVI int pi_row(int r) { return (r & 0x13) | ((r & 4) << 1) | ((r & 8) >> 1); }

template <int NKS>
DEVI void attn_load(const TileSrc& s, bf16x8 (&kf)[NKS], bf16x8 (&vf)[4]) {
#pragma unroll
    for (int ks = 0; ks < NKS; ++ks) kf[ks] = (ks < 4) ? *(const bf16x8*)(s.k + ks * 16) : *(const bf16x8*)(s.k2 + (ks - 4) * 16);
    vf[0] = *(const bf16x8*)(s.v);
    vf[1] = *(const bf16x8*)(s.v + 16);
    vf[2] = *(const bf16x8*)(s.vhi);
    vf[3] = *(const bf16x8*)(s.vhi + 16);
}

template <int NKS, bool SPLIT, class Src, class Mask>
DEVI void attn_wave(const bf16_t* qptr, int t0, int nt, Src src, Mask mask, bf16_t* optr, int lane, float* ex = nullptr, int half = 0) {
    bf16x8 q[NKS];
#pragma unroll
    for (int ks = 0; ks < NKS; ++ks) q[ks] = *(const bf16x8*)(qptr + ks * 16);
    f32x16 o0, o1;
#pragma unroll
    for (int r = 0; r < 16; ++r) { o0[r] = 0.f; o1[r] = 0.f; }
    float m = -1e30f, lsum = 0.f;
    bf16x8 kf[NKS], vf[4];
    nt += t0;
    { TileSrc s0 = src(t0); attn_load<NKS>(s0, kf, vf); }
    for (int t = t0; t < nt; ++t) {
        bf16x8 kn[NKS], vn[4];
        { TileSrc s1 = src(t + 1 < nt ? t + 1 : t); attn_load<NKS>(s1, kn, vn); }
        f32x16 s;
#pragma unroll
        for (int r = 0; r < 16; ++r) s[r] = 0.f;
#pragma unroll
        for (int ks = 0; ks < NKS; ++ks) s = __builtin_amdgcn_mfma_f32_32x32x16_bf16(kf[ks], q[ks], s, 0, 0, 0);
        mask(t, s);
        float mx = s[0];
#pragma unroll
        for (int r = 1; r < 16; ++r) mx = fmaxf(mx, s[r]);
        mx = fmaxf(mx, __shfl_xor(mx, 32));
        const float mn = fmaxf(m, mx);
        const float alpha = fast_exp2(m - mn);
        m = mn;
        float rs = 0.f;
#pragma unroll
        for (int r = 0; r < 16; ++r) { s[r] = fast_exp2(s[r] - mn); rs += s[r]; }
        lsum = lsum * alpha + rs;
#pragma unroll
        for (int r = 0; r < 16; ++r) { o0[r] *= alpha; o1[r] *= alpha; }
        bf16x8 p0, p1;
        {
            u32x4 a, b;
            a.x = pk2(s[0], s[1]); a.y = pk2(s[2], s[3]); a.z = pk2(s[4], s[5]); a.w = pk2(s[6], s[7]);
            b.x = pk2(s[8], s[9]); b.y = pk2(s[10], s[11]); b.z = pk2(s[12], s[13]); b.w = pk2(s[14], s[15]);
            p0 = __builtin_bit_cast(bf16x8, a); p1 = __builtin_bit_cast(bf16x8, b);
        }
        o0 = __builtin_amdgcn_mfma_f32_32x32x16_bf16(vf[0], p0, o0, 0, 0, 0);
        o0 = __builtin_amdgcn_mfma_f32_32x32x16_bf16(vf[1], p1, o0, 0, 0, 0);
        o1 = __builtin_amdgcn_mfma_f32_32x32x16_bf16(vf[2], p0, o1, 0, 0, 0);
        o1 = __builtin_amdgcn_mfma_f32_32x32x16_bf16(vf[3], p1, o1, 0, 0, 0);
#pragma unroll
        for (int ks = 0; ks < NKS; ++ks) kf[ks] = kn[ks];
#pragma unroll
        for (int x = 0; x < 4; ++x) vf[x] = vn[x];
    }
    if constexpr (SPLIT) {
        if (half == 1) {
#pragma unroll
            for (int r = 0; r < 16; ++r) { ex[r * 64 + lane] = o0[r]; ex[(16 + r) * 64 + lane] = o1[r]; }
            ex[32 * 64 + lane] = m; ex[33 * 64 + lane] = lsum;
        }
        __syncthreads();
        if (half == 0) {
            const float m2 = ex[32 * 64 + lane], l2 = ex[33 * 64 + lane];
            const float mn = fmaxf(m, m2), a1 = fast_exp2(m - mn), a2 = fast_exp2(m2 - mn);
            lsum = lsum * a1 + l2 * a2;
#pragma unroll
            for (int r = 0; r < 16; ++r) { o0[r] = o0[r] * a1 + ex[r * 64 + lane] * a2; o1[r] = o1[r] * a1 + ex[(16 + r) * 64 + lane] * a2; }
        }
        __syncthreads();
        if (half == 1) return;
    }
    lsum += __shfl_xor(lsum, 32);
    const float inv = 1.f / lsum;
    const int hl = lane >> 5;
#pragma unroll
    for (int qd = 0; qd < 4; ++qd) {
        u32x2 a, b;
        a.x = pk2(o0[4 * qd] * inv, o0[4 * qd + 1] * inv); a.y = pk2(o0[4 * qd + 2] * inv, o0[4 * qd + 3] * inv);
        b.x = pk2(o1[4 * qd] * inv, o1[4 * qd + 1] * inv); b.y = pk2(o1[4 * qd + 2] * inv, o1[4 * qd + 3] * inv);
        *(u32x2*)(optr + 8 * qd + 4 * hl) = a;
        *(u32x2*)(optr + 32 + 8 * qd + 4 * hl) = b;
    }
}

struct NoMask { DEVI void operator()(int, f32x16&) const {} };

DEVI void attn_mla(const P& p, unsigned char* ws_b, int l, bool lat, int b, int h, int qg, int lane, float* ex = nullptr, int half = 0) {
    const int hl = lane >> 5, c32 = lane & 31, pr = pi_row(c32);
    const bf16_t* Q = (const bf16_t*)(ws_b + WS_Q);
    const bf16_t* KN = (const bf16_t*)(ws_b + WS_KN);
    const bf16_t* KR = (const bf16_t*)(ws_b + WS_KR);
    const bf16_t* CKR = (const bf16_t*)(ws_b + WS_CKR) + (size_t)l * 1024 * 32;
    const bf16_t* VT = (const bf16_t*)(ws_b + WS_VTM);
    bf16_t* YM = (bf16_t*)(ws_b + WS_YM);
    if (!lat) {
        const int row0 = b * 256;
        const int qrow = row0 + qg * 32 + c32;
        const bf16_t* k0 = KN + (size_t)(row0 + pr) * 512 + h * 64 + hl * 8;
        const bf16_t* r0 = KR + (size_t)(row0 + pr) * 32 + hl * 8;
        const bf16_t* v0 = VT + ((size_t)((b * 8 + h) * 64 + c32)) * 256 + hl * 8;
        auto src = [=](int t) { TileSrc s; s.k = k0 + (size_t)t * 32 * 512; s.k2 = r0 + (size_t)t * 32 * 32; s.v = v0 + t * 32; s.vhi = s.v + 32 * 256; return s; };
        attn_wave<6, false>(Q + (size_t)qrow * 768 + h * 96 + hl * 8, 0, 8, src, NoMask(), YM + (size_t)qrow * 512 + h * 64, lane);
    } else {
        const int row0 = NCTX + b * 2048;
        const int qrow = row0 + qg * 32 + c32;
        const bf16_t* k0 = KN + (size_t)(row0 + pr) * 512 + h * 64 + hl * 8;
        const bf16_t* r0 = KR + (size_t)(row0 + pr) * 32 + hl * 8;
        const bf16_t* k1 = KN + (size_t)(M + b * 512 + pr) * 512 + h * 64 + hl * 8;
        const bf16_t* r1 = CKR + (size_t)(b * 512 + pr) * 32 + hl * 8;
        const bf16_t* v0 = VT + (size_t)4194304 + ((size_t)((b * 8 + h) * 64 + c32)) * 2560 + hl * 8;
        auto src = [=](int t) {
            TileSrc s;
            if (t < 64) { s.k = k0 + (size_t)t * 32 * 512; s.k2 = r0 + (size_t)t * 32 * 32; }
            else { s.k = k1 + (size_t)(t - 64) * 32 * 512; s.k2 = r1 + (size_t)(t - 64) * 32 * 32; }
            s.v = v0 + t * 32; s.vhi = s.v + 32 * 2560; return s; };
        attn_wave<6, true>(Q + (size_t)qrow * 768 + h * 96 + hl * 8, half * 40, 40, src, NoMask(), YM + (size_t)qrow * 512 + h * 64, lane, ex, half);
    }
}

template <int NKS, class Mask>
DEVI void attn_step(const bf16x8 (&kf)[NKS], const bf16x8 (&vf)[4], const bf16x8 (&q)[NKS], f32x16& o0, f32x16& o1, float& m, float& lsum, const Mask& mask, int t) {
    f32x16 s;
#pragma unroll
    for (int r = 0; r < 16; ++r) s[r] = 0.f;
#pragma unroll
    for (int ks = 0; ks < NKS; ++ks) s = __builtin_amdgcn_mfma_f32_32x32x16_bf16(kf[ks], q[ks], s, 0, 0, 0);
    mask(t, s);
    float mx = s[0];
#pragma unroll
    for (int r = 1; r < 16; ++r) mx = fmaxf(mx, s[r]);
    mx = fmaxf(mx, __shfl_xor(mx, 32));
    const float mn = fmaxf(m, mx);
    const float alpha = fast_exp2(m - mn);
    m = mn;
    float rs = 0.f;
#pragma unroll
    for (int r = 0; r < 16; ++r) { s[r] = fast_exp2(s[r] - mn); rs += s[r]; }
    lsum = lsum * alpha + rs;
#pragma unroll
    for (int r = 0; r < 16; ++r) { o0[r] *= alpha; o1[r] *= alpha; }
    bf16x8 p0, p1;
    {
        u32x4 a, b;
        a.x = pk2(s[0], s[1]); a.y = pk2(s[2], s[3]); a.z = pk2(s[4], s[5]); a.w = pk2(s[6], s[7]);
        b.x = pk2(s[8], s[9]); b.y = pk2(s[10], s[11]); b.z = pk2(s[12], s[13]); b.w = pk2(s[14], s[15]);
        p0 = __builtin_bit_cast(bf16x8, a); p1 = __builtin_bit_cast(bf16x8, b);
    }
    o0 = __builtin_amdgcn_mfma_f32_32x32x16_bf16(vf[0], p0, o0, 0, 0, 0);
    o0 = __builtin_amdgcn_mfma_f32_32x32x16_bf16(vf[1], p1, o0, 0, 0, 0);
    o1 = __builtin_amdgcn_mfma_f32_32x32x16_bf16(vf[2], p0, o1, 0, 0, 0);
    o1 = __builtin_amdgcn_mfma_f32_32x32x16_bf16(vf[3], p1, o1, 0, 0, 0);
}
struct MlaStage { u32x4 k, v; u32x2 r; };
DEVI void attn_mla_lat_shared(const P& p, unsigned char* ws_b, int l, int b, int h, int qg, int tid, unsigned char* smem, float* ex) {
    const int lane = tid & 63, wave = tid >> 6, half = wave >> 2, htid = tid & 255;
    const int hl = lane >> 5, c32 = lane & 31, pr = pi_row(c32);
    const bf16_t* Q = (const bf16_t*)(ws_b + WS_Q);
    const bf16_t* KN = (const bf16_t*)(ws_b + WS_KN);
    const bf16_t* KR = (const bf16_t*)(ws_b + WS_KR);
    const bf16_t* CKR = (const bf16_t*)(ws_b + WS_CKR) + (size_t)l * 1024 * 32;
    const bf16_t* VT = (const bf16_t*)(ws_b + WS_VTM) + (size_t)4194304 + (size_t)((b * 8 + h) * 64) * 2560;
    bf16_t* YM = (bf16_t*)(ws_b + WS_YM);
    const int row0 = NCTX + b * 2048;
    const int qrow = row0 + qg * 32 + c32;
    bf16_t* ring = (bf16_t*)(smem + 36864 + half * 36864);
    const int kkey = htid >> 3, kch = (htid & 7) * 8, vd = htid >> 2, vch = (htid & 3) * 8;
    const int rch = (htid & 7) * 4;
    const int tb = half * 40, tend = tb + 40;
    bf16x8 q[6];
    {
        const bf16_t* qptr = Q + (size_t)qrow * 768 + h * 96 + hl * 8;
#pragma unroll
        for (int ks = 0; ks < 6; ++ks) q[ks] = *(const bf16x8*)(qptr + ks * 16);
    }
    f32x16 o0, o1;
#pragma unroll
    for (int r = 0; r < 16; ++r) { o0[r] = 0.f; o1[r] = 0.f; }
    float m = -1e30f, lsum = 0.f;
#define MLA_LD(S, T) do { const int t_ = (T) < tend ? (T) : tend - 1; \
        const int krow_ = t_ < 64 ? row0 + t_ * 32 : M + b * 512 + (t_ - 64) * 32; \
        (S).k = *(const u32x4*)(KN + (size_t)(krow_ + kkey) * 512 + h * 64 + kch); \
        (S).v = *(const u32x4*)(VT + (size_t)vd * 2560 + t_ * 32 + vch); \
        (S).r = *(const u32x2*)((t_ < 64 ? KR + (size_t)(krow_ + kkey) * 32 : CKR + (size_t)(b * 512 + (t_ - 64) * 32 + kkey) * 32) + rch); } while (0)
#define MLA_ST(S, SLOT) do { bf16_t* sl_ = ring + (SLOT) * 6144; \
        *(u32x4*)(sl_ + kkey * 72 + kch) = (S).k; *(u32x4*)(sl_ + 3584 + vd * 40 + vch) = (S).v; \
        *(u32x2*)(sl_ + 2304 + kkey * 40 + rch) = (S).r; } while (0)
#define MLA_COMPUTE(SLOT, T) do { const bf16_t* sl_ = ring + (SLOT) * 6144; bf16x8 kf[6], vf[4]; \
        _Pragma("unroll") for (int ks = 0; ks < 4; ++ks) kf[ks] = *(const bf16x8*)(sl_ + pr * 72 + ks * 16 + hl * 8); \
        kf[4] = *(const bf16x8*)(sl_ + 2304 + pr * 40 + hl * 8); kf[5] = *(const bf16x8*)(sl_ + 2304 + pr * 40 + 16 + hl * 8); \
        vf[0] = *(const bf16x8*)(sl_ + 3584 + c32 * 40 + hl * 8); vf[1] = *(const bf16x8*)(sl_ + 3584 + c32 * 40 + 16 + hl * 8); \
        vf[2] = *(const bf16x8*)(sl_ + 3584 + (c32 + 32) * 40 + hl * 8); vf[3] = *(const bf16x8*)(sl_ + 3584 + (c32 + 32) * 40 + 16 + hl * 8); \
        attn_step<6>(kf, vf, q, o0, o1, m, lsum, NoMask(), (T)); } while (0)
    MlaStage s0, s1, s2;
    MLA_LD(s0, tb); MLA_LD(s1, tb + 1); MLA_LD(s2, tb + 2);
    MLA_ST(s0, 0); MLA_LD(s0, tb + 3);
    __syncthreads();
#pragma unroll 1
    for (int i = tb; i < tend; i += 3) {
        MLA_ST(s1, 1); MLA_LD(s1, i + 4); MLA_COMPUTE(0, i); __syncthreads();
        MLA_ST(s2, 2); MLA_LD(s2, i + 5); if (i + 1 < tend) MLA_COMPUTE(1, i + 1); __syncthreads();
        MLA_ST(s0, 0); MLA_LD(s0, i + 6); if (i + 2 < tend) MLA_COMPUTE(2, i + 2); __syncthreads();
    }
#undef MLA_LD
#undef MLA_ST
#undef MLA_COMPUTE
    if (half == 1) {
#pragma unroll
        for (int r = 0; r < 16; ++r) { ex[r * 64 + lane] = o0[r]; ex[(16 + r) * 64 + lane] = o1[r]; }
        ex[32 * 64 + lane] = m; ex[33 * 64 + lane] = lsum;
    }
    __syncthreads();
    if (half == 0) {
        const float m2 = ex[32 * 64 + lane], l2 = ex[33 * 64 + lane];
        const float mn = fmaxf(m, m2), a1 = fast_exp2(m - mn), a2 = fast_exp2(m2 - mn);
        lsum = lsum * a1 + l2 * a2;
#pragma unroll
        for (int r = 0; r < 16; ++r) { o0[r] = o0[r] * a1 + ex[r * 64 + lane] * a2; o1[r] = o1[r] * a1 + ex[(16 + r) * 64 + lane] * a2; }
    }
    __syncthreads();
    if (half == 1) return;
    lsum += __shfl_xor(lsum, 32);
    const float inv = 1.f / lsum;
    bf16_t* optr = YM + (size_t)qrow * 512 + h * 64;
#pragma unroll
    for (int qd = 0; qd < 4; ++qd) {
        u32x2 a, bb;
        a.x = pk2(o0[4 * qd] * inv, o0[4 * qd + 1] * inv); a.y = pk2(o0[4 * qd + 2] * inv, o0[4 * qd + 3] * inv);
        bb.x = pk2(o1[4 * qd] * inv, o1[4 * qd + 1] * inv); bb.y = pk2(o1[4 * qd + 2] * inv, o1[4 * qd + 3] * inv);
        *(u32x2*)(optr + 8 * qd + 4 * hl) = a;
        *(u32x2*)(optr + 32 + 8 * qd + 4 * hl) = bb;
    }
}

template <int NKS>
DEVI void attn_ctx_shared(const bf16_t* Kg, const bf16_t* KRg, const bf16_t* VTg, const bf16_t* qptr, bf16_t* optr, int tid, unsigned char* smem) {
    const int lane = tid & 63, hl = lane >> 5, c32 = lane & 31, pr = pi_row(c32);
    bf16_t* Ks = (bf16_t*)smem;
    bf16_t* Rs = Ks + 256 * 72;
    bf16_t* Vs = Rs + 256 * 40;
    {
        u32x4 kr[4], vr[4], rr[2];
#pragma unroll
        for (int i = 0; i < 4; ++i) { const int c = tid + 512 * i; kr[i] = *(const u32x4*)(Kg + (size_t)(c >> 3) * 512 + (c & 7) * 8); }
#pragma unroll
        for (int i = 0; i < 4; ++i) { const int c = tid + 512 * i; vr[i] = *(const u32x4*)(VTg + (size_t)(c >> 5) * 256 + (c & 31) * 8); }
        if constexpr (NKS == 6) {
#pragma unroll
            for (int i = 0; i < 2; ++i) { const int c = tid + 512 * i; rr[i] = *(const u32x4*)(KRg + (size_t)(c >> 2) * 32 + (c & 3) * 8); }
        }
#pragma unroll
        for (int i = 0; i < 4; ++i) { const int c = tid + 512 * i; *(u32x4*)(Ks + (c >> 3) * 72 + (c & 7) * 8) = kr[i]; }
#pragma unroll
        for (int i = 0; i < 4; ++i) { const int c = tid + 512 * i; *(u32x4*)(Vs + (c >> 5) * 264 + (c & 31) * 8) = vr[i]; }
        if constexpr (NKS == 6) {
#pragma unroll
            for (int i = 0; i < 2; ++i) { const int c = tid + 512 * i; *(u32x4*)(Rs + (c >> 2) * 40 + (c & 3) * 8) = rr[i]; }
        }
    }
    bf16x8 q[NKS];
#pragma unroll
    for (int ks = 0; ks < NKS; ++ks) q[ks] = *(const bf16x8*)(qptr + ks * 16);
    __syncthreads();
    f32x16 o0, o1;
#pragma unroll
    for (int r = 0; r < 16; ++r) { o0[r] = 0.f; o1[r] = 0.f; }
    float m = -1e30f, lsum = 0.f;
#pragma unroll 1
    for (int t = 0; t < 8; ++t) {
        bf16x8 kf[NKS], vf[4];
        const bf16_t* kp = Ks + (t * 32 + pr) * 72 + hl * 8;
#pragma unroll
        for (int ks = 0; ks < 4; ++ks) kf[ks] = *(const bf16x8*)(kp + ks * 16);
        if constexpr (NKS == 6) {
            const bf16_t* rp = Rs + (t * 32 + pr) * 40 + hl * 8;
            kf[4] = *(const bf16x8*)rp; kf[5] = *(const bf16x8*)(rp + 16);
        }
        const bf16_t* vp = Vs + c32 * 264 + t * 32 + hl * 8;
        vf[0] = *(const bf16x8*)vp; vf[1] = *(const bf16x8*)(vp + 16);
        vf[2] = *(const bf16x8*)(vp + 32 * 264); vf[3] = *(const bf16x8*)(vp + 32 * 264 + 16);
        attn_step<NKS>(kf, vf, q, o0, o1, m, lsum, NoMask(), t);
    }
    lsum += __shfl_xor(lsum, 32);
    const float inv = 1.f / lsum;
#pragma unroll
    for (int qd = 0; qd < 4; ++qd) {
        u32x2 a, bb;
        a.x = pk2(o0[4 * qd] * inv, o0[4 * qd + 1] * inv); a.y = pk2(o0[4 * qd + 2] * inv, o0[4 * qd + 3] * inv);
        bb.x = pk2(o1[4 * qd] * inv, o1[4 * qd + 1] * inv); bb.y = pk2(o1[4 * qd + 2] * inv, o1[4 * qd + 3] * inv);
        *(u32x2*)(optr + 8 * qd + 4 * hl) = a;
        *(u32x2*)(optr + 32 + 8 * qd + 4 * hl) = bb;
    }
    __syncthreads();
}

DEVI void attn_na_ctx(const P& p, unsigned char* ws_b, int b, int h, int qg, int lane) {
    const int hl = lane >> 5, c32 = lane & 31, pr = pi_row(c32);
    const bf16_t* Qn = (const bf16_t*)(ws_b + WS_NAQ);
    const bf16_t* Kn = (const bf16_t*)(ws_b + WS_NAK);
    const bf16_t* VT = (const bf16_t*)(ws_b + WS_NAVT);
    bf16_t* YN = (bf16_t*)(ws_b + WS_YN);
    const int row0 = b * 256, qrow = row0 + qg * 32 + c32;
    const bf16_t* k0 = Kn + (size_t)(row0 + pr) * 512 + h * 64 + hl * 8;
    const bf16_t* v0 = VT + ((size_t)((b * 8 + h) * 64 + c32)) * 256 + hl * 8;
    auto src = [=](int t) { TileSrc s; s.k = k0 + (size_t)t * 32 * 512; s.k2 = s.k; s.v = v0 + t * 32; s.vhi = s.v + 32 * 256; return s; };
    attn_wave<4, false>(Qn + (size_t)qrow * 512 + h * 64 + hl * 8, 0, 8, src, NoMask(), YN + (size_t)qrow * 512 + h * 64, lane);
}

struct NaMask {
    const float* rpb;
    int rs, rq, qc, hl;
    DEVI void operator()(int t, f32x16& s) const {
        if (t >= 16) return;
        const int kr = t >> 1, kh = t & 1;
        const int cs = min(max(qc - 8, 0), 48);
        const float* rp = rpb + (rs + kr - rq + 7) * 31;
#pragma unroll
        for (int r = 0; r < 16; ++r) {
            const int kk = (r & 3) + 4 * ((r >> 2) & 1) + 8 * hl + 16 * (r >> 3);
            const int kc = kh * 32 + kk;
            const bool ok = (kc >= cs) && (kc < cs + 16);
            const int dc = min(max(kc - qc + 15, 0), 30);
            const float bias = rp[dc];
            s[r] = ok ? s[r] + bias : -1e30f;
        }
    }
};
DEVI void attn_na_lat(const P& p, unsigned char* ws_b, int l, int b, int h, int rq, int qh, int lane, float* ex, int half, const float* rpb_lds) {
    const int hl = lane >> 5, c32 = lane & 31, pr = pi_row(c32);
    const bf16_t* Qn = (const bf16_t*)(ws_b + WS_NAQ);
    const bf16_t* Kn = (const bf16_t*)(ws_b + WS_NAK);
    const bf16_t* VT = (const bf16_t*)(ws_b + WS_NAVT) + (size_t)4194304;
    const bf16_t* CK = (const bf16_t*)(ws_b + WS_CNAK) + (size_t)l * 1024 * 512;
    const bf16_t* CV = (const bf16_t*)(ws_b + WS_CNAVT) + (size_t)l * 1024 * 512;
    bf16_t* YN = (bf16_t*)(ws_b + WS_YN);
    const int row0 = NCTX + b * 2048;
    const int qrow = row0 + rq * 64 + qh * 32 + c32;
    const int rs = min(max(rq - 4, 0), 24);
    const bf16_t* k0 = Kn + (size_t)(row0 + rs * 64 + pr) * 512 + h * 64 + hl * 8;
    const bf16_t* v0 = VT + ((size_t)((b * 8 + h) * 64 + c32)) * 2048 + rs * 64 + hl * 8;
    const bf16_t* k1 = CK + (size_t)(b * 512 + pr) * 512 + h * 64 + hl * 8;
    const bf16_t* v1 = CV + ((size_t)((b * 8 + h) * 64 + c32)) * 512 + hl * 8;
    auto src = [=](int t) {
        TileSrc s;
        if (t < 16) { s.k = k0 + (size_t)t * 32 * 512; s.v = v0 + t * 32; s.vhi = s.v + 32 * 2048; }
        else { s.k = k1 + (size_t)(t - 16) * 32 * 512; s.v = v1 + (t - 16) * 32; s.vhi = s.v + 32 * 512; }
        s.k2 = s.k; return s; };
    NaMask mk; mk.rpb = rpb_lds; mk.rs = rs; mk.rq = rq; mk.qc = qh * 32 + c32; mk.hl = hl;
    attn_wave<4, true>(Qn + (size_t)qrow * 512 + h * 64 + hl * 8, half * 16, 16, src, mk, YN + (size_t)qrow * 512 + h * 64, lane, ex, half);
}

DEVI void row_load(const float* src, f32x4 (&v)[4], int lane) {
#pragma unroll
    for (int j = 0; j < 4; ++j) v[j] = *(const f32x4*)(src + 4 * lane + 256 * j);
}
DEVI void row_ln_mod(f32x4 (&v)[4], float* xdst, bf16_t* hdst, const float* lng, const float* lnb, const float* shift, const float* scale, int lane) {
    if (lng) {
        float s = 0.f;
#pragma unroll
        for (int j = 0; j < 4; ++j) s += (v[j].x + v[j].y) + (v[j].z + v[j].w);
        const float mu = wave_sum(s) * (1.f / D);
        float q = 0.f;
#pragma unroll
        for (int j = 0; j < 4; ++j) { v[j] = v[j] - mu; q += (v[j].x * v[j].x + v[j].y * v[j].y) + (v[j].z * v[j].z + v[j].w * v[j].w); }
        const float rstd = rsqrtf(wave_sum(q) * (1.f / D) + 1e-5f);
#pragma unroll
        for (int j = 0; j < 4; ++j) {
            const f32x4 g = *(const f32x4*)(lng + 4 * lane + 256 * j), bb = *(const f32x4*)(lnb + 4 * lane + 256 * j);
            v[j] = v[j] * rstd * g + bb;
        }
    }
    if (xdst) {
#pragma unroll
        for (int j = 0; j < 4; ++j) *(f32x4*)(xdst + 4 * lane + 256 * j) = v[j];
    }
    if (hdst) {
        float s = 0.f;
#pragma unroll
        for (int j = 0; j < 4; ++j) s += (v[j].x + v[j].y) + (v[j].z + v[j].w);
        const float mu = wave_sum(s) * (1.f / D);
        float q = 0.f;
#pragma unroll
        for (int j = 0; j < 4; ++j) { v[j] = v[j] - mu; q += (v[j].x * v[j].x + v[j].y * v[j].y) + (v[j].z * v[j].z + v[j].w * v[j].w); }
        const float rstd = rsqrtf(wave_sum(q) * (1.f / D) + 1e-6f);
#pragma unroll
        for (int j = 0; j < 4; ++j) {
            const f32x4 sc = *(const f32x4*)(scale + 4 * lane + 256 * j), sh = *(const f32x4*)(shift + 4 * lane + 256 * j);
            const f32x4 o = v[j] * rstd * (sc + 1.f) + sh;
            u32x2 pk; pk.x = pk2(o.x, o.y); pk.y = pk2(o.z, o.w);
            *(u32x2*)(hdst + 4 * lane + 256 * j) = pk;
        }
    }
}

DEVI const float* phase_rows_src(const P& p, unsigned char* ws_b, int row, int lnidx) {
    return (lnidx < 0) ? (row < NCTX ? pin(p, 0) + (size_t)row * D : pin(p, 1) + (size_t)(row - NCTX) * D) : (const float*)(ws_b + WS_X) + (size_t)row * D;
}
DEVI void phase_rows_one(const P& p, unsigned char* ws_b, f32x4 (&v)[4], int row, int l, int lnidx, int ml, int ms, bool final_, int lane) {
    float* X = (float*)(ws_b + WS_X);
    bf16_t* H = (bf16_t*)(ws_b + WS_H);
    const float* MOD = (const float*)(ws_b + WS_MOD);
    const float* lng = (lnidx < 0) ? nullptr : pin(p, 28) + (size_t)(l * 3 + lnidx) * D;
    const float* lnb = (lnidx < 0) ? nullptr : pin(p, 29) + (size_t)(l * 3 + lnidx) * D;
    if (final_) { row_ln_mod(v, p.out + (size_t)row * D, nullptr, lng, lnb, nullptr, nullptr, lane); return; }
    const float* mb = MOD + ((size_t)ml * 3 + mod_group(row)) * 9216;
    row_ln_mod(v, X + (size_t)row * D, H + (size_t)row * D, lng, lnb, mb + ms * D, mb + (ms + 1) * D, lane);
}
DEVI void phase_rows(const P& p, unsigned char* ws_b, int l, int lnidx, int ml, int ms, bool final_, int gw, int ngw, int lane) {
    int row = gw;
    for (; row + ngw < M; row += 2 * ngw) {
        f32x4 va[4], vb[4];
        row_load(phase_rows_src(p, ws_b, row, lnidx), va, lane);
        row_load(phase_rows_src(p, ws_b, row + ngw, lnidx), vb, lane);
        phase_rows_one(p, ws_b, va, row, l, lnidx, ml, ms, final_, lane);
        phase_rows_one(p, ws_b, vb, row + ngw, l, lnidx, ml, ms, final_, lane);
    }
    if (row < M) { f32x4 va[4]; row_load(phase_rows_src(p, ws_b, row, lnidx), va, lane); phase_rows_one(p, ws_b, va, row, l, lnidx, ml, ms, final_, lane); }
}

DEVI void phase_rowmix(const P& p, unsigned char* ws_b, int l, int gw, int ngw, int lane) {
    bf16_t* UQ = (bf16_t*)(ws_b + WS_UQ);
    const float* UKV = (const float*)(ws_b + WS_UKV);
    const float* KRF = (const float*)(ws_b + WS_KRF);
    bf16_t* CKV = (bf16_t*)(ws_b + WS_CKV);
    bf16_t* KR = (bf16_t*)(ws_b + WS_KR);
    const float* ropec = (const float*)(ws_b + WS_ROPE);
    const float* ropes = ropec + 512;
    const float* gq = pin(p, 17) + l * 384;
    const float* gkv = pin(p, 19) + l * 256;
    for (int row = gw; row < M; row += ngw) {
        {
            unsigned* up = (unsigned*)(UQ + (size_t)row * 384) + lane;
            float x[6]; float ss = 0.f;
#pragma unroll
            for (int j = 0; j < 3; ++j) { const unsigned w = up[64 * j]; x[2 * j] = bf2f(w & 0xffffu); x[2 * j + 1] = bf2f(w >> 16); ss += x[2 * j] * x[2 * j] + x[2 * j + 1] * x[2 * j + 1]; }
            const float rs = rsqrtf(wave_sum(ss) * (1.f / 384.f) + 1e-6f);
#pragma unroll
            for (int j = 0; j < 3; ++j) { const int c = 2 * lane + 128 * j; up[64 * j] = pk2(x[2 * j] * rs * gq[c], x[2 * j + 1] * rs * gq[c + 1]); }
        }
        {
            const f32x4 v = *(const f32x4*)(UKV + (size_t)row * 256 + 4 * lane);
            const float ss = v.x * v.x + v.y * v.y + v.z * v.z + v.w * v.w;
            const float rs = rsqrtf(wave_sum(ss) * (1.f / 256.f) + 1e-6f);
            const f32x4 g = *(const f32x4*)(gkv + 4 * lane);
            const f32x4 o = v * rs * g;
            u32x2 pk; pk.x = pk2(o.x, o.y); pk.y = pk2(o.z, o.w);
            *(u32x2*)(CKV + (size_t)row * 256 + 4 * lane) = pk;
            if (row < NCTX) *(f32x4*)(p.out + OUT_CKV + ((size_t)((row >> 8) * 4 + l) * 256 + (row & 255)) * 256 + 4 * lane) = o;
        }
        {
            const float v = KRF[(size_t)row * 32 + (lane & 31)];
            const float pr = __shfl_xor(v, 8);
            float o = v;
            if (row >= NCTX) {
                const int c = lane & 31, axis = c >> 4, ii = c & 15, n = (row - NCTX) & 2047;
                const int pos = axis ? (n & 63) : (n >> 6);
                const float rot = (ii < 8) ? -pr : pr;
                o = v * ropec[pos * 8 + (ii & 7)] + rot * ropes[pos * 8 + (ii & 7)];
            }
            if (lane < 32) {
                KR[(size_t)row * 32 + lane] = f2bf(o);
                if (row < NCTX) p.out[OUT_KR + ((size_t)((row >> 8) * 4 + l) * 256 + (row & 255)) * 32 + lane] = v;
            }
        }
    }
}

DEVI void transpose_item(const float* __restrict__ src, int N, int c0, int k0, bf16_t* __restrict__ dst, int K, float* scr, int lane) {
#pragma unroll 8
    for (int i = 0; i < 32; ++i) { const int kk = 2 * i + (lane >> 5); scr[kk * 33 + (lane & 31)] = src[(size_t)(k0 + kk) * N + c0 + (lane & 31)]; }
    asm volatile("s_waitcnt lgkmcnt(0)" ::: "memory");
    const int c = lane & 7;
#pragma unroll
    for (int j = 0; j < 4; ++j) {
        const int n = (lane >> 3) + 8 * j; const float* s = scr + (8 * c) * 33 + n;
        u32x4 o; o.x = pk2(s[0], s[33]); o.y = pk2(s[2 * 33], s[3 * 33]); o.z = pk2(s[4 * 33], s[5 * 33]); o.w = pk2(s[6 * 33], s[7 * 33]);
        *(u32x4*)(dst + (size_t)n * K + k0 + 8 * c) = o;
    }
    asm volatile("s_waitcnt lgkmcnt(0)" ::: "memory");
}

DEVI void prep_weight_item(const P& p, unsigned char* ws_b, int item, float* scr, int lane) {
    const int l = item / 12944; int r = item % 12944;
    bf16_t* Wl = (bf16_t*)(ws_b + WS_W) + (size_t)l * LAYER_W;
    if (r < 8448) {
        const int which = r / 4224; r %= 4224;
        if (r < 2816) {
            const int rb = r >> 4, kb = r & 15;
            const int unit = rb >> 3, sub = rb & 7;
            const float* src = (sub < 4 ? (which ? pin(p, 13) : pin(p, 10)) : (which ? pin(p, 14) : pin(p, 11))) + (size_t)l * D * DFF;
            transpose_item(src, DFF, unit * 128 + (sub & 3) * 32, kb * 64, Wl + (which ? OFF_W13_2 : OFF_W13_1) + (size_t)rb * 32 * D, D, scr, lane);
        } else {
            r -= 2816; const int rb = r / 44, kb = r % 44;
            const float* src = (which ? pin(p, 15) : pin(p, 12)) + (size_t)l * DFF * D;
            transpose_item(src, D, rb * 32, kb * 64, Wl + (which ? OFF_W2_2 : OFF_W2_1) + (size_t)rb * 32 * DFF, DFF, scr, lane);
        }
        return;
    }
    r -= 8448;
    if (r < 2944) {
        const int rb = r >> 4, kb = r & 15, R0 = rb * 32;
        const float* src; int N, c0;
        if (R0 < 1184) { src = pin(p, 16) + (size_t)l * D * 2720; N = 2720; c0 = R0; }
        else if (R0 < 1280) return;
        else if (R0 < 2816) { src = pin(p, 16) + (size_t)l * D * 2720; N = 2720; c0 = R0 - 96; }
        else { src = pin(p, 25) + (size_t)l * D * 3072; N = 3072; c0 = R0 - 2816; }
        transpose_item(src, N, c0, kb * 64, Wl + OFF_WIN + (size_t)R0 * D, D, scr, lane);
        return;
    }
    r -= 2944;
    if (r < 512) { const int rb = r >> 4, kb = r & 15; transpose_item(pin(p, 27) + (size_t)l * D * D, D, rb * 32, kb * 64, Wl + OFF_WOUT + (size_t)rb * 32 * D, D, scr, lane); return; }
    r -= 512;
    if (r < 768) { const int w = r >> 8; r &= 255; const int rb = r >> 3, kb = r & 7;
        transpose_item((w == 0 ? pin(p, 22) : (w == 1 ? pin(p, 23) : pin(p, 24))) + (size_t)l * 512 * D, D, rb * 32, kb * 64, Wl + (w == 0 ? OFF_WBF : (w == 1 ? OFF_WBM : OFF_WBN)) + (size_t)rb * 32 * 512, 512, scr, lane); return; }
    r -= 768;
    if (r < 144) { const int rb = r / 6, kb = r % 6; transpose_item(pin(p, 18) + (size_t)l * 384 * 768, 768, rb * 32, kb * 64, Wl + OFF_WUQ + (size_t)rb * 32 * 384, 384, scr, lane); return; }
    r -= 144;
    { const int rb = r >> 2, kb = r & 3; transpose_item(pin(p, 20) + (size_t)l * 256 * 1024, 1024, rb * 32, kb * 64, Wl + OFF_WUKV + (size_t)rb * 32 * 256, 256, scr, lane); }
}

DEVI void phase_prep(const P& p, unsigned char* ws_b, unsigned char* smem, int tid) {
    const int lane = tid & 63, wave = tid >> 6;
    const int gw = blockIdx.x * NWAVES + wave, ngw = gridDim.x * NWAVES;
    const size_t gt = (size_t)blockIdx.x * NTHREADS + tid, ngt = (size_t)gridDim.x * NTHREADS;
    {
        float* sil = (float*)smem;
        const float* wada = pin(p, 8);
        float* MODP = (float*)(ws_b + WS_MODP);
        for (int item = blockIdx.x; item < 1152; item += gridDim.x) {
            const int l = item / 288, rem = item % 288, kc = rem / 18, cb = rem % 18;
            __syncthreads();
            if (tid < 192) {
                const int g = tid >> 6, k = kc * 64 + (tid & 63);
                const float cv = (g == 0) ? pin(p, 7)[k] : pin(p, 6)[(g - 1) * D + k];
                sil[tid] = cv * sigmoidf_(cv);
            }
            __syncthreads();
            const int col = cb * NTHREADS + tid;
            const float* w = wada + ((size_t)l * D + kc * 64) * 9216 + col;
            float a0 = 0.f, a1 = 0.f, a2 = 0.f;
#pragma unroll 16
            for (int k = 0; k < 64; ++k) { const float wv = w[(size_t)k * 9216]; a0 += sil[k] * wv; a1 += sil[64 + k] * wv; a2 += sil[128 + k] * wv; }
            float* o = MODP + ((size_t)(l * 16 + kc) * 3) * 9216 + col;
            o[0] = a0; o[9216] = a1; o[2 * 9216] = a2;
        }
        __syncthreads();
    }
    {
        float* scr = (float*)smem + wave * (64 * 33);
        for (int item = gw; item < 4 * 12944; item += ngw) prep_weight_item(p, ws_b, item, scr, lane);
    }
    {
        bf16_t* TABL = (bf16_t*)(ws_b + WS_TABL);
        for (size_t e = gt; e < (size_t)2048 * 4096; e += ngt) {
            const int k = (int)(e >> 12), kk = (int)(e & 4095), lidx = kk & 2047;
            const int idx = (k * lidx) & 2047;
            float sn, cs; sincospif((float)idx * (2.f / 2048.f), &sn, &cs);
            TABL[e] = f2bf((kk < 2048 ? cs : -sn) * 0.022097086912079608f);
        }
        bf16_t* TABC = (bf16_t*)(ws_b + WS_TABC);
        for (size_t e = gt; e < (size_t)256 * 512; e += ngt) {
            const int k = (int)(e >> 9), kk = (int)(e & 511), lidx = kk & 255;
            const int idx = (k * lidx) & 255;
            float sn, cs; sincospif((float)idx * (2.f / 256.f), &sn, &cs);
            TABC[e] = f2bf((kk < 256 ? cs : -sn) * 0.0625f);
        }
        bf16_t* WCS = (bf16_t*)(ws_b + WS_WCS);
        for (size_t e = gt; e < (size_t)256 * 128; e += ngt) {
            const int i = (int)(e >> 7), c = (int)(e & 127), m = i >> 1, cs_ = i & 1;
            const int idx = (m * c) & 127;
            float sn, cs; sincospif((float)idx * (2.f / 128.f), &sn, &cs);
            WCS[e] = f2bf((cs_ ? sn : cs) * 0.08838834764831845f);
        }
        float* ROPE = (float*)(ws_b + WS_ROPE);
        for (size_t e = gt; e < 512; e += ngt) {
            const int pos = (int)(e >> 3), i = (int)(e & 7);
            const float inv_freq = powf(10000.f, -(float)i / 8.f);
            const float ang = (float)pos * inv_freq;
            ROPE[e] = cosf(ang); ROPE[512 + e] = sinf(ang);
        }
    }
    {
        bf16_t* CCKV = (bf16_t*)(ws_b + WS_CCKV);
        for (size_t e = gt; e < (size_t)NL * 1024 * 256; e += ngt) {
            const int c = (int)(e & 255), i = (int)((e >> 8) & 511), b = (int)((e >> 17) & 1), l = (int)(e >> 18);
            CCKV[e] = f2bf(pin(p, 2)[((size_t)(b * 4 + l) * 512 + i) * 256 + c]);
        }
        bf16_t* CKR = (bf16_t*)(ws_b + WS_CKR);
        for (size_t e = gt; e < (size_t)NL * 1024 * 32; e += ngt) {
            const int c = (int)(e & 31), i = (int)((e >> 5) & 511), b = (int)((e >> 14) & 1), l = (int)(e >> 15);
            CKR[e] = f2bf(pin(p, 3)[((size_t)(b * 4 + l) * 512 + i) * 32 + c]);
        }
        bf16_t* CNAK = (bf16_t*)(ws_b + WS_CNAK);
        for (size_t e = gt; e < (size_t)NL * 1024 * 512; e += ngt) {
            const int c = (int)(e & 511), i = (int)((e >> 9) & 511), b = (int)((e >> 18) & 1), l = (int)(e >> 19);
            CNAK[e] = f2bf(pin(p, 4)[((size_t)(b * 4 + l) * 512 + i) * 512 + c]);
        }
        bf16_t* CNAVT = (bf16_t*)(ws_b + WS_CNAVT);
        for (size_t e = gt; e < (size_t)NL * 1024 * 512; e += ngt) {
            const int key = (int)(e & 511), hd = (int)((e >> 9) & 511), b = (int)((e >> 18) & 1), l = (int)(e >> 19);
            CNAVT[e] = f2bf(pin(p, 5)[((size_t)(b * 4 + l) * 512 + key) * 512 + hd]);
        }
    }
}

DEVI void phase_modreduce(const P& p, unsigned char* ws_b, int tid) {
    const float* MODP = (const float*)(ws_b + WS_MODP);
    float* MOD = (float*)(ws_b + WS_MOD);
    for (int e = blockIdx.x * NTHREADS + tid; e < NL * 3 * 9216; e += gridDim.x * NTHREADS) {
        const int l = e / (3 * 9216), rem = e % (3 * 9216);
        float a = pin(p, 9)[l * 9216 + (rem % 9216)];
#pragma unroll
        for (int kc = 0; kc < 16; ++kc) a += MODP[((size_t)(l * 16 + kc) * 3) * 9216 + rem];
        MOD[e] = a;
    }
}

#define XB_TMO      128
#define XB_XCNT(j)  (256  + 64 * (j))
#define XB_XSUB(j)  (1280 + 64 * (j))
#define XB_XGEN(j)  (2304 + 64 * (j))
#define XB_TOP      3328
#define XB_TOPGEN   3392
#define XCD_BAR_WORDS 3456
#define XB_SPIN_CAP (1u << 20)
#define LAS __attribute__((address_space(3)))
DEVI unsigned xb_ld(unsigned* p)              { return __hip_atomic_load(p, __ATOMIC_RELAXED, __HIP_MEMORY_SCOPE_AGENT); }
DEVI unsigned xb_add(unsigned* p, unsigned v) { return __hip_atomic_fetch_add(p, v, __ATOMIC_RELAXED, __HIP_MEMORY_SCOPE_AGENT); }
DEVI unsigned xb_xcc_id() { return (unsigned)__builtin_amdgcn_s_getreg((3 << 11) | 20) & 0xFu; }
#define XB_SPIN(cond, bar) do { unsigned _sp = 0; while (cond) { __builtin_amdgcn_s_sleep(1); \
    if ((++_sp & 255u) == 0u) { if (xb_ld(&(bar)[XB_TMO])) break; if (_sp > XB_SPIN_CAP) { atomicAdd(&(bar)[XB_TMO], 1u); break; } } } } while (0)
struct XcdBarrier { unsigned* bar; unsigned x; volatile LAS unsigned* st; };
DEVI XcdBarrier xcd_barrier_post(unsigned* bar, volatile LAS unsigned* st) {
    XcdBarrier b; b.bar = bar; b.x = xb_xcc_id(); b.st = st;
    if (threadIdx.x == 0) (void)xb_add(&bar[XB_XCNT(b.x)], 1u);
    return b;
}
DEVI void xcd_barrier_complete(unsigned* bar, unsigned x, unsigned& nloc, unsigned& nx) {
    const unsigned G = gridDim.x * gridDim.y * gridDim.z;
    unsigned sum, cnt, mine, sp = 0u;
    for (;;) {
        sum = 0u; cnt = 0u; mine = 0u;
#pragma unroll
        for (unsigned j = 0; j < 16; ++j) { const unsigned c = xb_ld(&bar[XB_XCNT(j)]); sum += c; cnt += (c > 0u) ? 1u : 0u; mine = (j == x) ? c : mine; }
        if (sum == G) break;
        __builtin_amdgcn_s_sleep(1);
        if ((++sp & 255u) == 0u) { if (xb_ld(&bar[XB_TMO])) break; if (sp > XB_SPIN_CAP) { atomicAdd(&bar[XB_TMO], 1u); break; } }
    }
    nloc = mine > 0u ? mine : 1u; nx = cnt > 0u ? cnt : 1u;
}
DEVI void xcd_barrier(const XcdBarrier& b) {
    asm volatile("s_waitcnt vmcnt(0)" ::: "memory");
    __syncthreads();
    if (threadIdx.x == 0) {
        unsigned* bar = b.bar;
        __builtin_amdgcn_s_waitcnt(0);
        unsigned nloc = b.st[0], nx = b.st[1];
        if (nloc == 0u) { xcd_barrier_complete(bar, b.x, nloc, nx); b.st[0] = nloc; b.st[1] = nx; }
        const unsigned old = xb_add(&bar[XB_XSUB(b.x)], 1u);
        const unsigned gen = old / nloc;
        if (old + 1u == (gen + 1u) * nloc) {
            __builtin_amdgcn_fence(__ATOMIC_RELEASE, "agent");
            asm volatile("s_waitcnt vmcnt(0)" ::: "memory");
            const unsigned og = xb_add(&bar[XB_TOP], 1u);
            const unsigned tg = og / nx;
            if (og + 1u == (tg + 1u) * nx) xb_add(&bar[XB_TOPGEN], 1u);
            else XB_SPIN(xb_ld(&bar[XB_TOPGEN]) == tg, bar);
            __builtin_amdgcn_fence(__ATOMIC_ACQUIRE, "agent");
            xb_add(&bar[XB_XGEN(b.x)], 1u);
            asm volatile("s_waitcnt vmcnt(0)" ::: "memory");
        } else {
            XB_SPIN(xb_ld(&bar[XB_XGEN(b.x)]) == gen, bar);
            __builtin_amdgcn_fence(__ATOMIC_ACQUIRE, "agent");
            asm volatile("s_waitcnt vmcnt(0)" ::: "memory");
        }
    }
    __syncthreads();
}

DEVI void run_phase(const P& p, unsigned char* ws_b, int ph, unsigned char* smem, int tid) {
    const int lane = tid & 63, wave = tid >> 6;
    const int gw = blockIdx.x * NWAVES + wave, ngw = gridDim.x * NWAVES;
    const int nb = gridDim.x, bid = blockIdx.x;
    const int grp = tid >> 8, ltid = tid & 255;
    bf16_t* sm = (bf16_t*)smem + grp * (SMEM_BYTES / 2);
    if (ph == 0) { phase_prep(p, ws_b, smem, tid); return; }
    if (ph == 1) { phase_modreduce(p, ws_b, tid); return; }
    if (ph == 2) { phase_rows(p, ws_b, 0, -1, 0, 0, false, gw, ngw, lane); return; }
    const int l = (ph - 3) / 13, s = (ph - 3) % 13;
    const bf16_t* Wl = (const bf16_t*)(ws_b + WS_W) + (size_t)l * LAYER_W;
    const float* MODl = (const float*)(ws_b + WS_MOD) + (size_t)l * 3 * 9216;
    switch (s) {
    case 0: case 10:
        {
            pg8::Gemm g{(const bf16_t*)(ws_b + WS_H), Wl + (s == 10 ? OFF_W13_2 : OFF_W13_1), M, 2 * DFF, D};
            pg8::StaticOrder S; S.init(M, 2 * DFF, nb, bid);
            pg8::EpiSwiGLU E{(bf16_t*)(ws_b + WS_ACT)};
            pg8::gemm_phase<pg8::EpiSwiGLU, pg8::StaticOrder, true, true>((PG8_LAS unsigned char*)smem, g, S, E, tid);
        }
        break;
    case 1: case 11:
        {
            pg8::Gemm g{(const bf16_t*)(ws_b + WS_ACT), Wl + (s == 11 ? OFF_W2_2 : OFF_W2_1), M, D, DFF};
            pg8::StaticOrder S; S.init(M, D, nb, bid);
            pg8::EpiResid E{(float*)(ws_b + WS_X), MODl + (s == 11 ? 8 : 2) * D, 0.5f};
            pg8::gemm_phase<pg8::EpiResid, pg8::StaticOrder, false, true>((PG8_LAS unsigned char*)smem, g, S, E, tid);
        }
        break;
    case 2: phase_rows(p, ws_b, l, 0, l, 3, false, gw, ngw, lane); break;
    case 3:
        {
            pg8::Gemm g{(const bf16_t*)(ws_b + WS_H), Wl + OFF_WIN, M, 5888, D};
            pg8::InGateOrder S{nb, bid, 0, nb == 256 ? 1024 : 1104};
            pg8::EpiIn E{ws_b, p.out, pin(p, 26), l};
            pg8::gemm_phase<pg8::EpiIn, pg8::InGateOrder, true, true>((PG8_LAS unsigned char*)smem, g, S, E, tid);
        }
        break;
    case 4: phase_rowmix(p, ws_b, l, gw, ngw, lane); break;
    case 5: {
        float* ex = (float*)smem + (wave & 3) * (34 * 64);
        int u = bid;
        for (; u < 256; u += nb) {
            const int wi = u * 4 + (wave & 3);
            float* rpb_lds = (float*)(smem + 36864);
            {
                const float* rsrc = pin(p, 21) + (size_t)(l * 8 + ((u * 4 >> 6) & 7)) * 465;
                if (tid < 465) rpb_lds[tid] = rsrc[tid] * LOG2E;
                __syncthreads();
            }
            attn_na_lat(p, ws_b, l, wi >> 9, (wi >> 6) & 7, (wi >> 1) & 31, wi & 1, lane, ex, wave >> 2, rpb_lds);
        }
        for (; u < 256 + 416; u += nb) job_ukv(p, ws_b, l, 2 * (u - 256) + grp, sm, ltid);
        for (; u < 256 + 416 + 288; u += nb) job_uq(p, ws_b, l, 2 * (u - 256 - 416) + grp, sm, ltid);
        for (; u < 256 + 416 + 288 + 384; u += nb) job_f1(p, ws_b, 2 * (u - 256 - 416 - 288) + grp, sm, ltid);
        for (; u < 256 + 416 + 288 + 384 + 256; u += nb) {
            const int wi = (u - 256 - 416 - 288 - 384) * 8 + wave;
            const int b = wi >> 6, h = (wi >> 3) & 7, qrow = b * 256 + wave * 32 + (lane & 31);
            attn_ctx_shared<4>((const bf16_t*)(ws_b + WS_NAK) + (size_t)(b * 256) * 512 + h * 64, nullptr,
                               (const bf16_t*)(ws_b + WS_NAVT) + (size_t)((b * 8 + h) * 64) * 256,
                               (const bf16_t*)(ws_b + WS_NAQ) + (size_t)qrow * 512 + h * 64 + (lane >> 5) * 8,
                               (bf16_t*)(ws_b + WS_YN) + (size_t)qrow * 512 + h * 64, tid, smem);
        }
    } break;
    case 6: {
        float* ex = (float*)smem + (wave & 3) * (34 * 64);
        int u = bid;
        for (; u < 256; u += nb) {
            const int wi = u * 4 + (wave & 3);
            attn_mla_lat_shared(p, ws_b, l, wi >> 9, (wi >> 6) & 7, wi & 63, tid, smem, ex);
        }
        for (; u < 256 + 128; u += nb) {
            const int t0 = u - 256, tt = ((t0 & 7) + 8 * ((t0 >> 3) >> 2)) * 4 + ((t0 >> 3) & 3);
            job_f2_lat(p, ws_b, tt, sm, ltid, grp, (float*)(smem + SMEM_BYTES));
        }
        for (; u < 256 + 128 + 128; u += nb) job_f2_ctx(p, ws_b, 2 * (u - 256 - 128) + grp, sm, ltid);
        int it = (nb == 256) ? (bid >= 128 ? bid - 128 : 1 << 20) : u - (256 + 128 + 128);
        for (; it < 256; ) {
            const int wi = it * 8 + wave;
            const int b = wi >> 6, h = (wi >> 3) & 7, qrow = b * 256 + wave * 32 + (lane & 31);
            attn_ctx_shared<6>((const bf16_t*)(ws_b + WS_KN) + (size_t)(b * 256) * 512 + h * 64, (const bf16_t*)(ws_b + WS_KR) + (size_t)(b * 256) * 32,
                               (const bf16_t*)(ws_b + WS_VTM) + (size_t)((b * 8 + h) * 64) * 256,
                               (const bf16_t*)(ws_b + WS_Q) + (size_t)qrow * 768 + h * 96 + (lane >> 5) * 8,
                               (bf16_t*)(ws_b + WS_YM) + (size_t)qrow * 512 + h * 64, tid, smem);
            if (nb != 256) it += nb;
            else if (bid < 208) it = 1 << 20;
            else it = (it < 128) ? 128 + (bid - 208) : it + 48;
        }
        if (nb == 256 && bid >= 128 && bid < 208) {
            int tid5 = tid; asm volatile("" : "+v"(tid5));
            pg8::Gemm g{(const bf16_t*)(ws_b + WS_H), Wl + OFF_WIN, M, 5888, D};
            pg8::InGateOrder S{1 << 20, bid - 128, 1024, 1104};
            pg8::EpiIn E{ws_b, p.out, pin(p, 26), l};
            pg8::gemm_phase<pg8::EpiIn, pg8::InGateOrder, false, true>((PG8_LAS unsigned char*)smem, g, S, E, tid5);
        }
    } break;
    case 7:

#pragma nounroll
        for (int sg = 0; sg < 3; ++sg) {
            int tid3 = tid; asm volatile("" : "+v"(tid3));
            pg8::Gemm g{(const bf16_t*)(ws_b + (sg == 0 ? WS_YF : (sg == 1 ? WS_YM : WS_YN))), Wl + (sg == 0 ? OFF_WBF : (sg == 1 ? OFF_WBM : OFF_WBN)), M, D, 512};
            pg8::StaticOrder S; S.init(M, D, nb, bid);
            pg8::EpiMerge E{(const bf16_t*)(ws_b + WS_GATE), (bf16_t*)(ws_b + WS_UF)  , (bf16_t*)(ws_b + WS_MERGED), sg};
            pg8::gemm_phase<pg8::EpiMerge, pg8::StaticOrder, false, true>((PG8_LAS unsigned char*)smem, g, S, E, tid3);
        }
        break;
    case 8:
        {
            pg8::Gemm g{(const bf16_t*)(ws_b + WS_MERGED), Wl + OFF_WOUT, M, D, D};
            pg8::StaticOrder S; S.init(M, D, nb, bid);
            pg8::EpiResid E{(float*)(ws_b + WS_X), MODl + 5 * D, 1.0f};
            pg8::gemm_phase<pg8::EpiResid, pg8::StaticOrder, false, true>((PG8_LAS unsigned char*)smem, g, S, E, tid);
        }
        break;
    case 9: phase_rows(p, ws_b, l, 1, l, 6, false, gw, ngw, lane); break;
    case 12:
        if (l == NL - 1) phase_rows(p, ws_b, l, 2, 0, 0, true, gw, ngw, lane);
        else phase_rows(p, ws_b, l, 2, l + 1, 0, false, gw, ngw, lane);
        break;
    default: break;
    }
}

__global__ void __launch_bounds__(NTHREADS, 2) mega_kernel(P p) {
    extern __shared__ __attribute__((aligned(16))) unsigned char smem[];
    __shared__ uint4 xb_words;
    cg::grid_group grid = cg::this_grid();
    const int tid = threadIdx.x;
    unsigned* bar = (unsigned*)(p.ws + WS_BAR);
    if (tid == 0) xb_words = make_uint4(0u, 0u, 0u, 0u);
    if (p.ph_lo == 0 && blockIdx.x == 0) for (int i = tid; i < XCD_BAR_WORDS; i += NTHREADS) bar[i] = 0u;
    __syncthreads();
    XcdBarrier xb; xb.bar = bar; xb.x = 0; xb.st = (volatile LAS unsigned*)&xb_words;
#pragma nounroll
    for (int ph = p.ph_lo; ph < p.ph_hi; ++ph) {
        int tid2 = tid; asm volatile("" : "+v"(tid2));
        unsigned char* ws_b = p.ws; asm volatile("" : "+s"(ws_b));
        run_phase(p, ws_b, ph, smem, tid2);
        if (ph + 1 < p.ph_hi) {
            if (ph == p.ph_lo) { grid.sync(); xb = xcd_barrier_post(bar, (volatile LAS unsigned*)&xb_words); }
            else xcd_barrier(xb);
        }
    }
}

extern "C" void kernel_launch(void* const* d_in, const int* in_sizes, int n_in, void* d_out, int out_size, void* d_ws, size_t ws_size,
                              hipStream_t stream) {
    static int grid_blocks = 0;
    if (grid_blocks == 0) {
        if (n_in != 30 || ws_size < WS_END) { fprintf(stderr, "kernel_launch: n_in %d ws %zu need %zu\n", n_in, ws_size, (size_t)WS_END); grid_blocks = -1; return; }
        int dev = 0, cus = 0, per_cu = 0;
        hipGetDevice(&dev);
        hipDeviceGetAttribute(&cus, hipDeviceAttributeMultiprocessorCount, dev);
        hipFuncSetAttribute((const void*)mega_kernel, hipFuncAttributeMaxDynamicSharedMemorySize, LDS_TOTAL);
        hipOccupancyMaxActiveBlocksPerMultiprocessor(&per_cu, (const void*)mega_kernel, NTHREADS, LDS_TOTAL);
        if (per_cu < 1) per_cu = 1;
        if (per_cu > 1) per_cu = 1;
        grid_blocks = cus * per_cu;
    }
    if (grid_blocks < 0) return;
    P p{};
    for (int i = 0; i < 30; ++i) p.in[i] = (const float*)d_in[i];
    p.out = (float*)d_out; p.ws = (unsigned char*)d_ws; p.ph_lo = 0; p.ph_hi = NPHASE;
#ifndef MULTI_LAUNCH
#define MULTI_LAUNCH 0
#endif
#if MULTI_LAUNCH
    for (int ph = 0; ph < NPHASE; ++ph) {
        p.ph_lo = ph; p.ph_hi = ph + 1;
        hipLaunchKernelGGL(mega_kernel, dim3(grid_blocks), dim3(NTHREADS), LDS_TOTAL, stream, p);
    }
#else
    void* args[] = {&p};
    hipError_t e = hipLaunchCooperativeKernel((const void*)mega_kernel, dim3(grid_blocks), dim3(NTHREADS), args, LDS_TOTAL, stream);
    if (e != hipSuccess) fprintf(stderr, "cooperative launch failed: %s (grid %d)\n", hipGetErrorString(e), grid_blocks);
#endif
}
```
